# Optimizing an MI355X kernel written in HIP

```python
import jax, jax.numpy as jnp
from jax import lax
import numpy as np

D_MODEL = 1024
BATCH = 8
SEQ = 4096
DEPTH = 2

GRID_W = 64
CTX_LEN = 256
N_HEADS = 8
N_KV_HEADS = 2
HEAD_DIM = 64
GQA_GROUP = N_HEADS // N_KV_HEADS
ATTN_WIDTH = N_HEADS * HEAD_DIM
KV_WIDTH = N_KV_HEADS * HEAD_DIM
Q_BLOCK = 128
ROPE_THETA = 10000.0
GMLP_GROUPS = 8
GMLP_GROUP_DIM = 64
GMLP_WIDTH = GMLP_GROUPS * GMLP_GROUP_DIM
CHUNK = 128
IN_PROJ_WIDTH = ATTN_WIDTH + 2 * KV_WIDTH + 2 * GMLP_WIDTH
MIX_WIDTH = ATTN_WIDTH + GMLP_WIDTH
POOL_WINDOWS = (2, 4, 8, 16)
POOL_GROUP_DIM = D_MODEL // len(POOL_WINDOWS)
D_FF = ((8 * D_MODEL // 3 + 255) // 256) * 256
N_EVEN = (DEPTH + 1) // 2
N_ODD = DEPTH // 2
EPS = 1e-6

kernel_name = "hybrid_gqa_gmlp_pool_dit_block"


def rms_norm(x, g):
    xf = x.astype(jnp.float32)
    y = xf * lax.rsqrt(jnp.mean(xf * xf, axis=-1, keepdims=True) + EPS)
    return (y * g.astype(jnp.float32)).astype(x.dtype)


def modulate(h, shift, scale):
    return h * (1.0 + scale) + shift


def adaln(cond, w_ada, b_ada):
    m = jax.nn.silu(cond) @ w_ada + b_ada
    return jnp.split(m, 6, axis=-1)


def axial_rope_tables(n):
    rows = n // GRID_W
    row = jnp.repeat(jnp.arange(rows), GRID_W).astype(jnp.float32)
    col = jnp.tile(jnp.arange(GRID_W), rows).astype(jnp.float32)
    half = HEAD_DIM // 2
    freqs = ROPE_THETA ** (-jnp.arange(0, half, 2, dtype=jnp.float32) / half)
    ang = jnp.concatenate([row[:, None] * freqs, col[:, None] * freqs], axis=-1)
    return jnp.cos(ang), jnp.sin(ang)


def apply_rope(x, cos, sin):
    xf = x.astype(jnp.float32)
    x1, x2 = xf[..., 0::2], xf[..., 1::2]
    c = cos[None, :, None, :]
    s = sin[None, :, None, :]
    out = jnp.stack([x1 * c - x2 * s, x1 * s + x2 * c], axis=-1).reshape(x.shape)
    return out.astype(x.dtype)


def attend(q, keys, vals):
    B, N = q.shape[0], q.shape[1]
    scale = HEAD_DIM ** -0.5
    qb = q.reshape(B, N // Q_BLOCK, Q_BLOCK, N_KV_HEADS, GQA_GROUP, HEAD_DIM).transpose(1, 0, 2, 3, 4, 5)

    def block(q_blk):
        s = jnp.einsum('bqkgd,bskd->bkgqs', q_blk, keys, preferred_element_type=jnp.float32) * scale
        p = jax.nn.softmax(s, axis=-1)
        return jnp.einsum('bkgqs,bskd->bqkgd', p.astype(vals.dtype), vals)

    out = lax.map(block, qb)
    return out.transpose(1, 0, 2, 3, 4, 5).reshape(B, N, ATTN_WIDTH)


def spatial_gating(u, v, g_v, w_s, b_s):
    B, N, _ = v.shape
    vg = rms_norm(v.reshape(B, N // CHUNK, CHUNK, GMLP_GROUPS, GMLP_GROUP_DIM), g_v)
    mixed = jnp.einsum('gpq,bnqgd->bnpgd', w_s, vg) + b_s.T[None, None, :, :, None]
    return u * mixed.reshape(B, N, GMLP_WIDTH)


def split_heads(t, h):
    return t.reshape(t.shape[0], t.shape[1], h, HEAD_DIM)


def attn_gmlp_mixer(xn, cn, w_in, w_out, q_norm, k_norm, g_v, w_s, b_s, cos, sin, ctx_live):
    splits = [ATTN_WIDTH, ATTN_WIDTH + KV_WIDTH, ATTN_WIDTH + 2 * KV_WIDTH,
              ATTN_WIDTH + 2 * KV_WIDTH + GMLP_WIDTH]
    qx, kx, vx, ux, gx = jnp.split(xn @ w_in, splits, axis=-1)
    qx = apply_rope(rms_norm(split_heads(qx, N_HEADS), q_norm), cos, sin)
    kx = apply_rope(rms_norm(split_heads(kx, N_KV_HEADS), k_norm), cos, sin)
    vx = split_heads(vx, N_KV_HEADS)
    if ctx_live:
        qc, kc, vc, uc, gc = jnp.split(cn @ w_in, splits, axis=-1)
    else:
        kc, vc = jnp.split(cn @ w_in[:, ATTN_WIDTH:ATTN_WIDTH + 2 * KV_WIDTH], [KV_WIDTH], axis=-1)
    kc = rms_norm(split_heads(kc, N_KV_HEADS), k_norm)
    vc = split_heads(vc, N_KV_HEADS)
    attn_x = attend(qx, jnp.concatenate([kx, kc], axis=1), jnp.concatenate([vx, vc], axis=1))
    gmlp_x = spatial_gating(jax.nn.gelu(ux, approximate=False), jax.nn.gelu(gx, approximate=False), g_v, w_s, b_s)
    out_x = jnp.concatenate([attn_x, gmlp_x], axis=-1) @ w_out
    out_c = None
    if ctx_live:
        qc = rms_norm(split_heads(qc, N_HEADS), q_norm)
        attn_c = attend(qc, kc, vc)
        gmlp_c = spatial_gating(jax.nn.gelu(uc, approximate=False), jax.nn.gelu(gc, approximate=False), g_v, w_s, b_s)
        out_c = jnp.concatenate([attn_c, gmlp_c], axis=-1) @ w_out
    return out_x, out_c


def multiscale_pool(h, w_pool, pool_scale):
    B, N, D = h.shape
    hf = h.astype(jnp.float32)
    cs = jnp.concatenate([jnp.zeros((B, 1, D), jnp.float32), jnp.cumsum(hf, axis=1)], axis=1)
    t = jnp.arange(N)
    outs = []
    for gi, w in enumerate(POOL_WINDOWS):
        left = w // 2
        right = w - 1 - left
        lo = jnp.clip(t - left, 0, N)
        hi = jnp.clip(t + right + 1, 0, N)
        sl = slice(gi * POOL_GROUP_DIM, (gi + 1) * POOL_GROUP_DIM)
        csg = cs[..., sl]
        cnt = (hi - lo).astype(jnp.float32)[None, :, None]
        mean = (jnp.take(csg, hi, axis=1) - jnp.take(csg, lo, axis=1)) / cnt
        outs.append(mean - hf[..., sl])
    pooled = jnp.stack(outs, axis=2).astype(h.dtype)
    y = jnp.einsum('bngc,gcd->bngd', pooled, w_pool).reshape(B, N, D)
    return y * pool_scale


def swiglu(h, w1, w3, w2):
    return (jax.nn.silu(h @ w1) * (h @ w3)) @ w2


def setup_inputs(seed: int = 0) -> dict:
    key = jax.random.key(seed)
    ks = iter(jax.random.split(key, 32))
    f32 = jnp.float32

    def nrm(shape, scale):
        return jax.random.normal(next(ks), shape, f32) * scale

    D = D_MODEL
    return {
        "x": nrm((BATCH, SEQ, D), 1.0),
        "c": nrm((BATCH, D), 1.0),
        "ctx": nrm((BATCH, CTX_LEN, D), 1.0),
        "c_ctx": nrm((D,), 1.0),
        "w_ada": nrm((DEPTH, D, 6 * D), 0.5 * D ** -0.5),
        "b_ada": nrm((DEPTH, 6 * D), 0.02),
        "g_mix": 1.0 + nrm((DEPTH, D), 0.05),
        "g_ffn": 1.0 + nrm((DEPTH, D), 0.05),
        "w_in": nrm((N_EVEN, D, IN_PROJ_WIDTH), D ** -0.5),
        "w_out": nrm((N_EVEN, MIX_WIDTH, D), MIX_WIDTH ** -0.5),
        "q_norm": 1.0 + nrm((N_EVEN, HEAD_DIM), 0.05),
        "k_norm": 1.0 + nrm((N_EVEN, HEAD_DIM), 0.05),
        "gmlp_norm": 1.0 + nrm((N_EVEN, GMLP_GROUPS, GMLP_GROUP_DIM), 0.05),
        "w_spatial": nrm((N_EVEN, GMLP_GROUPS, CHUNK, CHUNK), 0.5 * CHUNK ** -0.5),
        "b_spatial": 1.0 + nrm((N_EVEN, GMLP_GROUPS, CHUNK), 0.1),
        "w_pool": nrm((N_ODD, len(POOL_WINDOWS), POOL_GROUP_DIM, POOL_GROUP_DIM), POOL_GROUP_DIM ** -0.5),
        "pool_scale": 1.0 + nrm((N_ODD, D), 0.1),
        "w1": nrm((DEPTH, D, D_FF), D ** -0.5),
        "w3": nrm((DEPTH, D, D_FF), D ** -0.5),
        "w2": nrm((DEPTH, D_FF, D), D_FF ** -0.5),
        "g_final": 1.0 + nrm((D,), 0.05),
    }


def reference(x, c, ctx, c_ctx, w_ada, b_ada, g_mix, g_ffn, w_in, w_out, q_norm, k_norm,
              gmlp_norm, w_spatial, b_spatial, w_pool, pool_scale, w1, w3, w2, g_final):
    S = x.shape[1]
    cos, sin = axial_rope_tables(S)
    h_ctx = ctx
    for i in range(DEPTH):
        ctx_live = any(j % 2 == 0 for j in range(i + 1, DEPTH))
        sh1, sc1, ga1, sh2, sc2, ga2 = [m[:, None, :] for m in adaln(c, w_ada[i], b_ada[i])]
        csh1, csc1, cga1, csh2, csc2, cga2 = adaln(c_ctx, w_ada[i], b_ada[i])
        xn = modulate(rms_norm(x, g_mix[i]), sh1, sc1)
        if i % 2 == 0:
            e = i // 2
            cn = modulate(rms_norm(h_ctx, g_mix[i]), csh1, csc1)
            mix_x, mix_c = attn_gmlp_mixer(xn, cn, w_in[e], w_out[e], q_norm[e], k_norm[e], gmlp_norm[e],
                                           w_spatial[e], b_spatial[e], cos, sin, ctx_live)
        else:
            o = i // 2
            mix_x = multiscale_pool(xn, w_pool[o], pool_scale[o])
            mix_c = None
            if ctx_live:
                cn = modulate(rms_norm(h_ctx, g_mix[i]), csh1, csc1)
                mix_c = multiscale_pool(cn, w_pool[o], pool_scale[o])
        x = x + ga1 * mix_x
        x = x + ga2 * swiglu(modulate(rms_norm(x, g_ffn[i]), sh2, sc2), w1[i], w3[i], w2[i])
        if ctx_live:
            h_ctx = h_ctx + cga1 * mix_c
            h_ctx = h_ctx + cga2 * swiglu(modulate(rms_norm(h_ctx, g_ffn[i]), csh2, csc2), w1[i], w3[i], w2[i])
    return rms_norm(x, g_final)
```

```cpp
#include <hip/hip_runtime.h>
#include <cstdio>
#include <cstdint>

namespace ref {
constexpr int D = 1024, B = 8, S = 4096, M = B * S, CTX = 256, MC = B * CTX;
constexpr int NH = 8, NKV = 2, HD = 64, AW = 512, KVW = 128, GW = 512, INW = 1792, FF = 2816;
constexpr int SKV = S + CTX;
constexpr float EPS = 1e-6f;

__device__ __forceinline__ float silu_f(float v) { return v / (1.f + expf(-v)); }
__device__ __forceinline__ float gelu_f(float v) { return 0.5f * v * (1.f + erff(v * 0.70710678118654752f)); }

__global__ void __launch_bounds__(256) k_adaln(const float* c, const float* cctx, const float* w_ada, const float* b_ada, float* mods) {
    const int n = blockIdx.x * 256 + threadIdx.x;
    const int l = blockIdx.y;
    __shared__ float sc[9][D];
    for (int i = threadIdx.x; i < 9 * D; i += 256) { const int bb = i / D, k = i % D; const float v = bb < 8 ? c[bb * D + k] : cctx[k]; sc[bb][k] = silu_f(v); }
    __syncthreads();
    float acc[9];
#pragma unroll
    for (int j = 0; j < 9; ++j) acc[j] = 0.f;
    const float* w = w_ada + (size_t)l * D * 6 * D + n;
    for (int k = 0; k < D; ++k) { const float wv = w[(size_t)k * 6 * D];
#pragma unroll
        for (int j = 0; j < 9; ++j) acc[j] += sc[j][k] * wv; }
    const float bv = b_ada[l * 6 * D + n];
#pragma unroll
    for (int j = 0; j < 9; ++j) mods[((size_t)l * 9 + j) * 6 * D + n] = acc[j] + bv;
}

__global__ void __launch_bounds__(256) k_normmod(const float* x, const float* g, const float* modl, int sh_off, int sc_off, int rows_per_b, int fixed_bb, float* out) {
    const int row = blockIdx.x; const float* xr = x + (size_t)row * D;
    float v[4]; float s = 0.f;
#pragma unroll
    for (int j = 0; j < 4; ++j) { v[j] = xr[threadIdx.x + 256 * j]; s += v[j] * v[j]; }
    __shared__ float red[256];
    red[threadIdx.x] = s; __syncthreads();
    for (int o = 128; o > 0; o >>= 1) { if (threadIdx.x < o) red[threadIdx.x] += red[threadIdx.x + o]; __syncthreads(); }
    const float r = rsqrtf(red[0] * (1.f / D) + EPS);
    const int bb = fixed_bb >= 0 ? fixed_bb : row / rows_per_b;
#pragma unroll
    for (int j = 0; j < 4; ++j) { const int cidx = threadIdx.x + 256 * j; float y = v[j] * r * g[cidx];
        if (modl) y = y * (1.f + modl[(size_t)bb * 6 * D + sc_off + cidx]) + modl[(size_t)bb * 6 * D + sh_off + cidx];
        out[(size_t)row * D + cidx] = y; }
}

template <int MODE>
__global__ void __launch_bounds__(256) k_gemm(const float* A, int lda, const float* Bm, const float* B2, int ldb, float* C, int ldc, int K,
                                              const float* gate, int gate_stride, const float* cscale, int rows_per_b) {
    __shared__ float sA[16][64 + 4], sB[16][64 + 4], sB2[MODE == 2 ? 16 : 1][64 + 4];
    const int tx = threadIdx.x & 15, ty = threadIdx.x >> 4;
    const int r0 = blockIdx.y * 64, c0 = blockIdx.x * 64;
    float acc[4][4], acc2[4][4];
#pragma unroll
    for (int i = 0; i < 4; ++i)
#pragma unroll
        for (int j = 0; j < 4; ++j) { acc[i][j] = 0.f; acc2[i][j] = 0.f; }
    for (int k0 = 0; k0 < K; k0 += 16) {
#pragma unroll
        for (int i = 0; i < 4; ++i) { const int e = threadIdx.x + 256 * i; const int rr = e >> 4, kk = e & 15; sA[kk][rr] = A[(size_t)(r0 + rr) * lda + k0 + kk]; }
#pragma unroll
        for (int i = 0; i < 4; ++i) { const int e = threadIdx.x + 256 * i; const int kk = e >> 6, cc = e & 63; sB[kk][cc] = Bm[(size_t)(k0 + kk) * ldb + c0 + cc];
            if (MODE == 2) sB2[kk][cc] = B2[(size_t)(k0 + kk) * ldb + c0 + cc]; }
        __syncthreads();
#pragma unroll
        for (int kk = 0; kk < 16; ++kk) {
            float a[4], b[4], b2[4];
#pragma unroll
            for (int i = 0; i < 4; ++i) a[i] = sA[kk][ty * 4 + i];
#pragma unroll
            for (int j = 0; j < 4; ++j) { b[j] = sB[kk][tx * 4 + j]; if (MODE == 2) b2[j] = sB2[kk][tx * 4 + j]; }
#pragma unroll
            for (int i = 0; i < 4; ++i)
#pragma unroll
                for (int j = 0; j < 4; ++j) { acc[i][j] += a[i] * b[j]; if (MODE == 2) acc2[i][j] += a[i] * b2[j]; }
        }
        __syncthreads();
    }
#pragma unroll
    for (int i = 0; i < 4; ++i) { const int r = r0 + ty * 4 + i;
#pragma unroll
        for (int j = 0; j < 4; ++j) { const int cc = c0 + tx * 4 + j; float* p = C + (size_t)r * ldc + cc;
            if (MODE == 0) *p = acc[i][j];
            else if (MODE == 1) { float v = acc[i][j] * gate[(size_t)(r / rows_per_b) * gate_stride + cc]; if (cscale) v *= cscale[cc]; *p += v; }
            else *p = silu_f(acc[i][j]) * acc2[i][j]; } }
}

__global__ void __launch_bounds__(64) k_qkv_latent(const float* P, const float* qn, const float* kn, float* Q, float* Kb, float* Vb) {
    const int row = blockIdx.x, slot = blockIdx.y;
    const int b = row / S, t = row % S, d = threadIdx.x;
    const float* pr = P + (size_t)row * INW;
    if (slot >= 10) { const int hv = slot - 10; Vb[((size_t)b * SKV + t) * KVW + hv * HD + d] = pr[640 + hv * HD + d]; return; }
    const float v = slot < 8 ? pr[slot * HD + d] : pr[512 + (slot - 8) * HD + d];
    __shared__ float sv[64];
    float s = v * v;
    for (int o = 32; o > 0; o >>= 1) s += __shfl_xor(s, o);
    const float r = rsqrtf(s * (1.f / HD) + EPS);
    const float y = v * r * (slot < 8 ? qn[d] : kn[d]);
    sv[d] = y; __syncthreads();
    const int i = d >> 1;
    const float pos = i < 16 ? (float)(t / 64) : (float)(t % 64);
    const float fr = powf(10000.f, -(float)(2 * (i & 15)) / 32.f);
    const float ang = pos * fr, cs = cosf(ang), sn = sinf(ang);
    const float x1 = sv[2 * i], x2 = sv[2 * i + 1];
    const float o = (d & 1) ? (x1 * sn + x2 * cs) : (x1 * cs - x2 * sn);
    if (slot < 8) Q[(size_t)row * AW + slot * HD + d] = o;
    else Kb[((size_t)b * SKV + t) * KVW + (slot - 8) * HD + d] = o;
}
__global__ void __launch_bounds__(64) k_kv_ctx(const float* Pc, const float* kn, float* Kb, float* Vb) {
    const int row = blockIdx.x, slot = blockIdx.y;
    const int b = row / CTX, t = row % CTX, d = threadIdx.x;
    const float* pr = Pc + (size_t)row * 256;
    if (slot >= 2) { Vb[((size_t)b * SKV + S + t) * KVW + (slot - 2) * HD + d] = pr[128 + (slot - 2) * HD + d]; return; }
    const float v = pr[slot * HD + d];
    float s = v * v;
    for (int o = 32; o > 0; o >>= 1) s += __shfl_xor(s, o);
    const float r = rsqrtf(s * (1.f / HD) + EPS);
    Kb[((size_t)b * SKV + S + t) * KVW + slot * HD + d] = v * r * kn[d];
}
__global__ void __launch_bounds__(64) k_gmlp_prep(float* P, const float* gv) {
    const int row = blockIdx.x, g = blockIdx.y, d = threadIdx.x;
    float* pr = P + (size_t)row * INW;
    pr[768 + g * 64 + d] = gelu_f(pr[768 + g * 64 + d]);
    const float v = gelu_f(pr[1280 + g * 64 + d]);
    float s = v * v;
    for (int o = 32; o > 0; o >>= 1) s += __shfl_xor(s, o);
    pr[1280 + g * 64 + d] = v * rsqrtf(s * (1.f / 64) + EPS) * gv[g * 64 + d];
}
__global__ void __launch_bounds__(256) k_gmlp(const float* P, const float* ws, const float* bs, float* AM) {
    const int chunk = blockIdx.x, g = blockIdx.y;
    __shared__ float sv[128][64];
    for (int i = threadIdx.x; i < 128 * 64; i += 256) { const int q = i >> 6, d = i & 63; sv[q][d] = P[(size_t)(chunk * 128 + q) * INW + 1280 + g * 64 + d]; }
    __syncthreads();
    const int d = threadIdx.x & 63, pg = threadIdx.x >> 6;
    for (int p = pg; p < 128; p += 4) {
        const float* w = ws + ((size_t)g * 128 + p) * 128; float a = 0.f;
        for (int q = 0; q < 128; ++q) a += w[q] * sv[q][d];
        const size_t row = (size_t)chunk * 128 + p;
        AM[row * D + 512 + g * 64 + d] = P[row * INW + 768 + g * 64 + d] * (a + bs[g * 128 + p]);
    }
}
__global__ void __launch_bounds__(256) k_attn(const float* Q, const float* Kb, const float* Vb, float* AM) {
    const int b = blockIdx.z, h = blockIdx.y, t = blockIdx.x * 256 + threadIdx.x, kvh = h / 4;
    __shared__ float sk[32][64], sv[32][64];
    float q[64], o[64];
    const float* qp = Q + ((size_t)b * S + t) * AW + h * HD;
#pragma unroll
    for (int d = 0; d < 64; ++d) { q[d] = qp[d] * 0.125f; o[d] = 0.f; }
    float mx = -1e30f, l = 0.f;
    for (int k0 = 0; k0 < SKV; k0 += 32) {
        __syncthreads();
        for (int i = threadIdx.x; i < 32 * 64; i += 256) { const int kk = i >> 6, d = i & 63; const size_t off = ((size_t)b * SKV + k0 + kk) * KVW + kvh * HD + d; sk[kk][d] = Kb[off]; sv[kk][d] = Vb[off]; }
        __syncthreads();
        for (int kk = 0; kk < 32; ++kk) {
            float s = 0.f;
#pragma unroll
            for (int d = 0; d < 64; ++d) s += q[d] * sk[kk][d];
            if (s > mx) { const float f = expf(mx - s); l *= f;
#pragma unroll
                for (int d = 0; d < 64; ++d) o[d] *= f;
                mx = s; }
            const float p = expf(s - mx); l += p;
#pragma unroll
            for (int d = 0; d < 64; ++d) o[d] += p * sv[kk][d];
        }
    }
    const float il = 1.f / l;
    float* op = AM + ((size_t)b * S + t) * D + h * HD;
#pragma unroll
    for (int d = 0; d < 64; ++d) op[d] = o[d] * il;
}
__global__ void __launch_bounds__(256) k_pool(const float* xn, float* pooled) {
    const int row = blockIdx.x, b = row / S, t = row % S;
#pragma unroll
    for (int j = 0; j < 4; ++j) { const int cidx = threadIdx.x + 256 * j; const int g = cidx >> 8; const int w = 2 << g, left = w / 2, right = w - 1 - left;
        int lo = t - left; if (lo < 0) lo = 0; int hi = t + right + 1; if (hi > S) hi = S;
        float s = 0.f; for (int u = lo; u < hi; ++u) s += xn[((size_t)b * S + u) * D + cidx];
        pooled[(size_t)row * D + cidx] = s / (float)(hi - lo) - xn[(size_t)row * D + cidx]; }
}
}

extern "C" void kernel_launch(void* const* d_in, const int* in_sizes, int n_in, void* d_out, int out_size, void* d_ws, size_t ws_size, hipStream_t stream) {
    using namespace ref;
    const float* x = (const float*)d_in[0]; const float* c = (const float*)d_in[1]; const float* ctx = (const float*)d_in[2]; const float* c_ctx = (const float*)d_in[3];
    const float* w_ada = (const float*)d_in[4]; const float* b_ada = (const float*)d_in[5]; const float* g_mix = (const float*)d_in[6]; const float* g_ffn = (const float*)d_in[7];
    const float* w_in = (const float*)d_in[8]; const float* w_out = (const float*)d_in[9]; const float* q_norm = (const float*)d_in[10]; const float* k_norm = (const float*)d_in[11];
    const float* gmlp_norm = (const float*)d_in[12]; const float* w_spatial = (const float*)d_in[13]; const float* b_spatial = (const float*)d_in[14];
    const float* w_pool = (const float*)d_in[15]; const float* pool_scale = (const float*)d_in[16]; const float* w1 = (const float*)d_in[17]; const float* w3 = (const float*)d_in[18];
    const float* w2 = (const float*)d_in[19]; const float* g_final = (const float*)d_in[20];
    float* out = (float*)d_out; char* ws = (char*)d_ws;
    const size_t MiB = 1u << 20;
    float* R0 = (float*)(ws);
    float* R1 = (float*)(ws + 128 * MiB);
    float* Kb = (float*)(ws + 352 * MiB);
    float* Vb = (float*)(ws + 370 * MiB);
    float* Pc = (float*)(ws + 388 * MiB);
    float* cn = (float*)(ws + 390 * MiB);
    float* mods = (float*)(ws + 398 * MiB);
    float* Qb = (float*)(ws + 400 * MiB);
    const int SH1 = 0, SC1 = D, GA1 = 2 * D, SH2 = 3 * D, SC2 = 4 * D, GA2 = 5 * D;

    k_adaln<<<dim3(6 * D / 256, 2), 256, 0, stream>>>(c, c_ctx, w_ada, b_ada, mods);
    hipMemcpyAsync(out, x, (size_t)M * D * 4, hipMemcpyDeviceToDevice, stream);
    for (int l = 0; l < 2; ++l) {
        const float* modl = mods + (size_t)l * 9 * 6 * D;
        k_normmod<<<M, 256, 0, stream>>>(out, g_mix + l * D, modl, SH1, SC1, S, -1, R0);
        if (l == 0) {
            k_normmod<<<MC, 256, 0, stream>>>(ctx, g_mix, modl, SH1, SC1, CTX, 8, cn);
            k_gemm<0><<<dim3(INW / 64, M / 64), 256, 0, stream>>>(R0, D, w_in, nullptr, INW, R1, INW, D, nullptr, 0, nullptr, S);
            k_gemm<0><<<dim3(256 / 64, MC / 64), 256, 0, stream>>>(cn, D, w_in + 512, nullptr, INW, Pc, 256, D, nullptr, 0, nullptr, S);
            k_qkv_latent<<<dim3(M, 12), 64, 0, stream>>>(R1, q_norm, k_norm, Qb, Kb, Vb);
            k_kv_ctx<<<dim3(MC, 4), 64, 0, stream>>>(Pc, k_norm, Kb, Vb);
            k_gmlp_prep<<<dim3(M, 8), 64, 0, stream>>>(R1, gmlp_norm);
            k_attn<<<dim3(S / 256, NH, B), 256, 0, stream>>>(Qb, Kb, Vb, R0);
            k_gmlp<<<dim3(M / 128, 8), 256, 0, stream>>>(R1, w_spatial, b_spatial, R0);
            k_gemm<1><<<dim3(D / 64, M / 64), 256, 0, stream>>>(R0, D, w_out, nullptr, D, out, D, D, modl + GA1, 6 * D, nullptr, S);
        } else {
            k_pool<<<M, 256, 0, stream>>>(R0, R1);
            for (int g = 0; g < 4; ++g)
                k_gemm<1><<<dim3(256 / 64, M / 64), 256, 0, stream>>>(R1 + g * 256, D, w_pool + (size_t)g * 256 * 256, nullptr, 256, out + g * 256, D, 256, modl + GA1 + g * 256, 6 * D, pool_scale + g * 256, S);
        }
        k_normmod<<<M, 256, 0, stream>>>(out, g_ffn + l * D, modl, SH2, SC2, S, -1, R0);
        for (int half = 0; half < 2; ++half) {
            const size_t ro = (size_t)half * (M / 2);
            k_gemm<2><<<dim3(FF / 64, M / 2 / 64), 256, 0, stream>>>(R0 + ro * D, D, w1 + (size_t)l * D * FF, w3 + (size_t)l * D * FF, FF, R1, FF, D, nullptr, 0, nullptr, S);
            k_gemm<1><<<dim3(D / 64, M / 2 / 64), 256, 0, stream>>>(R1, FF, w2 + (size_t)l * FF * D, nullptr, D, out + ro * D, D, FF, modl + GA2 + (size_t)(half * 4) * 6 * D, 6 * D, nullptr, S);
        }
    }
    k_normmod<<<M, 256, 0, stream>>>(out, g_final, nullptr, 0, 0, S, -1, out);
}
```

```cpp
#include <hip/hip_runtime.h>
#include <hip/hip_bf16.h>
#include <cstdio>
#include <cstdint>
#include <cmath>
namespace pg8 {
#define PG8_LAS __attribute__((address_space(3)))
typedef unsigned short bf16_t;
typedef short bf16x8 __attribute__((ext_vector_type(8)));
typedef float f32x4 __attribute__((ext_vector_type(4)));
typedef float f32x2 __attribute__((ext_vector_type(2)));
typedef unsigned u32x4 __attribute__((ext_vector_type(4)));
constexpr int BM = 256, BK = 64, HALF = 128, HTB = HALF * BK * 2  , STAGE_BYTES = 8 * HTB, NXCD = 8, WGM = 8;

__host__ __device__ __forceinline__ int lds_byte(int r, int c) { const int st = (r >> 4) * 2 + (c >> 5), rr = r & 15, cc = c & 31, ob = rr * 64 + cc * 2; return st * 1024 + (ob ^ (((ob >> 9) & 1) << 5)); }
__host__ __device__ __forceinline__ void stage_rc(int b, int& R, int& C) { const int st = b / 1024, sb = b % 1024, swz = sb ^ (((sb >> 9) & 1) << 5); R = (st >> 1) * 16 + swz / 64; C = (st & 1) * 32 + (swz % 64) / 2; }
__host__ __device__ __forceinline__ int perm32(int rho) { const int n = rho >> 4, i = rho & 15; return 8 * (i >> 2) + 4 * n + (i & 3); }

struct Unit { int pm, pn; };
struct Gemm { const bf16_t* A; const bf16_t* Bt; int K; int lda; int a_pn_bytes; };

struct StaticOrder {
    int nM, nN, nwg, G, c, extra, extra_pn;
    __host__ __device__ void init(int M, int N, int G_, int c_, int extra_ = 0, int extra_pn_ = 0) { nM = M / BM; nN = N / BM; nwg = nM * nN; G = G_; c = c_; extra = extra_; extra_pn = extra_pn_; }
    __host__ __device__ bool next(int i, Unit& u) const {
        const long L = (long)i * G + c;
        if (L >= nwg) { const long e = L - nwg; if (e >= extra) return false; u.pm = nM + (int)e; u.pn = extra_pn; return true; }
        int wgid = (int)L; { const int q = nwg / NXCD, r = nwg % NXCD, xcd = wgid % NXCD, off = wgid / NXCD; wgid = (xcd < r ? xcd * (q + 1) : r * (q + 1) + (xcd - r) * q) + off; }
        const int nig = WGM * nN, gid = wgid / nig, fm = gid * WGM, gsz = (nM - fm) < WGM ? (nM - fm) : WGM;
        u.pm = fm + ((wgid % nig) % gsz); u.pn = (wgid % nig) / gsz; return true;
    }
    __device__ __forceinline__ void a_ready(const Unit&) const {}
    __device__ __forceinline__ void done(const Unit&) const {}
};

__device__ __forceinline__ unsigned cvt_pk_bf16(float lo, float hi) { unsigned r; asm volatile("v_cvt_pk_bf16_f32 %0, %1, %2" : "=v"(r) : "v"(lo), "v"(hi)); return r; }
__device__ __forceinline__ f32x2 gelu_pk(f32x2 v) {
    const f32x2 av = __builtin_elementwise_abs(v), d = av * 0.2316418882f + 1.0f;
    f32x2 t; t.x = __builtin_amdgcn_rcpf(d.x); t.y = __builtin_amdgcn_rcpf(d.y);
    f32x2 q = t * 0.5307027145f + (-0.7265760135f); q = q * t + 0.7107068705f; q = q * t + (-0.142248368f); q = q * t + 0.127414796f; q = q * t;
    const f32x2 s = (v * v) * (-0.72134752044f);
    f32x2 e; e.x = __builtin_amdgcn_exp2f(s.x); e.y = __builtin_amdgcn_exp2f(s.y);
    const f32x2 m = v * (q * e), r = v - m;
    f32x2 o; o.x = v.x < 0.f ? m.x : r.x; o.y = v.y < 0.f ? m.y : r.y; return o;
}
__device__ __forceinline__ f32x4 gelu4(f32x4 v) { const f32x2 a = gelu_pk((f32x2){v[0], v[1]}), b = gelu_pk((f32x2){v[2], v[3]}); return (f32x4){a.x, a.y, b.x, b.y}; }
__device__ __forceinline__ float silu1(float v) { return v * __builtin_amdgcn_rcpf(1.0f + __builtin_amdgcn_exp2f(v * -1.4426950408889634f)); }
__device__ __forceinline__ u32x4 pack8(f32x4 v0, f32x4 v1) { u32x4 w; w.x = cvt_pk_bf16(v0[0], v0[1]); w.y = cvt_pk_bf16(v0[2], v0[3]); w.z = cvt_pk_bf16(v1[0], v1[1]); w.w = cvt_pk_bf16(v1[2], v1[3]); return w; }

struct EpiInProj {
    static constexpr bool PERM = true, AFTER_DRAIN = false;
    bf16_t *Q, *KB, *VB, *U, *VG; const float *qn, *kn, *gv, *ropeC, *ropeS; float qscale;
    __device__ __forceinline__ void operator()(const f32x4 (&acc)[2][2][4][2], const Unit& u, int wr, int wc, int fr_, int fq_) const {
        int fr = fr_, fq = fq_; asm volatile("" : "+v"(fr), "+v"(fq));
        const int slot = 4 * u.pn + wc; const bool isctx = u.pm >= 128;
        const int rowl = wr * 64 + fr;
        const int row0 = u.pm * BM + rowl;
        const int kvrow0 = (isctx ? (u.pm - 128) * 4352 + 4096 : (u.pm >> 4) * 4352 + (u.pm & 15) * 256) + rowl;
        const int dl = 8 * fq;
        if (slot < 10) {
            const float* nw = slot < 8 ? qn : kn; const float osc = slot < 8 ? qscale : 1.0f;
            f32x4 w[2][2];
#pragma unroll
            for (int bj = 0; bj < 2; ++bj)
#pragma unroll
                for (int n = 0; n < 2; ++n) w[bj][n] = *(const f32x4*)(nw + 32 * bj + dl + 4 * n);
#pragma unroll
            for (int ai = 0; ai < 2; ++ai) {
                const int posr = (4 * u.pm + 2 * ai + wr) & 63;
                const f32x4 cr = *(const f32x4*)(ropeC + posr * 16 + 4 * fq), sr = *(const f32x4*)(ropeS + posr * 16 + 4 * fq);
#pragma unroll
                for (int m = 0; m < 4; ++m) {
                    float ss = 0.f;
#pragma unroll
                    for (int bj = 0; bj < 2; ++bj)
#pragma unroll
                        for (int n = 0; n < 2; ++n) { const f32x4 x = acc[ai][bj][m][n]; ss += (x[0] * x[0] + x[1] * x[1]) + (x[2] * x[2] + x[3] * x[3]); }
                    ss += __shfl_xor(ss, 16); ss += __shfl_xor(ss, 32);
                    const float r = __builtin_amdgcn_rsqf(ss * (1.0f / 64.0f) + 1e-6f) * osc;
                    const int posc = 16 * m + fr;
                    const f32x4 cc = *(const f32x4*)(ropeC + posc * 16 + 4 * fq), sc = *(const f32x4*)(ropeS + posc * 16 + 4 * fq);
#pragma unroll
                    for (int bj = 0; bj < 2; ++bj) {
                        f32x4 v0 = acc[ai][bj][m][0] * r * w[bj][0], v1 = acc[ai][bj][m][1] * r * w[bj][1];
                        if (!isctx) { const f32x4 c = bj ? cc : cr, s = bj ? sc : sr;
                            const f32x4 o0 = (f32x4){v0[0] * c[0] - v0[1] * s[0], v0[0] * s[0] + v0[1] * c[0], v0[2] * c[1] - v0[3] * s[1], v0[2] * s[1] + v0[3] * c[1]};
                            const f32x4 o1 = (f32x4){v1[0] * c[2] - v1[1] * s[2], v1[0] * s[2] + v1[1] * c[2], v1[2] * c[3] - v1[3] * s[3], v1[2] * s[3] + v1[3] * c[3]};
                            v0 = o0; v1 = o1; }
                        bf16_t* dst = slot < 8 ? Q + (size_t)(row0 + ai * HALF + m * 16) * 512 + slot * 64 + 32 * bj + dl
                                               : KB + (size_t)(kvrow0 + ai * HALF + m * 16) * 128 + (slot - 8) * 64 + 32 * bj + dl;
                        *(u32x4*)dst = pack8(v0, v1);
                    }
                    asm volatile("" ::: "memory");
                }
            }
        } else if (slot < 12) {
#pragma unroll
            for (int ai = 0; ai < 2; ++ai)
#pragma unroll
                for (int m = 0; m < 4; ++m)
#pragma unroll
                    for (int bj = 0; bj < 2; ++bj)
                        *(u32x4*)(VB + (size_t)(kvrow0 + ai * HALF + m * 16) * 128 + (slot - 10) * 64 + 32 * bj + dl) = pack8(acc[ai][bj][m][0], acc[ai][bj][m][1]);
        } else if (slot < 20) {
#pragma unroll
            for (int ai = 0; ai < 2; ++ai)
#pragma unroll
                for (int m = 0; m < 4; ++m)
#pragma unroll
                    for (int bj = 0; bj < 2; ++bj)
                        *(u32x4*)(U + (size_t)(row0 + ai * HALF + m * 16) * 512 + (slot - 12) * 64 + 32 * bj + dl) = pack8(gelu4(acc[ai][bj][m][0]), gelu4(acc[ai][bj][m][1]));
        } else {
            f32x4 w[2][2];
#pragma unroll
            for (int bj = 0; bj < 2; ++bj)
#pragma unroll
                for (int n = 0; n < 2; ++n) w[bj][n] = *(const f32x4*)(gv + (slot - 20) * 64 + 32 * bj + dl + 4 * n);
#pragma unroll
            for (int ai = 0; ai < 2; ++ai)
#pragma unroll
                for (int m = 0; m < 4; ++m) {
                    f32x4 g[2][2]; float ss = 0.f;
#pragma unroll
                    for (int bj = 0; bj < 2; ++bj)
#pragma unroll
                        for (int n = 0; n < 2; ++n) { const f32x4 x = gelu4(acc[ai][bj][m][n]); g[bj][n] = x; ss += (x[0] * x[0] + x[1] * x[1]) + (x[2] * x[2] + x[3] * x[3]); }
                    ss += __shfl_xor(ss, 16); ss += __shfl_xor(ss, 32);
                    const float r = __builtin_amdgcn_rsqf(ss * (1.0f / 64.0f) + 1e-6f);
#pragma unroll
                    for (int bj = 0; bj < 2; ++bj)
                        *(u32x4*)(VG + (size_t)(row0 + ai * HALF + m * 16) * 512 + (slot - 20) * 64 + 32 * bj + dl) = pack8(g[bj][0] * r * w[bj][0], g[bj][1] * r * w[bj][1]);
                }
        }
    }
};
struct EpiResid {
    static constexpr bool PERM = false, AFTER_DRAIN = false;
    const float* base; float* out; const float* gate; int gstride; const float* cs;
    __device__ __forceinline__ void operator()(const f32x4 (&acc)[2][2][4][2], const Unit& u, int wr, int wc, int fr_, int fq_) const {
        int fr = fr_, fq = fq_; asm volatile("" : "+v"(fr), "+v"(fq));
        const int row0 = u.pm * BM + wr * 64 + fr, col0 = u.pn * BM + wc * 32 + 4 * fq;
        const float* gp = gate + (size_t)(u.pm >> 4) * gstride + col0;
        f32x4 gvv[2][2];
#pragma unroll
        for (int bj = 0; bj < 2; ++bj)
#pragma unroll
            for (int n = 0; n < 2; ++n) { f32x4 g = *(const f32x4*)(gp + bj * HALF + n * 16); if (cs) g = g * *(const f32x4*)(cs + col0 + bj * HALF + n * 16); gvv[bj][n] = g; }
#pragma unroll
        for (int ai = 0; ai < 2; ++ai)
#pragma unroll
            for (int m = 0; m < 4; ++m) { const size_t off = (size_t)(row0 + ai * HALF + m * 16) * 1024 + col0;
#pragma unroll
                for (int bj = 0; bj < 2; ++bj)
#pragma unroll
                    for (int n = 0; n < 2; ++n) { const f32x4 b = *(const f32x4*)(base + off + bj * HALF + n * 16); *(f32x4*)(out + off + bj * HALF + n * 16) = b + gvv[bj][n] * acc[ai][bj][m][n]; } }
    }
};
struct EpiSwiglu {
    static constexpr bool PERM = true, AFTER_DRAIN = false;
    bf16_t* H; int ldh;
    __device__ __forceinline__ void operator()(const f32x4 (&acc)[2][2][4][2], const Unit& u, int wr, int wc, int fr_, int fq_) const {
        int fr = fr_, fq = fq_; asm volatile("" : "+v"(fr), "+v"(fq));
        const int row0 = u.pm * BM + wr * 64 + fr, col0 = u.pn * HALF + wc * 32 + 8 * fq;
#pragma unroll
        for (int ai = 0; ai < 2; ++ai)
#pragma unroll
            for (int m = 0; m < 4; ++m) { f32x4 h[2];
#pragma unroll
                for (int n = 0; n < 2; ++n) { const f32x4 a = acc[ai][0][m][n], b = acc[ai][1][m][n]; h[n] = (f32x4){silu1(a[0]) * b[0], silu1(a[1]) * b[1], silu1(a[2]) * b[2], silu1(a[3]) * b[3]}; }
                *(u32x4*)(H + (size_t)(row0 + ai * HALF + m * 16) * ldh + col0) = pack8(h[0], h[1]); }
    }
};

template <class Epi, class Sched, bool ALIGN_EPI = false, bool SP2 = false>
__device__ __forceinline__ void gemm_phase(PG8_LAS unsigned char* lds, const Gemm g, const Sched& S, const Epi& E) {
    int tid_ = threadIdx.x; asm volatile("" : "+v"(tid_));
    const int tid = tid_, wid = __builtin_amdgcn_readfirstlane(tid >> 6), lane = tid & 63, wr = wid >> 2, wc = wid & 3, fr = lane & 15, fq = lane >> 4;
    const int K = g.K, nt = K / BK;
    unsigned voffA[2], voffB[2];
#pragma unroll
    for (int i = 0; i < 2; ++i) { int R, C; stage_rc(tid * 16 + i * 8192, R, C); const int Rb = Epi::PERM ? ((R & ~31) + perm32(R & 31)) : R;
        voffA[i] = (unsigned)(R * g.lda + C) * 2u; voffB[i] = (unsigned)(Rb * K + C) * 2u; }
    const size_t kstep = (size_t)(BK * 2);
    const size_t hsA = (size_t)HALF * g.lda * 2, hsB = (size_t)HALF * K * 2;
    const size_t tsA = 2 * hsA, tsB = 2 * hsB;
    const unsigned ldsw = (unsigned)wid * 1024u;
    const int aoff = lds_byte(wr * 64 + fr, fq * 8), boff = lds_byte(wc * 32 + fr, fq * 8);
#define PG8_SA(b, h) (((b) * 2 + (h)) * HTB)
#define PG8_SB(b, h) ((4 + (b) * 2 + (h)) * HTB)
#define PG8_STAGE(bufoff, gbase, voff) do { _Pragma("unroll") for (int _i = 0; _i < 2; ++_i) \
        __builtin_amdgcn_global_load_lds((const unsigned*)((const char*)(gbase) + (voff)[_i]), (PG8_LAS unsigned*)(lds + (bufoff) + ldsw + _i * 8192), 16, 0, 0); } while (0)
#define PG8_LDA(dst, b, h) do { _Pragma("unroll") for (int m = 0; m < 4; ++m) _Pragma("unroll") for (int k = 0; k < 2; ++k) dst[m][k] = *(const PG8_LAS bf16x8*)(lds + PG8_SA(b, h) + aoff + m * 2048 + k * 1024); } while (0)
#define PG8_LDB(dst, b, h) do { _Pragma("unroll") for (int n = 0; n < 2; ++n) _Pragma("unroll") for (int k = 0; k < 2; ++k) dst[n][k] = *(const PG8_LAS bf16x8*)(lds + PG8_SB(b, h) + boff + n * 2048 + k * 1024); } while (0)
#define PG8_MMA(ai, bj, At, Bt) do { __builtin_amdgcn_s_setprio(1); _Pragma("unroll") for (int m = 0; m < 4; ++m) _Pragma("unroll") for (int n = 0; n < 2; ++n) _Pragma("unroll") for (int k = 0; k < 2; ++k) \
        acc[ai][bj][m][n] = __builtin_amdgcn_mfma_f32_16x16x32_bf16(Bt[n][k], At[m][k], acc[ai][bj][m][n], 0, 0, 0); __builtin_amdgcn_s_setprio(0); } while (0)
#define PG8_WAIT_V(n) asm volatile("s_waitcnt vmcnt(" #n ")" ::: "memory")
#define PG8_WAIT_L(n) asm volatile("s_waitcnt lgkmcnt(" #n ")" ::: "memory")
#define PG8_BAR __builtin_amdgcn_s_barrier()
#define PG8_SCHED __builtin_amdgcn_sched_barrier(0)
    Unit cur, nxt; int ui = 0;
    if (!S.next(0, cur)) return;
    f32x4 acc[2][2][4][2];
#pragma unroll
    for (int a = 0; a < 2; ++a)
#pragma unroll
        for (int b = 0; b < 2; ++b)
#pragma unroll
            for (int m = 0; m < 4; ++m)
#pragma unroll
                for (int n = 0; n < 2; ++n) acc[a][b][m][n] = (f32x4){0.f, 0.f, 0.f, 0.f};
    bf16x8 At[4][2], B0[2][2], B1[2][2];
    const char* cA = (const char*)g.A + (size_t)cur.pm * tsA + (size_t)cur.pn * g.a_pn_bytes; const char* cB = (const char*)g.Bt + (size_t)cur.pn * tsB;
    S.a_ready(cur);
    if constexpr (SP2) {
        PG8_STAGE(PG8_SB(0, 0), cB, voffB); PG8_STAGE(PG8_SB(0, 1), cB + hsB, voffB); PG8_STAGE(PG8_SA(0, 0), cA, voffA); PG8_STAGE(PG8_SA(0, 1), cA + hsA, voffA);
        if (wr == 1) PG8_BAR;
        PG8_WAIT_V(2); PG8_BAR;
        PG8_STAGE(PG8_SB(1, 0), cB + kstep, voffB); PG8_STAGE(PG8_SA(1, 0), cA + kstep, voffA); PG8_STAGE(PG8_SB(1, 1), cB + hsB + kstep, voffB);
        PG8_WAIT_V(6); PG8_BAR;
    } else {
        PG8_STAGE(PG8_SB(0, 0), cB, voffB); PG8_STAGE(PG8_SA(0, 0), cA, voffA); PG8_STAGE(PG8_SB(0, 1), cB + hsB, voffB); PG8_STAGE(PG8_SA(0, 1), cA + hsA, voffA);
        if (wr == 1) PG8_BAR;
        PG8_WAIT_V(4); PG8_BAR;
        PG8_STAGE(PG8_SB(1, 0), cB + kstep, voffB); PG8_STAGE(PG8_SA(1, 0), cA + kstep, voffA); PG8_STAGE(PG8_SB(1, 1), cB + hsB + kstep, voffB);
        PG8_WAIT_V(6); PG8_BAR;
    }
    for (;;) {
        const bool has_next = S.next(ui + 1, nxt);
        const char* nA = has_next ? (const char*)g.A + (size_t)nxt.pm * tsA + (size_t)nxt.pn * g.a_pn_bytes : cA; const char* nB = has_next ? (const char*)g.Bt + (size_t)nxt.pn * tsB : cB;
        for (int t = 0; t < nt; t += 2) {
            const bool last = (t == nt - 2);
            const char* a1 = cA + (size_t)(t + 1) * kstep;
            const char* a2 = last ? nA : cA + (size_t)(t + 2) * kstep; const char* b2 = last ? nB : cB + (size_t)(t + 2) * kstep;
            const char* a3 = a2 + kstep; const char* b3 = b2 + kstep;
            if (last && has_next) S.a_ready(nxt);
            if constexpr (SP2) {
            PG8_LDB(B0, 0, 0); PG8_LDB(B1, 0, 1); PG8_SCHED; PG8_LDA(At, 0, 0); PG8_STAGE(PG8_SA(1, 1), a1 + hsA, voffA);
            PG8_WAIT_V(8); PG8_WAIT_L(0); PG8_BAR; PG8_MMA(0, 0, At, B0); PG8_MMA(0, 1, At, B1); PG8_BAR; PG8_SCHED;
            PG8_LDA(At, 0, 1); PG8_STAGE(PG8_SB(0, 0), b2, voffB); PG8_STAGE(PG8_SB(0, 1), b2 + hsB, voffB); PG8_STAGE(PG8_SA(0, 0), a2, voffA);
            PG8_WAIT_V(8); PG8_WAIT_L(0); PG8_BAR; PG8_MMA(1, 0, At, B0); PG8_MMA(1, 1, At, B1); PG8_BAR; PG8_SCHED;
            PG8_LDB(B0, 1, 0); PG8_LDB(B1, 1, 1); PG8_SCHED; PG8_LDA(At, 1, 0); PG8_STAGE(PG8_SA(0, 1), a2 + hsA, voffA);
            PG8_WAIT_V(8); PG8_WAIT_L(0); PG8_BAR; PG8_MMA(0, 0, At, B0); PG8_MMA(0, 1, At, B1); PG8_BAR; PG8_SCHED;
            PG8_LDA(At, 1, 1); PG8_STAGE(PG8_SB(1, 0), b3, voffB); PG8_STAGE(PG8_SB(1, 1), b3 + hsB, voffB); PG8_STAGE(PG8_SA(1, 0), a3, voffA);
            PG8_WAIT_V(8); PG8_WAIT_L(0); PG8_BAR; PG8_MMA(1, 0, At, B0); PG8_MMA(1, 1, At, B1); PG8_BAR; PG8_SCHED;
            } else {
            PG8_LDB(B0, 0, 0); PG8_SCHED; PG8_LDA(At, 0, 0); PG8_STAGE(PG8_SA(1, 1), a1 + hsA, voffA);
            PG8_WAIT_L(8); PG8_BAR; PG8_WAIT_L(0); PG8_MMA(0, 0, At, B0); PG8_BAR; PG8_SCHED;
            PG8_LDB(B1, 0, 1); PG8_STAGE(PG8_SB(0, 0), b2, voffB);
            PG8_BAR; PG8_WAIT_L(0); PG8_MMA(0, 1, At, B1); PG8_BAR;
            PG8_LDA(At, 0, 1); PG8_STAGE(PG8_SA(0, 0), a2, voffA);
            PG8_BAR; PG8_WAIT_L(0); PG8_MMA(1, 0, At, B0); PG8_BAR; PG8_SCHED;
            PG8_STAGE(PG8_SB(0, 1), b2 + hsB, voffB);
            PG8_WAIT_V(6); PG8_BAR; PG8_MMA(1, 1, At, B1); PG8_BAR;
            PG8_LDB(B0, 1, 0); PG8_SCHED; PG8_LDA(At, 1, 0); PG8_STAGE(PG8_SA(0, 1), a2 + hsA, voffA);
            PG8_WAIT_L(8); PG8_BAR; PG8_WAIT_L(0); PG8_MMA(0, 0, At, B0); PG8_BAR; PG8_SCHED;
            PG8_LDB(B1, 1, 1); PG8_STAGE(PG8_SB(1, 0), b3, voffB);
            PG8_BAR; PG8_WAIT_L(0); PG8_MMA(0, 1, At, B1); PG8_BAR;
            PG8_LDA(At, 1, 1); PG8_STAGE(PG8_SA(1, 0), a3, voffA);
            PG8_BAR; PG8_WAIT_L(0); PG8_MMA(1, 0, At, B0); PG8_BAR; PG8_SCHED;
            PG8_STAGE(PG8_SB(1, 1), b3 + hsB, voffB);
            PG8_WAIT_V(6); PG8_BAR; PG8_MMA(1, 1, At, B1); PG8_BAR;
            }
        }
        if constexpr (ALIGN_EPI) { if (wr == 0) PG8_BAR; }
        if constexpr (!Epi::AFTER_DRAIN) { E(acc, cur, wr, wc, fr, fq); S.done(cur); }
        if (!has_next) break;
#pragma unroll
        for (int a = 0; a < 2; ++a)
#pragma unroll
            for (int b = 0; b < 2; ++b)
#pragma unroll
                for (int m = 0; m < 4; ++m)
#pragma unroll
                    for (int n = 0; n < 2; ++n) acc[a][b][m][n] = (f32x4){0.f, 0.f, 0.f, 0.f};
        cur = nxt; cA = nA; cB = nB; ++ui;
        if constexpr (ALIGN_EPI) { if (wr == 1) PG8_BAR; }
    }
    PG8_WAIT_V(0);
    if constexpr (!ALIGN_EPI) { if (wr == 0) PG8_BAR; }
    PG8_BAR;
    if constexpr (Epi::AFTER_DRAIN) { E.fused(acc, cur, wr, wc, fr, fq, lds, wid, lane); S.done(cur); }
#undef PG8_SA
#undef PG8_SB
#undef PG8_STAGE
#undef PG8_LDA
#undef PG8_LDB
#undef PG8_MMA
#undef PG8_WAIT_V
#undef PG8_WAIT_L
#undef PG8_BAR
#undef PG8_SCHED
}
}
namespace attn_body {
using bf16=__hip_bfloat16;
using bf16x8=__attribute__((ext_vector_type(8)))short;
using s16x4=__attribute__((ext_vector_type(4)))short;
using f32x16=__attribute__((ext_vector_type(16)))float;
using u32x4=__attribute__((ext_vector_type(4)))unsigned;
constexpr int BATCH=8,NHEAD=8,NKVH=2,SEQ=4096,SKV=4352,D=64,QP=512,KP=128,OP=1024;
constexpr int NW=8,QBLK=32,QB=QBLK*NW,KVBLK=64,NQB=SEQ/QB;
constexpr int ATTN_UNIT_ROWS=QB;
__device__ __forceinline__ int crow(int r,int hi){return (r&3)+8*(r>>2)+4*hi;}
#define SBAR() __builtin_amdgcn_sched_barrier(0)
constexpr int NSLOT=3, SLOTB=8192;
constexpr int LDS_K=0, LDS_V=NSLOT*SLOTB, LDS_WS=2*NSLOT*SLOTB, LDS_OST=LDS_WS+NW*64*4, LDS_BYTES=LDS_OST+NW*4096;
constexpr float C2=0.125f*1.4426950408889634f;
__device__ __forceinline__ void glds16(const void*gsrc,unsigned lds_dst){unsigned keep;
  asm volatile("s_mov_b32 %0, m0\n\ts_mov_b32 m0, %2\n\ts_nop 0\n\tglobal_load_lds_dwordx4 %1, off\n\ts_mov_b32 m0, %0":"=&s"(keep):"v"(gsrc),"s"(lds_dst):"memory");}
__device__ __forceinline__ float max3f(float a,float b,float c){float r;asm("v_max3_f32 %0, %1, %2, %3":"=v"(r):"v"(a),"v"(b),"v"(c));return r;}
__device__ __forceinline__ float max2f(float a,float b){float r;asm("v_max_f32_e32 %0, %1, %2":"=v"(r):"v"(a),"v"(b));return r;}
__device__ __forceinline__ float fadd_s(float a,float b){float r;asm("v_add_f32_e32 %0, %1, %2":"=v"(r):"v"(a),"v"(b));return r;}
__device__ __forceinline__ float fsub_s(float a,float b){float r;asm("v_sub_f32_e32 %0, %1, %2":"=v"(r):"v"(a),"v"(b));return r;}
typedef float f32x2_t __attribute__((ext_vector_type(2))); typedef __bf16 bf16x2_t __attribute__((ext_vector_type(2)));
__device__ __forceinline__ unsigned cvtpk_s(float lo,float hi){f32x2_t v={lo,hi};bf16x2_t b=__builtin_convertvector(v,bf16x2_t);return __builtin_bit_cast(unsigned,b);}
#define WAIT_BAR(N) asm volatile("s_waitcnt vmcnt(" #N ") lgkmcnt(0)\n\ts_barrier":::"memory")

__device__ __forceinline__ void qkt(f32x16&p0,f32x16&p1,const char*Kslot,const bf16x8*qr,const f32x16&negm,int r32,int hi){
  const char*kb=Kslot+hi*1024+r32*16;
  #pragma unroll
  for(int d0=0;d0<4;++d0){
    const bf16x8 b0=*reinterpret_cast<const bf16x8*>(kb+d0*2048);
    const bf16x8 b1=*reinterpret_cast<const bf16x8*>(kb+d0*2048+512);
    if(d0==0){p0=__builtin_amdgcn_mfma_f32_32x32x16_bf16(b0,qr[0],negm,0,0,0);p1=__builtin_amdgcn_mfma_f32_32x32x16_bf16(b1,qr[0],negm,0,0,0);}
    else{p0=__builtin_amdgcn_mfma_f32_32x32x16_bf16(b0,qr[d0],p0,0,0,0);p1=__builtin_amdgcn_mfma_f32_32x32x16_bf16(b1,qr[d0],p1,0,0,0);}}
}
typedef __attribute__((address_space(3))) const char* lds_cptr;
typedef short v4i16_t __attribute__((ext_vector_type(4)));
__device__ __forceinline__ void kload8(bf16x8*kf,lds_cptr kp){
  kf[0]=*(const __attribute__((address_space(3))) bf16x8*)(kp);      kf[1]=*(const __attribute__((address_space(3))) bf16x8*)(kp+512);
  kf[2]=*(const __attribute__((address_space(3))) bf16x8*)(kp+2048); kf[3]=*(const __attribute__((address_space(3))) bf16x8*)(kp+2560);
  kf[4]=*(const __attribute__((address_space(3))) bf16x8*)(kp+4096); kf[5]=*(const __attribute__((address_space(3))) bf16x8*)(kp+4608);
  kf[6]=*(const __attribute__((address_space(3))) bf16x8*)(kp+6144); kf[7]=*(const __attribute__((address_space(3))) bf16x8*)(kp+6656);
}
__device__ __forceinline__ void kload2(bf16x8*kf,lds_cptr kp,int j){ kf[2*j]=*(const __attribute__((address_space(3))) bf16x8*)(kp+j*2048); kf[2*j+1]=*(const __attribute__((address_space(3))) bf16x8*)(kp+j*2048+512); }
__device__ __forceinline__ s16x4 vtr(lds_cptr p){ return __builtin_bit_cast(s16x4,__builtin_amdgcn_ds_read_tr16_b64_v4i16((__attribute__((address_space(3))) v4i16_t*)p)); }
__device__ __forceinline__ float rowmax(const f32x16&p0,const f32x16&p1){
  float a=max3f(p0[0],p0[1],p1[0]),b=max3f(p0[2],p0[3],p1[1]);a=max3f(a,p1[2],p1[3]);
  #pragma unroll
  for(int r=4;r<16;r+=4){a=max3f(a,p0[r],p0[r+1]);b=max3f(b,p0[r+2],p0[r+3]);a=max3f(a,p1[r],p1[r+1]);b=max3f(b,p1[r+2],p1[r+3]);}
  const float m=max2f(a,b);
  auto rr=__builtin_amdgcn_permlane32_swap(__float_as_uint(m),__float_as_uint(m),false,false);
  return max2f(__uint_as_float(rr[0]),__uint_as_float(rr[1]));
}
__device__ __forceinline__ void pv(f32x16*o,int vb,bf16x8 pa0,bf16x8 pa1,bf16x8 pa2,bf16x8 pa3){
  #pragma unroll
  for(int d0=0;d0<2;++d0){s16x4 lo[4],hi[4];
    #pragma unroll
    for(int ks=0;ks<4;++ks){
      asm volatile("ds_read_b64_tr_b16 %0,%1 offset:%c2":"=&v"(lo[ks]):"v"(vb),"i"(d0*4096+ks*1024):"memory");
      asm volatile("ds_read_b64_tr_b16 %0,%1 offset:%c2":"=&v"(hi[ks]):"v"(vb),"i"(d0*4096+ks*1024+512):"memory");}
    asm volatile("s_waitcnt lgkmcnt(0)":::"memory");SBAR();
    #define PK(k) (bf16x8){lo[k][0],lo[k][1],lo[k][2],lo[k][3],hi[k][0],hi[k][1],hi[k][2],hi[k][3]}
    o[d0]=__builtin_amdgcn_mfma_f32_32x32x16_bf16(pa0,PK(0),o[d0],0,0,0);
    o[d0]=__builtin_amdgcn_mfma_f32_32x32x16_bf16(pa1,PK(1),o[d0],0,0,0);
    o[d0]=__builtin_amdgcn_mfma_f32_32x32x16_bf16(pa2,PK(2),o[d0],0,0,0);
    o[d0]=__builtin_amdgcn_mfma_f32_32x32x16_bf16(pa3,PK(3),o[d0],0,0,0);
    #undef PK
  }
}

#ifndef ATTN_STORE16
#define ATTN_STORE16(p,v) (*(u32x4*)(p)=(v))
#endif
template<int THRL> __device__ __forceinline__ void attn_unit(int b,int h,int qb,const bf16*Q,const bf16*__restrict__ K,const bf16*__restrict__ V,bf16*O,char*shm){
  int tid_=threadIdx.x; asm volatile("":"+v"(tid_)); const int tid=tid_,lane=tid&63,r32=lane&31,hi=lane>>5; const int wid=__builtin_amdgcn_readfirstlane(tid>>6);
  const long rowbase=(long)b*SEQ, kvbase=(long)b*SKV; const int q0=qb*QB;
  const bf16*Qw=Q+(rowbase+q0+wid*QBLK)*QP+h*D;
  const bf16*Kh=K+kvbase*KP+(h/(NHEAD/NKVH))*D,*Vh=V+kvbase*KP+(h/(NHEAD/NKVH))*D;
  const unsigned lds0=(unsigned)(uintptr_t)shm;
  float*wsf=(float*)(shm+LDS_WS)+wid*64;
  const bf16*ksrc=Kh+(long)lane*KP+wid*8;
  const bf16*vsrc=Vh+(long)(16*(wid&3)+(lane>>2))*KP+(wid>>2)*32+(lane&3)*8;
  const unsigned kdst=lds0+LDS_K+wid*1024, vdst=lds0+LDS_V+wid*1024;
  #define DMA_K(t,slot) glds16(ksrc+(long)(t)*KVBLK*KP,(unsigned)__builtin_amdgcn_readfirstlane(kdst+(slot)))
  #define DMA_V(t,slot) glds16(vsrc+(long)(t)*KVBLK*KP,(unsigned)__builtin_amdgcn_readfirstlane(vdst+(slot)))
  const int vb0=(int)(lds0+LDS_V)+((lane>>4)&1)*32+(lane&3)*8+(4*hi+((lane&15)>>2))*64;
  const char*Kbase=shm+LDS_K; bf16x8 kf[8];
  const lds_cptr shm3=(lds_cptr)shm; const lds_cptr kp0=shm3+LDS_K+hi*1024+r32*16; const lds_cptr vp0=shm3+LDS_V+((lane>>4)&1)*32+(lane&3)*8+(4*hi+((lane&15)>>2))*64;
  constexpr int NT=SKV/KVBLK;
  DMA_K(0,0);DMA_V(0,0);DMA_K(1,SLOTB);
  bf16x8 qr[4];
  #pragma unroll
  for(int d0=0;d0<4;++d0)qr[d0]=*reinterpret_cast<const bf16x8*>(&Qw[(long)r32*QP+d0*16+hi*8]);
  float mhat=0.f,l_reg=0.f;f32x16 o[2];o[0]=f32x16{};o[1]=f32x16{};f32x16 negm=f32x16{};asm volatile("":"+v"(negm));
  #define CMASK(P0,P1,t) do{}while(0)
  bool resc=false;
  #define START(P0,P1) do{ const float rm=rowmax(P0,P1); resc=false; \
    { const float dl=rm; mhat=fadd_s(mhat,dl); \
      _Pragma("unroll") for(int r=0;r<16;++r){P0[r]=fsub_s(P0[r],dl);P1[r]=fsub_s(P1[r],dl);} \
      _Pragma("unroll") for(int r=0;r<16;++r)negm[r]=-mhat; asm volatile("":"+v"(negm)); } \
    _Pragma("unroll") for(int r=0;r<16;++r)P0[r]=__builtin_amdgcn_exp2f(P0[r]); }while(0)
  #define RESC() do{ if(resc){ asm volatile("s_waitcnt lgkmcnt(0)":::"memory"); \
      _Pragma("unroll") for(int d_=0;d_<2;++d_) _Pragma("unroll") for(int r=0;r<16;++r)o[d_][r]*=wsf[crow(r,hi)]; } }while(0)
  f32x16 pA0,pA1,pB0,pB1;
  int sl_prev=0,sl_cur=0,sl_next=SLOTB;
  #define ROT() do{sl_prev=sl_cur;sl_cur=sl_next;sl_next=(sl_next==(NSLOT-1)*SLOTB)?0:sl_next+SLOTB;}while(0)
  DMA_K(2,2*SLOTB);
  WAIT_BAR(3);
  qkt(pA0,pA1,Kbase,qr,negm,r32,hi);asm volatile("s_nop 15\n\ts_nop 7":"+v"(pA0),"+v"(pA1));CMASK(pA0,pA1,0);
  START(pA0,pA1);
  _Pragma("unroll") for(int r=0;r<16;++r)pA1[r]=__builtin_amdgcn_exp2f(pA1[r]);
  WAIT_BAR(0);
  DMA_K(3,0);DMA_V(1,SLOTB);
  ROT();
  kload8(kf,kp0+sl_cur);
  WAIT_BAR(2);
  s16x4 vlo[8],vhi[8]; u32x4 pw0,pw1,pw2,pw3;
  #define PKW(P,B) cvtpk_s(P[B],P[B+1])
  #define PAF(k) __builtin_bit_cast(bf16x8,pw##k)
  #define VFR(i) (bf16x8){vlo[i][0],vlo[i][1],vlo[i][2],vlo[i][3],vhi[i][0],vhi[i][1],vhi[i][2],vhi[i][3]}
  #define PIN(x) asm volatile("":"+v"(x))
  #define MX3(a,b,c) __builtin_fmaxf(__builtin_fmaxf((a),(b)),(c))
  #define GAPA(MF,A0,A1,A2,A3,W0,W1,PW) do{ MF; sacc+=A0; sacc+=A1; sacc+=A2; sacc+=A3; PIN(sacc); W0; W1; PIN(PW); SBAR(); }while(0)
  #define EX(v) __builtin_amdgcn_exp2f(v)
  #define GAPB(MF,X,B) do{ MF; X[B]=EX(X[B]); X[B+1]=EX(X[B+1]); X[B+2]=EX(X[B+2]); X[B+3]=EX(X[B+3]); PIN(X); SBAR(); }while(0)
  #define VRD(i) do{ vlo[i]=vtr(vp_+(((i)>>2)*4096+((i)&3)*1024)); vhi[i]=vtr(vp_+(((i)>>2)*4096+((i)&3)*1024+512)); }while(0)
  #define KRD(G,j) do{ if(G){ kload2(kf,kp0+sl_next,j); SBAR(); } }while(0)
  #define STEP(C0,C1,P0,P1,t,GK,GV,GL) do{ SBAR(); \
    const lds_cptr vp_=vp0+sl_prev; \
    VRD(0); SBAR(); float sacc=(P0[0]+P0[1]); \
    GAPA(C0=__builtin_amdgcn_mfma_f32_32x32x16_bf16(kf[0],qr[0],negm,0,0,0), P0[2],P0[3],P0[4],P0[5],     pw0[0]=PKW(P0,0), pw0[1]=PKW(P0,2), pw0); \
    VRD(4); SBAR(); GAPA(C1=__builtin_amdgcn_mfma_f32_32x32x16_bf16(kf[1],qr[0],negm,0,0,0), P0[6],P0[7],P0[8],P0[9],     pw0[2]=PKW(P0,4), pw0[3]=PKW(P0,6), pw0); \
    VRD(1); SBAR(); GAPA(C0=__builtin_amdgcn_mfma_f32_32x32x16_bf16(kf[2],qr[1],C0,0,0,0),   P0[10],P0[11],P0[12],P0[13], pw1[0]=PKW(P0,8), pw1[1]=PKW(P0,10), pw1); \
    VRD(5); SBAR(); GAPA(C1=__builtin_amdgcn_mfma_f32_32x32x16_bf16(kf[3],qr[1],C1,0,0,0),   P0[14],P0[15],P1[0],P1[1],   pw1[2]=PKW(P0,12),pw1[3]=PKW(P0,14), pw1); \
    VRD(2); SBAR(); GAPA(C0=__builtin_amdgcn_mfma_f32_32x32x16_bf16(kf[4],qr[2],C0,0,0,0),   P1[2],P1[3],P1[4],P1[5],     pw2[0]=PKW(P1,0), pw2[1]=PKW(P1,2), pw2); \
    VRD(6); SBAR(); GAPA(C1=__builtin_amdgcn_mfma_f32_32x32x16_bf16(kf[5],qr[2],C1,0,0,0),   P1[6],P1[7],P1[8],P1[9],     pw2[2]=PKW(P1,4), pw2[3]=PKW(P1,6), pw2); \
    VRD(3); SBAR(); GAPA(C0=__builtin_amdgcn_mfma_f32_32x32x16_bf16(kf[6],qr[3],C0,0,0,0),   P1[10],P1[11],P1[12],P1[13], pw3[0]=PKW(P1,8), pw3[1]=PKW(P1,10), pw3); \
    VRD(7); SBAR(); GAPA(C1=__builtin_amdgcn_mfma_f32_32x32x16_bf16(kf[7],qr[3],C1,0,0,0),   P1[14],P1[15],0.f,0.f,       pw3[2]=PKW(P1,12),pw3[3]=PKW(P1,14), pw3); \
    l_reg+=sacc; \
    if(GK){DMA_K((t)+3,sl_cur);} if(GV){DMA_V((t)+1,sl_next);} \
    CMASK(C0,C1,t); \
    { float a=MX3(C0[0],C0[1],C1[0]),b=MX3(C0[2],C0[3],C1[1]); a=MX3(a,C1[2],C1[3]); \
      _Pragma("unroll") for(int r=4;r<16;r+=4){a=MX3(a,C0[r],C0[r+1]);b=MX3(b,C0[r+2],C0[r+3]);a=MX3(a,C1[r],C1[r+1]);b=MX3(b,C1[r+2],C1[r+3]);} \
      float rm=__builtin_fmaxf(a,b); { auto rr=__builtin_amdgcn_permlane32_swap(__float_as_uint(rm),__float_as_uint(rm),false,false); rm=__builtin_fmaxf(__uint_as_float(rr[0]),__uint_as_float(rr[1])); } \
      resc=false; \
      if(__builtin_expect(__any(rm>(float)THRL),0)){ const float dl=__builtin_fmaxf(rm,0.f); mhat+=dl; \
        _Pragma("unroll") for(int r=0;r<16;++r){C0[r]-=dl;C1[r]-=dl;} \
        _Pragma("unroll") for(int r=0;r<16;++r)negm[r]=-mhat; asm volatile("":"+v"(negm)); \
        const float f=__builtin_amdgcn_exp2f(-dl); l_reg*=f; if(hi==0)wsf[r32]=f; resc=true; } } \
    SBAR(); \
    GAPB(o[0]=__builtin_amdgcn_mfma_f32_32x32x16_bf16(PAF(0),VFR(0),o[0],0,0,0), C0,0); \
    GAPB(o[1]=__builtin_amdgcn_mfma_f32_32x32x16_bf16(PAF(0),VFR(4),o[1],0,0,0), C0,4); \
    KRD(GL,0); GAPB(o[0]=__builtin_amdgcn_mfma_f32_32x32x16_bf16(PAF(1),VFR(1),o[0],0,0,0), C0,8); \
    KRD(GL,1); GAPB(o[1]=__builtin_amdgcn_mfma_f32_32x32x16_bf16(PAF(1),VFR(5),o[1],0,0,0), C0,12); \
    KRD(GL,2); GAPB(o[0]=__builtin_amdgcn_mfma_f32_32x32x16_bf16(PAF(2),VFR(2),o[0],0,0,0), C1,0); \
    KRD(GL,3); GAPB(o[1]=__builtin_amdgcn_mfma_f32_32x32x16_bf16(PAF(2),VFR(6),o[1],0,0,0), C1,4); \
    GAPB(o[0]=__builtin_amdgcn_mfma_f32_32x32x16_bf16(PAF(3),VFR(3),o[0],0,0,0), C1,8); \
    GAPB(o[1]=__builtin_amdgcn_mfma_f32_32x32x16_bf16(PAF(3),VFR(7),o[1],0,0,0), C1,12); \
    }while(0)
  int t=1;
  #undef CMASK
  #define CMASK(P0,P1,t) do{}while(0)
  for(;t+5<NT;t+=2){
    STEP(pB0,pB1,pA0,pA1,t,true,true,true);     WAIT_BAR(2); RESC(); ROT();
    STEP(pA0,pA1,pB0,pB1,t+1,true,true,true);   WAIT_BAR(2); RESC(); ROT();
  }
  #undef CMASK
  #define CMASK(P0,P1,t) do{}while(0)
  #define ENDW(tt) do{ if((tt)+3<NT){WAIT_BAR(2);} else if((tt)+2<NT){WAIT_BAR(1);} else {WAIT_BAR(0);} }while(0)
  for(;t+1<NT;t+=2){
    STEP(pB0,pB1,pA0,pA1,t,(t+3<NT),(t+1<NT),(t+1<NT));       ENDW(t);   RESC(); ROT();
    STEP(pA0,pA1,pB0,pB1,t+1,(t+4<NT),(t+2<NT),(t+2<NT));     ENDW(t+1); RESC(); ROT();
  }
  STEP(pB0,pB1,pA0,pA1,NT-1,false,false,false); RESC();
  { float sacc=pB0[0]+pB0[1]; _Pragma("unroll") for(int r=2;r<16;++r)sacc+=pB0[r]; _Pragma("unroll") for(int r=0;r<16;++r)sacc+=pB1[r]; l_reg+=sacc;
    pw0=(u32x4){PKW(pB0,0),PKW(pB0,2),PKW(pB0,4),PKW(pB0,6)};pw1=(u32x4){PKW(pB0,8),PKW(pB0,10),PKW(pB0,12),PKW(pB0,14)};pw2=(u32x4){PKW(pB1,0),PKW(pB1,2),PKW(pB1,4),PKW(pB1,6)};pw3=(u32x4){PKW(pB1,8),PKW(pB1,10),PKW(pB1,12),PKW(pB1,14)};
    SBAR(); pv(o,vb0+sl_cur,PAF(0),PAF(1),PAF(2),PAF(3)); }
  #undef PKW
  #undef PAF
  #undef VFR
  #undef PIN
  #undef MX3
  #undef GAPA
  #undef GAPB
  #undef EX
  #undef VRD
  #undef KRD
  #undef STEP
  #undef ENDW
  {auto rr=__builtin_amdgcn_permlane32_swap(__float_as_uint(l_reg),__float_as_uint(l_reg),false,false);l_reg=__uint_as_float(rr[0])+__uint_as_float(rr[1]);}
  if(hi==0)wsf[32+r32]=l_reg;asm volatile("s_waitcnt lgkmcnt(0)":::"memory");
  float rli[16];
  #pragma unroll
  for(int r=0;r<16;++r)rli[r]=__builtin_amdgcn_rcpf(wsf[32+crow(r,hi)]);
  bf16*Ow=O+(rowbase+q0+wid*QBLK)*OP+h*D;
  { bf16*stg=(bf16*)(shm+LDS_OST)+wid*2048;
    #pragma unroll
    for(int r=0;r<16;++r){const int orow=crow(r,hi);
      #pragma unroll
      for(int d0=0;d0<2;++d0)stg[orow*64+d0*32+r32]=__float2bfloat16(o[d0][r]*rli[r]);}
    asm volatile("s_waitcnt lgkmcnt(0)":::"memory");
    #pragma unroll
    for(int i=0;i<4;++i){const int row=i*8+(lane>>3),ch=lane&7; const u32x4 v=*(const u32x4*)(stg+row*64+ch*8); ATTN_STORE16(Ow+(long)row*OP+ch*8,v);} }
  asm volatile("s_waitcnt lgkmcnt(0)\n\ts_barrier":::"memory");
  #undef DMA_K
  #undef DMA_V
  #undef CMASK
  #undef START
  #undef RESC
  #undef ROT
}
constexpr int ATTN_LDS_BYTES=LDS_BYTES;
struct AttnTensors { const bf16* Q; const bf16* K; const bf16* V; bf16* O; };
struct AttnUnit { int bh; int qb; };
struct StaticOrder {
  int vcu,G;
  __device__ __forceinline__ explicit StaticOrder(int grid,int v):vcu(v),G(grid){}
  __device__ __forceinline__ bool next(int i,AttnUnit&u)const{ const int per=(BATCH*NHEAD*NQB)/G; if(i>=per)return false; const int x=vcu*per+i; u.bh=(x>>6)*4+((x&63)>>4); u.qb=x&15; return true; }
  __device__ __forceinline__ void a_ready(const AttnUnit&)const{}
  __device__ __forceinline__ void done(const AttnUnit&)const{}
};
template<class Sched,int THRL=8> __device__ __forceinline__ void attn_phase(char*lds,const AttnTensors&T,const Sched&S){
  AttnUnit u;
  for(int i=0;S.next(i,u);++i){ S.a_ready(u); attn_unit<THRL>(u.bh/NHEAD,u.bh%NHEAD,u.qb,T.Q,T.K,T.V,T.O,lds); S.done(u); }
}
#undef SBAR
#undef WAIT_BAR
}
#ifndef PG8_SP2
#define PG8_SP2 true
#endif
#ifndef PG8_ALIGN
#define PG8_ALIGN true
#endif
constexpr int NWAVES = 8;
constexpr int DM = 1024, NB = 8, SEQ = 4096, MTOK = NB * SEQ, CTXL = 256, MCTX = NB * CTXL, MALL = MTOK + MCTX;
constexpr int INW = 1792, FF = 2816, SKV = SEQ + CTXL;
constexpr int N_PHASES = 14;
constexpr size_t MiB = 1u << 20;
constexpr size_t WS_CTL = 0, CTL_ZERO_BYTES = 1 * MiB;
constexpr size_t WS_MODS = 1 * MiB;
constexpr size_t WS_ROPE = WS_MODS + 512 * 1024;
constexpr size_t WS_WSB = 2 * MiB;
constexpr size_t WS_WPOOL = WS_WSB + 512 * 1024;
constexpr size_t WS_WIN = 4 * MiB;
constexpr size_t WS_WOUT = 8 * MiB;
constexpr size_t WS_W13 = 10 * MiB;
constexpr size_t WS_W2 = 32 * MiB;
constexpr size_t WS_XN = 44 * MiB;
constexpr size_t WS_Q = 112 * MiB;
constexpr size_t WS_KB = 144 * MiB;
constexpr size_t WS_VB = 153 * MiB;
constexpr size_t WS_U = 162 * MiB;
constexpr size_t WS_VG = 194 * MiB;
constexpr size_t WS_AM = 226 * MiB;
constexpr size_t WS_H = 290 * MiB;
constexpr size_t WS_END = 466 * MiB;
constexpr int CW_BAR = 4096;
constexpr int RING_OFF = 0, RING_BYTES = 131072;
constexpr int LDSCTL_OFF = RING_BYTES, MISC_OFF = LDSCTL_OFF + 320;
constexpr int LDS_BYTES = 147456;
static_assert(MISC_OFF + 128 <= LDS_BYTES, "LDS map");

#define GAS __attribute__((address_space(1)))
#define LAS __attribute__((address_space(3)))
typedef unsigned short bf16;
typedef unsigned v4u __attribute__((ext_vector_type(4)));
typedef unsigned v2u __attribute__((ext_vector_type(2)));
typedef float f32x4 __attribute__((ext_vector_type(4)));
typedef float f32x2 __attribute__((ext_vector_type(2)));
typedef short bf16x8 __attribute__((ext_vector_type(8)));
typedef GAS unsigned gu32;
typedef GAS unsigned long long gu64;
#define RLX_AGENT __ATOMIC_RELAXED, __HIP_MEMORY_SCOPE_AGENT
#define LDS_WAIT() asm volatile("s_waitcnt lgkmcnt(0)" ::: "memory")
#define VM_WAIT() asm volatile("s_waitcnt vmcnt(0)" ::: "memory")
__device__ __forceinline__ unsigned f2bf(float f) { unsigned u = __builtin_bit_cast(unsigned, f); return (u + 0x7fffu + ((u >> 16) & 1u)) >> 16; }
__device__ __forceinline__ unsigned pk2(float lo, float hi) { return f2bf(lo) | (f2bf(hi) << 16); }
__device__ __forceinline__ float bf2f(unsigned h) { return __builtin_bit_cast(float, h << 16); }

#define XB_TMO      128
#define XB_XCNT(j)  (256  + 64 * (j))
#define XB_XSUB(j)  (1280 + 64 * (j))
#define XB_XGEN(j)  (2304 + 64 * (j))
#define XB_TOP      3328
#define XB_TOPGEN   3392
#define XCD_BAR_WORDS 3456
#define XB_SPIN_CAP (1u << 18)

__device__ __forceinline__ unsigned xb_ld(unsigned* p)              { return __hip_atomic_load(p, __ATOMIC_RELAXED, __HIP_MEMORY_SCOPE_AGENT); }
__device__ __forceinline__ unsigned xb_add(unsigned* p, unsigned v) { return __hip_atomic_fetch_add(p, v, __ATOMIC_RELAXED, __HIP_MEMORY_SCOPE_AGENT); }
__device__ __forceinline__ unsigned xb_xcc_id() { return (unsigned)__builtin_amdgcn_s_getreg((3 << 11) | 20) & 0xFu; }
#define XB_SPIN(cond, bar) do { unsigned _sp = 0; while (cond) { __builtin_amdgcn_s_sleep(1); \
    if ((++_sp & 255u) == 0u) { if (xb_ld(&(bar)[XB_TMO])) break; if (_sp > XB_SPIN_CAP) { atomicAdd(&(bar)[XB_TMO], 1u); break; } } } } while (0)

struct XcdBarrier {
    unsigned* bar; unsigned x;
    volatile LAS unsigned* st;
};

__device__ __forceinline__ XcdBarrier xcd_barrier_post(unsigned* bar, volatile LAS unsigned* st) {
    XcdBarrier b; b.bar = bar; b.x = xb_xcc_id(); b.st = st;
    if (threadIdx.x == 0) (void)xb_add(&bar[XB_XCNT(b.x)], 1u);
    return b;
}
__device__ __forceinline__ void xcd_barrier_complete(unsigned* bar, unsigned x, unsigned& nloc, unsigned& nx) {
    const unsigned G = gridDim.x * gridDim.y * gridDim.z;
    unsigned sum, cnt, mine, sp = 0u;
    for (;;) {
        sum = 0u; cnt = 0u; mine = 0u;
#pragma unroll
        for (unsigned j = 0; j < 16; ++j) { const unsigned c = xb_ld(&bar[XB_XCNT(j)]); sum += c; cnt += (c > 0u) ? 1u : 0u; mine = (j == x) ? c : mine; }
        if (sum == G) break;
        __builtin_amdgcn_s_sleep(1);
        if ((++sp & 255u) == 0u) { if (xb_ld(&bar[XB_TMO])) break; if (sp > XB_SPIN_CAP) { atomicAdd(&bar[XB_TMO], 1u); break; } }
    }
    nloc = mine > 0u ? mine : 1u; nx = cnt > 0u ? cnt : 1u;
}

__device__ __forceinline__ void xcd_barrier(const XcdBarrier& b) {
    asm volatile("s_waitcnt vmcnt(0)" ::: "memory");
    __syncthreads();
    if (threadIdx.x == 0) {
        unsigned* bar = b.bar;
        __builtin_amdgcn_s_waitcnt(0);
        unsigned nloc = b.st[0], nx = b.st[1];
        if (nloc == 0u) { xcd_barrier_complete(bar, b.x, nloc, nx); b.st[0] = nloc; b.st[1] = nx; }
        const unsigned old = xb_add(&bar[XB_XSUB(b.x)], 1u);
        const unsigned gen = old / nloc;
        if (old + 1u == (gen + 1u) * nloc) {
            __builtin_amdgcn_fence(__ATOMIC_RELEASE, "agent");
            asm volatile("s_waitcnt vmcnt(0)" ::: "memory");
            const unsigned og = xb_add(&bar[XB_TOP], 1u);
            const unsigned tg = og / nx;
            if (og + 1u == (tg + 1u) * nx) xb_add(&bar[XB_TOPGEN], 1u);
            else XB_SPIN(xb_ld(&bar[XB_TOPGEN]) == tg, bar);
            __builtin_amdgcn_fence(__ATOMIC_ACQUIRE, "agent");
            xb_add(&bar[XB_XGEN(b.x)], 1u);
            asm volatile("s_waitcnt vmcnt(0)" ::: "memory");
        } else {
            XB_SPIN(xb_ld(&bar[XB_XGEN(b.x)]) == gen, bar);
            __builtin_amdgcn_fence(__ATOMIC_ACQUIRE, "agent");
            asm volatile("s_waitcnt vmcnt(0)" ::: "memory");
        }
    }
    __syncthreads();
}
struct Frame {
    LAS unsigned char* lds;
    volatile LAS unsigned* MISC;
    gu32* ctl;
    int tid, lane, wave;
    int vcu, G;
};
struct Args { const float* in[21]; float* out; unsigned char* ws; int ph_lo, ph_hi; };
static_assert(sizeof(Args) == 192, "Args has no padding");
enum { I_X = 0, I_C, I_CTX, I_CCTX, I_WADA, I_BADA, I_GMIX, I_GFFN, I_WIN, I_WOUT, I_QN, I_KN, I_GN, I_WSP, I_BSP, I_WPOOL, I_PSC, I_W1, I_W3, I_W2, I_GFIN };
constexpr int SH1 = 0, SC1 = DM, GA1 = 2 * DM, SH2 = 3 * DM, SC2 = 4 * DM, GA2 = 5 * DM, MODW = 6 * DM;

__device__ __forceinline__ float wave_sum(float v) {
#pragma unroll
    for (int o = 1; o < 64; o <<= 1) v += __shfl_xor(v, o);
    return v;
}
__device__ __forceinline__ void p0_transpose_item(const float* W, int ldw, int k0, int n0, bf16* WT, int ldt, int dst_row0, LAS float* scr, int lane) {
#pragma unroll 8
    for (int i = 0; i < 32; ++i) { const int kk = 2 * i + (lane >> 5); scr[kk * 33 + (lane & 31)] = W[(size_t)(k0 + kk) * ldw + n0 + (lane & 31)]; }
    LDS_WAIT(); asm volatile("" ::: "memory");
    const int c = lane & 7;
#pragma unroll
    for (int j = 0; j < 4; ++j) { const int n = (lane >> 3) + 8 * j; const LAS float* s = scr + (8 * c) * 33 + n;
        v4u o; o.x = pk2(s[0 * 33], s[1 * 33]); o.y = pk2(s[2 * 33], s[3 * 33]); o.z = pk2(s[4 * 33], s[5 * 33]); o.w = pk2(s[6 * 33], s[7 * 33]);
        *(GAS v4u*)(WT + (size_t)(dst_row0 + n) * ldt + k0 + 8 * c) = o; }
    LDS_WAIT(); asm volatile("" ::: "memory");
}
__device__ __forceinline__ void p0_prologue(Frame& F, const Args& args) {
    unsigned char* ws = args.ws;
    if (F.vcu < 192) {
        LAS float* sc = (LAS float*)(F.lds + RING_OFF); LAS float* part = sc + 9 * 1024;
        const float* c = args.in[I_C]; const float* cctx = args.in[I_CCTX];
        for (int i = F.tid; i < 9 * 1024; i += NWAVES * 64) { const int bb = i >> 10, k = i & 1023; const float v = bb < 8 ? c[bb * 1024 + k] : cctx[k]; sc[i] = v / (1.0f + expf(-v)); }
        __syncthreads();
        const int l = F.vcu / 96, cb = F.vcu % 96, k0 = F.wave * 128;
        const float* w = args.in[I_WADA] + (size_t)l * DM * MODW + (size_t)k0 * MODW + cb * 64 + F.lane;
        float acc[9];
#pragma unroll
        for (int j = 0; j < 9; ++j) acc[j] = 0.f;
        for (int k = 0; k < 128; k += 8) {
            float wv[8];
#pragma unroll
            for (int q = 0; q < 8; ++q) wv[q] = w[(size_t)(k + q) * MODW];
#pragma unroll
            for (int j = 0; j < 9; ++j) { const f32x4 s0 = *(const LAS f32x4*)(sc + j * 1024 + k0 + k), s1 = *(const LAS f32x4*)(sc + j * 1024 + k0 + k + 4);
                acc[j] += (s0[0] * wv[0] + s0[1] * wv[1]) + (s0[2] * wv[2] + s0[3] * wv[3]) + (s1[0] * wv[4] + s1[1] * wv[5]) + (s1[2] * wv[6] + s1[3] * wv[7]); }
        }
#pragma unroll
        for (int j = 0; j < 9; ++j) part[(F.wave * 9 + j) * 64 + F.lane] = acc[j];
        __syncthreads();
        float* mods = (float*)(ws + WS_MODS);
        for (int idx = F.tid; idx < 9 * 64; idx += NWAVES * 64) { const int j = idx >> 6, col = idx & 63; float s = 0.f;
#pragma unroll
            for (int wv_ = 0; wv_ < 8; ++wv_) s += part[(wv_ * 9 + j) * 64 + col];
            mods[(size_t)(l * 9 + j) * MODW + cb * 64 + col] = s + args.in[I_BADA][l * MODW + cb * 64 + col]; }
        __syncthreads();
    } else if (F.vcu == F.G - 1) {
        float* rc = (float*)(ws + WS_ROPE); float* rs = rc + 1024;
        for (int e = F.tid; e < 1024; e += NWAVES * 64) { const int pos = e >> 4, i = e & 15; const float fr = powf(10000.0f, -(float)(2 * i) / 32.0f); const float a = (float)pos * fr; rc[e] = cosf(a); rs[e] = sinf(a); }
    }
    LAS float* scr = (LAS float*)(F.lds + RING_OFF + F.wave * 16384);
    const int gw = F.vcu * NWAVES + F.wave, NGW = F.G * NWAVES;
    constexpr int I_IN = 16 * 56, I_OUT = 16 * 32, I_13 = 16 * 88, I_2 = 44 * 32, I_P = 4 * 8;
    constexpr int NITEMS = I_IN + I_OUT + 4 * I_13 + 2 * I_2 + 4 * I_P;
    for (int it = gw; it < NITEMS; it += NGW) {
        int r = it;
        if (r < I_IN) { const int kb = r / 56, nb = r % 56, f = 32 * nb, slot = f >> 6, bj = (f >> 5) & 1, pn = slot >> 2, wc = slot & 3;
            p0_transpose_item(args.in[I_WIN], INW, 64 * kb, f, (bf16*)(ws + WS_WIN), DM, 256 * pn + 128 * bj + 32 * wc, scr, F.lane); continue; } r -= I_IN;
        if (r < I_OUT) { const int kb = r / 32, nb = r % 32; p0_transpose_item(args.in[I_WOUT], DM, 64 * kb, 32 * nb, (bf16*)(ws + WS_WOUT), DM, 32 * nb, scr, F.lane); continue; } r -= I_OUT;
        if (r < 4 * I_13) { const int mi = r / I_13, rr = r % I_13, l = mi >> 1, which = mi & 1, kb = rr / 88, nb = rr % 88, n0 = 32 * nb;
            const float* W = args.in[which ? I_W3 : I_W1] + (size_t)l * DM * FF;
            p0_transpose_item(W, FF, 64 * kb, n0, (bf16*)(ws + WS_W13) + (size_t)l * 5632 * DM, DM, 256 * (n0 >> 7) + 128 * which + (n0 & 127), scr, F.lane); continue; } r -= 4 * I_13;
        if (r < 2 * I_2) { const int l = r / I_2, rr = r % I_2, kb = rr / 32, nb = rr % 32;
            p0_transpose_item(args.in[I_W2] + (size_t)l * FF * DM, DM, 64 * kb, 32 * nb, (bf16*)(ws + WS_W2) + (size_t)l * DM * FF, FF, 32 * nb, scr, F.lane); continue; } r -= 2 * I_2;
        { const int g = r / I_P, rr = r % I_P, kb = rr / 8, nb = rr % 8;
            p0_transpose_item(args.in[I_WPOOL] + (size_t)g * 256 * 256, 256, 64 * kb, 32 * nb, (bf16*)(ws + WS_WPOOL), 256, g * 256 + 32 * nb, scr, F.lane); }
    }
    { const float* wsp = args.in[I_WSP]; bf16* dst = (bf16*)(ws + WS_WSB);
        for (int e = (F.vcu * NWAVES * 64 + F.tid) * 4; e < 8 * 128 * 128; e += F.G * NWAVES * 64 * 4) { const f32x4 v = *(const f32x4*)(wsp + e); v2u o; o.x = pk2(v[0], v[1]); o.y = pk2(v[2], v[3]); *(v2u*)(dst + e) = o; } }
}
__device__ __forceinline__ void norm_pass(Frame& F, const float* src_lat, const float* src_ctx, bf16* dst, const float* gvec, const float* modl, int sh_off, int sc_off) {
    const int total = src_ctx ? MALL : MTOK, gw = F.vcu * NWAVES + F.wave, NGW = F.G * NWAVES, rpw = (total + NGW - 1) / NGW;
    const int r0 = gw * rpw, r1 = (r0 + rpw < total) ? r0 + rpw : total;
    int cur = -1; f32x4 gm[4], sh[4];
    for (int row = r0; row < r1; ++row) {
        const int bb = row < MTOK ? (row >> 12) : 8;
        if (bb != cur) { cur = bb;
#pragma unroll
            for (int j = 0; j < 4; ++j) { const int c = 4 * F.lane + 256 * j; const f32x4 g = *(const f32x4*)(gvec + c), s = *(const f32x4*)(modl + (size_t)bb * MODW + sc_off + c);
                gm[j] = g * (s + 1.0f); sh[j] = *(const f32x4*)(modl + (size_t)bb * MODW + sh_off + c); } }
        const float* xr = row < MTOK ? src_lat + (size_t)row * DM : src_ctx + (size_t)(row - MTOK) * DM;
        f32x4 v[4]; float ss = 0.f;
#pragma unroll
        for (int j = 0; j < 4; ++j) { v[j] = *(const f32x4*)(xr + 4 * F.lane + 256 * j); ss += (v[j][0] * v[j][0] + v[j][1] * v[j][1]) + (v[j][2] * v[j][2] + v[j][3] * v[j][3]); }
        const float r = 1.0f / sqrtf(wave_sum(ss) * (1.0f / DM) + 1e-6f);
        bf16* orow = dst + (size_t)row * DM;
#pragma unroll
        for (int j = 0; j < 4; ++j) { const f32x4 o = v[j] * r * gm[j] + sh[j]; v2u w; w.x = pk2(o[0], o[1]); w.y = pk2(o[2], o[3]); *(v2u*)(orow + 4 * F.lane + 256 * j) = w; }
    }
}
__device__ __forceinline__ void final_norm(Frame& F, float* out, const float* gvec) {
    const int gw = F.vcu * NWAVES + F.wave, NGW = F.G * NWAVES, rpw = (MTOK + NGW - 1) / NGW;
    const int r0 = gw * rpw, r1 = (r0 + rpw < MTOK) ? r0 + rpw : MTOK;
    f32x4 g[4];
#pragma unroll
    for (int j = 0; j < 4; ++j) g[j] = *(const f32x4*)(gvec + 4 * F.lane + 256 * j);
    for (int row = r0; row < r1; ++row) {
        float* xr = out + (size_t)row * DM; f32x4 v[4]; float ss = 0.f;
#pragma unroll
        for (int j = 0; j < 4; ++j) { v[j] = *(const f32x4*)(xr + 4 * F.lane + 256 * j); ss += (v[j][0] * v[j][0] + v[j][1] * v[j][1]) + (v[j][2] * v[j][2] + v[j][3] * v[j][3]); }
        const float r = 1.0f / sqrtf(wave_sum(ss) * (1.0f / DM) + 1e-6f);
#pragma unroll
        for (int j = 0; j < 4; ++j) *(f32x4*)(xr + 4 * F.lane + 256 * j) = v[j] * r * g[j];
    }
}
template <int W> __device__ __forceinline__ void pool_cols(const float* xb, int t0, int c, const LAS float* rs, f32x2 gm, f32x2 sh, bf16* dstb) {
    constexpr int L = W / 2, R = W / 2 - 1, NV = W - 1 + 16;
    f32x2 v[NV];
#define POOL_LD(dst_, t_) do { const int tt_ = (t_); if (tt_ < 0 || tt_ >= SEQ) dst_ = (f32x2){0.f, 0.f}; else { const f32x2 x_ = *(const f32x2*)(xb + (size_t)tt_ * DM + c); const float r_ = rs[tt_ - t0 + 8]; dst_ = x_ * r_ * gm + sh; } } while (0)
#pragma unroll
    for (int i = 0; i < W - 1; ++i) POOL_LD(v[i], t0 - L + i);
    for (int blk = 0; blk < 8; ++blk) {
        const int tb = t0 + 16 * blk;
#pragma unroll
        for (int i = 0; i < 16; ++i) POOL_LD(v[W - 1 + i], tb + R + i);
        f32x2 s = v[0];
#pragma unroll
        for (int i = 1; i < W; ++i) s += v[i];
#pragma unroll
        for (int j = 0; j < 16; ++j) { const int t = tb + j; const int lo = t - L < 0 ? 0 : t - L, hi = t + R > SEQ - 1 ? SEQ - 1 : t + R; const float cnt = (float)(hi - lo + 1);
            const f32x2 o = s / cnt - v[j + L]; *(unsigned*)(dstb + (size_t)t * DM + c) = pk2(o[0], o[1]);
            if (j < 15) s += v[j + W] - v[j]; }
#pragma unroll
        for (int i = 0; i < W - 1; ++i) v[i] = v[i + 16];
    }
#undef POOL_LD
}
__device__ __forceinline__ void pool_pass(Frame& F, const float* x, bf16* pooled, const float* gvec, const float* modl) {
    LAS float* rs = (LAS float*)(F.lds + RING_OFF);
    for (int strip = F.vcu; strip < MTOK / 128; strip += F.G) {
        const int b = strip >> 5, t0 = (strip & 31) * 128; const float* xb = x + (size_t)b * SEQ * DM;
        __syncthreads();
        for (int i = F.wave; i < 143; i += NWAVES) { const int t = t0 - 8 + i; float r = 0.f;
            if (t >= 0 && t < SEQ) { const float* xr = xb + (size_t)t * DM; float ss = 0.f;
#pragma unroll
                for (int j = 0; j < 4; ++j) { const f32x4 v = *(const f32x4*)(xr + 4 * F.lane + 256 * j); ss += (v[0] * v[0] + v[1] * v[1]) + (v[2] * v[2] + v[3] * v[3]); }
                r = 1.0f / sqrtf(wave_sum(ss) * (1.0f / DM) + 1e-6f); }
            if (F.lane == 0) rs[i] = r; }
        __syncthreads();
        const int c = 2 * F.tid; const float* mb = modl + (size_t)b * MODW;
        const f32x2 g = *(const f32x2*)(gvec + c), scv = *(const f32x2*)(mb + SC1 + c), shv = *(const f32x2*)(mb + SH1 + c); const f32x2 gm = g * (scv + 1.0f);
        bf16* dstb = pooled + (size_t)b * SEQ * DM;
        const int grp = F.wave >> 1;
        if (grp == 0) pool_cols<2>(xb, t0, c, rs, gm, shv, dstb); else if (grp == 1) pool_cols<4>(xb, t0, c, rs, gm, shv, dstb);
        else if (grp == 2) pool_cols<8>(xb, t0, c, rs, gm, shv, dstb); else pool_cols<16>(xb, t0, c, rs, gm, shv, dstb);
    }
    __syncthreads();
}
__device__ __forceinline__ void gmlp_unit(Frame& F, int unit, const bf16* VG, const bf16* U, const bf16* WSB, const float* bs, bf16* AM) {
    using attn_body::f32x16;
    const int g = F.wave, lane = F.lane, r32 = lane & 31, hi = lane >> 5;
    const size_t R0 = (size_t)unit * 128;
    LAS unsigned char* slot = F.lds + RING_OFF + g * 8192;
    const unsigned slot_addr = (unsigned)(uintptr_t)slot;
    const int vb = (int)slot_addr + ((lane >> 4) & 1) * 32 + (lane & 3) * 8 + (4 * hi + ((lane & 15) >> 2)) * 64;
    f32x16 o[4][2];
#pragma unroll
    for (int rb = 0; rb < 4; ++rb) { o[rb][0] = f32x16{}; o[rb][1] = f32x16{}; }
#pragma unroll
    for (int kt = 0; kt < 2; ++kt) {
#pragma unroll
        for (int p = 0; p < 8; ++p)
            attn_body::glds16(VG + (R0 + 64 * kt + 16 * (p & 3) + (lane >> 2)) * 512 + g * 64 + (p >> 2) * 32 + (lane & 3) * 8, (unsigned)__builtin_amdgcn_readfirstlane(slot_addr + p * 1024));
        VM_WAIT();
#pragma unroll
        for (int rb = 0; rb < 4; ++rb) { bf16x8 pa[4];
#pragma unroll
            for (int s = 0; s < 4; ++s) { const bf16* wp = WSB + ((size_t)(g * 128 + 32 * rb + r32) * 128 + 64 * kt + 16 * s + 4 * hi);
                const v2u a = *(const v2u*)wp, b = *(const v2u*)(wp + 8); pa[s] = __builtin_bit_cast(bf16x8, (v4u){a.x, a.y, b.x, b.y}); }
            attn_body::pv(o[rb], vb, pa[0], pa[1], pa[2], pa[3]); }
        LDS_WAIT();
    }
    LAS float* stg = (LAS float*)slot;
#pragma unroll
    for (int rb = 0; rb < 4; ++rb) {
#pragma unroll
        for (int r = 0; r < 16; ++r) { const int orow = attn_body::crow(r, hi); const float bv = bs[g * 128 + 32 * rb + orow];
            stg[orow * 64 + r32] = o[rb][0][r] + bv; stg[orow * 64 + 32 + r32] = o[rb][1][r] + bv; }
        LDS_WAIT();
#pragma unroll
        for (int i = 0; i < 4; ++i) { const int row = i * 8 + (lane >> 3), ch = lane & 7; const size_t grow = R0 + 32 * rb + row;
            const f32x4 a = *(const LAS f32x4*)(stg + row * 64 + ch * 8), b = *(const LAS f32x4*)(stg + row * 64 + ch * 8 + 4);
            const v4u uu = *(const v4u*)(U + grow * 512 + g * 64 + ch * 8);
            v4u w; w.x = pk2(a[0] * bf2f(uu.x & 0xffffu), a[1] * bf2f(uu.x >> 16)); w.y = pk2(a[2] * bf2f(uu.y & 0xffffu), a[3] * bf2f(uu.y >> 16));
            w.z = pk2(b[0] * bf2f(uu.z & 0xffffu), b[1] * bf2f(uu.z >> 16)); w.w = pk2(b[2] * bf2f(uu.w & 0xffffu), b[3] * bf2f(uu.w >> 16));
            *(v4u*)(AM + grow * 1024 + 512 + g * 64 + ch * 8) = w; }
        LDS_WAIT();
    }
}

__global__ void __launch_bounds__(NWAVES * 64, 2) mega_fwd(Args args) {
    extern __shared__ __attribute__((aligned(16))) unsigned char lds[];
    Frame F;
    F.lds = (LAS unsigned char*)lds;
    F.MISC = (volatile LAS unsigned*)(F.lds + MISC_OFF);
    F.tid = threadIdx.x; F.lane = F.tid & 63; F.wave = __builtin_amdgcn_readfirstlane(F.tid >> 6);
    F.G = gridDim.x; { const int bx = blockIdx.x; F.vcu = (F.G % 8 == 0) ? (bx % 8) * (F.G / 8) + bx / 8 : bx; }
    unsigned char* ws = args.ws;
    F.ctl = (gu32*)(ws + WS_CTL);
    for (int u = F.tid; u < (LDS_BYTES - LDSCTL_OFF) / 4; u += NWAVES * 64) ((LAS unsigned*)(F.lds + LDSCTL_OFF))[u] = 0u;
    __syncthreads();
    const int lo = args.ph_lo, hi = args.ph_hi;
    const bool one_launch = (hi - lo) > 1;
    XcdBarrier bar; bar.bar = (unsigned*)(F.ctl + CW_BAR); bar.x = 0; bar.st = nullptr;
    if (one_launch) bar = xcd_barrier_post((unsigned*)(F.ctl + CW_BAR), F.MISC + 8);
#ifndef PHASE_MASK
#define PHASE_MASK 0x3fff
#endif
#define IN(k) (((PHASE_MASK >> (k)) & 1) && lo <= (k) && (k) < hi)
#define SEAM(k) do { if (IN(k) && IN((k) + 1)) xcd_barrier(bar); } while (0)
#define RELAUNDER() do { int t_ = threadIdx.x; asm volatile("" : "+v"(t_)); F.tid = t_; F.lane = t_ & 63; } while (0)
    float* mods = (float*)(ws + WS_MODS);
    bf16* XN = (bf16*)(ws + WS_XN); bf16* AM = (bf16*)(ws + WS_AM); bf16* HB = (bf16*)(ws + WS_H);
    float* out = args.out;

    if (IN(0)) { RELAUNDER(); p0_prologue(F, args); } SEAM(0);
    if (IN(1)) { RELAUNDER(); norm_pass(F, args.in[I_X], args.in[I_CTX], XN, args.in[I_GMIX], mods, SH1, SC1); } SEAM(1);
    if (IN(2)) {
        pg8::Gemm g{XN, (const bf16*)(ws + WS_WIN), DM, DM, 0}; pg8::StaticOrder S; S.init(MTOK, INW, F.G, (int)blockIdx.x, MCTX / 256, 2);
        pg8::EpiInProj E{(bf16*)(ws + WS_Q), (bf16*)(ws + WS_KB), (bf16*)(ws + WS_VB), (bf16*)(ws + WS_U), (bf16*)(ws + WS_VG), args.in[I_QN], args.in[I_KN], args.in[I_GN],
                         (const float*)(ws + WS_ROPE), (const float*)(ws + WS_ROPE) + 1024, attn_body::C2};
        pg8::gemm_phase<pg8::EpiInProj, pg8::StaticOrder, PG8_ALIGN, PG8_SP2>(F.lds + RING_OFF, g, S, E);
    } SEAM(2);
    if (IN(3)) {
        const attn_body::AttnTensors AT{(const attn_body::bf16*)(ws + WS_Q), (const attn_body::bf16*)(ws + WS_KB), (const attn_body::bf16*)(ws + WS_VB), (attn_body::bf16*)AM};
        const attn_body::StaticOrder S((int)F.G, F.vcu);
        attn_body::attn_phase<attn_body::StaticOrder>((char*)lds + RING_OFF, AT, S);
        RELAUNDER();
        for (int u = F.vcu; u < MTOK / 128; u += F.G) gmlp_unit(F, u, (const bf16*)(ws + WS_VG), (const bf16*)(ws + WS_U), (const bf16*)(ws + WS_WSB), args.in[I_BSP], AM);
    } SEAM(3);
    if (IN(4)) {
        pg8::Gemm g{AM, (const bf16*)(ws + WS_WOUT), DM, DM, 0}; pg8::StaticOrder S; S.init(MTOK, DM, F.G, (int)blockIdx.x);
        pg8::EpiResid E{args.in[I_X], out, mods + GA1, MODW, nullptr};
        pg8::gemm_phase<pg8::EpiResid, pg8::StaticOrder, PG8_ALIGN, PG8_SP2>(F.lds + RING_OFF, g, S, E);
    } SEAM(4);
#pragma unroll 1
    for (int l = 0; l < 2; ++l) {
        const int pb = 5 + 5 * l;
        const float* modl = mods + (size_t)l * 9 * MODW;
        if (l == 1) {
            if (IN(8)) { RELAUNDER(); pool_pass(F, out, AM, args.in[I_GMIX] + DM, modl); } SEAM(8);
            if (IN(9)) {
                pg8::Gemm g{AM, (const bf16*)(ws + WS_WPOOL), 256, DM, 512}; pg8::StaticOrder S; S.init(MTOK, DM, F.G, (int)blockIdx.x);
                pg8::EpiResid E{out, out, modl + GA1, MODW, args.in[I_PSC]};
                pg8::gemm_phase<pg8::EpiResid, pg8::StaticOrder, PG8_ALIGN, PG8_SP2>(F.lds + RING_OFF, g, S, E);
            } SEAM(9);
        }
        if (IN(pb)) { RELAUNDER(); norm_pass(F, out, nullptr, XN, args.in[I_GFFN] + l * DM, modl, SH2, SC2); } SEAM(pb);
        if (IN(pb + 1)) {
            pg8::Gemm g{XN, (const bf16*)(ws + WS_W13) + (size_t)l * 5632 * DM, DM, DM, 0}; pg8::StaticOrder S; S.init(MTOK, 2 * FF, F.G, (int)blockIdx.x);
            pg8::EpiSwiglu E{HB, FF};
            pg8::gemm_phase<pg8::EpiSwiglu, pg8::StaticOrder, PG8_ALIGN, PG8_SP2>(F.lds + RING_OFF, g, S, E);
        } SEAM(pb + 1);
        if (IN(pb + 2)) {
            pg8::Gemm g{HB, (const bf16*)(ws + WS_W2) + (size_t)l * DM * FF, FF, FF, 0}; pg8::StaticOrder S; S.init(MTOK, DM, F.G, (int)blockIdx.x);
            pg8::EpiResid E{out, out, modl + GA2, MODW, nullptr};
            pg8::gemm_phase<pg8::EpiResid, pg8::StaticOrder, PG8_ALIGN, PG8_SP2>(F.lds + RING_OFF, g, S, E);
        } SEAM(pb + 2);
    }
    if (IN(13)) { RELAUNDER(); final_norm(F, out, args.in[I_GFIN]); }
#undef IN
#undef SEAM
}

extern "C" void kernel_launch(void* const* d_in, const int* in_sizes, int n_in, void* d_out, int out_size, void* d_ws, size_t ws_size, hipStream_t stream) {
    static int grid = 0;
    if (grid == 0) {
        if (n_in != 21 || out_size != MTOK * DM || ws_size < WS_END) { fprintf(stderr, "kernel_launch: unexpected shapes (n_in %d, out %d, ws %zu)\n", n_in, out_size, ws_size); grid = -1; return; }
        int dev = 0, cus = 0, per_cu = 0;
        if (hipGetDevice(&dev) != hipSuccess || hipDeviceGetAttribute(&cus, hipDeviceAttributeMultiprocessorCount, dev) != hipSuccess) { grid = -1; return; }
        if (hipFuncSetAttribute((const void*)mega_fwd, hipFuncAttributeMaxDynamicSharedMemorySize, LDS_BYTES) != hipSuccess) { fprintf(stderr, "kernel_launch: hipFuncSetAttribute failed\n"); grid = -1; return; }
        if (hipOccupancyMaxActiveBlocksPerMultiprocessor(&per_cu, (const void*)mega_fwd, NWAVES * 64, LDS_BYTES) != hipSuccess || per_cu < 1) { fprintf(stderr, "kernel_launch: occupancy query says %d\n", per_cu); per_cu = 1; }
        (void)hipGetLastError();
        grid = cus;
        if (grid != 256) fprintf(stderr, "kernel_launch: %d CUs (expected 256)\n", grid);
    }
    if (grid < 0) return;
    if (hipMemsetAsync((char*)d_ws + WS_CTL, 0, CTL_ZERO_BYTES, stream) != hipSuccess) return;
    Args a{};
    for (int i = 0; i < 21; ++i) a.in[i] = (const float*)d_in[i];
    a.out = (float*)d_out; a.ws = (unsigned char*)d_ws;
#if defined(MK_PER_PHASE)
    for (int p = 0; p < N_PHASES; ++p) { a.ph_lo = p; a.ph_hi = p + 1; hipLaunchKernelGGL(mega_fwd, dim3(grid), dim3(NWAVES * 64), LDS_BYTES, stream, a); }
#else
    a.ph_lo = 0; a.ph_hi = N_PHASES;
    hipLaunchKernelGGL(mega_fwd, dim3(grid), dim3(NWAVES * 64), LDS_BYTES, stream, a);
#endif
}
```

```cpp
#include <hip/hip_runtime.h>
#include <hip/hip_bf16.h>
#include <cstdio>
#include <cstdint>
#include <cmath>
constexpr int NWAVES_ = 8;
constexpr int NWAVES = 8;
constexpr int DM = 1024, NB = 8, SEQ = 4096, MTOK = NB * SEQ, CTXL = 256, MCTX = NB * CTXL, MALL = MTOK + MCTX;
constexpr int INW = 1792, FF = 2816, SKV = SEQ + CTXL;
constexpr int N_PHASES = 11;
constexpr size_t MiB = 1u << 20;
constexpr size_t WS_CTL = 0, CTL_ZERO_BYTES = 128 * 1024;
constexpr size_t WS_MODS = 1 * MiB;
constexpr size_t WS_ROPE = WS_MODS + 512 * 1024;
constexpr size_t WS_WSB = 2 * MiB;
constexpr size_t WS_WPOOL = WS_WSB + 512 * 1024;
constexpr size_t WS_WIN = 4 * MiB;
constexpr size_t WS_WOUT = 8 * MiB;
constexpr size_t WS_W13 = 10 * MiB;
constexpr size_t WS_W2 = 32 * MiB;
constexpr size_t WS_XN = 44 * MiB;
constexpr size_t WS_Q = 112 * MiB;
constexpr size_t WS_RES = 112 * MiB;
constexpr size_t WS_KB = 144 * MiB;
constexpr size_t WS_VB = 153 * MiB;
constexpr size_t WS_U = 162 * MiB;
constexpr size_t WS_VG = 194 * MiB;
constexpr size_t WS_AM = 226 * MiB;
constexpr size_t WS_H = 290 * MiB;
constexpr size_t WS_WPB = 474 * MiB;
constexpr size_t WS_END = 478 * MiB;
constexpr int CW_BAR = 4096;
constexpr size_t CTL_CNT = 65536;
constexpr size_t WS_PART = 466 * MiB;
static_assert(CTL_CNT + 32768 <= CTL_ZERO_BYTES, "CTL map");
constexpr size_t WS_BIAS = WS_ROPE + 65536;
constexpr int RING_OFF = 0, RING_BYTES = 131072;
constexpr int LDSCTL_OFF = RING_BYTES, MISC_OFF = LDSCTL_OFF + 320;
constexpr int RTAB_OFF = LDSCTL_OFF + 1024;
constexpr int LDS_BYTES = 147456;
static_assert(MISC_OFF + 128 <= LDS_BYTES, "LDS map");

struct Args { const float* in[21]; float* out; unsigned char* ws; int ph_lo, ph_hi; };
#define KARG __attribute__((address_space(4)))
typedef const KARG Args* ArgsP;
static_assert(sizeof(Args) == 192, "Args has no padding");
enum { I_X = 0, I_C, I_CTX, I_CCTX, I_WADA, I_BADA, I_GMIX, I_GFFN, I_WIN, I_WOUT, I_QN, I_KN, I_GN, I_WSP, I_BSP, I_WPOOL, I_PSC, I_W1, I_W3, I_W2, I_GFIN };
constexpr int SH1 = 0, SC1 = DM, GA1 = 2 * DM, SH2 = 3 * DM, SC2 = 4 * DM, GA2 = 5 * DM, MODW = 6 * DM;

namespace pg8 {
#define PG8_LAS __attribute__((address_space(3)))
typedef unsigned short bf16_t;
typedef short bf16x8 __attribute__((ext_vector_type(8)));
typedef float f32x4 __attribute__((ext_vector_type(4)));
typedef float f32x2 __attribute__((ext_vector_type(2)));
typedef unsigned u32x4 __attribute__((ext_vector_type(4)));
constexpr int BM = 256, BK = 64, HALF = 128, HTB = HALF * BK * 2  , STAGE_BYTES = 8 * HTB, NXCD = 8, WGM = 8;

__host__ __device__ __forceinline__ int lds_byte(int r, int c) { const int st = (r >> 4) * 2 + (c >> 5), rr = r & 15, cc = c & 31, ob = rr * 64 + cc * 2; return st * 1024 + (ob ^ (((ob >> 9) & 1) << 5)); }
__host__ __device__ __forceinline__ void stage_rc(int b, int& R, int& C) { const int st = b / 1024, sb = b % 1024, swz = sb ^ (((sb >> 9) & 1) << 5); R = (st >> 1) * 16 + swz / 64; C = (st & 1) * 32 + (swz % 64) / 2; }
__host__ __device__ __forceinline__ int perm32(int rho) { const int n = rho >> 4, i = rho & 15; return 8 * (i >> 2) + 4 * n + (i & 3); }

struct Unit { int pm, pn; };
struct Gemm { const bf16_t* A; const bf16_t* Bt; int K; int lda; int a_pn_bytes; int b_batch_bytes; };

struct StaticOrder {
    int nM, nN, nwg, G, c, extra, extra_pn;
    __host__ __device__ void init(int M, int N, int G_, int c_, int extra_ = 0, int extra_pn_ = 0) { nM = M / BM; nN = N / BM; nwg = nM * nN; G = G_; c = c_; extra = extra_; extra_pn = extra_pn_; }
    __host__ __device__ bool next(int i, Unit& u) const {
        const long L = (long)i * G + c;
        if (L >= nwg) { const long e = L - nwg; if (e >= extra) return false; u.pm = nM + (int)e; u.pn = extra_pn; return true; }
        int wgid = (int)L; { const int q = nwg / NXCD, r = nwg % NXCD, xcd = wgid % NXCD, off = wgid / NXCD; wgid = (xcd < r ? xcd * (q + 1) : r * (q + 1) + (xcd - r) * q) + off; }
        const int nig = WGM * nN, gid = wgid / nig, fm = gid * WGM, gsz = (nM - fm) < WGM ? (nM - fm) : WGM;
        u.pm = fm + ((wgid % nig) % gsz); u.pn = (wgid % nig) / gsz; return true;
    }
    __device__ __forceinline__ void a_ready(const Unit&) const {}
    __device__ __forceinline__ void done(const Unit&) const {}
};

__device__ __forceinline__ unsigned cvt_pk_bf16(float lo, float hi) { unsigned r; asm volatile("v_cvt_pk_bf16_f32 %0, %1, %2" : "=v"(r) : "v"(lo), "v"(hi)); return r; }
__device__ __forceinline__ f32x2 gelu_pk(f32x2 v) {
    const f32x2 av = __builtin_elementwise_abs(v), d = av * 0.2316418882f + 1.0f;
    f32x2 t; t.x = __builtin_amdgcn_rcpf(d.x); t.y = __builtin_amdgcn_rcpf(d.y);
    f32x2 q = t * 0.5307027145f + (-0.7265760135f); q = q * t + 0.7107068705f; q = q * t + (-0.142248368f); q = q * t + 0.127414796f; q = q * t;
    const f32x2 s = (v * v) * (-0.72134752044f);
    f32x2 e; e.x = __builtin_amdgcn_exp2f(s.x); e.y = __builtin_amdgcn_exp2f(s.y);
    const f32x2 m = v * (q * e), r = v - m;
    f32x2 o; o.x = v.x < 0.f ? m.x : r.x; o.y = v.y < 0.f ? m.y : r.y; return o;
}
__device__ __forceinline__ f32x4 gelu4(f32x4 v) { const f32x2 a = gelu_pk((f32x2){v[0], v[1]}), b = gelu_pk((f32x2){v[2], v[3]}); return (f32x4){a.x, a.y, b.x, b.y}; }
__device__ __forceinline__ float silu1(float v) { return v * __builtin_amdgcn_rcpf(1.0f + __builtin_amdgcn_exp2f(v * -1.4426950408889634f)); }
__device__ __forceinline__ u32x4 pack8(f32x4 v0, f32x4 v1) { u32x4 w; w.x = cvt_pk_bf16(v0[0], v0[1]); w.y = cvt_pk_bf16(v0[2], v0[3]); w.z = cvt_pk_bf16(v1[0], v1[1]); w.w = cvt_pk_bf16(v1[2], v1[3]); return w; }

struct EpiInProj {
    static constexpr bool PERM = true, AFTER_DRAIN = false;
    ArgsP A;
    __device__ __forceinline__ void operator()(const f32x4 (&acc)[2][2][4][2], const Unit& u, int wr, int wc, int fr_, int fq_) const {
        ArgsP a_ = A; asm volatile("" : "+s"(a_)); unsigned char* ws_ = a_->ws;
        bf16_t* Q = (bf16_t*)(ws_ + WS_Q); bf16_t* KB = (bf16_t*)(ws_ + WS_KB); bf16_t* VB = (bf16_t*)(ws_ + WS_VB); bf16_t* U = (bf16_t*)(ws_ + WS_U); bf16_t* VG = (bf16_t*)(ws_ + WS_VG);
        const float* qn = a_->in[I_QN]; const float* kn = a_->in[I_KN]; const float* gv = a_->in[I_GN]; const float* ropeC = (const float*)(ws_ + WS_ROPE); const float* ropeS = ropeC + 1024;
        const float qscale = 0.125f * 1.4426950408889634f;
        int t_ = threadIdx.x; asm volatile("" : "+v"(t_)); const int fr = t_ & 15, fq = (t_ >> 4) & 3; (void)fr_; (void)fq_;
        const int slot = 4 * u.pn + wc; const bool isctx = u.pm >= 128;
        const int rowl = wr * 64 + fr;
        const int row0 = u.pm * BM + rowl;
        const int kvrow0 = (isctx ? (u.pm - 128) * 4352 + 4096 : (u.pm >> 4) * 4352 + (u.pm & 15) * 256) + rowl;
        const int dl = 8 * fq;
        if (slot < 10) {
            const float* nw = slot < 8 ? qn : kn; const float osc = slot < 8 ? qscale : 1.0f;
            f32x4 w[2][2];
#pragma unroll
            for (int bj = 0; bj < 2; ++bj)
#pragma unroll
                for (int n = 0; n < 2; ++n) w[bj][n] = *(const f32x4*)(nw + 32 * bj + dl + 4 * n);
#pragma unroll
            for (int ai = 0; ai < 2; ++ai) {
                const int posr = (4 * u.pm + 2 * ai + wr) & 63;
                const f32x4 cr = *(const f32x4*)(ropeC + posr * 16 + 4 * fq), sr = *(const f32x4*)(ropeS + posr * 16 + 4 * fq);
#pragma unroll
                for (int m = 0; m < 4; ++m) {
                    float ss = 0.f;
#pragma unroll
                    for (int bj = 0; bj < 2; ++bj)
#pragma unroll
                        for (int n = 0; n < 2; ++n) { const f32x4 x = acc[ai][bj][m][n]; ss += (x[0] * x[0] + x[1] * x[1]) + (x[2] * x[2] + x[3] * x[3]); }
                    ss += __shfl_xor(ss, 16); ss += __shfl_xor(ss, 32);
                    const float r = __builtin_amdgcn_rsqf(ss * (1.0f / 64.0f) + 1e-6f) * osc;
                    const int posc = 16 * m + fr;
                    const f32x4 cc = *(const f32x4*)(ropeC + posc * 16 + 4 * fq), sc = *(const f32x4*)(ropeS + posc * 16 + 4 * fq);
#pragma unroll
                    for (int bj = 0; bj < 2; ++bj) {
                        f32x4 v0 = acc[ai][bj][m][0] * r * w[bj][0], v1 = acc[ai][bj][m][1] * r * w[bj][1];
                        if (!isctx) { const f32x4 c = bj ? cc : cr, s = bj ? sc : sr;
                            const f32x4 o0 = (f32x4){v0[0] * c[0] - v0[1] * s[0], v0[0] * s[0] + v0[1] * c[0], v0[2] * c[1] - v0[3] * s[1], v0[2] * s[1] + v0[3] * c[1]};
                            const f32x4 o1 = (f32x4){v1[0] * c[2] - v1[1] * s[2], v1[0] * s[2] + v1[1] * c[2], v1[2] * c[3] - v1[3] * s[3], v1[2] * s[3] + v1[3] * c[3]};
                            v0 = o0; v1 = o1; }
                        bf16_t* dst = slot < 8 ? Q + (size_t)(row0 + ai * HALF + m * 16) * 512 + slot * 64 + 32 * bj + dl
                                               : KB + (size_t)(kvrow0 + ai * HALF + m * 16) * 128 + (slot - 8) * 64 + 32 * bj + dl;
                        *(u32x4*)dst = pack8(v0, v1);
                    }
                    asm volatile("" ::: "memory");
                }
            }
        } else if (slot < 12) {
#pragma unroll
            for (int ai = 0; ai < 2; ++ai)
#pragma unroll
                for (int m = 0; m < 4; ++m)
#pragma unroll
                    for (int bj = 0; bj < 2; ++bj)
                        *(u32x4*)(VB + (size_t)(kvrow0 + ai * HALF + m * 16) * 128 + (slot - 10) * 64 + 32 * bj + dl) = pack8(acc[ai][bj][m][0], acc[ai][bj][m][1]);
        } else if (slot < 20) {
#pragma unroll
            for (int ai = 0; ai < 2; ++ai)
#pragma unroll
                for (int m = 0; m < 4; ++m)
#pragma unroll
                    for (int bj = 0; bj < 2; ++bj)
                        *(u32x4*)(U + (size_t)(row0 + ai * HALF + m * 16) * 512 + (slot - 12) * 64 + 32 * bj + dl) = pack8(gelu4(acc[ai][bj][m][0]), gelu4(acc[ai][bj][m][1]));
        } else {
            f32x4 w[2][2];
#pragma unroll
            for (int bj = 0; bj < 2; ++bj)
#pragma unroll
                for (int n = 0; n < 2; ++n) w[bj][n] = *(const f32x4*)(gv + (slot - 20) * 64 + 32 * bj + dl + 4 * n);
#pragma unroll
            for (int ai = 0; ai < 2; ++ai)
#pragma unroll
                for (int m = 0; m < 4; ++m) {
                    f32x4 g[2][2]; float ss = 0.f;
#pragma unroll
                    for (int bj = 0; bj < 2; ++bj)
#pragma unroll
                        for (int n = 0; n < 2; ++n) { const f32x4 x = gelu4(acc[ai][bj][m][n]); g[bj][n] = x; ss += (x[0] * x[0] + x[1] * x[1]) + (x[2] * x[2] + x[3] * x[3]); }
                    ss += __shfl_xor(ss, 16); ss += __shfl_xor(ss, 32);
                    const float r = __builtin_amdgcn_rsqf(ss * (1.0f / 64.0f) + 1e-6f);
#pragma unroll
                    for (int bj = 0; bj < 2; ++bj)
                        *(u32x4*)(VG + (size_t)(row0 + ai * HALF + m * 16) * 512 + (slot - 20) * 64 + 32 * bj + dl) = pack8(g[bj][0] * r * w[bj][0], g[bj][1] * r * w[bj][1]);
                }
        }
    }
};
constexpr int RS_M = 32768;
__device__ __forceinline__ float row_total(const float* part, int row, int fq) {
    const f32x4 p = *(const f32x4*)(part + ((size_t)fq * RS_M + row) * 4); float t = (p[0] + p[1]) + (p[2] + p[3]); t += __shfl_xor(t, 16); t += __shfl_xor(t, 32); return t;
}
template <int V> struct EpiResid {
    static constexpr bool PERM = true, AFTER_DRAIN = false, XNOUT = (V == 4), FINAL = (V == 10), BASE16 = (V != 4);
    ArgsP A; void* outp;
    __device__ __forceinline__ void operator()(f32x4 (&acc)[2][2][4][2], const Unit& u, int wr, int wc, int fr_, int fq_) const {
        int t_ = threadIdx.x; asm volatile("" : "+v"(t_)); const int fr = t_ & 15, fq = (t_ >> 4) & 3; (void)fr_; (void)fq_;
        const int row0 = u.pm * BM + wr * 64 + fr, col0 = u.pn * BM + wc * 32 + 8 * fq, b = u.pm >> 4;
        ArgsP a_ = A; asm volatile("" : "+s"(a_)); unsigned char* ws_ = a_->ws; constexpr int gstride = MODW;
        const float* mods_ = (const float*)(ws_ + WS_MODS); const float* modl_ = mods_ + (V == 10 ? 9 * MODW : 0);
        const float* basef = a_->in[I_X]; const bf16_t* baseh = (const bf16_t*)(ws_ + WS_RES); const float* gate = modl_ + (V == 4 ? GA1 : GA2);
        float* part = (float*)(ws_ + WS_PART) + (size_t)(V == 4 ? 0 : V == 10 ? 3 : 1) * 16 * RS_M;
        bf16_t* xn = (bf16_t*)(ws_ + WS_XN); const float* gnext = (V == 4) ? a_->in[I_GFFN] : a_->in[I_GMIX] + DM; const float* scnext = (V == 4) ? mods_ + SC2 : mods_ + 9 * MODW + SC1;
        unsigned* cnt = (unsigned*)(ws_ + WS_CTL + CTL_CNT); const float* gfin = a_->in[I_GFIN];
        bf16_t* resout = (bf16_t*)outp; float* out = (float*)outp;
        const float* gp = gate + (size_t)b * gstride + col0;
        f32x4 gvv[2][2], gmn[2][2];
#pragma unroll
        for (int bj = 0; bj < 2; ++bj)
#pragma unroll
            for (int n = 0; n < 2; ++n) { gvv[bj][n] = *(const f32x4*)(gp + bj * HALF + n * 4);
                if (XNOUT) gmn[bj][n] = *(const f32x4*)(gnext + col0 + bj * HALF + n * 4) * (*(const f32x4*)(scnext + (size_t)b * gstride + col0 + bj * HALF + n * 4) + 1.0f); }
        float ssv[2][4];
        f32x4 bsA[2][2], bsB[2][2], bsC[2][2], bsD[2][2], bsE[2][2], bsF[2][2], bsG[2][2], bsH[2][2];
        u32x4 hsA[2], hsB[2], hsC[2], hsD[2], hsE[2], hsF[2], hsG[2], hsH[2];
#define ER_LOAD(X, p) do { const size_t off_ = (size_t)(row0 + ((p) >> 2) * HALF + ((p) & 3) * 16) * 1024 + col0; \
            _Pragma("unroll") for (int bj = 0; bj < 2; ++bj) { if (BASE16) { if (FINAL) hs##X[bj] = __builtin_nontemporal_load((const u32x4*)(baseh + off_ + bj * HALF)); else hs##X[bj] = *(const u32x4*)(baseh + off_ + bj * HALF); } \
                else { bs##X[bj][0] = __builtin_nontemporal_load((const f32x4*)(basef + off_ + bj * HALF)); bs##X[bj][1] = __builtin_nontemporal_load((const f32x4*)(basef + off_ + bj * HALF + 4)); } } } while (0)
#define ER_WORK(X, p) do { const int ai = (p) >> 2, m = (p) & 3; const size_t off_ = (size_t)(row0 + ai * HALF + m * 16) * 1024 + col0; float ss = 0.f; \
            _Pragma("unroll") for (int bj = 0; bj < 2; ++bj) { f32x4 b0, b1; \
                if (BASE16) { const u32x4 h = hs##X[bj]; b0 = (f32x4){__builtin_bit_cast(float, h.x << 16), __builtin_bit_cast(float, h.x & 0xffff0000u), __builtin_bit_cast(float, h.y << 16), __builtin_bit_cast(float, h.y & 0xffff0000u)}; \
                    b1 = (f32x4){__builtin_bit_cast(float, h.z << 16), __builtin_bit_cast(float, h.z & 0xffff0000u), __builtin_bit_cast(float, h.w << 16), __builtin_bit_cast(float, h.w & 0xffff0000u)}; } \
                else { b0 = bs##X[bj][0]; b1 = bs##X[bj][1]; } \
                const f32x4 x0 = b0 + gvv[bj][0] * acc[ai][bj][m][0], x1 = b1 + gvv[bj][1] * acc[ai][bj][m][1]; \
                ss += ((x0[0] * x0[0] + x0[1] * x0[1]) + (x0[2] * x0[2] + x0[3] * x0[3])) + ((x1[0] * x1[0] + x1[1] * x1[1]) + (x1[2] * x1[2] + x1[3] * x1[3])); \
                if (FINAL) { acc[ai][bj][m][0] = x0; acc[ai][bj][m][1] = x1; } else *(u32x4*)(resout + off_ + bj * HALF) = pack8(x0, x1); \
                if (XNOUT) *(u32x4*)(xn + off_ + bj * HALF) = pack8(x0 * gmn[bj][0], x1 * gmn[bj][1]); } \
            ss += __shfl_xor(ss, 16); ss += __shfl_xor(ss, 32); ssv[ai][m] = ss; } while (0)
#define ER_FENCE asm volatile("" ::: "memory")
        if constexpr (FINAL) {
            ER_LOAD(A, 0); ER_LOAD(B, 1); ER_LOAD(C, 2); ER_LOAD(D, 3); ER_LOAD(E, 4); ER_LOAD(F, 5); ER_LOAD(G, 6); ER_LOAD(H, 7); ER_FENCE;
            ER_WORK(A, 0); ER_WORK(B, 1); ER_WORK(C, 2); ER_WORK(D, 3); ER_WORK(E, 4); ER_WORK(F, 5); ER_WORK(G, 6); ER_WORK(H, 7);
        } else if constexpr (BASE16) {
            ER_LOAD(A, 0); ER_LOAD(B, 1); ER_LOAD(C, 2); ER_LOAD(D, 3); ER_FENCE;
            ER_LOAD(E, 4); ER_FENCE; ER_WORK(A, 0); ER_FENCE;
            ER_LOAD(A, 5); ER_FENCE; ER_WORK(B, 1); ER_FENCE;
            ER_LOAD(B, 6); ER_FENCE; ER_WORK(C, 2); ER_FENCE;
            ER_LOAD(C, 7); ER_FENCE; ER_WORK(D, 3); ER_FENCE;
            ER_WORK(E, 4); ER_FENCE; ER_WORK(A, 5); ER_FENCE; ER_WORK(B, 6); ER_FENCE; ER_WORK(C, 7);
        } else {
            ER_LOAD(A, 0); ER_LOAD(B, 1); ER_FENCE;
            ER_LOAD(C, 2); ER_FENCE; ER_WORK(A, 0); ER_FENCE;
            ER_LOAD(A, 3); ER_FENCE; ER_WORK(B, 1); ER_FENCE;
            ER_LOAD(B, 4); ER_FENCE; ER_WORK(C, 2); ER_FENCE;
            ER_LOAD(C, 5); ER_FENCE; ER_WORK(A, 3); ER_FENCE;
            ER_LOAD(A, 6); ER_FENCE; ER_WORK(B, 4); ER_FENCE;
            ER_LOAD(B, 7); ER_FENCE; ER_WORK(C, 5); ER_FENCE;
            ER_WORK(A, 6); ER_FENCE;
            ER_WORK(B, 7);
        }
#undef ER_FENCE
#undef ER_LOAD
#undef ER_WORK
        if (fq == 0) {
#pragma unroll
            for (int ai = 0; ai < 2; ++ai)
#pragma unroll
                for (int m = 0; m < 4; ++m) { float* pp = part + ((size_t)u.pn * RS_M + (row0 + ai * HALF + m * 16)) * 4 + wc;
                    if (FINAL) __hip_atomic_store(pp, ssv[ai][m], __ATOMIC_RELAXED, __HIP_MEMORY_SCOPE_AGENT); else *pp = ssv[ai][m]; }
        }
        if (FINAL) {
            asm volatile("s_waitcnt vmcnt(0)" ::: "memory");
            unsigned* cw = cnt + 64 * u.pm;
            if (fr == 0 && fq == 0) __hip_atomic_fetch_add(cw, 1u, __ATOMIC_RELAXED, __HIP_MEMORY_SCOPE_AGENT);
            { unsigned sp = 0; while ((unsigned)__builtin_amdgcn_readfirstlane(__hip_atomic_load(cw, __ATOMIC_RELAXED, __HIP_MEMORY_SCOPE_AGENT)) < 32u) { __builtin_amdgcn_s_sleep(2); if (++sp > (1u << 22)) break; } }
            f32x4 gf[2][2];
#pragma unroll
            for (int bj = 0; bj < 2; ++bj)
#pragma unroll
                for (int n = 0; n < 2; ++n) gf[bj][n] = *(const f32x4*)(gfin + col0 + bj * HALF + n * 4);
            float rr[2][4];
            {
                f32x4 pq[8];
#pragma unroll
                for (int i = 0; i < 8; ++i) { const float* pp = part + ((size_t)fq * RS_M + (row0 + (i >> 2) * HALF + (i & 3) * 16)) * 4;
                    asm volatile("global_load_dwordx4 %0, %1, off sc1" : "=v"(pq[i]) : "v"(pp) : "memory"); }
                asm volatile("s_waitcnt vmcnt(0)" : "+v"(pq[0]), "+v"(pq[1]), "+v"(pq[2]), "+v"(pq[3]), "+v"(pq[4]), "+v"(pq[5]), "+v"(pq[6]), "+v"(pq[7]) :: "memory");
#pragma unroll
                for (int i = 0; i < 8; ++i) { float t = (pq[i][0] + pq[i][1]) + (pq[i][2] + pq[i][3]); t += __shfl_xor(t, 16); t += __shfl_xor(t, 32); rr[i >> 2][i & 3] = __builtin_amdgcn_rsqf(t * (1.0f / 1024.0f) + 1e-6f); }
            }
#pragma unroll
            for (int ai = 0; ai < 2; ++ai)
#pragma unroll
                for (int m = 0; m < 4; ++m) { const size_t off = (size_t)(row0 + ai * HALF + m * 16) * 1024 + col0;
#pragma unroll
                    for (int bj = 0; bj < 2; ++bj)
#pragma unroll
                        for (int n = 0; n < 2; ++n) *(f32x4*)(out + off + bj * HALF + n * 4) = acc[ai][bj][m][n] * rr[ai][m] * gf[bj][n]; }
        }
    }
};
template <int L> struct EpiSwiglu {
    static constexpr bool PERM = true, AFTER_DRAIN = false;
    ArgsP A; const PG8_LAS float* rtab; int pm0;
    __device__ __forceinline__ void operator()(const f32x4 (&acc)[2][2][4][2], const Unit& u, int wr, int wc, int fr_, int fq_) const {
        int t_ = threadIdx.x; asm volatile("" : "+v"(t_)); const int fr = t_ & 15, fq = (t_ >> 4) & 3; (void)fr_; (void)fq_;
        const int row0 = u.pm * BM + wr * 64 + fr, col0 = u.pn * HALF + wc * 32 + 8 * fq;
        ArgsP a_ = A; asm volatile("" : "+s"(a_)); unsigned char* ws_ = a_->ws; constexpr int ldh = FF;
        bf16_t* H = (bf16_t*)(ws_ + WS_H); const float* rowss = (const float*)(ws_ + WS_PART) + (size_t)(L ? 2 : 0) * 16 * RS_M; const float* bias = (const float*)(ws_ + WS_BIAS) + (size_t)L * 8 * 5632;
        const float* bp = bias + (size_t)(u.pm >> 4) * 5632 + u.pn * BM + wc * 32 + 8 * fq;
        f32x4 bv[2][2];
#pragma unroll
        for (int bj = 0; bj < 2; ++bj)
#pragma unroll
            for (int n = 0; n < 2; ++n) bv[bj][n] = *(const f32x4*)(bp + bj * HALF + 4 * n);
        float rr[2][4]; { const PG8_LAS float* rt = rtab + (u.pm == pm0 ? 0 : 256) + wr * 64 + fr; (void)rowss;
#pragma unroll
            for (int ai = 0; ai < 2; ++ai)
#pragma unroll
                for (int m = 0; m < 4; ++m) rr[ai][m] = rt[ai * HALF + m * 16]; }
#pragma unroll
        for (int ai = 0; ai < 2; ++ai)
#pragma unroll
            for (int m = 0; m < 4; ++m) { const int row = row0 + ai * HALF + m * 16; const float r = rr[ai][m]; f32x4 h[2];
#pragma unroll
                for (int n = 0; n < 2; ++n) { const f32x4 a = acc[ai][0][m][n] * r + bv[0][n], b = acc[ai][1][m][n] * r + bv[1][n]; h[n] = (f32x4){silu1(a[0]) * b[0], silu1(a[1]) * b[1], silu1(a[2]) * b[2], silu1(a[3]) * b[3]}; }
                *(u32x4*)(H + (size_t)row * ldh + col0) = pack8(h[0], h[1]); }
    }
};

struct EpiNull {
    static constexpr bool PERM = true, AFTER_DRAIN = false;
    bf16_t* D;
    __device__ __forceinline__ void operator()(const f32x4 (&acc)[2][2][4][2], const Unit& u, int wr, int wc, int fr_, int fq_) const {
        int t_ = threadIdx.x; asm volatile("" : "+v"(t_)); const int fr = t_ & 15, fq = (t_ >> 4) & 3; (void)fr_; (void)fq_;
        const int row0 = u.pm * BM + wr * 64 + fr, col0 = u.pn * BM + wc * 32 + 8 * fq;
#pragma unroll
        for (int ai = 0; ai < 2; ++ai)
#pragma unroll
            for (int m = 0; m < 4; ++m)
#pragma unroll
                for (int bj = 0; bj < 2; ++bj) *(u32x4*)(D + (size_t)(row0 + ai * HALF + m * 16) * 1024 + col0 + bj * HALF) = pack8(acc[ai][bj][m][0], acc[ai][bj][m][1]);
    }
};
struct EpiNullWide {
    static constexpr bool PERM = true, AFTER_DRAIN = false;
    bf16_t* D;
    __device__ __forceinline__ void operator()(const f32x4 (&acc)[2][2][4][2], const Unit& u, int wr, int wc, int fr_, int fq_) const {
        int t_ = threadIdx.x; asm volatile("" : "+v"(t_)); const int fr = t_ & 15, fq = (t_ >> 4) & 3; (void)fr_; (void)fq_;
        const int row0 = u.pm * BM + wr * 64 + fr, col0 = u.pn * HALF + wc * 32 + 8 * fq;
#pragma unroll
        for (int ai = 0; ai < 2; ++ai)
#pragma unroll
            for (int m = 0; m < 4; ++m) *(u32x4*)(D + (size_t)(row0 + ai * HALF + m * 16) * 2816 + col0) = pack8(acc[ai][0][m][0] + acc[ai][1][m][0], acc[ai][0][m][1] + acc[ai][1][m][1]);
    }
};
struct EpiZ {
    static constexpr bool PERM = true, AFTER_DRAIN = false;
    ArgsP A;
    __device__ __forceinline__ void operator()(const f32x4 (&acc)[2][2][4][2], const Unit& u, int wr, int wc, int fr_, int fq_) const {
        int t_ = threadIdx.x; asm volatile("" : "+v"(t_)); const int fr = t_ & 15, fq = (t_ >> 4) & 3; (void)fr_; (void)fq_;
        const int row0 = u.pm * BM + wr * 64 + fr, col0 = u.pn * BM + wc * 32 + 8 * fq;
        ArgsP a_ = A; asm volatile("" : "+s"(a_)); unsigned char* ws_ = a_->ws; bf16_t* Z = (bf16_t*)(ws_ + WS_AM); const float* rowss = (const float*)(ws_ + WS_PART) + (size_t)16 * RS_M;
        float rr[2][4];
#pragma unroll
        for (int ai = 0; ai < 2; ++ai) {
#pragma unroll
            for (int m = 0; m < 4; ++m) rr[ai][m] = __builtin_amdgcn_rsqf(row_total(rowss, row0 + ai * HALF + m * 16, fq) * (1.0f / 1024.0f) + 1e-6f);
            asm volatile("" ::: "memory"); }
#pragma unroll
        for (int ai = 0; ai < 2; ++ai)
#pragma unroll
            for (int m = 0; m < 4; ++m)
#pragma unroll
                for (int bj = 0; bj < 2; ++bj) *(u32x4*)(Z + (size_t)(row0 + ai * HALF + m * 16) * 1024 + col0 + bj * HALF) = pack8(acc[ai][bj][m][0] * rr[ai][m], acc[ai][bj][m][1] * rr[ai][m]);
    }
};

template <class Epi, class Sched, bool ALIGN_EPI = false, bool SP2 = false>
__device__ __forceinline__ void gemm_phase(PG8_LAS unsigned char* lds, const Gemm g, const Sched& S, const Epi& E) {
    int tid_ = threadIdx.x; asm volatile("" : "+v"(tid_));
    const int tid = tid_, wid = __builtin_amdgcn_readfirstlane(tid >> 6), lane = tid & 63, wr = wid >> 2, wc = wid & 3, fr = lane & 15, fq = lane >> 4;
    const int K = g.K, nt = K / BK;
    unsigned voffA[2], voffB[2];
#pragma unroll
    for (int i = 0; i < 2; ++i) { int R, C; stage_rc(tid * 16 + i * 8192, R, C); const int Rb = Epi::PERM ? ((R & ~31) + perm32(R & 31)) : R;
        voffA[i] = (unsigned)(R * g.lda + C) * 2u; voffB[i] = (unsigned)(Rb * K + C) * 2u; }
    const size_t kstep = (size_t)(BK * 2);
    const size_t hsA = (size_t)HALF * g.lda * 2, hsB = (size_t)HALF * K * 2;
    const size_t tsA = 2 * hsA, tsB = 2 * hsB;
    const unsigned ldsw = (unsigned)wid * 1024u;
    const int aoff = lds_byte(wr * 64 + fr, fq * 8), boff = lds_byte(wc * 32 + fr, fq * 8);
#define PG8_SA(b, h) (((b) * 2 + (h)) * HTB)
#define PG8_SB(b, h) ((4 + (b) * 2 + (h)) * HTB)
#define PG8_STAGE(bufoff, gbase, voff) do { _Pragma("unroll") for (int _i = 0; _i < 2; ++_i) \
        __builtin_amdgcn_global_load_lds((const unsigned*)((const char*)(gbase) + (voff)[_i]), (PG8_LAS unsigned*)(lds + (bufoff) + ldsw + _i * 8192), 16, 0, 0); } while (0)
#define PG8_LDA(dst, b, h) do { _Pragma("unroll") for (int m = 0; m < 4; ++m) _Pragma("unroll") for (int k = 0; k < 2; ++k) dst[m][k] = *(const PG8_LAS bf16x8*)(lds + PG8_SA(b, h) + aoff + m * 2048 + k * 1024); } while (0)
#define PG8_LDB(dst, b, h) do { _Pragma("unroll") for (int n = 0; n < 2; ++n) _Pragma("unroll") for (int k = 0; k < 2; ++k) dst[n][k] = *(const PG8_LAS bf16x8*)(lds + PG8_SB(b, h) + boff + n * 2048 + k * 1024); } while (0)
#define PG8_MMA(ai, bj, At, Bt) do { __builtin_amdgcn_s_setprio(1); _Pragma("unroll") for (int m = 0; m < 4; ++m) _Pragma("unroll") for (int n = 0; n < 2; ++n) _Pragma("unroll") for (int k = 0; k < 2; ++k) \
        acc[ai][bj][m][n] = __builtin_amdgcn_mfma_f32_16x16x32_bf16(Bt[n][k], At[m][k], acc[ai][bj][m][n], 0, 0, 0); __builtin_amdgcn_s_setprio(0); } while (0)
#define PG8_WAIT_V(n) asm volatile("s_waitcnt vmcnt(" #n ")" ::: "memory")
#define PG8_WAIT_L(n) asm volatile("s_waitcnt lgkmcnt(" #n ")" ::: "memory")
#define PG8_BAR __builtin_amdgcn_s_barrier()
#define PG8_SCHED __builtin_amdgcn_sched_barrier(0)
    Unit cur, nxt; int ui = 0;
    if (!S.next(0, cur)) return;
    f32x4 acc[2][2][4][2];
#pragma unroll
    for (int a = 0; a < 2; ++a)
#pragma unroll
        for (int b = 0; b < 2; ++b)
#pragma unroll
            for (int m = 0; m < 4; ++m)
#pragma unroll
                for (int n = 0; n < 2; ++n) acc[a][b][m][n] = (f32x4){0.f, 0.f, 0.f, 0.f};
    bf16x8 At[4][2], B0[2][2], B1[2][2];
    const char* cA = (const char*)g.A + (size_t)cur.pm * tsA + (size_t)cur.pn * g.a_pn_bytes; const char* cB = (const char*)g.Bt + (size_t)cur.pn * tsB + (size_t)(cur.pm >> 4) * g.b_batch_bytes;
    S.a_ready(cur);
    if constexpr (SP2) {
        PG8_STAGE(PG8_SB(0, 0), cB, voffB); PG8_STAGE(PG8_SB(0, 1), cB + hsB, voffB); PG8_STAGE(PG8_SA(0, 0), cA, voffA); PG8_STAGE(PG8_SA(0, 1), cA + hsA, voffA);
        if (wr == 1) PG8_BAR;
        PG8_WAIT_V(2); PG8_BAR;
        PG8_STAGE(PG8_SB(1, 0), cB + kstep, voffB); PG8_STAGE(PG8_SA(1, 0), cA + kstep, voffA); PG8_STAGE(PG8_SB(1, 1), cB + hsB + kstep, voffB);
        PG8_WAIT_V(6); PG8_BAR;
    } else {
        PG8_STAGE(PG8_SB(0, 0), cB, voffB); PG8_STAGE(PG8_SA(0, 0), cA, voffA); PG8_STAGE(PG8_SB(0, 1), cB + hsB, voffB); PG8_STAGE(PG8_SA(0, 1), cA + hsA, voffA);
        if (wr == 1) PG8_BAR;
        PG8_WAIT_V(4); PG8_BAR;
        PG8_STAGE(PG8_SB(1, 0), cB + kstep, voffB); PG8_STAGE(PG8_SA(1, 0), cA + kstep, voffA); PG8_STAGE(PG8_SB(1, 1), cB + hsB + kstep, voffB);
        PG8_WAIT_V(6); PG8_BAR;
    }
    for (;;) {
        const bool has_next = S.next(ui + 1, nxt);
        const char* nA = has_next ? (const char*)g.A + (size_t)nxt.pm * tsA + (size_t)nxt.pn * g.a_pn_bytes : cA; const char* nB = has_next ? (const char*)g.Bt + (size_t)nxt.pn * tsB + (size_t)(nxt.pm >> 4) * g.b_batch_bytes : cB;
#pragma unroll 1
        for (int t = 0; t < nt; t += 2) {
            const bool last = (t == nt - 2);
            const char* a1 = cA + (size_t)(t + 1) * kstep;
            const char* a2 = last ? nA : cA + (size_t)(t + 2) * kstep; const char* b2 = last ? nB : cB + (size_t)(t + 2) * kstep;
            const char* a3 = a2 + kstep; const char* b3 = b2 + kstep;
            if (last && has_next) S.a_ready(nxt);
            if constexpr (SP2) {
            PG8_LDB(B0, 0, 0); PG8_LDB(B1, 0, 1); PG8_SCHED; PG8_LDA(At, 0, 0); PG8_STAGE(PG8_SA(1, 1), a1 + hsA, voffA);
            PG8_WAIT_V(8); PG8_WAIT_L(0); PG8_BAR; PG8_MMA(0, 0, At, B0); PG8_MMA(0, 1, At, B1); PG8_BAR; PG8_SCHED;
            PG8_LDA(At, 0, 1); PG8_STAGE(PG8_SB(0, 0), b2, voffB); PG8_STAGE(PG8_SB(0, 1), b2 + hsB, voffB); PG8_STAGE(PG8_SA(0, 0), a2, voffA);
            PG8_WAIT_V(8); PG8_WAIT_L(0); PG8_BAR; PG8_MMA(1, 0, At, B0); PG8_MMA(1, 1, At, B1); PG8_BAR; PG8_SCHED;
            PG8_LDB(B0, 1, 0); PG8_LDB(B1, 1, 1); PG8_SCHED; PG8_LDA(At, 1, 0); PG8_STAGE(PG8_SA(0, 1), a2 + hsA, voffA);
            PG8_WAIT_V(8); PG8_WAIT_L(0); PG8_BAR; PG8_MMA(0, 0, At, B0); PG8_MMA(0, 1, At, B1); PG8_BAR; PG8_SCHED;
            PG8_LDA(At, 1, 1); PG8_STAGE(PG8_SB(1, 0), b3, voffB); PG8_STAGE(PG8_SB(1, 1), b3 + hsB, voffB); PG8_STAGE(PG8_SA(1, 0), a3, voffA);
            PG8_WAIT_V(8); PG8_WAIT_L(0); PG8_BAR; PG8_MMA(1, 0, At, B0); PG8_MMA(1, 1, At, B1); PG8_BAR; PG8_SCHED;
            } else {
            PG8_LDB(B0, 0, 0); PG8_SCHED; PG8_LDA(At, 0, 0); PG8_STAGE(PG8_SA(1, 1), a1 + hsA, voffA);
            PG8_WAIT_L(8); PG8_BAR; PG8_WAIT_L(0); PG8_MMA(0, 0, At, B0); PG8_BAR; PG8_SCHED;
            PG8_LDB(B1, 0, 1); PG8_STAGE(PG8_SB(0, 0), b2, voffB);
            PG8_BAR; PG8_WAIT_L(0); PG8_MMA(0, 1, At, B1); PG8_BAR;
            PG8_LDA(At, 0, 1); PG8_STAGE(PG8_SA(0, 0), a2, voffA);
            PG8_BAR; PG8_WAIT_L(0); PG8_MMA(1, 0, At, B0); PG8_BAR; PG8_SCHED;
            PG8_STAGE(PG8_SB(0, 1), b2 + hsB, voffB);
            PG8_WAIT_V(6); PG8_BAR; PG8_MMA(1, 1, At, B1); PG8_BAR;
            PG8_LDB(B0, 1, 0); PG8_SCHED; PG8_LDA(At, 1, 0); PG8_STAGE(PG8_SA(0, 1), a2 + hsA, voffA);
            PG8_WAIT_L(8); PG8_BAR; PG8_WAIT_L(0); PG8_MMA(0, 0, At, B0); PG8_BAR; PG8_SCHED;
            PG8_LDB(B1, 1, 1); PG8_STAGE(PG8_SB(1, 0), b3, voffB);
            PG8_BAR; PG8_WAIT_L(0); PG8_MMA(0, 1, At, B1); PG8_BAR;
            PG8_LDA(At, 1, 1); PG8_STAGE(PG8_SA(1, 0), a3, voffA);
            PG8_BAR; PG8_WAIT_L(0); PG8_MMA(1, 0, At, B0); PG8_BAR; PG8_SCHED;
            PG8_STAGE(PG8_SB(1, 1), b3 + hsB, voffB);
            PG8_WAIT_V(6); PG8_BAR; PG8_MMA(1, 1, At, B1); PG8_BAR;
            }
        }
        if constexpr (ALIGN_EPI) { if (wr == 0) PG8_BAR; }
        if constexpr (!Epi::AFTER_DRAIN) { E(acc, cur, wr, wc, fr, fq); S.done(cur); }
        if (!has_next) break;
#pragma unroll
        for (int a = 0; a < 2; ++a)
#pragma unroll
            for (int b = 0; b < 2; ++b)
#pragma unroll
                for (int m = 0; m < 4; ++m)
#pragma unroll
                    for (int n = 0; n < 2; ++n) acc[a][b][m][n] = (f32x4){0.f, 0.f, 0.f, 0.f};
        cur = nxt; cA = nA; cB = nB; ++ui;
        if constexpr (ALIGN_EPI) { if (wr == 1) PG8_BAR; }
    }
    PG8_WAIT_V(0);
    if constexpr (!ALIGN_EPI) { if (wr == 0) PG8_BAR; }
    PG8_BAR;
    if constexpr (Epi::AFTER_DRAIN) { E.fused(acc, cur, wr, wc, fr, fq, lds, wid, lane); S.done(cur); }
#undef PG8_SA
#undef PG8_SB
#undef PG8_STAGE
#undef PG8_LDA
#undef PG8_LDB
#undef PG8_MMA
#undef PG8_WAIT_V
#undef PG8_WAIT_L
#undef PG8_BAR
#undef PG8_SCHED
}
}
namespace attn_body {
using bf16=__hip_bfloat16;
using bf16x8=__attribute__((ext_vector_type(8)))short;
using s16x4=__attribute__((ext_vector_type(4)))short;
using f32x16=__attribute__((ext_vector_type(16)))float;
using u32x4=__attribute__((ext_vector_type(4)))unsigned;
constexpr int BATCH=8,NHEAD=8,NKVH=2,SEQ=4096,SKV=4352,D=64,QP=512,KP=128,OP=1024;
constexpr int NW=8,QBLK=32,QB=QBLK*NW,KVBLK=64,NQB=SEQ/QB;
constexpr int ATTN_UNIT_ROWS=QB;
__device__ __forceinline__ int crow(int r,int hi){return (r&3)+8*(r>>2)+4*hi;}
#define SBAR() __builtin_amdgcn_sched_barrier(0)
constexpr int NSLOT=3, SLOTB=8192;
constexpr int LDS_K=0, LDS_V=NSLOT*SLOTB, LDS_WS=2*NSLOT*SLOTB, LDS_OST=LDS_WS+NW*64*4, LDS_BYTES=LDS_OST+NW*4096;
constexpr float C2=0.125f*1.4426950408889634f;
__device__ __forceinline__ void glds16(const void*gsrc,unsigned lds_dst){unsigned keep;
  asm volatile("s_mov_b32 %0, m0\n\ts_mov_b32 m0, %2\n\ts_nop 0\n\tglobal_load_lds_dwordx4 %1, off\n\ts_mov_b32 m0, %0":"=&s"(keep):"v"(gsrc),"s"(lds_dst):"memory");}
__device__ __forceinline__ void glds16_nt(const void*gsrc,unsigned lds_dst){unsigned keep;
  asm volatile("s_mov_b32 %0, m0\n\ts_mov_b32 m0, %2\n\ts_nop 0\n\tglobal_load_lds_dwordx4 %1, off nt\n\ts_mov_b32 m0, %0":"=&s"(keep):"v"(gsrc),"s"(lds_dst):"memory");}
__device__ __forceinline__ float max3f(float a,float b,float c){float r;asm("v_max3_f32 %0, %1, %2, %3":"=v"(r):"v"(a),"v"(b),"v"(c));return r;}
__device__ __forceinline__ float max2f(float a,float b){float r;asm("v_max_f32_e32 %0, %1, %2":"=v"(r):"v"(a),"v"(b));return r;}
__device__ __forceinline__ float fadd_s(float a,float b){float r;asm("v_add_f32_e32 %0, %1, %2":"=v"(r):"v"(a),"v"(b));return r;}
__device__ __forceinline__ float fsub_s(float a,float b){float r;asm("v_sub_f32_e32 %0, %1, %2":"=v"(r):"v"(a),"v"(b));return r;}
typedef float f32x2_t __attribute__((ext_vector_type(2))); typedef __bf16 bf16x2_t __attribute__((ext_vector_type(2)));
__device__ __forceinline__ unsigned cvtpk_s(float lo,float hi){f32x2_t v={lo,hi};bf16x2_t b=__builtin_convertvector(v,bf16x2_t);return __builtin_bit_cast(unsigned,b);}
#define WAIT_BAR(N) asm volatile("s_waitcnt vmcnt(" #N ") lgkmcnt(0)\n\ts_barrier":::"memory")

__device__ __forceinline__ void qkt(f32x16&p0,f32x16&p1,const char*Kslot,const bf16x8*qr,const f32x16&negm,int r32,int hi){
  const char*kb=Kslot+hi*1024+r32*16;
  #pragma unroll
  for(int d0=0;d0<4;++d0){
    const bf16x8 b0=*reinterpret_cast<const bf16x8*>(kb+d0*2048);
    const bf16x8 b1=*reinterpret_cast<const bf16x8*>(kb+d0*2048+512);
    if(d0==0){p0=__builtin_amdgcn_mfma_f32_32x32x16_bf16(b0,qr[0],negm,0,0,0);p1=__builtin_amdgcn_mfma_f32_32x32x16_bf16(b1,qr[0],negm,0,0,0);}
    else{p0=__builtin_amdgcn_mfma_f32_32x32x16_bf16(b0,qr[d0],p0,0,0,0);p1=__builtin_amdgcn_mfma_f32_32x32x16_bf16(b1,qr[d0],p1,0,0,0);}}
}
typedef __attribute__((address_space(3))) const char* lds_cptr;
typedef short v4i16_t __attribute__((ext_vector_type(4)));
__device__ __forceinline__ void kload8(bf16x8*kf,lds_cptr kp){
  kf[0]=*(const __attribute__((address_space(3))) bf16x8*)(kp);      kf[1]=*(const __attribute__((address_space(3))) bf16x8*)(kp+512);
  kf[2]=*(const __attribute__((address_space(3))) bf16x8*)(kp+2048); kf[3]=*(const __attribute__((address_space(3))) bf16x8*)(kp+2560);
  kf[4]=*(const __attribute__((address_space(3))) bf16x8*)(kp+4096); kf[5]=*(const __attribute__((address_space(3))) bf16x8*)(kp+4608);
  kf[6]=*(const __attribute__((address_space(3))) bf16x8*)(kp+6144); kf[7]=*(const __attribute__((address_space(3))) bf16x8*)(kp+6656);
}
__device__ __forceinline__ void kload2(bf16x8*kf,lds_cptr kp,int j){ kf[2*j]=*(const __attribute__((address_space(3))) bf16x8*)(kp+j*2048); kf[2*j+1]=*(const __attribute__((address_space(3))) bf16x8*)(kp+j*2048+512); }
__device__ __forceinline__ s16x4 vtr(lds_cptr p){ return __builtin_bit_cast(s16x4,__builtin_amdgcn_ds_read_tr16_b64_v4i16((__attribute__((address_space(3))) v4i16_t*)p)); }
__device__ __forceinline__ float rowmax(const f32x16&p0,const f32x16&p1){
  float a=max3f(p0[0],p0[1],p1[0]),b=max3f(p0[2],p0[3],p1[1]);a=max3f(a,p1[2],p1[3]);
  #pragma unroll
  for(int r=4;r<16;r+=4){a=max3f(a,p0[r],p0[r+1]);b=max3f(b,p0[r+2],p0[r+3]);a=max3f(a,p1[r],p1[r+1]);b=max3f(b,p1[r+2],p1[r+3]);}
  const float m=max2f(a,b);
  auto rr=__builtin_amdgcn_permlane32_swap(__float_as_uint(m),__float_as_uint(m),false,false);
  return max2f(__uint_as_float(rr[0]),__uint_as_float(rr[1]));
}
__device__ __forceinline__ void pv(f32x16*o,int vb,bf16x8 pa0,bf16x8 pa1,bf16x8 pa2,bf16x8 pa3){
  #pragma unroll
  for(int d0=0;d0<2;++d0){s16x4 lo[4],hi[4];
    #pragma unroll
    for(int ks=0;ks<4;++ks){
      asm volatile("ds_read_b64_tr_b16 %0,%1 offset:%c2":"=&v"(lo[ks]):"v"(vb),"i"(d0*4096+ks*1024):"memory");
      asm volatile("ds_read_b64_tr_b16 %0,%1 offset:%c2":"=&v"(hi[ks]):"v"(vb),"i"(d0*4096+ks*1024+512):"memory");}
    asm volatile("s_waitcnt lgkmcnt(0)":::"memory");SBAR();
    #define PK(k) (bf16x8){lo[k][0],lo[k][1],lo[k][2],lo[k][3],hi[k][0],hi[k][1],hi[k][2],hi[k][3]}
    o[d0]=__builtin_amdgcn_mfma_f32_32x32x16_bf16(pa0,PK(0),o[d0],0,0,0);
    o[d0]=__builtin_amdgcn_mfma_f32_32x32x16_bf16(pa1,PK(1),o[d0],0,0,0);
    o[d0]=__builtin_amdgcn_mfma_f32_32x32x16_bf16(pa2,PK(2),o[d0],0,0,0);
    o[d0]=__builtin_amdgcn_mfma_f32_32x32x16_bf16(pa3,PK(3),o[d0],0,0,0);
    #undef PK
  }
}

#ifndef ATTN_STORE16
#define ATTN_STORE16(p,v) (*(u32x4*)(p)=(v))
#endif
template<int THRL,bool FIX> __device__ __forceinline__ void attn_unit(int b,int h,int qb,const bf16*Q,const bf16*__restrict__ K,const bf16*__restrict__ V,bf16*O,char*shm,float sref){
  int tid_=threadIdx.x; asm volatile("":"+v"(tid_)); const int tid=tid_,lane=tid&63,r32=lane&31,hi=lane>>5; const int wid=__builtin_amdgcn_readfirstlane(tid>>6);
  const long rowbase=(long)b*SEQ, kvbase=(long)b*SKV; const int q0=qb*QB;
  const bf16*Qw=Q+(rowbase+q0+wid*QBLK)*QP+h*D;
  const bf16*Kh=K+kvbase*KP+(h/(NHEAD/NKVH))*D,*Vh=V+kvbase*KP+(h/(NHEAD/NKVH))*D;
  const unsigned lds0=(unsigned)(uintptr_t)shm;
  float*wsf=(float*)(shm+LDS_WS)+wid*64;
  const bf16*ksrc=Kh+(long)lane*KP+wid*8;
  const bf16*vsrc=Vh+(long)(16*(wid&3)+(lane>>2))*KP+(wid>>2)*32+(lane&3)*8;
  const unsigned kdst=lds0+LDS_K+wid*1024, vdst=lds0+LDS_V+wid*1024;
  #define DMA_K(t,slot) glds16(ksrc+(long)(t)*KVBLK*KP,(unsigned)__builtin_amdgcn_readfirstlane(kdst+(slot)))
  #define DMA_V(t,slot) glds16(vsrc+(long)(t)*KVBLK*KP,(unsigned)__builtin_amdgcn_readfirstlane(vdst+(slot)))
  const int vb0=(int)(lds0+LDS_V)+((lane>>4)&1)*32+(lane&3)*8+(4*hi+((lane&15)>>2))*64;
  const char*Kbase=shm+LDS_K; bf16x8 kf[8];
  const lds_cptr shm3=(lds_cptr)shm; const lds_cptr kp0=shm3+LDS_K+hi*1024+r32*16; const lds_cptr vp0=shm3+LDS_V+((lane>>4)&1)*32+(lane&3)*8+(4*hi+((lane&15)>>2))*64;
  constexpr int NT=SKV/KVBLK;
  DMA_K(0,0);DMA_V(0,0);DMA_K(1,SLOTB);
  bf16x8 qr[4];
  #pragma unroll
  for(int d0=0;d0<4;++d0)qr[d0]=__builtin_nontemporal_load(reinterpret_cast<const bf16x8*>(&Qw[(long)r32*QP+d0*16+hi*8]));
  float mhat=0.f,l_reg=0.f;f32x16 o[2];o[0]=f32x16{};o[1]=f32x16{};f32x16 negm=f32x16{};
  if constexpr(FIX){ _Pragma("unroll") for(int r=0;r<16;++r)negm[r]=-sref; }
  asm volatile("":"+v"(negm));
  #define CMASK(P0,P1,t) do{}while(0)
  bool resc=false;
  #define START(P0,P1) do{ resc=false; if constexpr(!FIX) \
    { const float rm=rowmax(P0,P1); const float dl=rm; mhat=fadd_s(mhat,dl); \
      _Pragma("unroll") for(int r=0;r<16;++r){P0[r]=fsub_s(P0[r],dl);P1[r]=fsub_s(P1[r],dl);} \
      _Pragma("unroll") for(int r=0;r<16;++r)negm[r]=-mhat; asm volatile("":"+v"(negm)); } \
    _Pragma("unroll") for(int r=0;r<16;++r)P0[r]=__builtin_amdgcn_exp2f(P0[r]); }while(0)
  #define RESC() do{ if constexpr(!FIX) if(resc){ asm volatile("s_waitcnt lgkmcnt(0)":::"memory"); \
      _Pragma("unroll") for(int d_=0;d_<2;++d_) _Pragma("unroll") for(int r=0;r<16;++r)o[d_][r]*=wsf[crow(r,hi)]; } }while(0)
  f32x16 pA0,pA1,pB0,pB1;
  int sl_prev=0,sl_cur=0,sl_next=SLOTB;
  #define ROT() do{sl_prev=sl_cur;sl_cur=sl_next;sl_next=(sl_next==(NSLOT-1)*SLOTB)?0:sl_next+SLOTB;}while(0)
  DMA_K(2,2*SLOTB);
  WAIT_BAR(3);
  qkt(pA0,pA1,Kbase,qr,negm,r32,hi);asm volatile("s_nop 15\n\ts_nop 7":"+v"(pA0),"+v"(pA1));CMASK(pA0,pA1,0);
  START(pA0,pA1);
  _Pragma("unroll") for(int r=0;r<16;++r)pA1[r]=__builtin_amdgcn_exp2f(pA1[r]);
  WAIT_BAR(0);
  DMA_K(3,0);DMA_V(1,SLOTB);
  ROT();
  kload8(kf,kp0+sl_cur);
  WAIT_BAR(2);
  s16x4 vlo[8],vhi[8]; u32x4 pw0,pw1,pw2,pw3;
  #define PKW(P,B) cvtpk_s(P[B],P[B+1])
  #define PAF(k) __builtin_bit_cast(bf16x8,pw##k)
  #define VFR(i) (bf16x8){vlo[i][0],vlo[i][1],vlo[i][2],vlo[i][3],vhi[i][0],vhi[i][1],vhi[i][2],vhi[i][3]}
  #define PIN(x) asm volatile("":"+v"(x))
  #define MX3(a,b,c) __builtin_fmaxf(__builtin_fmaxf((a),(b)),(c))
  #define GAPA(MF,A0,A1,A2,A3,W0,W1,PW) do{ MF; sacc+=A0; sacc+=A1; sacc+=A2; sacc+=A3; PIN(sacc); W0; W1; PIN(PW); SBAR(); }while(0)
  #define EX(v) __builtin_amdgcn_exp2f(v)
  #define GAPB(MF,X,B) do{ MF; X[B]=EX(X[B]); X[B+1]=EX(X[B+1]); X[B+2]=EX(X[B+2]); X[B+3]=EX(X[B+3]); PIN(X); SBAR(); }while(0)
  #define VRD(i) do{ vlo[i]=vtr(vp_+(((i)>>2)*4096+((i)&3)*1024)); vhi[i]=vtr(vp_+(((i)>>2)*4096+((i)&3)*1024+512)); }while(0)
  #define KRD(G,j) do{ if(G){ kload2(kf,kp0+sl_next,j); SBAR(); } }while(0)
  #define STEP(C0,C1,P0,P1,t,GK,GV,GL) do{ SBAR(); \
    const lds_cptr vp_=vp0+sl_prev; \
    VRD(0); SBAR(); float sacc=(P0[0]+P0[1]); \
    GAPA(C0=__builtin_amdgcn_mfma_f32_32x32x16_bf16(kf[0],qr[0],negm,0,0,0), P0[2],P0[3],P0[4],P0[5],     pw0[0]=PKW(P0,0), pw0[1]=PKW(P0,2), pw0); \
    VRD(4); SBAR(); GAPA(C1=__builtin_amdgcn_mfma_f32_32x32x16_bf16(kf[1],qr[0],negm,0,0,0), P0[6],P0[7],P0[8],P0[9],     pw0[2]=PKW(P0,4), pw0[3]=PKW(P0,6), pw0); \
    VRD(1); SBAR(); GAPA(C0=__builtin_amdgcn_mfma_f32_32x32x16_bf16(kf[2],qr[1],C0,0,0,0),   P0[10],P0[11],P0[12],P0[13], pw1[0]=PKW(P0,8), pw1[1]=PKW(P0,10), pw1); \
    VRD(5); SBAR(); GAPA(C1=__builtin_amdgcn_mfma_f32_32x32x16_bf16(kf[3],qr[1],C1,0,0,0),   P0[14],P0[15],P1[0],P1[1],   pw1[2]=PKW(P0,12),pw1[3]=PKW(P0,14), pw1); \
    VRD(2); SBAR(); GAPA(C0=__builtin_amdgcn_mfma_f32_32x32x16_bf16(kf[4],qr[2],C0,0,0,0),   P1[2],P1[3],P1[4],P1[5],     pw2[0]=PKW(P1,0), pw2[1]=PKW(P1,2), pw2); \
    VRD(6); SBAR(); GAPA(C1=__builtin_amdgcn_mfma_f32_32x32x16_bf16(kf[5],qr[2],C1,0,0,0),   P1[6],P1[7],P1[8],P1[9],     pw2[2]=PKW(P1,4), pw2[3]=PKW(P1,6), pw2); \
    VRD(3); SBAR(); GAPA(C0=__builtin_amdgcn_mfma_f32_32x32x16_bf16(kf[6],qr[3],C0,0,0,0),   P1[10],P1[11],P1[12],P1[13], pw3[0]=PKW(P1,8), pw3[1]=PKW(P1,10), pw3); \
    VRD(7); SBAR(); GAPA(C1=__builtin_amdgcn_mfma_f32_32x32x16_bf16(kf[7],qr[3],C1,0,0,0),   P1[14],P1[15],0.f,0.f,       pw3[2]=PKW(P1,12),pw3[3]=PKW(P1,14), pw3); \
    l_reg+=sacc; \
    if(GK){DMA_K((t)+3,sl_cur);} if(GV){DMA_V((t)+1,sl_next);} \
    CMASK(C0,C1,t); \
    if constexpr(!FIX) { float a=MX3(C0[0],C0[1],C1[0]),b=MX3(C0[2],C0[3],C1[1]); a=MX3(a,C1[2],C1[3]); \
      _Pragma("unroll") for(int r=4;r<16;r+=4){a=MX3(a,C0[r],C0[r+1]);b=MX3(b,C0[r+2],C0[r+3]);a=MX3(a,C1[r],C1[r+1]);b=MX3(b,C1[r+2],C1[r+3]);} \
      float rm=__builtin_fmaxf(a,b); { auto rr=__builtin_amdgcn_permlane32_swap(__float_as_uint(rm),__float_as_uint(rm),false,false); rm=__builtin_fmaxf(__uint_as_float(rr[0]),__uint_as_float(rr[1])); } \
      resc=false; \
      if(__builtin_expect(__any(rm>(float)THRL),0)){ const float dl=__builtin_fmaxf(rm,0.f); mhat+=dl; \
        _Pragma("unroll") for(int r=0;r<16;++r){C0[r]-=dl;C1[r]-=dl;} \
        _Pragma("unroll") for(int r=0;r<16;++r)negm[r]=-mhat; asm volatile("":"+v"(negm)); \
        const float f=__builtin_amdgcn_exp2f(-dl); l_reg*=f; if(hi==0)wsf[r32]=f; resc=true; } } \
    SBAR(); \
    GAPB(o[0]=__builtin_amdgcn_mfma_f32_32x32x16_bf16(PAF(0),VFR(0),o[0],0,0,0), C0,0); \
    GAPB(o[1]=__builtin_amdgcn_mfma_f32_32x32x16_bf16(PAF(0),VFR(4),o[1],0,0,0), C0,4); \
    KRD(GL,0); GAPB(o[0]=__builtin_amdgcn_mfma_f32_32x32x16_bf16(PAF(1),VFR(1),o[0],0,0,0), C0,8); \
    KRD(GL,1); GAPB(o[1]=__builtin_amdgcn_mfma_f32_32x32x16_bf16(PAF(1),VFR(5),o[1],0,0,0), C0,12); \
    KRD(GL,2); GAPB(o[0]=__builtin_amdgcn_mfma_f32_32x32x16_bf16(PAF(2),VFR(2),o[0],0,0,0), C1,0); \
    KRD(GL,3); GAPB(o[1]=__builtin_amdgcn_mfma_f32_32x32x16_bf16(PAF(2),VFR(6),o[1],0,0,0), C1,4); \
    GAPB(o[0]=__builtin_amdgcn_mfma_f32_32x32x16_bf16(PAF(3),VFR(3),o[0],0,0,0), C1,8); \
    GAPB(o[1]=__builtin_amdgcn_mfma_f32_32x32x16_bf16(PAF(3),VFR(7),o[1],0,0,0), C1,12); \
    }while(0)
  int t=1;
  #undef CMASK
  #define CMASK(P0,P1,t) do{}while(0)
  for(;t+5<NT;t+=2){
    STEP(pB0,pB1,pA0,pA1,t,true,true,true);     WAIT_BAR(2); RESC(); ROT();
    STEP(pA0,pA1,pB0,pB1,t+1,true,true,true);   WAIT_BAR(2); RESC(); ROT();
  }
  #undef CMASK
  #define CMASK(P0,P1,t) do{}while(0)
  #define ENDW(tt) do{ if((tt)+3<NT){WAIT_BAR(2);} else if((tt)+2<NT){WAIT_BAR(1);} else {WAIT_BAR(0);} }while(0)
  for(;t+1<NT;t+=2){
    STEP(pB0,pB1,pA0,pA1,t,(t+3<NT),(t+1<NT),(t+1<NT));       ENDW(t);   RESC(); ROT();
    STEP(pA0,pA1,pB0,pB1,t+1,(t+4<NT),(t+2<NT),(t+2<NT));     ENDW(t+1); RESC(); ROT();
  }
  STEP(pB0,pB1,pA0,pA1,NT-1,false,false,false); RESC();
  { float sacc=pB0[0]+pB0[1]; _Pragma("unroll") for(int r=2;r<16;++r)sacc+=pB0[r]; _Pragma("unroll") for(int r=0;r<16;++r)sacc+=pB1[r]; l_reg+=sacc;
    pw0=(u32x4){PKW(pB0,0),PKW(pB0,2),PKW(pB0,4),PKW(pB0,6)};pw1=(u32x4){PKW(pB0,8),PKW(pB0,10),PKW(pB0,12),PKW(pB0,14)};pw2=(u32x4){PKW(pB1,0),PKW(pB1,2),PKW(pB1,4),PKW(pB1,6)};pw3=(u32x4){PKW(pB1,8),PKW(pB1,10),PKW(pB1,12),PKW(pB1,14)};
    SBAR(); pv(o,vb0+sl_cur,PAF(0),PAF(1),PAF(2),PAF(3)); }
  #undef PKW
  #undef PAF
  #undef VFR
  #undef PIN
  #undef MX3
  #undef GAPA
  #undef GAPB
  #undef EX
  #undef VRD
  #undef KRD
  #undef STEP
  #undef ENDW
  {auto rr=__builtin_amdgcn_permlane32_swap(__float_as_uint(l_reg),__float_as_uint(l_reg),false,false);l_reg=__uint_as_float(rr[0])+__uint_as_float(rr[1]);}
  if(hi==0)wsf[32+r32]=l_reg;asm volatile("s_waitcnt lgkmcnt(0)":::"memory");
  float rli[16];
  #pragma unroll
  for(int r=0;r<16;++r)rli[r]=__builtin_amdgcn_rcpf(wsf[32+crow(r,hi)]);
  bf16*Ow=O+(rowbase+q0+wid*QBLK)*OP+h*D;
  { bf16*stg=(bf16*)(shm+LDS_OST)+wid*2048;
    #pragma unroll
    for(int r=0;r<16;++r){const int orow=crow(r,hi);
      #pragma unroll
      for(int d0=0;d0<2;++d0)stg[orow*64+d0*32+r32]=__float2bfloat16(o[d0][r]*rli[r]);}
    asm volatile("s_waitcnt lgkmcnt(0)":::"memory");
    #pragma unroll
    for(int i=0;i<4;++i){const int row=i*8+(lane>>3),ch=lane&7; const u32x4 v=*(const u32x4*)(stg+row*64+ch*8); ATTN_STORE16(Ow+(long)row*OP+ch*8,v);} }
  asm volatile("s_waitcnt lgkmcnt(0)\n\ts_barrier":::"memory");
  #undef DMA_K
  #undef DMA_V
  #undef CMASK
  #undef START
  #undef RESC
  #undef ROT
}
constexpr int ATTN_LDS_BYTES=LDS_BYTES;
struct AttnTensors { const bf16* Q; const bf16* K; const bf16* V; bf16* O; };
struct AttnUnit { int bh; int qb; };
struct StaticOrder {
  int vcu,G;
  __device__ __forceinline__ explicit StaticOrder(int grid,int v):vcu(v),G(grid){}
  __device__ __forceinline__ bool next(int i,AttnUnit&u)const{ const int per=(BATCH*NHEAD*NQB)/G; if(i>=per)return false; const int x=vcu*per+i; u.bh=(x>>6)*4+((x&63)>>4); u.qb=x&15; return true; }
  __device__ __forceinline__ void a_ready(const AttnUnit&)const{}
  __device__ __forceinline__ void done(const AttnUnit&)const{}
};
template<class Sched,int THRL=8> __device__ __forceinline__ void attn_phase(char*lds,const AttnTensors&T,const Sched&S,const float*qnw,const float*knw){
  AttnUnit u;
  float mq=__builtin_fabsf(qnw[threadIdx.x&63]),mk=__builtin_fabsf(knw[threadIdx.x&63]);
  _Pragma("unroll") for(int o_=1;o_<64;o_<<=1){ mq=__builtin_fmaxf(mq,__shfl_xor(mq,o_)); mk=__builtin_fmaxf(mk,__shfl_xor(mk,o_)); }
  const float sref=C2*64.0f*1.02f*mq*mk;
  const bool fix=__builtin_amdgcn_readfirstlane((int)(sref<=40.0f && sref==sref))!=0;
  if(fix){ for(int i=0;S.next(i,u);++i){ S.a_ready(u); attn_unit<THRL,true>(u.bh/NHEAD,u.bh%NHEAD,u.qb,T.Q,T.K,T.V,T.O,lds,sref); S.done(u); } }
  else   { for(int i=0;S.next(i,u);++i){ S.a_ready(u); attn_unit<THRL,false>(u.bh/NHEAD,u.bh%NHEAD,u.qb,T.Q,T.K,T.V,T.O,lds,0.f); S.done(u); } }
}
#undef SBAR
#undef WAIT_BAR
}
#ifndef PG8_SP2
#define PG8_SP2 true
#endif
#ifndef PG8_ALIGN
#define PG8_ALIGN true
#endif
#define GAS __attribute__((address_space(1)))
#define LAS __attribute__((address_space(3)))
typedef unsigned short bf16;
typedef unsigned v4u __attribute__((ext_vector_type(4)));
typedef unsigned v2u __attribute__((ext_vector_type(2)));
typedef float f32x4 __attribute__((ext_vector_type(4)));
typedef float f32x2 __attribute__((ext_vector_type(2)));
typedef short bf16x8 __attribute__((ext_vector_type(8)));
typedef GAS unsigned gu32;
typedef GAS unsigned long long gu64;
#define RLX_AGENT __ATOMIC_RELAXED, __HIP_MEMORY_SCOPE_AGENT
#define LDS_WAIT() asm volatile("s_waitcnt lgkmcnt(0)" ::: "memory")
#define VM_WAIT() asm volatile("s_waitcnt vmcnt(0)" ::: "memory")
__device__ __forceinline__ unsigned f2bf(float f) { unsigned u = __builtin_bit_cast(unsigned, f); return (u + 0x7fffu + ((u >> 16) & 1u)) >> 16; }
__device__ __forceinline__ unsigned pk2(float lo, float hi) { return f2bf(lo) | (f2bf(hi) << 16); }
__device__ __forceinline__ float bf2f(unsigned h) { return __builtin_bit_cast(float, h << 16); }

#define XB_TMO      128
#define XB_XCNT(j)  (256  + 64 * (j))
#define XB_XSUB(j)  (1280 + 64 * (j))
#define XB_XGEN(j)  (2304 + 64 * (j))
#define XB_TOP      3328
#define XB_TOPGEN   3392
#define XCD_BAR_WORDS 3456
#define XB_SPIN_CAP (1u << 18)

__device__ __forceinline__ unsigned xb_ld(unsigned* p)              { return __hip_atomic_load(p, __ATOMIC_RELAXED, __HIP_MEMORY_SCOPE_AGENT); }
__device__ __forceinline__ unsigned xb_add(unsigned* p, unsigned v) { return __hip_atomic_fetch_add(p, v, __ATOMIC_RELAXED, __HIP_MEMORY_SCOPE_AGENT); }
__device__ __forceinline__ unsigned xb_xcc_id() { return (unsigned)__builtin_amdgcn_s_getreg((3 << 11) | 20) & 0xFu; }
#define XB_SPIN(cond, bar) do { unsigned _sp = 0; while (cond) { __builtin_amdgcn_s_sleep(1); \
    if ((++_sp & 255u) == 0u) { if (xb_ld(&(bar)[XB_TMO])) break; if (_sp > XB_SPIN_CAP) { atomicAdd(&(bar)[XB_TMO], 1u); break; } } } } while (0)

struct XcdBarrier {
    unsigned* bar; unsigned x;
    volatile LAS unsigned* st;
};

__device__ __forceinline__ XcdBarrier xcd_barrier_post(unsigned* bar, volatile LAS unsigned* st) {
    XcdBarrier b; b.bar = bar; b.x = xb_xcc_id(); b.st = st;
    if (threadIdx.x == 0) (void)xb_add(&bar[XB_XCNT(b.x)], 1u);
    return b;
}
__device__ __forceinline__ void xcd_barrier_complete(unsigned* bar, unsigned x, unsigned& nloc, unsigned& nx) {
    const unsigned G = gridDim.x * gridDim.y * gridDim.z;
    unsigned sum, cnt, mine, sp = 0u;
    for (;;) {
        sum = 0u; cnt = 0u; mine = 0u;
#pragma unroll
        for (unsigned j = 0; j < 16; ++j) { const unsigned c = xb_ld(&bar[XB_XCNT(j)]); sum += c; cnt += (c > 0u) ? 1u : 0u; mine = (j == x) ? c : mine; }
        if (sum == G) break;
        __builtin_amdgcn_s_sleep(1);
        if ((++sp & 255u) == 0u) { if (xb_ld(&bar[XB_TMO])) break; if (sp > XB_SPIN_CAP) { atomicAdd(&bar[XB_TMO], 1u); break; } }
    }
    nloc = mine > 0u ? mine : 1u; nx = cnt > 0u ? cnt : 1u;
}

__device__ __forceinline__ void xcd_barrier(const XcdBarrier& b) {
    asm volatile("s_waitcnt vmcnt(0)" ::: "memory");
    __syncthreads();
    if (threadIdx.x == 0) {
        unsigned* bar = b.bar;
        __builtin_amdgcn_s_waitcnt(0);
        unsigned nloc = b.st[0], nx = b.st[1];
        if (nloc == 0u) { xcd_barrier_complete(bar, b.x, nloc, nx); b.st[0] = nloc; b.st[1] = nx; }
        const unsigned old = xb_add(&bar[XB_XSUB(b.x)], 1u);
        const unsigned gen = old / nloc;
        if (old + 1u == (gen + 1u) * nloc) {
            __builtin_amdgcn_fence(__ATOMIC_RELEASE, "agent");
            asm volatile("s_waitcnt vmcnt(0)" ::: "memory");
            const unsigned og = xb_add(&bar[XB_TOP], 1u);
            const unsigned tg = og / nx;
            if (og + 1u == (tg + 1u) * nx) xb_add(&bar[XB_TOPGEN], 1u);
            else XB_SPIN(xb_ld(&bar[XB_TOPGEN]) == tg, bar);
            __builtin_amdgcn_fence(__ATOMIC_ACQUIRE, "agent");
            xb_add(&bar[XB_XGEN(b.x)], 1u);
            asm volatile("s_waitcnt vmcnt(0)" ::: "memory");
        } else {
            XB_SPIN(xb_ld(&bar[XB_XGEN(b.x)]) == gen, bar);
            __builtin_amdgcn_fence(__ATOMIC_ACQUIRE, "agent");
            asm volatile("s_waitcnt vmcnt(0)" ::: "memory");
        }
    }
    __syncthreads();
}
struct Frame {
    LAS unsigned char* lds;
    volatile LAS unsigned* MISC;
    gu32* ctl;
    int tid, lane, wave;
    int vcu, G;
};
__device__ __forceinline__ float wave_sum(float v) {
#pragma unroll
    for (int o = 1; o < 64; o <<= 1) v += __shfl_xor(v, o);
    return v;
}
__device__ __forceinline__ void p0_transpose_item(const float* W, int ldw, int k0, int n0, bf16* WT, int ldt, int dst_row0, LAS float* scr, int lane) {
#pragma unroll 8
    for (int i = 0; i < 32; ++i) { const int kk = 2 * i + (lane >> 5); scr[kk * 33 + (lane & 31)] = __builtin_nontemporal_load(W + (size_t)(k0 + kk) * ldw + n0 + (lane & 31)); }
    LDS_WAIT(); asm volatile("" ::: "memory");
    const int c = lane & 7;
#pragma unroll
    for (int j = 0; j < 4; ++j) { const int n = (lane >> 3) + 8 * j; const LAS float* s = scr + (8 * c) * 33 + n;
        v4u o; o.x = pk2(s[0 * 33], s[1 * 33]); o.y = pk2(s[2 * 33], s[3 * 33]); o.z = pk2(s[4 * 33], s[5 * 33]); o.w = pk2(s[6 * 33], s[7 * 33]);
        *(GAS v4u*)(WT + (size_t)(dst_row0 + n) * ldt + k0 + 8 * c) = o; }
    LDS_WAIT(); asm volatile("" ::: "memory");
}
__device__ __forceinline__ void p0_prologue(Frame& F, ArgsP ap) {
    unsigned char* ws = ap->ws;
    if (F.vcu < 192) {
        LAS float* sc = (LAS float*)(F.lds + RING_OFF); LAS float* part = sc + 9 * 1024;
        const float* c = ap->in[I_C]; const float* cctx = ap->in[I_CCTX];
        for (int i = F.tid; i < 9 * 1024; i += NWAVES * 64) { const int bb = i >> 10, k = i & 1023; const float v = bb < 8 ? c[bb * 1024 + k] : cctx[k]; sc[i] = v / (1.0f + expf(-v)); }
        __syncthreads();
        const int l = F.vcu / 96, cb = F.vcu % 96, k0 = F.wave * 128;
        const float* w = ap->in[I_WADA] + (size_t)l * DM * MODW + (size_t)k0 * MODW + cb * 64 + F.lane;
        float acc[9];
#pragma unroll
        for (int j = 0; j < 9; ++j) acc[j] = 0.f;
        for (int k = 0; k < 128; k += 8) {
            float wv[8];
#pragma unroll
            for (int q = 0; q < 8; ++q) wv[q] = __builtin_nontemporal_load(w + (size_t)(k + q) * MODW);
#pragma unroll
            for (int j = 0; j < 9; ++j) { const f32x4 s0 = *(const LAS f32x4*)(sc + j * 1024 + k0 + k), s1 = *(const LAS f32x4*)(sc + j * 1024 + k0 + k + 4);
                acc[j] += (s0[0] * wv[0] + s0[1] * wv[1]) + (s0[2] * wv[2] + s0[3] * wv[3]) + (s1[0] * wv[4] + s1[1] * wv[5]) + (s1[2] * wv[6] + s1[3] * wv[7]); }
        }
#pragma unroll
        for (int j = 0; j < 9; ++j) part[(F.wave * 9 + j) * 64 + F.lane] = acc[j];
        __syncthreads();
        float* mods = (float*)(ws + WS_MODS);
        for (int idx = F.tid; idx < 9 * 64; idx += NWAVES * 64) { const int j = idx >> 6, col = idx & 63; float s = 0.f;
#pragma unroll
            for (int wv_ = 0; wv_ < 8; ++wv_) s += part[(wv_ * 9 + j) * 64 + col];
            mods[(size_t)(l * 9 + j) * MODW + cb * 64 + col] = s + ap->in[I_BADA][l * MODW + cb * 64 + col]; }
        __syncthreads();
    } else if (F.vcu == F.G - 1) {
        float* rc = (float*)(ws + WS_ROPE); float* rs = rc + 1024;
        for (int e = F.tid; e < 1024; e += NWAVES * 64) { const int pos = e >> 4, i = e & 15; const float fr = powf(10000.0f, -(float)(2 * i) / 32.0f); const float a = (float)pos * fr; rc[e] = cosf(a); rs[e] = sinf(a); }
    }
    LAS float* scr = (LAS float*)(F.lds + RING_OFF + F.wave * 16384);
    const int gw = F.vcu * NWAVES + F.wave, NGW = F.G * NWAVES;
    constexpr int I_IN = 16 * 56, I_OUT = 16 * 32, I_13 = 16 * 88, I_2 = 44 * 32, I_P = 4 * 8;
    constexpr int NITEMS = I_IN + I_OUT + 4 * I_13 + 2 * I_2 + 4 * I_P;
    for (int it = gw; it < NITEMS; it += NGW) {
        int r = it;
        if (r < I_IN) { const int kb = r / 56, nb = r % 56, f = 32 * nb, slot = f >> 6, bj = (f >> 5) & 1, pn = slot >> 2, wc = slot & 3;
            p0_transpose_item(ap->in[I_WIN], INW, 64 * kb, f, (bf16*)(ws + WS_WIN), DM, 256 * pn + 128 * bj + 32 * wc, scr, F.lane); continue; } r -= I_IN;
        if (r < I_OUT) { const int kb = r / 32, nb = r % 32; p0_transpose_item(ap->in[I_WOUT], DM, 64 * kb, 32 * nb, (bf16*)(ws + WS_WOUT), DM, 32 * nb, scr, F.lane); continue; } r -= I_OUT;
        if (r < 4 * I_13) { const int mi = r / I_13, rr = r % I_13, l = mi >> 1, which = mi & 1, kb = rr / 88, nb = rr % 88, n0 = 32 * nb;
            const float* W = ap->in[which ? I_W3 : I_W1] + (size_t)l * DM * FF;
            p0_transpose_item(W, FF, 64 * kb, n0, (bf16*)(ws + WS_W13) + (size_t)l * 5632 * DM, DM, 256 * (n0 >> 7) + 128 * which + (n0 & 127), scr, F.lane); continue; } r -= 4 * I_13;
        if (r < 2 * I_2) { const int l = r / I_2, rr = r % I_2, kb = rr / 32, nb = rr % 32;
            p0_transpose_item(ap->in[I_W2] + (size_t)l * FF * DM, DM, 64 * kb, 32 * nb, (bf16*)(ws + WS_W2) + (size_t)l * DM * FF, FF, 32 * nb, scr, F.lane); continue; } r -= 2 * I_2;
        { const int g = r / I_P, rr = r % I_P, kb = rr / 8, nb = rr % 8;
            p0_transpose_item(ap->in[I_WPOOL] + (size_t)g * 256 * 256, 256, 64 * kb, 32 * nb, (bf16*)(ws + WS_WPOOL), 256, g * 256 + 32 * nb, scr, F.lane); }
    }
    { const float* wsp = ap->in[I_WSP]; bf16* dst = (bf16*)(ws + WS_WSB);
        for (int e = (F.vcu * NWAVES * 64 + F.tid) * 4; e < 8 * 128 * 128; e += F.G * NWAVES * 64 * 4) { const f32x4 v = *(const f32x4*)(wsp + e); v2u o; o.x = pk2(v[0], v[1]); o.y = pk2(v[2], v[3]); *(v2u*)(dst + e) = o; } }
}
__device__ __forceinline__ void p1_bias13(Frame& F, ArgsP ap) {
    if (F.vcu >= 176) return;
    const int l = F.vcu / 88, rem = F.vcu % 88, which = rem / 44, cb = rem % 44, k0 = F.wave * 128;
    LAS float* shs = (LAS float*)(F.lds + RING_OFF); LAS float* part = shs + 8 * 1024;
    const float* mods = (const float*)(ap->ws + WS_MODS);
    for (int i = F.tid; i < 8 * 1024; i += NWAVES * 64) { const int b = i >> 10, k = i & 1023; shs[i] = mods[(size_t)(l * 9 + b) * MODW + SH2 + k]; }
    __syncthreads();
    const float* w = ap->in[which ? I_W3 : I_W1] + (size_t)l * DM * FF + (size_t)k0 * FF + cb * 64 + F.lane;
    float acc[8];
#pragma unroll
    for (int j = 0; j < 8; ++j) acc[j] = 0.f;
    for (int k = 0; k < 128; k += 8) {
        float wv[8];
#pragma unroll
        for (int q = 0; q < 8; ++q) wv[q] = __builtin_nontemporal_load(w + (size_t)(k + q) * FF);
#pragma unroll
        for (int j = 0; j < 8; ++j) { const f32x4 s0 = *(const LAS f32x4*)(shs + j * 1024 + k0 + k), s1 = *(const LAS f32x4*)(shs + j * 1024 + k0 + k + 4);
            acc[j] += (s0[0] * wv[0] + s0[1] * wv[1]) + (s0[2] * wv[2] + s0[3] * wv[3]) + (s1[0] * wv[4] + s1[1] * wv[5]) + (s1[2] * wv[6] + s1[3] * wv[7]); }
    }
#pragma unroll
    for (int j = 0; j < 8; ++j) part[(F.wave * 8 + j) * 64 + F.lane] = acc[j];
    __syncthreads();
    float* bias = (float*)(ap->ws + WS_BIAS);
    for (int idx = F.tid; idx < 8 * 64; idx += NWAVES * 64) { const int j = idx >> 6, col = idx & 63, n = cb * 64 + col; float sum = 0.f;
#pragma unroll
        for (int wv_ = 0; wv_ < 8; ++wv_) sum += part[(wv_ * 8 + j) * 64 + col];
        bias[(size_t)(l * 8 + j) * 5632 + 256 * (n >> 7) + 128 * which + (n & 127)] = sum; }
    __syncthreads();
}
__device__ __forceinline__ void p1_poolw(Frame& F, ArgsP ap) {
    unsigned char* ws = ap->ws; const bf16* src = (const bf16*)(ws + WS_WPOOL); bf16* dst = (bf16*)(ws + WS_WPB);
    const float* gm = ap->in[I_GMIX] + DM; const float* mod1 = (const float*)(ws + WS_MODS) + (size_t)9 * MODW;
    for (int e = (F.vcu * NWAVES * 64 + F.tid) * 8; e < 8 * 1024 * 256; e += F.G * NWAVES * 64 * 8) {
        const int b = e >> 18, n = (e >> 8) & 1023, k = e & 255, gk = (n & ~255) + k;
        const v4u w = *(const v4u*)(src + (size_t)n * 256 + k); const f32x4 g0 = *(const f32x4*)(gm + gk), g1 = *(const f32x4*)(gm + gk + 4);
        const f32x4 s0 = *(const f32x4*)(mod1 + (size_t)b * MODW + SC1 + gk), s1 = *(const f32x4*)(mod1 + (size_t)b * MODW + SC1 + gk + 4);
        const f32x4 m0 = g0 * (s0 + 1.0f), m1 = g1 * (s1 + 1.0f);
        v4u o; o.x = pk2(bf2f(w.x & 0xffffu) * m0[0], bf2f(w.x >> 16) * m0[1]); o.y = pk2(bf2f(w.y & 0xffffu) * m0[2], bf2f(w.y >> 16) * m0[3]);
        o.z = pk2(bf2f(w.z & 0xffffu) * m1[0], bf2f(w.z >> 16) * m1[1]); o.w = pk2(bf2f(w.w & 0xffffu) * m1[2], bf2f(w.w >> 16) * m1[3]);
        *(v4u*)(dst + e) = o; }
}
__device__ __forceinline__ void norm_pass(Frame& F, const float* src_lat, const float* src_ctx, bf16* dst, const float* gvec, const float* modl, int sh_off, int sc_off) {
    const int total = src_ctx ? MALL : MTOK, gw = F.vcu * NWAVES + F.wave, NGW = F.G * NWAVES, rpw = (total + NGW - 1) / NGW;
    const int r0 = gw * rpw, r1 = (r0 + rpw < total) ? r0 + rpw : total;
    int cur = -1; f32x4 gm[4], sh[4];
    for (int row = r0; row < r1; ++row) {
        const int bb = row < MTOK ? (row >> 12) : 8;
        if (bb != cur) { cur = bb;
#pragma unroll
            for (int j = 0; j < 4; ++j) { const int c = 4 * F.lane + 256 * j; const f32x4 g = *(const f32x4*)(gvec + c), s = *(const f32x4*)(modl + (size_t)bb * MODW + sc_off + c);
                gm[j] = g * (s + 1.0f); sh[j] = *(const f32x4*)(modl + (size_t)bb * MODW + sh_off + c); } }
        const float* xr = row < MTOK ? src_lat + (size_t)row * DM : src_ctx + (size_t)(row - MTOK) * DM;
        f32x4 v[4]; float ss = 0.f;
#pragma unroll
        for (int j = 0; j < 4; ++j) { v[j] = __builtin_nontemporal_load((const f32x4*)(xr + 4 * F.lane + 256 * j)); ss += (v[j][0] * v[j][0] + v[j][1] * v[j][1]) + (v[j][2] * v[j][2] + v[j][3] * v[j][3]); }
        const float r = 1.0f / sqrtf(wave_sum(ss) * (1.0f / DM) + 1e-6f);
        bf16* orow = dst + (size_t)row * DM;
#pragma unroll
        for (int j = 0; j < 4; ++j) { const f32x4 o = v[j] * r * gm[j] + sh[j]; v2u w; w.x = pk2(o[0], o[1]); w.y = pk2(o[2], o[3]); *(v2u*)(orow + 4 * F.lane + 256 * j) = w; }
    }
}
__device__ __forceinline__ void final_norm(Frame& F, float* out, const float* gvec) {
    const int gw = F.vcu * NWAVES + F.wave, NGW = F.G * NWAVES, rpw = (MTOK + NGW - 1) / NGW;
    const int r0 = gw * rpw, r1 = (r0 + rpw < MTOK) ? r0 + rpw : MTOK;
    f32x4 g[4];
#pragma unroll
    for (int j = 0; j < 4; ++j) g[j] = *(const f32x4*)(gvec + 4 * F.lane + 256 * j);
    for (int row = r0; row < r1; ++row) {
        float* xr = out + (size_t)row * DM; f32x4 v[4]; float ss = 0.f;
#pragma unroll
        for (int j = 0; j < 4; ++j) { v[j] = *(const f32x4*)(xr + 4 * F.lane + 256 * j); ss += (v[j][0] * v[j][0] + v[j][1] * v[j][1]) + (v[j][2] * v[j][2] + v[j][3] * v[j][3]); }
        const float r = 1.0f / sqrtf(wave_sum(ss) * (1.0f / DM) + 1e-6f);
#pragma unroll
        for (int j = 0; j < 4; ++j) *(f32x4*)(xr + 4 * F.lane + 256 * j) = v[j] * r * g[j];
    }
}
template <int W> __device__ __forceinline__ void poolres_cols(const bf16* zb, bf16* outb, bf16* xnb, float* partb, int t0, int c, f32x2 gate, f32x2 gmn, int wave, int lane) {
    constexpr int L = W / 2, R = W / 2 - 1, NV = W - 1 + 16;
    f32x2 v[NV];
#define Z_LD(dst_, t_) do { const int tt_ = (t_); if (tt_ < 0 || tt_ >= SEQ) dst_ = (f32x2){0.f, 0.f}; else { const unsigned u_ = __builtin_nontemporal_load((const unsigned*)(zb + (size_t)tt_ * DM + c)); dst_ = (f32x2){bf2f(u_ & 0xffffu), bf2f(u_ >> 16)}; } } while (0)
#pragma unroll
    for (int i = 0; i < W - 1; ++i) Z_LD(v[i], t0 - L + i);
    for (int blk = 0; blk < 8; ++blk) {
        const int tb = t0 + 16 * blk;
        unsigned xr[16];
#pragma unroll
        for (int i = 0; i < 16; ++i) xr[i] = *(const unsigned*)(outb + (size_t)(tb + i) * DM + c);
#pragma unroll
        for (int i = 0; i < 16; ++i) Z_LD(v[W - 1 + i], tb + R + i);
        f32x2 s = v[0];
#pragma unroll
        for (int i = 1; i < W; ++i) s += v[i];
#pragma unroll
        for (int j = 0; j < 16; ++j) { const int t = tb + j; const int lo = t - L < 0 ? 0 : t - L, hi = t + R > SEQ - 1 ? SEQ - 1 : t + R; const float cnt = (float)(hi - lo + 1);
            const f32x2 o = s / cnt - v[j + L]; const f32x2 x3 = (f32x2){bf2f(xr[j] & 0xffffu), bf2f(xr[j] >> 16)} + gate * o;
            *(unsigned*)(outb + (size_t)t * DM + c) = pk2(x3[0], x3[1]); const f32x2 y = x3 * gmn; *(unsigned*)(xnb + (size_t)t * DM + c) = pk2(y[0], y[1]);
            const float ss = wave_sum(x3[0] * x3[0] + x3[1] * x3[1]);
            if (lane < 2) partb[((size_t)((wave >> 2) + 2 * lane) * MTOK + t) * 4 + (wave & 3)] = lane ? 0.f : ss;
            if (j < 15) s += v[j + W] - v[j]; }
#pragma unroll
        for (int i = 0; i < W - 1; ++i) v[i] = v[i + 16];
    }
#undef Z_LD
}
__device__ __forceinline__ void poolres_pass(Frame& F, const bf16* Z, bf16* out, bf16* xn, float* part, const float* gate, const float* pscale, const float* gnext, const float* scnext) {
    for (int strip = F.vcu; strip < MTOK / 128; strip += F.G) {
        const int b = strip >> 5, t0 = (strip & 31) * 128; const size_t ro = (size_t)b * SEQ;
        const int c = 2 * F.tid;
        const f32x2 gt = *(const f32x2*)(gate + (size_t)b * MODW + c) * *(const f32x2*)(pscale + c);
        const f32x2 gmn = *(const f32x2*)(gnext + c) * (*(const f32x2*)(scnext + (size_t)b * MODW + c) + 1.0f);
        const bf16* zb = Z + ro * DM; bf16* outb = out + ro * DM; bf16* xnb = xn + ro * DM; float* partb = part + ro * 4;
        const int grp = F.wave >> 1;
        if (grp == 0) poolres_cols<2>(zb, outb, xnb, partb, t0, c, gt, gmn, F.wave, F.lane); else if (grp == 1) poolres_cols<4>(zb, outb, xnb, partb, t0, c, gt, gmn, F.wave, F.lane);
        else if (grp == 2) poolres_cols<8>(zb, outb, xnb, partb, t0, c, gt, gmn, F.wave, F.lane); else poolres_cols<16>(zb, outb, xnb, partb, t0, c, gt, gmn, F.wave, F.lane);
    }
}
__device__ __forceinline__ void gmlp_unit(Frame& F, int unit, const bf16* VG, const bf16* U, const bf16* WSB, const float* bs, bf16* AM) {
    using attn_body::f32x16;
    const int g = F.wave, lane = F.lane, r32 = lane & 31, hi = lane >> 5;
    const size_t R0 = (size_t)unit * 128;
    LAS unsigned char* slot = F.lds + RING_OFF + g * 16384;
    const unsigned slot_addr = (unsigned)(uintptr_t)slot;
    const int vb = (int)slot_addr + ((lane >> 4) & 1) * 32 + (lane & 3) * 8 + (4 * hi + ((lane & 15) >> 2)) * 64;
#pragma unroll
    for (int kt = 0; kt < 2; ++kt)
#pragma unroll
        for (int p = 0; p < 8; ++p)
            attn_body::glds16_nt(VG + (R0 + 64 * kt + 16 * (p & 3) + (lane >> 2)) * 512 + g * 64 + (p >> 2) * 32 + (lane & 3) * 8, (unsigned)__builtin_amdgcn_readfirstlane(slot_addr + kt * 8192 + p * 1024));
    f32x16 o[4][2];
#pragma unroll
    for (int rb = 0; rb < 4; ++rb) { o[rb][0] = f32x16{}; o[rb][1] = f32x16{}; }
#define GM_LDPA(dst, kt_, rb_) do { int z_ = 0; asm volatile("" : "+v"(z_)); const char* wp = wb + z_ + (rb_) * 8192 + (kt_) * 128;     \
            _Pragma("unroll") for (int s = 0; s < 4; ++s) { const v2u a = *(const v2u*)(wp + s * 32), b = *(const v2u*)(wp + s * 32 + 16); dst[s] = __builtin_bit_cast(bf16x8, (v4u){a.x, a.y, b.x, b.y}); } } while (0)
    const char* wb = (const char*)(WSB + ((size_t)(g * 128 + r32) * 128 + 4 * hi));
    {
        bf16x8 pA[4], pB[4];
#define GM_PV(P, kt_, rb_) attn_body::pv(o[rb_], vb + (kt_) * 8192, P[0], P[1], P[2], P[3])
        GM_LDPA(pA, 0, 0);
        VM_WAIT();
        GM_LDPA(pB, 0, 1); GM_PV(pA, 0, 0);
        GM_LDPA(pA, 0, 2); GM_PV(pB, 0, 1);
        GM_LDPA(pB, 0, 3); GM_PV(pA, 0, 2);
        GM_LDPA(pA, 1, 0); GM_PV(pB, 0, 3);
        GM_LDPA(pB, 1, 1); GM_PV(pA, 1, 0);
        GM_LDPA(pA, 1, 2); GM_PV(pB, 1, 1);
        GM_LDPA(pB, 1, 3); GM_PV(pA, 1, 2);
        GM_PV(pB, 1, 3);
#undef GM_PV
    }
#undef GM_LDPA
    LDS_WAIT();
    LAS float* stg = (LAS float*)slot;
    v4u uA[4], uB[4]; float bA[4], bB[4];
#define GM_LDU(UU, BB, rb_) do { int zz_ = 0; asm volatile("" : "+v"(zz_)); const char* ub_ = (const char*)(U + (R0 + 32 * (rb_) + (lane >> 3)) * 512 + g * 64 + (lane & 7) * 8) + zz_; \
        const float* bb_ = bs + g * 128 + 32 * (rb_) + (lane >> 3) + zz_; _Pragma("unroll") for (int i = 0; i < 4; ++i) { UU[i] = __builtin_nontemporal_load((const v4u*)(ub_ + i * 8192)); BB[i] = bb_[8 * i]; } } while (0)
#define GM_EPI(UU, BB, rb_) do { \
        _Pragma("unroll") for (int r = 0; r < 16; ++r) { const int orow = attn_body::crow(r, hi); stg[orow * 64 + r32] = o[rb_][0][r]; stg[orow * 64 + 32 + r32] = o[rb_][1][r]; } \
        LDS_WAIT(); \
        _Pragma("unroll") for (int i = 0; i < 4; ++i) { const int row = i * 8 + (lane >> 3), ch = lane & 7; \
            const f32x4 a = *(const LAS f32x4*)(stg + row * 64 + ch * 8) + BB[i], b = *(const LAS f32x4*)(stg + row * 64 + ch * 8 + 4) + BB[i]; \
            v4u w; w.x = pk2(a[0] * bf2f(UU[i].x & 0xffffu), a[1] * bf2f(UU[i].x >> 16)); w.y = pk2(a[2] * bf2f(UU[i].y & 0xffffu), a[3] * bf2f(UU[i].y >> 16)); \
            w.z = pk2(b[0] * bf2f(UU[i].z & 0xffffu), b[1] * bf2f(UU[i].z >> 16)); w.w = pk2(b[2] * bf2f(UU[i].w & 0xffffu), b[3] * bf2f(UU[i].w >> 16)); \
            *(v4u*)(AM + (R0 + 32 * (rb_) + row) * 1024 + 512 + g * 64 + ch * 8) = w; } \
        LDS_WAIT(); } while (0)
    GM_LDU(uA, bA, 0);
    GM_LDU(uB, bB, 1); GM_EPI(uA, bA, 0);
    GM_LDU(uA, bA, 2); GM_EPI(uB, bB, 1);
    GM_LDU(uB, bB, 3); GM_EPI(uA, bA, 2);
    GM_EPI(uB, bB, 3);
#undef GM_LDU
#undef GM_EPI
}

template <class Sched> __device__ __forceinline__ int build_rtab(Frame& F, const Sched& S, const float* part, LAS float* rtab) {
    pg8::Unit u; int pm0 = -1, pm1 = -1;
    for (int i = 0; S.next(i, u); ++i) { if (pm0 < 0) pm0 = u.pm; else if (u.pm != pm0) pm1 = u.pm; }
    if (pm1 < 0) pm1 = pm0;
    { const int slot = F.tid >> 8, r = F.tid & 255, row = (slot ? pm1 : pm0) * 256 + r; float tot = 0.f;
#pragma unroll
        for (int pn = 0; pn < 4; ++pn) { const f32x4 p = *(const f32x4*)(part + ((size_t)pn * MTOK + row) * 4); tot += (p[0] + p[1]) + (p[2] + p[3]); }
        rtab[F.tid] = __builtin_amdgcn_rsqf(tot * (1.0f / DM) + 1e-6f); }
    __syncthreads();
    return pm0;
}
__global__ void __launch_bounds__(NWAVES * 64, 2) mega_fwd(Args args) {
    extern __shared__ __attribute__((aligned(16))) unsigned char lds[];
    Frame F;
    F.lds = (LAS unsigned char*)lds;
    F.MISC = (volatile LAS unsigned*)(F.lds + MISC_OFF);
    F.tid = threadIdx.x; F.lane = F.tid & 63; F.wave = __builtin_amdgcn_readfirstlane(F.tid >> 6);
    F.G = gridDim.x; { const int bx = blockIdx.x; F.vcu = (F.G % 8 == 0) ? (bx % 8) * (F.G / 8) + bx / 8 : bx; }
    ArgsP akp = (ArgsP)__builtin_amdgcn_kernarg_segment_ptr();
    F.ctl = (gu32*)(akp->ws + WS_CTL);
    for (int u = F.tid; u < (LDS_BYTES - LDSCTL_OFF) / 4; u += NWAVES * 64) ((LAS unsigned*)(F.lds + LDSCTL_OFF))[u] = 0u;
    __syncthreads();
    const int lo = akp->ph_lo, hi = akp->ph_hi;
    const bool one_launch = (hi - lo) > 1;
    XcdBarrier bar; bar.bar = (unsigned*)(F.ctl + CW_BAR); bar.x = 0; bar.st = nullptr;
    if (one_launch) bar = xcd_barrier_post((unsigned*)(F.ctl + CW_BAR), F.MISC + 8);
#ifndef PHASE_MASK
#define PHASE_MASK 0x7ff
#endif
#define IN(k) (((PHASE_MASK >> (k)) & 1) && lo <= (k) && (k) < hi)
#define SEAM(k) do { if (IN(k) && IN((k) + 1)) xcd_barrier(bar); } while (0)
#ifndef REPEAT_MASK
#define REPEAT_MASK 0
#endif
#define REP(k) for (int rep_ = 0; rep_ < (((REPEAT_MASK >> (k)) & 1) ? 2 : 1); ++rep_, (((REPEAT_MASK >> (k)) & 1) && rep_ == 1 && one_launch ? (xcd_barrier(bar), 0) : 0))
#define REPRES(k, dummy) ((((REPEAT_MASK >> (k)) & 1) && rep_ == 0) ? (void*)(ws + (dummy)) : (void*)(ws + WS_RES))
#define REPOUT(k, dummy) ((((REPEAT_MASK >> (k)) & 1) && rep_ == 0) ? (float*)(ws + (dummy)) : out)
#define PHASE_VARS() ArgsP A = akp; asm volatile("" : "+s"(A)); unsigned char* ws = A->ws; float* out = A->out; float* mods = (float*)(ws + WS_MODS); const float* mod1 = mods + (size_t)9 * MODW; bf16* XN = (bf16*)(ws + WS_XN); bf16* AM = (bf16*)(ws + WS_AM); bf16* HB = (bf16*)(ws + WS_H); \
    float* rs1 = (float*)(ws + WS_PART); float* rs2 = rs1 + 16 * MTOK; float* rs3 = rs2 + 16 * MTOK; float* rs4 = rs3 + 16 * MTOK; const float* bias13 = (const float*)(ws + WS_BIAS); \
    (void)out; (void)mods; (void)mod1; (void)XN; (void)AM; (void)HB; (void)rs1; (void)rs2; (void)rs3; (void)rs4; (void)bias13
#ifndef STAGGER_US
#define STAGGER_US 0
#endif
#define STAGGER() do { const unsigned g_ = (blockIdx.x >> 3) & 3u; if (STAGGER_US > 0 && g_) { const unsigned long long t0_ = __builtin_amdgcn_s_memrealtime(); while (__builtin_amdgcn_s_memrealtime() - t0_ < (unsigned long long)(g_ * STAGGER_US * 100)) __builtin_amdgcn_s_sleep(8); } } while (0)
#define RELAUNDER() do { int t_ = threadIdx.x; asm volatile("" : "+v"(t_)); F.tid = t_; F.lane = t_ & 63; } while (0)
    if (IN(0)) REP(0) { PHASE_VARS(); RELAUNDER(); p0_prologue(F, A); } SEAM(0);
    if (IN(1)) REP(1) { PHASE_VARS(); RELAUNDER(); p1_bias13(F, A); p1_poolw(F, A); norm_pass(F, A->in[I_X], A->in[I_CTX], XN, A->in[I_GMIX], mods, SH1, SC1); } SEAM(1);
    if (IN(2)) REP(2) { PHASE_VARS();
        pg8::Gemm g{XN, (const bf16*)(ws + WS_WIN), DM, DM, 0, 0}; pg8::StaticOrder S; S.init(MTOK, INW, F.G, (int)blockIdx.x, MCTX / 256, 2);
        pg8::EpiInProj E{A};
        pg8::gemm_phase<pg8::EpiInProj, pg8::StaticOrder, PG8_ALIGN, PG8_SP2>(F.lds + RING_OFF, g, S, E);
    } SEAM(2);
    if (IN(3)) REP(3) { PHASE_VARS();
        const attn_body::AttnTensors AT{(const attn_body::bf16*)(ws + WS_Q), (const attn_body::bf16*)(ws + WS_KB), (const attn_body::bf16*)(ws + WS_VB), (attn_body::bf16*)AM};
        const attn_body::StaticOrder S((int)F.G, F.vcu);
        const bool gfirst = (F.vcu & 1) != 0;
        for (int g2_ = 0; g2_ < 2; ++g2_) {
            if ((g2_ == 0) == gfirst) {
                RELAUNDER();
                for (int rp_ = 0; rp_ < (((REPEAT_MASK >> 11) & 1) ? 2 : 1); ++rp_) {
                    for (int u = F.vcu; u < MTOK / 128; u += F.G) gmlp_unit(F, u, (const bf16*)(ws + WS_VG), (const bf16*)(ws + WS_U), (const bf16*)(ws + WS_WSB), A->in[I_BSP], AM);
                    __syncthreads(); }
            } else attn_body::attn_phase<attn_body::StaticOrder>((char*)lds + RING_OFF, AT, S, A->in[I_QN], A->in[I_KN]);
        }
    } SEAM(3);
    if (IN(4)) REP(4) { PHASE_VARS(); STAGGER();
        pg8::Gemm g{AM, (const bf16*)(ws + WS_WOUT), DM, DM, 0, 0}; pg8::StaticOrder S; S.init(MTOK, DM, F.G, (int)blockIdx.x);
        pg8::EpiResid<4> E{A, (void*)(ws + WS_RES)};
        pg8::gemm_phase<pg8::EpiResid<4>, pg8::StaticOrder, PG8_ALIGN, PG8_SP2>(F.lds + RING_OFF, g, S, E);
    } SEAM(4);
    if (IN(5)) REP(5) { PHASE_VARS();
        pg8::Gemm g{XN, (const bf16*)(ws + WS_W13), DM, DM, 0, 0}; pg8::StaticOrder S; S.init(MTOK, 2 * FF, F.G, (int)blockIdx.x);
#if defined(PROBE_NULL5)
        if (rep_ == 0) { pg8::EpiNull EN{(bf16*)(ws + WS_VG)}; pg8::StaticOrder S2; S2.init(MTOK, DM, F.G, (int)blockIdx.x);   (void)S2;
            pg8::EpiNullWide ENW{(bf16*)(ws + WS_H)}; pg8::gemm_phase<pg8::EpiNullWide, pg8::StaticOrder, PG8_ALIGN, PG8_SP2>(F.lds + RING_OFF, g, S, ENW); (void)EN; } else
#endif
        { RELAUNDER(); LAS float* rtab = (LAS float*)(F.lds + RTAB_OFF); const int pm0 = build_rtab(F, S, rs1, rtab); pg8::EpiSwiglu<0> E{A, rtab, pm0};
        pg8::gemm_phase<pg8::EpiSwiglu<0>, pg8::StaticOrder, PG8_ALIGN, PG8_SP2>(F.lds + RING_OFF, g, S, E); }
    } SEAM(5);
    if (IN(6)) REP(6) { PHASE_VARS(); STAGGER();
        pg8::Gemm g{HB, (const bf16*)(ws + WS_W2), FF, FF, 0, 0}; pg8::StaticOrder S; S.init(MTOK, DM, F.G, (int)blockIdx.x);
#if defined(PROBE_NULL6)
        if (rep_ == 0) { pg8::EpiNull EN{(bf16*)(ws + WS_VG)}; pg8::gemm_phase<pg8::EpiNull, pg8::StaticOrder, PG8_ALIGN, PG8_SP2>(F.lds + RING_OFF, g, S, EN); } else
#elif defined(PROBE_NOXN6)
        if (rep_ == 0) { pg8::EpiResid<7> E7{A, REPRES(6, WS_VG)}; pg8::gemm_phase<pg8::EpiResid<7>, pg8::StaticOrder, PG8_ALIGN, PG8_SP2>(F.lds + RING_OFF, g, S, E7); } else
#endif
        { pg8::EpiResid<6> E{A, REPRES(6, WS_VG)};
        pg8::gemm_phase<pg8::EpiResid<6>, pg8::StaticOrder, PG8_ALIGN, PG8_SP2>(F.lds + RING_OFF, g, S, E); }
    } SEAM(6);
    if (IN(7)) REP(7) { PHASE_VARS();
        pg8::Gemm g{(const bf16*)(ws + WS_RES), (const bf16*)(ws + WS_WPB), 256, DM, 512, 1024 * 256 * 2}; pg8::StaticOrder S; S.init(MTOK, DM, F.G, (int)blockIdx.x);
        pg8::EpiZ E{A};
        pg8::gemm_phase<pg8::EpiZ, pg8::StaticOrder, PG8_ALIGN, PG8_SP2>(F.lds + RING_OFF, g, S, E);
    } SEAM(7);
    if (IN(8)) { PHASE_VARS(); RELAUNDER(); poolres_pass(F, AM, (bf16*)(ws + WS_RES), XN, rs3, mod1 + GA1, A->in[I_PSC], A->in[I_GFFN] + DM, mod1 + SC2); } SEAM(8);
    if (IN(9)) REP(9) { PHASE_VARS();
        pg8::Gemm g{XN, (const bf16*)(ws + WS_W13) + (size_t)5632 * DM, DM, DM, 0, 0}; pg8::StaticOrder S; S.init(MTOK, 2 * FF, F.G, (int)blockIdx.x);
        RELAUNDER(); LAS float* rtab = (LAS float*)(F.lds + RTAB_OFF); const int pm0 = build_rtab(F, S, rs3, rtab); pg8::EpiSwiglu<1> E{A, rtab, pm0};
        pg8::gemm_phase<pg8::EpiSwiglu<1>, pg8::StaticOrder, PG8_ALIGN, PG8_SP2>(F.lds + RING_OFF, g, S, E);
    } SEAM(9);
    if (IN(10)) REP(10) { PHASE_VARS(); STAGGER();
        pg8::Gemm g{HB, (const bf16*)(ws + WS_W2) + (size_t)DM * FF, FF, FF, 0, 0}; pg8::StaticOrder S; S.init(MTOK, DM, F.G, (int)blockIdx.x);
        pg8::EpiResid<10> E{A, out};
        pg8::gemm_phase<pg8::EpiResid<10>, pg8::StaticOrder, PG8_ALIGN, PG8_SP2>(F.lds + RING_OFF, g, S, E);
    }
#undef IN
#undef SEAM
}

extern "C" void kernel_launch(void* const* d_in, const int* in_sizes, int n_in, void* d_out, int out_size, void* d_ws, size_t ws_size, hipStream_t stream) {
    static int grid = 0;
    if (grid == 0) {
        if (n_in != 21 || out_size != MTOK * DM || ws_size < WS_END) { fprintf(stderr, "kernel_launch: unexpected shapes (n_in %d, out %d, ws %zu)\n", n_in, out_size, ws_size); grid = -1; return; }
        int dev = 0, cus = 0, per_cu = 0;
        if (hipGetDevice(&dev) != hipSuccess || hipDeviceGetAttribute(&cus, hipDeviceAttributeMultiprocessorCount, dev) != hipSuccess) { grid = -1; return; }
        if (hipFuncSetAttribute((const void*)mega_fwd, hipFuncAttributeMaxDynamicSharedMemorySize, LDS_BYTES) != hipSuccess) { fprintf(stderr, "kernel_launch: hipFuncSetAttribute failed\n"); grid = -1; return; }
        if (hipOccupancyMaxActiveBlocksPerMultiprocessor(&per_cu, (const void*)mega_fwd, NWAVES * 64, LDS_BYTES) != hipSuccess || per_cu < 1) { fprintf(stderr, "kernel_launch: occupancy query says %d\n", per_cu); per_cu = 1; }
        (void)hipGetLastError();
        grid = cus;
        if (grid != 256) fprintf(stderr, "kernel_launch: %d CUs (expected 256)\n", grid);
    }
    if (grid < 0) return;
    if (hipMemsetAsync((char*)d_ws + WS_CTL, 0, CTL_ZERO_BYTES, stream) != hipSuccess) return;
    Args a{};
    for (int i = 0; i < 21; ++i) a.in[i] = (const float*)d_in[i];
    a.out = (float*)d_out; a.ws = (unsigned char*)d_ws;
#if defined(MK_PER_PHASE)
    for (int p = 0; p < N_PHASES; ++p) { a.ph_lo = p; a.ph_hi = p + 1; hipLaunchKernelGGL(mega_fwd, dim3(grid), dim3(NWAVES * 64), LDS_BYTES, stream, a); }
#else
    a.ph_lo = 0; a.ph_hi = N_PHASES;
    hipLaunchKernelGGL(mega_fwd, dim3(grid), dim3(NWAVES * 64), LDS_BYTES, stream, a);
#endif
}
```

```cpp
#include <hip/hip_runtime.h>
#include <hip/hip_bf16.h>
#include <cstdio>
#include <cstdint>
#include <cmath>
constexpr int NWAVES_ = 8;
constexpr int NWAVES = 8;
constexpr int DM = 1024, NB = 8, SEQ = 4096, MTOK = NB * SEQ, CTXL = 256, MCTX = NB * CTXL, MALL = MTOK + MCTX;
constexpr int INW = 1792, FF = 2816, SKV = SEQ + CTXL;
constexpr int N_PHASES = 11;
constexpr size_t MiB = 1u << 20;
constexpr size_t WS_CTL = 0, CTL_ZERO_BYTES = 128 * 1024;
constexpr size_t WS_MODS = 1 * MiB;
constexpr size_t WS_ROPE = WS_MODS + 512 * 1024;
constexpr size_t WS_WSB = 2 * MiB;
constexpr size_t WS_WPOOL = WS_WSB + 512 * 1024;
constexpr size_t WS_WIN = 4 * MiB;
constexpr size_t WS_WOUT = 8 * MiB;
constexpr size_t WS_W13 = 10 * MiB;
constexpr size_t WS_W2 = 32 * MiB;
constexpr size_t WS_XN = 44 * MiB;
constexpr size_t WS_Q = 112 * MiB;
constexpr size_t WS_RES = 112 * MiB;
constexpr size_t WS_KB = 144 * MiB;
constexpr size_t WS_VB = 153 * MiB;
constexpr size_t WS_U = 162 * MiB;
constexpr size_t WS_VG = 194 * MiB;
constexpr size_t WS_AM = 226 * MiB;
constexpr size_t WS_H = 290 * MiB;
constexpr size_t WS_WPB = 474 * MiB;
constexpr size_t WS_END = 478 * MiB;
constexpr int CW_BAR = 4096;
constexpr size_t CTL_CNT = 65536;
constexpr size_t WS_PART = 466 * MiB;
static_assert(CTL_CNT + 32768 <= CTL_ZERO_BYTES, "CTL map");
constexpr size_t WS_BIAS = WS_ROPE + 65536;
constexpr int RING_OFF = 0, RING_BYTES = 131072;
constexpr int LDSCTL_OFF = RING_BYTES, MISC_OFF = LDSCTL_OFF + 320;
constexpr int RTAB_OFF = LDSCTL_OFF + 1024;
constexpr int LDS_BYTES = 147456;
static_assert(MISC_OFF + 128 <= LDS_BYTES, "LDS map");

struct Args { const float* in[21]; float* out; unsigned char* ws; int ph_lo, ph_hi; };
#define KARG __attribute__((address_space(4)))
typedef const KARG Args* ArgsP;
static_assert(sizeof(Args) == 192, "Args has no padding");
enum { I_X = 0, I_C, I_CTX, I_CCTX, I_WADA, I_BADA, I_GMIX, I_GFFN, I_WIN, I_WOUT, I_QN, I_KN, I_GN, I_WSP, I_BSP, I_WPOOL, I_PSC, I_W1, I_W3, I_W2, I_GFIN };
constexpr int SH1 = 0, SC1 = DM, GA1 = 2 * DM, SH2 = 3 * DM, SC2 = 4 * DM, GA2 = 5 * DM, MODW = 6 * DM;

namespace pg8 {
#define PG8_LAS __attribute__((address_space(3)))
typedef unsigned short bf16_t;
typedef short bf16x8 __attribute__((ext_vector_type(8)));
typedef float f32x4 __attribute__((ext_vector_type(4)));
typedef float f32x2 __attribute__((ext_vector_type(2)));
typedef unsigned u32x4 __attribute__((ext_vector_type(4)));
constexpr int BM = 256, BK = 64, HALF = 128, HTB = HALF * BK * 2  , STAGE_BYTES = 8 * HTB, NXCD = 8, WGM = 8;

__host__ __device__ __forceinline__ int lds_byte(int r, int c) { const int st = (r >> 4) * 2 + (c >> 5), rr = r & 15, cc = c & 31, ob = rr * 64 + cc * 2; return st * 1024 + (ob ^ (((ob >> 9) & 1) << 5)); }
__host__ __device__ __forceinline__ void stage_rc(int b, int& R, int& C) { const int st = b / 1024, sb = b % 1024, swz = sb ^ (((sb >> 9) & 1) << 5); R = (st >> 1) * 16 + swz / 64; C = (st & 1) * 32 + (swz % 64) / 2; }
__host__ __device__ __forceinline__ int perm32(int rho) { const int n = rho >> 4, i = rho & 15; return 8 * (i >> 2) + 4 * n + (i & 3); }

struct Unit { int pm, pn; };
struct Gemm { const bf16_t* A; const bf16_t* Bt; int K; int lda; int a_pn_bytes; int b_batch_bytes; };

struct StaticOrder {
    int nM, nN, nwg, G, c, extra, extra_pn;
    __host__ __device__ void init(int M, int N, int G_, int c_, int extra_ = 0, int extra_pn_ = 0) { nM = M / BM; nN = N / BM; nwg = nM * nN; G = G_; c = c_; extra = extra_; extra_pn = extra_pn_; }
    __host__ __device__ bool next(int i, Unit& u) const {
        const long L = (long)i * G + c;
        if (L >= nwg) { const long e = L - nwg; if (e >= extra) return false; u.pm = nM + (int)e; u.pn = extra_pn; return true; }
        int wgid = (int)L; { const int q = nwg / NXCD, r = nwg % NXCD, xcd = wgid % NXCD, off = wgid / NXCD; wgid = (xcd < r ? xcd * (q + 1) : r * (q + 1) + (xcd - r) * q) + off; }
        const int nig = WGM * nN, gid = wgid / nig, fm = gid * WGM, gsz = (nM - fm) < WGM ? (nM - fm) : WGM;
        u.pm = fm + ((wgid % nig) % gsz); u.pn = (wgid % nig) / gsz; return true;
    }
    __device__ __forceinline__ void a_ready(const Unit&) const {}
    __device__ __forceinline__ void done(const Unit&) const {}
};

__device__ __forceinline__ unsigned cvt_pk_bf16(float lo, float hi) { unsigned r; asm volatile("v_cvt_pk_bf16_f32 %0, %1, %2" : "=v"(r) : "v"(lo), "v"(hi)); return r; }
__device__ __forceinline__ f32x2 gelu_pk(f32x2 v) {
    const f32x2 av = __builtin_elementwise_abs(v), d = av * 0.2316418882f + 1.0f;
    f32x2 t; t.x = __builtin_amdgcn_rcpf(d.x); t.y = __builtin_amdgcn_rcpf(d.y);
    f32x2 q = t * 0.5307027145f + (-0.7265760135f); q = q * t + 0.7107068705f; q = q * t + (-0.142248368f); q = q * t + 0.127414796f; q = q * t;
    const f32x2 s = (v * v) * (-0.72134752044f);
    f32x2 e; e.x = __builtin_amdgcn_exp2f(s.x); e.y = __builtin_amdgcn_exp2f(s.y);
    const f32x2 m = v * (q * e), r = v - m;
    f32x2 o; o.x = v.x < 0.f ? m.x : r.x; o.y = v.y < 0.f ? m.y : r.y; return o;
}
__device__ __forceinline__ f32x4 gelu4(f32x4 v) { const f32x2 a = gelu_pk((f32x2){v[0], v[1]}), b = gelu_pk((f32x2){v[2], v[3]}); return (f32x4){a.x, a.y, b.x, b.y}; }
__device__ __forceinline__ float silu1(float v) { return v * __builtin_amdgcn_rcpf(1.0f + __builtin_amdgcn_exp2f(v * -1.4426950408889634f)); }
__device__ __forceinline__ u32x4 pack8(f32x4 v0, f32x4 v1) { u32x4 w; w.x = cvt_pk_bf16(v0[0], v0[1]); w.y = cvt_pk_bf16(v0[2], v0[3]); w.z = cvt_pk_bf16(v1[0], v1[1]); w.w = cvt_pk_bf16(v1[2], v1[3]); return w; }

struct EpiInProj {
    static constexpr bool PERM = true, AFTER_DRAIN = false;
    ArgsP A;
    __device__ __forceinline__ void operator()(const f32x4 (&acc)[2][2][4][2], const Unit& u, int wr, int wc, int fr_, int fq_) const {
        ArgsP a_ = A; asm volatile("" : "+s"(a_)); unsigned char* ws_ = a_->ws;
        bf16_t* Q = (bf16_t*)(ws_ + WS_Q); bf16_t* KB = (bf16_t*)(ws_ + WS_KB); bf16_t* VB = (bf16_t*)(ws_ + WS_VB); bf16_t* U = (bf16_t*)(ws_ + WS_U); bf16_t* VG = (bf16_t*)(ws_ + WS_VG);
        const float* qn = a_->in[I_QN]; const float* kn = a_->in[I_KN]; const float* gv = a_->in[I_GN]; const float* ropeC = (const float*)(ws_ + WS_ROPE); const float* ropeS = ropeC + 1024;
        const float qscale = 0.125f * 1.4426950408889634f;
        int t_ = threadIdx.x; asm volatile("" : "+v"(t_)); const int fr = t_ & 15, fq = (t_ >> 4) & 3; (void)fr_; (void)fq_;
        const int slot = 4 * u.pn + wc; const bool isctx = u.pm >= 128;
        const int rowl = wr * 64 + fr;
        const int row0 = u.pm * BM + rowl;
        const int kvrow0 = (isctx ? (u.pm - 128) * 4352 + 4096 : (u.pm >> 4) * 4352 + (u.pm & 15) * 256) + rowl;
        const int dl = 8 * fq;
        if (slot < 10) {
            const float* nw = slot < 8 ? qn : kn; const float osc = slot < 8 ? qscale : 1.0f;
            f32x4 w[2][2];
#pragma unroll
            for (int bj = 0; bj < 2; ++bj)
#pragma unroll
                for (int n = 0; n < 2; ++n) w[bj][n] = *(const f32x4*)(nw + 32 * bj + dl + 4 * n);
#pragma unroll
            for (int ai = 0; ai < 2; ++ai) {
                const int posr = (4 * u.pm + 2 * ai + wr) & 63;
                const f32x4 cr = *(const f32x4*)(ropeC + posr * 16 + 4 * fq), sr = *(const f32x4*)(ropeS + posr * 16 + 4 * fq);
#pragma unroll
                for (int m = 0; m < 4; ++m) {
                    float ss = 0.f;
#pragma unroll
                    for (int bj = 0; bj < 2; ++bj)
#pragma unroll
                        for (int n = 0; n < 2; ++n) { const f32x4 x = acc[ai][bj][m][n]; ss += (x[0] * x[0] + x[1] * x[1]) + (x[2] * x[2] + x[3] * x[3]); }
                    ss += __shfl_xor(ss, 16); ss += __shfl_xor(ss, 32);
                    const float r = __builtin_amdgcn_rsqf(ss * (1.0f / 64.0f) + 1e-6f) * osc;
                    const int posc = 16 * m + fr;
                    const f32x4 cc = *(const f32x4*)(ropeC + posc * 16 + 4 * fq), sc = *(const f32x4*)(ropeS + posc * 16 + 4 * fq);
#pragma unroll
                    for (int bj = 0; bj < 2; ++bj) {
                        f32x4 v0 = acc[ai][bj][m][0] * r * w[bj][0], v1 = acc[ai][bj][m][1] * r * w[bj][1];
                        if (!isctx) { const f32x4 c = bj ? cc : cr, s = bj ? sc : sr;
                            const f32x4 o0 = (f32x4){v0[0] * c[0] - v0[1] * s[0], v0[0] * s[0] + v0[1] * c[0], v0[2] * c[1] - v0[3] * s[1], v0[2] * s[1] + v0[3] * c[1]};
                            const f32x4 o1 = (f32x4){v1[0] * c[2] - v1[1] * s[2], v1[0] * s[2] + v1[1] * c[2], v1[2] * c[3] - v1[3] * s[3], v1[2] * s[3] + v1[3] * c[3]};
                            v0 = o0; v1 = o1; }
                        bf16_t* dst = slot < 8 ? Q + (size_t)(row0 + ai * HALF + m * 16) * 512 + slot * 64 + 32 * bj + dl
                                               : KB + (size_t)(kvrow0 + ai * HALF + m * 16) * 128 + (slot - 8) * 64 + 32 * bj + dl;
                        *(u32x4*)dst = pack8(v0, v1);
                    }
                    asm volatile("" ::: "memory");
                }
            }
        } else if (slot < 12) {
#pragma unroll
            for (int ai = 0; ai < 2; ++ai)
#pragma unroll
                for (int m = 0; m < 4; ++m)
#pragma unroll
                    for (int bj = 0; bj < 2; ++bj)
                        *(u32x4*)(VB + (size_t)(kvrow0 + ai * HALF + m * 16) * 128 + (slot - 10) * 64 + 32 * bj + dl) = pack8(acc[ai][bj][m][0], acc[ai][bj][m][1]);
        } else if (slot < 20) {
#pragma unroll
            for (int ai = 0; ai < 2; ++ai)
#pragma unroll
                for (int m = 0; m < 4; ++m)
#pragma unroll
                    for (int bj = 0; bj < 2; ++bj)
                        *(u32x4*)(U + (size_t)(row0 + ai * HALF + m * 16) * 512 + (slot - 12) * 64 + 32 * bj + dl) = pack8(gelu4(acc[ai][bj][m][0]), gelu4(acc[ai][bj][m][1]));
        } else {
            f32x4 w[2][2];
#pragma unroll
            for (int bj = 0; bj < 2; ++bj)
#pragma unroll
                for (int n = 0; n < 2; ++n) w[bj][n] = *(const f32x4*)(gv + (slot - 20) * 64 + 32 * bj + dl + 4 * n);
#pragma unroll
            for (int ai = 0; ai < 2; ++ai)
#pragma unroll
                for (int m = 0; m < 4; ++m) {
                    f32x4 g[2][2]; float ss = 0.f;
#pragma unroll
                    for (int bj = 0; bj < 2; ++bj)
#pragma unroll
                        for (int n = 0; n < 2; ++n) { const f32x4 x = gelu4(acc[ai][bj][m][n]); g[bj][n] = x; ss += (x[0] * x[0] + x[1] * x[1]) + (x[2] * x[2] + x[3] * x[3]); }
                    ss += __shfl_xor(ss, 16); ss += __shfl_xor(ss, 32);
                    const float r = __builtin_amdgcn_rsqf(ss * (1.0f / 64.0f) + 1e-6f);
#pragma unroll
                    for (int bj = 0; bj < 2; ++bj)
                        *(u32x4*)(VG + (size_t)(row0 + ai * HALF + m * 16) * 512 + (slot - 20) * 64 + 32 * bj + dl) = pack8(g[bj][0] * r * w[bj][0], g[bj][1] * r * w[bj][1]);
                }
        }
    }
};
constexpr int RS_M = 32768;
__device__ __forceinline__ float row_total(const float* part, int row, int fq) {
    const f32x4 p = *(const f32x4*)(part + ((size_t)fq * RS_M + row) * 4); float t = (p[0] + p[1]) + (p[2] + p[3]); t += __shfl_xor(t, 16); t += __shfl_xor(t, 32); return t;
}
template <int V> struct EpiResid {
    static constexpr bool PERM = true, AFTER_DRAIN = false, XNOUT = (V == 4), FINAL = (V == 10), BASE16 = (V != 4);
    ArgsP A; void* outp;
    __device__ __forceinline__ void operator()(f32x4 (&acc)[2][2][4][2], const Unit& u, int wr, int wc, int fr_, int fq_) const {
        int t_ = threadIdx.x; asm volatile("" : "+v"(t_)); const int fr = t_ & 15, fq = (t_ >> 4) & 3; (void)fr_; (void)fq_;
        const int row0 = u.pm * BM + wr * 64 + fr, col0 = u.pn * BM + wc * 32 + 8 * fq, b = u.pm >> 4;
        ArgsP a_ = A; asm volatile("" : "+s"(a_)); unsigned char* ws_ = a_->ws; constexpr int gstride = MODW;
        const float* mods_ = (const float*)(ws_ + WS_MODS); const float* modl_ = mods_ + (V == 10 ? 9 * MODW : 0);
        const float* basef = a_->in[I_X]; const bf16_t* baseh = (const bf16_t*)(ws_ + WS_RES); const float* gate = modl_ + (V == 4 ? GA1 : GA2);
        float* part = (float*)(ws_ + WS_PART) + (size_t)(V == 4 ? 0 : V == 10 ? 3 : 1) * 16 * RS_M;
        bf16_t* xn = (bf16_t*)(ws_ + WS_XN); const float* gnext = (V == 4) ? a_->in[I_GFFN] : a_->in[I_GMIX] + DM; const float* scnext = (V == 4) ? mods_ + SC2 : mods_ + 9 * MODW + SC1;
        unsigned* cnt = (unsigned*)(ws_ + WS_CTL + CTL_CNT); const float* gfin = a_->in[I_GFIN];
        bf16_t* resout = (bf16_t*)outp; float* out = (float*)outp;
        const float* gp = gate + (size_t)b * gstride + col0;
        f32x4 gvv[2][2], gmn[2][2];
#pragma unroll
        for (int bj = 0; bj < 2; ++bj)
#pragma unroll
            for (int n = 0; n < 2; ++n) { gvv[bj][n] = *(const f32x4*)(gp + bj * HALF + n * 4);
                if (XNOUT) gmn[bj][n] = *(const f32x4*)(gnext + col0 + bj * HALF + n * 4) * (*(const f32x4*)(scnext + (size_t)b * gstride + col0 + bj * HALF + n * 4) + 1.0f); }
        float ssv[2][4];
        f32x4 bsA[2][2], bsB[2][2], bsC[2][2], bsD[2][2], bsE[2][2], bsF[2][2], bsG[2][2], bsH[2][2];
        u32x4 hsA[2], hsB[2], hsC[2], hsD[2], hsE[2], hsF[2], hsG[2], hsH[2];
#define ER_LOAD(X, p) do { const size_t off_ = (size_t)(row0 + ((p) >> 2) * HALF + ((p) & 3) * 16) * 1024 + col0; \
            _Pragma("unroll") for (int bj = 0; bj < 2; ++bj) { if (BASE16) { if (FINAL) hs##X[bj] = __builtin_nontemporal_load((const u32x4*)(baseh + off_ + bj * HALF)); else hs##X[bj] = *(const u32x4*)(baseh + off_ + bj * HALF); } \
                else { bs##X[bj][0] = __builtin_nontemporal_load((const f32x4*)(basef + off_ + bj * HALF)); bs##X[bj][1] = __builtin_nontemporal_load((const f32x4*)(basef + off_ + bj * HALF + 4)); } } } while (0)
#define ER_WORK(X, p) do { const int ai = (p) >> 2, m = (p) & 3; const size_t off_ = (size_t)(row0 + ai * HALF + m * 16) * 1024 + col0; float ss = 0.f; \
            _Pragma("unroll") for (int bj = 0; bj < 2; ++bj) { f32x4 b0, b1; \
                if (BASE16) { const u32x4 h = hs##X[bj]; b0 = (f32x4){__builtin_bit_cast(float, h.x << 16), __builtin_bit_cast(float, h.x & 0xffff0000u), __builtin_bit_cast(float, h.y << 16), __builtin_bit_cast(float, h.y & 0xffff0000u)}; \
                    b1 = (f32x4){__builtin_bit_cast(float, h.z << 16), __builtin_bit_cast(float, h.z & 0xffff0000u), __builtin_bit_cast(float, h.w << 16), __builtin_bit_cast(float, h.w & 0xffff0000u)}; } \
                else { b0 = bs##X[bj][0]; b1 = bs##X[bj][1]; } \
                const f32x4 x0 = b0 + gvv[bj][0] * acc[ai][bj][m][0], x1 = b1 + gvv[bj][1] * acc[ai][bj][m][1]; \
                ss += ((x0[0] * x0[0] + x0[1] * x0[1]) + (x0[2] * x0[2] + x0[3] * x0[3])) + ((x1[0] * x1[0] + x1[1] * x1[1]) + (x1[2] * x1[2] + x1[3] * x1[3])); \
                if (FINAL) { acc[ai][bj][m][0] = x0; acc[ai][bj][m][1] = x1; } else *(u32x4*)(resout + off_ + bj * HALF) = pack8(x0, x1); \
                if (XNOUT) *(u32x4*)(xn + off_ + bj * HALF) = pack8(x0 * gmn[bj][0], x1 * gmn[bj][1]); } \
            ss += __shfl_xor(ss, 16); ss += __shfl_xor(ss, 32); ssv[ai][m] = ss; } while (0)
#define ER_FENCE asm volatile("" ::: "memory")
        if constexpr (FINAL) {
            ER_LOAD(A, 0); ER_LOAD(B, 1); ER_LOAD(C, 2); ER_LOAD(D, 3); ER_LOAD(E, 4); ER_LOAD(F, 5); ER_LOAD(G, 6); ER_LOAD(H, 7); ER_FENCE;
            ER_WORK(A, 0); ER_WORK(B, 1); ER_WORK(C, 2); ER_WORK(D, 3); ER_WORK(E, 4); ER_WORK(F, 5); ER_WORK(G, 6); ER_WORK(H, 7);
        } else if constexpr (BASE16) {
            ER_LOAD(A, 0); ER_LOAD(B, 1); ER_LOAD(C, 2); ER_LOAD(D, 3); ER_FENCE;
            ER_LOAD(E, 4); ER_FENCE; ER_WORK(A, 0); ER_FENCE;
            ER_LOAD(A, 5); ER_FENCE; ER_WORK(B, 1); ER_FENCE;
            ER_LOAD(B, 6); ER_FENCE; ER_WORK(C, 2); ER_FENCE;
            ER_LOAD(C, 7); ER_FENCE; ER_WORK(D, 3); ER_FENCE;
            ER_WORK(E, 4); ER_FENCE; ER_WORK(A, 5); ER_FENCE; ER_WORK(B, 6); ER_FENCE; ER_WORK(C, 7);
        } else {
            ER_LOAD(A, 0); ER_LOAD(B, 1); ER_FENCE;
            ER_LOAD(C, 2); ER_FENCE; ER_WORK(A, 0); ER_FENCE;
            ER_LOAD(A, 3); ER_FENCE; ER_WORK(B, 1); ER_FENCE;
            ER_LOAD(B, 4); ER_FENCE; ER_WORK(C, 2); ER_FENCE;
            ER_LOAD(C, 5); ER_FENCE; ER_WORK(A, 3); ER_FENCE;
            ER_LOAD(A, 6); ER_FENCE; ER_WORK(B, 4); ER_FENCE;
            ER_LOAD(B, 7); ER_FENCE; ER_WORK(C, 5); ER_FENCE;
            ER_WORK(A, 6); ER_FENCE;
            ER_WORK(B, 7);
        }
#undef ER_FENCE
#undef ER_LOAD
#undef ER_WORK
        if (fq == 0) {
#pragma unroll
            for (int ai = 0; ai < 2; ++ai)
#pragma unroll
                for (int m = 0; m < 4; ++m) { float* pp = part + ((size_t)u.pn * RS_M + (row0 + ai * HALF + m * 16)) * 4 + wc;
                    if (FINAL) __hip_atomic_store(pp, ssv[ai][m], __ATOMIC_RELAXED, __HIP_MEMORY_SCOPE_AGENT); else *pp = ssv[ai][m]; }
        }
        if (FINAL) {
            asm volatile("s_waitcnt vmcnt(0)" ::: "memory");
            unsigned* cw = cnt + 64 * u.pm;
            if (fr == 0 && fq == 0) __hip_atomic_fetch_add(cw, 1u, __ATOMIC_RELAXED, __HIP_MEMORY_SCOPE_AGENT);
            { unsigned sp = 0; while ((unsigned)__builtin_amdgcn_readfirstlane(__hip_atomic_load(cw, __ATOMIC_RELAXED, __HIP_MEMORY_SCOPE_AGENT)) < 32u) { __builtin_amdgcn_s_sleep(2); if (++sp > (1u << 22)) break; } }
            f32x4 gf[2][2];
#pragma unroll
            for (int bj = 0; bj < 2; ++bj)
#pragma unroll
                for (int n = 0; n < 2; ++n) gf[bj][n] = *(const f32x4*)(gfin + col0 + bj * HALF + n * 4);
            float rr[2][4];
            {
                f32x4 pq[8];
#pragma unroll
                for (int i = 0; i < 8; ++i) { const float* pp = part + ((size_t)fq * RS_M + (row0 + (i >> 2) * HALF + (i & 3) * 16)) * 4;
                    asm volatile("global_load_dwordx4 %0, %1, off sc1" : "=v"(pq[i]) : "v"(pp) : "memory"); }
                asm volatile("s_waitcnt vmcnt(0)" : "+v"(pq[0]), "+v"(pq[1]), "+v"(pq[2]), "+v"(pq[3]), "+v"(pq[4]), "+v"(pq[5]), "+v"(pq[6]), "+v"(pq[7]) :: "memory");
#pragma unroll
                for (int i = 0; i < 8; ++i) { float t = (pq[i][0] + pq[i][1]) + (pq[i][2] + pq[i][3]); t += __shfl_xor(t, 16); t += __shfl_xor(t, 32); rr[i >> 2][i & 3] = __builtin_amdgcn_rsqf(t * (1.0f / 1024.0f) + 1e-6f); }
            }
#pragma unroll
            for (int ai = 0; ai < 2; ++ai)
#pragma unroll
                for (int m = 0; m < 4; ++m) { const size_t off = (size_t)(row0 + ai * HALF + m * 16) * 1024 + col0;
#pragma unroll
                    for (int bj = 0; bj < 2; ++bj)
#pragma unroll
                        for (int n = 0; n < 2; ++n) *(f32x4*)(out + off + bj * HALF + n * 4) = acc[ai][bj][m][n] * rr[ai][m] * gf[bj][n]; }
        }
    }
};
template <int L> struct EpiSwiglu {
    static constexpr bool PERM = true, AFTER_DRAIN = false;
    ArgsP A; const PG8_LAS float* rtab; int pm0;
    __device__ __forceinline__ void operator()(const f32x4 (&acc)[2][2][4][2], const Unit& u, int wr, int wc, int fr_, int fq_) const {
        int t_ = threadIdx.x; asm volatile("" : "+v"(t_)); const int fr = t_ & 15, fq = (t_ >> 4) & 3; (void)fr_; (void)fq_;
        const int row0 = u.pm * BM + wr * 64 + fr, col0 = u.pn * HALF + wc * 32 + 8 * fq;
        ArgsP a_ = A; asm volatile("" : "+s"(a_)); unsigned char* ws_ = a_->ws; constexpr int ldh = FF;
        bf16_t* H = (bf16_t*)(ws_ + WS_H); const float* rowss = (const float*)(ws_ + WS_PART) + (size_t)(L ? 2 : 0) * 16 * RS_M; const float* bias = (const float*)(ws_ + WS_BIAS) + (size_t)L * 8 * 5632;
        const float* bp = bias + (size_t)(u.pm >> 4) * 5632 + u.pn * BM + wc * 32 + 8 * fq;
        f32x4 bv[2][2];
#pragma unroll
        for (int bj = 0; bj < 2; ++bj)
#pragma unroll
            for (int n = 0; n < 2; ++n) bv[bj][n] = *(const f32x4*)(bp + bj * HALF + 4 * n);
        float rr[2][4]; { const PG8_LAS float* rt = rtab + (u.pm == pm0 ? 0 : 256) + wr * 64 + fr; (void)rowss;
#pragma unroll
            for (int ai = 0; ai < 2; ++ai)
#pragma unroll
                for (int m = 0; m < 4; ++m) rr[ai][m] = rt[ai * HALF + m * 16]; }
#pragma unroll
        for (int ai = 0; ai < 2; ++ai)
#pragma unroll
            for (int m = 0; m < 4; ++m) { const int row = row0 + ai * HALF + m * 16; const float r = rr[ai][m]; f32x4 h[2];
#pragma unroll
                for (int n = 0; n < 2; ++n) { const f32x4 a = acc[ai][0][m][n] * r + bv[0][n], b = acc[ai][1][m][n] * r + bv[1][n]; h[n] = (f32x4){silu1(a[0]) * b[0], silu1(a[1]) * b[1], silu1(a[2]) * b[2], silu1(a[3]) * b[3]}; }
                *(u32x4*)(H + (size_t)row * ldh + col0) = pack8(h[0], h[1]); }
    }
};

struct EpiNull {
    static constexpr bool PERM = true, AFTER_DRAIN = false;
    bf16_t* D;
    __device__ __forceinline__ void operator()(const f32x4 (&acc)[2][2][4][2], const Unit& u, int wr, int wc, int fr_, int fq_) const {
        int t_ = threadIdx.x; asm volatile("" : "+v"(t_)); const int fr = t_ & 15, fq = (t_ >> 4) & 3; (void)fr_; (void)fq_;
        const int row0 = u.pm * BM + wr * 64 + fr, col0 = u.pn * BM + wc * 32 + 8 * fq;
#pragma unroll
        for (int ai = 0; ai < 2; ++ai)
#pragma unroll
            for (int m = 0; m < 4; ++m)
#pragma unroll
                for (int bj = 0; bj < 2; ++bj) *(u32x4*)(D + (size_t)(row0 + ai * HALF + m * 16) * 1024 + col0 + bj * HALF) = pack8(acc[ai][bj][m][0], acc[ai][bj][m][1]);
    }
};
struct EpiNullWide {
    static constexpr bool PERM = true, AFTER_DRAIN = false;
    bf16_t* D;
    __device__ __forceinline__ void operator()(const f32x4 (&acc)[2][2][4][2], const Unit& u, int wr, int wc, int fr_, int fq_) const {
        int t_ = threadIdx.x; asm volatile("" : "+v"(t_)); const int fr = t_ & 15, fq = (t_ >> 4) & 3; (void)fr_; (void)fq_;
        const int row0 = u.pm * BM + wr * 64 + fr, col0 = u.pn * HALF + wc * 32 + 8 * fq;
#pragma unroll
        for (int ai = 0; ai < 2; ++ai)
#pragma unroll
            for (int m = 0; m < 4; ++m) *(u32x4*)(D + (size_t)(row0 + ai * HALF + m * 16) * 2816 + col0) = pack8(acc[ai][0][m][0] + acc[ai][1][m][0], acc[ai][0][m][1] + acc[ai][1][m][1]);
    }
};
struct EpiZ {
    static constexpr bool PERM = true, AFTER_DRAIN = false;
    ArgsP A;
    __device__ __forceinline__ void operator()(const f32x4 (&acc)[2][2][4][2], const Unit& u, int wr, int wc, int fr_, int fq_) const {
        int t_ = threadIdx.x; asm volatile("" : "+v"(t_)); const int fr = t_ & 15, fq = (t_ >> 4) & 3; (void)fr_; (void)fq_;
        const int row0 = u.pm * BM + wr * 64 + fr, col0 = u.pn * BM + wc * 32 + 8 * fq;
        ArgsP a_ = A; asm volatile("" : "+s"(a_)); unsigned char* ws_ = a_->ws; bf16_t* Z = (bf16_t*)(ws_ + WS_AM); const float* rowss = (const float*)(ws_ + WS_PART) + (size_t)16 * RS_M;
        float rr[2][4];
#pragma unroll
        for (int ai = 0; ai < 2; ++ai) {
#pragma unroll
            for (int m = 0; m < 4; ++m) rr[ai][m] = __builtin_amdgcn_rsqf(row_total(rowss, row0 + ai * HALF + m * 16, fq) * (1.0f / 1024.0f) + 1e-6f);
            asm volatile("" ::: "memory"); }
#pragma unroll
        for (int ai = 0; ai < 2; ++ai)
#pragma unroll
            for (int m = 0; m < 4; ++m)
#pragma unroll
                for (int bj = 0; bj < 2; ++bj) *(u32x4*)(Z + (size_t)(row0 + ai * HALF + m * 16) * 1024 + col0 + bj * HALF) = pack8(acc[ai][bj][m][0] * rr[ai][m], acc[ai][bj][m][1] * rr[ai][m]);
    }
};

template <class Epi, class Sched, bool ALIGN_EPI = false, bool SP2 = false>
__device__ __forceinline__ void gemm_phase(PG8_LAS unsigned char* lds, const Gemm g, const Sched& S, const Epi& E) {
    int tid_ = threadIdx.x; asm volatile("" : "+v"(tid_));
    const int tid = tid_, wid = __builtin_amdgcn_readfirstlane(tid >> 6), lane = tid & 63, wr = wid >> 2, wc = wid & 3, fr = lane & 15, fq = lane >> 4;
    const int K = g.K, nt = K / BK;
    unsigned voffA[2], voffB[2];
#pragma unroll
    for (int i = 0; i < 2; ++i) { int R, C; stage_rc(tid * 16 + i * 8192, R, C); const int Rb = Epi::PERM ? ((R & ~31) + perm32(R & 31)) : R;
        voffA[i] = (unsigned)(R * g.lda + C) * 2u; voffB[i] = (unsigned)(Rb * K + C) * 2u; }
    const size_t kstep = (size_t)(BK * 2);
    const size_t hsA = (size_t)HALF * g.lda * 2, hsB = (size_t)HALF * K * 2;
    const size_t tsA = 2 * hsA, tsB = 2 * hsB;
    const unsigned ldsw = (unsigned)wid * 1024u;
    const int aoff = lds_byte(wr * 64 + fr, fq * 8), boff = lds_byte(wc * 32 + fr, fq * 8);
#define PG8_SA(b, h) (((b) * 2 + (h)) * HTB)
#define PG8_SB(b, h) ((4 + (b) * 2 + (h)) * HTB)
#define PG8_STAGE(bufoff, gbase, voff) do { _Pragma("unroll") for (int _i = 0; _i < 2; ++_i) \
        __builtin_amdgcn_global_load_lds((const unsigned*)((const char*)(gbase) + (voff)[_i]), (PG8_LAS unsigned*)(lds + (bufoff) + ldsw + _i * 8192), 16, 0, 0); } while (0)
#define PG8_LDA(dst, b, h) do { _Pragma("unroll") for (int m = 0; m < 4; ++m) _Pragma("unroll") for (int k = 0; k < 2; ++k) dst[m][k] = *(const PG8_LAS bf16x8*)(lds + PG8_SA(b, h) + aoff + m * 2048 + k * 1024); } while (0)
#define PG8_LDB(dst, b, h) do { _Pragma("unroll") for (int n = 0; n < 2; ++n) _Pragma("unroll") for (int k = 0; k < 2; ++k) dst[n][k] = *(const PG8_LAS bf16x8*)(lds + PG8_SB(b, h) + boff + n * 2048 + k * 1024); } while (0)
#define PG8_MMA(ai, bj, At, Bt) do { __builtin_amdgcn_s_setprio(1); _Pragma("unroll") for (int m = 0; m < 4; ++m) _Pragma("unroll") for (int n = 0; n < 2; ++n) _Pragma("unroll") for (int k = 0; k < 2; ++k) \
        acc[ai][bj][m][n] = __builtin_amdgcn_mfma_f32_16x16x32_bf16(Bt[n][k], At[m][k], acc[ai][bj][m][n], 0, 0, 0); __builtin_amdgcn_s_setprio(0); } while (0)
#define PG8_WAIT_V(n) asm volatile("s_waitcnt vmcnt(" #n ")" ::: "memory")
#define PG8_WAIT_L(n) asm volatile("s_waitcnt lgkmcnt(" #n ")" ::: "memory")
#define PG8_BAR __builtin_amdgcn_s_barrier()
#define PG8_SCHED __builtin_amdgcn_sched_barrier(0)
    Unit cur, nxt; int ui = 0;
    if (!S.next(0, cur)) return;
    f32x4 acc[2][2][4][2];
#pragma unroll
    for (int a = 0; a < 2; ++a)
#pragma unroll
        for (int b = 0; b < 2; ++b)
#pragma unroll
            for (int m = 0; m < 4; ++m)
#pragma unroll
                for (int n = 0; n < 2; ++n) acc[a][b][m][n] = (f32x4){0.f, 0.f, 0.f, 0.f};
    bf16x8 At[4][2], B0[2][2], B1[2][2];
    const char* cA = (const char*)g.A + (size_t)cur.pm * tsA + (size_t)cur.pn * g.a_pn_bytes; const char* cB = (const char*)g.Bt + (size_t)cur.pn * tsB + (size_t)(cur.pm >> 4) * g.b_batch_bytes;
    S.a_ready(cur);
    if constexpr (SP2) {
        PG8_STAGE(PG8_SB(0, 0), cB, voffB); PG8_STAGE(PG8_SB(0, 1), cB + hsB, voffB); PG8_STAGE(PG8_SA(0, 0), cA, voffA); PG8_STAGE(PG8_SA(0, 1), cA + hsA, voffA);
        if (wr == 1) PG8_BAR;
        PG8_WAIT_V(2); PG8_BAR;
        PG8_STAGE(PG8_SB(1, 0), cB + kstep, voffB); PG8_STAGE(PG8_SA(1, 0), cA + kstep, voffA); PG8_STAGE(PG8_SB(1, 1), cB + hsB + kstep, voffB);
        PG8_WAIT_V(6); PG8_BAR;
    } else {
        PG8_STAGE(PG8_SB(0, 0), cB, voffB); PG8_STAGE(PG8_SA(0, 0), cA, voffA); PG8_STAGE(PG8_SB(0, 1), cB + hsB, voffB); PG8_STAGE(PG8_SA(0, 1), cA + hsA, voffA);
        if (wr == 1) PG8_BAR;
        PG8_WAIT_V(4); PG8_BAR;
        PG8_STAGE(PG8_SB(1, 0), cB + kstep, voffB); PG8_STAGE(PG8_SA(1, 0), cA + kstep, voffA); PG8_STAGE(PG8_SB(1, 1), cB + hsB + kstep, voffB);
        PG8_WAIT_V(6); PG8_BAR;
    }
    for (;;) {
        const bool has_next = S.next(ui + 1, nxt);
        const char* nA = has_next ? (const char*)g.A + (size_t)nxt.pm * tsA + (size_t)nxt.pn * g.a_pn_bytes : cA; const char* nB = has_next ? (const char*)g.Bt + (size_t)nxt.pn * tsB + (size_t)(nxt.pm >> 4) * g.b_batch_bytes : cB;
#pragma unroll 1
        for (int t = 0; t < nt; t += 2) {
            const bool last = (t == nt - 2);
            const char* a1 = cA + (size_t)(t + 1) * kstep;
            const char* a2 = last ? nA : cA + (size_t)(t + 2) * kstep; const char* b2 = last ? nB : cB + (size_t)(t + 2) * kstep;
            const char* a3 = a2 + kstep; const char* b3 = b2 + kstep;
            if (last && has_next) S.a_ready(nxt);
            if constexpr (SP2) {
            PG8_LDB(B0, 0, 0); PG8_LDB(B1, 0, 1); PG8_SCHED; PG8_LDA(At, 0, 0); PG8_STAGE(PG8_SA(1, 1), a1 + hsA, voffA);
            PG8_WAIT_V(8); PG8_WAIT_L(0); PG8_BAR; PG8_MMA(0, 0, At, B0); PG8_MMA(0, 1, At, B1); PG8_BAR; PG8_SCHED;
            PG8_LDA(At, 0, 1); PG8_STAGE(PG8_SB(0, 0), b2, voffB); PG8_STAGE(PG8_SB(0, 1), b2 + hsB, voffB); PG8_STAGE(PG8_SA(0, 0), a2, voffA);
            PG8_WAIT_V(8); PG8_WAIT_L(0); PG8_BAR; PG8_MMA(1, 0, At, B0); PG8_MMA(1, 1, At, B1); PG8_BAR; PG8_SCHED;
            PG8_LDB(B0, 1, 0); PG8_LDB(B1, 1, 1); PG8_SCHED; PG8_LDA(At, 1, 0); PG8_STAGE(PG8_SA(0, 1), a2 + hsA, voffA);
            PG8_WAIT_V(8); PG8_WAIT_L(0); PG8_BAR; PG8_MMA(0, 0, At, B0); PG8_MMA(0, 1, At, B1); PG8_BAR; PG8_SCHED;
            PG8_LDA(At, 1, 1); PG8_STAGE(PG8_SB(1, 0), b3, voffB); PG8_STAGE(PG8_SB(1, 1), b3 + hsB, voffB); PG8_STAGE(PG8_SA(1, 0), a3, voffA);
            PG8_WAIT_V(8); PG8_WAIT_L(0); PG8_BAR; PG8_MMA(1, 0, At, B0); PG8_MMA(1, 1, At, B1); PG8_BAR; PG8_SCHED;
            } else {
            PG8_LDB(B0, 0, 0); PG8_SCHED; PG8_LDA(At, 0, 0); PG8_STAGE(PG8_SA(1, 1), a1 + hsA, voffA);
            PG8_WAIT_L(8); PG8_BAR; PG8_WAIT_L(0); PG8_MMA(0, 0, At, B0); PG8_BAR; PG8_SCHED;
            PG8_LDB(B1, 0, 1); PG8_STAGE(PG8_SB(0, 0), b2, voffB);
            PG8_BAR; PG8_WAIT_L(0); PG8_MMA(0, 1, At, B1); PG8_BAR;
            PG8_LDA(At, 0, 1); PG8_STAGE(PG8_SA(0, 0), a2, voffA);
            PG8_BAR; PG8_WAIT_L(0); PG8_MMA(1, 0, At, B0); PG8_BAR; PG8_SCHED;
            PG8_STAGE(PG8_SB(0, 1), b2 + hsB, voffB);
            PG8_WAIT_V(6); PG8_BAR; PG8_MMA(1, 1, At, B1); PG8_BAR;
            PG8_LDB(B0, 1, 0); PG8_SCHED; PG8_LDA(At, 1, 0); PG8_STAGE(PG8_SA(0, 1), a2 + hsA, voffA);
            PG8_WAIT_L(8); PG8_BAR; PG8_WAIT_L(0); PG8_MMA(0, 0, At, B0); PG8_BAR; PG8_SCHED;
            PG8_LDB(B1, 1, 1); PG8_STAGE(PG8_SB(1, 0), b3, voffB);
            PG8_BAR; PG8_WAIT_L(0); PG8_MMA(0, 1, At, B1); PG8_BAR;
            PG8_LDA(At, 1, 1); PG8_STAGE(PG8_SA(1, 0), a3, voffA);
            PG8_BAR; PG8_WAIT_L(0); PG8_MMA(1, 0, At, B0); PG8_BAR; PG8_SCHED;
            PG8_STAGE(PG8_SB(1, 1), b3 + hsB, voffB);
            PG8_WAIT_V(6); PG8_BAR; PG8_MMA(1, 1, At, B1); PG8_BAR;
            }
        }
        if constexpr (ALIGN_EPI) { if (wr == 0) PG8_BAR; }
        if constexpr (!Epi::AFTER_DRAIN) { E(acc, cur, wr, wc, fr, fq); S.done(cur); }
        if (!has_next) break;
#pragma unroll
        for (int a = 0; a < 2; ++a)
#pragma unroll
            for (int b = 0; b < 2; ++b)
#pragma unroll
                for (int m = 0; m < 4; ++m)
#pragma unroll
                    for (int n = 0; n < 2; ++n) acc[a][b][m][n] = (f32x4){0.f, 0.f, 0.f, 0.f};
        cur = nxt; cA = nA; cB = nB; ++ui;
        if constexpr (ALIGN_EPI) { if (wr == 1) PG8_BAR; }
    }
    PG8_WAIT_V(0);
    if constexpr (!ALIGN_EPI) { if (wr == 0) PG8_BAR; }
    PG8_BAR;
    if constexpr (Epi::AFTER_DRAIN) { E.fused(acc, cur, wr, wc, fr, fq, lds, wid, lane); S.done(cur); }
#undef PG8_SA
#undef PG8_SB
#undef PG8_STAGE
#undef PG8_LDA
#undef PG8_LDB
#undef PG8_MMA
#undef PG8_WAIT_V
#undef PG8_WAIT_L
#undef PG8_BAR
#undef PG8_SCHED
}
}
namespace attn_body {
using bf16=__hip_bfloat16;
using bf16x8=__attribute__((ext_vector_type(8)))short;
using s16x4=__attribute__((ext_vector_type(4)))short;
using f32x16=__attribute__((ext_vector_type(16)))float;
using u32x4=__attribute__((ext_vector_type(4)))unsigned;
constexpr int BATCH=8,NHEAD=8,NKVH=2,SEQ=4096,SKV=4352,D=64,QP=512,KP=128,OP=1024;
constexpr int NW=8,QBLK=32,QB=QBLK*NW,KVBLK=64,NQB=SEQ/QB;
constexpr int ATTN_UNIT_ROWS=QB;
__device__ __forceinline__ int crow(int r,int hi){return (r&3)+8*(r>>2)+4*hi;}
#define SBAR() __builtin_amdgcn_sched_barrier(0)
constexpr int NSLOT=3, SLOTB=8192;
constexpr int LDS_K=0, LDS_V=NSLOT*SLOTB, LDS_WS=2*NSLOT*SLOTB, LDS_OST=LDS_WS+NW*64*4, LDS_BYTES=LDS_OST+NW*4096;
constexpr float C2=0.125f*1.4426950408889634f;
__device__ __forceinline__ void glds16(const void*gsrc,unsigned lds_dst){unsigned keep;
  asm volatile("s_mov_b32 %0, m0\n\ts_mov_b32 m0, %2\n\ts_nop 0\n\tglobal_load_lds_dwordx4 %1, off\n\ts_mov_b32 m0, %0":"=&s"(keep):"v"(gsrc),"s"(lds_dst):"memory");}
__device__ __forceinline__ void glds16_nt(const void*gsrc,unsigned lds_dst){unsigned keep;
  asm volatile("s_mov_b32 %0, m0\n\ts_mov_b32 m0, %2\n\ts_nop 0\n\tglobal_load_lds_dwordx4 %1, off nt\n\ts_mov_b32 m0, %0":"=&s"(keep):"v"(gsrc),"s"(lds_dst):"memory");}
__device__ __forceinline__ float max3f(float a,float b,float c){float r;asm("v_max3_f32 %0, %1, %2, %3":"=v"(r):"v"(a),"v"(b),"v"(c));return r;}
__device__ __forceinline__ float max2f(float a,float b){float r;asm("v_max_f32_e32 %0, %1, %2":"=v"(r):"v"(a),"v"(b));return r;}
__device__ __forceinline__ float fadd_s(float a,float b){float r;asm("v_add_f32_e32 %0, %1, %2":"=v"(r):"v"(a),"v"(b));return r;}
__device__ __forceinline__ float fsub_s(float a,float b){float r;asm("v_sub_f32_e32 %0, %1, %2":"=v"(r):"v"(a),"v"(b));return r;}
typedef float f32x2_t __attribute__((ext_vector_type(2))); typedef __bf16 bf16x2_t __attribute__((ext_vector_type(2)));
__device__ __forceinline__ unsigned cvtpk_s(float lo,float hi){f32x2_t v={lo,hi};bf16x2_t b=__builtin_convertvector(v,bf16x2_t);return __builtin_bit_cast(unsigned,b);}
#define WAIT_BAR(N) asm volatile("s_waitcnt vmcnt(" #N ") lgkmcnt(0)\n\ts_barrier":::"memory")

__device__ __forceinline__ void qkt(f32x16&p0,f32x16&p1,const char*Kslot,const bf16x8*qr,const f32x16&negm,int r32,int hi){
  const char*kb=Kslot+hi*1024+r32*16;
  #pragma unroll
  for(int d0=0;d0<4;++d0){
    const bf16x8 b0=*reinterpret_cast<const bf16x8*>(kb+d0*2048);
    const bf16x8 b1=*reinterpret_cast<const bf16x8*>(kb+d0*2048+512);
    if(d0==0){p0=__builtin_amdgcn_mfma_f32_32x32x16_bf16(b0,qr[0],negm,0,0,0);p1=__builtin_amdgcn_mfma_f32_32x32x16_bf16(b1,qr[0],negm,0,0,0);}
    else{p0=__builtin_amdgcn_mfma_f32_32x32x16_bf16(b0,qr[d0],p0,0,0,0);p1=__builtin_amdgcn_mfma_f32_32x32x16_bf16(b1,qr[d0],p1,0,0,0);}}
}
typedef __attribute__((address_space(3))) const char* lds_cptr;
typedef short v4i16_t __attribute__((ext_vector_type(4)));
__device__ __forceinline__ void kload8(bf16x8*kf,lds_cptr kp){
  kf[0]=*(const __attribute__((address_space(3))) bf16x8*)(kp);      kf[1]=*(const __attribute__((address_space(3))) bf16x8*)(kp+512);
  kf[2]=*(const __attribute__((address_space(3))) bf16x8*)(kp+2048); kf[3]=*(const __attribute__((address_space(3))) bf16x8*)(kp+2560);
  kf[4]=*(const __attribute__((address_space(3))) bf16x8*)(kp+4096); kf[5]=*(const __attribute__((address_space(3))) bf16x8*)(kp+4608);
  kf[6]=*(const __attribute__((address_space(3))) bf16x8*)(kp+6144); kf[7]=*(const __attribute__((address_space(3))) bf16x8*)(kp+6656);
}
__device__ __forceinline__ void kload2(bf16x8*kf,lds_cptr kp,int j){ kf[2*j]=*(const __attribute__((address_space(3))) bf16x8*)(kp+j*2048); kf[2*j+1]=*(const __attribute__((address_space(3))) bf16x8*)(kp+j*2048+512); }
__device__ __forceinline__ s16x4 vtr(lds_cptr p){ return __builtin_bit_cast(s16x4,__builtin_amdgcn_ds_read_tr16_b64_v4i16((__attribute__((address_space(3))) v4i16_t*)p)); }
__device__ __forceinline__ float rowmax(const f32x16&p0,const f32x16&p1){
  float a=max3f(p0[0],p0[1],p1[0]),b=max3f(p0[2],p0[3],p1[1]);a=max3f(a,p1[2],p1[3]);
  #pragma unroll
  for(int r=4;r<16;r+=4){a=max3f(a,p0[r],p0[r+1]);b=max3f(b,p0[r+2],p0[r+3]);a=max3f(a,p1[r],p1[r+1]);b=max3f(b,p1[r+2],p1[r+3]);}
  const float m=max2f(a,b);
  auto rr=__builtin_amdgcn_permlane32_swap(__float_as_uint(m),__float_as_uint(m),false,false);
  return max2f(__uint_as_float(rr[0]),__uint_as_float(rr[1]));
}
__device__ __forceinline__ void pv(f32x16*o,int vb,bf16x8 pa0,bf16x8 pa1,bf16x8 pa2,bf16x8 pa3){
  #pragma unroll
  for(int d0=0;d0<2;++d0){s16x4 lo[4],hi[4];
    #pragma unroll
    for(int ks=0;ks<4;++ks){
      asm volatile("ds_read_b64_tr_b16 %0,%1 offset:%c2":"=&v"(lo[ks]):"v"(vb),"i"(d0*4096+ks*1024):"memory");
      asm volatile("ds_read_b64_tr_b16 %0,%1 offset:%c2":"=&v"(hi[ks]):"v"(vb),"i"(d0*4096+ks*1024+512):"memory");}
    asm volatile("s_waitcnt lgkmcnt(0)":::"memory");SBAR();
    #define PK(k) (bf16x8){lo[k][0],lo[k][1],lo[k][2],lo[k][3],hi[k][0],hi[k][1],hi[k][2],hi[k][3]}
    o[d0]=__builtin_amdgcn_mfma_f32_32x32x16_bf16(pa0,PK(0),o[d0],0,0,0);
    o[d0]=__builtin_amdgcn_mfma_f32_32x32x16_bf16(pa1,PK(1),o[d0],0,0,0);
    o[d0]=__builtin_amdgcn_mfma_f32_32x32x16_bf16(pa2,PK(2),o[d0],0,0,0);
    o[d0]=__builtin_amdgcn_mfma_f32_32x32x16_bf16(pa3,PK(3),o[d0],0,0,0);
    #undef PK
  }
}

#ifndef ATTN_STORE16
#define ATTN_STORE16(p,v) (*(u32x4*)(p)=(v))
#endif
template<int THRL,bool FIX> __device__ __forceinline__ void attn_unit(int b,int h,int qb,const bf16*Q,const bf16*__restrict__ K,const bf16*__restrict__ V,bf16*O,char*shm,float sref){
  int tid_=threadIdx.x; asm volatile("":"+v"(tid_)); const int tid=tid_,lane=tid&63,r32=lane&31,hi=lane>>5; const int wid=__builtin_amdgcn_readfirstlane(tid>>6);
  const long rowbase=(long)b*SEQ, kvbase=(long)b*SKV; const int q0=qb*QB;
  const bf16*Qw=Q+(rowbase+q0+wid*QBLK)*QP+h*D;
  const bf16*Kh=K+kvbase*KP+(h/(NHEAD/NKVH))*D,*Vh=V+kvbase*KP+(h/(NHEAD/NKVH))*D;
  const unsigned lds0=(unsigned)(uintptr_t)shm;
  float*wsf=(float*)(shm+LDS_WS)+wid*64;
  const bf16*ksrc=Kh+(long)lane*KP+wid*8;
  const bf16*vsrc=Vh+(long)(16*(wid&3)+(lane>>2))*KP+(wid>>2)*32+(lane&3)*8;
  const unsigned kdst=lds0+LDS_K+wid*1024, vdst=lds0+LDS_V+wid*1024;
  #define DMA_K(t,slot) glds16(ksrc+(long)(t)*KVBLK*KP,(unsigned)__builtin_amdgcn_readfirstlane(kdst+(slot)))
  #define DMA_V(t,slot) glds16(vsrc+(long)(t)*KVBLK*KP,(unsigned)__builtin_amdgcn_readfirstlane(vdst+(slot)))
  const int vb0=(int)(lds0+LDS_V)+((lane>>4)&1)*32+(lane&3)*8+(4*hi+((lane&15)>>2))*64;
  const char*Kbase=shm+LDS_K; bf16x8 kf[8];
  const lds_cptr shm3=(lds_cptr)shm; const lds_cptr kp0=shm3+LDS_K+hi*1024+r32*16; const lds_cptr vp0=shm3+LDS_V+((lane>>4)&1)*32+(lane&3)*8+(4*hi+((lane&15)>>2))*64;
  constexpr int NT=SKV/KVBLK;
  DMA_K(0,0);DMA_V(0,0);DMA_K(1,SLOTB);
  bf16x8 qr[4];
  #pragma unroll
  for(int d0=0;d0<4;++d0)qr[d0]=__builtin_nontemporal_load(reinterpret_cast<const bf16x8*>(&Qw[(long)r32*QP+d0*16+hi*8]));
  float mhat=0.f,l_reg=0.f;f32x16 o[2];o[0]=f32x16{};o[1]=f32x16{};f32x16 negm=f32x16{};
  if constexpr(FIX){ _Pragma("unroll") for(int r=0;r<16;++r)negm[r]=-sref; }
  asm volatile("":"+v"(negm));
  #define CMASK(P0,P1,t) do{}while(0)
  bool resc=false;
  #define START(P0,P1) do{ resc=false; if constexpr(!FIX) \
    { const float rm=rowmax(P0,P1); const float dl=rm; mhat=fadd_s(mhat,dl); \
      _Pragma("unroll") for(int r=0;r<16;++r){P0[r]=fsub_s(P0[r],dl);P1[r]=fsub_s(P1[r],dl);} \
      _Pragma("unroll") for(int r=0;r<16;++r)negm[r]=-mhat; asm volatile("":"+v"(negm)); } \
    _Pragma("unroll") for(int r=0;r<16;++r)P0[r]=__builtin_amdgcn_exp2f(P0[r]); }while(0)
  #define RESC() do{ if constexpr(!FIX) if(resc){ asm volatile("s_waitcnt lgkmcnt(0)":::"memory"); \
      _Pragma("unroll") for(int d_=0;d_<2;++d_) _Pragma("unroll") for(int r=0;r<16;++r)o[d_][r]*=wsf[crow(r,hi)]; } }while(0)
  f32x16 pA0,pA1,pB0,pB1;
  int sl_prev=0,sl_cur=0,sl_next=SLOTB;
  #define ROT() do{sl_prev=sl_cur;sl_cur=sl_next;sl_next=(sl_next==(NSLOT-1)*SLOTB)?0:sl_next+SLOTB;}while(0)
  DMA_K(2,2*SLOTB);
  WAIT_BAR(3);
  qkt(pA0,pA1,Kbase,qr,negm,r32,hi);asm volatile("s_nop 15\n\ts_nop 7":"+v"(pA0),"+v"(pA1));CMASK(pA0,pA1,0);
  START(pA0,pA1);
  _Pragma("unroll") for(int r=0;r<16;++r)pA1[r]=__builtin_amdgcn_exp2f(pA1[r]);
  WAIT_BAR(0);
  DMA_K(3,0);DMA_V(1,SLOTB);
  ROT();
  kload8(kf,kp0+sl_cur);
  WAIT_BAR(2);
  s16x4 vlo[8],vhi[8]; u32x4 pw0,pw1,pw2,pw3;
  #define PKW(P,B) cvtpk_s(P[B],P[B+1])
  #define PAF(k) __builtin_bit_cast(bf16x8,pw##k)
  #define VFR(i) (bf16x8){vlo[i][0],vlo[i][1],vlo[i][2],vlo[i][3],vhi[i][0],vhi[i][1],vhi[i][2],vhi[i][3]}
  #define PIN(x) asm volatile("":"+v"(x))
  #define MX3(a,b,c) __builtin_fmaxf(__builtin_fmaxf((a),(b)),(c))
  #define GAPA(MF,A0,A1,A2,A3,W0,W1,PW) do{ MF; sacc+=A0; sacc+=A1; sacc+=A2; sacc+=A3; PIN(sacc); W0; W1; PIN(PW); SBAR(); }while(0)
  #define EX(v) __builtin_amdgcn_exp2f(v)
  #define GAPB(MF,X,B) do{ MF; X[B]=EX(X[B]); X[B+1]=EX(X[B+1]); X[B+2]=EX(X[B+2]); X[B+3]=EX(X[B+3]); PIN(X); SBAR(); }while(0)
  #define VRD(i) do{ vlo[i]=vtr(vp_+(((i)>>2)*4096+((i)&3)*1024)); vhi[i]=vtr(vp_+(((i)>>2)*4096+((i)&3)*1024+512)); }while(0)
  #define KRD(G,j) do{ if(G){ kload2(kf,kp0+sl_next,j); SBAR(); } }while(0)
  #define STEP(C0,C1,P0,P1,t,GK,GV,GL) do{ SBAR(); \
    const lds_cptr vp_=vp0+sl_prev; \
    VRD(0); SBAR(); float sacc=(P0[0]+P0[1]); \
    GAPA(C0=__builtin_amdgcn_mfma_f32_32x32x16_bf16(kf[0],qr[0],negm,0,0,0), P0[2],P0[3],P0[4],P0[5],     pw0[0]=PKW(P0,0), pw0[1]=PKW(P0,2), pw0); \
    VRD(4); SBAR(); GAPA(C1=__builtin_amdgcn_mfma_f32_32x32x16_bf16(kf[1],qr[0],negm,0,0,0), P0[6],P0[7],P0[8],P0[9],     pw0[2]=PKW(P0,4), pw0[3]=PKW(P0,6), pw0); \
    VRD(1); SBAR(); GAPA(C0=__builtin_amdgcn_mfma_f32_32x32x16_bf16(kf[2],qr[1],C0,0,0,0),   P0[10],P0[11],P0[12],P0[13], pw1[0]=PKW(P0,8), pw1[1]=PKW(P0,10), pw1); \
    VRD(5); SBAR(); GAPA(C1=__builtin_amdgcn_mfma_f32_32x32x16_bf16(kf[3],qr[1],C1,0,0,0),   P0[14],P0[15],P1[0],P1[1],   pw1[2]=PKW(P0,12),pw1[3]=PKW(P0,14), pw1); \
    VRD(2); SBAR(); GAPA(C0=__builtin_amdgcn_mfma_f32_32x32x16_bf16(kf[4],qr[2],C0,0,0,0),   P1[2],P1[3],P1[4],P1[5],     pw2[0]=PKW(P1,0), pw2[1]=PKW(P1,2), pw2); \
    VRD(6); SBAR(); GAPA(C1=__builtin_amdgcn_mfma_f32_32x32x16_bf16(kf[5],qr[2],C1,0,0,0),   P1[6],P1[7],P1[8],P1[9],     pw2[2]=PKW(P1,4), pw2[3]=PKW(P1,6), pw2); \
    VRD(3); SBAR(); GAPA(C0=__builtin_amdgcn_mfma_f32_32x32x16_bf16(kf[6],qr[3],C0,0,0,0),   P1[10],P1[11],P1[12],P1[13], pw3[0]=PKW(P1,8), pw3[1]=PKW(P1,10), pw3); \
    VRD(7); SBAR(); GAPA(C1=__builtin_amdgcn_mfma_f32_32x32x16_bf16(kf[7],qr[3],C1,0,0,0),   P1[14],P1[15],0.f,0.f,       pw3[2]=PKW(P1,12),pw3[3]=PKW(P1,14), pw3); \
    l_reg+=sacc; \
    if(GK){DMA_K((t)+3,sl_cur);} if(GV){DMA_V((t)+1,sl_next);} \
    CMASK(C0,C1,t); \
    if constexpr(!FIX) { float a=MX3(C0[0],C0[1],C1[0]),b=MX3(C0[2],C0[3],C1[1]); a=MX3(a,C1[2],C1[3]); \
      _Pragma("unroll") for(int r=4;r<16;r+=4){a=MX3(a,C0[r],C0[r+1]);b=MX3(b,C0[r+2],C0[r+3]);a=MX3(a,C1[r],C1[r+1]);b=MX3(b,C1[r+2],C1[r+3]);} \
      float rm=__builtin_fmaxf(a,b); { auto rr=__builtin_amdgcn_permlane32_swap(__float_as_uint(rm),__float_as_uint(rm),false,false); rm=__builtin_fmaxf(__uint_as_float(rr[0]),__uint_as_float(rr[1])); } \
      resc=false; \
      if(__builtin_expect(__any(rm>(float)THRL),0)){ const float dl=__builtin_fmaxf(rm,0.f); mhat+=dl; \
        _Pragma("unroll") for(int r=0;r<16;++r){C0[r]-=dl;C1[r]-=dl;} \
        _Pragma("unroll") for(int r=0;r<16;++r)negm[r]=-mhat; asm volatile("":"+v"(negm)); \
        const float f=__builtin_amdgcn_exp2f(-dl); l_reg*=f; if(hi==0)wsf[r32]=f; resc=true; } } \
    SBAR(); \
    GAPB(o[0]=__builtin_amdgcn_mfma_f32_32x32x16_bf16(PAF(0),VFR(0),o[0],0,0,0), C0,0); \
    GAPB(o[1]=__builtin_amdgcn_mfma_f32_32x32x16_bf16(PAF(0),VFR(4),o[1],0,0,0), C0,4); \
    KRD(GL,0); GAPB(o[0]=__builtin_amdgcn_mfma_f32_32x32x16_bf16(PAF(1),VFR(1),o[0],0,0,0), C0,8); \
    KRD(GL,1); GAPB(o[1]=__builtin_amdgcn_mfma_f32_32x32x16_bf16(PAF(1),VFR(5),o[1],0,0,0), C0,12); \
    KRD(GL,2); GAPB(o[0]=__builtin_amdgcn_mfma_f32_32x32x16_bf16(PAF(2),VFR(2),o[0],0,0,0), C1,0); \
    KRD(GL,3); GAPB(o[1]=__builtin_amdgcn_mfma_f32_32x32x16_bf16(PAF(2),VFR(6),o[1],0,0,0), C1,4); \
    GAPB(o[0]=__builtin_amdgcn_mfma_f32_32x32x16_bf16(PAF(3),VFR(3),o[0],0,0,0), C1,8); \
    GAPB(o[1]=__builtin_amdgcn_mfma_f32_32x32x16_bf16(PAF(3),VFR(7),o[1],0,0,0), C1,12); \
    }while(0)
  int t=1;
  #undef CMASK
  #define CMASK(P0,P1,t) do{}while(0)
  for(;t+5<NT;t+=2){
    STEP(pB0,pB1,pA0,pA1,t,true,true,true);     WAIT_BAR(2); RESC(); ROT();
    STEP(pA0,pA1,pB0,pB1,t+1,true,true,true);   WAIT_BAR(2); RESC(); ROT();
  }
  #undef CMASK
  #define CMASK(P0,P1,t) do{}while(0)
  #define ENDW(tt) do{ if((tt)+3<NT){WAIT_BAR(2);} else if((tt)+2<NT){WAIT_BAR(1);} else {WAIT_BAR(0);} }while(0)
  for(;t+1<NT;t+=2){
    STEP(pB0,pB1,pA0,pA1,t,(t+3<NT),(t+1<NT),(t+1<NT));       ENDW(t);   RESC(); ROT();
    STEP(pA0,pA1,pB0,pB1,t+1,(t+4<NT),(t+2<NT),(t+2<NT));     ENDW(t+1); RESC(); ROT();
  }
  STEP(pB0,pB1,pA0,pA1,NT-1,false,false,false); RESC();
  { float sacc=pB0[0]+pB0[1]; _Pragma("unroll") for(int r=2;r<16;++r)sacc+=pB0[r]; _Pragma("unroll") for(int r=0;r<16;++r)sacc+=pB1[r]; l_reg+=sacc;
    pw0=(u32x4){PKW(pB0,0),PKW(pB0,2),PKW(pB0,4),PKW(pB0,6)};pw1=(u32x4){PKW(pB0,8),PKW(pB0,10),PKW(pB0,12),PKW(pB0,14)};pw2=(u32x4){PKW(pB1,0),PKW(pB1,2),PKW(pB1,4),PKW(pB1,6)};pw3=(u32x4){PKW(pB1,8),PKW(pB1,10),PKW(pB1,12),PKW(pB1,14)};
    SBAR(); pv(o,vb0+sl_cur,PAF(0),PAF(1),PAF(2),PAF(3)); }
  #undef PKW
  #undef PAF
  #undef VFR
  #undef PIN
  #undef MX3
  #undef GAPA
  #undef GAPB
  #undef EX
  #undef VRD
  #undef KRD
  #undef STEP
  #undef ENDW
  {auto rr=__builtin_amdgcn_permlane32_swap(__float_as_uint(l_reg),__float_as_uint(l_reg),false,false);l_reg=__uint_as_float(rr[0])+__uint_as_float(rr[1]);}
  if(hi==0)wsf[32+r32]=l_reg;asm volatile("s_waitcnt lgkmcnt(0)":::"memory");
  float rli[16];
  #pragma unroll
  for(int r=0;r<16;++r)rli[r]=__builtin_amdgcn_rcpf(wsf[32+crow(r,hi)]);
  bf16*Ow=O+(rowbase+q0+wid*QBLK)*OP+h*D;
  { bf16*stg=(bf16*)(shm+LDS_OST)+wid*2048;
    #pragma unroll
    for(int r=0;r<16;++r){const int orow=crow(r,hi);
      #pragma unroll
      for(int d0=0;d0<2;++d0)stg[orow*64+d0*32+r32]=__float2bfloat16(o[d0][r]*rli[r]);}
    asm volatile("s_waitcnt lgkmcnt(0)":::"memory");
    #pragma unroll
    for(int i=0;i<4;++i){const int row=i*8+(lane>>3),ch=lane&7; const u32x4 v=*(const u32x4*)(stg+row*64+ch*8); ATTN_STORE16(Ow+(long)row*OP+ch*8,v);} }
  asm volatile("s_waitcnt lgkmcnt(0)\n\ts_barrier":::"memory");
  #undef DMA_K
  #undef DMA_V
  #undef CMASK
  #undef START
  #undef RESC
  #undef ROT
}
constexpr int ATTN_LDS_BYTES=LDS_BYTES;
struct AttnTensors { const bf16* Q; const bf16* K; const bf16* V; bf16* O; };
struct AttnUnit { int bh; int qb; };
struct StaticOrder {
  int vcu,G;
  __device__ __forceinline__ explicit StaticOrder(int grid,int v):vcu(v),G(grid){}
  __device__ __forceinline__ bool next(int i,AttnUnit&u)const{ const int per=(BATCH*NHEAD*NQB)/G; if(i>=per)return false; const int x=vcu*per+i; u.bh=(x>>6)*4+((x&63)>>4); u.qb=x&15; return true; }
  __device__ __forceinline__ void a_ready(const AttnUnit&)const{}
  __device__ __forceinline__ void done(const AttnUnit&)const{}
};
template<class Sched,int THRL=8> __device__ __forceinline__ void attn_phase(char*lds,const AttnTensors&T,const Sched&S,const float*qnw,const float*knw){
  AttnUnit u;
  float mq=__builtin_fabsf(qnw[threadIdx.x&63]),mk=__builtin_fabsf(knw[threadIdx.x&63]);
  _Pragma("unroll") for(int o_=1;o_<64;o_<<=1){ mq=__builtin_fmaxf(mq,__shfl_xor(mq,o_)); mk=__builtin_fmaxf(mk,__shfl_xor(mk,o_)); }
  const float sref=C2*64.0f*1.02f*mq*mk;
  const bool fix=__builtin_amdgcn_readfirstlane((int)(sref<=40.0f && sref==sref))!=0;
  if(fix){ for(int i=0;S.next(i,u);++i){ S.a_ready(u); attn_unit<THRL,true>(u.bh/NHEAD,u.bh%NHEAD,u.qb,T.Q,T.K,T.V,T.O,lds,sref); S.done(u); } }
  else   { for(int i=0;S.next(i,u);++i){ S.a_ready(u); attn_unit<THRL,false>(u.bh/NHEAD,u.bh%NHEAD,u.qb,T.Q,T.K,T.V,T.O,lds,0.f); S.done(u); } }
}
#undef SBAR
#undef WAIT_BAR
}
#ifndef PG8_SP2
#define PG8_SP2 true
#endif
#ifndef PG8_ALIGN
#define PG8_ALIGN true
#endif
#define GAS __attribute__((address_space(1)))
#define LAS __attribute__((address_space(3)))
typedef unsigned short bf16;
typedef unsigned v4u __attribute__((ext_vector_type(4)));
typedef unsigned v2u __attribute__((ext_vector_type(2)));
typedef float f32x4 __attribute__((ext_vector_type(4)));
typedef float f32x2 __attribute__((ext_vector_type(2)));
typedef short bf16x8 __attribute__((ext_vector_type(8)));
typedef GAS unsigned gu32;
typedef GAS unsigned long long gu64;
#define RLX_AGENT __ATOMIC_RELAXED, __HIP_MEMORY_SCOPE_AGENT
#define LDS_WAIT() asm volatile("s_waitcnt lgkmcnt(0)" ::: "memory")
#define VM_WAIT() asm volatile("s_waitcnt vmcnt(0)" ::: "memory")
__device__ __forceinline__ unsigned f2bf(float f) { unsigned u = __builtin_bit_cast(unsigned, f); return (u + 0x7fffu + ((u >> 16) & 1u)) >> 16; }
__device__ __forceinline__ unsigned pk2(float lo, float hi) { unsigned r; asm("v_cvt_pk_bf16_f32 %0, %1, %2" : "=v"(r) : "v"(lo), "v"(hi)); return r; }
__device__ __forceinline__ float bf2f(unsigned h) { return __builtin_bit_cast(float, h << 16); }

#define XB_TMO      128
#define XB_XCNT(j)  (256  + 64 * (j))
#define XB_XSUB(j)  (1280 + 64 * (j))
#define XB_XGEN(j)  (2304 + 64 * (j))
#define XB_TOP      3328
#define XB_TOPGEN   3392
#define XCD_BAR_WORDS 3456
#define XB_SPIN_CAP (1u << 18)

__device__ __forceinline__ unsigned xb_ld(unsigned* p)              { return __hip_atomic_load(p, __ATOMIC_RELAXED, __HIP_MEMORY_SCOPE_AGENT); }
__device__ __forceinline__ unsigned xb_add(unsigned* p, unsigned v) { return __hip_atomic_fetch_add(p, v, __ATOMIC_RELAXED, __HIP_MEMORY_SCOPE_AGENT); }
__device__ __forceinline__ unsigned xb_xcc_id() { return (unsigned)__builtin_amdgcn_s_getreg((3 << 11) | 20) & 0xFu; }
#define XB_SPIN(cond, bar) do { unsigned _sp = 0; while (cond) { __builtin_amdgcn_s_sleep(1); \
    if ((++_sp & 255u) == 0u) { if (xb_ld(&(bar)[XB_TMO])) break; if (_sp > XB_SPIN_CAP) { atomicAdd(&(bar)[XB_TMO], 1u); break; } } } } while (0)

struct XcdBarrier {
    unsigned* bar; unsigned x;
    volatile LAS unsigned* st;
};

__device__ __forceinline__ XcdBarrier xcd_barrier_post(unsigned* bar, volatile LAS unsigned* st) {
    XcdBarrier b; b.bar = bar; b.x = xb_xcc_id(); b.st = st;
    if (threadIdx.x == 0) (void)xb_add(&bar[XB_XCNT(b.x)], 1u);
    return b;
}
__device__ __forceinline__ void xcd_barrier_complete(unsigned* bar, unsigned x, unsigned& nloc, unsigned& nx) {
    const unsigned G = gridDim.x * gridDim.y * gridDim.z;
    unsigned sum, cnt, mine, sp = 0u;
    for (;;) {
        sum = 0u; cnt = 0u; mine = 0u;
#pragma unroll
        for (unsigned j = 0; j < 16; ++j) { const unsigned c = xb_ld(&bar[XB_XCNT(j)]); sum += c; cnt += (c > 0u) ? 1u : 0u; mine = (j == x) ? c : mine; }
        if (sum == G) break;
        __builtin_amdgcn_s_sleep(1);
        if ((++sp & 255u) == 0u) { if (xb_ld(&bar[XB_TMO])) break; if (sp > XB_SPIN_CAP) { atomicAdd(&bar[XB_TMO], 1u); break; } }
    }
    nloc = mine > 0u ? mine : 1u; nx = cnt > 0u ? cnt : 1u;
}

__device__ __forceinline__ void xcd_barrier(const XcdBarrier& b) {
    asm volatile("s_waitcnt vmcnt(0)" ::: "memory");
    __syncthreads();
    if (threadIdx.x == 0) {
        unsigned* bar = b.bar;
        __builtin_amdgcn_s_waitcnt(0);
        unsigned nloc = b.st[0], nx = b.st[1];
        if (nloc == 0u) { xcd_barrier_complete(bar, b.x, nloc, nx); b.st[0] = nloc; b.st[1] = nx; }
        const unsigned old = xb_add(&bar[XB_XSUB(b.x)], 1u);
        const unsigned gen = old / nloc;
        if (old + 1u == (gen + 1u) * nloc) {
            __builtin_amdgcn_fence(__ATOMIC_RELEASE, "agent");
            asm volatile("s_waitcnt vmcnt(0)" ::: "memory");
            const unsigned og = xb_add(&bar[XB_TOP], 1u);
            const unsigned tg = og / nx;
            if (og + 1u == (tg + 1u) * nx) xb_add(&bar[XB_TOPGEN], 1u);
            else XB_SPIN(xb_ld(&bar[XB_TOPGEN]) == tg, bar);
            __builtin_amdgcn_fence(__ATOMIC_ACQUIRE, "agent");
            xb_add(&bar[XB_XGEN(b.x)], 1u);
            asm volatile("s_waitcnt vmcnt(0)" ::: "memory");
        } else {
            XB_SPIN(xb_ld(&bar[XB_XGEN(b.x)]) == gen, bar);
            __builtin_amdgcn_fence(__ATOMIC_ACQUIRE, "agent");
            asm volatile("s_waitcnt vmcnt(0)" ::: "memory");
        }
    }
    __syncthreads();
}
struct Frame {
    LAS unsigned char* lds;
    volatile LAS unsigned* MISC;
    gu32* ctl;
    int tid, lane, wave;
    int vcu, G;
};
__device__ __forceinline__ float wave_sum(float v) {
#pragma unroll
    for (int o = 1; o < 64; o <<= 1) v += __shfl_xor(v, o);
    return v;
}
__device__ __forceinline__ void p0_transpose_item(const float* W, int ldw, int k0, int n0, bf16* WT, int ldt, int dst_row0, LAS float* scr, int lane) {
#pragma unroll 8
    for (int i = 0; i < 32; ++i) { const int kk = 2 * i + (lane >> 5); scr[kk * 33 + (lane & 31)] = __builtin_nontemporal_load(W + (size_t)(k0 + kk) * ldw + n0 + (lane & 31)); }
    LDS_WAIT(); asm volatile("" ::: "memory");
    const int c = lane & 7;
#pragma unroll
    for (int j = 0; j < 4; ++j) { const int n = (lane >> 3) + 8 * j; const LAS float* s = scr + (8 * c) * 33 + n;
        v4u o; o.x = pk2(s[0 * 33], s[1 * 33]); o.y = pk2(s[2 * 33], s[3 * 33]); o.z = pk2(s[4 * 33], s[5 * 33]); o.w = pk2(s[6 * 33], s[7 * 33]);
        *(GAS v4u*)(WT + (size_t)(dst_row0 + n) * ldt + k0 + 8 * c) = o; }
    LDS_WAIT(); asm volatile("" ::: "memory");
}
__device__ __forceinline__ void p0_prologue(Frame& F, ArgsP ap) {
    unsigned char* ws = ap->ws;
    if (F.vcu < 192) {
        LAS float* sc = (LAS float*)(F.lds + RING_OFF); LAS float* part = sc + 9 * 1024;
        const float* c = ap->in[I_C]; const float* cctx = ap->in[I_CCTX];
        for (int i = F.tid; i < 9 * 1024; i += NWAVES * 64) { const int bb = i >> 10, k = i & 1023; const float v = bb < 8 ? c[bb * 1024 + k] : cctx[k]; sc[i] = v / (1.0f + expf(-v)); }
        __syncthreads();
        const int l = F.vcu / 96, cb = F.vcu % 96, k0 = F.wave * 128;
        const float* w = ap->in[I_WADA] + (size_t)l * DM * MODW + (size_t)k0 * MODW + cb * 64 + F.lane;
        float acc[9];
#pragma unroll
        for (int j = 0; j < 9; ++j) acc[j] = 0.f;
        for (int k = 0; k < 128; k += 8) {
            float wv[8];
#pragma unroll
            for (int q = 0; q < 8; ++q) wv[q] = __builtin_nontemporal_load(w + (size_t)(k + q) * MODW);
#pragma unroll
            for (int j = 0; j < 9; ++j) { const f32x4 s0 = *(const LAS f32x4*)(sc + j * 1024 + k0 + k), s1 = *(const LAS f32x4*)(sc + j * 1024 + k0 + k + 4);
                acc[j] += (s0[0] * wv[0] + s0[1] * wv[1]) + (s0[2] * wv[2] + s0[3] * wv[3]) + (s1[0] * wv[4] + s1[1] * wv[5]) + (s1[2] * wv[6] + s1[3] * wv[7]); }
        }
#pragma unroll
        for (int j = 0; j < 9; ++j) part[(F.wave * 9 + j) * 64 + F.lane] = acc[j];
        __syncthreads();
        float* mods = (float*)(ws + WS_MODS);
        for (int idx = F.tid; idx < 9 * 64; idx += NWAVES * 64) { const int j = idx >> 6, col = idx & 63; float s = 0.f;
#pragma unroll
            for (int wv_ = 0; wv_ < 8; ++wv_) s += part[(wv_ * 9 + j) * 64 + col];
            mods[(size_t)(l * 9 + j) * MODW + cb * 64 + col] = s + ap->in[I_BADA][l * MODW + cb * 64 + col]; }
        __syncthreads();
    } else if (F.vcu == F.G - 1) {
        float* rc = (float*)(ws + WS_ROPE); float* rs = rc + 1024;
        for (int e = F.tid; e < 1024; e += NWAVES * 64) { const int pos = e >> 4, i = e & 15; const float fr = powf(10000.0f, -(float)(2 * i) / 32.0f); const float a = (float)pos * fr; rc[e] = cosf(a); rs[e] = sinf(a); }
    }
    LAS float* scr = (LAS float*)(F.lds + RING_OFF + F.wave * 16384);
    const int gw = F.vcu * NWAVES + F.wave, NGW = F.G * NWAVES;
    constexpr int I_IN = 16 * 56, I_OUT = 16 * 32, I_13 = 16 * 88, I_2 = 44 * 32, I_P = 4 * 8;
    constexpr int NITEMS = I_IN + I_OUT + 4 * I_13 + 2 * I_2 + 4 * I_P;
    for (int it = gw; it < NITEMS; it += NGW) {
        int r = it;
        if (r < I_IN) { const int kb = r / 56, nb = r % 56, f = 32 * nb, slot = f >> 6, bj = (f >> 5) & 1, pn = slot >> 2, wc = slot & 3;
            p0_transpose_item(ap->in[I_WIN], INW, 64 * kb, f, (bf16*)(ws + WS_WIN), DM, 256 * pn + 128 * bj + 32 * wc, scr, F.lane); continue; } r -= I_IN;
        if (r < I_OUT) { const int kb = r / 32, nb = r % 32; p0_transpose_item(ap->in[I_WOUT], DM, 64 * kb, 32 * nb, (bf16*)(ws + WS_WOUT), DM, 32 * nb, scr, F.lane); continue; } r -= I_OUT;
        if (r < 4 * I_13) { const int mi = r / I_13, rr = r % I_13, l = mi >> 1, which = mi & 1, kb = rr / 88, nb = rr % 88, n0 = 32 * nb;
            const float* W = ap->in[which ? I_W3 : I_W1] + (size_t)l * DM * FF;
            p0_transpose_item(W, FF, 64 * kb, n0, (bf16*)(ws + WS_W13) + (size_t)l * 5632 * DM, DM, 256 * (n0 >> 7) + 128 * which + (n0 & 127), scr, F.lane); continue; } r -= 4 * I_13;
        if (r < 2 * I_2) { const int l = r / I_2, rr = r % I_2, kb = rr / 32, nb = rr % 32;
            p0_transpose_item(ap->in[I_W2] + (size_t)l * FF * DM, DM, 64 * kb, 32 * nb, (bf16*)(ws + WS_W2) + (size_t)l * DM * FF, FF, 32 * nb, scr, F.lane); continue; } r -= 2 * I_2;
        { const int g = r / I_P, rr = r % I_P, kb = rr / 8, nb = rr % 8;
            p0_transpose_item(ap->in[I_WPOOL] + (size_t)g * 256 * 256, 256, 64 * kb, 32 * nb, (bf16*)(ws + WS_WPOOL), 256, g * 256 + 32 * nb, scr, F.lane); }
    }
    { const float* wsp = ap->in[I_WSP]; bf16* dst = (bf16*)(ws + WS_WSB);
        for (int e = (F.vcu * NWAVES * 64 + F.tid) * 4; e < 8 * 128 * 128; e += F.G * NWAVES * 64 * 4) { const f32x4 v = *(const f32x4*)(wsp + e); v2u o; o.x = pk2(v[0], v[1]); o.y = pk2(v[2], v[3]); *(v2u*)(dst + e) = o; } }
}
__device__ __forceinline__ void p1_bias13(Frame& F, ArgsP ap) {
    if (F.vcu >= 176) return;
    const int l = F.vcu / 88, rem = F.vcu % 88, which = rem / 44, cb = rem % 44, k0 = F.wave * 128;
    LAS float* shs = (LAS float*)(F.lds + RING_OFF); LAS float* part = shs + 8 * 1024;
    const float* mods = (const float*)(ap->ws + WS_MODS);
    for (int i = F.tid; i < 8 * 1024; i += NWAVES * 64) { const int b = i >> 10, k = i & 1023; shs[i] = mods[(size_t)(l * 9 + b) * MODW + SH2 + k]; }
    __syncthreads();
    const float* w = ap->in[which ? I_W3 : I_W1] + (size_t)l * DM * FF + (size_t)k0 * FF + cb * 64 + F.lane;
    float acc[8];
#pragma unroll
    for (int j = 0; j < 8; ++j) acc[j] = 0.f;
    for (int k = 0; k < 128; k += 8) {
        float wv[8];
#pragma unroll
        for (int q = 0; q < 8; ++q) wv[q] = __builtin_nontemporal_load(w + (size_t)(k + q) * FF);
#pragma unroll
        for (int j = 0; j < 8; ++j) { const f32x4 s0 = *(const LAS f32x4*)(shs + j * 1024 + k0 + k), s1 = *(const LAS f32x4*)(shs + j * 1024 + k0 + k + 4);
            acc[j] += (s0[0] * wv[0] + s0[1] * wv[1]) + (s0[2] * wv[2] + s0[3] * wv[3]) + (s1[0] * wv[4] + s1[1] * wv[5]) + (s1[2] * wv[6] + s1[3] * wv[7]); }
    }
#pragma unroll
    for (int j = 0; j < 8; ++j) part[(F.wave * 8 + j) * 64 + F.lane] = acc[j];
    __syncthreads();
    float* bias = (float*)(ap->ws + WS_BIAS);
    for (int idx = F.tid; idx < 8 * 64; idx += NWAVES * 64) { const int j = idx >> 6, col = idx & 63, n = cb * 64 + col; float sum = 0.f;
#pragma unroll
        for (int wv_ = 0; wv_ < 8; ++wv_) sum += part[(wv_ * 8 + j) * 64 + col];
        bias[(size_t)(l * 8 + j) * 5632 + 256 * (n >> 7) + 128 * which + (n & 127)] = sum; }
    __syncthreads();
}
__device__ __forceinline__ void p1_poolw(Frame& F, ArgsP ap) {
    unsigned char* ws = ap->ws; const bf16* src = (const bf16*)(ws + WS_WPOOL); bf16* dst = (bf16*)(ws + WS_WPB);
    const float* gm = ap->in[I_GMIX] + DM; const float* mod1 = (const float*)(ws + WS_MODS) + (size_t)9 * MODW;
    for (int e = (F.vcu * NWAVES * 64 + F.tid) * 8; e < 8 * 1024 * 256; e += F.G * NWAVES * 64 * 8) {
        const int b = e >> 18, n = (e >> 8) & 1023, k = e & 255, gk = (n & ~255) + k;
        const v4u w = *(const v4u*)(src + (size_t)n * 256 + k); const f32x4 g0 = *(const f32x4*)(gm + gk), g1 = *(const f32x4*)(gm + gk + 4);
        const f32x4 s0 = *(const f32x4*)(mod1 + (size_t)b * MODW + SC1 + gk), s1 = *(const f32x4*)(mod1 + (size_t)b * MODW + SC1 + gk + 4);
        const f32x4 m0 = g0 * (s0 + 1.0f), m1 = g1 * (s1 + 1.0f);
        v4u o; o.x = pk2(bf2f(w.x & 0xffffu) * m0[0], bf2f(w.x >> 16) * m0[1]); o.y = pk2(bf2f(w.y & 0xffffu) * m0[2], bf2f(w.y >> 16) * m0[3]);
        o.z = pk2(bf2f(w.z & 0xffffu) * m1[0], bf2f(w.z >> 16) * m1[1]); o.w = pk2(bf2f(w.w & 0xffffu) * m1[2], bf2f(w.w >> 16) * m1[3]);
        *(v4u*)(dst + e) = o; }
}
__device__ __forceinline__ void norm_pass(Frame& F, const float* src_lat, const float* src_ctx, bf16* dst, const float* gvec, const float* modl, int sh_off, int sc_off) {
    const int total = src_ctx ? MALL : MTOK, gw = F.vcu * NWAVES + F.wave, NGW = F.G * NWAVES, rpw = (total + NGW - 1) / NGW;
    const int r0 = gw * rpw, r1 = (r0 + rpw < total) ? r0 + rpw : total;
    int cur = -1; f32x4 gm[4], sh[4];
    for (int row = r0; row < r1; ++row) {
        const int bb = row < MTOK ? (row >> 12) : 8;
        if (bb != cur) { cur = bb;
#pragma unroll
            for (int j = 0; j < 4; ++j) { const int c = 4 * F.lane + 256 * j; const f32x4 g = *(const f32x4*)(gvec + c), s = *(const f32x4*)(modl + (size_t)bb * MODW + sc_off + c);
                gm[j] = g * (s + 1.0f); sh[j] = *(const f32x4*)(modl + (size_t)bb * MODW + sh_off + c); } }
        const float* xr = row < MTOK ? src_lat + (size_t)row * DM : src_ctx + (size_t)(row - MTOK) * DM;
        f32x4 v[4]; float ss = 0.f;
#pragma unroll
        for (int j = 0; j < 4; ++j) { v[j] = __builtin_nontemporal_load((const f32x4*)(xr + 4 * F.lane + 256 * j)); ss += (v[j][0] * v[j][0] + v[j][1] * v[j][1]) + (v[j][2] * v[j][2] + v[j][3] * v[j][3]); }
        const float r = 1.0f / sqrtf(wave_sum(ss) * (1.0f / DM) + 1e-6f);
        bf16* orow = dst + (size_t)row * DM;
#pragma unroll
        for (int j = 0; j < 4; ++j) { const f32x4 o = v[j] * r * gm[j] + sh[j]; v2u w; w.x = pk2(o[0], o[1]); w.y = pk2(o[2], o[3]); *(v2u*)(orow + 4 * F.lane + 256 * j) = w; }
    }
}
__device__ __forceinline__ void final_norm(Frame& F, float* out, const float* gvec) {
    const int gw = F.vcu * NWAVES + F.wave, NGW = F.G * NWAVES, rpw = (MTOK + NGW - 1) / NGW;
    const int r0 = gw * rpw, r1 = (r0 + rpw < MTOK) ? r0 + rpw : MTOK;
    f32x4 g[4];
#pragma unroll
    for (int j = 0; j < 4; ++j) g[j] = *(const f32x4*)(gvec + 4 * F.lane + 256 * j);
    for (int row = r0; row < r1; ++row) {
        float* xr = out + (size_t)row * DM; f32x4 v[4]; float ss = 0.f;
#pragma unroll
        for (int j = 0; j < 4; ++j) { v[j] = *(const f32x4*)(xr + 4 * F.lane + 256 * j); ss += (v[j][0] * v[j][0] + v[j][1] * v[j][1]) + (v[j][2] * v[j][2] + v[j][3] * v[j][3]); }
        const float r = 1.0f / sqrtf(wave_sum(ss) * (1.0f / DM) + 1e-6f);
#pragma unroll
        for (int j = 0; j < 4; ++j) *(f32x4*)(xr + 4 * F.lane + 256 * j) = v[j] * r * g[j];
    }
}
template <int W> __device__ __forceinline__ void poolres_cols(const bf16* zb, bf16* outb, bf16* xnb, float* partb, int t0, int c, f32x2 gate, f32x2 gmn, int wave, int lane) {
    constexpr int L = W / 2, R = W / 2 - 1, NV = W - 1 + 16;
    f32x2 v[NV];
#define Z_LD(dst_, t_) do { const int tt_ = (t_); if (tt_ < 0 || tt_ >= SEQ) dst_ = (f32x2){0.f, 0.f}; else { const unsigned u_ = __builtin_nontemporal_load((const unsigned*)(zb + (size_t)tt_ * DM + c)); dst_ = (f32x2){bf2f(u_ & 0xffffu), bf2f(u_ >> 16)}; } } while (0)
#pragma unroll
    for (int i = 0; i < W - 1; ++i) Z_LD(v[i], t0 - L + i);
    for (int blk = 0; blk < 8; ++blk) {
        const int tb = t0 + 16 * blk;
        unsigned xr[16];
#pragma unroll
        for (int i = 0; i < 16; ++i) xr[i] = *(const unsigned*)(outb + (size_t)(tb + i) * DM + c);
#pragma unroll
        for (int i = 0; i < 16; ++i) Z_LD(v[W - 1 + i], tb + R + i);
        f32x2 s = v[0];
#pragma unroll
        for (int i = 1; i < W; ++i) s += v[i];
#pragma unroll
        for (int j = 0; j < 16; ++j) { const int t = tb + j; const int lo = t - L < 0 ? 0 : t - L, hi = t + R > SEQ - 1 ? SEQ - 1 : t + R; const float cnt = (float)(hi - lo + 1);
            const f32x2 o = s / cnt - v[j + L]; const f32x2 x3 = (f32x2){bf2f(xr[j] & 0xffffu), bf2f(xr[j] >> 16)} + gate * o;
            *(unsigned*)(outb + (size_t)t * DM + c) = pk2(x3[0], x3[1]); const f32x2 y = x3 * gmn; *(unsigned*)(xnb + (size_t)t * DM + c) = pk2(y[0], y[1]);
            const float ss = wave_sum(x3[0] * x3[0] + x3[1] * x3[1]);
            if (lane < 2) partb[((size_t)((wave >> 2) + 2 * lane) * MTOK + t) * 4 + (wave & 3)] = lane ? 0.f : ss;
            if (j < 15) s += v[j + W] - v[j]; }
#pragma unroll
        for (int i = 0; i < W - 1; ++i) v[i] = v[i + 16];
    }
#undef Z_LD
}
__device__ __forceinline__ void poolres_pass(Frame& F, const bf16* Z, bf16* out, bf16* xn, float* part, const float* gate, const float* pscale, const float* gnext, const float* scnext) {
    for (int strip = F.vcu; strip < MTOK / 128; strip += F.G) {
        const int b = strip >> 5, t0 = (strip & 31) * 128; const size_t ro = (size_t)b * SEQ;
        const int c = 2 * F.tid;
        const f32x2 gt = *(const f32x2*)(gate + (size_t)b * MODW + c) * *(const f32x2*)(pscale + c);
        const f32x2 gmn = *(const f32x2*)(gnext + c) * (*(const f32x2*)(scnext + (size_t)b * MODW + c) + 1.0f);
        const bf16* zb = Z + ro * DM; bf16* outb = out + ro * DM; bf16* xnb = xn + ro * DM; float* partb = part + ro * 4;
        const int grp = F.wave >> 1;
        if (grp == 0) poolres_cols<2>(zb, outb, xnb, partb, t0, c, gt, gmn, F.wave, F.lane); else if (grp == 1) poolres_cols<4>(zb, outb, xnb, partb, t0, c, gt, gmn, F.wave, F.lane);
        else if (grp == 2) poolres_cols<8>(zb, outb, xnb, partb, t0, c, gt, gmn, F.wave, F.lane); else poolres_cols<16>(zb, outb, xnb, partb, t0, c, gt, gmn, F.wave, F.lane);
    }
}
__device__ __forceinline__ void gmlp_unit(Frame& F, int unit, const bf16* VG, const bf16* U, const bf16* WSB, const float* bs, bf16* AM) {
    using attn_body::f32x16;
    const int g = F.wave, lane = F.lane, r32 = lane & 31, hi = lane >> 5;
    const size_t R0 = (size_t)unit * 128;
    LAS unsigned char* slot = F.lds + RING_OFF + g * 16384;
    const unsigned slot_addr = (unsigned)(uintptr_t)slot;
    const int vb = (int)slot_addr + ((lane >> 4) & 1) * 32 + (lane & 3) * 8 + (4 * hi + ((lane & 15) >> 2)) * 64;
#pragma unroll
    for (int kt = 0; kt < 2; ++kt)
#pragma unroll
        for (int p = 0; p < 8; ++p)
            attn_body::glds16_nt(VG + (R0 + 64 * kt + 16 * (p & 3) + (lane >> 2)) * 512 + g * 64 + (p >> 2) * 32 + (lane & 3) * 8, (unsigned)__builtin_amdgcn_readfirstlane(slot_addr + kt * 8192 + p * 1024));
    f32x16 o[4][2];
#pragma unroll
    for (int rb = 0; rb < 4; ++rb) { o[rb][0] = f32x16{}; o[rb][1] = f32x16{}; }
#define GM_LDPA(dst, kt_, rb_) do { int z_ = 0; asm volatile("" : "+v"(z_)); const char* wp = wb + z_ + (rb_) * 8192 + (kt_) * 128;     \
            _Pragma("unroll") for (int s = 0; s < 4; ++s) { const v2u a = *(const v2u*)(wp + s * 32), b = *(const v2u*)(wp + s * 32 + 16); dst[s] = __builtin_bit_cast(bf16x8, (v4u){a.x, a.y, b.x, b.y}); } } while (0)
    const char* wb = (const char*)(WSB + ((size_t)(g * 128 + r32) * 128 + 4 * hi));
    {
        bf16x8 pA[4], pB[4];
#define GM_PV(P, kt_, rb_) attn_body::pv(o[rb_], vb + (kt_) * 8192, P[0], P[1], P[2], P[3])
        GM_LDPA(pA, 0, 0);
        VM_WAIT();
        GM_LDPA(pB, 0, 1); GM_PV(pA, 0, 0);
        GM_LDPA(pA, 0, 2); GM_PV(pB, 0, 1);
        GM_LDPA(pB, 0, 3); GM_PV(pA, 0, 2);
        GM_LDPA(pA, 1, 0); GM_PV(pB, 0, 3);
        GM_LDPA(pB, 1, 1); GM_PV(pA, 1, 0);
        GM_LDPA(pA, 1, 2); GM_PV(pB, 1, 1);
        GM_LDPA(pB, 1, 3); GM_PV(pA, 1, 2);
        GM_PV(pB, 1, 3);
#undef GM_PV
    }
#undef GM_LDPA
    LDS_WAIT();
    LAS float* stg = (LAS float*)slot;
    v4u uA[4], uB[4]; float bA[4], bB[4];
#define GM_LDU(UU, BB, rb_) do { int zz_ = 0; asm volatile("" : "+v"(zz_)); const char* ub_ = (const char*)(U + (R0 + 32 * (rb_) + (lane >> 3)) * 512 + g * 64 + (lane & 7) * 8) + zz_; \
        const float* bb_ = bs + g * 128 + 32 * (rb_) + (lane >> 3) + zz_; _Pragma("unroll") for (int i = 0; i < 4; ++i) { UU[i] = __builtin_nontemporal_load((const v4u*)(ub_ + i * 8192)); BB[i] = bb_[8 * i]; } } while (0)
#define GM_EPI(UU, BB, rb_) do { \
        _Pragma("unroll") for (int r = 0; r < 16; ++r) { const int orow = attn_body::crow(r, hi); stg[orow * 64 + r32] = o[rb_][0][r]; stg[orow * 64 + 32 + r32] = o[rb_][1][r]; } \
        LDS_WAIT(); \
        _Pragma("unroll") for (int i = 0; i < 4; ++i) { const int row = i * 8 + (lane >> 3), ch = lane & 7; \
            const f32x4 a = *(const LAS f32x4*)(stg + row * 64 + ch * 8) + BB[i], b = *(const LAS f32x4*)(stg + row * 64 + ch * 8 + 4) + BB[i]; \
            v4u w; w.x = pk2(a[0] * bf2f(UU[i].x & 0xffffu), a[1] * bf2f(UU[i].x >> 16)); w.y = pk2(a[2] * bf2f(UU[i].y & 0xffffu), a[3] * bf2f(UU[i].y >> 16)); \
            w.z = pk2(b[0] * bf2f(UU[i].z & 0xffffu), b[1] * bf2f(UU[i].z >> 16)); w.w = pk2(b[2] * bf2f(UU[i].w & 0xffffu), b[3] * bf2f(UU[i].w >> 16)); \
            *(v4u*)(AM + (R0 + 32 * (rb_) + row) * 1024 + 512 + g * 64 + ch * 8) = w; } \
        LDS_WAIT(); } while (0)
    GM_LDU(uA, bA, 0);
    GM_LDU(uB, bB, 1); GM_EPI(uA, bA, 0);
    GM_LDU(uA, bA, 2); GM_EPI(uB, bB, 1);
    GM_LDU(uB, bB, 3); GM_EPI(uA, bA, 2);
    GM_EPI(uB, bB, 3);
#undef GM_LDU
#undef GM_EPI
}

template <class Sched> __device__ __forceinline__ int build_rtab(Frame& F, const Sched& S, const float* part, LAS float* rtab) {
    pg8::Unit u; int pm0 = -1, pm1 = -1;
    for (int i = 0; S.next(i, u); ++i) { if (pm0 < 0) pm0 = u.pm; else if (u.pm != pm0) pm1 = u.pm; }
    if (pm1 < 0) pm1 = pm0;
    { const int slot = F.tid >> 8, r = F.tid & 255, row = (slot ? pm1 : pm0) * 256 + r; float tot = 0.f;
#pragma unroll
        for (int pn = 0; pn < 4; ++pn) { const f32x4 p = *(const f32x4*)(part + ((size_t)pn * MTOK + row) * 4); tot += (p[0] + p[1]) + (p[2] + p[3]); }
        rtab[F.tid] = __builtin_amdgcn_rsqf(tot * (1.0f / DM) + 1e-6f); }
    __syncthreads();
    return pm0;
}
__global__ void __launch_bounds__(NWAVES * 64, 2) mega_fwd(Args args) {
    extern __shared__ __attribute__((aligned(16))) unsigned char lds[];
    Frame F;
    F.lds = (LAS unsigned char*)lds;
    F.MISC = (volatile LAS unsigned*)(F.lds + MISC_OFF);
    F.tid = threadIdx.x; F.lane = F.tid & 63; F.wave = __builtin_amdgcn_readfirstlane(F.tid >> 6);
    F.G = gridDim.x; { const int bx = blockIdx.x; F.vcu = (F.G % 8 == 0) ? (bx % 8) * (F.G / 8) + bx / 8 : bx; }
    ArgsP akp = (ArgsP)__builtin_amdgcn_kernarg_segment_ptr();
    F.ctl = (gu32*)(akp->ws + WS_CTL);
    for (int u = F.tid; u < (LDS_BYTES - LDSCTL_OFF) / 4; u += NWAVES * 64) ((LAS unsigned*)(F.lds + LDSCTL_OFF))[u] = 0u;
    __syncthreads();
    const int lo = akp->ph_lo, hi = akp->ph_hi;
    const bool one_launch = (hi - lo) > 1;
    XcdBarrier bar; bar.bar = (unsigned*)(F.ctl + CW_BAR); bar.x = 0; bar.st = nullptr;
    if (one_launch) bar = xcd_barrier_post((unsigned*)(F.ctl + CW_BAR), F.MISC + 8);
#ifndef PHASE_MASK
#define PHASE_MASK 0x7ff
#endif
#define IN(k) (((PHASE_MASK >> (k)) & 1) && lo <= (k) && (k) < hi)
#define SEAM(k) do { if (IN(k) && IN((k) + 1)) xcd_barrier(bar); } while (0)
#ifndef REPEAT_MASK
#define REPEAT_MASK 0
#endif
#define REP(k) for (int rep_ = 0; rep_ < (((REPEAT_MASK >> (k)) & 1) ? 2 : 1); ++rep_, (((REPEAT_MASK >> (k)) & 1) && rep_ == 1 && one_launch ? (xcd_barrier(bar), 0) : 0))
#define REPRES(k, dummy) ((((REPEAT_MASK >> (k)) & 1) && rep_ == 0) ? (void*)(ws + (dummy)) : (void*)(ws + WS_RES))
#define REPOUT(k, dummy) ((((REPEAT_MASK >> (k)) & 1) && rep_ == 0) ? (float*)(ws + (dummy)) : out)
#define PHASE_VARS() ArgsP A = akp; asm volatile("" : "+s"(A)); unsigned char* ws = A->ws; float* out = A->out; float* mods = (float*)(ws + WS_MODS); const float* mod1 = mods + (size_t)9 * MODW; bf16* XN = (bf16*)(ws + WS_XN); bf16* AM = (bf16*)(ws + WS_AM); bf16* HB = (bf16*)(ws + WS_H); \
    float* rs1 = (float*)(ws + WS_PART); float* rs2 = rs1 + 16 * MTOK; float* rs3 = rs2 + 16 * MTOK; float* rs4 = rs3 + 16 * MTOK; const float* bias13 = (const float*)(ws + WS_BIAS); \
    (void)out; (void)mods; (void)mod1; (void)XN; (void)AM; (void)HB; (void)rs1; (void)rs2; (void)rs3; (void)rs4; (void)bias13
#ifndef STAGGER_US
#define STAGGER_US 0
#endif
#define STAGGER() do { const unsigned g_ = (blockIdx.x >> 3) & 3u; if (STAGGER_US > 0 && g_) { const unsigned long long t0_ = __builtin_amdgcn_s_memrealtime(); while (__builtin_amdgcn_s_memrealtime() - t0_ < (unsigned long long)(g_ * STAGGER_US * 100)) __builtin_amdgcn_s_sleep(8); } } while (0)
#define RELAUNDER() do { int t_ = threadIdx.x; asm volatile("" : "+v"(t_)); F.tid = t_; F.lane = t_ & 63; } while (0)
    if (IN(0)) REP(0) { PHASE_VARS(); RELAUNDER(); p0_prologue(F, A); } SEAM(0);
    if (IN(1)) REP(1) { PHASE_VARS(); RELAUNDER(); p1_bias13(F, A); p1_poolw(F, A); norm_pass(F, A->in[I_X], A->in[I_CTX], XN, A->in[I_GMIX], mods, SH1, SC1); } SEAM(1);
    if (IN(2)) REP(2) { PHASE_VARS();
        pg8::Gemm g{XN, (const bf16*)(ws + WS_WIN), DM, DM, 0, 0}; pg8::StaticOrder S; S.init(MTOK, INW, F.G, (int)blockIdx.x, MCTX / 256, 2);
        pg8::EpiInProj E{A};
        pg8::gemm_phase<pg8::EpiInProj, pg8::StaticOrder, PG8_ALIGN, PG8_SP2>(F.lds + RING_OFF, g, S, E);
    } SEAM(2);
    if (IN(3)) REP(3) { PHASE_VARS();
        const attn_body::AttnTensors AT{(const attn_body::bf16*)(ws + WS_Q), (const attn_body::bf16*)(ws + WS_KB), (const attn_body::bf16*)(ws + WS_VB), (attn_body::bf16*)AM};
        const attn_body::StaticOrder S((int)F.G, F.vcu);
        const bool gfirst = (F.vcu & 1) != 0;
        for (int g2_ = 0; g2_ < 2; ++g2_) {
            if ((g2_ == 0) == gfirst) {
                RELAUNDER();
                for (int rp_ = 0; rp_ < (((REPEAT_MASK >> 11) & 1) ? 2 : 1); ++rp_) {
                    for (int u = F.vcu; u < MTOK / 128; u += F.G) gmlp_unit(F, u, (const bf16*)(ws + WS_VG), (const bf16*)(ws + WS_U), (const bf16*)(ws + WS_WSB), A->in[I_BSP], AM);
                    __syncthreads(); }
            } else attn_body::attn_phase<attn_body::StaticOrder>((char*)lds + RING_OFF, AT, S, A->in[I_QN], A->in[I_KN]);
        }
    } SEAM(3);
    if (IN(4)) REP(4) { PHASE_VARS(); STAGGER();
        pg8::Gemm g{AM, (const bf16*)(ws + WS_WOUT), DM, DM, 0, 0}; pg8::StaticOrder S; S.init(MTOK, DM, F.G, (int)blockIdx.x);
        pg8::EpiResid<4> E{A, (void*)(ws + WS_RES)};
        pg8::gemm_phase<pg8::EpiResid<4>, pg8::StaticOrder, PG8_ALIGN, PG8_SP2>(F.lds + RING_OFF, g, S, E);
    } SEAM(4);
    if (IN(5)) REP(5) { PHASE_VARS();
        pg8::Gemm g{XN, (const bf16*)(ws + WS_W13), DM, DM, 0, 0}; pg8::StaticOrder S; S.init(MTOK, 2 * FF, F.G, (int)blockIdx.x);
#if defined(PROBE_NULL5)
        if (rep_ == 0) { pg8::EpiNull EN{(bf16*)(ws + WS_VG)}; pg8::StaticOrder S2; S2.init(MTOK, DM, F.G, (int)blockIdx.x);   (void)S2;
            pg8::EpiNullWide ENW{(bf16*)(ws + WS_H)}; pg8::gemm_phase<pg8::EpiNullWide, pg8::StaticOrder, PG8_ALIGN, PG8_SP2>(F.lds + RING_OFF, g, S, ENW); (void)EN; } else
#endif
        { RELAUNDER(); LAS float* rtab = (LAS float*)(F.lds + RTAB_OFF); const int pm0 = build_rtab(F, S, rs1, rtab); pg8::EpiSwiglu<0> E{A, rtab, pm0};
        pg8::gemm_phase<pg8::EpiSwiglu<0>, pg8::StaticOrder, PG8_ALIGN, PG8_SP2>(F.lds + RING_OFF, g, S, E); }
    } SEAM(5);
    if (IN(6)) REP(6) { PHASE_VARS(); STAGGER();
        pg8::Gemm g{HB, (const bf16*)(ws + WS_W2), FF, FF, 0, 0}; pg8::StaticOrder S; S.init(MTOK, DM, F.G, (int)blockIdx.x);
#if defined(PROBE_NULL6)
        if (rep_ == 0) { pg8::EpiNull EN{(bf16*)(ws + WS_VG)}; pg8::gemm_phase<pg8::EpiNull, pg8::StaticOrder, PG8_ALIGN, PG8_SP2>(F.lds + RING_OFF, g, S, EN); } else
#elif defined(PROBE_NOXN6)
        if (rep_ == 0) { pg8::EpiResid<7> E7{A, REPRES(6, WS_VG)}; pg8::gemm_phase<pg8::EpiResid<7>, pg8::StaticOrder, PG8_ALIGN, PG8_SP2>(F.lds + RING_OFF, g, S, E7); } else
#endif
        { pg8::EpiResid<6> E{A, REPRES(6, WS_VG)};
        pg8::gemm_phase<pg8::EpiResid<6>, pg8::StaticOrder, PG8_ALIGN, PG8_SP2>(F.lds + RING_OFF, g, S, E); }
    } SEAM(6);
    if (IN(7)) REP(7) { PHASE_VARS();
        pg8::Gemm g{(const bf16*)(ws + WS_RES), (const bf16*)(ws + WS_WPB), 256, DM, 512, 1024 * 256 * 2}; pg8::StaticOrder S; S.init(MTOK, DM, F.G, (int)blockIdx.x);
        pg8::EpiZ E{A};
        pg8::gemm_phase<pg8::EpiZ, pg8::StaticOrder, PG8_ALIGN, PG8_SP2>(F.lds + RING_OFF, g, S, E);
    } SEAM(7);
    if (IN(8)) { PHASE_VARS(); RELAUNDER(); poolres_pass(F, AM, (bf16*)(ws + WS_RES), XN, rs3, mod1 + GA1, A->in[I_PSC], A->in[I_GFFN] + DM, mod1 + SC2); } SEAM(8);
    if (IN(9)) REP(9) { PHASE_VARS();
        pg8::Gemm g{XN, (const bf16*)(ws + WS_W13) + (size_t)5632 * DM, DM, DM, 0, 0}; pg8::StaticOrder S; S.init(MTOK, 2 * FF, F.G, (int)blockIdx.x);
        RELAUNDER(); LAS float* rtab = (LAS float*)(F.lds + RTAB_OFF); const int pm0 = build_rtab(F, S, rs3, rtab); pg8::EpiSwiglu<1> E{A, rtab, pm0};
        pg8::gemm_phase<pg8::EpiSwiglu<1>, pg8::StaticOrder, PG8_ALIGN, PG8_SP2>(F.lds + RING_OFF, g, S, E);
    } SEAM(9);
    if (IN(10)) REP(10) { PHASE_VARS(); STAGGER();
        pg8::Gemm g{HB, (const bf16*)(ws + WS_W2) + (size_t)DM * FF, FF, FF, 0, 0}; pg8::StaticOrder S; S.init(MTOK, DM, F.G, (int)blockIdx.x);
        pg8::EpiResid<10> E{A, out};
        pg8::gemm_phase<pg8::EpiResid<10>, pg8::StaticOrder, PG8_ALIGN, PG8_SP2>(F.lds + RING_OFF, g, S, E);
    }
#undef IN
#undef SEAM
}

extern "C" void kernel_launch(void* const* d_in, const int* in_sizes, int n_in, void* d_out, int out_size, void* d_ws, size_t ws_size, hipStream_t stream) {
    static int grid = 0;
    if (grid == 0) {
        if (n_in != 21 || out_size != MTOK * DM || ws_size < WS_END) { fprintf(stderr, "kernel_launch: unexpected shapes (n_in %d, out %d, ws %zu)\n", n_in, out_size, ws_size); grid = -1; return; }
        int dev = 0, cus = 0, per_cu = 0;
        if (hipGetDevice(&dev) != hipSuccess || hipDeviceGetAttribute(&cus, hipDeviceAttributeMultiprocessorCount, dev) != hipSuccess) { grid = -1; return; }
        if (hipFuncSetAttribute((const void*)mega_fwd, hipFuncAttributeMaxDynamicSharedMemorySize, LDS_BYTES) != hipSuccess) { fprintf(stderr, "kernel_launch: hipFuncSetAttribute failed\n"); grid = -1; return; }
        if (hipOccupancyMaxActiveBlocksPerMultiprocessor(&per_cu, (const void*)mega_fwd, NWAVES * 64, LDS_BYTES) != hipSuccess || per_cu < 1) { fprintf(stderr, "kernel_launch: occupancy query says %d\n", per_cu); per_cu = 1; }
        (void)hipGetLastError();
        grid = cus;
        if (grid != 256) fprintf(stderr, "kernel_launch: %d CUs (expected 256)\n", grid);
    }
    if (grid < 0) return;
    if (hipMemsetAsync((char*)d_ws + WS_CTL, 0, CTL_ZERO_BYTES, stream) != hipSuccess) return;
    Args a{};
    for (int i = 0; i < 21; ++i) a.in[i] = (const float*)d_in[i];
    a.out = (float*)d_out; a.ws = (unsigned char*)d_ws;
#if defined(MK_PER_PHASE)
    for (int p = 0; p < N_PHASES; ++p) { a.ph_lo = p; a.ph_hi = p + 1; hipLaunchKernelGGL(mega_fwd, dim3(grid), dim3(NWAVES * 64), LDS_BYTES, stream, a); }
#else
    a.ph_lo = 0; a.ph_hi = N_PHASES;
    hipLaunchKernelGGL(mega_fwd, dim3(grid), dim3(NWAVES * 64), LDS_BYTES, stream, a);
#endif
}
```

```cpp
#include <hip/hip_runtime.h>
#include <hip/hip_bf16.h>
#include <cstdio>
#include <cstdint>
#include <cmath>
constexpr int NWAVES_ = 8;
constexpr int NWAVES = 8;
constexpr int DM = 1024, NB = 8, SEQ = 4096, MTOK = NB * SEQ, CTXL = 256, MCTX = NB * CTXL, MALL = MTOK + MCTX;
constexpr int INW = 1792, FF = 2816, SKV = SEQ + CTXL;
constexpr int N_PHASES = 11;
constexpr size_t MiB = 1u << 20;
constexpr size_t WS_CTL = 0, CTL_ZERO_BYTES = 128 * 1024;
constexpr size_t WS_MODS = 1 * MiB;
constexpr size_t WS_ROPE = WS_MODS + 512 * 1024;
constexpr size_t WS_WSB = 2 * MiB;
constexpr size_t WS_WPOOL = WS_WSB + 512 * 1024;
constexpr size_t WS_WIN = 4 * MiB;
constexpr size_t WS_WOUT = 8 * MiB;
constexpr size_t WS_W13 = 10 * MiB;
constexpr size_t WS_W2 = 32 * MiB;
constexpr size_t WS_XN = 44 * MiB;
constexpr size_t WS_Q = 112 * MiB;
constexpr size_t WS_RES = 112 * MiB;
constexpr size_t WS_KB = 144 * MiB;
constexpr size_t WS_VB = 153 * MiB;
constexpr size_t WS_U = 162 * MiB;
constexpr size_t WS_VG = 194 * MiB;
constexpr size_t WS_AM = 226 * MiB;
constexpr size_t WS_H = 290 * MiB;
constexpr size_t WS_WPB = 474 * MiB;
constexpr size_t WS_END = 478 * MiB;
constexpr int CW_BAR = 4096;
constexpr size_t CTL_CNT = 65536;
constexpr size_t WS_PART = 466 * MiB;
static_assert(CTL_CNT + 32768 <= CTL_ZERO_BYTES, "CTL map");
constexpr size_t WS_BIAS = WS_ROPE + 65536;
constexpr int RING_OFF = 0, RING_BYTES = 131072;
constexpr int LDSCTL_OFF = RING_BYTES, MISC_OFF = LDSCTL_OFF + 320;
constexpr int RTAB_OFF = LDSCTL_OFF + 1024;
constexpr int LDS_BYTES = 147456;
static_assert(MISC_OFF + 128 <= LDS_BYTES, "LDS map");

struct Args { const float* in[21]; float* out; unsigned char* ws; int ph_lo, ph_hi; };
#define KARG __attribute__((address_space(4)))
typedef const KARG Args* ArgsP;
static_assert(sizeof(Args) == 192, "Args has no padding");
enum { I_X = 0, I_C, I_CTX, I_CCTX, I_WADA, I_BADA, I_GMIX, I_GFFN, I_WIN, I_WOUT, I_QN, I_KN, I_GN, I_WSP, I_BSP, I_WPOOL, I_PSC, I_W1, I_W3, I_W2, I_GFIN };
constexpr int SH1 = 0, SC1 = DM, GA1 = 2 * DM, SH2 = 3 * DM, SC2 = 4 * DM, GA2 = 5 * DM, MODW = 6 * DM;

namespace pg8 {
#define PG8_LAS __attribute__((address_space(3)))
typedef unsigned short bf16_t;
typedef short bf16x8 __attribute__((ext_vector_type(8)));
typedef float f32x4 __attribute__((ext_vector_type(4)));
typedef float f32x2 __attribute__((ext_vector_type(2)));
typedef unsigned u32x4 __attribute__((ext_vector_type(4)));
constexpr int BM = 256, BK = 64, HALF = 128, HTB = HALF * BK * 2  , STAGE_BYTES = 8 * HTB, NXCD = 8, WGM = 8;

__host__ __device__ __forceinline__ int lds_byte(int r, int c) { const int st = (r >> 4) * 2 + (c >> 5), rr = r & 15, cc = c & 31, ob = rr * 64 + cc * 2; return st * 1024 + (ob ^ (((ob >> 9) & 1) << 5)); }
__host__ __device__ __forceinline__ void stage_rc(int b, int& R, int& C) { const int st = b / 1024, sb = b % 1024, swz = sb ^ (((sb >> 9) & 1) << 5); R = (st >> 1) * 16 + swz / 64; C = (st & 1) * 32 + (swz % 64) / 2; }
__host__ __device__ __forceinline__ int perm32(int rho) { const int n = rho >> 4, i = rho & 15; return 8 * (i >> 2) + 4 * n + (i & 3); }

struct Unit { int pm, pn; };
struct Gemm { const bf16_t* A; const bf16_t* Bt; int K; int lda; int a_pn_bytes; int b_batch_bytes; };

struct StaticOrder {
    int nM, nN, nwg, G, c, extra, extra_pn;
    __host__ __device__ void init(int M, int N, int G_, int c_, int extra_ = 0, int extra_pn_ = 0) { nM = M / BM; nN = N / BM; nwg = nM * nN; G = G_; c = c_; extra = extra_; extra_pn = extra_pn_; }
    __host__ __device__ bool next(int i, Unit& u) const {
        const long L = (long)i * G + c;
        if (L >= nwg) { const long e = L - nwg; if (e >= extra) return false; u.pm = nM + (int)e; u.pn = extra_pn; return true; }
        int wgid = (int)L; { const int q = nwg / NXCD, r = nwg % NXCD, xcd = wgid % NXCD, off = wgid / NXCD; wgid = (xcd < r ? xcd * (q + 1) : r * (q + 1) + (xcd - r) * q) + off; }
        const int nig = WGM * nN, gid = wgid / nig, fm = gid * WGM, gsz = (nM - fm) < WGM ? (nM - fm) : WGM;
        u.pm = fm + ((wgid % nig) % gsz); u.pn = (wgid % nig) / gsz; return true;
    }
    __device__ __forceinline__ void a_ready(const Unit&) const {}
    __device__ __forceinline__ void done(const Unit&) const {}
};

__device__ __forceinline__ unsigned cvt_pk_bf16(float lo, float hi) { unsigned r; asm volatile("v_cvt_pk_bf16_f32 %0, %1, %2" : "=v"(r) : "v"(lo), "v"(hi)); return r; }
__device__ __forceinline__ f32x2 gelu_pk(f32x2 v) {
    const f32x2 av = __builtin_elementwise_abs(v), d = av * 0.2316418882f + 1.0f;
    f32x2 t; t.x = __builtin_amdgcn_rcpf(d.x); t.y = __builtin_amdgcn_rcpf(d.y);
    f32x2 q = t * 0.5307027145f + (-0.7265760135f); q = q * t + 0.7107068705f; q = q * t + (-0.142248368f); q = q * t + 0.127414796f; q = q * t;
    const f32x2 s = (v * v) * (-0.72134752044f);
    f32x2 e; e.x = __builtin_amdgcn_exp2f(s.x); e.y = __builtin_amdgcn_exp2f(s.y);
    const f32x2 m = v * (q * e), r = v - m;
    f32x2 o; o.x = v.x < 0.f ? m.x : r.x; o.y = v.y < 0.f ? m.y : r.y; return o;
}
__device__ __forceinline__ f32x4 gelu4(f32x4 v) { const f32x2 a = gelu_pk((f32x2){v[0], v[1]}), b = gelu_pk((f32x2){v[2], v[3]}); return (f32x4){a.x, a.y, b.x, b.y}; }
__device__ __forceinline__ float silu1(float v) { return v * __builtin_amdgcn_rcpf(1.0f + __builtin_amdgcn_exp2f(v * -1.4426950408889634f)); }
__device__ __forceinline__ u32x4 pack8(f32x4 v0, f32x4 v1) { u32x4 w; w.x = cvt_pk_bf16(v0[0], v0[1]); w.y = cvt_pk_bf16(v0[2], v0[3]); w.z = cvt_pk_bf16(v1[0], v1[1]); w.w = cvt_pk_bf16(v1[2], v1[3]); return w; }

struct EpiInProj {
    static constexpr bool PERM = true, AFTER_DRAIN = false;
    ArgsP A;
    __device__ __forceinline__ void operator()(const f32x4 (&acc)[2][2][4][2], const Unit& u, int wr, int wc, int fr_, int fq_) const {
        ArgsP a_ = A; asm volatile("" : "+s"(a_)); unsigned char* ws_ = a_->ws;
        bf16_t* Q = (bf16_t*)(ws_ + WS_Q); bf16_t* KB = (bf16_t*)(ws_ + WS_KB); bf16_t* VB = (bf16_t*)(ws_ + WS_VB); bf16_t* U = (bf16_t*)(ws_ + WS_U); bf16_t* VG = (bf16_t*)(ws_ + WS_VG);
        const float* qn = a_->in[I_QN]; const float* kn = a_->in[I_KN]; const float* gv = a_->in[I_GN]; const float* ropeC = (const float*)(ws_ + WS_ROPE); const float* ropeS = ropeC + 1024;
        const float qscale = 0.125f * 1.4426950408889634f;
        int t_ = threadIdx.x; asm volatile("" : "+v"(t_)); const int fr = t_ & 15, fq = (t_ >> 4) & 3; (void)fr_; (void)fq_;
        const int slot = 4 * u.pn + wc; const bool isctx = u.pm >= 128;
        const int rowl = wr * 64 + fr;
        const int row0 = u.pm * BM + rowl;
        const int kvrow0 = (isctx ? (u.pm - 128) * 4352 + 4096 : (u.pm >> 4) * 4352 + (u.pm & 15) * 256) + rowl;
        const int dl = 8 * fq;
        if (slot < 10) {
            const float* nw = slot < 8 ? qn : kn; const float osc = slot < 8 ? qscale : 1.0f;
            f32x4 w[2][2];
#pragma unroll
            for (int bj = 0; bj < 2; ++bj)
#pragma unroll
                for (int n = 0; n < 2; ++n) w[bj][n] = *(const f32x4*)(nw + 32 * bj + dl + 4 * n);
#pragma unroll
            for (int ai = 0; ai < 2; ++ai) {
                const int posr = (4 * u.pm + 2 * ai + wr) & 63;
                const f32x4 cr = *(const f32x4*)(ropeC + posr * 16 + 4 * fq), sr = *(const f32x4*)(ropeS + posr * 16 + 4 * fq);
#pragma unroll
                for (int m = 0; m < 4; ++m) {
                    float ss = 0.f;
#pragma unroll
                    for (int bj = 0; bj < 2; ++bj)
#pragma unroll
                        for (int n = 0; n < 2; ++n) { const f32x4 x = acc[ai][bj][m][n]; ss += (x[0] * x[0] + x[1] * x[1]) + (x[2] * x[2] + x[3] * x[3]); }
                    ss += __shfl_xor(ss, 16); ss += __shfl_xor(ss, 32);
                    const float r = __builtin_amdgcn_rsqf(ss * (1.0f / 64.0f) + 1e-6f) * osc;
                    const int posc = 16 * m + fr;
                    const f32x4 cc = *(const f32x4*)(ropeC + posc * 16 + 4 * fq), sc = *(const f32x4*)(ropeS + posc * 16 + 4 * fq);
#pragma unroll
                    for (int bj = 0; bj < 2; ++bj) {
                        f32x4 v0 = acc[ai][bj][m][0] * r * w[bj][0], v1 = acc[ai][bj][m][1] * r * w[bj][1];
                        if (!isctx) { const f32x4 c = bj ? cc : cr, s = bj ? sc : sr;
                            const f32x4 o0 = (f32x4){v0[0] * c[0] - v0[1] * s[0], v0[0] * s[0] + v0[1] * c[0], v0[2] * c[1] - v0[3] * s[1], v0[2] * s[1] + v0[3] * c[1]};
                            const f32x4 o1 = (f32x4){v1[0] * c[2] - v1[1] * s[2], v1[0] * s[2] + v1[1] * c[2], v1[2] * c[3] - v1[3] * s[3], v1[2] * s[3] + v1[3] * c[3]};
                            v0 = o0; v1 = o1; }
                        bf16_t* dst = slot < 8 ? Q + (size_t)(row0 + ai * HALF + m * 16) * 512 + slot * 64 + 32 * bj + dl
                                               : KB + (size_t)(kvrow0 + ai * HALF + m * 16) * 128 + (slot - 8) * 64 + 32 * bj + dl;
                        *(u32x4*)dst = pack8(v0, v1);
                    }
                    asm volatile("" ::: "memory");
                }
            }
        } else if (slot < 12) {
#pragma unroll
            for (int ai = 0; ai < 2; ++ai)
#pragma unroll
                for (int m = 0; m < 4; ++m)
#pragma unroll
                    for (int bj = 0; bj < 2; ++bj)
                        *(u32x4*)(VB + (size_t)(kvrow0 + ai * HALF + m * 16) * 128 + (slot - 10) * 64 + 32 * bj + dl) = pack8(acc[ai][bj][m][0], acc[ai][bj][m][1]);
        } else if (slot < 20) {
#pragma unroll
            for (int ai = 0; ai < 2; ++ai)
#pragma unroll
                for (int m = 0; m < 4; ++m)
#pragma unroll
                    for (int bj = 0; bj < 2; ++bj)
                        *(u32x4*)(U + (size_t)(row0 + ai * HALF + m * 16) * 512 + (slot - 12) * 64 + 32 * bj + dl) = pack8(gelu4(acc[ai][bj][m][0]), gelu4(acc[ai][bj][m][1]));
        } else {
            f32x4 w[2][2];
#pragma unroll
            for (int bj = 0; bj < 2; ++bj)
#pragma unroll
                for (int n = 0; n < 2; ++n) w[bj][n] = *(const f32x4*)(gv + (slot - 20) * 64 + 32 * bj + dl + 4 * n);
#pragma unroll
            for (int ai = 0; ai < 2; ++ai)
#pragma unroll
                for (int m = 0; m < 4; ++m) {
                    f32x4 g[2][2]; float ss = 0.f;
#pragma unroll
                    for (int bj = 0; bj < 2; ++bj)
#pragma unroll
                        for (int n = 0; n < 2; ++n) { const f32x4 x = gelu4(acc[ai][bj][m][n]); g[bj][n] = x; ss += (x[0] * x[0] + x[1] * x[1]) + (x[2] * x[2] + x[3] * x[3]); }
                    ss += __shfl_xor(ss, 16); ss += __shfl_xor(ss, 32);
                    const float r = __builtin_amdgcn_rsqf(ss * (1.0f / 64.0f) + 1e-6f);
#pragma unroll
                    for (int bj = 0; bj < 2; ++bj)
                        *(u32x4*)(VG + (size_t)(row0 + ai * HALF + m * 16) * 512 + (slot - 20) * 64 + 32 * bj + dl) = pack8(g[bj][0] * r * w[bj][0], g[bj][1] * r * w[bj][1]);
                }
        }
    }
};
constexpr int RS_M = 32768;
__device__ __forceinline__ float row_total(const float* part, int row, int fq) {
    const f32x4 p = *(const f32x4*)(part + ((size_t)fq * RS_M + row) * 4); float t = (p[0] + p[1]) + (p[2] + p[3]); t += __shfl_xor(t, 16); t += __shfl_xor(t, 32); return t;
}
template <int V> struct EpiResid {
    static constexpr bool PERM = true, AFTER_DRAIN = false, XNOUT = (V == 4), FINAL = (V == 10), BASE16 = (V != 4);
    ArgsP A; void* outp;
    __device__ __forceinline__ void operator()(f32x4 (&acc)[2][2][4][2], const Unit& u, int wr, int wc, int fr_, int fq_) const {
        int t_ = threadIdx.x; asm volatile("" : "+v"(t_)); const int fr = t_ & 15, fq = (t_ >> 4) & 3; (void)fr_; (void)fq_;
        const int row0 = u.pm * BM + wr * 64 + fr, col0 = u.pn * BM + wc * 32 + 8 * fq, b = u.pm >> 4;
        ArgsP a_ = A; asm volatile("" : "+s"(a_)); unsigned char* ws_ = a_->ws; constexpr int gstride = MODW;
        const float* mods_ = (const float*)(ws_ + WS_MODS); const float* modl_ = mods_ + (V == 10 ? 9 * MODW : 0);
        const float* basef = a_->in[I_X]; const bf16_t* baseh = (const bf16_t*)(ws_ + WS_RES); const float* gate = modl_ + (V == 4 ? GA1 : GA2);
        float* part = (float*)(ws_ + WS_PART) + (size_t)(V == 4 ? 0 : V == 10 ? 3 : 1) * 16 * RS_M;
        bf16_t* xn = (bf16_t*)(ws_ + WS_XN); const float* gnext = (V == 4) ? a_->in[I_GFFN] : a_->in[I_GMIX] + DM; const float* scnext = (V == 4) ? mods_ + SC2 : mods_ + 9 * MODW + SC1;
        unsigned* cnt = (unsigned*)(ws_ + WS_CTL + CTL_CNT); const float* gfin = a_->in[I_GFIN];
        bf16_t* resout = (bf16_t*)outp; float* out = (float*)outp;
        const float* gp = gate + (size_t)b * gstride + col0;
        f32x4 gvv[2][2], gmn[2][2];
#pragma unroll
        for (int bj = 0; bj < 2; ++bj)
#pragma unroll
            for (int n = 0; n < 2; ++n) { gvv[bj][n] = *(const f32x4*)(gp + bj * HALF + n * 4);
                if (XNOUT) gmn[bj][n] = *(const f32x4*)(gnext + col0 + bj * HALF + n * 4) * (*(const f32x4*)(scnext + (size_t)b * gstride + col0 + bj * HALF + n * 4) + 1.0f); }
        float ssv[2][4];
        f32x4 bsA[2][2], bsB[2][2], bsC[2][2], bsD[2][2], bsE[2][2], bsF[2][2], bsG[2][2], bsH[2][2];
        u32x4 hsA[2], hsB[2], hsC[2], hsD[2], hsE[2], hsF[2], hsG[2], hsH[2];
#define ER_LOAD(X, p) do { const size_t off_ = (size_t)(row0 + ((p) >> 2) * HALF + ((p) & 3) * 16) * 1024 + col0; \
            _Pragma("unroll") for (int bj = 0; bj < 2; ++bj) { if (BASE16) { if (FINAL) hs##X[bj] = __builtin_nontemporal_load((const u32x4*)(baseh + off_ + bj * HALF)); else hs##X[bj] = *(const u32x4*)(baseh + off_ + bj * HALF); } \
                else { bs##X[bj][0] = __builtin_nontemporal_load((const f32x4*)(basef + off_ + bj * HALF)); bs##X[bj][1] = __builtin_nontemporal_load((const f32x4*)(basef + off_ + bj * HALF + 4)); } } } while (0)
#define ER_WORK(X, p) do { const int ai = (p) >> 2, m = (p) & 3; const size_t off_ = (size_t)(row0 + ai * HALF + m * 16) * 1024 + col0; float ss = 0.f; \
            _Pragma("unroll") for (int bj = 0; bj < 2; ++bj) { f32x4 b0, b1; \
                if (BASE16) { const u32x4 h = hs##X[bj]; b0 = (f32x4){__builtin_bit_cast(float, h.x << 16), __builtin_bit_cast(float, h.x & 0xffff0000u), __builtin_bit_cast(float, h.y << 16), __builtin_bit_cast(float, h.y & 0xffff0000u)}; \
                    b1 = (f32x4){__builtin_bit_cast(float, h.z << 16), __builtin_bit_cast(float, h.z & 0xffff0000u), __builtin_bit_cast(float, h.w << 16), __builtin_bit_cast(float, h.w & 0xffff0000u)}; } \
                else { b0 = bs##X[bj][0]; b1 = bs##X[bj][1]; } \
                const f32x4 x0 = b0 + gvv[bj][0] * acc[ai][bj][m][0], x1 = b1 + gvv[bj][1] * acc[ai][bj][m][1]; \
                ss += ((x0[0] * x0[0] + x0[1] * x0[1]) + (x0[2] * x0[2] + x0[3] * x0[3])) + ((x1[0] * x1[0] + x1[1] * x1[1]) + (x1[2] * x1[2] + x1[3] * x1[3])); \
                if (FINAL) { acc[ai][bj][m][0] = x0; acc[ai][bj][m][1] = x1; } else *(u32x4*)(resout + off_ + bj * HALF) = pack8(x0, x1); \
                if (XNOUT) *(u32x4*)(xn + off_ + bj * HALF) = pack8(x0 * gmn[bj][0], x1 * gmn[bj][1]); } \
            ss += __shfl_xor(ss, 16); ss += __shfl_xor(ss, 32); ssv[ai][m] = ss; } while (0)
#define ER_FENCE asm volatile("" ::: "memory")
        if constexpr (FINAL) {
            ER_LOAD(A, 0); ER_LOAD(B, 1); ER_LOAD(C, 2); ER_LOAD(D, 3); ER_LOAD(E, 4); ER_LOAD(F, 5); ER_LOAD(G, 6); ER_LOAD(H, 7); ER_FENCE;
            ER_WORK(A, 0); ER_WORK(B, 1); ER_WORK(C, 2); ER_WORK(D, 3); ER_WORK(E, 4); ER_WORK(F, 5); ER_WORK(G, 6); ER_WORK(H, 7);
        } else if constexpr (BASE16) {
            ER_LOAD(A, 0); ER_LOAD(B, 1); ER_LOAD(C, 2); ER_LOAD(D, 3); ER_FENCE;
            ER_LOAD(E, 4); ER_FENCE; ER_WORK(A, 0); ER_FENCE;
            ER_LOAD(A, 5); ER_FENCE; ER_WORK(B, 1); ER_FENCE;
            ER_LOAD(B, 6); ER_FENCE; ER_WORK(C, 2); ER_FENCE;
            ER_LOAD(C, 7); ER_FENCE; ER_WORK(D, 3); ER_FENCE;
            ER_WORK(E, 4); ER_FENCE; ER_WORK(A, 5); ER_FENCE; ER_WORK(B, 6); ER_FENCE; ER_WORK(C, 7);
        } else {
            ER_LOAD(A, 0); ER_LOAD(B, 1); ER_FENCE;
            ER_LOAD(C, 2); ER_FENCE; ER_WORK(A, 0); ER_FENCE;
            ER_LOAD(A, 3); ER_FENCE; ER_WORK(B, 1); ER_FENCE;
            ER_LOAD(B, 4); ER_FENCE; ER_WORK(C, 2); ER_FENCE;
            ER_LOAD(C, 5); ER_FENCE; ER_WORK(A, 3); ER_FENCE;
            ER_LOAD(A, 6); ER_FENCE; ER_WORK(B, 4); ER_FENCE;
            ER_LOAD(B, 7); ER_FENCE; ER_WORK(C, 5); ER_FENCE;
            ER_WORK(A, 6); ER_FENCE;
            ER_WORK(B, 7);
        }
#undef ER_FENCE
#undef ER_LOAD
#undef ER_WORK
        if (fq == 0) {
#pragma unroll
            for (int ai = 0; ai < 2; ++ai)
#pragma unroll
                for (int m = 0; m < 4; ++m) { float* pp = part + ((size_t)u.pn * RS_M + (row0 + ai * HALF + m * 16)) * 4 + wc;
                    if (FINAL) __hip_atomic_store(pp, ssv[ai][m], __ATOMIC_RELAXED, __HIP_MEMORY_SCOPE_AGENT); else *pp = ssv[ai][m]; }
        }
        if (FINAL) {
            asm volatile("s_waitcnt vmcnt(0)" ::: "memory");
            unsigned* cw = cnt + 64 * u.pm;
            if (fr == 0 && fq == 0) __hip_atomic_fetch_add(cw, 1u, __ATOMIC_RELAXED, __HIP_MEMORY_SCOPE_AGENT);
            { unsigned sp = 0; while ((unsigned)__builtin_amdgcn_readfirstlane(__hip_atomic_load(cw, __ATOMIC_RELAXED, __HIP_MEMORY_SCOPE_AGENT)) < 32u) { __builtin_amdgcn_s_sleep(2); if (++sp > (1u << 22)) break; } }
            f32x4 gf[2][2];
#pragma unroll
            for (int bj = 0; bj < 2; ++bj)
#pragma unroll
                for (int n = 0; n < 2; ++n) gf[bj][n] = *(const f32x4*)(gfin + col0 + bj * HALF + n * 4);
            float rr[2][4];
            {
                f32x4 pq[8];
#pragma unroll
                for (int i = 0; i < 8; ++i) { const float* pp = part + ((size_t)fq * RS_M + (row0 + (i >> 2) * HALF + (i & 3) * 16)) * 4;
                    asm volatile("global_load_dwordx4 %0, %1, off sc1" : "=v"(pq[i]) : "v"(pp) : "memory"); }
                asm volatile("s_waitcnt vmcnt(0)" : "+v"(pq[0]), "+v"(pq[1]), "+v"(pq[2]), "+v"(pq[3]), "+v"(pq[4]), "+v"(pq[5]), "+v"(pq[6]), "+v"(pq[7]) :: "memory");
#pragma unroll
                for (int i = 0; i < 8; ++i) { float t = (pq[i][0] + pq[i][1]) + (pq[i][2] + pq[i][3]); t += __shfl_xor(t, 16); t += __shfl_xor(t, 32); rr[i >> 2][i & 3] = __builtin_amdgcn_rsqf(t * (1.0f / 1024.0f) + 1e-6f); }
            }
#pragma unroll
            for (int ai = 0; ai < 2; ++ai)
#pragma unroll
                for (int m = 0; m < 4; ++m) { const size_t off = (size_t)(row0 + ai * HALF + m * 16) * 1024 + col0;
#pragma unroll
                    for (int bj = 0; bj < 2; ++bj)
#pragma unroll
                        for (int n = 0; n < 2; ++n) *(f32x4*)(out + off + bj * HALF + n * 4) = acc[ai][bj][m][n] * rr[ai][m] * gf[bj][n]; }
        }
    }
};
template <int L> struct EpiSwiglu {
    static constexpr bool PERM = true, AFTER_DRAIN = false;
    ArgsP A; const PG8_LAS float* rtab; int pm0;
    __device__ __forceinline__ void operator()(const f32x4 (&acc)[2][2][4][2], const Unit& u, int wr, int wc, int fr_, int fq_) const {
        int t_ = threadIdx.x; asm volatile("" : "+v"(t_)); const int fr = t_ & 15, fq = (t_ >> 4) & 3; (void)fr_; (void)fq_;
        const int row0 = u.pm * BM + wr * 64 + fr, col0 = u.pn * HALF + wc * 32 + 8 * fq;
        ArgsP a_ = A; asm volatile("" : "+s"(a_)); unsigned char* ws_ = a_->ws; constexpr int ldh = FF;
        bf16_t* H = (bf16_t*)(ws_ + WS_H); const float* rowss = (const float*)(ws_ + WS_PART) + (size_t)(L ? 2 : 0) * 16 * RS_M; const float* bias = (const float*)(ws_ + WS_BIAS) + (size_t)L * 8 * 5632;
        const float* bp = bias + (size_t)(u.pm >> 4) * 5632 + u.pn * BM + wc * 32 + 8 * fq;
        f32x4 bv[2][2];
#pragma unroll
        for (int bj = 0; bj < 2; ++bj)
#pragma unroll
            for (int n = 0; n < 2; ++n) bv[bj][n] = *(const f32x4*)(bp + bj * HALF + 4 * n);
        float rr[2][4]; { const PG8_LAS float* rt = rtab + (u.pm == pm0 ? 0 : 256) + wr * 64 + fr; (void)rowss;
#pragma unroll
            for (int ai = 0; ai < 2; ++ai)
#pragma unroll
                for (int m = 0; m < 4; ++m) rr[ai][m] = rt[ai * HALF + m * 16]; }
#pragma unroll
        for (int ai = 0; ai < 2; ++ai)
#pragma unroll
            for (int m = 0; m < 4; ++m) { const int row = row0 + ai * HALF + m * 16; const float r = rr[ai][m]; f32x4 h[2];
#pragma unroll
                for (int n = 0; n < 2; ++n) { const f32x4 a = acc[ai][0][m][n] * r + bv[0][n], b = acc[ai][1][m][n] * r + bv[1][n]; h[n] = (f32x4){silu1(a[0]) * b[0], silu1(a[1]) * b[1], silu1(a[2]) * b[2], silu1(a[3]) * b[3]}; }
                *(u32x4*)(H + (size_t)row * ldh + col0) = pack8(h[0], h[1]); }
    }
};

struct EpiNull {
    static constexpr bool PERM = true, AFTER_DRAIN = false;
    bf16_t* D;
    __device__ __forceinline__ void operator()(const f32x4 (&acc)[2][2][4][2], const Unit& u, int wr, int wc, int fr_, int fq_) const {
        int t_ = threadIdx.x; asm volatile("" : "+v"(t_)); const int fr = t_ & 15, fq = (t_ >> 4) & 3; (void)fr_; (void)fq_;
        const int row0 = u.pm * BM + wr * 64 + fr, col0 = u.pn * BM + wc * 32 + 8 * fq;
#pragma unroll
        for (int ai = 0; ai < 2; ++ai)
#pragma unroll
            for (int m = 0; m < 4; ++m)
#pragma unroll
                for (int bj = 0; bj < 2; ++bj) *(u32x4*)(D + (size_t)(row0 + ai * HALF + m * 16) * 1024 + col0 + bj * HALF) = pack8(acc[ai][bj][m][0], acc[ai][bj][m][1]);
    }
};
struct EpiNullWide {
    static constexpr bool PERM = true, AFTER_DRAIN = false;
    bf16_t* D;
    __device__ __forceinline__ void operator()(const f32x4 (&acc)[2][2][4][2], const Unit& u, int wr, int wc, int fr_, int fq_) const {
        int t_ = threadIdx.x; asm volatile("" : "+v"(t_)); const int fr = t_ & 15, fq = (t_ >> 4) & 3; (void)fr_; (void)fq_;
        const int row0 = u.pm * BM + wr * 64 + fr, col0 = u.pn * HALF + wc * 32 + 8 * fq;
#pragma unroll
        for (int ai = 0; ai < 2; ++ai)
#pragma unroll
            for (int m = 0; m < 4; ++m) *(u32x4*)(D + (size_t)(row0 + ai * HALF + m * 16) * 2816 + col0) = pack8(acc[ai][0][m][0] + acc[ai][1][m][0], acc[ai][0][m][1] + acc[ai][1][m][1]);
    }
};
struct EpiZ {
    static constexpr bool PERM = true, AFTER_DRAIN = false;
    ArgsP A;
    __device__ __forceinline__ void operator()(const f32x4 (&acc)[2][2][4][2], const Unit& u, int wr, int wc, int fr_, int fq_) const {
        int t_ = threadIdx.x; asm volatile("" : "+v"(t_)); const int fr = t_ & 15, fq = (t_ >> 4) & 3; (void)fr_; (void)fq_;
        const int row0 = u.pm * BM + wr * 64 + fr, col0 = u.pn * BM + wc * 32 + 8 * fq;
        ArgsP a_ = A; asm volatile("" : "+s"(a_)); unsigned char* ws_ = a_->ws; bf16_t* Z = (bf16_t*)(ws_ + WS_AM); const float* rowss = (const float*)(ws_ + WS_PART) + (size_t)16 * RS_M;
        float rr[2][4];
#pragma unroll
        for (int ai = 0; ai < 2; ++ai) {
#pragma unroll
            for (int m = 0; m < 4; ++m) rr[ai][m] = __builtin_amdgcn_rsqf(row_total(rowss, row0 + ai * HALF + m * 16, fq) * (1.0f / 1024.0f) + 1e-6f);
            asm volatile("" ::: "memory"); }
#pragma unroll
        for (int ai = 0; ai < 2; ++ai)
#pragma unroll
            for (int m = 0; m < 4; ++m)
#pragma unroll
                for (int bj = 0; bj < 2; ++bj) *(u32x4*)(Z + (size_t)(row0 + ai * HALF + m * 16) * 1024 + col0 + bj * HALF) = pack8(acc[ai][bj][m][0] * rr[ai][m], acc[ai][bj][m][1] * rr[ai][m]);
    }
};

template <class Epi, class Sched, bool ALIGN_EPI = false, bool SP2 = false>
__device__ __forceinline__ void gemm_phase(PG8_LAS unsigned char* lds, const Gemm g, const Sched& S, const Epi& E) {
    int tid_ = threadIdx.x; asm volatile("" : "+v"(tid_));
    const int tid = tid_, wid = __builtin_amdgcn_readfirstlane(tid >> 6), lane = tid & 63, wr = wid >> 2, wc = wid & 3, fr = lane & 15, fq = lane >> 4;
    const int K = g.K, nt = K / BK;
    unsigned voffA[2], voffB[2];
#pragma unroll
    for (int i = 0; i < 2; ++i) { int R, C; stage_rc(tid * 16 + i * 8192, R, C); const int Rb = Epi::PERM ? ((R & ~31) + perm32(R & 31)) : R;
        voffA[i] = (unsigned)(R * g.lda + C) * 2u; voffB[i] = (unsigned)(Rb * K + C) * 2u; }
    const size_t kstep = (size_t)(BK * 2);
    const size_t hsA = (size_t)HALF * g.lda * 2, hsB = (size_t)HALF * K * 2;
    const size_t tsA = 2 * hsA, tsB = 2 * hsB;
    const unsigned ldsw = (unsigned)wid * 1024u;
    const int aoff = lds_byte(wr * 64 + fr, fq * 8), boff = lds_byte(wc * 32 + fr, fq * 8);
#define PG8_SA(b, h) (((b) * 2 + (h)) * HTB)
#define PG8_SB(b, h) ((4 + (b) * 2 + (h)) * HTB)
#define PG8_STAGE(bufoff, gbase, voff) do { _Pragma("unroll") for (int _i = 0; _i < 2; ++_i) \
        __builtin_amdgcn_global_load_lds((const unsigned*)((const char*)(gbase) + (voff)[_i]), (PG8_LAS unsigned*)(lds + (bufoff) + ldsw + _i * 8192), 16, 0, 0); } while (0)
#define PG8_LDA(dst, b, h) do { _Pragma("unroll") for (int m = 0; m < 4; ++m) _Pragma("unroll") for (int k = 0; k < 2; ++k) dst[m][k] = *(const PG8_LAS bf16x8*)(lds + PG8_SA(b, h) + aoff + m * 2048 + k * 1024); } while (0)
#define PG8_LDB(dst, b, h) do { _Pragma("unroll") for (int n = 0; n < 2; ++n) _Pragma("unroll") for (int k = 0; k < 2; ++k) dst[n][k] = *(const PG8_LAS bf16x8*)(lds + PG8_SB(b, h) + boff + n * 2048 + k * 1024); } while (0)
#define PG8_MMA(ai, bj, At, Bt) do { __builtin_amdgcn_s_setprio(1); _Pragma("unroll") for (int m = 0; m < 4; ++m) _Pragma("unroll") for (int n = 0; n < 2; ++n) _Pragma("unroll") for (int k = 0; k < 2; ++k) \
        acc[ai][bj][m][n] = __builtin_amdgcn_mfma_f32_16x16x32_bf16(Bt[n][k], At[m][k], acc[ai][bj][m][n], 0, 0, 0); __builtin_amdgcn_s_setprio(0); } while (0)
#define PG8_WAIT_V(n) asm volatile("s_waitcnt vmcnt(" #n ")" ::: "memory")
#define PG8_WAIT_L(n) asm volatile("s_waitcnt lgkmcnt(" #n ")" ::: "memory")
#define PG8_BAR __builtin_amdgcn_s_barrier()
#define PG8_SCHED __builtin_amdgcn_sched_barrier(0)
    Unit cur, nxt; int ui = 0;
    if (!S.next(0, cur)) return;
    f32x4 acc[2][2][4][2];
#pragma unroll
    for (int a = 0; a < 2; ++a)
#pragma unroll
        for (int b = 0; b < 2; ++b)
#pragma unroll
            for (int m = 0; m < 4; ++m)
#pragma unroll
                for (int n = 0; n < 2; ++n) acc[a][b][m][n] = (f32x4){0.f, 0.f, 0.f, 0.f};
    bf16x8 At[4][2], B0[2][2], B1[2][2];
    const char* cA = (const char*)g.A + (size_t)cur.pm * tsA + (size_t)cur.pn * g.a_pn_bytes; const char* cB = (const char*)g.Bt + (size_t)cur.pn * tsB + (size_t)(cur.pm >> 4) * g.b_batch_bytes;
    S.a_ready(cur);
    if constexpr (SP2) {
        PG8_STAGE(PG8_SB(0, 0), cB, voffB); PG8_STAGE(PG8_SB(0, 1), cB + hsB, voffB); PG8_STAGE(PG8_SA(0, 0), cA, voffA); PG8_STAGE(PG8_SA(0, 1), cA + hsA, voffA);
        if (wr == 1) PG8_BAR;
        PG8_WAIT_V(2); PG8_BAR;
        PG8_STAGE(PG8_SB(1, 0), cB + kstep, voffB); PG8_STAGE(PG8_SA(1, 0), cA + kstep, voffA); PG8_STAGE(PG8_SB(1, 1), cB + hsB + kstep, voffB);
        PG8_WAIT_V(6); PG8_BAR;
    } else {
        PG8_STAGE(PG8_SB(0, 0), cB, voffB); PG8_STAGE(PG8_SA(0, 0), cA, voffA); PG8_STAGE(PG8_SB(0, 1), cB + hsB, voffB); PG8_STAGE(PG8_SA(0, 1), cA + hsA, voffA);
        if (wr == 1) PG8_BAR;
        PG8_WAIT_V(4); PG8_BAR;
        PG8_STAGE(PG8_SB(1, 0), cB + kstep, voffB); PG8_STAGE(PG8_SA(1, 0), cA + kstep, voffA); PG8_STAGE(PG8_SB(1, 1), cB + hsB + kstep, voffB);
        PG8_WAIT_V(6); PG8_BAR;
    }
    for (;;) {
        const bool has_next = S.next(ui + 1, nxt);
        const char* nA = has_next ? (const char*)g.A + (size_t)nxt.pm * tsA + (size_t)nxt.pn * g.a_pn_bytes : cA; const char* nB = has_next ? (const char*)g.Bt + (size_t)nxt.pn * tsB + (size_t)(nxt.pm >> 4) * g.b_batch_bytes : cB;
#pragma unroll 1
        for (int t = 0; t < nt; t += 2) {
            const bool last = (t == nt - 2);
            const char* a1 = cA + (size_t)(t + 1) * kstep;
            const char* a2 = last ? nA : cA + (size_t)(t + 2) * kstep; const char* b2 = last ? nB : cB + (size_t)(t + 2) * kstep;
            const char* a3 = a2 + kstep; const char* b3 = b2 + kstep;
            if (last && has_next) S.a_ready(nxt);
            if constexpr (SP2) {
            PG8_LDB(B0, 0, 0); PG8_LDB(B1, 0, 1); PG8_SCHED; PG8_LDA(At, 0, 0); PG8_STAGE(PG8_SA(1, 1), a1 + hsA, voffA);
            PG8_WAIT_V(8); PG8_WAIT_L(0); PG8_BAR; PG8_MMA(0, 0, At, B0); PG8_MMA(0, 1, At, B1); PG8_BAR; PG8_SCHED;
            PG8_LDA(At, 0, 1); PG8_STAGE(PG8_SB(0, 0), b2, voffB); PG8_STAGE(PG8_SB(0, 1), b2 + hsB, voffB); PG8_STAGE(PG8_SA(0, 0), a2, voffA);
            PG8_WAIT_V(8); PG8_WAIT_L(0); PG8_BAR; PG8_MMA(1, 0, At, B0); PG8_MMA(1, 1, At, B1); PG8_BAR; PG8_SCHED;
            PG8_LDB(B0, 1, 0); PG8_LDB(B1, 1, 1); PG8_SCHED; PG8_LDA(At, 1, 0); PG8_STAGE(PG8_SA(0, 1), a2 + hsA, voffA);
            PG8_WAIT_V(8); PG8_WAIT_L(0); PG8_BAR; PG8_MMA(0, 0, At, B0); PG8_MMA(0, 1, At, B1); PG8_BAR; PG8_SCHED;
            PG8_LDA(At, 1, 1); PG8_STAGE(PG8_SB(1, 0), b3, voffB); PG8_STAGE(PG8_SB(1, 1), b3 + hsB, voffB); PG8_STAGE(PG8_SA(1, 0), a3, voffA);
            PG8_WAIT_V(8); PG8_WAIT_L(0); PG8_BAR; PG8_MMA(1, 0, At, B0); PG8_MMA(1, 1, At, B1); PG8_BAR; PG8_SCHED;
            } else {
            PG8_LDB(B0, 0, 0); PG8_SCHED; PG8_LDA(At, 0, 0); PG8_STAGE(PG8_SA(1, 1), a1 + hsA, voffA);
            PG8_WAIT_L(8); PG8_BAR; PG8_WAIT_L(0); PG8_MMA(0, 0, At, B0); PG8_BAR; PG8_SCHED;
            PG8_LDB(B1, 0, 1); PG8_STAGE(PG8_SB(0, 0), b2, voffB);
            PG8_BAR; PG8_WAIT_L(0); PG8_MMA(0, 1, At, B1); PG8_BAR;
            PG8_LDA(At, 0, 1); PG8_STAGE(PG8_SA(0, 0), a2, voffA);
            PG8_BAR; PG8_WAIT_L(0); PG8_MMA(1, 0, At, B0); PG8_BAR; PG8_SCHED;
            PG8_STAGE(PG8_SB(0, 1), b2 + hsB, voffB);
            PG8_WAIT_V(6); PG8_BAR; PG8_MMA(1, 1, At, B1); PG8_BAR;
            PG8_LDB(B0, 1, 0); PG8_SCHED; PG8_LDA(At, 1, 0); PG8_STAGE(PG8_SA(0, 1), a2 + hsA, voffA);
            PG8_WAIT_L(8); PG8_BAR; PG8_WAIT_L(0); PG8_MMA(0, 0, At, B0); PG8_BAR; PG8_SCHED;
            PG8_LDB(B1, 1, 1); PG8_STAGE(PG8_SB(1, 0), b3, voffB);
            PG8_BAR; PG8_WAIT_L(0); PG8_MMA(0, 1, At, B1); PG8_BAR;
            PG8_LDA(At, 1, 1); PG8_STAGE(PG8_SA(1, 0), a3, voffA);
            PG8_BAR; PG8_WAIT_L(0); PG8_MMA(1, 0, At, B0); PG8_BAR; PG8_SCHED;
            PG8_STAGE(PG8_SB(1, 1), b3 + hsB, voffB);
            PG8_WAIT_V(6); PG8_BAR; PG8_MMA(1, 1, At, B1); PG8_BAR;
            }
        }
        if constexpr (ALIGN_EPI) { if (wr == 0) PG8_BAR; }
        if constexpr (!Epi::AFTER_DRAIN) { E(acc, cur, wr, wc, fr, fq); S.done(cur); }
        if (!has_next) break;
#pragma unroll
        for (int a = 0; a < 2; ++a)
#pragma unroll
            for (int b = 0; b < 2; ++b)
#pragma unroll
                for (int m = 0; m < 4; ++m)
#pragma unroll
                    for (int n = 0; n < 2; ++n) acc[a][b][m][n] = (f32x4){0.f, 0.f, 0.f, 0.f};
        cur = nxt; cA = nA; cB = nB; ++ui;
        if constexpr (ALIGN_EPI) { if (wr == 1) PG8_BAR; }
    }
    PG8_WAIT_V(0);
    if constexpr (!ALIGN_EPI) { if (wr == 0) PG8_BAR; }
    PG8_BAR;
    if constexpr (Epi::AFTER_DRAIN) { E.fused(acc, cur, wr, wc, fr, fq, lds, wid, lane); S.done(cur); }
#undef PG8_SA
#undef PG8_SB
#undef PG8_STAGE
#undef PG8_LDA
#undef PG8_LDB
#undef PG8_MMA
#undef PG8_WAIT_V
#undef PG8_WAIT_L
#undef PG8_BAR
#undef PG8_SCHED
}
}
namespace attn_body {
using bf16=__hip_bfloat16;
using bf16x8=__attribute__((ext_vector_type(8)))short;
using s16x4=__attribute__((ext_vector_type(4)))short;
using f32x16=__attribute__((ext_vector_type(16)))float;
using u32x4=__attribute__((ext_vector_type(4)))unsigned;
constexpr int BATCH=8,NHEAD=8,NKVH=2,SEQ=4096,SKV=4352,D=64,QP=512,KP=128,OP=1024;
constexpr int NW=8,QBLK=32,QB=QBLK*NW,KVBLK=64,NQB=SEQ/QB;
constexpr int ATTN_UNIT_ROWS=QB;
__device__ __forceinline__ int crow(int r,int hi){return (r&3)+8*(r>>2)+4*hi;}
#define SBAR() __builtin_amdgcn_sched_barrier(0)
constexpr int NSLOT=3, SLOTB=8192;
constexpr int LDS_K=0, LDS_V=NSLOT*SLOTB, LDS_WS=2*NSLOT*SLOTB, LDS_OST=LDS_WS+NW*64*4, LDS_BYTES=LDS_OST+NW*4096;
constexpr float C2=0.125f*1.4426950408889634f;
__device__ __forceinline__ void glds16(const void*gsrc,unsigned lds_dst){unsigned keep;
  asm volatile("s_mov_b32 %0, m0\n\ts_mov_b32 m0, %2\n\ts_nop 0\n\tglobal_load_lds_dwordx4 %1, off\n\ts_mov_b32 m0, %0":"=&s"(keep):"v"(gsrc),"s"(lds_dst):"memory");}
__device__ __forceinline__ void glds16_nt(const void*gsrc,unsigned lds_dst){unsigned keep;
  asm volatile("s_mov_b32 %0, m0\n\ts_mov_b32 m0, %2\n\ts_nop 0\n\tglobal_load_lds_dwordx4 %1, off nt\n\ts_mov_b32 m0, %0":"=&s"(keep):"v"(gsrc),"s"(lds_dst):"memory");}
__device__ __forceinline__ float max3f(float a,float b,float c){float r;asm("v_max3_f32 %0, %1, %2, %3":"=v"(r):"v"(a),"v"(b),"v"(c));return r;}
__device__ __forceinline__ float max2f(float a,float b){float r;asm("v_max_f32_e32 %0, %1, %2":"=v"(r):"v"(a),"v"(b));return r;}
__device__ __forceinline__ float fadd_s(float a,float b){float r;asm("v_add_f32_e32 %0, %1, %2":"=v"(r):"v"(a),"v"(b));return r;}
__device__ __forceinline__ float fsub_s(float a,float b){float r;asm("v_sub_f32_e32 %0, %1, %2":"=v"(r):"v"(a),"v"(b));return r;}
typedef float f32x2_t __attribute__((ext_vector_type(2))); typedef __bf16 bf16x2_t __attribute__((ext_vector_type(2)));
__device__ __forceinline__ unsigned cvtpk_s(float lo,float hi){f32x2_t v={lo,hi};bf16x2_t b=__builtin_convertvector(v,bf16x2_t);return __builtin_bit_cast(unsigned,b);}
#define WAIT_BAR(N) asm volatile("s_waitcnt vmcnt(" #N ") lgkmcnt(0)\n\ts_barrier":::"memory")

__device__ __forceinline__ void qkt(f32x16&p0,f32x16&p1,const char*Kslot,const bf16x8*qr,const f32x16&negm,int r32,int hi){
  const char*kb=Kslot+hi*1024+r32*16;
  #pragma unroll
  for(int d0=0;d0<4;++d0){
    const bf16x8 b0=*reinterpret_cast<const bf16x8*>(kb+d0*2048);
    const bf16x8 b1=*reinterpret_cast<const bf16x8*>(kb+d0*2048+512);
    if(d0==0){p0=__builtin_amdgcn_mfma_f32_32x32x16_bf16(b0,qr[0],negm,0,0,0);p1=__builtin_amdgcn_mfma_f32_32x32x16_bf16(b1,qr[0],negm,0,0,0);}
    else{p0=__builtin_amdgcn_mfma_f32_32x32x16_bf16(b0,qr[d0],p0,0,0,0);p1=__builtin_amdgcn_mfma_f32_32x32x16_bf16(b1,qr[d0],p1,0,0,0);}}
}
typedef __attribute__((address_space(3))) const char* lds_cptr;
typedef short v4i16_t __attribute__((ext_vector_type(4)));
__device__ __forceinline__ void kload8(bf16x8*kf,lds_cptr kp){
  kf[0]=*(const __attribute__((address_space(3))) bf16x8*)(kp);      kf[1]=*(const __attribute__((address_space(3))) bf16x8*)(kp+512);
  kf[2]=*(const __attribute__((address_space(3))) bf16x8*)(kp+2048); kf[3]=*(const __attribute__((address_space(3))) bf16x8*)(kp+2560);
  kf[4]=*(const __attribute__((address_space(3))) bf16x8*)(kp+4096); kf[5]=*(const __attribute__((address_space(3))) bf16x8*)(kp+4608);
  kf[6]=*(const __attribute__((address_space(3))) bf16x8*)(kp+6144); kf[7]=*(const __attribute__((address_space(3))) bf16x8*)(kp+6656);
}
__device__ __forceinline__ void kload2(bf16x8*kf,lds_cptr kp,int j){ kf[2*j]=*(const __attribute__((address_space(3))) bf16x8*)(kp+j*2048); kf[2*j+1]=*(const __attribute__((address_space(3))) bf16x8*)(kp+j*2048+512); }
__device__ __forceinline__ s16x4 vtr(lds_cptr p){ return __builtin_bit_cast(s16x4,__builtin_amdgcn_ds_read_tr16_b64_v4i16((__attribute__((address_space(3))) v4i16_t*)p)); }
__device__ __forceinline__ float rowmax(const f32x16&p0,const f32x16&p1){
  float a=max3f(p0[0],p0[1],p1[0]),b=max3f(p0[2],p0[3],p1[1]);a=max3f(a,p1[2],p1[3]);
  #pragma unroll
  for(int r=4;r<16;r+=4){a=max3f(a,p0[r],p0[r+1]);b=max3f(b,p0[r+2],p0[r+3]);a=max3f(a,p1[r],p1[r+1]);b=max3f(b,p1[r+2],p1[r+3]);}
  const float m=max2f(a,b);
  auto rr=__builtin_amdgcn_permlane32_swap(__float_as_uint(m),__float_as_uint(m),false,false);
  return max2f(__uint_as_float(rr[0]),__uint_as_float(rr[1]));
}
__device__ __forceinline__ void pv(f32x16*o,int vb,bf16x8 pa0,bf16x8 pa1,bf16x8 pa2,bf16x8 pa3){
  #pragma unroll
  for(int d0=0;d0<2;++d0){s16x4 lo[4],hi[4];
    #pragma unroll
    for(int ks=0;ks<4;++ks){
      asm volatile("ds_read_b64_tr_b16 %0,%1 offset:%c2":"=&v"(lo[ks]):"v"(vb),"i"(d0*4096+ks*1024):"memory");
      asm volatile("ds_read_b64_tr_b16 %0,%1 offset:%c2":"=&v"(hi[ks]):"v"(vb),"i"(d0*4096+ks*1024+512):"memory");}
    asm volatile("s_waitcnt lgkmcnt(0)":::"memory");SBAR();
    #define PK(k) (bf16x8){lo[k][0],lo[k][1],lo[k][2],lo[k][3],hi[k][0],hi[k][1],hi[k][2],hi[k][3]}
    o[d0]=__builtin_amdgcn_mfma_f32_32x32x16_bf16(pa0,PK(0),o[d0],0,0,0);
    o[d0]=__builtin_amdgcn_mfma_f32_32x32x16_bf16(pa1,PK(1),o[d0],0,0,0);
    o[d0]=__builtin_amdgcn_mfma_f32_32x32x16_bf16(pa2,PK(2),o[d0],0,0,0);
    o[d0]=__builtin_amdgcn_mfma_f32_32x32x16_bf16(pa3,PK(3),o[d0],0,0,0);
    #undef PK
  }
}

#ifndef ATTN_STORE16
#define ATTN_STORE16(p,v) (*(u32x4*)(p)=(v))
#endif
template<int THRL,bool FIX> __device__ __forceinline__ void attn_unit(int b,int h,int qb,const bf16*Q,const bf16*__restrict__ K,const bf16*__restrict__ V,bf16*O,char*shm,float sref){
  int tid_=threadIdx.x; asm volatile("":"+v"(tid_)); const int tid=tid_,lane=tid&63,r32=lane&31,hi=lane>>5; const int wid=__builtin_amdgcn_readfirstlane(tid>>6);
  const long rowbase=(long)b*SEQ, kvbase=(long)b*SKV; const int q0=qb*QB;
  const bf16*Qw=Q+(rowbase+q0+wid*QBLK)*QP+h*D;
  const bf16*Kh=K+kvbase*KP+(h/(NHEAD/NKVH))*D,*Vh=V+kvbase*KP+(h/(NHEAD/NKVH))*D;
  const unsigned lds0=(unsigned)(uintptr_t)shm;
  float*wsf=(float*)(shm+LDS_WS)+wid*64;
  const bf16*ksrc=Kh+(long)lane*KP+wid*8;
  const bf16*vsrc=Vh+(long)(16*(wid&3)+(lane>>2))*KP+(wid>>2)*32+(lane&3)*8;
  const unsigned kdst=lds0+LDS_K+wid*1024, vdst=lds0+LDS_V+wid*1024;
  #define DMA_K(t,slot) glds16(ksrc+(long)(t)*KVBLK*KP,(unsigned)__builtin_amdgcn_readfirstlane(kdst+(slot)))
  #define DMA_V(t,slot) glds16(vsrc+(long)(t)*KVBLK*KP,(unsigned)__builtin_amdgcn_readfirstlane(vdst+(slot)))
  const int vb0=(int)(lds0+LDS_V)+((lane>>4)&1)*32+(lane&3)*8+(4*hi+((lane&15)>>2))*64;
  const char*Kbase=shm+LDS_K; bf16x8 kf[8];
  const lds_cptr shm3=(lds_cptr)shm; const lds_cptr kp0=shm3+LDS_K+hi*1024+r32*16; const lds_cptr vp0=shm3+LDS_V+((lane>>4)&1)*32+(lane&3)*8+(4*hi+((lane&15)>>2))*64;
  constexpr int NT=SKV/KVBLK;
  DMA_K(0,0);DMA_V(0,0);DMA_K(1,SLOTB);
  bf16x8 qr[4];
  #pragma unroll
  for(int d0=0;d0<4;++d0)qr[d0]=__builtin_nontemporal_load(reinterpret_cast<const bf16x8*>(&Qw[(long)r32*QP+d0*16+hi*8]));
  float mhat=0.f,l_reg=0.f;f32x16 o[2];o[0]=f32x16{};o[1]=f32x16{};f32x16 negm=f32x16{};
  if constexpr(FIX){ _Pragma("unroll") for(int r=0;r<16;++r)negm[r]=-sref; }
  asm volatile("":"+v"(negm));
  #define CMASK(P0,P1,t) do{}while(0)
  bool resc=false;
  #define START(P0,P1) do{ resc=false; if constexpr(!FIX) \
    { const float rm=rowmax(P0,P1); const float dl=rm; mhat=fadd_s(mhat,dl); \
      _Pragma("unroll") for(int r=0;r<16;++r){P0[r]=fsub_s(P0[r],dl);P1[r]=fsub_s(P1[r],dl);} \
      _Pragma("unroll") for(int r=0;r<16;++r)negm[r]=-mhat; asm volatile("":"+v"(negm)); } \
    _Pragma("unroll") for(int r=0;r<16;++r)P0[r]=__builtin_amdgcn_exp2f(P0[r]); }while(0)
  #define RESC() do{ if constexpr(!FIX) if(resc){ asm volatile("s_waitcnt lgkmcnt(0)":::"memory"); \
      _Pragma("unroll") for(int d_=0;d_<2;++d_) _Pragma("unroll") for(int r=0;r<16;++r)o[d_][r]*=wsf[crow(r,hi)]; } }while(0)
  f32x16 pA0,pA1,pB0,pB1;
  int sl_prev=0,sl_cur=0,sl_next=SLOTB;
  #define ROT() do{sl_prev=sl_cur;sl_cur=sl_next;sl_next=(sl_next==(NSLOT-1)*SLOTB)?0:sl_next+SLOTB;}while(0)
  DMA_K(2,2*SLOTB);
  WAIT_BAR(3);
  qkt(pA0,pA1,Kbase,qr,negm,r32,hi);asm volatile("s_nop 15\n\ts_nop 7":"+v"(pA0),"+v"(pA1));CMASK(pA0,pA1,0);
  START(pA0,pA1);
  _Pragma("unroll") for(int r=0;r<16;++r)pA1[r]=__builtin_amdgcn_exp2f(pA1[r]);
  WAIT_BAR(0);
  DMA_K(3,0);DMA_V(1,SLOTB);
  ROT();
  kload8(kf,kp0+sl_cur);
  WAIT_BAR(2);
  s16x4 vlo[8],vhi[8]; u32x4 pw0,pw1,pw2,pw3;
  #define PKW(P,B) cvtpk_s(P[B],P[B+1])
  #define PAF(k) __builtin_bit_cast(bf16x8,pw##k)
  #define VFR(i) (bf16x8){vlo[i][0],vlo[i][1],vlo[i][2],vlo[i][3],vhi[i][0],vhi[i][1],vhi[i][2],vhi[i][3]}
  #define PIN(x) asm volatile("":"+v"(x))
  #define MX3(a,b,c) __builtin_fmaxf(__builtin_fmaxf((a),(b)),(c))
  #define GAPA(MF,A0,A1,A2,A3,W0,W1,PW) do{ MF; sacc+=A0; sacc+=A1; sacc+=A2; sacc+=A3; PIN(sacc); W0; W1; PIN(PW); SBAR(); }while(0)
  #define EX(v) __builtin_amdgcn_exp2f(v)
  #define GAPB(MF,X,B) do{ MF; X[B]=EX(X[B]); X[B+1]=EX(X[B+1]); X[B+2]=EX(X[B+2]); X[B+3]=EX(X[B+3]); PIN(X); SBAR(); }while(0)
  #define VRD(i) do{ vlo[i]=vtr(vp_+(((i)>>2)*4096+((i)&3)*1024)); vhi[i]=vtr(vp_+(((i)>>2)*4096+((i)&3)*1024+512)); }while(0)
  #define KRD(G,j) do{ if(G){ kload2(kf,kp0+sl_next,j); SBAR(); } }while(0)
  #define STEP(C0,C1,P0,P1,t,GK,GV,GL) do{ SBAR(); \
    const lds_cptr vp_=vp0+sl_prev; \
    VRD(0); SBAR(); float sacc=(P0[0]+P0[1]); \
    GAPA(C0=__builtin_amdgcn_mfma_f32_32x32x16_bf16(kf[0],qr[0],negm,0,0,0), P0[2],P0[3],P0[4],P0[5],     pw0[0]=PKW(P0,0), pw0[1]=PKW(P0,2), pw0); \
    VRD(4); SBAR(); GAPA(C1=__builtin_amdgcn_mfma_f32_32x32x16_bf16(kf[1],qr[0],negm,0,0,0), P0[6],P0[7],P0[8],P0[9],     pw0[2]=PKW(P0,4), pw0[3]=PKW(P0,6), pw0); \
    VRD(1); SBAR(); GAPA(C0=__builtin_amdgcn_mfma_f32_32x32x16_bf16(kf[2],qr[1],C0,0,0,0),   P0[10],P0[11],P0[12],P0[13], pw1[0]=PKW(P0,8), pw1[1]=PKW(P0,10), pw1); \
    VRD(5); SBAR(); GAPA(C1=__builtin_amdgcn_mfma_f32_32x32x16_bf16(kf[3],qr[1],C1,0,0,0),   P0[14],P0[15],P1[0],P1[1],   pw1[2]=PKW(P0,12),pw1[3]=PKW(P0,14), pw1); \
    VRD(2); SBAR(); GAPA(C0=__builtin_amdgcn_mfma_f32_32x32x16_bf16(kf[4],qr[2],C0,0,0,0),   P1[2],P1[3],P1[4],P1[5],     pw2[0]=PKW(P1,0), pw2[1]=PKW(P1,2), pw2); \
    VRD(6); SBAR(); GAPA(C1=__builtin_amdgcn_mfma_f32_32x32x16_bf16(kf[5],qr[2],C1,0,0,0),   P1[6],P1[7],P1[8],P1[9],     pw2[2]=PKW(P1,4), pw2[3]=PKW(P1,6), pw2); \
    VRD(3); SBAR(); GAPA(C0=__builtin_amdgcn_mfma_f32_32x32x16_bf16(kf[6],qr[3],C0,0,0,0),   P1[10],P1[11],P1[12],P1[13], pw3[0]=PKW(P1,8), pw3[1]=PKW(P1,10), pw3); \
    VRD(7); SBAR(); GAPA(C1=__builtin_amdgcn_mfma_f32_32x32x16_bf16(kf[7],qr[3],C1,0,0,0),   P1[14],P1[15],0.f,0.f,       pw3[2]=PKW(P1,12),pw3[3]=PKW(P1,14), pw3); \
    l_reg+=sacc; \
    if(GK){DMA_K((t)+3,sl_cur);} if(GV){DMA_V((t)+1,sl_next);} \
    CMASK(C0,C1,t); \
    if constexpr(!FIX) { float a=MX3(C0[0],C0[1],C1[0]),b=MX3(C0[2],C0[3],C1[1]); a=MX3(a,C1[2],C1[3]); \
      _Pragma("unroll") for(int r=4;r<16;r+=4){a=MX3(a,C0[r],C0[r+1]);b=MX3(b,C0[r+2],C0[r+3]);a=MX3(a,C1[r],C1[r+1]);b=MX3(b,C1[r+2],C1[r+3]);} \
      float rm=__builtin_fmaxf(a,b); { auto rr=__builtin_amdgcn_permlane32_swap(__float_as_uint(rm),__float_as_uint(rm),false,false); rm=__builtin_fmaxf(__uint_as_float(rr[0]),__uint_as_float(rr[1])); } \
      resc=false; \
      if(__builtin_expect(__any(rm>(float)THRL),0)){ const float dl=__builtin_fmaxf(rm,0.f); mhat+=dl; \
        _Pragma("unroll") for(int r=0;r<16;++r){C0[r]-=dl;C1[r]-=dl;} \
        _Pragma("unroll") for(int r=0;r<16;++r)negm[r]=-mhat; asm volatile("":"+v"(negm)); \
        const float f=__builtin_amdgcn_exp2f(-dl); l_reg*=f; if(hi==0)wsf[r32]=f; resc=true; } } \
    SBAR(); \
    GAPB(o[0]=__builtin_amdgcn_mfma_f32_32x32x16_bf16(PAF(0),VFR(0),o[0],0,0,0), C0,0); \
    GAPB(o[1]=__builtin_amdgcn_mfma_f32_32x32x16_bf16(PAF(0),VFR(4),o[1],0,0,0), C0,4); \
    KRD(GL,0); GAPB(o[0]=__builtin_amdgcn_mfma_f32_32x32x16_bf16(PAF(1),VFR(1),o[0],0,0,0), C0,8); \
    KRD(GL,1); GAPB(o[1]=__builtin_amdgcn_mfma_f32_32x32x16_bf16(PAF(1),VFR(5),o[1],0,0,0), C0,12); \
    KRD(GL,2); GAPB(o[0]=__builtin_amdgcn_mfma_f32_32x32x16_bf16(PAF(2),VFR(2),o[0],0,0,0), C1,0); \
    KRD(GL,3); GAPB(o[1]=__builtin_amdgcn_mfma_f32_32x32x16_bf16(PAF(2),VFR(6),o[1],0,0,0), C1,4); \
    GAPB(o[0]=__builtin_amdgcn_mfma_f32_32x32x16_bf16(PAF(3),VFR(3),o[0],0,0,0), C1,8); \
    GAPB(o[1]=__builtin_amdgcn_mfma_f32_32x32x16_bf16(PAF(3),VFR(7),o[1],0,0,0), C1,12); \
    }while(0)
  int t=1;
  #undef CMASK
  #define CMASK(P0,P1,t) do{}while(0)
  for(;t+5<NT;t+=2){
    STEP(pB0,pB1,pA0,pA1,t,true,true,true);     WAIT_BAR(2); RESC(); ROT();
    STEP(pA0,pA1,pB0,pB1,t+1,true,true,true);   WAIT_BAR(2); RESC(); ROT();
  }
  #undef CMASK
  #define CMASK(P0,P1,t) do{}while(0)
  #define ENDW(tt) do{ if((tt)+3<NT){WAIT_BAR(2);} else if((tt)+2<NT){WAIT_BAR(1);} else {WAIT_BAR(0);} }while(0)
  for(;t+1<NT;t+=2){
    STEP(pB0,pB1,pA0,pA1,t,(t+3<NT),(t+1<NT),(t+1<NT));       ENDW(t);   RESC(); ROT();
    STEP(pA0,pA1,pB0,pB1,t+1,(t+4<NT),(t+2<NT),(t+2<NT));     ENDW(t+1); RESC(); ROT();
  }
  STEP(pB0,pB1,pA0,pA1,NT-1,false,false,false); RESC();
  { float sacc=pB0[0]+pB0[1]; _Pragma("unroll") for(int r=2;r<16;++r)sacc+=pB0[r]; _Pragma("unroll") for(int r=0;r<16;++r)sacc+=pB1[r]; l_reg+=sacc;
    pw0=(u32x4){PKW(pB0,0),PKW(pB0,2),PKW(pB0,4),PKW(pB0,6)};pw1=(u32x4){PKW(pB0,8),PKW(pB0,10),PKW(pB0,12),PKW(pB0,14)};pw2=(u32x4){PKW(pB1,0),PKW(pB1,2),PKW(pB1,4),PKW(pB1,6)};pw3=(u32x4){PKW(pB1,8),PKW(pB1,10),PKW(pB1,12),PKW(pB1,14)};
    SBAR(); pv(o,vb0+sl_cur,PAF(0),PAF(1),PAF(2),PAF(3)); }
  #undef PKW
  #undef PAF
  #undef VFR
  #undef PIN
  #undef MX3
  #undef GAPA
  #undef GAPB
  #undef EX
  #undef VRD
  #undef KRD
  #undef STEP
  #undef ENDW
  {auto rr=__builtin_amdgcn_permlane32_swap(__float_as_uint(l_reg),__float_as_uint(l_reg),false,false);l_reg=__uint_as_float(rr[0])+__uint_as_float(rr[1]);}
  if(hi==0)wsf[32+r32]=l_reg;asm volatile("s_waitcnt lgkmcnt(0)":::"memory");
  float rli[16];
  #pragma unroll
  for(int r=0;r<16;++r)rli[r]=__builtin_amdgcn_rcpf(wsf[32+crow(r,hi)]);
  bf16*Ow=O+(rowbase+q0+wid*QBLK)*OP+h*D;
  { bf16*stg=(bf16*)(shm+LDS_OST)+wid*2048;
    #pragma unroll
    for(int r=0;r<16;++r){const int orow=crow(r,hi);
      #pragma unroll
      for(int d0=0;d0<2;++d0)stg[orow*64+d0*32+r32]=__float2bfloat16(o[d0][r]*rli[r]);}
    asm volatile("s_waitcnt lgkmcnt(0)":::"memory");
    #pragma unroll
    for(int i=0;i<4;++i){const int row=i*8+(lane>>3),ch=lane&7; const u32x4 v=*(const u32x4*)(stg+row*64+ch*8); ATTN_STORE16(Ow+(long)row*OP+ch*8,v);} }
  asm volatile("s_waitcnt lgkmcnt(0)\n\ts_barrier":::"memory");
  #undef DMA_K
  #undef DMA_V
  #undef CMASK
  #undef START
  #undef RESC
  #undef ROT
}
constexpr int ATTN_LDS_BYTES=LDS_BYTES;
struct AttnTensors { const bf16* Q; const bf16* K; const bf16* V; bf16* O; };
struct AttnUnit { int bh; int qb; };
struct StaticOrder {
  int vcu,G;
  __device__ __forceinline__ explicit StaticOrder(int grid,int v):vcu(v),G(grid){}
  __device__ __forceinline__ bool next(int i,AttnUnit&u)const{ const int per=(BATCH*NHEAD*NQB)/G; if(i>=per)return false; const int x=vcu*per+i; u.bh=(x>>6)*4+((x&63)>>4); u.qb=x&15; return true; }
  __device__ __forceinline__ void a_ready(const AttnUnit&)const{}
  __device__ __forceinline__ void done(const AttnUnit&)const{}
};
template<class Sched,int THRL=8> __device__ __forceinline__ void attn_phase(char*lds,const AttnTensors&T,const Sched&S,const float*qnw,const float*knw){
  AttnUnit u;
  float mq=__builtin_fabsf(qnw[threadIdx.x&63]),mk=__builtin_fabsf(knw[threadIdx.x&63]);
  _Pragma("unroll") for(int o_=1;o_<64;o_<<=1){ mq=__builtin_fmaxf(mq,__shfl_xor(mq,o_)); mk=__builtin_fmaxf(mk,__shfl_xor(mk,o_)); }
  const float sref=C2*64.0f*1.02f*mq*mk;
  const bool fix=__builtin_amdgcn_readfirstlane((int)(sref<=40.0f && sref==sref))!=0;
  if(fix){ for(int i=0;S.next(i,u);++i){ S.a_ready(u); attn_unit<THRL,true>(u.bh/NHEAD,u.bh%NHEAD,u.qb,T.Q,T.K,T.V,T.O,lds,sref); S.done(u); } }
  else   { for(int i=0;S.next(i,u);++i){ S.a_ready(u); attn_unit<THRL,false>(u.bh/NHEAD,u.bh%NHEAD,u.qb,T.Q,T.K,T.V,T.O,lds,0.f); S.done(u); } }
}
#undef SBAR
#undef WAIT_BAR
}
#ifndef PG8_SP2
#define PG8_SP2 true
#endif
#ifndef PG8_ALIGN
#define PG8_ALIGN true
#endif
#define GAS __attribute__((address_space(1)))
#define LAS __attribute__((address_space(3)))
typedef unsigned short bf16;
typedef unsigned v4u __attribute__((ext_vector_type(4)));
typedef unsigned v2u __attribute__((ext_vector_type(2)));
typedef float f32x4 __attribute__((ext_vector_type(4)));
typedef float f32x2 __attribute__((ext_vector_type(2)));
typedef short bf16x8 __attribute__((ext_vector_type(8)));
typedef GAS unsigned gu32;
typedef GAS unsigned long long gu64;
#define RLX_AGENT __ATOMIC_RELAXED, __HIP_MEMORY_SCOPE_AGENT
#define LDS_WAIT() asm volatile("s_waitcnt lgkmcnt(0)" ::: "memory")
#define VM_WAIT() asm volatile("s_waitcnt vmcnt(0)" ::: "memory")
__device__ __forceinline__ unsigned f2bf(float f) { unsigned u = __builtin_bit_cast(unsigned, f); return (u + 0x7fffu + ((u >> 16) & 1u)) >> 16; }
__device__ __forceinline__ unsigned pk2(float lo, float hi) { unsigned r; asm("v_cvt_pk_bf16_f32 %0, %1, %2" : "=v"(r) : "v"(lo), "v"(hi)); return r; }
__device__ __forceinline__ float bf2f(unsigned h) { return __builtin_bit_cast(float, h << 16); }

#define XB_TMO      128
#define XB_XCNT(j)  (256  + 64 * (j))
#define XB_XSUB(j)  (1280 + 64 * (j))
#define XB_XGEN(j)  (2304 + 64 * (j))
#define XB_TOP      3328
#define XB_TOPGEN   3392
#define XCD_BAR_WORDS 3456
#define XB_SPIN_CAP (1u << 18)

__device__ __forceinline__ unsigned xb_ld(unsigned* p)              { return __hip_atomic_load(p, __ATOMIC_RELAXED, __HIP_MEMORY_SCOPE_AGENT); }
__device__ __forceinline__ unsigned xb_add(unsigned* p, unsigned v) { return __hip_atomic_fetch_add(p, v, __ATOMIC_RELAXED, __HIP_MEMORY_SCOPE_AGENT); }
__device__ __forceinline__ unsigned xb_xcc_id() { return (unsigned)__builtin_amdgcn_s_getreg((3 << 11) | 20) & 0xFu; }
#define XB_SPIN(cond, bar) do { unsigned _sp = 0; while (cond) { __builtin_amdgcn_s_sleep(1); \
    if ((++_sp & 255u) == 0u) { if (xb_ld(&(bar)[XB_TMO])) break; if (_sp > XB_SPIN_CAP) { atomicAdd(&(bar)[XB_TMO], 1u); break; } } } } while (0)

struct XcdBarrier {
    unsigned* bar; unsigned x;
    volatile LAS unsigned* st;
};

__device__ __forceinline__ XcdBarrier xcd_barrier_post(unsigned* bar, volatile LAS unsigned* st) {
    XcdBarrier b; b.bar = bar; b.x = xb_xcc_id(); b.st = st;
    if (threadIdx.x == 0) (void)xb_add(&bar[XB_XCNT(b.x)], 1u);
    return b;
}
__device__ __forceinline__ void xcd_barrier_complete(unsigned* bar, unsigned x, unsigned& nloc, unsigned& nx) {
    const unsigned G = gridDim.x * gridDim.y * gridDim.z;
    unsigned sum, cnt, mine, sp = 0u;
    for (;;) {
        sum = 0u; cnt = 0u; mine = 0u;
#pragma unroll
        for (unsigned j = 0; j < 16; ++j) { const unsigned c = xb_ld(&bar[XB_XCNT(j)]); sum += c; cnt += (c > 0u) ? 1u : 0u; mine = (j == x) ? c : mine; }
        if (sum == G) break;
        __builtin_amdgcn_s_sleep(1);
        if ((++sp & 255u) == 0u) { if (xb_ld(&bar[XB_TMO])) break; if (sp > XB_SPIN_CAP) { atomicAdd(&bar[XB_TMO], 1u); break; } }
    }
    nloc = mine > 0u ? mine : 1u; nx = cnt > 0u ? cnt : 1u;
}

__device__ __forceinline__ void xcd_barrier(const XcdBarrier& b) {
    asm volatile("s_waitcnt vmcnt(0)" ::: "memory");
    __syncthreads();
    if (threadIdx.x == 0) {
        unsigned* bar = b.bar;
        __builtin_amdgcn_s_waitcnt(0);
        unsigned nloc = b.st[0], nx = b.st[1];
        if (nloc == 0u) { xcd_barrier_complete(bar, b.x, nloc, nx); b.st[0] = nloc; b.st[1] = nx; }
        const unsigned old = xb_add(&bar[XB_XSUB(b.x)], 1u);
        const unsigned gen = old / nloc;
        if (old + 1u == (gen + 1u) * nloc) {
            __builtin_amdgcn_fence(__ATOMIC_RELEASE, "agent");
            asm volatile("s_waitcnt vmcnt(0)" ::: "memory");
            const unsigned og = xb_add(&bar[XB_TOP], 1u);
            const unsigned tg = og / nx;
            if (og + 1u == (tg + 1u) * nx) xb_add(&bar[XB_TOPGEN], 1u);
            else XB_SPIN(xb_ld(&bar[XB_TOPGEN]) == tg, bar);
            __builtin_amdgcn_fence(__ATOMIC_ACQUIRE, "agent");
            xb_add(&bar[XB_XGEN(b.x)], 1u);
            asm volatile("s_waitcnt vmcnt(0)" ::: "memory");
        } else {
            XB_SPIN(xb_ld(&bar[XB_XGEN(b.x)]) == gen, bar);
            __builtin_amdgcn_fence(__ATOMIC_ACQUIRE, "agent");
            asm volatile("s_waitcnt vmcnt(0)" ::: "memory");
        }
    }
    __syncthreads();
}
struct Frame {
    LAS unsigned char* lds;
    volatile LAS unsigned* MISC;
    gu32* ctl;
    int tid, lane, wave;
    int vcu, G;
};
__device__ __forceinline__ float wave_sum(float v) {
#pragma unroll
    for (int o = 1; o < 64; o <<= 1) v += __shfl_xor(v, o);
    return v;
}
__device__ __forceinline__ void p0_transpose_item(const float* W, int ldw, int k0, int n0, bf16* WT, int ldt, int dst_row0, LAS float* scr, int lane) {
#pragma unroll 8
    for (int i = 0; i < 32; ++i) { const int kk = 2 * i + (lane >> 5); scr[kk * 33 + (lane & 31)] = __builtin_nontemporal_load(W + (size_t)(k0 + kk) * ldw + n0 + (lane & 31)); }
    LDS_WAIT(); asm volatile("" ::: "memory");
    const int c = lane & 7;
#pragma unroll
    for (int j = 0; j < 4; ++j) { const int n = (lane >> 3) + 8 * j; const LAS float* s = scr + (8 * c) * 33 + n;
        v4u o; o.x = pk2(s[0 * 33], s[1 * 33]); o.y = pk2(s[2 * 33], s[3 * 33]); o.z = pk2(s[4 * 33], s[5 * 33]); o.w = pk2(s[6 * 33], s[7 * 33]);
        *(GAS v4u*)(WT + (size_t)(dst_row0 + n) * ldt + k0 + 8 * c) = o; }
    LDS_WAIT(); asm volatile("" ::: "memory");
}
__device__ __forceinline__ void p0_prologue(Frame& F, ArgsP ap) {
    unsigned char* ws = ap->ws;
    if (F.vcu < 192) {
        LAS float* sc = (LAS float*)(F.lds + RING_OFF); LAS float* part = sc + 9 * 1024;
        const float* c = ap->in[I_C]; const float* cctx = ap->in[I_CCTX];
        for (int i = F.tid; i < 9 * 1024; i += NWAVES * 64) { const int bb = i >> 10, k = i & 1023; const float v = bb < 8 ? c[bb * 1024 + k] : cctx[k]; sc[i] = v / (1.0f + expf(-v)); }
        __syncthreads();
        const int l = F.vcu / 96, cb = F.vcu % 96, k0 = F.wave * 128;
        const float* w = ap->in[I_WADA] + (size_t)l * DM * MODW + (size_t)k0 * MODW + cb * 64 + F.lane;
        float acc[9];
#pragma unroll
        for (int j = 0; j < 9; ++j) acc[j] = 0.f;
        for (int k = 0; k < 128; k += 8) {
            float wv[8];
#pragma unroll
            for (int q = 0; q < 8; ++q) wv[q] = __builtin_nontemporal_load(w + (size_t)(k + q) * MODW);
#pragma unroll
            for (int j = 0; j < 9; ++j) { const f32x4 s0 = *(const LAS f32x4*)(sc + j * 1024 + k0 + k), s1 = *(const LAS f32x4*)(sc + j * 1024 + k0 + k + 4);
                acc[j] += (s0[0] * wv[0] + s0[1] * wv[1]) + (s0[2] * wv[2] + s0[3] * wv[3]) + (s1[0] * wv[4] + s1[1] * wv[5]) + (s1[2] * wv[6] + s1[3] * wv[7]); }
        }
#pragma unroll
        for (int j = 0; j < 9; ++j) part[(F.wave * 9 + j) * 64 + F.lane] = acc[j];
        __syncthreads();
        float* mods = (float*)(ws + WS_MODS);
        for (int idx = F.tid; idx < 9 * 64; idx += NWAVES * 64) { const int j = idx >> 6, col = idx & 63; float s = 0.f;
#pragma unroll
            for (int wv_ = 0; wv_ < 8; ++wv_) s += part[(wv_ * 9 + j) * 64 + col];
            mods[(size_t)(l * 9 + j) * MODW + cb * 64 + col] = s + ap->in[I_BADA][l * MODW + cb * 64 + col]; }
        __syncthreads();
    } else if (F.vcu == F.G - 1) {
        float* rc = (float*)(ws + WS_ROPE); float* rs = rc + 1024;
        for (int e = F.tid; e < 1024; e += NWAVES * 64) { const int pos = e >> 4, i = e & 15; const float fr = powf(10000.0f, -(float)(2 * i) / 32.0f); const float a = (float)pos * fr; rc[e] = cosf(a); rs[e] = sinf(a); }
    }
    LAS float* scr = (LAS float*)(F.lds + RING_OFF + F.wave * 16384);
    const int gw = F.vcu * NWAVES + F.wave, NGW = F.G * NWAVES;
    constexpr int I_IN = 16 * 56, I_OUT = 16 * 32, I_13 = 16 * 88, I_2 = 44 * 32, I_P = 4 * 8;
    constexpr int NITEMS = I_IN + I_OUT + 4 * I_13 + 2 * I_2 + 4 * I_P;
    for (int it = gw; it < NITEMS; it += NGW) {
        int r = it;
        if (r < I_IN) { const int kb = r / 56, nb = r % 56, f = 32 * nb, slot = f >> 6, bj = (f >> 5) & 1, pn = slot >> 2, wc = slot & 3;
            p0_transpose_item(ap->in[I_WIN], INW, 64 * kb, f, (bf16*)(ws + WS_WIN), DM, 256 * pn + 128 * bj + 32 * wc, scr, F.lane); continue; } r -= I_IN;
        if (r < I_OUT) { const int kb = r / 32, nb = r % 32; p0_transpose_item(ap->in[I_WOUT], DM, 64 * kb, 32 * nb, (bf16*)(ws + WS_WOUT), DM, 32 * nb, scr, F.lane); continue; } r -= I_OUT;
        if (r < 4 * I_13) { const int mi = r / I_13, rr = r % I_13, l = mi >> 1, which = mi & 1, kb = rr / 88, nb = rr % 88, n0 = 32 * nb;
            const float* W = ap->in[which ? I_W3 : I_W1] + (size_t)l * DM * FF;
            p0_transpose_item(W, FF, 64 * kb, n0, (bf16*)(ws + WS_W13) + (size_t)l * 5632 * DM, DM, 256 * (n0 >> 7) + 128 * which + (n0 & 127), scr, F.lane); continue; } r -= 4 * I_13;
        if (r < 2 * I_2) { const int l = r / I_2, rr = r % I_2, kb = rr / 32, nb = rr % 32;
            p0_transpose_item(ap->in[I_W2] + (size_t)l * FF * DM, DM, 64 * kb, 32 * nb, (bf16*)(ws + WS_W2) + (size_t)l * DM * FF, FF, 32 * nb, scr, F.lane); continue; } r -= 2 * I_2;
        { const int g = r / I_P, rr = r % I_P, kb = rr / 8, nb = rr % 8;
            p0_transpose_item(ap->in[I_WPOOL] + (size_t)g * 256 * 256, 256, 64 * kb, 32 * nb, (bf16*)(ws + WS_WPOOL), 256, g * 256 + 32 * nb, scr, F.lane); }
    }
    { const float* wsp = ap->in[I_WSP]; bf16* dst = (bf16*)(ws + WS_WSB);
        for (int e = (F.vcu * NWAVES * 64 + F.tid) * 4; e < 8 * 128 * 128; e += F.G * NWAVES * 64 * 4) { const f32x4 v = *(const f32x4*)(wsp + e); v2u o; o.x = pk2(v[0], v[1]); o.y = pk2(v[2], v[3]); *(v2u*)(dst + e) = o; } }
}
__device__ __forceinline__ void p1_bias13(Frame& F, ArgsP ap) {
    if (F.vcu >= 176) return;
    const int l = F.vcu / 88, rem = F.vcu % 88, which = rem / 44, cb = rem % 44, k0 = F.wave * 128;
    LAS float* shs = (LAS float*)(F.lds + RING_OFF); LAS float* part = shs + 8 * 1024;
    const float* mods = (const float*)(ap->ws + WS_MODS);
    for (int i = F.tid; i < 8 * 1024; i += NWAVES * 64) { const int b = i >> 10, k = i & 1023; shs[i] = mods[(size_t)(l * 9 + b) * MODW + SH2 + k]; }
    __syncthreads();
    const float* w = ap->in[which ? I_W3 : I_W1] + (size_t)l * DM * FF + (size_t)k0 * FF + cb * 64 + F.lane;
    float acc[8];
#pragma unroll
    for (int j = 0; j < 8; ++j) acc[j] = 0.f;
    for (int k = 0; k < 128; k += 8) {
        float wv[8];
#pragma unroll
        for (int q = 0; q < 8; ++q) wv[q] = __builtin_nontemporal_load(w + (size_t)(k + q) * FF);
#pragma unroll
        for (int j = 0; j < 8; ++j) { const f32x4 s0 = *(const LAS f32x4*)(shs + j * 1024 + k0 + k), s1 = *(const LAS f32x4*)(shs + j * 1024 + k0 + k + 4);
            acc[j] += (s0[0] * wv[0] + s0[1] * wv[1]) + (s0[2] * wv[2] + s0[3] * wv[3]) + (s1[0] * wv[4] + s1[1] * wv[5]) + (s1[2] * wv[6] + s1[3] * wv[7]); }
    }
#pragma unroll
    for (int j = 0; j < 8; ++j) part[(F.wave * 8 + j) * 64 + F.lane] = acc[j];
    __syncthreads();
    float* bias = (float*)(ap->ws + WS_BIAS);
    for (int idx = F.tid; idx < 8 * 64; idx += NWAVES * 64) { const int j = idx >> 6, col = idx & 63, n = cb * 64 + col; float sum = 0.f;
#pragma unroll
        for (int wv_ = 0; wv_ < 8; ++wv_) sum += part[(wv_ * 8 + j) * 64 + col];
        bias[(size_t)(l * 8 + j) * 5632 + 256 * (n >> 7) + 128 * which + (n & 127)] = sum; }
    __syncthreads();
}
__device__ __forceinline__ void p1_poolw(Frame& F, ArgsP ap) {
    unsigned char* ws = ap->ws; const bf16* src = (const bf16*)(ws + WS_WPOOL); bf16* dst = (bf16*)(ws + WS_WPB);
    const float* gm = ap->in[I_GMIX] + DM; const float* mod1 = (const float*)(ws + WS_MODS) + (size_t)9 * MODW;
    for (int e = (F.vcu * NWAVES * 64 + F.tid) * 8; e < 8 * 1024 * 256; e += F.G * NWAVES * 64 * 8) {
        const int b = e >> 18, n = (e >> 8) & 1023, k = e & 255, gk = (n & ~255) + k;
        const v4u w = *(const v4u*)(src + (size_t)n * 256 + k); const f32x4 g0 = *(const f32x4*)(gm + gk), g1 = *(const f32x4*)(gm + gk + 4);
        const f32x4 s0 = *(const f32x4*)(mod1 + (size_t)b * MODW + SC1 + gk), s1 = *(const f32x4*)(mod1 + (size_t)b * MODW + SC1 + gk + 4);
        const f32x4 m0 = g0 * (s0 + 1.0f), m1 = g1 * (s1 + 1.0f);
        v4u o; o.x = pk2(bf2f(w.x & 0xffffu) * m0[0], bf2f(w.x >> 16) * m0[1]); o.y = pk2(bf2f(w.y & 0xffffu) * m0[2], bf2f(w.y >> 16) * m0[3]);
        o.z = pk2(bf2f(w.z & 0xffffu) * m1[0], bf2f(w.z >> 16) * m1[1]); o.w = pk2(bf2f(w.w & 0xffffu) * m1[2], bf2f(w.w >> 16) * m1[3]);
        *(v4u*)(dst + e) = o; }
}
__device__ __forceinline__ void norm_pass(Frame& F, const float* src_lat, const float* src_ctx, bf16* dst, const float* gvec, const float* modl, int sh_off, int sc_off) {
    const int total = src_ctx ? MALL : MTOK, gw = F.vcu * NWAVES + F.wave, NGW = F.G * NWAVES, rpw = (total + NGW - 1) / NGW;
    const int r0 = gw * rpw, r1 = (r0 + rpw < total) ? r0 + rpw : total;
    int cur = -1; f32x4 gm[4], sh[4];
    for (int row = r0; row < r1; ++row) {
        const int bb = row < MTOK ? (row >> 12) : 8;
        if (bb != cur) { cur = bb;
#pragma unroll
            for (int j = 0; j < 4; ++j) { const int c = 4 * F.lane + 256 * j; const f32x4 g = *(const f32x4*)(gvec + c), s = *(const f32x4*)(modl + (size_t)bb * MODW + sc_off + c);
                gm[j] = g * (s + 1.0f); sh[j] = *(const f32x4*)(modl + (size_t)bb * MODW + sh_off + c); } }
        const float* xr = row < MTOK ? src_lat + (size_t)row * DM : src_ctx + (size_t)(row - MTOK) * DM;
        f32x4 v[4]; float ss = 0.f;
#pragma unroll
        for (int j = 0; j < 4; ++j) { v[j] = __builtin_nontemporal_load((const f32x4*)(xr + 4 * F.lane + 256 * j)); ss += (v[j][0] * v[j][0] + v[j][1] * v[j][1]) + (v[j][2] * v[j][2] + v[j][3] * v[j][3]); }
        const float r = __builtin_amdgcn_rsqf(wave_sum(ss) * (1.0f / DM) + 1e-6f);
        bf16* orow = dst + (size_t)row * DM;
#pragma unroll
        for (int j = 0; j < 4; ++j) { const f32x4 o = v[j] * r * gm[j] + sh[j]; v2u w; w.x = pk2(o[0], o[1]); w.y = pk2(o[2], o[3]); *(v2u*)(orow + 4 * F.lane + 256 * j) = w; }
    }
}
__device__ __forceinline__ void final_norm(Frame& F, float* out, const float* gvec) {
    const int gw = F.vcu * NWAVES + F.wave, NGW = F.G * NWAVES, rpw = (MTOK + NGW - 1) / NGW;
    const int r0 = gw * rpw, r1 = (r0 + rpw < MTOK) ? r0 + rpw : MTOK;
    f32x4 g[4];
#pragma unroll
    for (int j = 0; j < 4; ++j) g[j] = *(const f32x4*)(gvec + 4 * F.lane + 256 * j);
    for (int row = r0; row < r1; ++row) {
        float* xr = out + (size_t)row * DM; f32x4 v[4]; float ss = 0.f;
#pragma unroll
        for (int j = 0; j < 4; ++j) { v[j] = *(const f32x4*)(xr + 4 * F.lane + 256 * j); ss += (v[j][0] * v[j][0] + v[j][1] * v[j][1]) + (v[j][2] * v[j][2] + v[j][3] * v[j][3]); }
        const float r = 1.0f / sqrtf(wave_sum(ss) * (1.0f / DM) + 1e-6f);
#pragma unroll
        for (int j = 0; j < 4; ++j) *(f32x4*)(xr + 4 * F.lane + 256 * j) = v[j] * r * g[j];
    }
}
template <int W> __device__ __forceinline__ void poolres_cols(const bf16* zb, bf16* outb, bf16* xnb, float* partb, int t0, int c, f32x2 gate, f32x2 gmn, int wave, int lane) {
    constexpr int L = W / 2, R = W / 2 - 1, NV = W - 1 + 16;
    f32x2 v[NV];
#define Z_LD(dst_, t_) do { const int tt_ = (t_); if (tt_ < 0 || tt_ >= SEQ) dst_ = (f32x2){0.f, 0.f}; else { const unsigned u_ = __builtin_nontemporal_load((const unsigned*)(zb + (size_t)tt_ * DM + c)); dst_ = (f32x2){bf2f(u_ & 0xffffu), bf2f(u_ >> 16)}; } } while (0)
#pragma unroll
    for (int i = 0; i < W - 1; ++i) Z_LD(v[i], t0 - L + i);
    for (int blk = 0; blk < 8; ++blk) {
        const int tb = t0 + 16 * blk;
        unsigned xr[16];
#pragma unroll
        for (int i = 0; i < 16; ++i) xr[i] = *(const unsigned*)(outb + (size_t)(tb + i) * DM + c);
#pragma unroll
        for (int i = 0; i < 16; ++i) Z_LD(v[W - 1 + i], tb + R + i);
        f32x2 s = v[0];
#pragma unroll
        for (int i = 1; i < W; ++i) s += v[i];
#pragma unroll
        for (int j = 0; j < 16; ++j) { const int t = tb + j; const int lo = t - L < 0 ? 0 : t - L, hi = t + R > SEQ - 1 ? SEQ - 1 : t + R; const float icnt = __builtin_amdgcn_rcpf((float)(hi - lo + 1));
            const f32x2 o = s * icnt - v[j + L]; const f32x2 x3 = (f32x2){bf2f(xr[j] & 0xffffu), bf2f(xr[j] >> 16)} + gate * o;
            *(unsigned*)(outb + (size_t)t * DM + c) = pk2(x3[0], x3[1]); const f32x2 y = x3 * gmn; *(unsigned*)(xnb + (size_t)t * DM + c) = pk2(y[0], y[1]);
            const float ss = wave_sum(x3[0] * x3[0] + x3[1] * x3[1]);
            if (lane < 2) partb[((size_t)((wave >> 2) + 2 * lane) * MTOK + t) * 4 + (wave & 3)] = lane ? 0.f : ss;
            if (j < 15) s += v[j + W] - v[j]; }
#pragma unroll
        for (int i = 0; i < W - 1; ++i) v[i] = v[i + 16];
    }
#undef Z_LD
}
__device__ __forceinline__ void poolres_pass(Frame& F, const bf16* Z, bf16* out, bf16* xn, float* part, const float* gate, const float* pscale, const float* gnext, const float* scnext) {
    for (int strip = F.vcu; strip < MTOK / 128; strip += F.G) {
        const int b = strip >> 5, t0 = (strip & 31) * 128; const size_t ro = (size_t)b * SEQ;
        const int c = 2 * F.tid;
        const f32x2 gt = *(const f32x2*)(gate + (size_t)b * MODW + c) * *(const f32x2*)(pscale + c);
        const f32x2 gmn = *(const f32x2*)(gnext + c) * (*(const f32x2*)(scnext + (size_t)b * MODW + c) + 1.0f);
        const bf16* zb = Z + ro * DM; bf16* outb = out + ro * DM; bf16* xnb = xn + ro * DM; float* partb = part + ro * 4;
        const int grp = F.wave >> 1;
        if (grp == 0) poolres_cols<2>(zb, outb, xnb, partb, t0, c, gt, gmn, F.wave, F.lane); else if (grp == 1) poolres_cols<4>(zb, outb, xnb, partb, t0, c, gt, gmn, F.wave, F.lane);
        else if (grp == 2) poolres_cols<8>(zb, outb, xnb, partb, t0, c, gt, gmn, F.wave, F.lane); else poolres_cols<16>(zb, outb, xnb, partb, t0, c, gt, gmn, F.wave, F.lane);
    }
}
__device__ __forceinline__ void gmlp_unit(Frame& F, int unit, const bf16* VG, const bf16* U, const bf16* WSB, const float* bs, bf16* AM) {
    using attn_body::f32x16;
    const int g = F.wave, lane = F.lane, r32 = lane & 31, hi = lane >> 5;
    const size_t R0 = (size_t)unit * 128;
    LAS unsigned char* slot = F.lds + RING_OFF + g * 16384;
    const unsigned slot_addr = (unsigned)(uintptr_t)slot;
    const int vb = (int)slot_addr + ((lane >> 4) & 1) * 32 + (lane & 3) * 8 + (4 * hi + ((lane & 15) >> 2)) * 64;
#pragma unroll
    for (int kt = 0; kt < 2; ++kt)
#pragma unroll
        for (int p = 0; p < 8; ++p)
            attn_body::glds16_nt(VG + (R0 + 64 * kt + 16 * (p & 3) + (lane >> 2)) * 512 + g * 64 + (p >> 2) * 32 + (lane & 3) * 8, (unsigned)__builtin_amdgcn_readfirstlane(slot_addr + kt * 8192 + p * 1024));
    f32x16 o[4][2];
#pragma unroll
    for (int rb = 0; rb < 4; ++rb) { o[rb][0] = f32x16{}; o[rb][1] = f32x16{}; }
#define GM_LDPA(dst, kt_, rb_) do { int z_ = 0; asm volatile("" : "+v"(z_)); const char* wp = wb + z_ + (rb_) * 8192 + (kt_) * 128;     \
            _Pragma("unroll") for (int s = 0; s < 4; ++s) { const v2u a = *(const v2u*)(wp + s * 32), b = *(const v2u*)(wp + s * 32 + 16); dst[s] = __builtin_bit_cast(bf16x8, (v4u){a.x, a.y, b.x, b.y}); } } while (0)
    const char* wb = (const char*)(WSB + ((size_t)(g * 128 + r32) * 128 + 4 * hi));
    {
        bf16x8 pA[4], pB[4];
#define GM_PV(P, kt_, rb_) attn_body::pv(o[rb_], vb + (kt_) * 8192, P[0], P[1], P[2], P[3])
        GM_LDPA(pA, 0, 0);
        VM_WAIT();
        GM_LDPA(pB, 0, 1); GM_PV(pA, 0, 0);
        GM_LDPA(pA, 0, 2); GM_PV(pB, 0, 1);
        GM_LDPA(pB, 0, 3); GM_PV(pA, 0, 2);
        GM_LDPA(pA, 1, 0); GM_PV(pB, 0, 3);
        GM_LDPA(pB, 1, 1); GM_PV(pA, 1, 0);
        GM_LDPA(pA, 1, 2); GM_PV(pB, 1, 1);
        GM_LDPA(pB, 1, 3); GM_PV(pA, 1, 2);
        GM_PV(pB, 1, 3);
#undef GM_PV
    }
#undef GM_LDPA
    LDS_WAIT();
    LAS float* stg = (LAS float*)slot;
    v4u uA[4], uB[4]; float bA[4], bB[4];
#define GM_LDU(UU, BB, rb_) do { int zz_ = 0; asm volatile("" : "+v"(zz_)); const char* ub_ = (const char*)(U + (R0 + 32 * (rb_) + (lane >> 3)) * 512 + g * 64 + (lane & 7) * 8) + zz_; \
        const float* bb_ = bs + g * 128 + 32 * (rb_) + (lane >> 3) + zz_; _Pragma("unroll") for (int i = 0; i < 4; ++i) { UU[i] = __builtin_nontemporal_load((const v4u*)(ub_ + i * 8192)); BB[i] = bb_[8 * i]; } } while (0)
#define GM_EPI(UU, BB, rb_) do { \
        _Pragma("unroll") for (int r = 0; r < 16; ++r) { const int orow = attn_body::crow(r, hi); stg[orow * 64 + r32] = o[rb_][0][r]; stg[orow * 64 + 32 + r32] = o[rb_][1][r]; } \
        LDS_WAIT(); \
        _Pragma("unroll") for (int i = 0; i < 4; ++i) { const int row = i * 8 + (lane >> 3), ch = lane & 7; \
            const f32x4 a = *(const LAS f32x4*)(stg + row * 64 + ch * 8) + BB[i], b = *(const LAS f32x4*)(stg + row * 64 + ch * 8 + 4) + BB[i]; \
            v4u w; w.x = pk2(a[0] * bf2f(UU[i].x & 0xffffu), a[1] * bf2f(UU[i].x >> 16)); w.y = pk2(a[2] * bf2f(UU[i].y & 0xffffu), a[3] * bf2f(UU[i].y >> 16)); \
            w.z = pk2(b[0] * bf2f(UU[i].z & 0xffffu), b[1] * bf2f(UU[i].z >> 16)); w.w = pk2(b[2] * bf2f(UU[i].w & 0xffffu), b[3] * bf2f(UU[i].w >> 16)); \
            *(v4u*)(AM + (R0 + 32 * (rb_) + row) * 1024 + 512 + g * 64 + ch * 8) = w; } \
        LDS_WAIT(); } while (0)
    GM_LDU(uA, bA, 0);
    GM_LDU(uB, bB, 1); GM_EPI(uA, bA, 0);
    GM_LDU(uA, bA, 2); GM_EPI(uB, bB, 1);
    GM_LDU(uB, bB, 3); GM_EPI(uA, bA, 2);
    GM_EPI(uB, bB, 3);
#undef GM_LDU
#undef GM_EPI
}

template <class Sched> __device__ __forceinline__ int build_rtab(Frame& F, const Sched& S, const float* part, LAS float* rtab) {
    pg8::Unit u; int pm0 = -1, pm1 = -1;
    for (int i = 0; S.next(i, u); ++i) { if (pm0 < 0) pm0 = u.pm; else if (u.pm != pm0) pm1 = u.pm; }
    if (pm1 < 0) pm1 = pm0;
    { const int slot = F.tid >> 8, r = F.tid & 255, row = (slot ? pm1 : pm0) * 256 + r; float tot = 0.f;
#pragma unroll
        for (int pn = 0; pn < 4; ++pn) { const f32x4 p = *(const f32x4*)(part + ((size_t)pn * MTOK + row) * 4); tot += (p[0] + p[1]) + (p[2] + p[3]); }
        rtab[F.tid] = __builtin_amdgcn_rsqf(tot * (1.0f / DM) + 1e-6f); }
    __syncthreads();
    return pm0;
}
__global__ void __launch_bounds__(NWAVES * 64, 2) mega_fwd(Args args) {
    extern __shared__ __attribute__((aligned(16))) unsigned char lds[];
    Frame F;
    F.lds = (LAS unsigned char*)lds;
    F.MISC = (volatile LAS unsigned*)(F.lds + MISC_OFF);
    F.tid = threadIdx.x; F.lane = F.tid & 63; F.wave = __builtin_amdgcn_readfirstlane(F.tid >> 6);
    F.G = gridDim.x; { const int bx = blockIdx.x; F.vcu = (F.G % 8 == 0) ? (bx % 8) * (F.G / 8) + bx / 8 : bx; }
    ArgsP akp = (ArgsP)__builtin_amdgcn_kernarg_segment_ptr();
    F.ctl = (gu32*)(akp->ws + WS_CTL);
    for (int u = F.tid; u < (LDS_BYTES - LDSCTL_OFF) / 4; u += NWAVES * 64) ((LAS unsigned*)(F.lds + LDSCTL_OFF))[u] = 0u;
    __syncthreads();
    const int lo = akp->ph_lo, hi = akp->ph_hi;
    const bool one_launch = (hi - lo) > 1;
    XcdBarrier bar; bar.bar = (unsigned*)(F.ctl + CW_BAR); bar.x = 0; bar.st = nullptr;
    if (one_launch) bar = xcd_barrier_post((unsigned*)(F.ctl + CW_BAR), F.MISC + 8);
#ifndef PHASE_MASK
#define PHASE_MASK 0x7ff
#endif
#define IN(k) (((PHASE_MASK >> (k)) & 1) && lo <= (k) && (k) < hi)
#define SEAM(k) do { if (IN(k) && IN((k) + 1)) xcd_barrier(bar); } while (0)
#ifndef REPEAT_MASK
#define REPEAT_MASK 0
#endif
#define REP(k) for (int rep_ = 0; rep_ < (((REPEAT_MASK >> (k)) & 1) ? 2 : 1); ++rep_, (((REPEAT_MASK >> (k)) & 1) && rep_ == 1 && one_launch ? (xcd_barrier(bar), 0) : 0))
#define REPRES(k, dummy) ((((REPEAT_MASK >> (k)) & 1) && rep_ == 0) ? (void*)(ws + (dummy)) : (void*)(ws + WS_RES))
#define REPOUT(k, dummy) ((((REPEAT_MASK >> (k)) & 1) && rep_ == 0) ? (float*)(ws + (dummy)) : out)
#define PHASE_VARS() ArgsP A = akp; asm volatile("" : "+s"(A)); unsigned char* ws = A->ws; float* out = A->out; float* mods = (float*)(ws + WS_MODS); const float* mod1 = mods + (size_t)9 * MODW; bf16* XN = (bf16*)(ws + WS_XN); bf16* AM = (bf16*)(ws + WS_AM); bf16* HB = (bf16*)(ws + WS_H); \
    float* rs1 = (float*)(ws + WS_PART); float* rs2 = rs1 + 16 * MTOK; float* rs3 = rs2 + 16 * MTOK; float* rs4 = rs3 + 16 * MTOK; const float* bias13 = (const float*)(ws + WS_BIAS); \
    (void)out; (void)mods; (void)mod1; (void)XN; (void)AM; (void)HB; (void)rs1; (void)rs2; (void)rs3; (void)rs4; (void)bias13
#ifndef STAGGER_US
#define STAGGER_US 0
#endif
#define STAGGER() do { const unsigned g_ = (blockIdx.x >> 3) & 3u; if (STAGGER_US > 0 && g_) { const unsigned long long t0_ = __builtin_amdgcn_s_memrealtime(); while (__builtin_amdgcn_s_memrealtime() - t0_ < (unsigned long long)(g_ * STAGGER_US * 100)) __builtin_amdgcn_s_sleep(8); } } while (0)
#define RELAUNDER() do { int t_ = threadIdx.x; asm volatile("" : "+v"(t_)); F.tid = t_; F.lane = t_ & 63; } while (0)
    if (IN(0)) REP(0) { PHASE_VARS(); RELAUNDER(); p0_prologue(F, A); } SEAM(0);
    if (IN(1)) REP(1) { PHASE_VARS(); RELAUNDER(); p1_bias13(F, A); p1_poolw(F, A); norm_pass(F, A->in[I_X], A->in[I_CTX], XN, A->in[I_GMIX], mods, SH1, SC1); } SEAM(1);
    if (IN(2)) REP(2) { PHASE_VARS();
        pg8::Gemm g{XN, (const bf16*)(ws + WS_WIN), DM, DM, 0, 0}; pg8::StaticOrder S; S.init(MTOK, INW, F.G, (int)blockIdx.x, MCTX / 256, 2);
        pg8::EpiInProj E{A};
        pg8::gemm_phase<pg8::EpiInProj, pg8::StaticOrder, PG8_ALIGN, PG8_SP2>(F.lds + RING_OFF, g, S, E);
    } SEAM(2);
    if (IN(3)) REP(3) { PHASE_VARS();
        const attn_body::AttnTensors AT{(const attn_body::bf16*)(ws + WS_Q), (const attn_body::bf16*)(ws + WS_KB), (const attn_body::bf16*)(ws + WS_VB), (attn_body::bf16*)AM};
        const attn_body::StaticOrder S((int)F.G, F.vcu);
        const bool gfirst = (F.vcu & 1) != 0;
        for (int g2_ = 0; g2_ < 2; ++g2_) {
            if ((g2_ == 0) == gfirst) {
                RELAUNDER();
                for (int rp_ = 0; rp_ < (((REPEAT_MASK >> 11) & 1) ? 2 : 1); ++rp_) {
                    for (int u = F.vcu; u < MTOK / 128; u += F.G) gmlp_unit(F, u, (const bf16*)(ws + WS_VG), (const bf16*)(ws + WS_U), (const bf16*)(ws + WS_WSB), A->in[I_BSP], AM);
                    __syncthreads(); }
            } else attn_body::attn_phase<attn_body::StaticOrder>((char*)lds + RING_OFF, AT, S, A->in[I_QN], A->in[I_KN]);
        }
    } SEAM(3);
    if (IN(4)) REP(4) { PHASE_VARS(); STAGGER();
        pg8::Gemm g{AM, (const bf16*)(ws + WS_WOUT), DM, DM, 0, 0}; pg8::StaticOrder S; S.init(MTOK, DM, F.G, (int)blockIdx.x);
        pg8::EpiResid<4> E{A, (void*)(ws + WS_RES)};
        pg8::gemm_phase<pg8::EpiResid<4>, pg8::StaticOrder, PG8_ALIGN, PG8_SP2>(F.lds + RING_OFF, g, S, E);
    } SEAM(4);
    if (IN(5)) REP(5) { PHASE_VARS();
        pg8::Gemm g{XN, (const bf16*)(ws + WS_W13), DM, DM, 0, 0}; pg8::StaticOrder S; S.init(MTOK, 2 * FF, F.G, (int)blockIdx.x);
#if defined(PROBE_NULL5)
        if (rep_ == 0) { pg8::EpiNull EN{(bf16*)(ws + WS_VG)}; pg8::StaticOrder S2; S2.init(MTOK, DM, F.G, (int)blockIdx.x);   (void)S2;
            pg8::EpiNullWide ENW{(bf16*)(ws + WS_H)}; pg8::gemm_phase<pg8::EpiNullWide, pg8::StaticOrder, PG8_ALIGN, PG8_SP2>(F.lds + RING_OFF, g, S, ENW); (void)EN; } else
#endif
        { RELAUNDER(); LAS float* rtab = (LAS float*)(F.lds + RTAB_OFF); const int pm0 = build_rtab(F, S, rs1, rtab); pg8::EpiSwiglu<0> E{A, rtab, pm0};
        pg8::gemm_phase<pg8::EpiSwiglu<0>, pg8::StaticOrder, PG8_ALIGN, PG8_SP2>(F.lds + RING_OFF, g, S, E); }
    } SEAM(5);
    if (IN(6)) REP(6) { PHASE_VARS(); STAGGER();
        pg8::Gemm g{HB, (const bf16*)(ws + WS_W2), FF, FF, 0, 0}; pg8::StaticOrder S; S.init(MTOK, DM, F.G, (int)blockIdx.x);
#if defined(PROBE_NULL6)
        if (rep_ == 0) { pg8::EpiNull EN{(bf16*)(ws + WS_VG)}; pg8::gemm_phase<pg8::EpiNull, pg8::StaticOrder, PG8_ALIGN, PG8_SP2>(F.lds + RING_OFF, g, S, EN); } else
#elif defined(PROBE_NOXN6)
        if (rep_ == 0) { pg8::EpiResid<7> E7{A, REPRES(6, WS_VG)}; pg8::gemm_phase<pg8::EpiResid<7>, pg8::StaticOrder, PG8_ALIGN, PG8_SP2>(F.lds + RING_OFF, g, S, E7); } else
#endif
        { pg8::EpiResid<6> E{A, REPRES(6, WS_VG)};
        pg8::gemm_phase<pg8::EpiResid<6>, pg8::StaticOrder, PG8_ALIGN, PG8_SP2>(F.lds + RING_OFF, g, S, E); }
    } SEAM(6);
    if (IN(7)) REP(7) { PHASE_VARS();
        pg8::Gemm g{(const bf16*)(ws + WS_RES), (const bf16*)(ws + WS_WPB), 256, DM, 512, 1024 * 256 * 2}; pg8::StaticOrder S; S.init(MTOK, DM, F.G, (int)blockIdx.x);
        pg8::EpiZ E{A};
        pg8::gemm_phase<pg8::EpiZ, pg8::StaticOrder, PG8_ALIGN, PG8_SP2>(F.lds + RING_OFF, g, S, E);
    } SEAM(7);
    if (IN(8)) { PHASE_VARS(); RELAUNDER(); poolres_pass(F, AM, (bf16*)(ws + WS_RES), XN, rs3, mod1 + GA1, A->in[I_PSC], A->in[I_GFFN] + DM, mod1 + SC2); } SEAM(8);
    if (IN(9)) REP(9) { PHASE_VARS();
        pg8::Gemm g{XN, (const bf16*)(ws + WS_W13) + (size_t)5632 * DM, DM, DM, 0, 0}; pg8::StaticOrder S; S.init(MTOK, 2 * FF, F.G, (int)blockIdx.x);
        RELAUNDER(); LAS float* rtab = (LAS float*)(F.lds + RTAB_OFF); const int pm0 = build_rtab(F, S, rs3, rtab); pg8::EpiSwiglu<1> E{A, rtab, pm0};
        pg8::gemm_phase<pg8::EpiSwiglu<1>, pg8::StaticOrder, PG8_ALIGN, PG8_SP2>(F.lds + RING_OFF, g, S, E);
    } SEAM(9);
    if (IN(10)) REP(10) { PHASE_VARS(); STAGGER();
        pg8::Gemm g{HB, (const bf16*)(ws + WS_W2) + (size_t)DM * FF, FF, FF, 0, 0}; pg8::StaticOrder S; S.init(MTOK, DM, F.G, (int)blockIdx.x);
        pg8::EpiResid<10> E{A, out};
        pg8::gemm_phase<pg8::EpiResid<10>, pg8::StaticOrder, PG8_ALIGN, PG8_SP2>(F.lds + RING_OFF, g, S, E);
    }
#undef IN
#undef SEAM
}

extern "C" void kernel_launch(void* const* d_in, const int* in_sizes, int n_in, void* d_out, int out_size, void* d_ws, size_t ws_size, hipStream_t stream) {
    static int grid = 0;
    if (grid == 0) {
        if (n_in != 21 || out_size != MTOK * DM || ws_size < WS_END) { fprintf(stderr, "kernel_launch: unexpected shapes (n_in %d, out %d, ws %zu)\n", n_in, out_size, ws_size); grid = -1; return; }
        int dev = 0, cus = 0, per_cu = 0;
        if (hipGetDevice(&dev) != hipSuccess || hipDeviceGetAttribute(&cus, hipDeviceAttributeMultiprocessorCount, dev) != hipSuccess) { grid = -1; return; }
        if (hipFuncSetAttribute((const void*)mega_fwd, hipFuncAttributeMaxDynamicSharedMemorySize, LDS_BYTES) != hipSuccess) { fprintf(stderr, "kernel_launch: hipFuncSetAttribute failed\n"); grid = -1; return; }
        if (hipOccupancyMaxActiveBlocksPerMultiprocessor(&per_cu, (const void*)mega_fwd, NWAVES * 64, LDS_BYTES) != hipSuccess || per_cu < 1) { fprintf(stderr, "kernel_launch: occupancy query says %d\n", per_cu); per_cu = 1; }
        (void)hipGetLastError();
        grid = cus;
        if (grid != 256) fprintf(stderr, "kernel_launch: %d CUs (expected 256)\n", grid);
    }
    if (grid < 0) return;
    if (hipMemsetAsync((char*)d_ws + WS_CTL, 0, CTL_ZERO_BYTES, stream) != hipSuccess) return;
    Args a{};
    for (int i = 0; i < 21; ++i) a.in[i] = (const float*)d_in[i];
    a.out = (float*)d_out; a.ws = (unsigned char*)d_ws;
#if defined(MK_PER_PHASE)
    for (int p = 0; p < N_PHASES; ++p) { a.ph_lo = p; a.ph_hi = p + 1; hipLaunchKernelGGL(mega_fwd, dim3(grid), dim3(NWAVES * 64), LDS_BYTES, stream, a); }
#else
    a.ph_lo = 0; a.ph_hi = N_PHASES;
    hipLaunchKernelGGL(mega_fwd, dim3(grid), dim3(NWAVES * 64), LDS_BYTES, stream, a);
#endif
}
```

```cpp
#include <hip/hip_runtime.h>
#include <hip/hip_bf16.h>
#include <cstdio>
#include <cstdint>
#include <cmath>
constexpr int NWAVES_ = 8;
constexpr int NWAVES = 8;
constexpr int DM = 1024, NB = 8, SEQ = 4096, MTOK = NB * SEQ, CTXL = 256, MCTX = NB * CTXL, MALL = MTOK + MCTX;
constexpr int INW = 1792, FF = 2816, SKV = SEQ + CTXL;
constexpr int N_PHASES = 11;
constexpr size_t MiB = 1u << 20;
constexpr size_t WS_CTL = 0, CTL_ZERO_BYTES = 128 * 1024;
constexpr size_t WS_MODS = 1 * MiB;
constexpr size_t WS_ROPE = WS_MODS + 512 * 1024;
constexpr size_t WS_WSB = 2 * MiB;
constexpr size_t WS_WPOOL = WS_WSB + 512 * 1024;
constexpr size_t WS_WIN = 4 * MiB;
constexpr size_t WS_WOUT = 8 * MiB;
constexpr size_t WS_W13 = 10 * MiB;
constexpr size_t WS_W2 = 32 * MiB;
constexpr size_t WS_XN = 44 * MiB;
constexpr size_t WS_Q = 112 * MiB;
constexpr size_t WS_RES = 112 * MiB;
constexpr size_t WS_KB = 144 * MiB;
constexpr size_t WS_VB = 153 * MiB;
constexpr size_t WS_U = 162 * MiB;
constexpr size_t WS_VG = 194 * MiB;
constexpr size_t WS_AM = 226 * MiB;
constexpr size_t WS_H = 290 * MiB;
constexpr size_t WS_WPB = 474 * MiB;
constexpr size_t WS_END = 478 * MiB;
constexpr int CW_BAR = 4096;
constexpr size_t CTL_CNT = 65536;
constexpr size_t WS_PART = 466 * MiB;
static_assert(CTL_CNT + 32768 <= CTL_ZERO_BYTES, "CTL map");
constexpr size_t WS_BIAS = WS_ROPE + 65536;
constexpr int RING_OFF = 0, RING_BYTES = 131072;
constexpr int LDSCTL_OFF = RING_BYTES, MISC_OFF = LDSCTL_OFF + 320;
constexpr int RTAB_OFF = LDSCTL_OFF + 1024;
constexpr int LDS_BYTES = 147456;
static_assert(MISC_OFF + 128 <= LDS_BYTES, "LDS map");

struct Args { const float* in[21]; float* out; unsigned char* ws; int ph_lo, ph_hi; };
#define KARG __attribute__((address_space(4)))
typedef const KARG Args* ArgsP;
static_assert(sizeof(Args) == 192, "Args has no padding");
enum { I_X = 0, I_C, I_CTX, I_CCTX, I_WADA, I_BADA, I_GMIX, I_GFFN, I_WIN, I_WOUT, I_QN, I_KN, I_GN, I_WSP, I_BSP, I_WPOOL, I_PSC, I_W1, I_W3, I_W2, I_GFIN };
constexpr int SH1 = 0, SC1 = DM, GA1 = 2 * DM, SH2 = 3 * DM, SC2 = 4 * DM, GA2 = 5 * DM, MODW = 6 * DM;

template <int CTRL> __device__ __forceinline__ float dpp_add(float x) { return x + __builtin_bit_cast(float, __builtin_amdgcn_update_dpp(0, __builtin_bit_cast(int, x), CTRL, 0xF, 0xF, true)); }
__device__ __forceinline__ float xor16_add(float x) { const unsigned u = __builtin_bit_cast(unsigned, x); auto r = __builtin_amdgcn_permlane16_swap(u, u, false, false); return __builtin_bit_cast(float, (unsigned)r[0]) + __builtin_bit_cast(float, (unsigned)r[1]); }
__device__ __forceinline__ float xor32_add(float x) { const unsigned u = __builtin_bit_cast(unsigned, x); auto r = __builtin_amdgcn_permlane32_swap(u, u, false, false); return __builtin_bit_cast(float, (unsigned)r[0]) + __builtin_bit_cast(float, (unsigned)r[1]); }
__device__ __forceinline__ float wave_sum64(float v) { v = dpp_add<0xB1>(v); v = dpp_add<0x4E>(v); v = dpp_add<0x124>(v); v = dpp_add<0x128>(v); v = xor16_add(v); return xor32_add(v); }
namespace pg8 {
#define PG8_LAS __attribute__((address_space(3)))
typedef unsigned short bf16_t;
typedef short bf16x8 __attribute__((ext_vector_type(8)));
typedef float f32x4 __attribute__((ext_vector_type(4)));
typedef float f32x2 __attribute__((ext_vector_type(2)));
typedef unsigned u32x4 __attribute__((ext_vector_type(4)));
constexpr int BM = 256, BK = 64, HALF = 128, HTB = HALF * BK * 2  , STAGE_BYTES = 8 * HTB, NXCD = 8, WGM = 8;

__host__ __device__ __forceinline__ int lds_byte(int r, int c) { const int st = (r >> 4) * 2 + (c >> 5), rr = r & 15, cc = c & 31, ob = rr * 64 + cc * 2; return st * 1024 + (ob ^ (((ob >> 9) & 1) << 5)); }
__host__ __device__ __forceinline__ void stage_rc(int b, int& R, int& C) { const int st = b / 1024, sb = b % 1024, swz = sb ^ (((sb >> 9) & 1) << 5); R = (st >> 1) * 16 + swz / 64; C = (st & 1) * 32 + (swz % 64) / 2; }
__host__ __device__ __forceinline__ int perm32(int rho) { const int n = rho >> 4, i = rho & 15; return 8 * (i >> 2) + 4 * n + (i & 3); }

struct Unit { int pm, pn; };
struct Gemm { const bf16_t* A; const bf16_t* Bt; int K; int lda; int a_pn_bytes; int b_batch_bytes; };

struct StaticOrder {
    int nM, nN, nwg, G, c, extra, extra_pn;
    __host__ __device__ void init(int M, int N, int G_, int c_, int extra_ = 0, int extra_pn_ = 0) { nM = M / BM; nN = N / BM; nwg = nM * nN; G = G_; c = c_; extra = extra_; extra_pn = extra_pn_; }
    __host__ __device__ bool next(int i, Unit& u) const {
        const long L = (long)i * G + c;
        if (L >= nwg) { const long e = L - nwg; if (e >= extra) return false; u.pm = nM + (int)e; u.pn = extra_pn; return true; }
        int wgid = (int)L; { const int q = nwg / NXCD, r = nwg % NXCD, xcd = wgid % NXCD, off = wgid / NXCD; wgid = (xcd < r ? xcd * (q + 1) : r * (q + 1) + (xcd - r) * q) + off; }
        const int nig = WGM * nN, gid = wgid / nig, fm = gid * WGM, gsz = (nM - fm) < WGM ? (nM - fm) : WGM;
        u.pm = fm + ((wgid % nig) % gsz); u.pn = (wgid % nig) / gsz; return true;
    }
    __device__ __forceinline__ void a_ready(const Unit&) const {}
    __device__ __forceinline__ void done(const Unit&) const {}
};

__device__ __forceinline__ unsigned cvt_pk_bf16(float lo, float hi) { unsigned r; asm volatile("v_cvt_pk_bf16_f32 %0, %1, %2" : "=v"(r) : "v"(lo), "v"(hi)); return r; }
__device__ __forceinline__ f32x2 gelu_pk(f32x2 v) {
    const f32x2 av = __builtin_elementwise_abs(v), d = av * 0.2316418882f + 1.0f;
    f32x2 t; t.x = __builtin_amdgcn_rcpf(d.x); t.y = __builtin_amdgcn_rcpf(d.y);
    f32x2 q = t * 0.5307027145f + (-0.7265760135f); q = q * t + 0.7107068705f; q = q * t + (-0.142248368f); q = q * t + 0.127414796f; q = q * t;
    const f32x2 s = (v * v) * (-0.72134752044f);
    f32x2 e; e.x = __builtin_amdgcn_exp2f(s.x); e.y = __builtin_amdgcn_exp2f(s.y);
    const f32x2 m = v * (q * e), r = v - m;
    f32x2 o; o.x = v.x < 0.f ? m.x : r.x; o.y = v.y < 0.f ? m.y : r.y; return o;
}
__device__ __forceinline__ f32x4 gelu4(f32x4 v) { const f32x2 a = gelu_pk((f32x2){v[0], v[1]}), b = gelu_pk((f32x2){v[2], v[3]}); return (f32x4){a.x, a.y, b.x, b.y}; }
__device__ __forceinline__ float silu1(float v) { return v * __builtin_amdgcn_rcpf(1.0f + __builtin_amdgcn_exp2f(v * -1.4426950408889634f)); }
__device__ __forceinline__ u32x4 pack8(f32x4 v0, f32x4 v1) { u32x4 w; w.x = cvt_pk_bf16(v0[0], v0[1]); w.y = cvt_pk_bf16(v0[2], v0[3]); w.z = cvt_pk_bf16(v1[0], v1[1]); w.w = cvt_pk_bf16(v1[2], v1[3]); return w; }

struct EpiInProj {
    static constexpr bool PERM = true, AFTER_DRAIN = false;
    ArgsP A;
    __device__ __forceinline__ void operator()(const f32x4 (&acc)[2][2][4][2], const Unit& u, int wr, int wc, int fr_, int fq_) const {
        ArgsP a_ = A; asm volatile("" : "+s"(a_)); unsigned char* ws_ = a_->ws;
        bf16_t* Q = (bf16_t*)(ws_ + WS_Q); bf16_t* KB = (bf16_t*)(ws_ + WS_KB); bf16_t* VB = (bf16_t*)(ws_ + WS_VB); bf16_t* U = (bf16_t*)(ws_ + WS_U); bf16_t* VG = (bf16_t*)(ws_ + WS_VG);
        const float* qn = a_->in[I_QN]; const float* kn = a_->in[I_KN]; const float* gv = a_->in[I_GN]; const float* ropeC = (const float*)(ws_ + WS_ROPE); const float* ropeS = ropeC + 1024;
        const float qscale = 0.125f * 1.4426950408889634f;
        int t_ = threadIdx.x; asm volatile("" : "+v"(t_)); const int fr = t_ & 15, fq = (t_ >> 4) & 3; (void)fr_; (void)fq_;
        const int slot = 4 * u.pn + wc; const bool isctx = u.pm >= 128;
        const int rowl = wr * 64 + fr;
        const int row0 = u.pm * BM + rowl;
        const int kvrow0 = (isctx ? (u.pm - 128) * 4352 + 4096 : (u.pm >> 4) * 4352 + (u.pm & 15) * 256) + rowl;
        const int dl = 8 * fq;
        if (slot < 10) {
            const float* nw = slot < 8 ? qn : kn; const float osc = slot < 8 ? qscale : 1.0f;
            f32x4 w[2][2];
#pragma unroll
            for (int bj = 0; bj < 2; ++bj)
#pragma unroll
                for (int n = 0; n < 2; ++n) w[bj][n] = *(const f32x4*)(nw + 32 * bj + dl + 4 * n);
#pragma unroll
            for (int ai = 0; ai < 2; ++ai) {
                const int posr = (4 * u.pm + 2 * ai + wr) & 63;
                const f32x4 cr = *(const f32x4*)(ropeC + posr * 16 + 4 * fq), sr = *(const f32x4*)(ropeS + posr * 16 + 4 * fq);
#pragma unroll
                for (int m = 0; m < 4; ++m) {
                    float ss = 0.f;
#pragma unroll
                    for (int bj = 0; bj < 2; ++bj)
#pragma unroll
                        for (int n = 0; n < 2; ++n) { const f32x4 x = acc[ai][bj][m][n]; ss += (x[0] * x[0] + x[1] * x[1]) + (x[2] * x[2] + x[3] * x[3]); }
                    ss = xor32_add(xor16_add(ss));
                    const float r = __builtin_amdgcn_rsqf(ss * (1.0f / 64.0f) + 1e-6f) * osc;
                    const int posc = 16 * m + fr;
                    const f32x4 cc = *(const f32x4*)(ropeC + posc * 16 + 4 * fq), sc = *(const f32x4*)(ropeS + posc * 16 + 4 * fq);
#pragma unroll
                    for (int bj = 0; bj < 2; ++bj) {
                        f32x4 v0 = acc[ai][bj][m][0] * r * w[bj][0], v1 = acc[ai][bj][m][1] * r * w[bj][1];
                        if (!isctx) { const f32x4 c = bj ? cc : cr, s = bj ? sc : sr;
                            const f32x4 o0 = (f32x4){v0[0] * c[0] - v0[1] * s[0], v0[0] * s[0] + v0[1] * c[0], v0[2] * c[1] - v0[3] * s[1], v0[2] * s[1] + v0[3] * c[1]};
                            const f32x4 o1 = (f32x4){v1[0] * c[2] - v1[1] * s[2], v1[0] * s[2] + v1[1] * c[2], v1[2] * c[3] - v1[3] * s[3], v1[2] * s[3] + v1[3] * c[3]};
                            v0 = o0; v1 = o1; }
                        bf16_t* dst = slot < 8 ? Q + (size_t)(row0 + ai * HALF + m * 16) * 512 + slot * 64 + 32 * bj + dl
                                               : KB + (size_t)(kvrow0 + ai * HALF + m * 16) * 128 + (slot - 8) * 64 + 32 * bj + dl;
                        *(u32x4*)dst = pack8(v0, v1);
                    }
                    asm volatile("" ::: "memory");
                }
            }
        } else if (slot < 12) {
#pragma unroll
            for (int ai = 0; ai < 2; ++ai)
#pragma unroll
                for (int m = 0; m < 4; ++m)
#pragma unroll
                    for (int bj = 0; bj < 2; ++bj)
                        *(u32x4*)(VB + (size_t)(kvrow0 + ai * HALF + m * 16) * 128 + (slot - 10) * 64 + 32 * bj + dl) = pack8(acc[ai][bj][m][0], acc[ai][bj][m][1]);
        } else if (slot < 20) {
#pragma unroll
            for (int ai = 0; ai < 2; ++ai)
#pragma unroll
                for (int m = 0; m < 4; ++m)
#pragma unroll
                    for (int bj = 0; bj < 2; ++bj)
                        *(u32x4*)(U + (size_t)(row0 + ai * HALF + m * 16) * 512 + (slot - 12) * 64 + 32 * bj + dl) = pack8(gelu4(acc[ai][bj][m][0]), gelu4(acc[ai][bj][m][1]));
        } else {
            f32x4 w[2][2];
#pragma unroll
            for (int bj = 0; bj < 2; ++bj)
#pragma unroll
                for (int n = 0; n < 2; ++n) w[bj][n] = *(const f32x4*)(gv + (slot - 20) * 64 + 32 * bj + dl + 4 * n);
#pragma unroll
            for (int ai = 0; ai < 2; ++ai)
#pragma unroll
                for (int m = 0; m < 4; ++m) {
                    f32x4 g[2][2]; float ss = 0.f;
#pragma unroll
                    for (int bj = 0; bj < 2; ++bj)
#pragma unroll
                        for (int n = 0; n < 2; ++n) { const f32x4 x = gelu4(acc[ai][bj][m][n]); g[bj][n] = x; ss += (x[0] * x[0] + x[1] * x[1]) + (x[2] * x[2] + x[3] * x[3]); }
                    ss = xor32_add(xor16_add(ss));
                    const float r = __builtin_amdgcn_rsqf(ss * (1.0f / 64.0f) + 1e-6f);
#pragma unroll
                    for (int bj = 0; bj < 2; ++bj)
                        *(u32x4*)(VG + (size_t)(row0 + ai * HALF + m * 16) * 512 + (slot - 20) * 64 + 32 * bj + dl) = pack8(g[bj][0] * r * w[bj][0], g[bj][1] * r * w[bj][1]);
                }
        }
    }
};
constexpr int RS_M = 32768;
__device__ __forceinline__ float row_total(const float* part, int row, int fq) {
    const f32x4 p = *(const f32x4*)(part + ((size_t)fq * RS_M + row) * 4); float t = (p[0] + p[1]) + (p[2] + p[3]); t = xor32_add(xor16_add(t)); return t;
}
template <int V> struct EpiResid {
    static constexpr bool PERM = true, AFTER_DRAIN = false, XNOUT = (V == 4), FINAL = (V == 10), BASE16 = (V != 4);
    ArgsP A; void* outp;
    __device__ __forceinline__ void operator()(f32x4 (&acc)[2][2][4][2], const Unit& u, int wr, int wc, int fr_, int fq_) const {
        int t_ = threadIdx.x; asm volatile("" : "+v"(t_)); const int fr = t_ & 15, fq = (t_ >> 4) & 3; (void)fr_; (void)fq_;
        const int row0 = u.pm * BM + wr * 64 + fr, col0 = u.pn * BM + wc * 32 + 8 * fq, b = u.pm >> 4;
        ArgsP a_ = A; asm volatile("" : "+s"(a_)); unsigned char* ws_ = a_->ws; constexpr int gstride = MODW;
        const float* mods_ = (const float*)(ws_ + WS_MODS); const float* modl_ = mods_ + (V == 10 ? 9 * MODW : 0);
        const float* basef = a_->in[I_X]; const bf16_t* baseh = (const bf16_t*)(ws_ + WS_RES); const float* gate = modl_ + (V == 4 ? GA1 : GA2);
        float* part = (float*)(ws_ + WS_PART) + (size_t)(V == 4 ? 0 : V == 10 ? 3 : 1) * 16 * RS_M;
        bf16_t* xn = (bf16_t*)(ws_ + WS_XN); const float* gnext = (V == 4) ? a_->in[I_GFFN] : a_->in[I_GMIX] + DM; const float* scnext = (V == 4) ? mods_ + SC2 : mods_ + 9 * MODW + SC1;
        unsigned* cnt = (unsigned*)(ws_ + WS_CTL + CTL_CNT); const float* gfin = a_->in[I_GFIN];
        bf16_t* resout = (bf16_t*)outp; float* out = (float*)outp;
        const float* gp = gate + (size_t)b * gstride + col0;
        f32x4 gvv[2][2], gmn[2][2];
#pragma unroll
        for (int bj = 0; bj < 2; ++bj)
#pragma unroll
            for (int n = 0; n < 2; ++n) { gvv[bj][n] = *(const f32x4*)(gp + bj * HALF + n * 4);
                if (XNOUT) gmn[bj][n] = *(const f32x4*)(gnext + col0 + bj * HALF + n * 4) * (*(const f32x4*)(scnext + (size_t)b * gstride + col0 + bj * HALF + n * 4) + 1.0f); }
        float ssv[2][4];
        f32x4 bsA[2][2], bsB[2][2], bsC[2][2], bsD[2][2], bsE[2][2], bsF[2][2], bsG[2][2], bsH[2][2];
        u32x4 hsA[2], hsB[2], hsC[2], hsD[2], hsE[2], hsF[2], hsG[2], hsH[2];
#define ER_LOAD(X, p) do { const size_t off_ = (size_t)(row0 + ((p) >> 2) * HALF + ((p) & 3) * 16) * 1024 + col0; \
            _Pragma("unroll") for (int bj = 0; bj < 2; ++bj) { if (BASE16) { if (FINAL) hs##X[bj] = __builtin_nontemporal_load((const u32x4*)(baseh + off_ + bj * HALF)); else hs##X[bj] = *(const u32x4*)(baseh + off_ + bj * HALF); } \
                else { bs##X[bj][0] = __builtin_nontemporal_load((const f32x4*)(basef + off_ + bj * HALF)); bs##X[bj][1] = __builtin_nontemporal_load((const f32x4*)(basef + off_ + bj * HALF + 4)); } } } while (0)
#define ER_WORK(X, p) do { const int ai = (p) >> 2, m = (p) & 3; const size_t off_ = (size_t)(row0 + ai * HALF + m * 16) * 1024 + col0; float ss = 0.f; \
            _Pragma("unroll") for (int bj = 0; bj < 2; ++bj) { f32x4 b0, b1; \
                if (BASE16) { const u32x4 h = hs##X[bj]; b0 = (f32x4){__builtin_bit_cast(float, h.x << 16), __builtin_bit_cast(float, h.x & 0xffff0000u), __builtin_bit_cast(float, h.y << 16), __builtin_bit_cast(float, h.y & 0xffff0000u)}; \
                    b1 = (f32x4){__builtin_bit_cast(float, h.z << 16), __builtin_bit_cast(float, h.z & 0xffff0000u), __builtin_bit_cast(float, h.w << 16), __builtin_bit_cast(float, h.w & 0xffff0000u)}; } \
                else { b0 = bs##X[bj][0]; b1 = bs##X[bj][1]; } \
                const f32x4 x0 = b0 + gvv[bj][0] * acc[ai][bj][m][0], x1 = b1 + gvv[bj][1] * acc[ai][bj][m][1]; \
                ss += ((x0[0] * x0[0] + x0[1] * x0[1]) + (x0[2] * x0[2] + x0[3] * x0[3])) + ((x1[0] * x1[0] + x1[1] * x1[1]) + (x1[2] * x1[2] + x1[3] * x1[3])); \
                if (FINAL) { acc[ai][bj][m][0] = x0; acc[ai][bj][m][1] = x1; } else *(u32x4*)(resout + off_ + bj * HALF) = pack8(x0, x1); \
                if (XNOUT) *(u32x4*)(xn + off_ + bj * HALF) = pack8(x0 * gmn[bj][0], x1 * gmn[bj][1]); } \
            ss = xor32_add(xor16_add(ss)); ssv[ai][m] = ss; } while (0)
#define ER_FENCE asm volatile("" ::: "memory")
        if constexpr (FINAL) {
            ER_LOAD(A, 0); ER_LOAD(B, 1); ER_LOAD(C, 2); ER_LOAD(D, 3); ER_LOAD(E, 4); ER_LOAD(F, 5); ER_LOAD(G, 6); ER_LOAD(H, 7); ER_FENCE;
            ER_WORK(A, 0); ER_WORK(B, 1); ER_WORK(C, 2); ER_WORK(D, 3); ER_WORK(E, 4); ER_WORK(F, 5); ER_WORK(G, 6); ER_WORK(H, 7);
        } else if constexpr (BASE16) {
            ER_LOAD(A, 0); ER_LOAD(B, 1); ER_LOAD(C, 2); ER_LOAD(D, 3); ER_FENCE;
            ER_LOAD(E, 4); ER_FENCE; ER_WORK(A, 0); ER_FENCE;
            ER_LOAD(A, 5); ER_FENCE; ER_WORK(B, 1); ER_FENCE;
            ER_LOAD(B, 6); ER_FENCE; ER_WORK(C, 2); ER_FENCE;
            ER_LOAD(C, 7); ER_FENCE; ER_WORK(D, 3); ER_FENCE;
            ER_WORK(E, 4); ER_FENCE; ER_WORK(A, 5); ER_FENCE; ER_WORK(B, 6); ER_FENCE; ER_WORK(C, 7);
        } else {
            ER_LOAD(A, 0); ER_LOAD(B, 1); ER_FENCE;
            ER_LOAD(C, 2); ER_FENCE; ER_WORK(A, 0); ER_FENCE;
            ER_LOAD(A, 3); ER_FENCE; ER_WORK(B, 1); ER_FENCE;
            ER_LOAD(B, 4); ER_FENCE; ER_WORK(C, 2); ER_FENCE;
            ER_LOAD(C, 5); ER_FENCE; ER_WORK(A, 3); ER_FENCE;
            ER_LOAD(A, 6); ER_FENCE; ER_WORK(B, 4); ER_FENCE;
            ER_LOAD(B, 7); ER_FENCE; ER_WORK(C, 5); ER_FENCE;
            ER_WORK(A, 6); ER_FENCE;
            ER_WORK(B, 7);
        }
#undef ER_FENCE
#undef ER_LOAD
#undef ER_WORK
        if (fq == 0) {
#pragma unroll
            for (int ai = 0; ai < 2; ++ai)
#pragma unroll
                for (int m = 0; m < 4; ++m) { float* pp = part + ((size_t)u.pn * RS_M + (row0 + ai * HALF + m * 16)) * 4 + wc;
                    if (FINAL) __hip_atomic_store(pp, ssv[ai][m], __ATOMIC_RELAXED, __HIP_MEMORY_SCOPE_AGENT); else *pp = ssv[ai][m]; }
        }
        if (FINAL) {
            asm volatile("s_waitcnt vmcnt(0)" ::: "memory");
            unsigned* cw = cnt + 64 * u.pm;
            if (fr == 0 && fq == 0) __hip_atomic_fetch_add(cw, 1u, __ATOMIC_RELAXED, __HIP_MEMORY_SCOPE_AGENT);
            { unsigned sp = 0; while ((unsigned)__builtin_amdgcn_readfirstlane(__hip_atomic_load(cw, __ATOMIC_RELAXED, __HIP_MEMORY_SCOPE_AGENT)) < 32u) { __builtin_amdgcn_s_sleep(2); if (++sp > (1u << 22)) break; } }
            f32x4 gf[2][2];
#pragma unroll
            for (int bj = 0; bj < 2; ++bj)
#pragma unroll
                for (int n = 0; n < 2; ++n) gf[bj][n] = *(const f32x4*)(gfin + col0 + bj * HALF + n * 4);
            float rr[2][4];
            {
                f32x4 pq[8];
#pragma unroll
                for (int i = 0; i < 8; ++i) { const float* pp = part + ((size_t)fq * RS_M + (row0 + (i >> 2) * HALF + (i & 3) * 16)) * 4;
                    asm volatile("global_load_dwordx4 %0, %1, off sc1" : "=v"(pq[i]) : "v"(pp) : "memory"); }
                asm volatile("s_waitcnt vmcnt(0)" : "+v"(pq[0]), "+v"(pq[1]), "+v"(pq[2]), "+v"(pq[3]), "+v"(pq[4]), "+v"(pq[5]), "+v"(pq[6]), "+v"(pq[7]) :: "memory");
#pragma unroll
                for (int i = 0; i < 8; ++i) { float t = (pq[i][0] + pq[i][1]) + (pq[i][2] + pq[i][3]); t = xor32_add(xor16_add(t)); rr[i >> 2][i & 3] = __builtin_amdgcn_rsqf(t * (1.0f / 1024.0f) + 1e-6f); }
            }
#pragma unroll
            for (int ai = 0; ai < 2; ++ai)
#pragma unroll
                for (int m = 0; m < 4; ++m) { const size_t off = (size_t)(row0 + ai * HALF + m * 16) * 1024 + col0;
#pragma unroll
                    for (int bj = 0; bj < 2; ++bj)
#pragma unroll
                        for (int n = 0; n < 2; ++n) *(f32x4*)(out + off + bj * HALF + n * 4) = acc[ai][bj][m][n] * rr[ai][m] * gf[bj][n]; }
        }
    }
};
template <int L> struct EpiSwiglu {
    static constexpr bool PERM = true, AFTER_DRAIN = false;
    ArgsP A; const PG8_LAS float* rtab; int pm0;
    __device__ __forceinline__ void operator()(const f32x4 (&acc)[2][2][4][2], const Unit& u, int wr, int wc, int fr_, int fq_) const {
        int t_ = threadIdx.x; asm volatile("" : "+v"(t_)); const int fr = t_ & 15, fq = (t_ >> 4) & 3; (void)fr_; (void)fq_;
        const int row0 = u.pm * BM + wr * 64 + fr, col0 = u.pn * HALF + wc * 32 + 8 * fq;
        ArgsP a_ = A; asm volatile("" : "+s"(a_)); unsigned char* ws_ = a_->ws; constexpr int ldh = FF;
        bf16_t* H = (bf16_t*)(ws_ + WS_H); const float* rowss = (const float*)(ws_ + WS_PART) + (size_t)(L ? 2 : 0) * 16 * RS_M; const float* bias = (const float*)(ws_ + WS_BIAS) + (size_t)L * 8 * 5632;
        const float* bp = bias + (size_t)(u.pm >> 4) * 5632 + u.pn * BM + wc * 32 + 8 * fq;
        f32x4 bv[2][2];
#pragma unroll
        for (int bj = 0; bj < 2; ++bj)
#pragma unroll
            for (int n = 0; n < 2; ++n) bv[bj][n] = *(const f32x4*)(bp + bj * HALF + 4 * n);
        float rr[2][4]; { const PG8_LAS float* rt = rtab + (u.pm == pm0 ? 0 : 256) + wr * 64 + fr; (void)rowss;
#pragma unroll
            for (int ai = 0; ai < 2; ++ai)
#pragma unroll
                for (int m = 0; m < 4; ++m) rr[ai][m] = rt[ai * HALF + m * 16]; }
#pragma unroll
        for (int ai = 0; ai < 2; ++ai)
#pragma unroll
            for (int m = 0; m < 4; ++m) { const int row = row0 + ai * HALF + m * 16; const float r = rr[ai][m]; f32x4 h[2];
#pragma unroll
                for (int n = 0; n < 2; ++n) { const f32x4 a = acc[ai][0][m][n] * r + bv[0][n], b = acc[ai][1][m][n] * r + bv[1][n]; h[n] = (f32x4){silu1(a[0]) * b[0], silu1(a[1]) * b[1], silu1(a[2]) * b[2], silu1(a[3]) * b[3]}; }
                *(u32x4*)(H + (size_t)row * ldh + col0) = pack8(h[0], h[1]); }
    }
};

struct EpiNull {
    static constexpr bool PERM = true, AFTER_DRAIN = false;
    bf16_t* D;
    __device__ __forceinline__ void operator()(const f32x4 (&acc)[2][2][4][2], const Unit& u, int wr, int wc, int fr_, int fq_) const {
        int t_ = threadIdx.x; asm volatile("" : "+v"(t_)); const int fr = t_ & 15, fq = (t_ >> 4) & 3; (void)fr_; (void)fq_;
        const int row0 = u.pm * BM + wr * 64 + fr, col0 = u.pn * BM + wc * 32 + 8 * fq;
#pragma unroll
        for (int ai = 0; ai < 2; ++ai)
#pragma unroll
            for (int m = 0; m < 4; ++m)
#pragma unroll
                for (int bj = 0; bj < 2; ++bj) *(u32x4*)(D + (size_t)(row0 + ai * HALF + m * 16) * 1024 + col0 + bj * HALF) = pack8(acc[ai][bj][m][0], acc[ai][bj][m][1]);
    }
};
struct EpiNullWide {
    static constexpr bool PERM = true, AFTER_DRAIN = false;
    bf16_t* D;
    __device__ __forceinline__ void operator()(const f32x4 (&acc)[2][2][4][2], const Unit& u, int wr, int wc, int fr_, int fq_) const {
        int t_ = threadIdx.x; asm volatile("" : "+v"(t_)); const int fr = t_ & 15, fq = (t_ >> 4) & 3; (void)fr_; (void)fq_;
        const int row0 = u.pm * BM + wr * 64 + fr, col0 = u.pn * HALF + wc * 32 + 8 * fq;
#pragma unroll
        for (int ai = 0; ai < 2; ++ai)
#pragma unroll
            for (int m = 0; m < 4; ++m) *(u32x4*)(D + (size_t)(row0 + ai * HALF + m * 16) * 2816 + col0) = pack8(acc[ai][0][m][0] + acc[ai][1][m][0], acc[ai][0][m][1] + acc[ai][1][m][1]);
    }
};
struct EpiZ {
    static constexpr bool PERM = true, AFTER_DRAIN = false;
    ArgsP A;
    __device__ __forceinline__ void operator()(const f32x4 (&acc)[2][2][4][2], const Unit& u, int wr, int wc, int fr_, int fq_) const {
        int t_ = threadIdx.x; asm volatile("" : "+v"(t_)); const int fr = t_ & 15, fq = (t_ >> 4) & 3; (void)fr_; (void)fq_;
        const int row0 = u.pm * BM + wr * 64 + fr, col0 = u.pn * BM + wc * 32 + 8 * fq;
        ArgsP a_ = A; asm volatile("" : "+s"(a_)); unsigned char* ws_ = a_->ws; bf16_t* Z = (bf16_t*)(ws_ + WS_AM); const float* rowss = (const float*)(ws_ + WS_PART) + (size_t)16 * RS_M;
        float rr[2][4];
#pragma unroll
        for (int ai = 0; ai < 2; ++ai) {
#pragma unroll
            for (int m = 0; m < 4; ++m) rr[ai][m] = __builtin_amdgcn_rsqf(row_total(rowss, row0 + ai * HALF + m * 16, fq) * (1.0f / 1024.0f) + 1e-6f);
            asm volatile("" ::: "memory"); }
#pragma unroll
        for (int ai = 0; ai < 2; ++ai)
#pragma unroll
            for (int m = 0; m < 4; ++m)
#pragma unroll
                for (int bj = 0; bj < 2; ++bj) *(u32x4*)(Z + (size_t)(row0 + ai * HALF + m * 16) * 1024 + col0 + bj * HALF) = pack8(acc[ai][bj][m][0] * rr[ai][m], acc[ai][bj][m][1] * rr[ai][m]);
    }
};

template <class Epi, class Sched, bool ALIGN_EPI = false, bool SP2 = false>
__device__ __forceinline__ void gemm_phase(PG8_LAS unsigned char* lds, const Gemm g, const Sched& S, const Epi& E) {
    int tid_ = threadIdx.x; asm volatile("" : "+v"(tid_));
    const int tid = tid_, wid = __builtin_amdgcn_readfirstlane(tid >> 6), lane = tid & 63, wr = wid >> 2, wc = wid & 3, fr = lane & 15, fq = lane >> 4;
    const int K = g.K, nt = K / BK;
    unsigned voffA[2], voffB[2];
#pragma unroll
    for (int i = 0; i < 2; ++i) { int R, C; stage_rc(tid * 16 + i * 8192, R, C); const int Rb = Epi::PERM ? ((R & ~31) + perm32(R & 31)) : R;
        voffA[i] = (unsigned)(R * g.lda + C) * 2u; voffB[i] = (unsigned)(Rb * K + C) * 2u; }
    const size_t kstep = (size_t)(BK * 2);
    const size_t hsA = (size_t)HALF * g.lda * 2, hsB = (size_t)HALF * K * 2;
    const size_t tsA = 2 * hsA, tsB = 2 * hsB;
    const unsigned ldsw = (unsigned)wid * 1024u;
    const int aoff = lds_byte(wr * 64 + fr, fq * 8), boff = lds_byte(wc * 32 + fr, fq * 8);
#define PG8_SA(b, h) (((b) * 2 + (h)) * HTB)
#define PG8_SB(b, h) ((4 + (b) * 2 + (h)) * HTB)
#define PG8_STAGE(bufoff, gbase, voff) do { _Pragma("unroll") for (int _i = 0; _i < 2; ++_i) \
        __builtin_amdgcn_global_load_lds((const unsigned*)((const char*)(gbase) + (voff)[_i]), (PG8_LAS unsigned*)(lds + (bufoff) + ldsw + _i * 8192), 16, 0, 0); } while (0)
#define PG8_LDA(dst, b, h) do { _Pragma("unroll") for (int m = 0; m < 4; ++m) _Pragma("unroll") for (int k = 0; k < 2; ++k) dst[m][k] = *(const PG8_LAS bf16x8*)(lds + PG8_SA(b, h) + aoff + m * 2048 + k * 1024); } while (0)
#define PG8_LDB(dst, b, h) do { _Pragma("unroll") for (int n = 0; n < 2; ++n) _Pragma("unroll") for (int k = 0; k < 2; ++k) dst[n][k] = *(const PG8_LAS bf16x8*)(lds + PG8_SB(b, h) + boff + n * 2048 + k * 1024); } while (0)
#define PG8_MMA(ai, bj, At, Bt) do { __builtin_amdgcn_s_setprio(1); _Pragma("unroll") for (int m = 0; m < 4; ++m) _Pragma("unroll") for (int n = 0; n < 2; ++n) _Pragma("unroll") for (int k = 0; k < 2; ++k) \
        acc[ai][bj][m][n] = __builtin_amdgcn_mfma_f32_16x16x32_bf16(Bt[n][k], At[m][k], acc[ai][bj][m][n], 0, 0, 0); __builtin_amdgcn_s_setprio(0); } while (0)
#define PG8_WAIT_V(n) asm volatile("s_waitcnt vmcnt(" #n ")" ::: "memory")
#define PG8_WAIT_L(n) asm volatile("s_waitcnt lgkmcnt(" #n ")" ::: "memory")
#define PG8_BAR __builtin_amdgcn_s_barrier()
#define PG8_SCHED __builtin_amdgcn_sched_barrier(0)
    Unit cur, nxt; int ui = 0;
    if (!S.next(0, cur)) return;
    f32x4 acc[2][2][4][2];
#pragma unroll
    for (int a = 0; a < 2; ++a)
#pragma unroll
        for (int b = 0; b < 2; ++b)
#pragma unroll
            for (int m = 0; m < 4; ++m)
#pragma unroll
                for (int n = 0; n < 2; ++n) acc[a][b][m][n] = (f32x4){0.f, 0.f, 0.f, 0.f};
    bf16x8 At[4][2], B0[2][2], B1[2][2];
    const char* cA = (const char*)g.A + (size_t)cur.pm * tsA + (size_t)cur.pn * g.a_pn_bytes; const char* cB = (const char*)g.Bt + (size_t)cur.pn * tsB + (size_t)(cur.pm >> 4) * g.b_batch_bytes;
    S.a_ready(cur);
    if constexpr (SP2) {
        PG8_STAGE(PG8_SB(0, 0), cB, voffB); PG8_STAGE(PG8_SB(0, 1), cB + hsB, voffB); PG8_STAGE(PG8_SA(0, 0), cA, voffA); PG8_STAGE(PG8_SA(0, 1), cA + hsA, voffA);
        if (wr == 1) PG8_BAR;
        PG8_WAIT_V(2); PG8_BAR;
        PG8_STAGE(PG8_SB(1, 0), cB + kstep, voffB); PG8_STAGE(PG8_SA(1, 0), cA + kstep, voffA); PG8_STAGE(PG8_SB(1, 1), cB + hsB + kstep, voffB);
        PG8_WAIT_V(6); PG8_BAR;
    } else {
        PG8_STAGE(PG8_SB(0, 0), cB, voffB); PG8_STAGE(PG8_SA(0, 0), cA, voffA); PG8_STAGE(PG8_SB(0, 1), cB + hsB, voffB); PG8_STAGE(PG8_SA(0, 1), cA + hsA, voffA);
        if (wr == 1) PG8_BAR;
        PG8_WAIT_V(4); PG8_BAR;
        PG8_STAGE(PG8_SB(1, 0), cB + kstep, voffB); PG8_STAGE(PG8_SA(1, 0), cA + kstep, voffA); PG8_STAGE(PG8_SB(1, 1), cB + hsB + kstep, voffB);
        PG8_WAIT_V(6); PG8_BAR;
    }
    for (;;) {
        const bool has_next = S.next(ui + 1, nxt);
        const char* nA = has_next ? (const char*)g.A + (size_t)nxt.pm * tsA + (size_t)nxt.pn * g.a_pn_bytes : cA; const char* nB = has_next ? (const char*)g.Bt + (size_t)nxt.pn * tsB + (size_t)(nxt.pm >> 4) * g.b_batch_bytes : cB;
#pragma unroll 1
        for (int t = 0; t < nt; t += 2) {
            const bool last = (t == nt - 2);
            const char* a1 = cA + (size_t)(t + 1) * kstep;
            const char* a2 = last ? nA : cA + (size_t)(t + 2) * kstep; const char* b2 = last ? nB : cB + (size_t)(t + 2) * kstep;
            const char* a3 = a2 + kstep; const char* b3 = b2 + kstep;
            if (last && has_next) S.a_ready(nxt);
            if constexpr (SP2) {
            PG8_LDB(B0, 0, 0); PG8_LDB(B1, 0, 1); PG8_SCHED; PG8_LDA(At, 0, 0); PG8_STAGE(PG8_SA(1, 1), a1 + hsA, voffA);
            PG8_WAIT_V(8); PG8_WAIT_L(0); PG8_BAR; PG8_MMA(0, 0, At, B0); PG8_MMA(0, 1, At, B1); PG8_BAR; PG8_SCHED;
            PG8_LDA(At, 0, 1); PG8_STAGE(PG8_SB(0, 0), b2, voffB); PG8_STAGE(PG8_SB(0, 1), b2 + hsB, voffB); PG8_STAGE(PG8_SA(0, 0), a2, voffA);
            PG8_WAIT_V(8); PG8_WAIT_L(0); PG8_BAR; PG8_MMA(1, 0, At, B0); PG8_MMA(1, 1, At, B1); PG8_BAR; PG8_SCHED;
            PG8_LDB(B0, 1, 0); PG8_LDB(B1, 1, 1); PG8_SCHED; PG8_LDA(At, 1, 0); PG8_STAGE(PG8_SA(0, 1), a2 + hsA, voffA);
            PG8_WAIT_V(8); PG8_WAIT_L(0); PG8_BAR; PG8_MMA(0, 0, At, B0); PG8_MMA(0, 1, At, B1); PG8_BAR; PG8_SCHED;
            PG8_LDA(At, 1, 1); PG8_STAGE(PG8_SB(1, 0), b3, voffB); PG8_STAGE(PG8_SB(1, 1), b3 + hsB, voffB); PG8_STAGE(PG8_SA(1, 0), a3, voffA);
            PG8_WAIT_V(8); PG8_WAIT_L(0); PG8_BAR; PG8_MMA(1, 0, At, B0); PG8_MMA(1, 1, At, B1); PG8_BAR; PG8_SCHED;
            } else {
            PG8_LDB(B0, 0, 0); PG8_SCHED; PG8_LDA(At, 0, 0); PG8_STAGE(PG8_SA(1, 1), a1 + hsA, voffA);
            PG8_WAIT_L(8); PG8_BAR; PG8_WAIT_L(0); PG8_MMA(0, 0, At, B0); PG8_BAR; PG8_SCHED;
            PG8_LDB(B1, 0, 1); PG8_STAGE(PG8_SB(0, 0), b2, voffB);
            PG8_BAR; PG8_WAIT_L(0); PG8_MMA(0, 1, At, B1); PG8_BAR;
            PG8_LDA(At, 0, 1); PG8_STAGE(PG8_SA(0, 0), a2, voffA);
            PG8_BAR; PG8_WAIT_L(0); PG8_MMA(1, 0, At, B0); PG8_BAR; PG8_SCHED;
            PG8_STAGE(PG8_SB(0, 1), b2 + hsB, voffB);
            PG8_WAIT_V(6); PG8_BAR; PG8_MMA(1, 1, At, B1); PG8_BAR;
            PG8_LDB(B0, 1, 0); PG8_SCHED; PG8_LDA(At, 1, 0); PG8_STAGE(PG8_SA(0, 1), a2 + hsA, voffA);
            PG8_WAIT_L(8); PG8_BAR; PG8_WAIT_L(0); PG8_MMA(0, 0, At, B0); PG8_BAR; PG8_SCHED;
            PG8_LDB(B1, 1, 1); PG8_STAGE(PG8_SB(1, 0), b3, voffB);
            PG8_BAR; PG8_WAIT_L(0); PG8_MMA(0, 1, At, B1); PG8_BAR;
            PG8_LDA(At, 1, 1); PG8_STAGE(PG8_SA(1, 0), a3, voffA);
            PG8_BAR; PG8_WAIT_L(0); PG8_MMA(1, 0, At, B0); PG8_BAR; PG8_SCHED;
            PG8_STAGE(PG8_SB(1, 1), b3 + hsB, voffB);
            PG8_WAIT_V(6); PG8_BAR; PG8_MMA(1, 1, At, B1); PG8_BAR;
            }
        }
        if constexpr (ALIGN_EPI) { if (wr == 0) PG8_BAR; }
        if constexpr (!Epi::AFTER_DRAIN) { E(acc, cur, wr, wc, fr, fq); S.done(cur); }
        if (!has_next) break;
#pragma unroll
        for (int a = 0; a < 2; ++a)
#pragma unroll
            for (int b = 0; b < 2; ++b)
#pragma unroll
                for (int m = 0; m < 4; ++m)
#pragma unroll
                    for (int n = 0; n < 2; ++n) acc[a][b][m][n] = (f32x4){0.f, 0.f, 0.f, 0.f};
        cur = nxt; cA = nA; cB = nB; ++ui;
        if constexpr (ALIGN_EPI) { if (wr == 1) PG8_BAR; }
    }
    PG8_WAIT_V(0);
    if constexpr (!ALIGN_EPI) { if (wr == 0) PG8_BAR; }
    PG8_BAR;
    if constexpr (Epi::AFTER_DRAIN) { E.fused(acc, cur, wr, wc, fr, fq, lds, wid, lane); S.done(cur); }
#undef PG8_SA
#undef PG8_SB
#undef PG8_STAGE
#undef PG8_LDA
#undef PG8_LDB
#undef PG8_MMA
#undef PG8_WAIT_V
#undef PG8_WAIT_L
#undef PG8_BAR
#undef PG8_SCHED
}
}
namespace attn_body {
using bf16=__hip_bfloat16;
using bf16x8=__attribute__((ext_vector_type(8)))short;
using s16x4=__attribute__((ext_vector_type(4)))short;
using f32x16=__attribute__((ext_vector_type(16)))float;
using u32x4=__attribute__((ext_vector_type(4)))unsigned;
constexpr int BATCH=8,NHEAD=8,NKVH=2,SEQ=4096,SKV=4352,D=64,QP=512,KP=128,OP=1024;
constexpr int NW=8,QBLK=32,QB=QBLK*NW,KVBLK=64,NQB=SEQ/QB;
constexpr int ATTN_UNIT_ROWS=QB;
__device__ __forceinline__ int crow(int r,int hi){return (r&3)+8*(r>>2)+4*hi;}
#define SBAR() __builtin_amdgcn_sched_barrier(0)
constexpr int NSLOT=3, SLOTB=8192;
constexpr int LDS_K=0, LDS_V=NSLOT*SLOTB, LDS_WS=2*NSLOT*SLOTB, LDS_OST=LDS_WS+NW*64*4, LDS_BYTES=LDS_OST+NW*4096;
constexpr float C2=0.125f*1.4426950408889634f;
__device__ __forceinline__ void glds16(const void*gsrc,unsigned lds_dst){unsigned keep;
  asm volatile("s_mov_b32 %0, m0\n\ts_mov_b32 m0, %2\n\ts_nop 0\n\tglobal_load_lds_dwordx4 %1, off\n\ts_mov_b32 m0, %0":"=&s"(keep):"v"(gsrc),"s"(lds_dst):"memory");}
__device__ __forceinline__ void glds16_nt(const void*gsrc,unsigned lds_dst){unsigned keep;
  asm volatile("s_mov_b32 %0, m0\n\ts_mov_b32 m0, %2\n\ts_nop 0\n\tglobal_load_lds_dwordx4 %1, off nt\n\ts_mov_b32 m0, %0":"=&s"(keep):"v"(gsrc),"s"(lds_dst):"memory");}
__device__ __forceinline__ float max3f(float a,float b,float c){float r;asm("v_max3_f32 %0, %1, %2, %3":"=v"(r):"v"(a),"v"(b),"v"(c));return r;}
__device__ __forceinline__ float max2f(float a,float b){float r;asm("v_max_f32_e32 %0, %1, %2":"=v"(r):"v"(a),"v"(b));return r;}
__device__ __forceinline__ float fadd_s(float a,float b){float r;asm("v_add_f32_e32 %0, %1, %2":"=v"(r):"v"(a),"v"(b));return r;}
__device__ __forceinline__ float fsub_s(float a,float b){float r;asm("v_sub_f32_e32 %0, %1, %2":"=v"(r):"v"(a),"v"(b));return r;}
typedef float f32x2_t __attribute__((ext_vector_type(2))); typedef __bf16 bf16x2_t __attribute__((ext_vector_type(2)));
__device__ __forceinline__ unsigned cvtpk_s(float lo,float hi){f32x2_t v={lo,hi};bf16x2_t b=__builtin_convertvector(v,bf16x2_t);return __builtin_bit_cast(unsigned,b);}
#define WAIT_BAR(N) asm volatile("s_waitcnt vmcnt(" #N ") lgkmcnt(0)\n\ts_barrier":::"memory")

__device__ __forceinline__ void qkt(f32x16&p0,f32x16&p1,const char*Kslot,const bf16x8*qr,const f32x16&negm,int r32,int hi){
  const char*kb=Kslot+hi*1024+r32*16;
  #pragma unroll
  for(int d0=0;d0<4;++d0){
    const bf16x8 b0=*reinterpret_cast<const bf16x8*>(kb+d0*2048);
    const bf16x8 b1=*reinterpret_cast<const bf16x8*>(kb+d0*2048+512);
    if(d0==0){p0=__builtin_amdgcn_mfma_f32_32x32x16_bf16(b0,qr[0],negm,0,0,0);p1=__builtin_amdgcn_mfma_f32_32x32x16_bf16(b1,qr[0],negm,0,0,0);}
    else{p0=__builtin_amdgcn_mfma_f32_32x32x16_bf16(b0,qr[d0],p0,0,0,0);p1=__builtin_amdgcn_mfma_f32_32x32x16_bf16(b1,qr[d0],p1,0,0,0);}}
}
typedef __attribute__((address_space(3))) const char* lds_cptr;
typedef short v4i16_t __attribute__((ext_vector_type(4)));
__device__ __forceinline__ void kload8(bf16x8*kf,lds_cptr kp){
  kf[0]=*(const __attribute__((address_space(3))) bf16x8*)(kp);      kf[1]=*(const __attribute__((address_space(3))) bf16x8*)(kp+512);
  kf[2]=*(const __attribute__((address_space(3))) bf16x8*)(kp+2048); kf[3]=*(const __attribute__((address_space(3))) bf16x8*)(kp+2560);
  kf[4]=*(const __attribute__((address_space(3))) bf16x8*)(kp+4096); kf[5]=*(const __attribute__((address_space(3))) bf16x8*)(kp+4608);
  kf[6]=*(const __attribute__((address_space(3))) bf16x8*)(kp+6144); kf[7]=*(const __attribute__((address_space(3))) bf16x8*)(kp+6656);
}
__device__ __forceinline__ void kload2(bf16x8*kf,lds_cptr kp,int j){ kf[2*j]=*(const __attribute__((address_space(3))) bf16x8*)(kp+j*2048); kf[2*j+1]=*(const __attribute__((address_space(3))) bf16x8*)(kp+j*2048+512); }
__device__ __forceinline__ s16x4 vtr(lds_cptr p){ return __builtin_bit_cast(s16x4,__builtin_amdgcn_ds_read_tr16_b64_v4i16((__attribute__((address_space(3))) v4i16_t*)p)); }
__device__ __forceinline__ float rowmax(const f32x16&p0,const f32x16&p1){
  float a=max3f(p0[0],p0[1],p1[0]),b=max3f(p0[2],p0[3],p1[1]);a=max3f(a,p1[2],p1[3]);
  #pragma unroll
  for(int r=4;r<16;r+=4){a=max3f(a,p0[r],p0[r+1]);b=max3f(b,p0[r+2],p0[r+3]);a=max3f(a,p1[r],p1[r+1]);b=max3f(b,p1[r+2],p1[r+3]);}
  const float m=max2f(a,b);
  auto rr=__builtin_amdgcn_permlane32_swap(__float_as_uint(m),__float_as_uint(m),false,false);
  return max2f(__uint_as_float(rr[0]),__uint_as_float(rr[1]));
}
__device__ __forceinline__ void pv(f32x16*o,int vb,bf16x8 pa0,bf16x8 pa1,bf16x8 pa2,bf16x8 pa3){
  #pragma unroll
  for(int d0=0;d0<2;++d0){s16x4 lo[4],hi[4];
    #pragma unroll
    for(int ks=0;ks<4;++ks){
      asm volatile("ds_read_b64_tr_b16 %0,%1 offset:%c2":"=&v"(lo[ks]):"v"(vb),"i"(d0*4096+ks*1024):"memory");
      asm volatile("ds_read_b64_tr_b16 %0,%1 offset:%c2":"=&v"(hi[ks]):"v"(vb),"i"(d0*4096+ks*1024+512):"memory");}
    asm volatile("s_waitcnt lgkmcnt(0)":::"memory");SBAR();
    #define PK(k) (bf16x8){lo[k][0],lo[k][1],lo[k][2],lo[k][3],hi[k][0],hi[k][1],hi[k][2],hi[k][3]}
    o[d0]=__builtin_amdgcn_mfma_f32_32x32x16_bf16(pa0,PK(0),o[d0],0,0,0);
    o[d0]=__builtin_amdgcn_mfma_f32_32x32x16_bf16(pa1,PK(1),o[d0],0,0,0);
    o[d0]=__builtin_amdgcn_mfma_f32_32x32x16_bf16(pa2,PK(2),o[d0],0,0,0);
    o[d0]=__builtin_amdgcn_mfma_f32_32x32x16_bf16(pa3,PK(3),o[d0],0,0,0);
    #undef PK
  }
}

#ifndef ATTN_STORE16
#define ATTN_STORE16(p,v) (*(u32x4*)(p)=(v))
#endif
template<int THRL,bool FIX> __device__ __forceinline__ void attn_unit(int b,int h,int qb,const bf16*Q,const bf16*__restrict__ K,const bf16*__restrict__ V,bf16*O,char*shm,float sref){
  int tid_=threadIdx.x; asm volatile("":"+v"(tid_)); const int tid=tid_,lane=tid&63,r32=lane&31,hi=lane>>5; const int wid=__builtin_amdgcn_readfirstlane(tid>>6);
  const long rowbase=(long)b*SEQ, kvbase=(long)b*SKV; const int q0=qb*QB;
  const bf16*Qw=Q+(rowbase+q0+wid*QBLK)*QP+h*D;
  const bf16*Kh=K+kvbase*KP+(h/(NHEAD/NKVH))*D,*Vh=V+kvbase*KP+(h/(NHEAD/NKVH))*D;
  const unsigned lds0=(unsigned)(uintptr_t)shm;
  float*wsf=(float*)(shm+LDS_WS)+wid*64;
  const bf16*ksrc=Kh+(long)lane*KP+wid*8;
  const bf16*vsrc=Vh+(long)(16*(wid&3)+(lane>>2))*KP+(wid>>2)*32+(lane&3)*8;
  const unsigned kdst=lds0+LDS_K+wid*1024, vdst=lds0+LDS_V+wid*1024;
  #define DMA_K(t,slot) glds16(ksrc+(long)(t)*KVBLK*KP,(unsigned)__builtin_amdgcn_readfirstlane(kdst+(slot)))
  #define DMA_V(t,slot) glds16(vsrc+(long)(t)*KVBLK*KP,(unsigned)__builtin_amdgcn_readfirstlane(vdst+(slot)))
  const int vb0=(int)(lds0+LDS_V)+((lane>>4)&1)*32+(lane&3)*8+(4*hi+((lane&15)>>2))*64;
  const char*Kbase=shm+LDS_K; bf16x8 kf[8];
  const lds_cptr shm3=(lds_cptr)shm; const lds_cptr kp0=shm3+LDS_K+hi*1024+r32*16; const lds_cptr vp0=shm3+LDS_V+((lane>>4)&1)*32+(lane&3)*8+(4*hi+((lane&15)>>2))*64;
  constexpr int NT=SKV/KVBLK;
  DMA_K(0,0);DMA_V(0,0);DMA_K(1,SLOTB);
  bf16x8 qr[4];
  #pragma unroll
  for(int d0=0;d0<4;++d0)qr[d0]=__builtin_nontemporal_load(reinterpret_cast<const bf16x8*>(&Qw[(long)r32*QP+d0*16+hi*8]));
  float mhat=0.f,l_reg=0.f;f32x16 o[2];o[0]=f32x16{};o[1]=f32x16{};f32x16 negm=f32x16{};
  if constexpr(FIX){ _Pragma("unroll") for(int r=0;r<16;++r)negm[r]=-sref; }
  asm volatile("":"+v"(negm));
  #define CMASK(P0,P1,t) do{}while(0)
  bool resc=false;
  #define START(P0,P1) do{ resc=false; if constexpr(!FIX) \
    { const float rm=rowmax(P0,P1); const float dl=rm; mhat=fadd_s(mhat,dl); \
      _Pragma("unroll") for(int r=0;r<16;++r){P0[r]=fsub_s(P0[r],dl);P1[r]=fsub_s(P1[r],dl);} \
      _Pragma("unroll") for(int r=0;r<16;++r)negm[r]=-mhat; asm volatile("":"+v"(negm)); } \
    _Pragma("unroll") for(int r=0;r<16;++r)P0[r]=__builtin_amdgcn_exp2f(P0[r]); }while(0)
  #define RESC() do{ if constexpr(!FIX) if(resc){ asm volatile("s_waitcnt lgkmcnt(0)":::"memory"); \
      _Pragma("unroll") for(int d_=0;d_<2;++d_) _Pragma("unroll") for(int r=0;r<16;++r)o[d_][r]*=wsf[crow(r,hi)]; } }while(0)
  f32x16 pA0,pA1,pB0,pB1;
  int sl_prev=0,sl_cur=0,sl_next=SLOTB;
  #define ROT() do{sl_prev=sl_cur;sl_cur=sl_next;sl_next=(sl_next==(NSLOT-1)*SLOTB)?0:sl_next+SLOTB;}while(0)
  DMA_K(2,2*SLOTB);
  WAIT_BAR(3);
  qkt(pA0,pA1,Kbase,qr,negm,r32,hi);asm volatile("s_nop 15\n\ts_nop 7":"+v"(pA0),"+v"(pA1));CMASK(pA0,pA1,0);
  START(pA0,pA1);
  _Pragma("unroll") for(int r=0;r<16;++r)pA1[r]=__builtin_amdgcn_exp2f(pA1[r]);
  WAIT_BAR(0);
  DMA_K(3,0);DMA_V(1,SLOTB);
  ROT();
  kload8(kf,kp0+sl_cur);
  WAIT_BAR(2);
  s16x4 vlo[8],vhi[8]; u32x4 pw0,pw1,pw2,pw3;
  #define PKW(P,B) cvtpk_s(P[B],P[B+1])
  #define PAF(k) __builtin_bit_cast(bf16x8,pw##k)
  #define VFR(i) (bf16x8){vlo[i][0],vlo[i][1],vlo[i][2],vlo[i][3],vhi[i][0],vhi[i][1],vhi[i][2],vhi[i][3]}
  #define PIN(x) asm volatile("":"+v"(x))
  #define MX3(a,b,c) __builtin_fmaxf(__builtin_fmaxf((a),(b)),(c))
  #define GAPA(MF,A0,A1,A2,A3,W0,W1,PW) do{ MF; sacc+=A0; sacc+=A1; sacc+=A2; sacc+=A3; PIN(sacc); W0; W1; PIN(PW); SBAR(); }while(0)
  #define EX(v) __builtin_amdgcn_exp2f(v)
  #define GAPB(MF,X,B) do{ MF; X[B]=EX(X[B]); X[B+1]=EX(X[B+1]); X[B+2]=EX(X[B+2]); X[B+3]=EX(X[B+3]); PIN(X); SBAR(); }while(0)
  #define VRD(i) do{ vlo[i]=vtr(vp_+(((i)>>2)*4096+((i)&3)*1024)); vhi[i]=vtr(vp_+(((i)>>2)*4096+((i)&3)*1024+512)); }while(0)
  #define KRD(G,j) do{ if(G){ kload2(kf,kp0+sl_next,j); SBAR(); } }while(0)
  #define STEP(C0,C1,P0,P1,t,GK,GV,GL) do{ SBAR(); \
    const lds_cptr vp_=vp0+sl_prev; \
    VRD(0); SBAR(); float sacc=(P0[0]+P0[1]); \
    GAPA(C0=__builtin_amdgcn_mfma_f32_32x32x16_bf16(kf[0],qr[0],negm,0,0,0), P0[2],P0[3],P0[4],P0[5],     pw0[0]=PKW(P0,0), pw0[1]=PKW(P0,2), pw0); \
    VRD(4); SBAR(); GAPA(C1=__builtin_amdgcn_mfma_f32_32x32x16_bf16(kf[1],qr[0],negm,0,0,0), P0[6],P0[7],P0[8],P0[9],     pw0[2]=PKW(P0,4), pw0[3]=PKW(P0,6), pw0); \
    VRD(1); SBAR(); GAPA(C0=__builtin_amdgcn_mfma_f32_32x32x16_bf16(kf[2],qr[1],C0,0,0,0),   P0[10],P0[11],P0[12],P0[13], pw1[0]=PKW(P0,8), pw1[1]=PKW(P0,10), pw1); \
    VRD(5); SBAR(); GAPA(C1=__builtin_amdgcn_mfma_f32_32x32x16_bf16(kf[3],qr[1],C1,0,0,0),   P0[14],P0[15],P1[0],P1[1],   pw1[2]=PKW(P0,12),pw1[3]=PKW(P0,14), pw1); \
    VRD(2); SBAR(); GAPA(C0=__builtin_amdgcn_mfma_f32_32x32x16_bf16(kf[4],qr[2],C0,0,0,0),   P1[2],P1[3],P1[4],P1[5],     pw2[0]=PKW(P1,0), pw2[1]=PKW(P1,2), pw2); \
    VRD(6); SBAR(); GAPA(C1=__builtin_amdgcn_mfma_f32_32x32x16_bf16(kf[5],qr[2],C1,0,0,0),   P1[6],P1[7],P1[8],P1[9],     pw2[2]=PKW(P1,4), pw2[3]=PKW(P1,6), pw2); \
    VRD(3); SBAR(); GAPA(C0=__builtin_amdgcn_mfma_f32_32x32x16_bf16(kf[6],qr[3],C0,0,0,0),   P1[10],P1[11],P1[12],P1[13], pw3[0]=PKW(P1,8), pw3[1]=PKW(P1,10), pw3); \
    VRD(7); SBAR(); GAPA(C1=__builtin_amdgcn_mfma_f32_32x32x16_bf16(kf[7],qr[3],C1,0,0,0),   P1[14],P1[15],0.f,0.f,       pw3[2]=PKW(P1,12),pw3[3]=PKW(P1,14), pw3); \
    l_reg+=sacc; \
    if(GK){DMA_K((t)+3,sl_cur);} if(GV){DMA_V((t)+1,sl_next);} \
    CMASK(C0,C1,t); \
    if constexpr(!FIX) { float a=MX3(C0[0],C0[1],C1[0]),b=MX3(C0[2],C0[3],C1[1]); a=MX3(a,C1[2],C1[3]); \
      _Pragma("unroll") for(int r=4;r<16;r+=4){a=MX3(a,C0[r],C0[r+1]);b=MX3(b,C0[r+2],C0[r+3]);a=MX3(a,C1[r],C1[r+1]);b=MX3(b,C1[r+2],C1[r+3]);} \
      float rm=__builtin_fmaxf(a,b); { auto rr=__builtin_amdgcn_permlane32_swap(__float_as_uint(rm),__float_as_uint(rm),false,false); rm=__builtin_fmaxf(__uint_as_float(rr[0]),__uint_as_float(rr[1])); } \
      resc=false; \
      if(__builtin_expect(__any(rm>(float)THRL),0)){ const float dl=__builtin_fmaxf(rm,0.f); mhat+=dl; \
        _Pragma("unroll") for(int r=0;r<16;++r){C0[r]-=dl;C1[r]-=dl;} \
        _Pragma("unroll") for(int r=0;r<16;++r)negm[r]=-mhat; asm volatile("":"+v"(negm)); \
        const float f=__builtin_amdgcn_exp2f(-dl); l_reg*=f; if(hi==0)wsf[r32]=f; resc=true; } } \
    SBAR(); \
    GAPB(o[0]=__builtin_amdgcn_mfma_f32_32x32x16_bf16(PAF(0),VFR(0),o[0],0,0,0), C0,0); \
    GAPB(o[1]=__builtin_amdgcn_mfma_f32_32x32x16_bf16(PAF(0),VFR(4),o[1],0,0,0), C0,4); \
    KRD(GL,0); GAPB(o[0]=__builtin_amdgcn_mfma_f32_32x32x16_bf16(PAF(1),VFR(1),o[0],0,0,0), C0,8); \
    KRD(GL,1); GAPB(o[1]=__builtin_amdgcn_mfma_f32_32x32x16_bf16(PAF(1),VFR(5),o[1],0,0,0), C0,12); \
    KRD(GL,2); GAPB(o[0]=__builtin_amdgcn_mfma_f32_32x32x16_bf16(PAF(2),VFR(2),o[0],0,0,0), C1,0); \
    KRD(GL,3); GAPB(o[1]=__builtin_amdgcn_mfma_f32_32x32x16_bf16(PAF(2),VFR(6),o[1],0,0,0), C1,4); \
    GAPB(o[0]=__builtin_amdgcn_mfma_f32_32x32x16_bf16(PAF(3),VFR(3),o[0],0,0,0), C1,8); \
    GAPB(o[1]=__builtin_amdgcn_mfma_f32_32x32x16_bf16(PAF(3),VFR(7),o[1],0,0,0), C1,12); \
    }while(0)
  int t=1;
  #undef CMASK
  #define CMASK(P0,P1,t) do{}while(0)
  for(;t+5<NT;t+=2){
    STEP(pB0,pB1,pA0,pA1,t,true,true,true);     WAIT_BAR(2); RESC(); ROT();
    STEP(pA0,pA1,pB0,pB1,t+1,true,true,true);   WAIT_BAR(2); RESC(); ROT();
  }
  #undef CMASK
  #define CMASK(P0,P1,t) do{}while(0)
  #define ENDW(tt) do{ if((tt)+3<NT){WAIT_BAR(2);} else if((tt)+2<NT){WAIT_BAR(1);} else {WAIT_BAR(0);} }while(0)
  for(;t+1<NT;t+=2){
    STEP(pB0,pB1,pA0,pA1,t,(t+3<NT),(t+1<NT),(t+1<NT));       ENDW(t);   RESC(); ROT();
    STEP(pA0,pA1,pB0,pB1,t+1,(t+4<NT),(t+2<NT),(t+2<NT));     ENDW(t+1); RESC(); ROT();
  }
  STEP(pB0,pB1,pA0,pA1,NT-1,false,false,false); RESC();
  { float sacc=pB0[0]+pB0[1]; _Pragma("unroll") for(int r=2;r<16;++r)sacc+=pB0[r]; _Pragma("unroll") for(int r=0;r<16;++r)sacc+=pB1[r]; l_reg+=sacc;
    pw0=(u32x4){PKW(pB0,0),PKW(pB0,2),PKW(pB0,4),PKW(pB0,6)};pw1=(u32x4){PKW(pB0,8),PKW(pB0,10),PKW(pB0,12),PKW(pB0,14)};pw2=(u32x4){PKW(pB1,0),PKW(pB1,2),PKW(pB1,4),PKW(pB1,6)};pw3=(u32x4){PKW(pB1,8),PKW(pB1,10),PKW(pB1,12),PKW(pB1,14)};
    SBAR(); pv(o,vb0+sl_cur,PAF(0),PAF(1),PAF(2),PAF(3)); }
  #undef PKW
  #undef PAF
  #undef VFR
  #undef PIN
  #undef MX3
  #undef GAPA
  #undef GAPB
  #undef EX
  #undef VRD
  #undef KRD
  #undef STEP
  #undef ENDW
  {auto rr=__builtin_amdgcn_permlane32_swap(__float_as_uint(l_reg),__float_as_uint(l_reg),false,false);l_reg=__uint_as_float(rr[0])+__uint_as_float(rr[1]);}
  if(hi==0)wsf[32+r32]=l_reg;asm volatile("s_waitcnt lgkmcnt(0)":::"memory");
  float rli[16];
  #pragma unroll
  for(int r=0;r<16;++r)rli[r]=__builtin_amdgcn_rcpf(wsf[32+crow(r,hi)]);
  bf16*Ow=O+(rowbase+q0+wid*QBLK)*OP+h*D;
  { bf16*stg=(bf16*)(shm+LDS_OST)+wid*2048;
    #pragma unroll
    for(int r=0;r<16;++r){const int orow=crow(r,hi);
      #pragma unroll
      for(int d0=0;d0<2;++d0)stg[orow*64+d0*32+r32]=__float2bfloat16(o[d0][r]*rli[r]);}
    asm volatile("s_waitcnt lgkmcnt(0)":::"memory");
    #pragma unroll
    for(int i=0;i<4;++i){const int row=i*8+(lane>>3),ch=lane&7; const u32x4 v=*(const u32x4*)(stg+row*64+ch*8); ATTN_STORE16(Ow+(long)row*OP+ch*8,v);} }
  asm volatile("s_waitcnt lgkmcnt(0)\n\ts_barrier":::"memory");
  #undef DMA_K
  #undef DMA_V
  #undef CMASK
  #undef START
  #undef RESC
  #undef ROT
}
constexpr int ATTN_LDS_BYTES=LDS_BYTES;
struct AttnTensors { const bf16* Q; const bf16* K; const bf16* V; bf16* O; };
struct AttnUnit { int bh; int qb; };
struct StaticOrder {
  int vcu,G;
  __device__ __forceinline__ explicit StaticOrder(int grid,int v):vcu(v),G(grid){}
  __device__ __forceinline__ bool next(int i,AttnUnit&u)const{ const int per=(BATCH*NHEAD*NQB)/G; if(i>=per)return false; const int x=vcu*per+i; u.bh=(x>>6)*4+((x&63)>>4); u.qb=x&15; return true; }
  __device__ __forceinline__ void a_ready(const AttnUnit&)const{}
  __device__ __forceinline__ void done(const AttnUnit&)const{}
};
template<class Sched,int THRL=8> __device__ __forceinline__ void attn_phase(char*lds,const AttnTensors&T,const Sched&S,const float*qnw,const float*knw){
  AttnUnit u;
  float mq=__builtin_fabsf(qnw[threadIdx.x&63]),mk=__builtin_fabsf(knw[threadIdx.x&63]);
  _Pragma("unroll") for(int o_=1;o_<64;o_<<=1){ mq=__builtin_fmaxf(mq,__shfl_xor(mq,o_)); mk=__builtin_fmaxf(mk,__shfl_xor(mk,o_)); }
  const float sref=C2*64.0f*1.02f*mq*mk;
  const bool fix=__builtin_amdgcn_readfirstlane((int)(sref<=40.0f && sref==sref))!=0;
  if(fix){ for(int i=0;S.next(i,u);++i){ S.a_ready(u); attn_unit<THRL,true>(u.bh/NHEAD,u.bh%NHEAD,u.qb,T.Q,T.K,T.V,T.O,lds,sref); S.done(u); } }
  else   { for(int i=0;S.next(i,u);++i){ S.a_ready(u); attn_unit<THRL,false>(u.bh/NHEAD,u.bh%NHEAD,u.qb,T.Q,T.K,T.V,T.O,lds,0.f); S.done(u); } }
}
#undef SBAR
#undef WAIT_BAR
}
#ifndef PG8_SP2
#define PG8_SP2 true
#endif
#ifndef PG8_ALIGN
#define PG8_ALIGN true
#endif
#define GAS __attribute__((address_space(1)))
#define LAS __attribute__((address_space(3)))
typedef unsigned short bf16;
typedef unsigned v4u __attribute__((ext_vector_type(4)));
typedef unsigned v2u __attribute__((ext_vector_type(2)));
typedef float f32x4 __attribute__((ext_vector_type(4)));
typedef float f32x2 __attribute__((ext_vector_type(2)));
typedef short bf16x8 __attribute__((ext_vector_type(8)));
typedef GAS unsigned gu32;
typedef GAS unsigned long long gu64;
#define RLX_AGENT __ATOMIC_RELAXED, __HIP_MEMORY_SCOPE_AGENT
#define LDS_WAIT() asm volatile("s_waitcnt lgkmcnt(0)" ::: "memory")
#define VM_WAIT() asm volatile("s_waitcnt vmcnt(0)" ::: "memory")
__device__ __forceinline__ unsigned f2bf(float f) { unsigned u = __builtin_bit_cast(unsigned, f); return (u + 0x7fffu + ((u >> 16) & 1u)) >> 16; }
__device__ __forceinline__ unsigned pk2(float lo, float hi) { unsigned r; asm("v_cvt_pk_bf16_f32 %0, %1, %2" : "=v"(r) : "v"(lo), "v"(hi)); return r; }
__device__ __forceinline__ float bf2f(unsigned h) { return __builtin_bit_cast(float, h << 16); }

#define XB_TMO      128
#define XB_XCNT(j)  (256  + 64 * (j))
#define XB_XSUB(j)  (1280 + 64 * (j))
#define XB_XGEN(j)  (2304 + 64 * (j))
#define XB_TOP      3328
#define XB_TOPGEN   3392
#define XCD_BAR_WORDS 3456
#define XB_SPIN_CAP (1u << 18)

__device__ __forceinline__ unsigned xb_ld(unsigned* p)              { return __hip_atomic_load(p, __ATOMIC_RELAXED, __HIP_MEMORY_SCOPE_AGENT); }
__device__ __forceinline__ unsigned xb_add(unsigned* p, unsigned v) { return __hip_atomic_fetch_add(p, v, __ATOMIC_RELAXED, __HIP_MEMORY_SCOPE_AGENT); }
__device__ __forceinline__ unsigned xb_xcc_id() { return (unsigned)__builtin_amdgcn_s_getreg((3 << 11) | 20) & 0xFu; }
#define XB_SPIN(cond, bar) do { unsigned _sp = 0; while (cond) { __builtin_amdgcn_s_sleep(1); \
    if ((++_sp & 255u) == 0u) { if (xb_ld(&(bar)[XB_TMO])) break; if (_sp > XB_SPIN_CAP) { atomicAdd(&(bar)[XB_TMO], 1u); break; } } } } while (0)

struct XcdBarrier {
    unsigned* bar; unsigned x;
    volatile LAS unsigned* st;
};

__device__ __forceinline__ XcdBarrier xcd_barrier_post(unsigned* bar, volatile LAS unsigned* st) {
    XcdBarrier b; b.bar = bar; b.x = xb_xcc_id(); b.st = st;
    if (threadIdx.x == 0) (void)xb_add(&bar[XB_XCNT(b.x)], 1u);
    return b;
}
__device__ __forceinline__ void xcd_barrier_complete(unsigned* bar, unsigned x, unsigned& nloc, unsigned& nx) {
    const unsigned G = gridDim.x * gridDim.y * gridDim.z;
    unsigned sum, cnt, mine, sp = 0u;
    for (;;) {
        sum = 0u; cnt = 0u; mine = 0u;
#pragma unroll
        for (unsigned j = 0; j < 16; ++j) { const unsigned c = xb_ld(&bar[XB_XCNT(j)]); sum += c; cnt += (c > 0u) ? 1u : 0u; mine = (j == x) ? c : mine; }
        if (sum == G) break;
        __builtin_amdgcn_s_sleep(1);
        if ((++sp & 255u) == 0u) { if (xb_ld(&bar[XB_TMO])) break; if (sp > XB_SPIN_CAP) { atomicAdd(&bar[XB_TMO], 1u); break; } }
    }
    nloc = mine > 0u ? mine : 1u; nx = cnt > 0u ? cnt : 1u;
}

__device__ __forceinline__ void xcd_barrier(const XcdBarrier& b) {
    asm volatile("s_waitcnt vmcnt(0)" ::: "memory");
    __syncthreads();
    if (threadIdx.x == 0) {
        unsigned* bar = b.bar;
        __builtin_amdgcn_s_waitcnt(0);
        unsigned nloc = b.st[0], nx = b.st[1];
        if (nloc == 0u) { xcd_barrier_complete(bar, b.x, nloc, nx); b.st[0] = nloc; b.st[1] = nx; }
        const unsigned old = xb_add(&bar[XB_XSUB(b.x)], 1u);
        const unsigned gen = old / nloc;
        if (old + 1u == (gen + 1u) * nloc) {
            __builtin_amdgcn_fence(__ATOMIC_RELEASE, "agent");
            asm volatile("s_waitcnt vmcnt(0)" ::: "memory");
            const unsigned og = xb_add(&bar[XB_TOP], 1u);
            const unsigned tg = og / nx;
            if (og + 1u == (tg + 1u) * nx) xb_add(&bar[XB_TOPGEN], 1u);
            else XB_SPIN(xb_ld(&bar[XB_TOPGEN]) == tg, bar);
            __builtin_amdgcn_fence(__ATOMIC_ACQUIRE, "agent");
            xb_add(&bar[XB_XGEN(b.x)], 1u);
            asm volatile("s_waitcnt vmcnt(0)" ::: "memory");
        } else {
            XB_SPIN(xb_ld(&bar[XB_XGEN(b.x)]) == gen, bar);
            __builtin_amdgcn_fence(__ATOMIC_ACQUIRE, "agent");
            asm volatile("s_waitcnt vmcnt(0)" ::: "memory");
        }
    }
    __syncthreads();
}
struct Frame {
    LAS unsigned char* lds;
    volatile LAS unsigned* MISC;
    gu32* ctl;
    int tid, lane, wave;
    int vcu, G;
};
__device__ __forceinline__ float wave_sum(float v) { return wave_sum64(v); }
__device__ __forceinline__ void p0_transpose_item(const float* W, int ldw, int k0, int n0, bf16* WT, int ldt, int dst_row0, LAS float* scr, int lane) {
#pragma unroll 8
    for (int i = 0; i < 32; ++i) { const int kk = 2 * i + (lane >> 5); scr[kk * 33 + (lane & 31)] = __builtin_nontemporal_load(W + (size_t)(k0 + kk) * ldw + n0 + (lane & 31)); }
    LDS_WAIT(); asm volatile("" ::: "memory");
    const int c = lane & 7;
#pragma unroll
    for (int j = 0; j < 4; ++j) { const int n = (lane >> 3) + 8 * j; const LAS float* s = scr + (8 * c) * 33 + n;
        v4u o; o.x = pk2(s[0 * 33], s[1 * 33]); o.y = pk2(s[2 * 33], s[3 * 33]); o.z = pk2(s[4 * 33], s[5 * 33]); o.w = pk2(s[6 * 33], s[7 * 33]);
        *(GAS v4u*)(WT + (size_t)(dst_row0 + n) * ldt + k0 + 8 * c) = o; }
    LDS_WAIT(); asm volatile("" ::: "memory");
}
__device__ __forceinline__ void p0_prologue(Frame& F, ArgsP ap) {
    unsigned char* ws = ap->ws;
    if (F.vcu < 192) {
        LAS float* sc = (LAS float*)(F.lds + RING_OFF); LAS float* part = sc + 9 * 1024;
        const float* c = ap->in[I_C]; const float* cctx = ap->in[I_CCTX];
        for (int i = F.tid; i < 9 * 1024; i += NWAVES * 64) { const int bb = i >> 10, k = i & 1023; const float v = bb < 8 ? c[bb * 1024 + k] : cctx[k]; sc[i] = v / (1.0f + expf(-v)); }
        __syncthreads();
        const int l = F.vcu / 96, cb = F.vcu % 96, k0 = F.wave * 128;
        const float* w = ap->in[I_WADA] + (size_t)l * DM * MODW + (size_t)k0 * MODW + cb * 64 + F.lane;
        float acc[9];
#pragma unroll
        for (int j = 0; j < 9; ++j) acc[j] = 0.f;
        for (int k = 0; k < 128; k += 8) {
            float wv[8];
#pragma unroll
            for (int q = 0; q < 8; ++q) wv[q] = __builtin_nontemporal_load(w + (size_t)(k + q) * MODW);
#pragma unroll
            for (int j = 0; j < 9; ++j) { const f32x4 s0 = *(const LAS f32x4*)(sc + j * 1024 + k0 + k), s1 = *(const LAS f32x4*)(sc + j * 1024 + k0 + k + 4);
                acc[j] += (s0[0] * wv[0] + s0[1] * wv[1]) + (s0[2] * wv[2] + s0[3] * wv[3]) + (s1[0] * wv[4] + s1[1] * wv[5]) + (s1[2] * wv[6] + s1[3] * wv[7]); }
        }
#pragma unroll
        for (int j = 0; j < 9; ++j) part[(F.wave * 9 + j) * 64 + F.lane] = acc[j];
        __syncthreads();
        float* mods = (float*)(ws + WS_MODS);
        for (int idx = F.tid; idx < 9 * 64; idx += NWAVES * 64) { const int j = idx >> 6, col = idx & 63; float s = 0.f;
#pragma unroll
            for (int wv_ = 0; wv_ < 8; ++wv_) s += part[(wv_ * 9 + j) * 64 + col];
            mods[(size_t)(l * 9 + j) * MODW + cb * 64 + col] = s + ap->in[I_BADA][l * MODW + cb * 64 + col]; }
        __syncthreads();
    } else if (F.vcu == F.G - 1) {
        float* rc = (float*)(ws + WS_ROPE); float* rs = rc + 1024;
        for (int e = F.tid; e < 1024; e += NWAVES * 64) { const int pos = e >> 4, i = e & 15; const float fr = powf(10000.0f, -(float)(2 * i) / 32.0f); const float a = (float)pos * fr; rc[e] = cosf(a); rs[e] = sinf(a); }
    }
    LAS float* scr = (LAS float*)(F.lds + RING_OFF + F.wave * 16384);
    const int gw = F.vcu * NWAVES + F.wave, NGW = F.G * NWAVES;
    constexpr int I_IN = 16 * 56, I_OUT = 16 * 32, I_13 = 16 * 88, I_2 = 44 * 32, I_P = 4 * 8;
    constexpr int NITEMS = I_IN + I_OUT + 4 * I_13 + 2 * I_2 + 4 * I_P;
    for (int it = gw; it < NITEMS; it += NGW) {
        int r = it;
        if (r < I_IN) { const int kb = r / 56, nb = r % 56, f = 32 * nb, slot = f >> 6, bj = (f >> 5) & 1, pn = slot >> 2, wc = slot & 3;
            p0_transpose_item(ap->in[I_WIN], INW, 64 * kb, f, (bf16*)(ws + WS_WIN), DM, 256 * pn + 128 * bj + 32 * wc, scr, F.lane); continue; } r -= I_IN;
        if (r < I_OUT) { const int kb = r / 32, nb = r % 32; p0_transpose_item(ap->in[I_WOUT], DM, 64 * kb, 32 * nb, (bf16*)(ws + WS_WOUT), DM, 32 * nb, scr, F.lane); continue; } r -= I_OUT;
        if (r < 4 * I_13) { const int mi = r / I_13, rr = r % I_13, l = mi >> 1, which = mi & 1, kb = rr / 88, nb = rr % 88, n0 = 32 * nb;
            const float* W = ap->in[which ? I_W3 : I_W1] + (size_t)l * DM * FF;
            p0_transpose_item(W, FF, 64 * kb, n0, (bf16*)(ws + WS_W13) + (size_t)l * 5632 * DM, DM, 256 * (n0 >> 7) + 128 * which + (n0 & 127), scr, F.lane); continue; } r -= 4 * I_13;
        if (r < 2 * I_2) { const int l = r / I_2, rr = r % I_2, kb = rr / 32, nb = rr % 32;
            p0_transpose_item(ap->in[I_W2] + (size_t)l * FF * DM, DM, 64 * kb, 32 * nb, (bf16*)(ws + WS_W2) + (size_t)l * DM * FF, FF, 32 * nb, scr, F.lane); continue; } r -= 2 * I_2;
        { const int g = r / I_P, rr = r % I_P, kb = rr / 8, nb = rr % 8;
            p0_transpose_item(ap->in[I_WPOOL] + (size_t)g * 256 * 256, 256, 64 * kb, 32 * nb, (bf16*)(ws + WS_WPOOL), 256, g * 256 + 32 * nb, scr, F.lane); }
    }
    { const float* wsp = ap->in[I_WSP]; bf16* dst = (bf16*)(ws + WS_WSB);
        for (int e = (F.vcu * NWAVES * 64 + F.tid) * 4; e < 8 * 128 * 128; e += F.G * NWAVES * 64 * 4) { const f32x4 v = *(const f32x4*)(wsp + e); v2u o; o.x = pk2(v[0], v[1]); o.y = pk2(v[2], v[3]); *(v2u*)(dst + e) = o; } }
}
__device__ __forceinline__ void p1_bias13(Frame& F, ArgsP ap) {
    if (F.vcu >= 176) return;
    const int l = F.vcu / 88, rem = F.vcu % 88, which = rem / 44, cb = rem % 44, k0 = F.wave * 128;
    LAS float* shs = (LAS float*)(F.lds + RING_OFF); LAS float* part = shs + 8 * 1024;
    const float* mods = (const float*)(ap->ws + WS_MODS);
    for (int i = F.tid; i < 8 * 1024; i += NWAVES * 64) { const int b = i >> 10, k = i & 1023; shs[i] = mods[(size_t)(l * 9 + b) * MODW + SH2 + k]; }
    __syncthreads();
    const float* w = ap->in[which ? I_W3 : I_W1] + (size_t)l * DM * FF + (size_t)k0 * FF + cb * 64 + F.lane;
    float acc[8];
#pragma unroll
    for (int j = 0; j < 8; ++j) acc[j] = 0.f;
    for (int k = 0; k < 128; k += 8) {
        float wv[8];
#pragma unroll
        for (int q = 0; q < 8; ++q) wv[q] = __builtin_nontemporal_load(w + (size_t)(k + q) * FF);
#pragma unroll
        for (int j = 0; j < 8; ++j) { const f32x4 s0 = *(const LAS f32x4*)(shs + j * 1024 + k0 + k), s1 = *(const LAS f32x4*)(shs + j * 1024 + k0 + k + 4);
            acc[j] += (s0[0] * wv[0] + s0[1] * wv[1]) + (s0[2] * wv[2] + s0[3] * wv[3]) + (s1[0] * wv[4] + s1[1] * wv[5]) + (s1[2] * wv[6] + s1[3] * wv[7]); }
    }
#pragma unroll
    for (int j = 0; j < 8; ++j) part[(F.wave * 8 + j) * 64 + F.lane] = acc[j];
    __syncthreads();
    float* bias = (float*)(ap->ws + WS_BIAS);
    for (int idx = F.tid; idx < 8 * 64; idx += NWAVES * 64) { const int j = idx >> 6, col = idx & 63, n = cb * 64 + col; float sum = 0.f;
#pragma unroll
        for (int wv_ = 0; wv_ < 8; ++wv_) sum += part[(wv_ * 8 + j) * 64 + col];
        bias[(size_t)(l * 8 + j) * 5632 + 256 * (n >> 7) + 128 * which + (n & 127)] = sum; }
    __syncthreads();
}
__device__ __forceinline__ void p1_poolw(Frame& F, ArgsP ap) {
    unsigned char* ws = ap->ws; const bf16* src = (const bf16*)(ws + WS_WPOOL); bf16* dst = (bf16*)(ws + WS_WPB);
    const float* gm = ap->in[I_GMIX] + DM; const float* mod1 = (const float*)(ws + WS_MODS) + (size_t)9 * MODW;
    for (int e = (F.vcu * NWAVES * 64 + F.tid) * 8; e < 8 * 1024 * 256; e += F.G * NWAVES * 64 * 8) {
        const int b = e >> 18, n = (e >> 8) & 1023, k = e & 255, gk = (n & ~255) + k;
        const v4u w = *(const v4u*)(src + (size_t)n * 256 + k); const f32x4 g0 = *(const f32x4*)(gm + gk), g1 = *(const f32x4*)(gm + gk + 4);
        const f32x4 s0 = *(const f32x4*)(mod1 + (size_t)b * MODW + SC1 + gk), s1 = *(const f32x4*)(mod1 + (size_t)b * MODW + SC1 + gk + 4);
        const f32x4 m0 = g0 * (s0 + 1.0f), m1 = g1 * (s1 + 1.0f);
        v4u o; o.x = pk2(bf2f(w.x & 0xffffu) * m0[0], bf2f(w.x >> 16) * m0[1]); o.y = pk2(bf2f(w.y & 0xffffu) * m0[2], bf2f(w.y >> 16) * m0[3]);
        o.z = pk2(bf2f(w.z & 0xffffu) * m1[0], bf2f(w.z >> 16) * m1[1]); o.w = pk2(bf2f(w.w & 0xffffu) * m1[2], bf2f(w.w >> 16) * m1[3]);
        *(v4u*)(dst + e) = o; }
}
__device__ __forceinline__ void norm_pass(Frame& F, const float* src_lat, const float* src_ctx, bf16* dst, const float* gvec, const float* modl, int sh_off, int sc_off) {
    const int total = src_ctx ? MALL : MTOK, gw = F.vcu * NWAVES + F.wave, NGW = F.G * NWAVES, rpw = (total + NGW - 1) / NGW;
    const int r0 = gw * rpw, r1 = (r0 + rpw < total) ? r0 + rpw : total;
    int cur = -1; f32x4 gm[4], sh[4];
    for (int row = r0; row < r1; ++row) {
        const int bb = row < MTOK ? (row >> 12) : 8;
        if (bb != cur) { cur = bb;
#pragma unroll
            for (int j = 0; j < 4; ++j) { const int c = 4 * F.lane + 256 * j; const f32x4 g = *(const f32x4*)(gvec + c), s = *(const f32x4*)(modl + (size_t)bb * MODW + sc_off + c);
                gm[j] = g * (s + 1.0f); sh[j] = *(const f32x4*)(modl + (size_t)bb * MODW + sh_off + c); } }
        const float* xr = row < MTOK ? src_lat + (size_t)row * DM : src_ctx + (size_t)(row - MTOK) * DM;
        f32x4 v[4]; float ss = 0.f;
#pragma unroll
        for (int j = 0; j < 4; ++j) { v[j] = __builtin_nontemporal_load((const f32x4*)(xr + 4 * F.lane + 256 * j)); ss += (v[j][0] * v[j][0] + v[j][1] * v[j][1]) + (v[j][2] * v[j][2] + v[j][3] * v[j][3]); }
        const float r = __builtin_amdgcn_rsqf(wave_sum(ss) * (1.0f / DM) + 1e-6f);
        bf16* orow = dst + (size_t)row * DM;
#pragma unroll
        for (int j = 0; j < 4; ++j) { const f32x4 o = v[j] * r * gm[j] + sh[j]; v2u w; w.x = pk2(o[0], o[1]); w.y = pk2(o[2], o[3]); *(v2u*)(orow + 4 * F.lane + 256 * j) = w; }
    }
}
__device__ __forceinline__ void final_norm(Frame& F, float* out, const float* gvec) {
    const int gw = F.vcu * NWAVES + F.wave, NGW = F.G * NWAVES, rpw = (MTOK + NGW - 1) / NGW;
    const int r0 = gw * rpw, r1 = (r0 + rpw < MTOK) ? r0 + rpw : MTOK;
    f32x4 g[4];
#pragma unroll
    for (int j = 0; j < 4; ++j) g[j] = *(const f32x4*)(gvec + 4 * F.lane + 256 * j);
    for (int row = r0; row < r1; ++row) {
        float* xr = out + (size_t)row * DM; f32x4 v[4]; float ss = 0.f;
#pragma unroll
        for (int j = 0; j < 4; ++j) { v[j] = *(const f32x4*)(xr + 4 * F.lane + 256 * j); ss += (v[j][0] * v[j][0] + v[j][1] * v[j][1]) + (v[j][2] * v[j][2] + v[j][3] * v[j][3]); }
        const float r = 1.0f / sqrtf(wave_sum(ss) * (1.0f / DM) + 1e-6f);
#pragma unroll
        for (int j = 0; j < 4; ++j) *(f32x4*)(xr + 4 * F.lane + 256 * j) = v[j] * r * g[j];
    }
}
template <int W> __device__ __forceinline__ void poolres_cols(const bf16* zb, bf16* outb, bf16* xnb, float* partb, int t0, int c, f32x2 gate, f32x2 gmn, int wave, int lane) {
    constexpr int L = W / 2, R = W / 2 - 1, NV = W - 1 + 16;
    f32x2 v[NV];
#define Z_LD(dst_, t_) do { const int tt_ = (t_); if (tt_ < 0 || tt_ >= SEQ) dst_ = (f32x2){0.f, 0.f}; else { const unsigned u_ = __builtin_nontemporal_load((const unsigned*)(zb + (size_t)tt_ * DM + c)); dst_ = (f32x2){bf2f(u_ & 0xffffu), bf2f(u_ >> 16)}; } } while (0)
#pragma unroll
    for (int i = 0; i < W - 1; ++i) Z_LD(v[i], t0 - L + i);
    for (int blk = 0; blk < 8; ++blk) {
        const int tb = t0 + 16 * blk;
        unsigned xr[16];
#pragma unroll
        for (int i = 0; i < 16; ++i) xr[i] = *(const unsigned*)(outb + (size_t)(tb + i) * DM + c);
#pragma unroll
        for (int i = 0; i < 16; ++i) Z_LD(v[W - 1 + i], tb + R + i);
        f32x2 s = v[0];
#pragma unroll
        for (int i = 1; i < W; ++i) s += v[i];
#pragma unroll
        for (int j = 0; j < 16; ++j) { const int t = tb + j; const int lo = t - L < 0 ? 0 : t - L, hi = t + R > SEQ - 1 ? SEQ - 1 : t + R; const float icnt = __builtin_amdgcn_rcpf((float)(hi - lo + 1));
            const f32x2 o = s * icnt - v[j + L]; const f32x2 x3 = (f32x2){bf2f(xr[j] & 0xffffu), bf2f(xr[j] >> 16)} + gate * o;
            *(unsigned*)(outb + (size_t)t * DM + c) = pk2(x3[0], x3[1]); const f32x2 y = x3 * gmn; *(unsigned*)(xnb + (size_t)t * DM + c) = pk2(y[0], y[1]);
            const float ss = wave_sum(x3[0] * x3[0] + x3[1] * x3[1]);
            if (lane < 2) partb[((size_t)((wave >> 2) + 2 * lane) * MTOK + t) * 4 + (wave & 3)] = lane ? 0.f : ss;
            if (j < 15) s += v[j + W] - v[j]; }
#pragma unroll
        for (int i = 0; i < W - 1; ++i) v[i] = v[i + 16];
    }
#undef Z_LD
}
__device__ __forceinline__ void poolres_pass(Frame& F, const bf16* Z, bf16* out, bf16* xn, float* part, const float* gate, const float* pscale, const float* gnext, const float* scnext) {
    for (int strip = F.vcu; strip < MTOK / 128; strip += F.G) {
        const int b = strip >> 5, t0 = (strip & 31) * 128; const size_t ro = (size_t)b * SEQ;
        const int c = 2 * F.tid;
        const f32x2 gt = *(const f32x2*)(gate + (size_t)b * MODW + c) * *(const f32x2*)(pscale + c);
        const f32x2 gmn = *(const f32x2*)(gnext + c) * (*(const f32x2*)(scnext + (size_t)b * MODW + c) + 1.0f);
        const bf16* zb = Z + ro * DM; bf16* outb = out + ro * DM; bf16* xnb = xn + ro * DM; float* partb = part + ro * 4;
        const int grp = F.wave >> 1;
        if (grp == 0) poolres_cols<2>(zb, outb, xnb, partb, t0, c, gt, gmn, F.wave, F.lane); else if (grp == 1) poolres_cols<4>(zb, outb, xnb, partb, t0, c, gt, gmn, F.wave, F.lane);
        else if (grp == 2) poolres_cols<8>(zb, outb, xnb, partb, t0, c, gt, gmn, F.wave, F.lane); else poolres_cols<16>(zb, outb, xnb, partb, t0, c, gt, gmn, F.wave, F.lane);
    }
}
__device__ __forceinline__ void gmlp_unit(Frame& F, int unit, const bf16* VG, const bf16* U, const bf16* WSB, const float* bs, bf16* AM) {
    using attn_body::f32x16;
    const int g = F.wave, lane = F.lane, r32 = lane & 31, hi = lane >> 5;
    const size_t R0 = (size_t)unit * 128;
    LAS unsigned char* slot = F.lds + RING_OFF + g * 16384;
    const unsigned slot_addr = (unsigned)(uintptr_t)slot;
    const int vb = (int)slot_addr + ((lane >> 4) & 1) * 32 + (lane & 3) * 8 + (4 * hi + ((lane & 15) >> 2)) * 64;
#pragma unroll
    for (int kt = 0; kt < 2; ++kt)
#pragma unroll
        for (int p = 0; p < 8; ++p)
            attn_body::glds16_nt(VG + (R0 + 64 * kt + 16 * (p & 3) + (lane >> 2)) * 512 + g * 64 + (p >> 2) * 32 + (lane & 3) * 8, (unsigned)__builtin_amdgcn_readfirstlane(slot_addr + kt * 8192 + p * 1024));
    f32x16 o[4][2];
#pragma unroll
    for (int rb = 0; rb < 4; ++rb) { o[rb][0] = f32x16{}; o[rb][1] = f32x16{}; }
#define GM_LDPA(dst, kt_, rb_) do { int z_ = 0; asm volatile("" : "+v"(z_)); const char* wp = wb + z_ + (rb_) * 8192 + (kt_) * 128;     \
            _Pragma("unroll") for (int s = 0; s < 4; ++s) { const v2u a = *(const v2u*)(wp + s * 32), b = *(const v2u*)(wp + s * 32 + 16); dst[s] = __builtin_bit_cast(bf16x8, (v4u){a.x, a.y, b.x, b.y}); } } while (0)
    const char* wb = (const char*)(WSB + ((size_t)(g * 128 + r32) * 128 + 4 * hi));
    {
        bf16x8 pA[4], pB[4];
#define GM_PV(P, kt_, rb_) attn_body::pv(o[rb_], vb + (kt_) * 8192, P[0], P[1], P[2], P[3])
        GM_LDPA(pA, 0, 0);
        VM_WAIT();
        GM_LDPA(pB, 0, 1); GM_PV(pA, 0, 0);
        GM_LDPA(pA, 0, 2); GM_PV(pB, 0, 1);
        GM_LDPA(pB, 0, 3); GM_PV(pA, 0, 2);
        GM_LDPA(pA, 1, 0); GM_PV(pB, 0, 3);
        GM_LDPA(pB, 1, 1); GM_PV(pA, 1, 0);
        GM_LDPA(pA, 1, 2); GM_PV(pB, 1, 1);
        GM_LDPA(pB, 1, 3); GM_PV(pA, 1, 2);
        GM_PV(pB, 1, 3);
#undef GM_PV
    }
#undef GM_LDPA
    LDS_WAIT();
    LAS float* stg = (LAS float*)slot;
    v4u uA[4], uB[4]; float bA[4], bB[4];
#define GM_LDU(UU, BB, rb_) do { int zz_ = 0; asm volatile("" : "+v"(zz_)); const char* ub_ = (const char*)(U + (R0 + 32 * (rb_) + (lane >> 3)) * 512 + g * 64 + (lane & 7) * 8) + zz_; \
        const float* bb_ = bs + g * 128 + 32 * (rb_) + (lane >> 3) + zz_; _Pragma("unroll") for (int i = 0; i < 4; ++i) { UU[i] = __builtin_nontemporal_load((const v4u*)(ub_ + i * 8192)); BB[i] = bb_[8 * i]; } } while (0)
#define GM_EPI(UU, BB, rb_) do { \
        _Pragma("unroll") for (int r = 0; r < 16; ++r) { const int orow = attn_body::crow(r, hi); stg[orow * 64 + r32] = o[rb_][0][r]; stg[orow * 64 + 32 + r32] = o[rb_][1][r]; } \
        LDS_WAIT(); \
        _Pragma("unroll") for (int i = 0; i < 4; ++i) { const int row = i * 8 + (lane >> 3), ch = lane & 7; \
            const f32x4 a = *(const LAS f32x4*)(stg + row * 64 + ch * 8) + BB[i], b = *(const LAS f32x4*)(stg + row * 64 + ch * 8 + 4) + BB[i]; \
            v4u w; w.x = pk2(a[0] * bf2f(UU[i].x & 0xffffu), a[1] * bf2f(UU[i].x >> 16)); w.y = pk2(a[2] * bf2f(UU[i].y & 0xffffu), a[3] * bf2f(UU[i].y >> 16)); \
            w.z = pk2(b[0] * bf2f(UU[i].z & 0xffffu), b[1] * bf2f(UU[i].z >> 16)); w.w = pk2(b[2] * bf2f(UU[i].w & 0xffffu), b[3] * bf2f(UU[i].w >> 16)); \
            *(v4u*)(AM + (R0 + 32 * (rb_) + row) * 1024 + 512 + g * 64 + ch * 8) = w; } \
        LDS_WAIT(); } while (0)
    GM_LDU(uA, bA, 0);
    GM_LDU(uB, bB, 1); GM_EPI(uA, bA, 0);
    GM_LDU(uA, bA, 2); GM_EPI(uB, bB, 1);
    GM_LDU(uB, bB, 3); GM_EPI(uA, bA, 2);
    GM_EPI(uB, bB, 3);
#undef GM_LDU
#undef GM_EPI
}

template <class Sched> __device__ __forceinline__ int build_rtab(Frame& F, const Sched& S, const float* part, LAS float* rtab) {
    pg8::Unit u; int pm0 = -1, pm1 = -1;
    for (int i = 0; S.next(i, u); ++i) { if (pm0 < 0) pm0 = u.pm; else if (u.pm != pm0) pm1 = u.pm; }
    if (pm1 < 0) pm1 = pm0;
    { const int slot = F.tid >> 8, r = F.tid & 255, row = (slot ? pm1 : pm0) * 256 + r; float tot = 0.f;
#pragma unroll
        for (int pn = 0; pn < 4; ++pn) { const f32x4 p = *(const f32x4*)(part + ((size_t)pn * MTOK + row) * 4); tot += (p[0] + p[1]) + (p[2] + p[3]); }
        rtab[F.tid] = __builtin_amdgcn_rsqf(tot * (1.0f / DM) + 1e-6f); }
    __syncthreads();
    return pm0;
}
__global__ void __launch_bounds__(NWAVES * 64, 2) mega_fwd(Args args) {
    extern __shared__ __attribute__((aligned(16))) unsigned char lds[];
    Frame F;
    F.lds = (LAS unsigned char*)lds;
    F.MISC = (volatile LAS unsigned*)(F.lds + MISC_OFF);
    F.tid = threadIdx.x; F.lane = F.tid & 63; F.wave = __builtin_amdgcn_readfirstlane(F.tid >> 6);
    F.G = gridDim.x; { const int bx = blockIdx.x; F.vcu = (F.G % 8 == 0) ? (bx % 8) * (F.G / 8) + bx / 8 : bx; }
    ArgsP akp = (ArgsP)__builtin_amdgcn_kernarg_segment_ptr();
    F.ctl = (gu32*)(akp->ws + WS_CTL);
    for (int u = F.tid; u < (LDS_BYTES - LDSCTL_OFF) / 4; u += NWAVES * 64) ((LAS unsigned*)(F.lds + LDSCTL_OFF))[u] = 0u;
    __syncthreads();
    const int lo = akp->ph_lo, hi = akp->ph_hi;
    const bool one_launch = (hi - lo) > 1;
    XcdBarrier bar; bar.bar = (unsigned*)(F.ctl + CW_BAR); bar.x = 0; bar.st = nullptr;
    if (one_launch) bar = xcd_barrier_post((unsigned*)(F.ctl + CW_BAR), F.MISC + 8);
#ifndef PHASE_MASK
#define PHASE_MASK 0x7ff
#endif
#define IN(k) (((PHASE_MASK >> (k)) & 1) && lo <= (k) && (k) < hi)
#define SEAM(k) do { if (IN(k) && IN((k) + 1)) xcd_barrier(bar); } while (0)
#ifndef REPEAT_MASK
#define REPEAT_MASK 0
#endif
#define REP(k) for (int rep_ = 0; rep_ < (((REPEAT_MASK >> (k)) & 1) ? 2 : 1); ++rep_, (((REPEAT_MASK >> (k)) & 1) && rep_ == 1 && one_launch ? (xcd_barrier(bar), 0) : 0))
#define REPRES(k, dummy) ((((REPEAT_MASK >> (k)) & 1) && rep_ == 0) ? (void*)(ws + (dummy)) : (void*)(ws + WS_RES))
#define REPOUT(k, dummy) ((((REPEAT_MASK >> (k)) & 1) && rep_ == 0) ? (float*)(ws + (dummy)) : out)
#define PHASE_VARS() ArgsP A = akp; asm volatile("" : "+s"(A)); unsigned char* ws = A->ws; float* out = A->out; float* mods = (float*)(ws + WS_MODS); const float* mod1 = mods + (size_t)9 * MODW; bf16* XN = (bf16*)(ws + WS_XN); bf16* AM = (bf16*)(ws + WS_AM); bf16* HB = (bf16*)(ws + WS_H); \
    float* rs1 = (float*)(ws + WS_PART); float* rs2 = rs1 + 16 * MTOK; float* rs3 = rs2 + 16 * MTOK; float* rs4 = rs3 + 16 * MTOK; const float* bias13 = (const float*)(ws + WS_BIAS); \
    (void)out; (void)mods; (void)mod1; (void)XN; (void)AM; (void)HB; (void)rs1; (void)rs2; (void)rs3; (void)rs4; (void)bias13
#ifndef STAGGER_US
#define STAGGER_US 0
#endif
#define STAGGER() do { const unsigned g_ = (blockIdx.x >> 3) & 3u; if (STAGGER_US > 0 && g_) { const unsigned long long t0_ = __builtin_amdgcn_s_memrealtime(); while (__builtin_amdgcn_s_memrealtime() - t0_ < (unsigned long long)(g_ * STAGGER_US * 100)) __builtin_amdgcn_s_sleep(8); } } while (0)
#define RELAUNDER() do { int t_ = threadIdx.x; asm volatile("" : "+v"(t_)); F.tid = t_; F.lane = t_ & 63; } while (0)
    if (IN(0)) REP(0) { PHASE_VARS(); RELAUNDER(); p0_prologue(F, A); } SEAM(0);
    if (IN(1)) REP(1) { PHASE_VARS(); RELAUNDER(); p1_bias13(F, A); p1_poolw(F, A); norm_pass(F, A->in[I_X], A->in[I_CTX], XN, A->in[I_GMIX], mods, SH1, SC1); } SEAM(1);
    if (IN(2)) REP(2) { PHASE_VARS();
        pg8::Gemm g{XN, (const bf16*)(ws + WS_WIN), DM, DM, 0, 0}; pg8::StaticOrder S; S.init(MTOK, INW, F.G, (int)blockIdx.x, MCTX / 256, 2);
        pg8::EpiInProj E{A};
        pg8::gemm_phase<pg8::EpiInProj, pg8::StaticOrder, PG8_ALIGN, PG8_SP2>(F.lds + RING_OFF, g, S, E);
    } SEAM(2);
    if (IN(3)) REP(3) { PHASE_VARS();
        const attn_body::AttnTensors AT{(const attn_body::bf16*)(ws + WS_Q), (const attn_body::bf16*)(ws + WS_KB), (const attn_body::bf16*)(ws + WS_VB), (attn_body::bf16*)AM};
        const attn_body::StaticOrder S((int)F.G, F.vcu);
        const bool gfirst = (F.vcu & 1) != 0;
        for (int g2_ = 0; g2_ < 2; ++g2_) {
            if ((g2_ == 0) == gfirst) {
                RELAUNDER();
                for (int rp_ = 0; rp_ < (((REPEAT_MASK >> 11) & 1) ? 2 : 1); ++rp_) {
                    for (int u = F.vcu; u < MTOK / 128; u += F.G) gmlp_unit(F, u, (const bf16*)(ws + WS_VG), (const bf16*)(ws + WS_U), (const bf16*)(ws + WS_WSB), A->in[I_BSP], AM);
                    __syncthreads(); }
            } else attn_body::attn_phase<attn_body::StaticOrder>((char*)lds + RING_OFF, AT, S, A->in[I_QN], A->in[I_KN]);
        }
    } SEAM(3);
    if (IN(4)) REP(4) { PHASE_VARS(); STAGGER();
        pg8::Gemm g{AM, (const bf16*)(ws + WS_WOUT), DM, DM, 0, 0}; pg8::StaticOrder S; S.init(MTOK, DM, F.G, (int)blockIdx.x);
        pg8::EpiResid<4> E{A, (void*)(ws + WS_RES)};
        pg8::gemm_phase<pg8::EpiResid<4>, pg8::StaticOrder, PG8_ALIGN, PG8_SP2>(F.lds + RING_OFF, g, S, E);
    } SEAM(4);
    if (IN(5)) REP(5) { PHASE_VARS();
        pg8::Gemm g{XN, (const bf16*)(ws + WS_W13), DM, DM, 0, 0}; pg8::StaticOrder S; S.init(MTOK, 2 * FF, F.G, (int)blockIdx.x);
#if defined(PROBE_NULL5)
        if (rep_ == 0) { pg8::EpiNull EN{(bf16*)(ws + WS_VG)}; pg8::StaticOrder S2; S2.init(MTOK, DM, F.G, (int)blockIdx.x);   (void)S2;
            pg8::EpiNullWide ENW{(bf16*)(ws + WS_H)}; pg8::gemm_phase<pg8::EpiNullWide, pg8::StaticOrder, PG8_ALIGN, PG8_SP2>(F.lds + RING_OFF, g, S, ENW); (void)EN; } else
#endif
        { RELAUNDER(); LAS float* rtab = (LAS float*)(F.lds + RTAB_OFF); const int pm0 = build_rtab(F, S, rs1, rtab); pg8::EpiSwiglu<0> E{A, rtab, pm0};
        pg8::gemm_phase<pg8::EpiSwiglu<0>, pg8::StaticOrder, PG8_ALIGN, PG8_SP2>(F.lds + RING_OFF, g, S, E); }
    } SEAM(5);
    if (IN(6)) REP(6) { PHASE_VARS(); STAGGER();
        pg8::Gemm g{HB, (const bf16*)(ws + WS_W2), FF, FF, 0, 0}; pg8::StaticOrder S; S.init(MTOK, DM, F.G, (int)blockIdx.x);
#if defined(PROBE_NULL6)
        if (rep_ == 0) { pg8::EpiNull EN{(bf16*)(ws + WS_VG)}; pg8::gemm_phase<pg8::EpiNull, pg8::StaticOrder, PG8_ALIGN, PG8_SP2>(F.lds + RING_OFF, g, S, EN); } else
#elif defined(PROBE_NOXN6)
        if (rep_ == 0) { pg8::EpiResid<7> E7{A, REPRES(6, WS_VG)}; pg8::gemm_phase<pg8::EpiResid<7>, pg8::StaticOrder, PG8_ALIGN, PG8_SP2>(F.lds + RING_OFF, g, S, E7); } else
#endif
        { pg8::EpiResid<6> E{A, REPRES(6, WS_VG)};
        pg8::gemm_phase<pg8::EpiResid<6>, pg8::StaticOrder, PG8_ALIGN, PG8_SP2>(F.lds + RING_OFF, g, S, E); }
    } SEAM(6);
    if (IN(7)) REP(7) { PHASE_VARS();
        pg8::Gemm g{(const bf16*)(ws + WS_RES), (const bf16*)(ws + WS_WPB), 256, DM, 512, 1024 * 256 * 2}; pg8::StaticOrder S; S.init(MTOK, DM, F.G, (int)blockIdx.x);
        pg8::EpiZ E{A};
        pg8::gemm_phase<pg8::EpiZ, pg8::StaticOrder, PG8_ALIGN, PG8_SP2>(F.lds + RING_OFF, g, S, E);
    } SEAM(7);
    if (IN(8)) { PHASE_VARS(); RELAUNDER(); poolres_pass(F, AM, (bf16*)(ws + WS_RES), XN, rs3, mod1 + GA1, A->in[I_PSC], A->in[I_GFFN] + DM, mod1 + SC2); } SEAM(8);
    if (IN(9)) REP(9) { PHASE_VARS();
        pg8::Gemm g{XN, (const bf16*)(ws + WS_W13) + (size_t)5632 * DM, DM, DM, 0, 0}; pg8::StaticOrder S; S.init(MTOK, 2 * FF, F.G, (int)blockIdx.x);
        RELAUNDER(); LAS float* rtab = (LAS float*)(F.lds + RTAB_OFF); const int pm0 = build_rtab(F, S, rs3, rtab); pg8::EpiSwiglu<1> E{A, rtab, pm0};
        pg8::gemm_phase<pg8::EpiSwiglu<1>, pg8::StaticOrder, PG8_ALIGN, PG8_SP2>(F.lds + RING_OFF, g, S, E);
    } SEAM(9);
    if (IN(10)) REP(10) { PHASE_VARS(); STAGGER();
        pg8::Gemm g{HB, (const bf16*)(ws + WS_W2) + (size_t)DM * FF, FF, FF, 0, 0}; pg8::StaticOrder S; S.init(MTOK, DM, F.G, (int)blockIdx.x);
        pg8::EpiResid<10> E{A, out};
        pg8::gemm_phase<pg8::EpiResid<10>, pg8::StaticOrder, PG8_ALIGN, PG8_SP2>(F.lds + RING_OFF, g, S, E);
    }
#undef IN
#undef SEAM
}

extern "C" void kernel_launch(void* const* d_in, const int* in_sizes, int n_in, void* d_out, int out_size, void* d_ws, size_t ws_size, hipStream_t stream) {
    static int grid = 0;
    if (grid == 0) {
        if (n_in != 21 || out_size != MTOK * DM || ws_size < WS_END) { fprintf(stderr, "kernel_launch: unexpected shapes (n_in %d, out %d, ws %zu)\n", n_in, out_size, ws_size); grid = -1; return; }
        int dev = 0, cus = 0, per_cu = 0;
        if (hipGetDevice(&dev) != hipSuccess || hipDeviceGetAttribute(&cus, hipDeviceAttributeMultiprocessorCount, dev) != hipSuccess) { grid = -1; return; }
        if (hipFuncSetAttribute((const void*)mega_fwd, hipFuncAttributeMaxDynamicSharedMemorySize, LDS_BYTES) != hipSuccess) { fprintf(stderr, "kernel_launch: hipFuncSetAttribute failed\n"); grid = -1; return; }
        if (hipOccupancyMaxActiveBlocksPerMultiprocessor(&per_cu, (const void*)mega_fwd, NWAVES * 64, LDS_BYTES) != hipSuccess || per_cu < 1) { fprintf(stderr, "kernel_launch: occupancy query says %d\n", per_cu); per_cu = 1; }
        (void)hipGetLastError();
        grid = cus;
        if (grid != 256) fprintf(stderr, "kernel_launch: %d CUs (expected 256)\n", grid);
    }
    if (grid < 0) return;
    if (hipMemsetAsync((char*)d_ws + WS_CTL, 0, CTL_ZERO_BYTES, stream) != hipSuccess) return;
    Args a{};
    for (int i = 0; i < 21; ++i) a.in[i] = (const float*)d_in[i];
    a.out = (float*)d_out; a.ws = (unsigned char*)d_ws;
#if defined(MK_PER_PHASE)
    for (int p = 0; p < N_PHASES; ++p) { a.ph_lo = p; a.ph_hi = p + 1; hipLaunchKernelGGL(mega_fwd, dim3(grid), dim3(NWAVES * 64), LDS_BYTES, stream, a); }
#else
    a.ph_lo = 0; a.ph_hi = N_PHASES;
    hipLaunchKernelGGL(mega_fwd, dim3(grid), dim3(NWAVES * 64), LDS_BYTES, stream, a);
#endif
}
```

```cpp
#include <hip/hip_runtime.h>
#include <hip/hip_bf16.h>
#include <cstdio>
#include <cstdint>
#include <cmath>
constexpr int NWAVES_ = 8;
constexpr int NWAVES = 8;
constexpr int DM = 1024, NB = 8, SEQ = 4096, MTOK = NB * SEQ, CTXL = 256, MCTX = NB * CTXL, MALL = MTOK + MCTX;
constexpr int INW = 1792, FF = 2816, SKV = SEQ + CTXL;
constexpr int N_PHASES = 11;
constexpr size_t MiB = 1u << 20;
constexpr size_t WS_CTL = 0, CTL_ZERO_BYTES = 128 * 1024;
constexpr size_t WS_MODS = 1 * MiB;
constexpr size_t WS_ROPE = WS_MODS + 512 * 1024;
constexpr size_t WS_WSB = 2 * MiB;
constexpr size_t WS_WPOOL = WS_WSB + 512 * 1024;
constexpr size_t WS_WIN = 4 * MiB;
constexpr size_t WS_WOUT = 8 * MiB;
constexpr size_t WS_W13 = 10 * MiB;
constexpr size_t WS_W2 = 32 * MiB;
constexpr size_t WS_XN = 44 * MiB;
constexpr size_t WS_Q = 112 * MiB;
constexpr size_t WS_RES = 112 * MiB;
constexpr size_t WS_KB = 144 * MiB;
constexpr size_t WS_VB = 153 * MiB;
constexpr size_t WS_U = 162 * MiB;
constexpr size_t WS_VG = 194 * MiB;
constexpr size_t WS_AM = 226 * MiB;
constexpr size_t WS_H = 290 * MiB;
constexpr size_t WS_WPB = 474 * MiB;
constexpr size_t WS_END = 478 * MiB;
constexpr int CW_BAR = 4096;
constexpr size_t CTL_CNT = 65536;
constexpr size_t WS_PART = 466 * MiB;
static_assert(CTL_CNT + 32768 <= CTL_ZERO_BYTES, "CTL map");
constexpr size_t WS_BIAS = WS_ROPE + 65536;
constexpr int RING_OFF = 0, RING_BYTES = 131072;
constexpr int LDSCTL_OFF = RING_BYTES, MISC_OFF = LDSCTL_OFF + 320;
constexpr int RTAB_OFF = LDSCTL_OFF + 1024;
constexpr int LDS_BYTES = 147456;
static_assert(MISC_OFF + 128 <= LDS_BYTES, "LDS map");

struct Args { const float* in[21]; float* out; unsigned char* ws; int ph_lo, ph_hi; };
#define KARG __attribute__((address_space(4)))
typedef const KARG Args* ArgsP;
static_assert(sizeof(Args) == 192, "Args has no padding");
enum { I_X = 0, I_C, I_CTX, I_CCTX, I_WADA, I_BADA, I_GMIX, I_GFFN, I_WIN, I_WOUT, I_QN, I_KN, I_GN, I_WSP, I_BSP, I_WPOOL, I_PSC, I_W1, I_W3, I_W2, I_GFIN };
constexpr int SH1 = 0, SC1 = DM, GA1 = 2 * DM, SH2 = 3 * DM, SC2 = 4 * DM, GA2 = 5 * DM, MODW = 6 * DM;

template <int CTRL> __device__ __forceinline__ float dpp_add(float x) { return x + __builtin_bit_cast(float, __builtin_amdgcn_update_dpp(0, __builtin_bit_cast(int, x), CTRL, 0xF, 0xF, true)); }
__device__ __forceinline__ float xor16_add(float x) { const unsigned u = __builtin_bit_cast(unsigned, x); auto r = __builtin_amdgcn_permlane16_swap(u, u, false, false); return __builtin_bit_cast(float, (unsigned)r[0]) + __builtin_bit_cast(float, (unsigned)r[1]); }
__device__ __forceinline__ float xor32_add(float x) { const unsigned u = __builtin_bit_cast(unsigned, x); auto r = __builtin_amdgcn_permlane32_swap(u, u, false, false); return __builtin_bit_cast(float, (unsigned)r[0]) + __builtin_bit_cast(float, (unsigned)r[1]); }
__device__ __forceinline__ float wave_sum64(float v) { v = dpp_add<0xB1>(v); v = dpp_add<0x4E>(v); v = dpp_add<0x124>(v); v = dpp_add<0x128>(v); v = xor16_add(v); return xor32_add(v); }
namespace pg8 {
#define PG8_LAS __attribute__((address_space(3)))
typedef unsigned short bf16_t;
typedef short bf16x8 __attribute__((ext_vector_type(8)));
typedef float f32x4 __attribute__((ext_vector_type(4)));
typedef float f32x2 __attribute__((ext_vector_type(2)));
typedef unsigned u32x4 __attribute__((ext_vector_type(4)));
constexpr int BM = 256, BK = 64, HALF = 128, HTB = HALF * BK * 2  , STAGE_BYTES = 8 * HTB, NXCD = 8, WGM = 8;

__host__ __device__ __forceinline__ int lds_byte(int r, int c) { const int st = (r >> 4) * 2 + (c >> 5), rr = r & 15, cc = c & 31, ob = rr * 64 + cc * 2; return st * 1024 + (ob ^ (((ob >> 9) & 1) << 5)); }
__host__ __device__ __forceinline__ void stage_rc(int b, int& R, int& C) { const int st = b / 1024, sb = b % 1024, swz = sb ^ (((sb >> 9) & 1) << 5); R = (st >> 1) * 16 + swz / 64; C = (st & 1) * 32 + (swz % 64) / 2; }
__host__ __device__ __forceinline__ int perm32(int rho) { const int n = rho >> 4, i = rho & 15; return 8 * (i >> 2) + 4 * n + (i & 3); }

struct Unit { int pm, pn; };
struct Gemm { const bf16_t* A; const bf16_t* Bt; int K; int lda; int a_pn_bytes; int b_batch_bytes; };

struct StaticOrder {
    int nM, nN, nwg, G, c, extra, extra_pn;
    __host__ __device__ void init(int M, int N, int G_, int c_, int extra_ = 0, int extra_pn_ = 0) { nM = M / BM; nN = N / BM; nwg = nM * nN; G = G_; c = c_; extra = extra_; extra_pn = extra_pn_; }
    __host__ __device__ bool next(int i, Unit& u) const {
        const long L = (long)i * G + c;
        if (L >= nwg) { const long e = L - nwg; if (e >= extra) return false; u.pm = nM + (int)e; u.pn = extra_pn; return true; }
        int wgid = (int)L; { const int q = nwg / NXCD, r = nwg % NXCD, xcd = wgid % NXCD, off = wgid / NXCD; wgid = (xcd < r ? xcd * (q + 1) : r * (q + 1) + (xcd - r) * q) + off; }
        const int nig = WGM * nN, gid = wgid / nig, fm = gid * WGM, gsz = (nM - fm) < WGM ? (nM - fm) : WGM;
        u.pm = fm + ((wgid % nig) % gsz); u.pn = (wgid % nig) / gsz; return true;
    }
    __device__ __forceinline__ void a_ready(const Unit&) const {}
    __device__ __forceinline__ void done(const Unit&) const {}
};

__device__ __forceinline__ unsigned cvt_pk_bf16(float lo, float hi) { unsigned r; asm volatile("v_cvt_pk_bf16_f32 %0, %1, %2" : "=v"(r) : "v"(lo), "v"(hi)); return r; }
__device__ __forceinline__ f32x2 gelu_pk(f32x2 v) {
    const f32x2 av = __builtin_elementwise_abs(v), d = av * 0.2316418882f + 1.0f;
    f32x2 t; t.x = __builtin_amdgcn_rcpf(d.x); t.y = __builtin_amdgcn_rcpf(d.y);
    f32x2 q = t * 0.5307027145f + (-0.7265760135f); q = q * t + 0.7107068705f; q = q * t + (-0.142248368f); q = q * t + 0.127414796f; q = q * t;
    const f32x2 s = (v * v) * (-0.72134752044f);
    f32x2 e; e.x = __builtin_amdgcn_exp2f(s.x); e.y = __builtin_amdgcn_exp2f(s.y);
    const f32x2 m = v * (q * e), r = v - m;
    f32x2 o; o.x = v.x < 0.f ? m.x : r.x; o.y = v.y < 0.f ? m.y : r.y; return o;
}
__device__ __forceinline__ f32x4 gelu4(f32x4 v) { const f32x2 a = gelu_pk((f32x2){v[0], v[1]}), b = gelu_pk((f32x2){v[2], v[3]}); return (f32x4){a.x, a.y, b.x, b.y}; }
__device__ __forceinline__ float silu1(float v) { return v * __builtin_amdgcn_rcpf(1.0f + __builtin_amdgcn_exp2f(v * -1.4426950408889634f)); }
__device__ __forceinline__ u32x4 pack8(f32x4 v0, f32x4 v1) { u32x4 w; w.x = cvt_pk_bf16(v0[0], v0[1]); w.y = cvt_pk_bf16(v0[2], v0[3]); w.z = cvt_pk_bf16(v1[0], v1[1]); w.w = cvt_pk_bf16(v1[2], v1[3]); return w; }

struct EpiInProj {
    static constexpr bool PERM = true, AFTER_DRAIN = false;
    ArgsP A;
    __device__ __forceinline__ void operator()(const f32x4 (&acc)[2][2][4][2], const Unit& u, int wr, int wc, int fr_, int fq_) const {
        ArgsP a_ = A; asm volatile("" : "+s"(a_)); unsigned char* ws_ = a_->ws;
        bf16_t* Q = (bf16_t*)(ws_ + WS_Q); bf16_t* KB = (bf16_t*)(ws_ + WS_KB); bf16_t* VB = (bf16_t*)(ws_ + WS_VB); bf16_t* U = (bf16_t*)(ws_ + WS_U); bf16_t* VG = (bf16_t*)(ws_ + WS_VG);
        const float* qn = a_->in[I_QN]; const float* kn = a_->in[I_KN]; const float* gv = a_->in[I_GN]; const float* ropeC = (const float*)(ws_ + WS_ROPE); const float* ropeS = ropeC + 1024;
        const float qscale = 0.125f * 1.4426950408889634f;
        int t_ = threadIdx.x; asm volatile("" : "+v"(t_)); const int fr = t_ & 15, fq = (t_ >> 4) & 3; (void)fr_; (void)fq_;
        const int slot = 4 * u.pn + wc; const bool isctx = u.pm >= 128;
        const int rowl = wr * 64 + fr;
        const int row0 = u.pm * BM + rowl;
        const int kvrow0 = (isctx ? (u.pm - 128) * 4352 + 4096 : (u.pm >> 4) * 4352 + (u.pm & 15) * 256) + rowl;
        const int dl = 8 * fq;
        if (slot < 10) {
            const float* nw = slot < 8 ? qn : kn; const float osc = slot < 8 ? qscale : 1.0f;
            f32x4 w[2][2];
#pragma unroll
            for (int bj = 0; bj < 2; ++bj)
#pragma unroll
                for (int n = 0; n < 2; ++n) w[bj][n] = *(const f32x4*)(nw + 32 * bj + dl + 4 * n);
#pragma unroll
            for (int ai = 0; ai < 2; ++ai) {
                const int posr = (4 * u.pm + 2 * ai + wr) & 63;
                const f32x4 cr = *(const f32x4*)(ropeC + posr * 16 + 4 * fq), sr = *(const f32x4*)(ropeS + posr * 16 + 4 * fq);
#pragma unroll
                for (int m = 0; m < 4; ++m) {
                    float ss = 0.f;
#pragma unroll
                    for (int bj = 0; bj < 2; ++bj)
#pragma unroll
                        for (int n = 0; n < 2; ++n) { const f32x4 x = acc[ai][bj][m][n]; ss += (x[0] * x[0] + x[1] * x[1]) + (x[2] * x[2] + x[3] * x[3]); }
                    ss = xor32_add(xor16_add(ss));
                    const float r = __builtin_amdgcn_rsqf(ss * (1.0f / 64.0f) + 1e-6f) * osc;
                    const int posc = 16 * m + fr;
                    const f32x4 cc = *(const f32x4*)(ropeC + posc * 16 + 4 * fq), sc = *(const f32x4*)(ropeS + posc * 16 + 4 * fq);
#pragma unroll
                    for (int bj = 0; bj < 2; ++bj) {
                        f32x4 v0 = acc[ai][bj][m][0] * r * w[bj][0], v1 = acc[ai][bj][m][1] * r * w[bj][1];
                        if (!isctx) { const f32x4 c = bj ? cc : cr, s = bj ? sc : sr;
                            const f32x4 o0 = (f32x4){v0[0] * c[0] - v0[1] * s[0], v0[0] * s[0] + v0[1] * c[0], v0[2] * c[1] - v0[3] * s[1], v0[2] * s[1] + v0[3] * c[1]};
                            const f32x4 o1 = (f32x4){v1[0] * c[2] - v1[1] * s[2], v1[0] * s[2] + v1[1] * c[2], v1[2] * c[3] - v1[3] * s[3], v1[2] * s[3] + v1[3] * c[3]};
                            v0 = o0; v1 = o1; }
                        bf16_t* dst = slot < 8 ? Q + (size_t)(row0 + ai * HALF + m * 16) * 512 + slot * 64 + 32 * bj + dl
                                               : KB + (size_t)(kvrow0 + ai * HALF + m * 16) * 128 + (slot - 8) * 64 + 32 * bj + dl;
                        *(u32x4*)dst = pack8(v0, v1);
                    }
                    asm volatile("" ::: "memory");
                }
            }
        } else if (slot < 12) {
#pragma unroll
            for (int ai = 0; ai < 2; ++ai)
#pragma unroll
                for (int m = 0; m < 4; ++m)
#pragma unroll
                    for (int bj = 0; bj < 2; ++bj)
                        *(u32x4*)(VB + (size_t)(kvrow0 + ai * HALF + m * 16) * 128 + (slot - 10) * 64 + 32 * bj + dl) = pack8(acc[ai][bj][m][0], acc[ai][bj][m][1]);
        } else if (slot < 20) {
#pragma unroll
            for (int ai = 0; ai < 2; ++ai)
#pragma unroll
                for (int m = 0; m < 4; ++m)
#pragma unroll
                    for (int bj = 0; bj < 2; ++bj)
                        *(u32x4*)(U + (size_t)(row0 + ai * HALF + m * 16) * 512 + (slot - 12) * 64 + 32 * bj + dl) = pack8(gelu4(acc[ai][bj][m][0]), gelu4(acc[ai][bj][m][1]));
        } else {
            f32x4 w[2][2];
#pragma unroll
            for (int bj = 0; bj < 2; ++bj)
#pragma unroll
                for (int n = 0; n < 2; ++n) w[bj][n] = *(const f32x4*)(gv + (slot - 20) * 64 + 32 * bj + dl + 4 * n);
#pragma unroll
            for (int ai = 0; ai < 2; ++ai)
#pragma unroll
                for (int m = 0; m < 4; ++m) {
                    f32x4 g[2][2]; float ss = 0.f;
#pragma unroll
                    for (int bj = 0; bj < 2; ++bj)
#pragma unroll
                        for (int n = 0; n < 2; ++n) { const f32x4 x = gelu4(acc[ai][bj][m][n]); g[bj][n] = x; ss += (x[0] * x[0] + x[1] * x[1]) + (x[2] * x[2] + x[3] * x[3]); }
                    ss = xor32_add(xor16_add(ss));
                    const float r = __builtin_amdgcn_rsqf(ss * (1.0f / 64.0f) + 1e-6f);
#pragma unroll
                    for (int bj = 0; bj < 2; ++bj)
                        *(u32x4*)(VG + (size_t)(row0 + ai * HALF + m * 16) * 512 + (slot - 20) * 64 + 32 * bj + dl) = pack8(g[bj][0] * r * w[bj][0], g[bj][1] * r * w[bj][1]);
                }
        }
    }
};
constexpr int RS_M = 32768;
__device__ __forceinline__ float row_total(const float* part, int row, int fq) {
    const f32x4 p = *(const f32x4*)(part + ((size_t)fq * RS_M + row) * 4); float t = (p[0] + p[1]) + (p[2] + p[3]); t = xor32_add(xor16_add(t)); return t;
}
template <int V> struct EpiResid {
    static constexpr bool PERM = true, AFTER_DRAIN = false, XNOUT = (V == 4), FINAL = (V == 10), BASE16 = (V != 4);
    ArgsP A; void* outp;
    __device__ __forceinline__ void operator()(f32x4 (&acc)[2][2][4][2], const Unit& u, int wr, int wc, int fr_, int fq_) const {
        int t_ = threadIdx.x; asm volatile("" : "+v"(t_)); const int fr = t_ & 15, fq = (t_ >> 4) & 3; (void)fr_; (void)fq_;
        const int row0 = u.pm * BM + wr * 64 + fr, col0 = u.pn * BM + wc * 32 + 8 * fq, b = u.pm >> 4;
        ArgsP a_ = A; asm volatile("" : "+s"(a_)); unsigned char* ws_ = a_->ws; constexpr int gstride = MODW;
        const float* mods_ = (const float*)(ws_ + WS_MODS); const float* modl_ = mods_ + (V == 10 ? 9 * MODW : 0);
        const float* basef = a_->in[I_X]; const bf16_t* baseh = (const bf16_t*)(ws_ + WS_RES); const float* gate = modl_ + (V == 4 ? GA1 : GA2);
        float* part = (float*)(ws_ + WS_PART) + (size_t)(V == 4 ? 0 : V == 10 ? 3 : 1) * 16 * RS_M;
        bf16_t* xn = (bf16_t*)(ws_ + WS_XN); const float* gnext = (V == 4) ? a_->in[I_GFFN] : a_->in[I_GMIX] + DM; const float* scnext = (V == 4) ? mods_ + SC2 : mods_ + 9 * MODW + SC1;
        unsigned* cnt = (unsigned*)(ws_ + WS_CTL + CTL_CNT); const float* gfin = a_->in[I_GFIN];
        bf16_t* resout = (bf16_t*)outp; float* out = (float*)outp;
        const float* gp = gate + (size_t)b * gstride + col0;
        f32x4 gvv[2][2], gmn[2][2];
#pragma unroll
        for (int bj = 0; bj < 2; ++bj)
#pragma unroll
            for (int n = 0; n < 2; ++n) { gvv[bj][n] = *(const f32x4*)(gp + bj * HALF + n * 4);
                if (XNOUT) gmn[bj][n] = *(const f32x4*)(gnext + col0 + bj * HALF + n * 4) * (*(const f32x4*)(scnext + (size_t)b * gstride + col0 + bj * HALF + n * 4) + 1.0f); }
        float ssv[2][4];
        f32x4 bsA[2][2], bsB[2][2], bsC[2][2], bsD[2][2], bsE[2][2], bsF[2][2], bsG[2][2], bsH[2][2];
        u32x4 hsA[2], hsB[2], hsC[2], hsD[2], hsE[2], hsF[2], hsG[2], hsH[2];
#define ER_LOAD(X, p) do { const size_t off_ = (size_t)(row0 + ((p) >> 2) * HALF + ((p) & 3) * 16) * 1024 + col0; \
            _Pragma("unroll") for (int bj = 0; bj < 2; ++bj) { if (BASE16) { if (FINAL) hs##X[bj] = __builtin_nontemporal_load((const u32x4*)(baseh + off_ + bj * HALF)); else hs##X[bj] = *(const u32x4*)(baseh + off_ + bj * HALF); } \
                else { bs##X[bj][0] = __builtin_nontemporal_load((const f32x4*)(basef + off_ + bj * HALF)); bs##X[bj][1] = __builtin_nontemporal_load((const f32x4*)(basef + off_ + bj * HALF + 4)); } } } while (0)
#define ER_WORK(X, p) do { const int ai = (p) >> 2, m = (p) & 3; const size_t off_ = (size_t)(row0 + ai * HALF + m * 16) * 1024 + col0; float ss = 0.f; \
            _Pragma("unroll") for (int bj = 0; bj < 2; ++bj) { f32x4 b0, b1; \
                if (BASE16) { const u32x4 h = hs##X[bj]; b0 = (f32x4){__builtin_bit_cast(float, h.x << 16), __builtin_bit_cast(float, h.x & 0xffff0000u), __builtin_bit_cast(float, h.y << 16), __builtin_bit_cast(float, h.y & 0xffff0000u)}; \
                    b1 = (f32x4){__builtin_bit_cast(float, h.z << 16), __builtin_bit_cast(float, h.z & 0xffff0000u), __builtin_bit_cast(float, h.w << 16), __builtin_bit_cast(float, h.w & 0xffff0000u)}; } \
                else { b0 = bs##X[bj][0]; b1 = bs##X[bj][1]; } \
                const f32x4 x0 = b0 + gvv[bj][0] * acc[ai][bj][m][0], x1 = b1 + gvv[bj][1] * acc[ai][bj][m][1]; \
                ss += ((x0[0] * x0[0] + x0[1] * x0[1]) + (x0[2] * x0[2] + x0[3] * x0[3])) + ((x1[0] * x1[0] + x1[1] * x1[1]) + (x1[2] * x1[2] + x1[3] * x1[3])); \
                if (FINAL) { acc[ai][bj][m][0] = x0; acc[ai][bj][m][1] = x1; } else *(u32x4*)(resout + off_ + bj * HALF) = pack8(x0, x1); \
                if (XNOUT) *(u32x4*)(xn + off_ + bj * HALF) = pack8(x0 * gmn[bj][0], x1 * gmn[bj][1]); } \
            ss = xor32_add(xor16_add(ss)); ssv[ai][m] = ss; } while (0)
#define ER_FENCE asm volatile("" ::: "memory")
        if constexpr (FINAL) {
            ER_LOAD(A, 0); ER_LOAD(B, 1); ER_LOAD(C, 2); ER_LOAD(D, 3); ER_LOAD(E, 4); ER_LOAD(F, 5); ER_LOAD(G, 6); ER_LOAD(H, 7); ER_FENCE;
            ER_WORK(A, 0); ER_WORK(B, 1); ER_WORK(C, 2); ER_WORK(D, 3); ER_WORK(E, 4); ER_WORK(F, 5); ER_WORK(G, 6); ER_WORK(H, 7);
        } else if constexpr (BASE16) {
            ER_LOAD(A, 0); ER_LOAD(B, 1); ER_LOAD(C, 2); ER_LOAD(D, 3); ER_FENCE;
            ER_LOAD(E, 4); ER_FENCE; ER_WORK(A, 0); ER_FENCE;
            ER_LOAD(A, 5); ER_FENCE; ER_WORK(B, 1); ER_FENCE;
            ER_LOAD(B, 6); ER_FENCE; ER_WORK(C, 2); ER_FENCE;
            ER_LOAD(C, 7); ER_FENCE; ER_WORK(D, 3); ER_FENCE;
            ER_WORK(E, 4); ER_FENCE; ER_WORK(A, 5); ER_FENCE; ER_WORK(B, 6); ER_FENCE; ER_WORK(C, 7);
        } else {
            ER_LOAD(A, 0); ER_LOAD(B, 1); ER_FENCE;
            ER_LOAD(C, 2); ER_FENCE; ER_WORK(A, 0); ER_FENCE;
            ER_LOAD(A, 3); ER_FENCE; ER_WORK(B, 1); ER_FENCE;
            ER_LOAD(B, 4); ER_FENCE; ER_WORK(C, 2); ER_FENCE;
            ER_LOAD(C, 5); ER_FENCE; ER_WORK(A, 3); ER_FENCE;
            ER_LOAD(A, 6); ER_FENCE; ER_WORK(B, 4); ER_FENCE;
            ER_LOAD(B, 7); ER_FENCE; ER_WORK(C, 5); ER_FENCE;
            ER_WORK(A, 6); ER_FENCE;
            ER_WORK(B, 7);
        }
#undef ER_FENCE
#undef ER_LOAD
#undef ER_WORK
        if (fq == 0) {
#pragma unroll
            for (int ai = 0; ai < 2; ++ai)
#pragma unroll
                for (int m = 0; m < 4; ++m) { float* pp = part + ((size_t)u.pn * RS_M + (row0 + ai * HALF + m * 16)) * 4 + wc;
                    if (FINAL) __hip_atomic_store(pp, ssv[ai][m], __ATOMIC_RELAXED, __HIP_MEMORY_SCOPE_AGENT); else *pp = ssv[ai][m]; }
        }
        if (FINAL) {
            asm volatile("s_waitcnt vmcnt(0)" ::: "memory");
            unsigned* cw = cnt + 64 * u.pm;
            if (fr == 0 && fq == 0) __hip_atomic_fetch_add(cw, 1u, __ATOMIC_RELAXED, __HIP_MEMORY_SCOPE_AGENT);
            { unsigned sp = 0; while ((unsigned)__builtin_amdgcn_readfirstlane(__hip_atomic_load(cw, __ATOMIC_RELAXED, __HIP_MEMORY_SCOPE_AGENT)) < 32u) { __builtin_amdgcn_s_sleep(2); if (++sp > (1u << 22)) break; } }
            f32x4 gf[2][2];
#pragma unroll
            for (int bj = 0; bj < 2; ++bj)
#pragma unroll
                for (int n = 0; n < 2; ++n) gf[bj][n] = *(const f32x4*)(gfin + col0 + bj * HALF + n * 4);
            float rr[2][4];
            {
                f32x4 pq[8];
#pragma unroll
                for (int i = 0; i < 8; ++i) { const float* pp = part + ((size_t)fq * RS_M + (row0 + (i >> 2) * HALF + (i & 3) * 16)) * 4;
                    asm volatile("global_load_dwordx4 %0, %1, off sc1" : "=v"(pq[i]) : "v"(pp) : "memory"); }
                asm volatile("s_waitcnt vmcnt(0)" : "+v"(pq[0]), "+v"(pq[1]), "+v"(pq[2]), "+v"(pq[3]), "+v"(pq[4]), "+v"(pq[5]), "+v"(pq[6]), "+v"(pq[7]) :: "memory");
#pragma unroll
                for (int i = 0; i < 8; ++i) { float t = (pq[i][0] + pq[i][1]) + (pq[i][2] + pq[i][3]); t = xor32_add(xor16_add(t)); rr[i >> 2][i & 3] = __builtin_amdgcn_rsqf(t * (1.0f / 1024.0f) + 1e-6f); }
            }
#pragma unroll
            for (int ai = 0; ai < 2; ++ai)
#pragma unroll
                for (int m = 0; m < 4; ++m) { const size_t off = (size_t)(row0 + ai * HALF + m * 16) * 1024 + col0;
#pragma unroll
                    for (int bj = 0; bj < 2; ++bj)
#pragma unroll
                        for (int n = 0; n < 2; ++n) *(f32x4*)(out + off + bj * HALF + n * 4) = acc[ai][bj][m][n] * rr[ai][m] * gf[bj][n]; }
        }
    }
};
template <int L> struct EpiSwiglu {
    static constexpr bool PERM = true, AFTER_DRAIN = false;
    ArgsP A; const PG8_LAS float* rtab; int pm0;
    __device__ __forceinline__ void operator()(const f32x4 (&acc)[2][2][4][2], const Unit& u, int wr, int wc, int fr_, int fq_) const {
        int t_ = threadIdx.x; asm volatile("" : "+v"(t_)); const int fr = t_ & 15, fq = (t_ >> 4) & 3; (void)fr_; (void)fq_;
        const int row0 = u.pm * BM + wr * 64 + fr, col0 = u.pn * HALF + wc * 32 + 8 * fq;
        ArgsP a_ = A; asm volatile("" : "+s"(a_)); unsigned char* ws_ = a_->ws; constexpr int ldh = FF;
        bf16_t* H = (bf16_t*)(ws_ + WS_H); const float* rowss = (const float*)(ws_ + WS_PART) + (size_t)(L ? 2 : 0) * 16 * RS_M; const float* bias = (const float*)(ws_ + WS_BIAS) + (size_t)L * 8 * 5632;
        const float* bp = bias + (size_t)(u.pm >> 4) * 5632 + u.pn * BM + wc * 32 + 8 * fq;
        f32x4 bv[2][2];
#pragma unroll
        for (int bj = 0; bj < 2; ++bj)
#pragma unroll
            for (int n = 0; n < 2; ++n) bv[bj][n] = *(const f32x4*)(bp + bj * HALF + 4 * n);
        float rr[2][4]; { const PG8_LAS float* rt = rtab + (u.pm == pm0 ? 0 : 256) + wr * 64 + fr; (void)rowss;
#pragma unroll
            for (int ai = 0; ai < 2; ++ai)
#pragma unroll
                for (int m = 0; m < 4; ++m) rr[ai][m] = rt[ai * HALF + m * 16]; }
#pragma unroll
        for (int ai = 0; ai < 2; ++ai)
#pragma unroll
            for (int m = 0; m < 4; ++m) { const int row = row0 + ai * HALF + m * 16; const float r = rr[ai][m]; f32x4 h[2];
#pragma unroll
                for (int n = 0; n < 2; ++n) { const f32x4 a = acc[ai][0][m][n] * r + bv[0][n], b = acc[ai][1][m][n] * r + bv[1][n]; h[n] = (f32x4){silu1(a[0]) * b[0], silu1(a[1]) * b[1], silu1(a[2]) * b[2], silu1(a[3]) * b[3]}; }
                *(u32x4*)(H + (size_t)row * ldh + col0) = pack8(h[0], h[1]); }
    }
};

struct EpiNull {
    static constexpr bool PERM = true, AFTER_DRAIN = false;
    bf16_t* D;
    __device__ __forceinline__ void operator()(const f32x4 (&acc)[2][2][4][2], const Unit& u, int wr, int wc, int fr_, int fq_) const {
        int t_ = threadIdx.x; asm volatile("" : "+v"(t_)); const int fr = t_ & 15, fq = (t_ >> 4) & 3; (void)fr_; (void)fq_;
        const int row0 = u.pm * BM + wr * 64 + fr, col0 = u.pn * BM + wc * 32 + 8 * fq;
#pragma unroll
        for (int ai = 0; ai < 2; ++ai)
#pragma unroll
            for (int m = 0; m < 4; ++m)
#pragma unroll
                for (int bj = 0; bj < 2; ++bj) *(u32x4*)(D + (size_t)(row0 + ai * HALF + m * 16) * 1024 + col0 + bj * HALF) = pack8(acc[ai][bj][m][0], acc[ai][bj][m][1]);
    }
};
struct EpiNullWide {
    static constexpr bool PERM = true, AFTER_DRAIN = false;
    bf16_t* D;
    __device__ __forceinline__ void operator()(const f32x4 (&acc)[2][2][4][2], const Unit& u, int wr, int wc, int fr_, int fq_) const {
        int t_ = threadIdx.x; asm volatile("" : "+v"(t_)); const int fr = t_ & 15, fq = (t_ >> 4) & 3; (void)fr_; (void)fq_;
        const int row0 = u.pm * BM + wr * 64 + fr, col0 = u.pn * HALF + wc * 32 + 8 * fq;
#pragma unroll
        for (int ai = 0; ai < 2; ++ai)
#pragma unroll
            for (int m = 0; m < 4; ++m) *(u32x4*)(D + (size_t)(row0 + ai * HALF + m * 16) * 2816 + col0) = pack8(acc[ai][0][m][0] + acc[ai][1][m][0], acc[ai][0][m][1] + acc[ai][1][m][1]);
    }
};
struct EpiZ {
    static constexpr bool PERM = true, AFTER_DRAIN = false;
    ArgsP A;
    __device__ __forceinline__ void operator()(const f32x4 (&acc)[2][2][4][2], const Unit& u, int wr, int wc, int fr_, int fq_) const {
        int t_ = threadIdx.x; asm volatile("" : "+v"(t_)); const int fr = t_ & 15, fq = (t_ >> 4) & 3; (void)fr_; (void)fq_;
        const int row0 = u.pm * BM + wr * 64 + fr, col0 = u.pn * BM + wc * 32 + 8 * fq;
        ArgsP a_ = A; asm volatile("" : "+s"(a_)); unsigned char* ws_ = a_->ws; bf16_t* Z = (bf16_t*)(ws_ + WS_AM); const float* rowss = (const float*)(ws_ + WS_PART) + (size_t)16 * RS_M;
        float rr[2][4];
#pragma unroll
        for (int ai = 0; ai < 2; ++ai) {
#pragma unroll
            for (int m = 0; m < 4; ++m) rr[ai][m] = __builtin_amdgcn_rsqf(row_total(rowss, row0 + ai * HALF + m * 16, fq) * (1.0f / 1024.0f) + 1e-6f);
            asm volatile("" ::: "memory"); }
#pragma unroll
        for (int ai = 0; ai < 2; ++ai)
#pragma unroll
            for (int m = 0; m < 4; ++m)
#pragma unroll
                for (int bj = 0; bj < 2; ++bj) *(u32x4*)(Z + (size_t)(row0 + ai * HALF + m * 16) * 1024 + col0 + bj * HALF) = pack8(acc[ai][bj][m][0] * rr[ai][m], acc[ai][bj][m][1] * rr[ai][m]);
    }
};

template <class Epi, class Sched, bool ALIGN_EPI = false, bool SP2 = false>
__device__ __forceinline__ void gemm_phase(PG8_LAS unsigned char* lds, const Gemm g, const Sched& S, const Epi& E) {
    int tid_ = threadIdx.x; asm volatile("" : "+v"(tid_));
    const int tid = tid_, wid = __builtin_amdgcn_readfirstlane(tid >> 6), lane = tid & 63, wr = wid >> 2, wc = wid & 3, fr = lane & 15, fq = lane >> 4;
    const int K = g.K, nt = K / BK;
    unsigned voffA[2], voffB[2];
#pragma unroll
    for (int i = 0; i < 2; ++i) { int R, C; stage_rc(tid * 16 + i * 8192, R, C); const int Rb = Epi::PERM ? ((R & ~31) + perm32(R & 31)) : R;
        voffA[i] = (unsigned)(R * g.lda + C) * 2u; voffB[i] = (unsigned)(Rb * K + C) * 2u; }
    const size_t kstep = (size_t)(BK * 2);
    const size_t hsA = (size_t)HALF * g.lda * 2, hsB = (size_t)HALF * K * 2;
    const size_t tsA = 2 * hsA, tsB = 2 * hsB;
    const unsigned ldsw = (unsigned)wid * 1024u;
    const int aoff = lds_byte(wr * 64 + fr, fq * 8), boff = lds_byte(wc * 32 + fr, fq * 8);
#define PG8_SA(b, h) (((b) * 2 + (h)) * HTB)
#define PG8_SB(b, h) ((4 + (b) * 2 + (h)) * HTB)
#define PG8_STAGE(bufoff, gbase, voff) do { _Pragma("unroll") for (int _i = 0; _i < 2; ++_i) \
        __builtin_amdgcn_global_load_lds((const unsigned*)((const char*)(gbase) + (voff)[_i]), (PG8_LAS unsigned*)(lds + (bufoff) + ldsw + _i * 8192), 16, 0, 0); } while (0)
#define PG8_LDA(dst, b, h) do { _Pragma("unroll") for (int m = 0; m < 4; ++m) _Pragma("unroll") for (int k = 0; k < 2; ++k) dst[m][k] = *(const PG8_LAS bf16x8*)(lds + PG8_SA(b, h) + aoff + m * 2048 + k * 1024); } while (0)
#define PG8_LDB(dst, b, h) do { _Pragma("unroll") for (int n = 0; n < 2; ++n) _Pragma("unroll") for (int k = 0; k < 2; ++k) dst[n][k] = *(const PG8_LAS bf16x8*)(lds + PG8_SB(b, h) + boff + n * 2048 + k * 1024); } while (0)
#define PG8_MMA(ai, bj, At, Bt) do { __builtin_amdgcn_s_setprio(1); _Pragma("unroll") for (int m = 0; m < 4; ++m) _Pragma("unroll") for (int n = 0; n < 2; ++n) _Pragma("unroll") for (int k = 0; k < 2; ++k) \
        acc[ai][bj][m][n] = __builtin_amdgcn_mfma_f32_16x16x32_bf16(Bt[n][k], At[m][k], acc[ai][bj][m][n], 0, 0, 0); __builtin_amdgcn_s_setprio(0); } while (0)
#define PG8_WAIT_V(n) asm volatile("s_waitcnt vmcnt(" #n ")" ::: "memory")
#define PG8_WAIT_L(n) asm volatile("s_waitcnt lgkmcnt(" #n ")" ::: "memory")
#define PG8_BAR __builtin_amdgcn_s_barrier()
#define PG8_SCHED __builtin_amdgcn_sched_barrier(0)
    Unit cur, nxt; int ui = 0;
    if (!S.next(0, cur)) return;
    f32x4 acc[2][2][4][2];
#pragma unroll
    for (int a = 0; a < 2; ++a)
#pragma unroll
        for (int b = 0; b < 2; ++b)
#pragma unroll
            for (int m = 0; m < 4; ++m)
#pragma unroll
                for (int n = 0; n < 2; ++n) acc[a][b][m][n] = (f32x4){0.f, 0.f, 0.f, 0.f};
    bf16x8 At[4][2], B0[2][2], B1[2][2];
    const char* cA = (const char*)g.A + (size_t)cur.pm * tsA + (size_t)cur.pn * g.a_pn_bytes; const char* cB = (const char*)g.Bt + (size_t)cur.pn * tsB + (size_t)(cur.pm >> 4) * g.b_batch_bytes;
    S.a_ready(cur);
    if constexpr (SP2) {
        PG8_STAGE(PG8_SB(0, 0), cB, voffB); PG8_STAGE(PG8_SB(0, 1), cB + hsB, voffB); PG8_STAGE(PG8_SA(0, 0), cA, voffA); PG8_STAGE(PG8_SA(0, 1), cA + hsA, voffA);
        if (wr == 1) PG8_BAR;
        PG8_WAIT_V(2); PG8_BAR;
        PG8_STAGE(PG8_SB(1, 0), cB + kstep, voffB); PG8_STAGE(PG8_SA(1, 0), cA + kstep, voffA); PG8_STAGE(PG8_SB(1, 1), cB + hsB + kstep, voffB);
        PG8_WAIT_V(6); PG8_BAR;
    } else {
        PG8_STAGE(PG8_SB(0, 0), cB, voffB); PG8_STAGE(PG8_SA(0, 0), cA, voffA); PG8_STAGE(PG8_SB(0, 1), cB + hsB, voffB); PG8_STAGE(PG8_SA(0, 1), cA + hsA, voffA);
        if (wr == 1) PG8_BAR;
        PG8_WAIT_V(4); PG8_BAR;
        PG8_STAGE(PG8_SB(1, 0), cB + kstep, voffB); PG8_STAGE(PG8_SA(1, 0), cA + kstep, voffA); PG8_STAGE(PG8_SB(1, 1), cB + hsB + kstep, voffB);
        PG8_WAIT_V(6); PG8_BAR;
    }
    for (;;) {
        const bool has_next = S.next(ui + 1, nxt);
        const char* nA = has_next ? (const char*)g.A + (size_t)nxt.pm * tsA + (size_t)nxt.pn * g.a_pn_bytes : cA; const char* nB = has_next ? (const char*)g.Bt + (size_t)nxt.pn * tsB + (size_t)(nxt.pm >> 4) * g.b_batch_bytes : cB;
#pragma unroll 1
        for (int t = 0; t < nt; t += 2) {
            const bool last = (t == nt - 2);
            const char* a1 = cA + (size_t)(t + 1) * kstep;
            const char* a2 = last ? nA : cA + (size_t)(t + 2) * kstep; const char* b2 = last ? nB : cB + (size_t)(t + 2) * kstep;
            const char* a3 = a2 + kstep; const char* b3 = b2 + kstep;
            if (last && has_next) S.a_ready(nxt);
            if constexpr (SP2) {
            PG8_LDB(B0, 0, 0); PG8_LDB(B1, 0, 1); PG8_SCHED; PG8_LDA(At, 0, 0); PG8_STAGE(PG8_SA(1, 1), a1 + hsA, voffA);
            PG8_WAIT_V(8); PG8_WAIT_L(0); PG8_BAR; PG8_MMA(0, 0, At, B0); PG8_MMA(0, 1, At, B1); PG8_BAR; PG8_SCHED;
            PG8_LDA(At, 0, 1); PG8_STAGE(PG8_SB(0, 0), b2, voffB); PG8_STAGE(PG8_SB(0, 1), b2 + hsB, voffB); PG8_STAGE(PG8_SA(0, 0), a2, voffA);
            PG8_WAIT_V(8); PG8_WAIT_L(0); PG8_BAR; PG8_MMA(1, 0, At, B0); PG8_MMA(1, 1, At, B1); PG8_BAR; PG8_SCHED;
            PG8_LDB(B0, 1, 0); PG8_LDB(B1, 1, 1); PG8_SCHED; PG8_LDA(At, 1, 0); PG8_STAGE(PG8_SA(0, 1), a2 + hsA, voffA);
            PG8_WAIT_V(8); PG8_WAIT_L(0); PG8_BAR; PG8_MMA(0, 0, At, B0); PG8_MMA(0, 1, At, B1); PG8_BAR; PG8_SCHED;
            PG8_LDA(At, 1, 1); PG8_STAGE(PG8_SB(1, 0), b3, voffB); PG8_STAGE(PG8_SB(1, 1), b3 + hsB, voffB); PG8_STAGE(PG8_SA(1, 0), a3, voffA);
            PG8_WAIT_V(8); PG8_WAIT_L(0); PG8_BAR; PG8_MMA(1, 0, At, B0); PG8_MMA(1, 1, At, B1); PG8_BAR; PG8_SCHED;
            } else {
            PG8_LDB(B0, 0, 0); PG8_SCHED; PG8_LDA(At, 0, 0); PG8_STAGE(PG8_SA(1, 1), a1 + hsA, voffA);
            PG8_WAIT_L(8); PG8_BAR; PG8_WAIT_L(0); PG8_MMA(0, 0, At, B0); PG8_BAR; PG8_SCHED;
            PG8_LDB(B1, 0, 1); PG8_STAGE(PG8_SB(0, 0), b2, voffB);
            PG8_BAR; PG8_WAIT_L(0); PG8_MMA(0, 1, At, B1); PG8_BAR;
            PG8_LDA(At, 0, 1); PG8_STAGE(PG8_SA(0, 0), a2, voffA);
            PG8_BAR; PG8_WAIT_L(0); PG8_MMA(1, 0, At, B0); PG8_BAR; PG8_SCHED;
            PG8_STAGE(PG8_SB(0, 1), b2 + hsB, voffB);
            PG8_WAIT_V(6); PG8_BAR; PG8_MMA(1, 1, At, B1); PG8_BAR;
            PG8_LDB(B0, 1, 0); PG8_SCHED; PG8_LDA(At, 1, 0); PG8_STAGE(PG8_SA(0, 1), a2 + hsA, voffA);
            PG8_WAIT_L(8); PG8_BAR; PG8_WAIT_L(0); PG8_MMA(0, 0, At, B0); PG8_BAR; PG8_SCHED;
            PG8_LDB(B1, 1, 1); PG8_STAGE(PG8_SB(1, 0), b3, voffB);
            PG8_BAR; PG8_WAIT_L(0); PG8_MMA(0, 1, At, B1); PG8_BAR;
            PG8_LDA(At, 1, 1); PG8_STAGE(PG8_SA(1, 0), a3, voffA);
            PG8_BAR; PG8_WAIT_L(0); PG8_MMA(1, 0, At, B0); PG8_BAR; PG8_SCHED;
            PG8_STAGE(PG8_SB(1, 1), b3 + hsB, voffB);
            PG8_WAIT_V(6); PG8_BAR; PG8_MMA(1, 1, At, B1); PG8_BAR;
            }
        }
        if constexpr (ALIGN_EPI) { if (wr == 0) PG8_BAR; }
        if constexpr (!Epi::AFTER_DRAIN) { E(acc, cur, wr, wc, fr, fq); S.done(cur); }
        if (!has_next) break;
#pragma unroll
        for (int a = 0; a < 2; ++a)
#pragma unroll
            for (int b = 0; b < 2; ++b)
#pragma unroll
                for (int m = 0; m < 4; ++m)
#pragma unroll
                    for (int n = 0; n < 2; ++n) acc[a][b][m][n] = (f32x4){0.f, 0.f, 0.f, 0.f};
        cur = nxt; cA = nA; cB = nB; ++ui;
        if constexpr (ALIGN_EPI) { if (wr == 1) PG8_BAR; }
    }
    PG8_WAIT_V(0);
    if constexpr (!ALIGN_EPI) { if (wr == 0) PG8_BAR; }
    PG8_BAR;
    if constexpr (Epi::AFTER_DRAIN) { E.fused(acc, cur, wr, wc, fr, fq, lds, wid, lane); S.done(cur); }
#undef PG8_SA
#undef PG8_SB
#undef PG8_STAGE
#undef PG8_LDA
#undef PG8_LDB
#undef PG8_MMA
#undef PG8_WAIT_V
#undef PG8_WAIT_L
#undef PG8_BAR
#undef PG8_SCHED
}
}
namespace attn_body {
using bf16=__hip_bfloat16;
using bf16x8=__attribute__((ext_vector_type(8)))short;
using s16x4=__attribute__((ext_vector_type(4)))short;
using f32x16=__attribute__((ext_vector_type(16)))float;
using u32x4=__attribute__((ext_vector_type(4)))unsigned;
constexpr int BATCH=8,NHEAD=8,NKVH=2,SEQ=4096,SKV=4352,D=64,QP=512,KP=128,OP=1024;
constexpr int NW=8,QBLK=32,QB=QBLK*NW,KVBLK=64,NQB=SEQ/QB;
constexpr int ATTN_UNIT_ROWS=QB;
__device__ __forceinline__ int crow(int r,int hi){return (r&3)+8*(r>>2)+4*hi;}
#define SBAR() __builtin_amdgcn_sched_barrier(0)
constexpr int NSLOT=3, SLOTB=8192;
constexpr int LDS_K=0, LDS_V=NSLOT*SLOTB, LDS_WS=2*NSLOT*SLOTB, LDS_OST=LDS_WS+NW*64*4, LDS_BYTES=LDS_OST+NW*4096;
constexpr float C2=0.125f*1.4426950408889634f;
__device__ __forceinline__ void glds16(const void*gsrc,unsigned lds_dst){unsigned keep;
  asm volatile("s_mov_b32 %0, m0\n\ts_mov_b32 m0, %2\n\ts_nop 0\n\tglobal_load_lds_dwordx4 %1, off\n\ts_mov_b32 m0, %0":"=&s"(keep):"v"(gsrc),"s"(lds_dst):"memory");}
__device__ __forceinline__ void glds16_nt(const void*gsrc,unsigned lds_dst){unsigned keep;
  asm volatile("s_mov_b32 %0, m0\n\ts_mov_b32 m0, %2\n\ts_nop 0\n\tglobal_load_lds_dwordx4 %1, off nt\n\ts_mov_b32 m0, %0":"=&s"(keep):"v"(gsrc),"s"(lds_dst):"memory");}
__device__ __forceinline__ float max3f(float a,float b,float c){float r;asm("v_max3_f32 %0, %1, %2, %3":"=v"(r):"v"(a),"v"(b),"v"(c));return r;}
__device__ __forceinline__ float max2f(float a,float b){float r;asm("v_max_f32_e32 %0, %1, %2":"=v"(r):"v"(a),"v"(b));return r;}
__device__ __forceinline__ float fadd_s(float a,float b){float r;asm("v_add_f32_e32 %0, %1, %2":"=v"(r):"v"(a),"v"(b));return r;}
__device__ __forceinline__ float fsub_s(float a,float b){float r;asm("v_sub_f32_e32 %0, %1, %2":"=v"(r):"v"(a),"v"(b));return r;}
typedef float f32x2_t __attribute__((ext_vector_type(2))); typedef __bf16 bf16x2_t __attribute__((ext_vector_type(2)));
__device__ __forceinline__ unsigned cvtpk_s(float lo,float hi){f32x2_t v={lo,hi};bf16x2_t b=__builtin_convertvector(v,bf16x2_t);return __builtin_bit_cast(unsigned,b);}
#define WAIT_BAR(N) asm volatile("s_waitcnt vmcnt(" #N ") lgkmcnt(0)\n\ts_barrier":::"memory")

__device__ __forceinline__ void qkt(f32x16&p0,f32x16&p1,const char*Kslot,const bf16x8*qr,const f32x16&negm,int r32,int hi){
  const char*kb=Kslot+hi*1024+r32*16;
  #pragma unroll
  for(int d0=0;d0<4;++d0){
    const bf16x8 b0=*reinterpret_cast<const bf16x8*>(kb+d0*2048);
    const bf16x8 b1=*reinterpret_cast<const bf16x8*>(kb+d0*2048+512);
    if(d0==0){p0=__builtin_amdgcn_mfma_f32_32x32x16_bf16(b0,qr[0],negm,0,0,0);p1=__builtin_amdgcn_mfma_f32_32x32x16_bf16(b1,qr[0],negm,0,0,0);}
    else{p0=__builtin_amdgcn_mfma_f32_32x32x16_bf16(b0,qr[d0],p0,0,0,0);p1=__builtin_amdgcn_mfma_f32_32x32x16_bf16(b1,qr[d0],p1,0,0,0);}}
}
typedef __attribute__((address_space(3))) const char* lds_cptr;
typedef short v4i16_t __attribute__((ext_vector_type(4)));
__device__ __forceinline__ void kload8(bf16x8*kf,lds_cptr kp){
  kf[0]=*(const __attribute__((address_space(3))) bf16x8*)(kp);      kf[1]=*(const __attribute__((address_space(3))) bf16x8*)(kp+512);
  kf[2]=*(const __attribute__((address_space(3))) bf16x8*)(kp+2048); kf[3]=*(const __attribute__((address_space(3))) bf16x8*)(kp+2560);
  kf[4]=*(const __attribute__((address_space(3))) bf16x8*)(kp+4096); kf[5]=*(const __attribute__((address_space(3))) bf16x8*)(kp+4608);
  kf[6]=*(const __attribute__((address_space(3))) bf16x8*)(kp+6144); kf[7]=*(const __attribute__((address_space(3))) bf16x8*)(kp+6656);
}
__device__ __forceinline__ void kload2(bf16x8*kf,lds_cptr kp,int j){ kf[2*j]=*(const __attribute__((address_space(3))) bf16x8*)(kp+j*2048); kf[2*j+1]=*(const __attribute__((address_space(3))) bf16x8*)(kp+j*2048+512); }
__device__ __forceinline__ s16x4 vtr(lds_cptr p){ return __builtin_bit_cast(s16x4,__builtin_amdgcn_ds_read_tr16_b64_v4i16((__attribute__((address_space(3))) v4i16_t*)p)); }
__device__ __forceinline__ float rowmax(const f32x16&p0,const f32x16&p1){
  float a=max3f(p0[0],p0[1],p1[0]),b=max3f(p0[2],p0[3],p1[1]);a=max3f(a,p1[2],p1[3]);
  #pragma unroll
  for(int r=4;r<16;r+=4){a=max3f(a,p0[r],p0[r+1]);b=max3f(b,p0[r+2],p0[r+3]);a=max3f(a,p1[r],p1[r+1]);b=max3f(b,p1[r+2],p1[r+3]);}
  const float m=max2f(a,b);
  auto rr=__builtin_amdgcn_permlane32_swap(__float_as_uint(m),__float_as_uint(m),false,false);
  return max2f(__uint_as_float(rr[0]),__uint_as_float(rr[1]));
}
__device__ __forceinline__ void pv(f32x16*o,int vb,bf16x8 pa0,bf16x8 pa1,bf16x8 pa2,bf16x8 pa3){
  #pragma unroll
  for(int d0=0;d0<2;++d0){s16x4 lo[4],hi[4];
    #pragma unroll
    for(int ks=0;ks<4;++ks){
      asm volatile("ds_read_b64_tr_b16 %0,%1 offset:%c2":"=&v"(lo[ks]):"v"(vb),"i"(d0*4096+ks*1024):"memory");
      asm volatile("ds_read_b64_tr_b16 %0,%1 offset:%c2":"=&v"(hi[ks]):"v"(vb),"i"(d0*4096+ks*1024+512):"memory");}
    asm volatile("s_waitcnt lgkmcnt(0)":::"memory");SBAR();
    #define PK(k) (bf16x8){lo[k][0],lo[k][1],lo[k][2],lo[k][3],hi[k][0],hi[k][1],hi[k][2],hi[k][3]}
    o[d0]=__builtin_amdgcn_mfma_f32_32x32x16_bf16(pa0,PK(0),o[d0],0,0,0);
    o[d0]=__builtin_amdgcn_mfma_f32_32x32x16_bf16(pa1,PK(1),o[d0],0,0,0);
    o[d0]=__builtin_amdgcn_mfma_f32_32x32x16_bf16(pa2,PK(2),o[d0],0,0,0);
    o[d0]=__builtin_amdgcn_mfma_f32_32x32x16_bf16(pa3,PK(3),o[d0],0,0,0);
    #undef PK
  }
}

#ifndef ATTN_STORE16
#define ATTN_STORE16(p,v) (*(u32x4*)(p)=(v))
#endif
template<int THRL,bool FIX> __device__ __forceinline__ void attn_unit(int b,int h,int qb,const bf16*Q,const bf16*__restrict__ K,const bf16*__restrict__ V,bf16*O,char*shm,float sref){
  int tid_=threadIdx.x; asm volatile("":"+v"(tid_)); const int tid=tid_,lane=tid&63,r32=lane&31,hi=lane>>5; const int wid=__builtin_amdgcn_readfirstlane(tid>>6);
  const long rowbase=(long)b*SEQ, kvbase=(long)b*SKV; const int q0=qb*QB;
  const bf16*Qw=Q+(rowbase+q0+wid*QBLK)*QP+h*D;
  const bf16*Kh=K+kvbase*KP+(h/(NHEAD/NKVH))*D,*Vh=V+kvbase*KP+(h/(NHEAD/NKVH))*D;
  const unsigned lds0=(unsigned)(uintptr_t)shm;
  float*wsf=(float*)(shm+LDS_WS)+wid*64;
  const bf16*ksrc=Kh+(long)lane*KP+wid*8;
  const bf16*vsrc=Vh+(long)(16*(wid&3)+(lane>>2))*KP+(wid>>2)*32+(lane&3)*8;
  const unsigned kdst=lds0+LDS_K+wid*1024, vdst=lds0+LDS_V+wid*1024;
  #define DMA_K(t,slot) glds16(ksrc+(long)(t)*KVBLK*KP,(unsigned)__builtin_amdgcn_readfirstlane(kdst+(slot)))
  #define DMA_V(t,slot) glds16(vsrc+(long)(t)*KVBLK*KP,(unsigned)__builtin_amdgcn_readfirstlane(vdst+(slot)))
  const int vb0=(int)(lds0+LDS_V)+((lane>>4)&1)*32+(lane&3)*8+(4*hi+((lane&15)>>2))*64;
  const char*Kbase=shm+LDS_K; bf16x8 kf[8];
  const lds_cptr shm3=(lds_cptr)shm; const lds_cptr kp0=shm3+LDS_K+hi*1024+r32*16; const lds_cptr vp0=shm3+LDS_V+((lane>>4)&1)*32+(lane&3)*8+(4*hi+((lane&15)>>2))*64;
  constexpr int NT=SKV/KVBLK;
  DMA_K(0,0);DMA_V(0,0);DMA_K(1,SLOTB);
  bf16x8 qr[4];
  #pragma unroll
  for(int d0=0;d0<4;++d0)qr[d0]=__builtin_nontemporal_load(reinterpret_cast<const bf16x8*>(&Qw[(long)r32*QP+d0*16+hi*8]));
  float mhat=0.f,l_reg=0.f;f32x16 o[2];o[0]=f32x16{};o[1]=f32x16{};f32x16 negm=f32x16{};
  if constexpr(FIX){ _Pragma("unroll") for(int r=0;r<16;++r)negm[r]=-sref; }
  asm volatile("":"+v"(negm));
  #define CMASK(P0,P1,t) do{}while(0)
  bool resc=false;
  #define START(P0,P1) do{ resc=false; if constexpr(!FIX) \
    { const float rm=rowmax(P0,P1); const float dl=rm; mhat=fadd_s(mhat,dl); \
      _Pragma("unroll") for(int r=0;r<16;++r){P0[r]=fsub_s(P0[r],dl);P1[r]=fsub_s(P1[r],dl);} \
      _Pragma("unroll") for(int r=0;r<16;++r)negm[r]=-mhat; asm volatile("":"+v"(negm)); } \
    _Pragma("unroll") for(int r=0;r<16;++r)P0[r]=__builtin_amdgcn_exp2f(P0[r]); }while(0)
  #define RESC() do{ if constexpr(!FIX) if(resc){ asm volatile("s_waitcnt lgkmcnt(0)":::"memory"); \
      _Pragma("unroll") for(int d_=0;d_<2;++d_) _Pragma("unroll") for(int r=0;r<16;++r)o[d_][r]*=wsf[crow(r,hi)]; } }while(0)
  f32x16 pA0,pA1,pB0,pB1;
  int sl_prev=0,sl_cur=0,sl_next=SLOTB;
  #define ROT() do{sl_prev=sl_cur;sl_cur=sl_next;sl_next=(sl_next==(NSLOT-1)*SLOTB)?0:sl_next+SLOTB;}while(0)
  DMA_K(2,2*SLOTB);
  WAIT_BAR(3);
  qkt(pA0,pA1,Kbase,qr,negm,r32,hi);asm volatile("s_nop 15\n\ts_nop 7":"+v"(pA0),"+v"(pA1));CMASK(pA0,pA1,0);
  START(pA0,pA1);
  _Pragma("unroll") for(int r=0;r<16;++r)pA1[r]=__builtin_amdgcn_exp2f(pA1[r]);
  WAIT_BAR(0);
  DMA_K(3,0);DMA_V(1,SLOTB);
  ROT();
  kload8(kf,kp0+sl_cur);
  WAIT_BAR(2);
  s16x4 vlo[8],vhi[8]; u32x4 pw0,pw1,pw2,pw3;
  #define PKW(P,B) cvtpk_s(P[B],P[B+1])
  #define PAF(k) __builtin_bit_cast(bf16x8,pw##k)
  #define VFR(i) (bf16x8){vlo[i][0],vlo[i][1],vlo[i][2],vlo[i][3],vhi[i][0],vhi[i][1],vhi[i][2],vhi[i][3]}
  #define PIN(x) asm volatile("":"+v"(x))
  #define MX3(a,b,c) __builtin_fmaxf(__builtin_fmaxf((a),(b)),(c))
  #define GAPA(MF,A0,A1,A2,A3,W0,W1,PW) do{ MF; sacc+=A0; sacc+=A1; sacc+=A2; sacc+=A3; PIN(sacc); W0; W1; PIN(PW); SBAR(); }while(0)
  #define EX(v) __builtin_amdgcn_exp2f(v)
  #define GAPB(MF,X,B) do{ MF; X[B]=EX(X[B]); X[B+1]=EX(X[B+1]); X[B+2]=EX(X[B+2]); X[B+3]=EX(X[B+3]); PIN(X); SBAR(); }while(0)
  #define VRD(i) do{ vlo[i]=vtr(vp_+(((i)>>2)*4096+((i)&3)*1024)); vhi[i]=vtr(vp_+(((i)>>2)*4096+((i)&3)*1024+512)); }while(0)
  #define KRD(G,j) do{ if(G){ kload2(kf,kp0+sl_next,j); SBAR(); } }while(0)
  #define STEP(C0,C1,P0,P1,t,GK,GV,GL) do{ SBAR(); \
    const lds_cptr vp_=vp0+sl_prev; \
    VRD(0); SBAR(); float sacc=(P0[0]+P0[1]); \
    GAPA(C0=__builtin_amdgcn_mfma_f32_32x32x16_bf16(kf[0],qr[0],negm,0,0,0), P0[2],P0[3],P0[4],P0[5],     pw0[0]=PKW(P0,0), pw0[1]=PKW(P0,2), pw0); \
    VRD(4); SBAR(); GAPA(C1=__builtin_amdgcn_mfma_f32_32x32x16_bf16(kf[1],qr[0],negm,0,0,0), P0[6],P0[7],P0[8],P0[9],     pw0[2]=PKW(P0,4), pw0[3]=PKW(P0,6), pw0); \
    VRD(1); SBAR(); GAPA(C0=__builtin_amdgcn_mfma_f32_32x32x16_bf16(kf[2],qr[1],C0,0,0,0),   P0[10],P0[11],P0[12],P0[13], pw1[0]=PKW(P0,8), pw1[1]=PKW(P0,10), pw1); \
    VRD(5); SBAR(); GAPA(C1=__builtin_amdgcn_mfma_f32_32x32x16_bf16(kf[3],qr[1],C1,0,0,0),   P0[14],P0[15],P1[0],P1[1],   pw1[2]=PKW(P0,12),pw1[3]=PKW(P0,14), pw1); \
    VRD(2); SBAR(); GAPA(C0=__builtin_amdgcn_mfma_f32_32x32x16_bf16(kf[4],qr[2],C0,0,0,0),   P1[2],P1[3],P1[4],P1[5],     pw2[0]=PKW(P1,0), pw2[1]=PKW(P1,2), pw2); \
    VRD(6); SBAR(); GAPA(C1=__builtin_amdgcn_mfma_f32_32x32x16_bf16(kf[5],qr[2],C1,0,0,0),   P1[6],P1[7],P1[8],P1[9],     pw2[2]=PKW(P1,4), pw2[3]=PKW(P1,6), pw2); \
    VRD(3); SBAR(); GAPA(C0=__builtin_amdgcn_mfma_f32_32x32x16_bf16(kf[6],qr[3],C0,0,0,0),   P1[10],P1[11],P1[12],P1[13], pw3[0]=PKW(P1,8), pw3[1]=PKW(P1,10), pw3); \
    VRD(7); SBAR(); GAPA(C1=__builtin_amdgcn_mfma_f32_32x32x16_bf16(kf[7],qr[3],C1,0,0,0),   P1[14],P1[15],0.f,0.f,       pw3[2]=PKW(P1,12),pw3[3]=PKW(P1,14), pw3); \
    l_reg+=sacc; \
    if(GK){DMA_K((t)+3,sl_cur);} if(GV){DMA_V((t)+1,sl_next);} \
    CMASK(C0,C1,t); \
    if constexpr(!FIX) { float a=MX3(C0[0],C0[1],C1[0]),b=MX3(C0[2],C0[3],C1[1]); a=MX3(a,C1[2],C1[3]); \
      _Pragma("unroll") for(int r=4;r<16;r+=4){a=MX3(a,C0[r],C0[r+1]);b=MX3(b,C0[r+2],C0[r+3]);a=MX3(a,C1[r],C1[r+1]);b=MX3(b,C1[r+2],C1[r+3]);} \
      float rm=__builtin_fmaxf(a,b); { auto rr=__builtin_amdgcn_permlane32_swap(__float_as_uint(rm),__float_as_uint(rm),false,false); rm=__builtin_fmaxf(__uint_as_float(rr[0]),__uint_as_float(rr[1])); } \
      resc=false; \
      if(__builtin_expect(__any(rm>(float)THRL),0)){ const float dl=__builtin_fmaxf(rm,0.f); mhat+=dl; \
        _Pragma("unroll") for(int r=0;r<16;++r){C0[r]-=dl;C1[r]-=dl;} \
        _Pragma("unroll") for(int r=0;r<16;++r)negm[r]=-mhat; asm volatile("":"+v"(negm)); \
        const float f=__builtin_amdgcn_exp2f(-dl); l_reg*=f; if(hi==0)wsf[r32]=f; resc=true; } } \
    SBAR(); \
    GAPB(o[0]=__builtin_amdgcn_mfma_f32_32x32x16_bf16(PAF(0),VFR(0),o[0],0,0,0), C0,0); \
    GAPB(o[1]=__builtin_amdgcn_mfma_f32_32x32x16_bf16(PAF(0),VFR(4),o[1],0,0,0), C0,4); \
    KRD(GL,0); GAPB(o[0]=__builtin_amdgcn_mfma_f32_32x32x16_bf16(PAF(1),VFR(1),o[0],0,0,0), C0,8); \
    KRD(GL,1); GAPB(o[1]=__builtin_amdgcn_mfma_f32_32x32x16_bf16(PAF(1),VFR(5),o[1],0,0,0), C0,12); \
    KRD(GL,2); GAPB(o[0]=__builtin_amdgcn_mfma_f32_32x32x16_bf16(PAF(2),VFR(2),o[0],0,0,0), C1,0); \
    KRD(GL,3); GAPB(o[1]=__builtin_amdgcn_mfma_f32_32x32x16_bf16(PAF(2),VFR(6),o[1],0,0,0), C1,4); \
    GAPB(o[0]=__builtin_amdgcn_mfma_f32_32x32x16_bf16(PAF(3),VFR(3),o[0],0,0,0), C1,8); \
    GAPB(o[1]=__builtin_amdgcn_mfma_f32_32x32x16_bf16(PAF(3),VFR(7),o[1],0,0,0), C1,12); \
    }while(0)
  int t=1;
  #undef CMASK
  #define CMASK(P0,P1,t) do{}while(0)
  for(;t+5<NT;t+=2){
    STEP(pB0,pB1,pA0,pA1,t,true,true,true);     WAIT_BAR(2); RESC(); ROT();
    STEP(pA0,pA1,pB0,pB1,t+1,true,true,true);   WAIT_BAR(2); RESC(); ROT();
  }
  #undef CMASK
  #define CMASK(P0,P1,t) do{}while(0)
  #define ENDW(tt) do{ if((tt)+3<NT){WAIT_BAR(2);} else if((tt)+2<NT){WAIT_BAR(1);} else {WAIT_BAR(0);} }while(0)
  for(;t+1<NT;t+=2){
    STEP(pB0,pB1,pA0,pA1,t,(t+3<NT),(t+1<NT),(t+1<NT));       ENDW(t);   RESC(); ROT();
    STEP(pA0,pA1,pB0,pB1,t+1,(t+4<NT),(t+2<NT),(t+2<NT));     ENDW(t+1); RESC(); ROT();
  }
  STEP(pB0,pB1,pA0,pA1,NT-1,false,false,false); RESC();
  { float sacc=pB0[0]+pB0[1]; _Pragma("unroll") for(int r=2;r<16;++r)sacc+=pB0[r]; _Pragma("unroll") for(int r=0;r<16;++r)sacc+=pB1[r]; l_reg+=sacc;
    pw0=(u32x4){PKW(pB0,0),PKW(pB0,2),PKW(pB0,4),PKW(pB0,6)};pw1=(u32x4){PKW(pB0,8),PKW(pB0,10),PKW(pB0,12),PKW(pB0,14)};pw2=(u32x4){PKW(pB1,0),PKW(pB1,2),PKW(pB1,4),PKW(pB1,6)};pw3=(u32x4){PKW(pB1,8),PKW(pB1,10),PKW(pB1,12),PKW(pB1,14)};
    SBAR(); pv(o,vb0+sl_cur,PAF(0),PAF(1),PAF(2),PAF(3)); }
  #undef PKW
  #undef PAF
  #undef VFR
  #undef PIN
  #undef MX3
  #undef GAPA
  #undef GAPB
  #undef EX
  #undef VRD
  #undef KRD
  #undef STEP
  #undef ENDW
  {auto rr=__builtin_amdgcn_permlane32_swap(__float_as_uint(l_reg),__float_as_uint(l_reg),false,false);l_reg=__uint_as_float(rr[0])+__uint_as_float(rr[1]);}
  if(hi==0)wsf[32+r32]=l_reg;asm volatile("s_waitcnt lgkmcnt(0)":::"memory");
  float rli[16];
  #pragma unroll
  for(int r=0;r<16;++r)rli[r]=__builtin_amdgcn_rcpf(wsf[32+crow(r,hi)]);
  bf16*Ow=O+(rowbase+q0+wid*QBLK)*OP+h*D;
  { bf16*stg=(bf16*)(shm+LDS_OST)+wid*2048;
    #pragma unroll
    for(int r=0;r<16;++r){const int orow=crow(r,hi);
      #pragma unroll
      for(int d0=0;d0<2;++d0)stg[orow*64+d0*32+r32]=__float2bfloat16(o[d0][r]*rli[r]);}
    asm volatile("s_waitcnt lgkmcnt(0)":::"memory");
    #pragma unroll
    for(int i=0;i<4;++i){const int row=i*8+(lane>>3),ch=lane&7; const u32x4 v=*(const u32x4*)(stg+row*64+ch*8); ATTN_STORE16(Ow+(long)row*OP+ch*8,v);} }
  asm volatile("s_waitcnt lgkmcnt(0)\n\ts_barrier":::"memory");
  #undef DMA_K
  #undef DMA_V
  #undef CMASK
  #undef START
  #undef RESC
  #undef ROT
}
constexpr int ATTN_LDS_BYTES=LDS_BYTES;
struct AttnTensors { const bf16* Q; const bf16* K; const bf16* V; bf16* O; };
struct AttnUnit { int bh; int qb; };
struct StaticOrder {
  int vcu,G;
  __device__ __forceinline__ explicit StaticOrder(int grid,int v):vcu(v),G(grid){}
  __device__ __forceinline__ bool next(int i,AttnUnit&u)const{ const int per=(BATCH*NHEAD*NQB)/G; if(i>=per)return false; const int x=vcu*per+i; u.bh=(x>>6)*4+((x&63)>>4); u.qb=x&15; return true; }
  __device__ __forceinline__ void a_ready(const AttnUnit&)const{}
  __device__ __forceinline__ void done(const AttnUnit&)const{}
};
template<class Sched,int THRL=8> __device__ __forceinline__ void attn_phase(char*lds,const AttnTensors&T,const Sched&S,const float*qnw,const float*knw){
  AttnUnit u;
  float mq=__builtin_fabsf(qnw[threadIdx.x&63]),mk=__builtin_fabsf(knw[threadIdx.x&63]);
  _Pragma("unroll") for(int o_=1;o_<64;o_<<=1){ mq=__builtin_fmaxf(mq,__shfl_xor(mq,o_)); mk=__builtin_fmaxf(mk,__shfl_xor(mk,o_)); }
  const float sref=C2*64.0f*1.02f*mq*mk;
  const bool fix=__builtin_amdgcn_readfirstlane((int)(sref<=40.0f && sref==sref))!=0;
  if(fix){ for(int i=0;S.next(i,u);++i){ S.a_ready(u); attn_unit<THRL,true>(u.bh/NHEAD,u.bh%NHEAD,u.qb,T.Q,T.K,T.V,T.O,lds,sref); S.done(u); } }
  else   { for(int i=0;S.next(i,u);++i){ S.a_ready(u); attn_unit<THRL,false>(u.bh/NHEAD,u.bh%NHEAD,u.qb,T.Q,T.K,T.V,T.O,lds,0.f); S.done(u); } }
}
#undef SBAR
#undef WAIT_BAR
}
#ifndef PG8_SP2
#define PG8_SP2 true
#endif
#ifndef PG8_ALIGN
#define PG8_ALIGN true
#endif
#define GAS __attribute__((address_space(1)))
#define LAS __attribute__((address_space(3)))
typedef unsigned short bf16;
typedef unsigned v4u __attribute__((ext_vector_type(4)));
typedef unsigned v2u __attribute__((ext_vector_type(2)));
typedef float f32x4 __attribute__((ext_vector_type(4)));
typedef float f32x2 __attribute__((ext_vector_type(2)));
typedef short bf16x8 __attribute__((ext_vector_type(8)));
typedef GAS unsigned gu32;
typedef GAS unsigned long long gu64;
#define RLX_AGENT __ATOMIC_RELAXED, __HIP_MEMORY_SCOPE_AGENT
#define LDS_WAIT() asm volatile("s_waitcnt lgkmcnt(0)" ::: "memory")
#define VM_WAIT() asm volatile("s_waitcnt vmcnt(0)" ::: "memory")
__device__ __forceinline__ unsigned f2bf(float f) { unsigned u = __builtin_bit_cast(unsigned, f); return (u + 0x7fffu + ((u >> 16) & 1u)) >> 16; }
__device__ __forceinline__ unsigned pk2(float lo, float hi) { unsigned r; asm("v_cvt_pk_bf16_f32 %0, %1, %2" : "=v"(r) : "v"(lo), "v"(hi)); return r; }
__device__ __forceinline__ float bf2f(unsigned h) { return __builtin_bit_cast(float, h << 16); }

#define XB_TMO      128
#define XB_XCNT(j)  (256  + 64 * (j))
#define XB_XSUB(j)  (1280 + 64 * (j))
#define XB_XGEN(j)  (2304 + 64 * (j))
#define XB_TOP      3328
#define XB_TOPGEN   3392
#define XCD_BAR_WORDS 3456
#define XB_SPIN_CAP (1u << 18)

__device__ __forceinline__ unsigned xb_ld(unsigned* p)              { return __hip_atomic_load(p, __ATOMIC_RELAXED, __HIP_MEMORY_SCOPE_AGENT); }
__device__ __forceinline__ unsigned xb_add(unsigned* p, unsigned v) { return __hip_atomic_fetch_add(p, v, __ATOMIC_RELAXED, __HIP_MEMORY_SCOPE_AGENT); }
__device__ __forceinline__ unsigned xb_xcc_id() { return (unsigned)__builtin_amdgcn_s_getreg((3 << 11) | 20) & 0xFu; }
#define XB_SPIN(cond, bar) do { unsigned _sp = 0; while (cond) { __builtin_amdgcn_s_sleep(1); \
    if ((++_sp & 255u) == 0u) { if (xb_ld(&(bar)[XB_TMO])) break; if (_sp > XB_SPIN_CAP) { atomicAdd(&(bar)[XB_TMO], 1u); break; } } } } while (0)

struct XcdBarrier {
    unsigned* bar; unsigned x;
    volatile LAS unsigned* st;
};

__device__ __forceinline__ XcdBarrier xcd_barrier_post(unsigned* bar, volatile LAS unsigned* st) {
    XcdBarrier b; b.bar = bar; b.x = xb_xcc_id(); b.st = st;
    if (threadIdx.x == 0) (void)xb_add(&bar[XB_XCNT(b.x)], 1u);
    return b;
}
__device__ __forceinline__ void xcd_barrier_complete(unsigned* bar, unsigned x, unsigned& nloc, unsigned& nx) {
    const unsigned G = gridDim.x * gridDim.y * gridDim.z;
    unsigned sum, cnt, mine, sp = 0u;
    for (;;) {
        sum = 0u; cnt = 0u; mine = 0u;
#pragma unroll
        for (unsigned j = 0; j < 16; ++j) { const unsigned c = xb_ld(&bar[XB_XCNT(j)]); sum += c; cnt += (c > 0u) ? 1u : 0u; mine = (j == x) ? c : mine; }
        if (sum == G) break;
        __builtin_amdgcn_s_sleep(1);
        if ((++sp & 255u) == 0u) { if (xb_ld(&bar[XB_TMO])) break; if (sp > XB_SPIN_CAP) { atomicAdd(&bar[XB_TMO], 1u); break; } }
    }
    nloc = mine > 0u ? mine : 1u; nx = cnt > 0u ? cnt : 1u;
}

__device__ __forceinline__ void xcd_barrier(const XcdBarrier& b) {
    asm volatile("s_waitcnt vmcnt(0)" ::: "memory");
    __syncthreads();
    if (threadIdx.x == 0) {
        unsigned* bar = b.bar;
        __builtin_amdgcn_s_waitcnt(0);
        unsigned nloc = b.st[0], nx = b.st[1];
        if (nloc == 0u) { xcd_barrier_complete(bar, b.x, nloc, nx); b.st[0] = nloc; b.st[1] = nx; }
        const unsigned old = xb_add(&bar[XB_XSUB(b.x)], 1u);
        const unsigned gen = old / nloc;
        if (old + 1u == (gen + 1u) * nloc) {
            __builtin_amdgcn_fence(__ATOMIC_RELEASE, "agent");
            asm volatile("s_waitcnt vmcnt(0)" ::: "memory");
            const unsigned og = xb_add(&bar[XB_TOP], 1u);
            const unsigned tg = og / nx;
            if (og + 1u == (tg + 1u) * nx) xb_add(&bar[XB_TOPGEN], 1u);
            else XB_SPIN(xb_ld(&bar[XB_TOPGEN]) == tg, bar);
            __builtin_amdgcn_fence(__ATOMIC_ACQUIRE, "agent");
            xb_add(&bar[XB_XGEN(b.x)], 1u);
            asm volatile("s_waitcnt vmcnt(0)" ::: "memory");
        } else {
            XB_SPIN(xb_ld(&bar[XB_XGEN(b.x)]) == gen, bar);
            __builtin_amdgcn_fence(__ATOMIC_ACQUIRE, "agent");
            asm volatile("s_waitcnt vmcnt(0)" ::: "memory");
        }
    }
    __syncthreads();
}
struct Frame {
    LAS unsigned char* lds;
    volatile LAS unsigned* MISC;
    gu32* ctl;
    int tid, lane, wave;
    int vcu, G;
};
__device__ __forceinline__ float wave_sum(float v) { return wave_sum64(v); }
__device__ __forceinline__ void p0_transpose_item(const float* W, int ldw, int k0, int n0, bf16* WT, int ldt, int dst_row0, LAS float* scr, int lane) {
#pragma unroll 8
    for (int i = 0; i < 32; ++i) { const int kk = 2 * i + (lane >> 5); scr[kk * 33 + (lane & 31)] = __builtin_nontemporal_load(W + (size_t)(k0 + kk) * ldw + n0 + (lane & 31)); }
    LDS_WAIT(); asm volatile("" ::: "memory");
    const int c = lane & 7;
#pragma unroll
    for (int j = 0; j < 4; ++j) { const int n = (lane >> 3) + 8 * j; const LAS float* s = scr + (8 * c) * 33 + n;
        v4u o; o.x = pk2(s[0 * 33], s[1 * 33]); o.y = pk2(s[2 * 33], s[3 * 33]); o.z = pk2(s[4 * 33], s[5 * 33]); o.w = pk2(s[6 * 33], s[7 * 33]);
        *(GAS v4u*)(WT + (size_t)(dst_row0 + n) * ldt + k0 + 8 * c) = o; }
    LDS_WAIT(); asm volatile("" ::: "memory");
}
__device__ __forceinline__ void p0_prologue(Frame& F, ArgsP ap) {
    unsigned char* ws = ap->ws;
    if (F.vcu < 192) {
        LAS float* sc = (LAS float*)(F.lds + RING_OFF); LAS float* part = sc + 9 * 1024;
        const float* c = ap->in[I_C]; const float* cctx = ap->in[I_CCTX];
        for (int i = F.tid; i < 9 * 1024; i += NWAVES * 64) { const int bb = i >> 10, k = i & 1023; const float v = bb < 8 ? c[bb * 1024 + k] : cctx[k]; sc[i] = v / (1.0f + expf(-v)); }
        __syncthreads();
        const int l = F.vcu / 96, cb = F.vcu % 96, k0 = F.wave * 128;
        const float* w = ap->in[I_WADA] + (size_t)l * DM * MODW + (size_t)k0 * MODW + cb * 64 + F.lane;
        float acc[9];
#pragma unroll
        for (int j = 0; j < 9; ++j) acc[j] = 0.f;
        for (int k = 0; k < 128; k += 8) {
            float wv[8];
#pragma unroll
            for (int q = 0; q < 8; ++q) wv[q] = __builtin_nontemporal_load(w + (size_t)(k + q) * MODW);
#pragma unroll
            for (int j = 0; j < 9; ++j) { const f32x4 s0 = *(const LAS f32x4*)(sc + j * 1024 + k0 + k), s1 = *(const LAS f32x4*)(sc + j * 1024 + k0 + k + 4);
                acc[j] += (s0[0] * wv[0] + s0[1] * wv[1]) + (s0[2] * wv[2] + s0[3] * wv[3]) + (s1[0] * wv[4] + s1[1] * wv[5]) + (s1[2] * wv[6] + s1[3] * wv[7]); }
        }
#pragma unroll
        for (int j = 0; j < 9; ++j) part[(F.wave * 9 + j) * 64 + F.lane] = acc[j];
        __syncthreads();
        float* mods = (float*)(ws + WS_MODS);
        for (int idx = F.tid; idx < 9 * 64; idx += NWAVES * 64) { const int j = idx >> 6, col = idx & 63; float s = 0.f;
#pragma unroll
            for (int wv_ = 0; wv_ < 8; ++wv_) s += part[(wv_ * 9 + j) * 64 + col];
            mods[(size_t)(l * 9 + j) * MODW + cb * 64 + col] = s + ap->in[I_BADA][l * MODW + cb * 64 + col]; }
        __syncthreads();
    } else if (F.vcu == F.G - 1) {
        float* rc = (float*)(ws + WS_ROPE); float* rs = rc + 1024;
        for (int e = F.tid; e < 1024; e += NWAVES * 64) { const int pos = e >> 4, i = e & 15; const float fr = powf(10000.0f, -(float)(2 * i) / 32.0f); const float a = (float)pos * fr; rc[e] = cosf(a); rs[e] = sinf(a); }
    }
    LAS float* scr = (LAS float*)(F.lds + RING_OFF + F.wave * 16384);
    const int gw = F.vcu * NWAVES + F.wave, NGW = F.G * NWAVES;
    constexpr int I_IN = 16 * 56, I_OUT = 16 * 32, I_13 = 16 * 88, I_2 = 44 * 32, I_P = 4 * 8;
    constexpr int NITEMS = I_IN + I_OUT + 4 * I_13 + 2 * I_2 + 4 * I_P;
    for (int it = gw; it < NITEMS; it += NGW) {
        int r = it;
        if (r < I_IN) { const int kb = r / 56, nb = r % 56, f = 32 * nb, slot = f >> 6, bj = (f >> 5) & 1, pn = slot >> 2, wc = slot & 3;
            p0_transpose_item(ap->in[I_WIN], INW, 64 * kb, f, (bf16*)(ws + WS_WIN), DM, 256 * pn + 128 * bj + 32 * wc, scr, F.lane); continue; } r -= I_IN;
        if (r < I_OUT) { const int kb = r / 32, nb = r % 32; p0_transpose_item(ap->in[I_WOUT], DM, 64 * kb, 32 * nb, (bf16*)(ws + WS_WOUT), DM, 32 * nb, scr, F.lane); continue; } r -= I_OUT;
        if (r < 4 * I_13) { const int mi = r / I_13, rr = r % I_13, l = mi >> 1, which = mi & 1, kb = rr / 88, nb = rr % 88, n0 = 32 * nb;
            const float* W = ap->in[which ? I_W3 : I_W1] + (size_t)l * DM * FF;
            p0_transpose_item(W, FF, 64 * kb, n0, (bf16*)(ws + WS_W13) + (size_t)l * 5632 * DM, DM, 256 * (n0 >> 7) + 128 * which + (n0 & 127), scr, F.lane); continue; } r -= 4 * I_13;
        if (r < 2 * I_2) { const int l = r / I_2, rr = r % I_2, kb = rr / 32, nb = rr % 32;
            p0_transpose_item(ap->in[I_W2] + (size_t)l * FF * DM, DM, 64 * kb, 32 * nb, (bf16*)(ws + WS_W2) + (size_t)l * DM * FF, FF, 32 * nb, scr, F.lane); continue; } r -= 2 * I_2;
        { const int g = r / I_P, rr = r % I_P, kb = rr / 8, nb = rr % 8;
            p0_transpose_item(ap->in[I_WPOOL] + (size_t)g * 256 * 256, 256, 64 * kb, 32 * nb, (bf16*)(ws + WS_WPOOL), 256, g * 256 + 32 * nb, scr, F.lane); }
    }
    { const float* wsp = ap->in[I_WSP]; bf16* dst = (bf16*)(ws + WS_WSB);
        for (int e = (F.vcu * NWAVES * 64 + F.tid) * 4; e < 8 * 128 * 128; e += F.G * NWAVES * 64 * 4) { const f32x4 v = *(const f32x4*)(wsp + e); v2u o; o.x = pk2(v[0], v[1]); o.y = pk2(v[2], v[3]); *(v2u*)(dst + e) = o; } }
}
__device__ __forceinline__ void p1_bias13(Frame& F, ArgsP ap) {
    if (F.vcu >= 176) return;
    const int l = F.vcu / 88, rem = F.vcu % 88, which = rem / 44, cb = rem % 44, k0 = F.wave * 128;
    LAS float* shs = (LAS float*)(F.lds + RING_OFF); LAS float* part = shs + 8 * 1024;
    const float* mods = (const float*)(ap->ws + WS_MODS);
    for (int i = F.tid; i < 8 * 1024; i += NWAVES * 64) { const int b = i >> 10, k = i & 1023; shs[i] = mods[(size_t)(l * 9 + b) * MODW + SH2 + k]; }
    __syncthreads();
    const float* w = ap->in[which ? I_W3 : I_W1] + (size_t)l * DM * FF + (size_t)k0 * FF + cb * 64 + F.lane;
    float acc[8];
#pragma unroll
    for (int j = 0; j < 8; ++j) acc[j] = 0.f;
    for (int k = 0; k < 128; k += 8) {
        float wv[8];
#pragma unroll
        for (int q = 0; q < 8; ++q) wv[q] = __builtin_nontemporal_load(w + (size_t)(k + q) * FF);
#pragma unroll
        for (int j = 0; j < 8; ++j) { const f32x4 s0 = *(const LAS f32x4*)(shs + j * 1024 + k0 + k), s1 = *(const LAS f32x4*)(shs + j * 1024 + k0 + k + 4);
            acc[j] += (s0[0] * wv[0] + s0[1] * wv[1]) + (s0[2] * wv[2] + s0[3] * wv[3]) + (s1[0] * wv[4] + s1[1] * wv[5]) + (s1[2] * wv[6] + s1[3] * wv[7]); }
    }
#pragma unroll
    for (int j = 0; j < 8; ++j) part[(F.wave * 8 + j) * 64 + F.lane] = acc[j];
    __syncthreads();
    float* bias = (float*)(ap->ws + WS_BIAS);
    for (int idx = F.tid; idx < 8 * 64; idx += NWAVES * 64) { const int j = idx >> 6, col = idx & 63, n = cb * 64 + col; float sum = 0.f;
#pragma unroll
        for (int wv_ = 0; wv_ < 8; ++wv_) sum += part[(wv_ * 8 + j) * 64 + col];
        bias[(size_t)(l * 8 + j) * 5632 + 256 * (n >> 7) + 128 * which + (n & 127)] = sum; }
    __syncthreads();
}
__device__ __forceinline__ void p1_poolw(Frame& F, ArgsP ap) {
    unsigned char* ws = ap->ws; const bf16* src = (const bf16*)(ws + WS_WPOOL); bf16* dst = (bf16*)(ws + WS_WPB);
    const float* gm = ap->in[I_GMIX] + DM; const float* mod1 = (const float*)(ws + WS_MODS) + (size_t)9 * MODW;
    for (int e = (F.vcu * NWAVES * 64 + F.tid) * 8; e < 8 * 1024 * 256; e += F.G * NWAVES * 64 * 8) {
        const int b = e >> 18, n = (e >> 8) & 1023, k = e & 255, gk = (n & ~255) + k;
        const v4u w = *(const v4u*)(src + (size_t)n * 256 + k); const f32x4 g0 = *(const f32x4*)(gm + gk), g1 = *(const f32x4*)(gm + gk + 4);
        const f32x4 s0 = *(const f32x4*)(mod1 + (size_t)b * MODW + SC1 + gk), s1 = *(const f32x4*)(mod1 + (size_t)b * MODW + SC1 + gk + 4);
        const f32x4 m0 = g0 * (s0 + 1.0f), m1 = g1 * (s1 + 1.0f);
        v4u o; o.x = pk2(bf2f(w.x & 0xffffu) * m0[0], bf2f(w.x >> 16) * m0[1]); o.y = pk2(bf2f(w.y & 0xffffu) * m0[2], bf2f(w.y >> 16) * m0[3]);
        o.z = pk2(bf2f(w.z & 0xffffu) * m1[0], bf2f(w.z >> 16) * m1[1]); o.w = pk2(bf2f(w.w & 0xffffu) * m1[2], bf2f(w.w >> 16) * m1[3]);
        *(v4u*)(dst + e) = o; }
}
__device__ __forceinline__ void norm_pass(Frame& F, const float* src_lat, const float* src_ctx, bf16* dst, const float* gvec, const float* modl, int sh_off, int sc_off) {
    const int total = src_ctx ? MALL : MTOK, gw = F.vcu * NWAVES + F.wave, NGW = F.G * NWAVES, rpw = (total + NGW - 1) / NGW;
    const int r0 = gw * rpw, r1 = (r0 + rpw < total) ? r0 + rpw : total;
    int cur = -1; f32x4 gm[4], sh[4];
    for (int row = r0; row < r1; ++row) {
        const int bb = row < MTOK ? (row >> 12) : 8;
        if (bb != cur) { cur = bb;
#pragma unroll
            for (int j = 0; j < 4; ++j) { const int c = 4 * F.lane + 256 * j; const f32x4 g = *(const f32x4*)(gvec + c), s = *(const f32x4*)(modl + (size_t)bb * MODW + sc_off + c);
                gm[j] = g * (s + 1.0f); sh[j] = *(const f32x4*)(modl + (size_t)bb * MODW + sh_off + c); } }
        const float* xr = row < MTOK ? src_lat + (size_t)row * DM : src_ctx + (size_t)(row - MTOK) * DM;
        f32x4 v[4]; float ss = 0.f;
#pragma unroll
        for (int j = 0; j < 4; ++j) { v[j] = __builtin_nontemporal_load((const f32x4*)(xr + 4 * F.lane + 256 * j)); ss += (v[j][0] * v[j][0] + v[j][1] * v[j][1]) + (v[j][2] * v[j][2] + v[j][3] * v[j][3]); }
        const float r = __builtin_amdgcn_rsqf(wave_sum(ss) * (1.0f / DM) + 1e-6f);
        bf16* orow = dst + (size_t)row * DM;
#pragma unroll
        for (int j = 0; j < 4; ++j) { const f32x4 o = v[j] * r * gm[j] + sh[j]; v2u w; w.x = pk2(o[0], o[1]); w.y = pk2(o[2], o[3]); *(v2u*)(orow + 4 * F.lane + 256 * j) = w; }
    }
}
__device__ __forceinline__ void final_norm(Frame& F, float* out, const float* gvec) {
    const int gw = F.vcu * NWAVES + F.wave, NGW = F.G * NWAVES, rpw = (MTOK + NGW - 1) / NGW;
    const int r0 = gw * rpw, r1 = (r0 + rpw < MTOK) ? r0 + rpw : MTOK;
    f32x4 g[4];
#pragma unroll
    for (int j = 0; j < 4; ++j) g[j] = *(const f32x4*)(gvec + 4 * F.lane + 256 * j);
    for (int row = r0; row < r1; ++row) {
        float* xr = out + (size_t)row * DM; f32x4 v[4]; float ss = 0.f;
#pragma unroll
        for (int j = 0; j < 4; ++j) { v[j] = *(const f32x4*)(xr + 4 * F.lane + 256 * j); ss += (v[j][0] * v[j][0] + v[j][1] * v[j][1]) + (v[j][2] * v[j][2] + v[j][3] * v[j][3]); }
        const float r = 1.0f / sqrtf(wave_sum(ss) * (1.0f / DM) + 1e-6f);
#pragma unroll
        for (int j = 0; j < 4; ++j) *(f32x4*)(xr + 4 * F.lane + 256 * j) = v[j] * r * g[j];
    }
}
template <int W> __device__ __forceinline__ void poolres_cols(const bf16* zb, bf16* outb, bf16* xnb, float* partb, int t0, int c, f32x4 gate, f32x4 gmn, int grp, int lane) {
    constexpr int L = W / 2, R = W / 2 - 1, NV = W - 1 + 16;
    f32x4 v[NV];
#define BF4(u_) (f32x4){bf2f((u_).x & 0xffffu), bf2f((u_).x >> 16), bf2f((u_).y & 0xffffu), bf2f((u_).y >> 16)}
#define Z_LD(dst_, t_) do { const int tt_ = (t_); if (tt_ < 0 || tt_ >= SEQ) dst_ = (f32x4){0.f, 0.f, 0.f, 0.f}; else { const v2u u_ = __builtin_nontemporal_load((const v2u*)(zb + (size_t)tt_ * DM + c)); dst_ = BF4(u_); } } while (0)
#pragma unroll
    for (int i = 0; i < W - 1; ++i) Z_LD(v[i], t0 - L + i);
    for (int blk = 0; blk < 4; ++blk) {
        const int tb = t0 + 16 * blk;
        v2u xr[16];
#pragma unroll
        for (int i = 0; i < 16; ++i) xr[i] = *(const v2u*)(outb + (size_t)(tb + i) * DM + c);
#pragma unroll
        for (int i = 0; i < 16; ++i) Z_LD(v[W - 1 + i], tb + R + i);
        f32x4 s = v[0];
#pragma unroll
        for (int i = 1; i < W; ++i) s += v[i];
#pragma unroll
        for (int j = 0; j < 16; ++j) { const int t = tb + j; const int lo = t - L < 0 ? 0 : t - L, hi = t + R > SEQ - 1 ? SEQ - 1 : t + R; const float icnt = __builtin_amdgcn_rcpf((float)(hi - lo + 1));
            const f32x4 o = s * icnt - v[j + L]; const f32x4 x3 = BF4(xr[j]) + gate * o;
            v2u w; w.x = pk2(x3[0], x3[1]); w.y = pk2(x3[2], x3[3]); *(v2u*)(outb + (size_t)t * DM + c) = w;
            const f32x4 y = x3 * gmn; v2u wy; wy.x = pk2(y[0], y[1]); wy.y = pk2(y[2], y[3]); *(v2u*)(xnb + (size_t)t * DM + c) = wy;
            const float ss = wave_sum((x3[0] * x3[0] + x3[1] * x3[1]) + (x3[2] * x3[2] + x3[3] * x3[3]));
            if (lane == 0) *(f32x4*)(partb + ((size_t)grp * MTOK + t) * 4) = (f32x4){ss, 0.f, 0.f, 0.f};
            if (j < 15) s += v[j + W] - v[j]; }
#pragma unroll
        for (int i = 0; i < W - 1; ++i) v[i] = v[i + 16];
    }
#undef Z_LD
#undef BF4
}
__device__ __forceinline__ void poolres_pass(Frame& F, const bf16* Z, bf16* out, bf16* xn, float* part, const float* gate, const float* pscale, const float* gnext, const float* scnext) {
    for (int strip = F.vcu; strip < MTOK / 128; strip += F.G) {
        const int b = strip >> 5, grp = F.wave >> 1, t0 = (strip & 31) * 128 + 64 * (F.wave & 1); const size_t ro = (size_t)b * SEQ;
        const int c = 256 * grp + 4 * F.lane;
        const f32x4 gt = *(const f32x4*)(gate + (size_t)b * MODW + c) * *(const f32x4*)(pscale + c);
        const f32x4 gmn = *(const f32x4*)(gnext + c) * (*(const f32x4*)(scnext + (size_t)b * MODW + c) + 1.0f);
        const bf16* zb = Z + ro * DM; bf16* outb = out + ro * DM; bf16* xnb = xn + ro * DM; float* partb = part + ro * 4;
        if (grp == 0) poolres_cols<2>(zb, outb, xnb, partb, t0, c, gt, gmn, grp, F.lane); else if (grp == 1) poolres_cols<4>(zb, outb, xnb, partb, t0, c, gt, gmn, grp, F.lane);
        else if (grp == 2) poolres_cols<8>(zb, outb, xnb, partb, t0, c, gt, gmn, grp, F.lane); else poolres_cols<16>(zb, outb, xnb, partb, t0, c, gt, gmn, grp, F.lane);
    }
}
__device__ __forceinline__ void gmlp_unit(Frame& F, int unit, const bf16* VG, const bf16* U, const bf16* WSB, const float* bs, bf16* AM) {
    using attn_body::f32x16;
    const int g = F.wave, lane = F.lane, r32 = lane & 31, hi = lane >> 5;
    const size_t R0 = (size_t)unit * 128;
    LAS unsigned char* slot = F.lds + RING_OFF + g * 16384;
    const unsigned slot_addr = (unsigned)(uintptr_t)slot;
    const int vb = (int)slot_addr + ((lane >> 4) & 1) * 32 + (lane & 3) * 8 + (4 * hi + ((lane & 15) >> 2)) * 64;
#pragma unroll
    for (int kt = 0; kt < 2; ++kt)
#pragma unroll
        for (int p = 0; p < 8; ++p)
            attn_body::glds16_nt(VG + (R0 + 64 * kt + 16 * (p & 3) + (lane >> 2)) * 512 + g * 64 + (p >> 2) * 32 + (lane & 3) * 8, (unsigned)__builtin_amdgcn_readfirstlane(slot_addr + kt * 8192 + p * 1024));
    f32x16 o[4][2];
#pragma unroll
    for (int rb = 0; rb < 4; ++rb) { o[rb][0] = f32x16{}; o[rb][1] = f32x16{}; }
#define GM_LDPA(dst, kt_, rb_) do { int z_ = 0; asm volatile("" : "+v"(z_)); const char* wp = wb + z_ + (rb_) * 8192 + (kt_) * 128;     \
            _Pragma("unroll") for (int s = 0; s < 4; ++s) { const v2u a = *(const v2u*)(wp + s * 32), b = *(const v2u*)(wp + s * 32 + 16); dst[s] = __builtin_bit_cast(bf16x8, (v4u){a.x, a.y, b.x, b.y}); } } while (0)
    const char* wb = (const char*)(WSB + ((size_t)(g * 128 + r32) * 128 + 4 * hi));
    {
        bf16x8 pA[4], pB[4];
#define GM_PV(P, kt_, rb_) attn_body::pv(o[rb_], vb + (kt_) * 8192, P[0], P[1], P[2], P[3])
        GM_LDPA(pA, 0, 0);
        VM_WAIT();
        GM_LDPA(pB, 0, 1); GM_PV(pA, 0, 0);
        GM_LDPA(pA, 0, 2); GM_PV(pB, 0, 1);
        GM_LDPA(pB, 0, 3); GM_PV(pA, 0, 2);
        GM_LDPA(pA, 1, 0); GM_PV(pB, 0, 3);
        GM_LDPA(pB, 1, 1); GM_PV(pA, 1, 0);
        GM_LDPA(pA, 1, 2); GM_PV(pB, 1, 1);
        GM_LDPA(pB, 1, 3); GM_PV(pA, 1, 2);
        GM_PV(pB, 1, 3);
#undef GM_PV
    }
#undef GM_LDPA
    LDS_WAIT();
    LAS float* stg = (LAS float*)slot;
    v4u uA[4], uB[4]; float bA[4], bB[4];
#define GM_LDU(UU, BB, rb_) do { int zz_ = 0; asm volatile("" : "+v"(zz_)); const char* ub_ = (const char*)(U + (R0 + 32 * (rb_) + (lane >> 3)) * 512 + g * 64 + (lane & 7) * 8) + zz_; \
        const float* bb_ = bs + g * 128 + 32 * (rb_) + (lane >> 3) + zz_; _Pragma("unroll") for (int i = 0; i < 4; ++i) { UU[i] = __builtin_nontemporal_load((const v4u*)(ub_ + i * 8192)); BB[i] = bb_[8 * i]; } } while (0)
#define GM_EPI(UU, BB, rb_) do { \
        _Pragma("unroll") for (int r = 0; r < 16; ++r) { const int orow = attn_body::crow(r, hi); stg[orow * 64 + r32] = o[rb_][0][r]; stg[orow * 64 + 32 + r32] = o[rb_][1][r]; } \
        LDS_WAIT(); \
        _Pragma("unroll") for (int i = 0; i < 4; ++i) { const int row = i * 8 + (lane >> 3), ch = lane & 7; \
            const f32x4 a = *(const LAS f32x4*)(stg + row * 64 + ch * 8) + BB[i], b = *(const LAS f32x4*)(stg + row * 64 + ch * 8 + 4) + BB[i]; \
            v4u w; w.x = pk2(a[0] * bf2f(UU[i].x & 0xffffu), a[1] * bf2f(UU[i].x >> 16)); w.y = pk2(a[2] * bf2f(UU[i].y & 0xffffu), a[3] * bf2f(UU[i].y >> 16)); \
            w.z = pk2(b[0] * bf2f(UU[i].z & 0xffffu), b[1] * bf2f(UU[i].z >> 16)); w.w = pk2(b[2] * bf2f(UU[i].w & 0xffffu), b[3] * bf2f(UU[i].w >> 16)); \
            *(v4u*)(AM + (R0 + 32 * (rb_) + row) * 1024 + 512 + g * 64 + ch * 8) = w; } \
        LDS_WAIT(); } while (0)
    GM_LDU(uA, bA, 0);
    GM_LDU(uB, bB, 1); GM_EPI(uA, bA, 0);
    GM_LDU(uA, bA, 2); GM_EPI(uB, bB, 1);
    GM_LDU(uB, bB, 3); GM_EPI(uA, bA, 2);
    GM_EPI(uB, bB, 3);
#undef GM_LDU
#undef GM_EPI
}

template <class Sched> __device__ __forceinline__ int build_rtab(Frame& F, const Sched& S, const float* part, LAS float* rtab) {
    pg8::Unit u; int pm0 = -1, pm1 = -1;
    for (int i = 0; S.next(i, u); ++i) { if (pm0 < 0) pm0 = u.pm; else if (u.pm != pm0) pm1 = u.pm; }
    if (pm1 < 0) pm1 = pm0;
    { const int slot = F.tid >> 8, r = F.tid & 255, row = (slot ? pm1 : pm0) * 256 + r; float tot = 0.f;
#pragma unroll
        for (int pn = 0; pn < 4; ++pn) { const f32x4 p = *(const f32x4*)(part + ((size_t)pn * MTOK + row) * 4); tot += (p[0] + p[1]) + (p[2] + p[3]); }
        rtab[F.tid] = __builtin_amdgcn_rsqf(tot * (1.0f / DM) + 1e-6f); }
    __syncthreads();
    return pm0;
}
__global__ void __launch_bounds__(NWAVES * 64, 2) mega_fwd(Args args) {
    extern __shared__ __attribute__((aligned(16))) unsigned char lds[];
    Frame F;
    F.lds = (LAS unsigned char*)lds;
    F.MISC = (volatile LAS unsigned*)(F.lds + MISC_OFF);
    F.tid = threadIdx.x; F.lane = F.tid & 63; F.wave = __builtin_amdgcn_readfirstlane(F.tid >> 6);
    F.G = gridDim.x; { const int bx = blockIdx.x; F.vcu = (F.G % 8 == 0) ? (bx % 8) * (F.G / 8) + bx / 8 : bx; }
    ArgsP akp = (ArgsP)__builtin_amdgcn_kernarg_segment_ptr();
    F.ctl = (gu32*)(akp->ws + WS_CTL);
    for (int u = F.tid; u < (LDS_BYTES - LDSCTL_OFF) / 4; u += NWAVES * 64) ((LAS unsigned*)(F.lds + LDSCTL_OFF))[u] = 0u;
    __syncthreads();
    const int lo = akp->ph_lo, hi = akp->ph_hi;
    const bool one_launch = (hi - lo) > 1;
    XcdBarrier bar; bar.bar = (unsigned*)(F.ctl + CW_BAR); bar.x = 0; bar.st = nullptr;
    if (one_launch) bar = xcd_barrier_post((unsigned*)(F.ctl + CW_BAR), F.MISC + 8);
#ifndef PHASE_MASK
#define PHASE_MASK 0x7ff
#endif
#define IN(k) (((PHASE_MASK >> (k)) & 1) && lo <= (k) && (k) < hi)
#define SEAM(k) do { if (IN(k) && IN((k) + 1)) xcd_barrier(bar); } while (0)
#ifndef REPEAT_MASK
#define REPEAT_MASK 0
#endif
#define REP(k) for (int rep_ = 0; rep_ < (((REPEAT_MASK >> (k)) & 1) ? 2 : 1); ++rep_, (((REPEAT_MASK >> (k)) & 1) && rep_ == 1 && one_launch ? (xcd_barrier(bar), 0) : 0))
#define REPRES(k, dummy) ((((REPEAT_MASK >> (k)) & 1) && rep_ == 0) ? (void*)(ws + (dummy)) : (void*)(ws + WS_RES))
#define REPOUT(k, dummy) ((((REPEAT_MASK >> (k)) & 1) && rep_ == 0) ? (float*)(ws + (dummy)) : out)
#define PHASE_VARS() ArgsP A = akp; asm volatile("" : "+s"(A)); unsigned char* ws = A->ws; float* out = A->out; float* mods = (float*)(ws + WS_MODS); const float* mod1 = mods + (size_t)9 * MODW; bf16* XN = (bf16*)(ws + WS_XN); bf16* AM = (bf16*)(ws + WS_AM); bf16* HB = (bf16*)(ws + WS_H); \
    float* rs1 = (float*)(ws + WS_PART); float* rs2 = rs1 + 16 * MTOK; float* rs3 = rs2 + 16 * MTOK; float* rs4 = rs3 + 16 * MTOK; const float* bias13 = (const float*)(ws + WS_BIAS); \
    (void)out; (void)mods; (void)mod1; (void)XN; (void)AM; (void)HB; (void)rs1; (void)rs2; (void)rs3; (void)rs4; (void)bias13
#ifndef STAGGER_US
#define STAGGER_US 0
#endif
#define STAGGER() do { const unsigned g_ = (blockIdx.x >> 3) & 3u; if (STAGGER_US > 0 && g_) { const unsigned long long t0_ = __builtin_amdgcn_s_memrealtime(); while (__builtin_amdgcn_s_memrealtime() - t0_ < (unsigned long long)(g_ * STAGGER_US * 100)) __builtin_amdgcn_s_sleep(8); } } while (0)
#define RELAUNDER() do { int t_ = threadIdx.x; asm volatile("" : "+v"(t_)); F.tid = t_; F.lane = t_ & 63; } while (0)
    if (IN(0)) REP(0) { PHASE_VARS(); RELAUNDER(); p0_prologue(F, A); } SEAM(0);
    if (IN(1)) REP(1) { PHASE_VARS(); RELAUNDER(); p1_bias13(F, A); p1_poolw(F, A); norm_pass(F, A->in[I_X], A->in[I_CTX], XN, A->in[I_GMIX], mods, SH1, SC1); } SEAM(1);
    if (IN(2)) REP(2) { PHASE_VARS();
        pg8::Gemm g{XN, (const bf16*)(ws + WS_WIN), DM, DM, 0, 0}; pg8::StaticOrder S; S.init(MTOK, INW, F.G, (int)blockIdx.x, MCTX / 256, 2);
        pg8::EpiInProj E{A};
        pg8::gemm_phase<pg8::EpiInProj, pg8::StaticOrder, PG8_ALIGN, PG8_SP2>(F.lds + RING_OFF, g, S, E);
    } SEAM(2);
    if (IN(3)) REP(3) { PHASE_VARS();
        const attn_body::AttnTensors AT{(const attn_body::bf16*)(ws + WS_Q), (const attn_body::bf16*)(ws + WS_KB), (const attn_body::bf16*)(ws + WS_VB), (attn_body::bf16*)AM};
        const attn_body::StaticOrder S((int)F.G, F.vcu);
        const bool gfirst = (F.vcu & 1) != 0;
        for (int g2_ = 0; g2_ < 2; ++g2_) {
            if ((g2_ == 0) == gfirst) {
                RELAUNDER();
                for (int rp_ = 0; rp_ < (((REPEAT_MASK >> 11) & 1) ? 2 : 1); ++rp_) {
                    for (int u = F.vcu; u < MTOK / 128; u += F.G) gmlp_unit(F, u, (const bf16*)(ws + WS_VG), (const bf16*)(ws + WS_U), (const bf16*)(ws + WS_WSB), A->in[I_BSP], AM);
                    __syncthreads(); }
            } else attn_body::attn_phase<attn_body::StaticOrder>((char*)lds + RING_OFF, AT, S, A->in[I_QN], A->in[I_KN]);
        }
    } SEAM(3);
    if (IN(4)) REP(4) { PHASE_VARS(); STAGGER();
        pg8::Gemm g{AM, (const bf16*)(ws + WS_WOUT), DM, DM, 0, 0}; pg8::StaticOrder S; S.init(MTOK, DM, F.G, (int)blockIdx.x);
        pg8::EpiResid<4> E{A, (void*)(ws + WS_RES)};
        pg8::gemm_phase<pg8::EpiResid<4>, pg8::StaticOrder, PG8_ALIGN, PG8_SP2>(F.lds + RING_OFF, g, S, E);
    } SEAM(4);
    if (IN(5)) REP(5) { PHASE_VARS();
        pg8::Gemm g{XN, (const bf16*)(ws + WS_W13), DM, DM, 0, 0}; pg8::StaticOrder S; S.init(MTOK, 2 * FF, F.G, (int)blockIdx.x);
#if defined(PROBE_NULL5)
        if (rep_ == 0) { pg8::EpiNull EN{(bf16*)(ws + WS_VG)}; pg8::StaticOrder S2; S2.init(MTOK, DM, F.G, (int)blockIdx.x);   (void)S2;
            pg8::EpiNullWide ENW{(bf16*)(ws + WS_H)}; pg8::gemm_phase<pg8::EpiNullWide, pg8::StaticOrder, PG8_ALIGN, PG8_SP2>(F.lds + RING_OFF, g, S, ENW); (void)EN; } else
#endif
        { RELAUNDER(); LAS float* rtab = (LAS float*)(F.lds + RTAB_OFF); const int pm0 = build_rtab(F, S, rs1, rtab); pg8::EpiSwiglu<0> E{A, rtab, pm0};
        pg8::gemm_phase<pg8::EpiSwiglu<0>, pg8::StaticOrder, PG8_ALIGN, PG8_SP2>(F.lds + RING_OFF, g, S, E); }
    } SEAM(5);
    if (IN(6)) REP(6) { PHASE_VARS(); STAGGER();
        pg8::Gemm g{HB, (const bf16*)(ws + WS_W2), FF, FF, 0, 0}; pg8::StaticOrder S; S.init(MTOK, DM, F.G, (int)blockIdx.x);
#if defined(PROBE_NULL6)
        if (rep_ == 0) { pg8::EpiNull EN{(bf16*)(ws + WS_VG)}; pg8::gemm_phase<pg8::EpiNull, pg8::StaticOrder, PG8_ALIGN, PG8_SP2>(F.lds + RING_OFF, g, S, EN); } else
#elif defined(PROBE_NOXN6)
        if (rep_ == 0) { pg8::EpiResid<7> E7{A, REPRES(6, WS_VG)}; pg8::gemm_phase<pg8::EpiResid<7>, pg8::StaticOrder, PG8_ALIGN, PG8_SP2>(F.lds + RING_OFF, g, S, E7); } else
#endif
        { pg8::EpiResid<6> E{A, REPRES(6, WS_VG)};
        pg8::gemm_phase<pg8::EpiResid<6>, pg8::StaticOrder, PG8_ALIGN, PG8_SP2>(F.lds + RING_OFF, g, S, E); }
    } SEAM(6);
    if (IN(7)) REP(7) { PHASE_VARS();
        pg8::Gemm g{(const bf16*)(ws + WS_RES), (const bf16*)(ws + WS_WPB), 256, DM, 512, 1024 * 256 * 2}; pg8::StaticOrder S; S.init(MTOK, DM, F.G, (int)blockIdx.x);
        pg8::EpiZ E{A};
        pg8::gemm_phase<pg8::EpiZ, pg8::StaticOrder, PG8_ALIGN, PG8_SP2>(F.lds + RING_OFF, g, S, E);
    } SEAM(7);
    if (IN(8)) { PHASE_VARS(); RELAUNDER(); poolres_pass(F, AM, (bf16*)(ws + WS_RES), XN, rs3, mod1 + GA1, A->in[I_PSC], A->in[I_GFFN] + DM, mod1 + SC2); } SEAM(8);
    if (IN(9)) REP(9) { PHASE_VARS();
        pg8::Gemm g{XN, (const bf16*)(ws + WS_W13) + (size_t)5632 * DM, DM, DM, 0, 0}; pg8::StaticOrder S; S.init(MTOK, 2 * FF, F.G, (int)blockIdx.x);
        RELAUNDER(); LAS float* rtab = (LAS float*)(F.lds + RTAB_OFF); const int pm0 = build_rtab(F, S, rs3, rtab); pg8::EpiSwiglu<1> E{A, rtab, pm0};
        pg8::gemm_phase<pg8::EpiSwiglu<1>, pg8::StaticOrder, PG8_ALIGN, PG8_SP2>(F.lds + RING_OFF, g, S, E);
    } SEAM(9);
    if (IN(10)) REP(10) { PHASE_VARS(); STAGGER();
        pg8::Gemm g{HB, (const bf16*)(ws + WS_W2) + (size_t)DM * FF, FF, FF, 0, 0}; pg8::StaticOrder S; S.init(MTOK, DM, F.G, (int)blockIdx.x);
        pg8::EpiResid<10> E{A, out};
        pg8::gemm_phase<pg8::EpiResid<10>, pg8::StaticOrder, PG8_ALIGN, PG8_SP2>(F.lds + RING_OFF, g, S, E);
    }
#undef IN
#undef SEAM
}

extern "C" void kernel_launch(void* const* d_in, const int* in_sizes, int n_in, void* d_out, int out_size, void* d_ws, size_t ws_size, hipStream_t stream) {
    static int grid = 0;
    if (grid == 0) {
        if (n_in != 21 || out_size != MTOK * DM || ws_size < WS_END) { fprintf(stderr, "kernel_launch: unexpected shapes (n_in %d, out %d, ws %zu)\n", n_in, out_size, ws_size); grid = -1; return; }
        int dev = 0, cus = 0, per_cu = 0;
        if (hipGetDevice(&dev) != hipSuccess || hipDeviceGetAttribute(&cus, hipDeviceAttributeMultiprocessorCount, dev) != hipSuccess) { grid = -1; return; }
        if (hipFuncSetAttribute((const void*)mega_fwd, hipFuncAttributeMaxDynamicSharedMemorySize, LDS_BYTES) != hipSuccess) { fprintf(stderr, "kernel_launch: hipFuncSetAttribute failed\n"); grid = -1; return; }
        if (hipOccupancyMaxActiveBlocksPerMultiprocessor(&per_cu, (const void*)mega_fwd, NWAVES * 64, LDS_BYTES) != hipSuccess || per_cu < 1) { fprintf(stderr, "kernel_launch: occupancy query says %d\n", per_cu); per_cu = 1; }
        (void)hipGetLastError();
        grid = cus;
        if (grid != 256) fprintf(stderr, "kernel_launch: %d CUs (expected 256)\n", grid);
    }
    if (grid < 0) return;
    if (hipMemsetAsync((char*)d_ws + WS_CTL, 0, CTL_ZERO_BYTES, stream) != hipSuccess) return;
    Args a{};
    for (int i = 0; i < 21; ++i) a.in[i] = (const float*)d_in[i];
    a.out = (float*)d_out; a.ws = (unsigned char*)d_ws;
#if defined(MK_PER_PHASE)
    for (int p = 0; p < N_PHASES; ++p) { a.ph_lo = p; a.ph_hi = p + 1; hipLaunchKernelGGL(mega_fwd, dim3(grid), dim3(NWAVES * 64), LDS_BYTES, stream, a); }
#else
    a.ph_lo = 0; a.ph_hi = N_PHASES;
    hipLaunchKernelGGL(mega_fwd, dim3(grid), dim3(NWAVES * 64), LDS_BYTES, stream, a);
#endif
}
```

```cpp
#include <hip/hip_runtime.h>
#include <hip/hip_bf16.h>
#include <cstdio>
#include <cstdint>
#include <cmath>
constexpr int NWAVES_ = 8;
constexpr int NWAVES = 8;
constexpr int DM = 1024, NB = 8, SEQ = 4096, MTOK = NB * SEQ, CTXL = 256, MCTX = NB * CTXL, MALL = MTOK + MCTX;
constexpr int INW = 1792, FF = 2816, SKV = SEQ + CTXL;
constexpr int N_PHASES = 11;
constexpr size_t MiB = 1u << 20;
constexpr size_t WS_CTL = 0, CTL_ZERO_BYTES = 128 * 1024;
constexpr size_t WS_MODS = 1 * MiB;
constexpr size_t WS_ROPE = WS_MODS + 512 * 1024;
constexpr size_t WS_WSB = 2 * MiB;
constexpr size_t WS_WPOOL = WS_WSB + 512 * 1024;
constexpr size_t WS_WIN = 4 * MiB;
constexpr size_t WS_WOUT = 8 * MiB;
constexpr size_t WS_W13 = 10 * MiB;
constexpr size_t WS_W2 = 32 * MiB;
constexpr size_t WS_XN = 44 * MiB;
constexpr size_t WS_Q = 112 * MiB;
constexpr size_t WS_RES = 112 * MiB;
constexpr size_t WS_KB = 144 * MiB;
constexpr size_t WS_VB = 153 * MiB;
constexpr size_t WS_U = 162 * MiB;
constexpr size_t WS_VG = 194 * MiB;
constexpr size_t WS_AM = 226 * MiB;
constexpr size_t WS_H = 290 * MiB;
constexpr size_t WS_WPB = 474 * MiB;
constexpr size_t WS_END = 478 * MiB;
constexpr int CW_BAR = 4096;
constexpr size_t CTL_CNT = 65536;
constexpr size_t WS_PART = 466 * MiB;
static_assert(CTL_CNT + 32768 <= CTL_ZERO_BYTES, "CTL map");
constexpr size_t WS_BIAS = WS_ROPE + 65536;
constexpr int RING_OFF = 0, RING_BYTES = 131072;
constexpr int LDSCTL_OFF = RING_BYTES, MISC_OFF = LDSCTL_OFF + 320;
constexpr int RTAB_OFF = LDSCTL_OFF + 1024;
constexpr int LDS_BYTES = 147456;
static_assert(MISC_OFF + 128 <= LDS_BYTES, "LDS map");

struct Args { const float* in[21]; float* out; unsigned char* ws; int ph_lo, ph_hi; };
#define KARG __attribute__((address_space(4)))
typedef const KARG Args* ArgsP;
static_assert(sizeof(Args) == 192, "Args has no padding");
enum { I_X = 0, I_C, I_CTX, I_CCTX, I_WADA, I_BADA, I_GMIX, I_GFFN, I_WIN, I_WOUT, I_QN, I_KN, I_GN, I_WSP, I_BSP, I_WPOOL, I_PSC, I_W1, I_W3, I_W2, I_GFIN };
constexpr int SH1 = 0, SC1 = DM, GA1 = 2 * DM, SH2 = 3 * DM, SC2 = 4 * DM, GA2 = 5 * DM, MODW = 6 * DM;

template <int CTRL> __device__ __forceinline__ float dpp_add(float x) { return x + __builtin_bit_cast(float, __builtin_amdgcn_update_dpp(0, __builtin_bit_cast(int, x), CTRL, 0xF, 0xF, true)); }
__device__ __forceinline__ float xor16_add(float x) { const unsigned u = __builtin_bit_cast(unsigned, x); auto r = __builtin_amdgcn_permlane16_swap(u, u, false, false); return __builtin_bit_cast(float, (unsigned)r[0]) + __builtin_bit_cast(float, (unsigned)r[1]); }
__device__ __forceinline__ float xor32_add(float x) { const unsigned u = __builtin_bit_cast(unsigned, x); auto r = __builtin_amdgcn_permlane32_swap(u, u, false, false); return __builtin_bit_cast(float, (unsigned)r[0]) + __builtin_bit_cast(float, (unsigned)r[1]); }
__device__ __forceinline__ float wave_sum64(float v) { v = dpp_add<0xB1>(v); v = dpp_add<0x4E>(v); v = dpp_add<0x124>(v); v = dpp_add<0x128>(v); v = xor16_add(v); return xor32_add(v); }
namespace pg8 {
#define PG8_LAS __attribute__((address_space(3)))
typedef unsigned short bf16_t;
typedef short bf16x8 __attribute__((ext_vector_type(8)));
typedef float f32x4 __attribute__((ext_vector_type(4)));
typedef float f32x2 __attribute__((ext_vector_type(2)));
typedef unsigned u32x4 __attribute__((ext_vector_type(4)));
constexpr int BM = 256, BK = 64, HALF = 128, HTB = HALF * BK * 2  , STAGE_BYTES = 8 * HTB, NXCD = 8, WGM = 8;

__host__ __device__ __forceinline__ int lds_byte(int r, int c) { const int st = (r >> 4) * 2 + (c >> 5), rr = r & 15, cc = c & 31, ob = rr * 64 + cc * 2; return st * 1024 + (ob ^ (((ob >> 9) & 1) << 5)); }
__host__ __device__ __forceinline__ void stage_rc(int b, int& R, int& C) { const int st = b / 1024, sb = b % 1024, swz = sb ^ (((sb >> 9) & 1) << 5); R = (st >> 1) * 16 + swz / 64; C = (st & 1) * 32 + (swz % 64) / 2; }
__host__ __device__ __forceinline__ int perm32(int rho) { const int n = rho >> 4, i = rho & 15; return 8 * (i >> 2) + 4 * n + (i & 3); }

struct Unit { int pm, pn; };
struct Gemm { const bf16_t* A; const bf16_t* Bt; int K; int lda; int a_pn_bytes; int b_batch_bytes; };

struct StaticOrder {
    int nM, nN, nwg, G, c, extra, extra_pn;
    __host__ __device__ void init(int M, int N, int G_, int c_, int extra_ = 0, int extra_pn_ = 0) { nM = M / BM; nN = N / BM; nwg = nM * nN; G = G_; c = c_; extra = extra_; extra_pn = extra_pn_; }
    __host__ __device__ bool next(int i, Unit& u) const {
        const long L = (long)i * G + c;
        if (L >= nwg) { const long e = L - nwg; if (e >= extra) return false; u.pm = nM + (int)e; u.pn = extra_pn; return true; }
        int wgid = (int)L; { const int q = nwg / NXCD, r = nwg % NXCD, xcd = wgid % NXCD, off = wgid / NXCD; wgid = (xcd < r ? xcd * (q + 1) : r * (q + 1) + (xcd - r) * q) + off; }
        const int nig = WGM * nN, gid = wgid / nig, fm = gid * WGM, gsz = (nM - fm) < WGM ? (nM - fm) : WGM;
        u.pm = fm + ((wgid % nig) % gsz); u.pn = (wgid % nig) / gsz; return true;
    }
    __device__ __forceinline__ void a_ready(const Unit&) const {}
    __device__ __forceinline__ void done(const Unit&) const {}
};

__device__ __forceinline__ unsigned cvt_pk_bf16(float lo, float hi) { unsigned r; asm volatile("v_cvt_pk_bf16_f32 %0, %1, %2" : "=v"(r) : "v"(lo), "v"(hi)); return r; }
__device__ __forceinline__ f32x2 gelu_pk(f32x2 v) {
    const f32x2 av = __builtin_elementwise_abs(v), d = av * 0.2316418882f + 1.0f;
    f32x2 t; t.x = __builtin_amdgcn_rcpf(d.x); t.y = __builtin_amdgcn_rcpf(d.y);
    f32x2 q = t * 0.5307027145f + (-0.7265760135f); q = q * t + 0.7107068705f; q = q * t + (-0.142248368f); q = q * t + 0.127414796f; q = q * t;
    const f32x2 s = (v * v) * (-0.72134752044f);
    f32x2 e; e.x = __builtin_amdgcn_exp2f(s.x); e.y = __builtin_amdgcn_exp2f(s.y);
    const f32x2 m = v * (q * e), r = v - m;
    f32x2 o; o.x = v.x < 0.f ? m.x : r.x; o.y = v.y < 0.f ? m.y : r.y; return o;
}
__device__ __forceinline__ f32x4 gelu4(f32x4 v) { const f32x2 a = gelu_pk((f32x2){v[0], v[1]}), b = gelu_pk((f32x2){v[2], v[3]}); return (f32x4){a.x, a.y, b.x, b.y}; }
__device__ __forceinline__ float silu1(float v) { return v * __builtin_amdgcn_rcpf(1.0f + __builtin_amdgcn_exp2f(v * -1.4426950408889634f)); }
__device__ __forceinline__ u32x4 pack8(f32x4 v0, f32x4 v1) { u32x4 w; w.x = cvt_pk_bf16(v0[0], v0[1]); w.y = cvt_pk_bf16(v0[2], v0[3]); w.z = cvt_pk_bf16(v1[0], v1[1]); w.w = cvt_pk_bf16(v1[2], v1[3]); return w; }

struct EpiInProj {
    static constexpr bool PERM = true, AFTER_DRAIN = false;
    ArgsP A;
    __device__ __forceinline__ void operator()(const f32x4 (&acc)[2][2][4][2], const Unit& u, int wr, int wc, int fr_, int fq_) const {
        ArgsP a_ = A; asm volatile("" : "+s"(a_)); unsigned char* ws_ = a_->ws;
        bf16_t* Q = (bf16_t*)(ws_ + WS_Q); bf16_t* KB = (bf16_t*)(ws_ + WS_KB); bf16_t* VB = (bf16_t*)(ws_ + WS_VB); bf16_t* U = (bf16_t*)(ws_ + WS_U); bf16_t* VG = (bf16_t*)(ws_ + WS_VG);
        const float* qn = a_->in[I_QN]; const float* kn = a_->in[I_KN]; const float* gv = a_->in[I_GN]; const float* ropeC = (const float*)(ws_ + WS_ROPE); const float* ropeS = ropeC + 1024;
        const float qscale = 0.125f * 1.4426950408889634f;
        int t_ = threadIdx.x; asm volatile("" : "+v"(t_)); const int fr = t_ & 15, fq = (t_ >> 4) & 3; (void)fr_; (void)fq_;
        const int slot = 4 * u.pn + wc; const bool isctx = u.pm >= 128;
        const int rowl = wr * 64 + fr;
        const int row0 = u.pm * BM + rowl;
        const int kvrow0 = (isctx ? (u.pm - 128) * 4352 + 4096 : (u.pm >> 4) * 4352 + (u.pm & 15) * 256) + rowl;
        const int dl = 8 * fq;
        if (slot < 10) {
            const float* nw = slot < 8 ? qn : kn; const float osc = slot < 8 ? qscale : 1.0f;
            f32x4 w[2][2];
#pragma unroll
            for (int bj = 0; bj < 2; ++bj)
#pragma unroll
                for (int n = 0; n < 2; ++n) w[bj][n] = *(const f32x4*)(nw + 32 * bj + dl + 4 * n);
#pragma unroll
            for (int ai = 0; ai < 2; ++ai) {
                const int posr = (4 * u.pm + 2 * ai + wr) & 63;
                const f32x4 cr = *(const f32x4*)(ropeC + posr * 16 + 4 * fq), sr = *(const f32x4*)(ropeS + posr * 16 + 4 * fq);
#pragma unroll
                for (int m = 0; m < 4; ++m) {
                    float ss = 0.f;
#pragma unroll
                    for (int bj = 0; bj < 2; ++bj)
#pragma unroll
                        for (int n = 0; n < 2; ++n) { const f32x4 x = acc[ai][bj][m][n]; ss += (x[0] * x[0] + x[1] * x[1]) + (x[2] * x[2] + x[3] * x[3]); }
                    ss = xor32_add(xor16_add(ss));
                    const float r = __builtin_amdgcn_rsqf(ss * (1.0f / 64.0f) + 1e-6f) * osc;
                    const int posc = 16 * m + fr;
                    const f32x4 cc = *(const f32x4*)(ropeC + posc * 16 + 4 * fq), sc = *(const f32x4*)(ropeS + posc * 16 + 4 * fq);
#pragma unroll
                    for (int bj = 0; bj < 2; ++bj) {
                        f32x4 v0 = acc[ai][bj][m][0] * r * w[bj][0], v1 = acc[ai][bj][m][1] * r * w[bj][1];
                        if (!isctx) { const f32x4 c = bj ? cc : cr, s = bj ? sc : sr;
                            const f32x4 o0 = (f32x4){v0[0] * c[0] - v0[1] * s[0], v0[0] * s[0] + v0[1] * c[0], v0[2] * c[1] - v0[3] * s[1], v0[2] * s[1] + v0[3] * c[1]};
                            const f32x4 o1 = (f32x4){v1[0] * c[2] - v1[1] * s[2], v1[0] * s[2] + v1[1] * c[2], v1[2] * c[3] - v1[3] * s[3], v1[2] * s[3] + v1[3] * c[3]};
                            v0 = o0; v1 = o1; }
                        bf16_t* dst = slot < 8 ? Q + (size_t)(row0 + ai * HALF + m * 16) * 512 + slot * 64 + 32 * bj + dl
                                               : KB + (size_t)(kvrow0 + ai * HALF + m * 16) * 128 + (slot - 8) * 64 + 32 * bj + dl;
                        *(u32x4*)dst = pack8(v0, v1);
                    }
                    asm volatile("" ::: "memory");
                }
            }
        } else if (slot < 12) {
#pragma unroll
            for (int ai = 0; ai < 2; ++ai)
#pragma unroll
                for (int m = 0; m < 4; ++m)
#pragma unroll
                    for (int bj = 0; bj < 2; ++bj)
                        *(u32x4*)(VB + (size_t)(kvrow0 + ai * HALF + m * 16) * 128 + (slot - 10) * 64 + 32 * bj + dl) = pack8(acc[ai][bj][m][0], acc[ai][bj][m][1]);
        } else if (slot < 20) {
#pragma unroll
            for (int ai = 0; ai < 2; ++ai)
#pragma unroll
                for (int m = 0; m < 4; ++m)
#pragma unroll
                    for (int bj = 0; bj < 2; ++bj)
                        *(u32x4*)(U + (size_t)(row0 + ai * HALF + m * 16) * 512 + (slot - 12) * 64 + 32 * bj + dl) = pack8(gelu4(acc[ai][bj][m][0]), gelu4(acc[ai][bj][m][1]));
        } else {
            f32x4 w[2][2];
#pragma unroll
            for (int bj = 0; bj < 2; ++bj)
#pragma unroll
                for (int n = 0; n < 2; ++n) w[bj][n] = *(const f32x4*)(gv + (slot - 20) * 64 + 32 * bj + dl + 4 * n);
#pragma unroll
            for (int ai = 0; ai < 2; ++ai)
#pragma unroll
                for (int m = 0; m < 4; ++m) {
                    f32x4 g[2][2]; float ss = 0.f;
#pragma unroll
                    for (int bj = 0; bj < 2; ++bj)
#pragma unroll
                        for (int n = 0; n < 2; ++n) { const f32x4 x = gelu4(acc[ai][bj][m][n]); g[bj][n] = x; ss += (x[0] * x[0] + x[1] * x[1]) + (x[2] * x[2] + x[3] * x[3]); }
                    ss = xor32_add(xor16_add(ss));
                    const float r = __builtin_amdgcn_rsqf(ss * (1.0f / 64.0f) + 1e-6f);
#pragma unroll
                    for (int bj = 0; bj < 2; ++bj)
                        *(u32x4*)(VG + (size_t)(row0 + ai * HALF + m * 16) * 512 + (slot - 20) * 64 + 32 * bj + dl) = pack8(g[bj][0] * r * w[bj][0], g[bj][1] * r * w[bj][1]);
                }
        }
    }
};
constexpr int RS_M = 32768;
__device__ __forceinline__ float row_total(const float* part, int row, int fq) {
    const f32x4 p = *(const f32x4*)(part + ((size_t)fq * RS_M + row) * 4); float t = (p[0] + p[1]) + (p[2] + p[3]); t = xor32_add(xor16_add(t)); return t;
}
template <int V> struct EpiResid {
    static constexpr bool PERM = true, AFTER_DRAIN = false, XNOUT = (V == 4), FINAL = (V == 10), BASE16 = (V != 4);
    ArgsP A; void* outp;
    __device__ __forceinline__ void operator()(f32x4 (&acc)[2][2][4][2], const Unit& u, int wr, int wc, int fr_, int fq_) const {
        int t_ = threadIdx.x; asm volatile("" : "+v"(t_)); const int fr = t_ & 15, fq = (t_ >> 4) & 3; (void)fr_; (void)fq_;
        const int row0 = u.pm * BM + wr * 64 + fr, col0 = u.pn * BM + wc * 32 + 8 * fq, b = u.pm >> 4;
        ArgsP a_ = A; asm volatile("" : "+s"(a_)); unsigned char* ws_ = a_->ws; constexpr int gstride = MODW;
        const float* mods_ = (const float*)(ws_ + WS_MODS); const float* modl_ = mods_ + (V == 10 ? 9 * MODW : 0);
        const float* basef = a_->in[I_X]; const bf16_t* baseh = (const bf16_t*)(ws_ + WS_RES); const float* gate = modl_ + (V == 4 ? GA1 : GA2);
        float* part = (float*)(ws_ + WS_PART) + (size_t)(V == 4 ? 0 : V == 10 ? 3 : 1) * 16 * RS_M;
        bf16_t* xn = (bf16_t*)(ws_ + WS_XN); const float* gnext = (V == 4) ? a_->in[I_GFFN] : a_->in[I_GMIX] + DM; const float* scnext = (V == 4) ? mods_ + SC2 : mods_ + 9 * MODW + SC1;
        unsigned* cnt = (unsigned*)(ws_ + WS_CTL + CTL_CNT); const float* gfin = a_->in[I_GFIN];
        bf16_t* resout = (bf16_t*)outp; float* out = (float*)outp;
        const float* gp = gate + (size_t)b * gstride + col0;
        f32x4 gvv[2][2], gmn[2][2];
#pragma unroll
        for (int bj = 0; bj < 2; ++bj)
#pragma unroll
            for (int n = 0; n < 2; ++n) { gvv[bj][n] = *(const f32x4*)(gp + bj * HALF + n * 4);
                if (XNOUT) gmn[bj][n] = *(const f32x4*)(gnext + col0 + bj * HALF + n * 4) * (*(const f32x4*)(scnext + (size_t)b * gstride + col0 + bj * HALF + n * 4) + 1.0f); }
        float ssv[2][4];
        f32x4 bsA[2][2], bsB[2][2], bsC[2][2], bsD[2][2], bsE[2][2], bsF[2][2], bsG[2][2], bsH[2][2];
        u32x4 hsA[2], hsB[2], hsC[2], hsD[2], hsE[2], hsF[2], hsG[2], hsH[2];
#define ER_LOAD(X, p) do { const size_t off_ = (size_t)(row0 + ((p) >> 2) * HALF + ((p) & 3) * 16) * 1024 + col0; \
            _Pragma("unroll") for (int bj = 0; bj < 2; ++bj) { if (BASE16) { if (FINAL) hs##X[bj] = __builtin_nontemporal_load((const u32x4*)(baseh + off_ + bj * HALF)); else hs##X[bj] = *(const u32x4*)(baseh + off_ + bj * HALF); } \
                else { bs##X[bj][0] = __builtin_nontemporal_load((const f32x4*)(basef + off_ + bj * HALF)); bs##X[bj][1] = __builtin_nontemporal_load((const f32x4*)(basef + off_ + bj * HALF + 4)); } } } while (0)
#define ER_WORK(X, p) do { const int ai = (p) >> 2, m = (p) & 3; const size_t off_ = (size_t)(row0 + ai * HALF + m * 16) * 1024 + col0; float ss = 0.f; \
            _Pragma("unroll") for (int bj = 0; bj < 2; ++bj) { f32x4 b0, b1; \
                if (BASE16) { const u32x4 h = hs##X[bj]; b0 = (f32x4){__builtin_bit_cast(float, h.x << 16), __builtin_bit_cast(float, h.x & 0xffff0000u), __builtin_bit_cast(float, h.y << 16), __builtin_bit_cast(float, h.y & 0xffff0000u)}; \
                    b1 = (f32x4){__builtin_bit_cast(float, h.z << 16), __builtin_bit_cast(float, h.z & 0xffff0000u), __builtin_bit_cast(float, h.w << 16), __builtin_bit_cast(float, h.w & 0xffff0000u)}; } \
                else { b0 = bs##X[bj][0]; b1 = bs##X[bj][1]; } \
                const f32x4 x0 = b0 + gvv[bj][0] * acc[ai][bj][m][0], x1 = b1 + gvv[bj][1] * acc[ai][bj][m][1]; \
                ss += ((x0[0] * x0[0] + x0[1] * x0[1]) + (x0[2] * x0[2] + x0[3] * x0[3])) + ((x1[0] * x1[0] + x1[1] * x1[1]) + (x1[2] * x1[2] + x1[3] * x1[3])); \
                if (FINAL) { acc[ai][bj][m][0] = x0; acc[ai][bj][m][1] = x1; } else *(u32x4*)(resout + off_ + bj * HALF) = pack8(x0, x1); \
                if (XNOUT) *(u32x4*)(xn + off_ + bj * HALF) = pack8(x0 * gmn[bj][0], x1 * gmn[bj][1]); } \
            ss = xor32_add(xor16_add(ss)); ssv[ai][m] = ss; } while (0)
#define ER_FENCE asm volatile("" ::: "memory")
        if constexpr (FINAL) {
            ER_LOAD(A, 0); ER_LOAD(B, 1); ER_LOAD(C, 2); ER_LOAD(D, 3); ER_LOAD(E, 4); ER_LOAD(F, 5); ER_LOAD(G, 6); ER_LOAD(H, 7); ER_FENCE;
            ER_WORK(A, 0); ER_WORK(B, 1); ER_WORK(C, 2); ER_WORK(D, 3); ER_WORK(E, 4); ER_WORK(F, 5); ER_WORK(G, 6); ER_WORK(H, 7);
        } else if constexpr (BASE16) {
            ER_LOAD(A, 0); ER_LOAD(B, 1); ER_LOAD(C, 2); ER_LOAD(D, 3); ER_FENCE;
            ER_LOAD(E, 4); ER_FENCE; ER_WORK(A, 0); ER_FENCE;
            ER_LOAD(A, 5); ER_FENCE; ER_WORK(B, 1); ER_FENCE;
            ER_LOAD(B, 6); ER_FENCE; ER_WORK(C, 2); ER_FENCE;
            ER_LOAD(C, 7); ER_FENCE; ER_WORK(D, 3); ER_FENCE;
            ER_WORK(E, 4); ER_FENCE; ER_WORK(A, 5); ER_FENCE; ER_WORK(B, 6); ER_FENCE; ER_WORK(C, 7);
        } else {
            ER_LOAD(A, 0); ER_LOAD(B, 1); ER_FENCE;
            ER_LOAD(C, 2); ER_FENCE; ER_WORK(A, 0); ER_FENCE;
            ER_LOAD(A, 3); ER_FENCE; ER_WORK(B, 1); ER_FENCE;
            ER_LOAD(B, 4); ER_FENCE; ER_WORK(C, 2); ER_FENCE;
            ER_LOAD(C, 5); ER_FENCE; ER_WORK(A, 3); ER_FENCE;
            ER_LOAD(A, 6); ER_FENCE; ER_WORK(B, 4); ER_FENCE;
            ER_LOAD(B, 7); ER_FENCE; ER_WORK(C, 5); ER_FENCE;
            ER_WORK(A, 6); ER_FENCE;
            ER_WORK(B, 7);
        }
#undef ER_FENCE
#undef ER_LOAD
#undef ER_WORK
        if (fq == 0) {
#pragma unroll
            for (int ai = 0; ai < 2; ++ai)
#pragma unroll
                for (int m = 0; m < 4; ++m) { float* pp = part + ((size_t)u.pn * RS_M + (row0 + ai * HALF + m * 16)) * 4 + wc;
                    if (FINAL) __hip_atomic_store(pp, ssv[ai][m], __ATOMIC_RELAXED, __HIP_MEMORY_SCOPE_AGENT); else *pp = ssv[ai][m]; }
        }
        if (FINAL) {
            asm volatile("s_waitcnt vmcnt(0)" ::: "memory");
            unsigned* cw = cnt + 64 * u.pm;
            if (fr == 0 && fq == 0) __hip_atomic_fetch_add(cw, 1u, __ATOMIC_RELAXED, __HIP_MEMORY_SCOPE_AGENT);
            { unsigned sp = 0; while ((unsigned)__builtin_amdgcn_readfirstlane(__hip_atomic_load(cw, __ATOMIC_RELAXED, __HIP_MEMORY_SCOPE_AGENT)) < 32u) { __builtin_amdgcn_s_sleep(2); if (++sp > (1u << 22)) break; } }
            f32x4 gf[2][2];
#pragma unroll
            for (int bj = 0; bj < 2; ++bj)
#pragma unroll
                for (int n = 0; n < 2; ++n) gf[bj][n] = *(const f32x4*)(gfin + col0 + bj * HALF + n * 4);
            float rr[2][4];
            {
                f32x4 pq[8];
#pragma unroll
                for (int i = 0; i < 8; ++i) { const float* pp = part + ((size_t)fq * RS_M + (row0 + (i >> 2) * HALF + (i & 3) * 16)) * 4;
                    asm volatile("global_load_dwordx4 %0, %1, off sc1" : "=v"(pq[i]) : "v"(pp) : "memory"); }
                asm volatile("s_waitcnt vmcnt(0)" : "+v"(pq[0]), "+v"(pq[1]), "+v"(pq[2]), "+v"(pq[3]), "+v"(pq[4]), "+v"(pq[5]), "+v"(pq[6]), "+v"(pq[7]) :: "memory");
#pragma unroll
                for (int i = 0; i < 8; ++i) { float t = (pq[i][0] + pq[i][1]) + (pq[i][2] + pq[i][3]); t = xor32_add(xor16_add(t)); rr[i >> 2][i & 3] = __builtin_amdgcn_rsqf(t * (1.0f / 1024.0f) + 1e-6f); }
            }
#pragma unroll
            for (int ai = 0; ai < 2; ++ai)
#pragma unroll
                for (int m = 0; m < 4; ++m) { const size_t off = (size_t)(row0 + ai * HALF + m * 16) * 1024 + col0;
#pragma unroll
                    for (int bj = 0; bj < 2; ++bj)
#pragma unroll
                        for (int n = 0; n < 2; ++n) *(f32x4*)(out + off + bj * HALF + n * 4) = acc[ai][bj][m][n] * rr[ai][m] * gf[bj][n]; }
        }
    }
};
template <int L> struct EpiSwiglu {
    static constexpr bool PERM = true, AFTER_DRAIN = false;
    ArgsP A; const PG8_LAS float* rtab; int pm0;
    __device__ __forceinline__ void operator()(const f32x4 (&acc)[2][2][4][2], const Unit& u, int wr, int wc, int fr_, int fq_) const {
        int t_ = threadIdx.x; asm volatile("" : "+v"(t_)); const int fr = t_ & 15, fq = (t_ >> 4) & 3; (void)fr_; (void)fq_;
        const int row0 = u.pm * BM + wr * 64 + fr, col0 = u.pn * HALF + wc * 32 + 8 * fq;
        ArgsP a_ = A; asm volatile("" : "+s"(a_)); unsigned char* ws_ = a_->ws; constexpr int ldh = FF;
        bf16_t* H = (bf16_t*)(ws_ + WS_H); const float* rowss = (const float*)(ws_ + WS_PART) + (size_t)(L ? 2 : 0) * 16 * RS_M; const float* bias = (const float*)(ws_ + WS_BIAS) + (size_t)L * 8 * 5632;
        const float* bp = bias + (size_t)(u.pm >> 4) * 5632 + u.pn * BM + wc * 32 + 8 * fq;
        f32x4 bv[2][2];
#pragma unroll
        for (int bj = 0; bj < 2; ++bj)
#pragma unroll
            for (int n = 0; n < 2; ++n) bv[bj][n] = *(const f32x4*)(bp + bj * HALF + 4 * n);
        float rr[2][4]; { const PG8_LAS float* rt = rtab + (u.pm == pm0 ? 0 : 256) + wr * 64 + fr; (void)rowss;
#pragma unroll
            for (int ai = 0; ai < 2; ++ai)
#pragma unroll
                for (int m = 0; m < 4; ++m) rr[ai][m] = rt[ai * HALF + m * 16]; }
#pragma unroll
        for (int ai = 0; ai < 2; ++ai)
#pragma unroll
            for (int m = 0; m < 4; ++m) { const int row = row0 + ai * HALF + m * 16; const float r = rr[ai][m]; f32x4 h[2];
#pragma unroll
                for (int n = 0; n < 2; ++n) { const f32x4 a = acc[ai][0][m][n] * r + bv[0][n], b = acc[ai][1][m][n] * r + bv[1][n]; h[n] = (f32x4){silu1(a[0]) * b[0], silu1(a[1]) * b[1], silu1(a[2]) * b[2], silu1(a[3]) * b[3]}; }
                *(u32x4*)(H + (size_t)row * ldh + col0) = pack8(h[0], h[1]); }
    }
};

struct EpiNull {
    static constexpr bool PERM = true, AFTER_DRAIN = false;
    bf16_t* D;
    __device__ __forceinline__ void operator()(const f32x4 (&acc)[2][2][4][2], const Unit& u, int wr, int wc, int fr_, int fq_) const {
        int t_ = threadIdx.x; asm volatile("" : "+v"(t_)); const int fr = t_ & 15, fq = (t_ >> 4) & 3; (void)fr_; (void)fq_;
        const int row0 = u.pm * BM + wr * 64 + fr, col0 = u.pn * BM + wc * 32 + 8 * fq;
#pragma unroll
        for (int ai = 0; ai < 2; ++ai)
#pragma unroll
            for (int m = 0; m < 4; ++m)
#pragma unroll
                for (int bj = 0; bj < 2; ++bj) *(u32x4*)(D + (size_t)(row0 + ai * HALF + m * 16) * 1024 + col0 + bj * HALF) = pack8(acc[ai][bj][m][0], acc[ai][bj][m][1]);
    }
};
struct EpiNullWide {
    static constexpr bool PERM = true, AFTER_DRAIN = false;
    bf16_t* D;
    __device__ __forceinline__ void operator()(const f32x4 (&acc)[2][2][4][2], const Unit& u, int wr, int wc, int fr_, int fq_) const {
        int t_ = threadIdx.x; asm volatile("" : "+v"(t_)); const int fr = t_ & 15, fq = (t_ >> 4) & 3; (void)fr_; (void)fq_;
        const int row0 = u.pm * BM + wr * 64 + fr, col0 = u.pn * HALF + wc * 32 + 8 * fq;
#pragma unroll
        for (int ai = 0; ai < 2; ++ai)
#pragma unroll
            for (int m = 0; m < 4; ++m) *(u32x4*)(D + (size_t)(row0 + ai * HALF + m * 16) * 2816 + col0) = pack8(acc[ai][0][m][0] + acc[ai][1][m][0], acc[ai][0][m][1] + acc[ai][1][m][1]);
    }
};
struct EpiZ {
    static constexpr bool PERM = true, AFTER_DRAIN = false;
    ArgsP A;
    __device__ __forceinline__ void operator()(const f32x4 (&acc)[2][2][4][2], const Unit& u, int wr, int wc, int fr_, int fq_) const {
        int t_ = threadIdx.x; asm volatile("" : "+v"(t_)); const int fr = t_ & 15, fq = (t_ >> 4) & 3; (void)fr_; (void)fq_;
        const int row0 = u.pm * BM + wr * 64 + fr, col0 = u.pn * BM + wc * 32 + 8 * fq;
        ArgsP a_ = A; asm volatile("" : "+s"(a_)); unsigned char* ws_ = a_->ws; bf16_t* Z = (bf16_t*)(ws_ + WS_AM);
#pragma unroll
        for (int ai = 0; ai < 2; ++ai)
#pragma unroll
            for (int m = 0; m < 4; ++m)
#pragma unroll
                for (int bj = 0; bj < 2; ++bj) *(u32x4*)(Z + (size_t)(row0 + ai * HALF + m * 16) * 1024 + col0 + bj * HALF) = pack8(acc[ai][bj][m][0], acc[ai][bj][m][1]);
    }
};

template <class Epi, class Sched, bool ALIGN_EPI = false, bool SP2 = false>
__device__ __forceinline__ void gemm_phase(PG8_LAS unsigned char* lds, const Gemm g, const Sched& S, const Epi& E) {
    int tid_ = threadIdx.x; asm volatile("" : "+v"(tid_));
    const int tid = tid_, wid = __builtin_amdgcn_readfirstlane(tid >> 6), lane = tid & 63, wr = wid >> 2, wc = wid & 3, fr = lane & 15, fq = lane >> 4;
    const int K = g.K, nt = K / BK;
    unsigned voffA[2], voffB[2];
#pragma unroll
    for (int i = 0; i < 2; ++i) { int R, C; stage_rc(tid * 16 + i * 8192, R, C); const int Rb = Epi::PERM ? ((R & ~31) + perm32(R & 31)) : R;
        voffA[i] = (unsigned)(R * g.lda + C) * 2u; voffB[i] = (unsigned)(Rb * K + C) * 2u; }
    const size_t kstep = (size_t)(BK * 2);
    const size_t hsA = (size_t)HALF * g.lda * 2, hsB = (size_t)HALF * K * 2;
    const size_t tsA = 2 * hsA, tsB = 2 * hsB;
    const unsigned ldsw = (unsigned)wid * 1024u;
    const int aoff = lds_byte(wr * 64 + fr, fq * 8), boff = lds_byte(wc * 32 + fr, fq * 8);
#define PG8_SA(b, h) (((b) * 2 + (h)) * HTB)
#define PG8_SB(b, h) ((4 + (b) * 2 + (h)) * HTB)
#define PG8_STAGE(bufoff, gbase, voff) do { _Pragma("unroll") for (int _i = 0; _i < 2; ++_i) \
        __builtin_amdgcn_global_load_lds((const unsigned*)((const char*)(gbase) + (voff)[_i]), (PG8_LAS unsigned*)(lds + (bufoff) + ldsw + _i * 8192), 16, 0, 0); } while (0)
#define PG8_LDA(dst, b, h) do { _Pragma("unroll") for (int m = 0; m < 4; ++m) _Pragma("unroll") for (int k = 0; k < 2; ++k) dst[m][k] = *(const PG8_LAS bf16x8*)(lds + PG8_SA(b, h) + aoff + m * 2048 + k * 1024); } while (0)
#define PG8_LDB(dst, b, h) do { _Pragma("unroll") for (int n = 0; n < 2; ++n) _Pragma("unroll") for (int k = 0; k < 2; ++k) dst[n][k] = *(const PG8_LAS bf16x8*)(lds + PG8_SB(b, h) + boff + n * 2048 + k * 1024); } while (0)
#define PG8_MMA(ai, bj, At, Bt) do { __builtin_amdgcn_s_setprio(1); _Pragma("unroll") for (int m = 0; m < 4; ++m) _Pragma("unroll") for (int n = 0; n < 2; ++n) _Pragma("unroll") for (int k = 0; k < 2; ++k) \
        acc[ai][bj][m][n] = __builtin_amdgcn_mfma_f32_16x16x32_bf16(Bt[n][k], At[m][k], acc[ai][bj][m][n], 0, 0, 0); __builtin_amdgcn_s_setprio(0); } while (0)
#define PG8_WAIT_V(n) asm volatile("s_waitcnt vmcnt(" #n ")" ::: "memory")
#define PG8_WAIT_L(n) asm volatile("s_waitcnt lgkmcnt(" #n ")" ::: "memory")
#define PG8_BAR __builtin_amdgcn_s_barrier()
#define PG8_SCHED __builtin_amdgcn_sched_barrier(0)
    Unit cur, nxt; int ui = 0;
    if (!S.next(0, cur)) return;
    f32x4 acc[2][2][4][2];
#pragma unroll
    for (int a = 0; a < 2; ++a)
#pragma unroll
        for (int b = 0; b < 2; ++b)
#pragma unroll
            for (int m = 0; m < 4; ++m)
#pragma unroll
                for (int n = 0; n < 2; ++n) acc[a][b][m][n] = (f32x4){0.f, 0.f, 0.f, 0.f};
    bf16x8 At[4][2], B0[2][2], B1[2][2];
    const char* cA = (const char*)g.A + (size_t)cur.pm * tsA + (size_t)cur.pn * g.a_pn_bytes; const char* cB = (const char*)g.Bt + (size_t)cur.pn * tsB + (size_t)(cur.pm >> 4) * g.b_batch_bytes;
    S.a_ready(cur);
    if constexpr (SP2) {
        PG8_STAGE(PG8_SB(0, 0), cB, voffB); PG8_STAGE(PG8_SB(0, 1), cB + hsB, voffB); PG8_STAGE(PG8_SA(0, 0), cA, voffA); PG8_STAGE(PG8_SA(0, 1), cA + hsA, voffA);
        if (wr == 1) PG8_BAR;
        PG8_WAIT_V(2); PG8_BAR;
        PG8_STAGE(PG8_SB(1, 0), cB + kstep, voffB); PG8_STAGE(PG8_SA(1, 0), cA + kstep, voffA); PG8_STAGE(PG8_SB(1, 1), cB + hsB + kstep, voffB);
        PG8_WAIT_V(6); PG8_BAR;
    } else {
        PG8_STAGE(PG8_SB(0, 0), cB, voffB); PG8_STAGE(PG8_SA(0, 0), cA, voffA); PG8_STAGE(PG8_SB(0, 1), cB + hsB, voffB); PG8_STAGE(PG8_SA(0, 1), cA + hsA, voffA);
        if (wr == 1) PG8_BAR;
        PG8_WAIT_V(4); PG8_BAR;
        PG8_STAGE(PG8_SB(1, 0), cB + kstep, voffB); PG8_STAGE(PG8_SA(1, 0), cA + kstep, voffA); PG8_STAGE(PG8_SB(1, 1), cB + hsB + kstep, voffB);
        PG8_WAIT_V(6); PG8_BAR;
    }
    for (;;) {
        const bool has_next = S.next(ui + 1, nxt);
        const char* nA = has_next ? (const char*)g.A + (size_t)nxt.pm * tsA + (size_t)nxt.pn * g.a_pn_bytes : cA; const char* nB = has_next ? (const char*)g.Bt + (size_t)nxt.pn * tsB + (size_t)(nxt.pm >> 4) * g.b_batch_bytes : cB;
#pragma unroll 1
        for (int t = 0; t < nt; t += 2) {
            const bool last = (t == nt - 2);
            const char* a1 = cA + (size_t)(t + 1) * kstep;
            const char* a2 = last ? nA : cA + (size_t)(t + 2) * kstep; const char* b2 = last ? nB : cB + (size_t)(t + 2) * kstep;
            const char* a3 = a2 + kstep; const char* b3 = b2 + kstep;
            if (last && has_next) S.a_ready(nxt);
            if constexpr (SP2) {
            PG8_LDB(B0, 0, 0); PG8_LDB(B1, 0, 1); PG8_SCHED; PG8_LDA(At, 0, 0); PG8_STAGE(PG8_SA(1, 1), a1 + hsA, voffA);
            PG8_WAIT_V(8); PG8_WAIT_L(0); PG8_BAR; PG8_MMA(0, 0, At, B0); PG8_MMA(0, 1, At, B1); PG8_BAR; PG8_SCHED;
            PG8_LDA(At, 0, 1); PG8_STAGE(PG8_SB(0, 0), b2, voffB); PG8_STAGE(PG8_SB(0, 1), b2 + hsB, voffB); PG8_STAGE(PG8_SA(0, 0), a2, voffA);
            PG8_WAIT_V(8); PG8_WAIT_L(0); PG8_BAR; PG8_MMA(1, 0, At, B0); PG8_MMA(1, 1, At, B1); PG8_BAR; PG8_SCHED;
            PG8_LDB(B0, 1, 0); PG8_LDB(B1, 1, 1); PG8_SCHED; PG8_LDA(At, 1, 0); PG8_STAGE(PG8_SA(0, 1), a2 + hsA, voffA);
            PG8_WAIT_V(8); PG8_WAIT_L(0); PG8_BAR; PG8_MMA(0, 0, At, B0); PG8_MMA(0, 1, At, B1); PG8_BAR; PG8_SCHED;
            PG8_LDA(At, 1, 1); PG8_STAGE(PG8_SB(1, 0), b3, voffB); PG8_STAGE(PG8_SB(1, 1), b3 + hsB, voffB); PG8_STAGE(PG8_SA(1, 0), a3, voffA);
            PG8_WAIT_V(8); PG8_WAIT_L(0); PG8_BAR; PG8_MMA(1, 0, At, B0); PG8_MMA(1, 1, At, B1); PG8_BAR; PG8_SCHED;
            } else {
            PG8_LDB(B0, 0, 0); PG8_SCHED; PG8_LDA(At, 0, 0); PG8_STAGE(PG8_SA(1, 1), a1 + hsA, voffA);
            PG8_WAIT_L(8); PG8_BAR; PG8_WAIT_L(0); PG8_MMA(0, 0, At, B0); PG8_BAR; PG8_SCHED;
            PG8_LDB(B1, 0, 1); PG8_STAGE(PG8_SB(0, 0), b2, voffB);
            PG8_BAR; PG8_WAIT_L(0); PG8_MMA(0, 1, At, B1); PG8_BAR;
            PG8_LDA(At, 0, 1); PG8_STAGE(PG8_SA(0, 0), a2, voffA);
            PG8_BAR; PG8_WAIT_L(0); PG8_MMA(1, 0, At, B0); PG8_BAR; PG8_SCHED;
            PG8_STAGE(PG8_SB(0, 1), b2 + hsB, voffB);
            PG8_WAIT_V(6); PG8_BAR; PG8_MMA(1, 1, At, B1); PG8_BAR;
            PG8_LDB(B0, 1, 0); PG8_SCHED; PG8_LDA(At, 1, 0); PG8_STAGE(PG8_SA(0, 1), a2 + hsA, voffA);
            PG8_WAIT_L(8); PG8_BAR; PG8_WAIT_L(0); PG8_MMA(0, 0, At, B0); PG8_BAR; PG8_SCHED;
            PG8_LDB(B1, 1, 1); PG8_STAGE(PG8_SB(1, 0), b3, voffB);
            PG8_BAR; PG8_WAIT_L(0); PG8_MMA(0, 1, At, B1); PG8_BAR;
            PG8_LDA(At, 1, 1); PG8_STAGE(PG8_SA(1, 0), a3, voffA);
            PG8_BAR; PG8_WAIT_L(0); PG8_MMA(1, 0, At, B0); PG8_BAR; PG8_SCHED;
            PG8_STAGE(PG8_SB(1, 1), b3 + hsB, voffB);
            PG8_WAIT_V(6); PG8_BAR; PG8_MMA(1, 1, At, B1); PG8_BAR;
            }
        }
        if constexpr (ALIGN_EPI) { if (wr == 0) PG8_BAR; }
        if constexpr (!Epi::AFTER_DRAIN) { E(acc, cur, wr, wc, fr, fq); S.done(cur); }
        if (!has_next) break;
#pragma unroll
        for (int a = 0; a < 2; ++a)
#pragma unroll
            for (int b = 0; b < 2; ++b)
#pragma unroll
                for (int m = 0; m < 4; ++m)
#pragma unroll
                    for (int n = 0; n < 2; ++n) acc[a][b][m][n] = (f32x4){0.f, 0.f, 0.f, 0.f};
        cur = nxt; cA = nA; cB = nB; ++ui;
        if constexpr (ALIGN_EPI) { if (wr == 1) PG8_BAR; }
    }
    PG8_WAIT_V(0);
    if constexpr (!ALIGN_EPI) { if (wr == 0) PG8_BAR; }
    PG8_BAR;
    if constexpr (Epi::AFTER_DRAIN) { E.fused(acc, cur, wr, wc, fr, fq, lds, wid, lane); S.done(cur); }
#undef PG8_SA
#undef PG8_SB
#undef PG8_STAGE
#undef PG8_LDA
#undef PG8_LDB
#undef PG8_MMA
#undef PG8_WAIT_V
#undef PG8_WAIT_L
#undef PG8_BAR
#undef PG8_SCHED
}
}
namespace attn_body {
using bf16=__hip_bfloat16;
using bf16x8=__attribute__((ext_vector_type(8)))short;
using s16x4=__attribute__((ext_vector_type(4)))short;
using f32x16=__attribute__((ext_vector_type(16)))float;
using u32x4=__attribute__((ext_vector_type(4)))unsigned;
constexpr int BATCH=8,NHEAD=8,NKVH=2,SEQ=4096,SKV=4352,D=64,QP=512,KP=128,OP=1024;
constexpr int NW=8,QBLK=32,QB=QBLK*NW,KVBLK=64,NQB=SEQ/QB;
constexpr int ATTN_UNIT_ROWS=QB;
__device__ __forceinline__ int crow(int r,int hi){return (r&3)+8*(r>>2)+4*hi;}
#define SBAR() __builtin_amdgcn_sched_barrier(0)
constexpr int NSLOT=3, SLOTB=8192;
constexpr int LDS_K=0, LDS_V=NSLOT*SLOTB, LDS_WS=2*NSLOT*SLOTB, LDS_OST=LDS_WS+NW*64*4, LDS_BYTES=LDS_OST+NW*4096;
constexpr float C2=0.125f*1.4426950408889634f;
__device__ __forceinline__ void glds16(const void*gsrc,unsigned lds_dst){unsigned keep;
  asm volatile("s_mov_b32 %0, m0\n\ts_mov_b32 m0, %2\n\ts_nop 0\n\tglobal_load_lds_dwordx4 %1, off\n\ts_mov_b32 m0, %0":"=&s"(keep):"v"(gsrc),"s"(lds_dst):"memory");}
__device__ __forceinline__ void glds16_nt(const void*gsrc,unsigned lds_dst){unsigned keep;
  asm volatile("s_mov_b32 %0, m0\n\ts_mov_b32 m0, %2\n\ts_nop 0\n\tglobal_load_lds_dwordx4 %1, off nt\n\ts_mov_b32 m0, %0":"=&s"(keep):"v"(gsrc),"s"(lds_dst):"memory");}
__device__ __forceinline__ float max3f(float a,float b,float c){float r;asm("v_max3_f32 %0, %1, %2, %3":"=v"(r):"v"(a),"v"(b),"v"(c));return r;}
__device__ __forceinline__ float max2f(float a,float b){float r;asm("v_max_f32_e32 %0, %1, %2":"=v"(r):"v"(a),"v"(b));return r;}
__device__ __forceinline__ float fadd_s(float a,float b){float r;asm("v_add_f32_e32 %0, %1, %2":"=v"(r):"v"(a),"v"(b));return r;}
__device__ __forceinline__ float fsub_s(float a,float b){float r;asm("v_sub_f32_e32 %0, %1, %2":"=v"(r):"v"(a),"v"(b));return r;}
typedef float f32x2_t __attribute__((ext_vector_type(2))); typedef __bf16 bf16x2_t __attribute__((ext_vector_type(2)));
__device__ __forceinline__ unsigned cvtpk_s(float lo,float hi){f32x2_t v={lo,hi};bf16x2_t b=__builtin_convertvector(v,bf16x2_t);return __builtin_bit_cast(unsigned,b);}
#define WAIT_BAR(N) asm volatile("s_waitcnt vmcnt(" #N ") lgkmcnt(0)\n\ts_barrier":::"memory")

__device__ __forceinline__ void qkt(f32x16&p0,f32x16&p1,const char*Kslot,const bf16x8*qr,const f32x16&negm,int r32,int hi){
  const char*kb=Kslot+hi*1024+r32*16;
  #pragma unroll
  for(int d0=0;d0<4;++d0){
    const bf16x8 b0=*reinterpret_cast<const bf16x8*>(kb+d0*2048);
    const bf16x8 b1=*reinterpret_cast<const bf16x8*>(kb+d0*2048+512);
    if(d0==0){p0=__builtin_amdgcn_mfma_f32_32x32x16_bf16(b0,qr[0],negm,0,0,0);p1=__builtin_amdgcn_mfma_f32_32x32x16_bf16(b1,qr[0],negm,0,0,0);}
    else{p0=__builtin_amdgcn_mfma_f32_32x32x16_bf16(b0,qr[d0],p0,0,0,0);p1=__builtin_amdgcn_mfma_f32_32x32x16_bf16(b1,qr[d0],p1,0,0,0);}}
}
typedef __attribute__((address_space(3))) const char* lds_cptr;
typedef short v4i16_t __attribute__((ext_vector_type(4)));
__device__ __forceinline__ void kload8(bf16x8*kf,lds_cptr kp){
  kf[0]=*(const __attribute__((address_space(3))) bf16x8*)(kp);      kf[1]=*(const __attribute__((address_space(3))) bf16x8*)(kp+512);
  kf[2]=*(const __attribute__((address_space(3))) bf16x8*)(kp+2048); kf[3]=*(const __attribute__((address_space(3))) bf16x8*)(kp+2560);
  kf[4]=*(const __attribute__((address_space(3))) bf16x8*)(kp+4096); kf[5]=*(const __attribute__((address_space(3))) bf16x8*)(kp+4608);
  kf[6]=*(const __attribute__((address_space(3))) bf16x8*)(kp+6144); kf[7]=*(const __attribute__((address_space(3))) bf16x8*)(kp+6656);
}
__device__ __forceinline__ void kload2(bf16x8*kf,lds_cptr kp,int j){ kf[2*j]=*(const __attribute__((address_space(3))) bf16x8*)(kp+j*2048); kf[2*j+1]=*(const __attribute__((address_space(3))) bf16x8*)(kp+j*2048+512); }
__device__ __forceinline__ s16x4 vtr(lds_cptr p){ return __builtin_bit_cast(s16x4,__builtin_amdgcn_ds_read_tr16_b64_v4i16((__attribute__((address_space(3))) v4i16_t*)p)); }
__device__ __forceinline__ float rowmax(const f32x16&p0,const f32x16&p1){
  float a=max3f(p0[0],p0[1],p1[0]),b=max3f(p0[2],p0[3],p1[1]);a=max3f(a,p1[2],p1[3]);
  #pragma unroll
  for(int r=4;r<16;r+=4){a=max3f(a,p0[r],p0[r+1]);b=max3f(b,p0[r+2],p0[r+3]);a=max3f(a,p1[r],p1[r+1]);b=max3f(b,p1[r+2],p1[r+3]);}
  const float m=max2f(a,b);
  auto rr=__builtin_amdgcn_permlane32_swap(__float_as_uint(m),__float_as_uint(m),false,false);
  return max2f(__uint_as_float(rr[0]),__uint_as_float(rr[1]));
}
__device__ __forceinline__ void pv(f32x16*o,int vb,bf16x8 pa0,bf16x8 pa1,bf16x8 pa2,bf16x8 pa3){
  #pragma unroll
  for(int d0=0;d0<2;++d0){s16x4 lo[4],hi[4];
    #pragma unroll
    for(int ks=0;ks<4;++ks){
      asm volatile("ds_read_b64_tr_b16 %0,%1 offset:%c2":"=&v"(lo[ks]):"v"(vb),"i"(d0*4096+ks*1024):"memory");
      asm volatile("ds_read_b64_tr_b16 %0,%1 offset:%c2":"=&v"(hi[ks]):"v"(vb),"i"(d0*4096+ks*1024+512):"memory");}
    asm volatile("s_waitcnt lgkmcnt(0)":::"memory");SBAR();
    #define PK(k) (bf16x8){lo[k][0],lo[k][1],lo[k][2],lo[k][3],hi[k][0],hi[k][1],hi[k][2],hi[k][3]}
    o[d0]=__builtin_amdgcn_mfma_f32_32x32x16_bf16(pa0,PK(0),o[d0],0,0,0);
    o[d0]=__builtin_amdgcn_mfma_f32_32x32x16_bf16(pa1,PK(1),o[d0],0,0,0);
    o[d0]=__builtin_amdgcn_mfma_f32_32x32x16_bf16(pa2,PK(2),o[d0],0,0,0);
    o[d0]=__builtin_amdgcn_mfma_f32_32x32x16_bf16(pa3,PK(3),o[d0],0,0,0);
    #undef PK
  }
}

#ifndef ATTN_STORE16
#define ATTN_STORE16(p,v) (*(u32x4*)(p)=(v))
#endif
template<int THRL,bool FIX> __device__ __forceinline__ void attn_unit(int b,int h,int qb,const bf16*Q,const bf16*__restrict__ K,const bf16*__restrict__ V,bf16*O,char*shm,float sref){
  int tid_=threadIdx.x; asm volatile("":"+v"(tid_)); const int tid=tid_,lane=tid&63,r32=lane&31,hi=lane>>5; const int wid=__builtin_amdgcn_readfirstlane(tid>>6);
  const long rowbase=(long)b*SEQ, kvbase=(long)b*SKV; const int q0=qb*QB;
  const bf16*Qw=Q+(rowbase+q0+wid*QBLK)*QP+h*D;
  const bf16*Kh=K+kvbase*KP+(h/(NHEAD/NKVH))*D,*Vh=V+kvbase*KP+(h/(NHEAD/NKVH))*D;
  const unsigned lds0=(unsigned)(uintptr_t)shm;
  float*wsf=(float*)(shm+LDS_WS)+wid*64;
  const bf16*ksrc=Kh+(long)lane*KP+wid*8;
  const bf16*vsrc=Vh+(long)(16*(wid&3)+(lane>>2))*KP+(wid>>2)*32+(lane&3)*8;
  const unsigned kdst=lds0+LDS_K+wid*1024, vdst=lds0+LDS_V+wid*1024;
  #define DMA_K(t,slot) glds16(ksrc+(long)(t)*KVBLK*KP,(unsigned)__builtin_amdgcn_readfirstlane(kdst+(slot)))
  #define DMA_V(t,slot) glds16(vsrc+(long)(t)*KVBLK*KP,(unsigned)__builtin_amdgcn_readfirstlane(vdst+(slot)))
  const int vb0=(int)(lds0+LDS_V)+((lane>>4)&1)*32+(lane&3)*8+(4*hi+((lane&15)>>2))*64;
  const char*Kbase=shm+LDS_K; bf16x8 kf[8];
  const lds_cptr shm3=(lds_cptr)shm; const lds_cptr kp0=shm3+LDS_K+hi*1024+r32*16; const lds_cptr vp0=shm3+LDS_V+((lane>>4)&1)*32+(lane&3)*8+(4*hi+((lane&15)>>2))*64;
  constexpr int NT=SKV/KVBLK;
  DMA_K(0,0);DMA_V(0,0);DMA_K(1,SLOTB);
  bf16x8 qr[4];
  #pragma unroll
  for(int d0=0;d0<4;++d0)qr[d0]=__builtin_nontemporal_load(reinterpret_cast<const bf16x8*>(&Qw[(long)r32*QP+d0*16+hi*8]));
  float mhat=0.f,l_reg=0.f;f32x16 o[2];o[0]=f32x16{};o[1]=f32x16{};f32x16 negm=f32x16{};
  if constexpr(FIX){ _Pragma("unroll") for(int r=0;r<16;++r)negm[r]=-sref; }
  asm volatile("":"+v"(negm));
  #define CMASK(P0,P1,t) do{}while(0)
  bool resc=false;
  #define START(P0,P1) do{ resc=false; if constexpr(!FIX) \
    { const float rm=rowmax(P0,P1); const float dl=rm; mhat=fadd_s(mhat,dl); \
      _Pragma("unroll") for(int r=0;r<16;++r){P0[r]=fsub_s(P0[r],dl);P1[r]=fsub_s(P1[r],dl);} \
      _Pragma("unroll") for(int r=0;r<16;++r)negm[r]=-mhat; asm volatile("":"+v"(negm)); } \
    _Pragma("unroll") for(int r=0;r<16;++r)P0[r]=__builtin_amdgcn_exp2f(P0[r]); }while(0)
  #define RESC() do{ if constexpr(!FIX) if(resc){ asm volatile("s_waitcnt lgkmcnt(0)":::"memory"); \
      _Pragma("unroll") for(int d_=0;d_<2;++d_) _Pragma("unroll") for(int r=0;r<16;++r)o[d_][r]*=wsf[crow(r,hi)]; } }while(0)
  f32x16 pA0,pA1,pB0,pB1;
  int sl_prev=0,sl_cur=0,sl_next=SLOTB;
  #define ROT() do{sl_prev=sl_cur;sl_cur=sl_next;sl_next=(sl_next==(NSLOT-1)*SLOTB)?0:sl_next+SLOTB;}while(0)
  DMA_K(2,2*SLOTB);
  WAIT_BAR(3);
  qkt(pA0,pA1,Kbase,qr,negm,r32,hi);asm volatile("s_nop 15\n\ts_nop 7":"+v"(pA0),"+v"(pA1));CMASK(pA0,pA1,0);
  START(pA0,pA1);
  _Pragma("unroll") for(int r=0;r<16;++r)pA1[r]=__builtin_amdgcn_exp2f(pA1[r]);
  WAIT_BAR(0);
  DMA_K(3,0);DMA_V(1,SLOTB);
  ROT();
  kload8(kf,kp0+sl_cur);
  WAIT_BAR(2);
  s16x4 vlo[8],vhi[8]; u32x4 pw0,pw1,pw2,pw3;
  #define PKW(P,B) cvtpk_s(P[B],P[B+1])
  #define PAF(k) __builtin_bit_cast(bf16x8,pw##k)
  #define VFR(i) (bf16x8){vlo[i][0],vlo[i][1],vlo[i][2],vlo[i][3],vhi[i][0],vhi[i][1],vhi[i][2],vhi[i][3]}
  #define PIN(x) asm volatile("":"+v"(x))
  #define MX3(a,b,c) __builtin_fmaxf(__builtin_fmaxf((a),(b)),(c))
  #define GAPA(MF,A0,A1,A2,A3,W0,W1,PW) do{ MF; sacc+=A0; sacc+=A1; sacc+=A2; sacc+=A3; PIN(sacc); W0; W1; PIN(PW); SBAR(); }while(0)
  #define EX(v) __builtin_amdgcn_exp2f(v)
  #define GAPB(MF,X,B) do{ MF; X[B]=EX(X[B]); X[B+1]=EX(X[B+1]); X[B+2]=EX(X[B+2]); X[B+3]=EX(X[B+3]); PIN(X); SBAR(); }while(0)
  #define VRD(i) do{ vlo[i]=vtr(vp_+(((i)>>2)*4096+((i)&3)*1024)); vhi[i]=vtr(vp_+(((i)>>2)*4096+((i)&3)*1024+512)); }while(0)
  #define KRD(G,j) do{ if(G){ kload2(kf,kp0+sl_next,j); SBAR(); } }while(0)
  #define STEP(C0,C1,P0,P1,t,GK,GV,GL) do{ SBAR(); \
    const lds_cptr vp_=vp0+sl_prev; \
    VRD(0); SBAR(); float sacc=(P0[0]+P0[1]); \
    GAPA(C0=__builtin_amdgcn_mfma_f32_32x32x16_bf16(kf[0],qr[0],negm,0,0,0), P0[2],P0[3],P0[4],P0[5],     pw0[0]=PKW(P0,0), pw0[1]=PKW(P0,2), pw0); \
    VRD(4); SBAR(); GAPA(C1=__builtin_amdgcn_mfma_f32_32x32x16_bf16(kf[1],qr[0],negm,0,0,0), P0[6],P0[7],P0[8],P0[9],     pw0[2]=PKW(P0,4), pw0[3]=PKW(P0,6), pw0); \
    VRD(1); SBAR(); GAPA(C0=__builtin_amdgcn_mfma_f32_32x32x16_bf16(kf[2],qr[1],C0,0,0,0),   P0[10],P0[11],P0[12],P0[13], pw1[0]=PKW(P0,8), pw1[1]=PKW(P0,10), pw1); \
    VRD(5); SBAR(); GAPA(C1=__builtin_amdgcn_mfma_f32_32x32x16_bf16(kf[3],qr[1],C1,0,0,0),   P0[14],P0[15],P1[0],P1[1],   pw1[2]=PKW(P0,12),pw1[3]=PKW(P0,14), pw1); \
    VRD(2); SBAR(); GAPA(C0=__builtin_amdgcn_mfma_f32_32x32x16_bf16(kf[4],qr[2],C0,0,0,0),   P1[2],P1[3],P1[4],P1[5],     pw2[0]=PKW(P1,0), pw2[1]=PKW(P1,2), pw2); \
    VRD(6); SBAR(); GAPA(C1=__builtin_amdgcn_mfma_f32_32x32x16_bf16(kf[5],qr[2],C1,0,0,0),   P1[6],P1[7],P1[8],P1[9],     pw2[2]=PKW(P1,4), pw2[3]=PKW(P1,6), pw2); \
    VRD(3); SBAR(); GAPA(C0=__builtin_amdgcn_mfma_f32_32x32x16_bf16(kf[6],qr[3],C0,0,0,0),   P1[10],P1[11],P1[12],P1[13], pw3[0]=PKW(P1,8), pw3[1]=PKW(P1,10), pw3); \
    VRD(7); SBAR(); GAPA(C1=__builtin_amdgcn_mfma_f32_32x32x16_bf16(kf[7],qr[3],C1,0,0,0),   P1[14],P1[15],0.f,0.f,       pw3[2]=PKW(P1,12),pw3[3]=PKW(P1,14), pw3); \
    l_reg+=sacc; \
    if(GK){DMA_K((t)+3,sl_cur);} if(GV){DMA_V((t)+1,sl_next);} \
    CMASK(C0,C1,t); \
    if constexpr(!FIX) { float a=MX3(C0[0],C0[1],C1[0]),b=MX3(C0[2],C0[3],C1[1]); a=MX3(a,C1[2],C1[3]); \
      _Pragma("unroll") for(int r=4;r<16;r+=4){a=MX3(a,C0[r],C0[r+1]);b=MX3(b,C0[r+2],C0[r+3]);a=MX3(a,C1[r],C1[r+1]);b=MX3(b,C1[r+2],C1[r+3]);} \
      float rm=__builtin_fmaxf(a,b); { auto rr=__builtin_amdgcn_permlane32_swap(__float_as_uint(rm),__float_as_uint(rm),false,false); rm=__builtin_fmaxf(__uint_as_float(rr[0]),__uint_as_float(rr[1])); } \
      resc=false; \
      if(__builtin_expect(__any(rm>(float)THRL),0)){ const float dl=__builtin_fmaxf(rm,0.f); mhat+=dl; \
        _Pragma("unroll") for(int r=0;r<16;++r){C0[r]-=dl;C1[r]-=dl;} \
        _Pragma("unroll") for(int r=0;r<16;++r)negm[r]=-mhat; asm volatile("":"+v"(negm)); \
        const float f=__builtin_amdgcn_exp2f(-dl); l_reg*=f; if(hi==0)wsf[r32]=f; resc=true; } } \
    SBAR(); \
    GAPB(o[0]=__builtin_amdgcn_mfma_f32_32x32x16_bf16(PAF(0),VFR(0),o[0],0,0,0), C0,0); \
    GAPB(o[1]=__builtin_amdgcn_mfma_f32_32x32x16_bf16(PAF(0),VFR(4),o[1],0,0,0), C0,4); \
    KRD(GL,0); GAPB(o[0]=__builtin_amdgcn_mfma_f32_32x32x16_bf16(PAF(1),VFR(1),o[0],0,0,0), C0,8); \
    KRD(GL,1); GAPB(o[1]=__builtin_amdgcn_mfma_f32_32x32x16_bf16(PAF(1),VFR(5),o[1],0,0,0), C0,12); \
    KRD(GL,2); GAPB(o[0]=__builtin_amdgcn_mfma_f32_32x32x16_bf16(PAF(2),VFR(2),o[0],0,0,0), C1,0); \
    KRD(GL,3); GAPB(o[1]=__builtin_amdgcn_mfma_f32_32x32x16_bf16(PAF(2),VFR(6),o[1],0,0,0), C1,4); \
    GAPB(o[0]=__builtin_amdgcn_mfma_f32_32x32x16_bf16(PAF(3),VFR(3),o[0],0,0,0), C1,8); \
    GAPB(o[1]=__builtin_amdgcn_mfma_f32_32x32x16_bf16(PAF(3),VFR(7),o[1],0,0,0), C1,12); \
    }while(0)
  int t=1;
  #undef CMASK
  #define CMASK(P0,P1,t) do{}while(0)
  for(;t+5<NT;t+=2){
    STEP(pB0,pB1,pA0,pA1,t,true,true,true);     WAIT_BAR(2); RESC(); ROT();
    STEP(pA0,pA1,pB0,pB1,t+1,true,true,true);   WAIT_BAR(2); RESC(); ROT();
  }
  #undef CMASK
  #define CMASK(P0,P1,t) do{}while(0)
  #define ENDW(tt) do{ if((tt)+3<NT){WAIT_BAR(2);} else if((tt)+2<NT){WAIT_BAR(1);} else {WAIT_BAR(0);} }while(0)
  for(;t+1<NT;t+=2){
    STEP(pB0,pB1,pA0,pA1,t,(t+3<NT),(t+1<NT),(t+1<NT));       ENDW(t);   RESC(); ROT();
    STEP(pA0,pA1,pB0,pB1,t+1,(t+4<NT),(t+2<NT),(t+2<NT));     ENDW(t+1); RESC(); ROT();
  }
  STEP(pB0,pB1,pA0,pA1,NT-1,false,false,false); RESC();
  { float sacc=pB0[0]+pB0[1]; _Pragma("unroll") for(int r=2;r<16;++r)sacc+=pB0[r]; _Pragma("unroll") for(int r=0;r<16;++r)sacc+=pB1[r]; l_reg+=sacc;
    pw0=(u32x4){PKW(pB0,0),PKW(pB0,2),PKW(pB0,4),PKW(pB0,6)};pw1=(u32x4){PKW(pB0,8),PKW(pB0,10),PKW(pB0,12),PKW(pB0,14)};pw2=(u32x4){PKW(pB1,0),PKW(pB1,2),PKW(pB1,4),PKW(pB1,6)};pw3=(u32x4){PKW(pB1,8),PKW(pB1,10),PKW(pB1,12),PKW(pB1,14)};
    SBAR(); pv(o,vb0+sl_cur,PAF(0),PAF(1),PAF(2),PAF(3)); }
  #undef PKW
  #undef PAF
  #undef VFR
  #undef PIN
  #undef MX3
  #undef GAPA
  #undef GAPB
  #undef EX
  #undef VRD
  #undef KRD
  #undef STEP
  #undef ENDW
  {auto rr=__builtin_amdgcn_permlane32_swap(__float_as_uint(l_reg),__float_as_uint(l_reg),false,false);l_reg=__uint_as_float(rr[0])+__uint_as_float(rr[1]);}
  if(hi==0)wsf[32+r32]=l_reg;asm volatile("s_waitcnt lgkmcnt(0)":::"memory");
  float rli[16];
  #pragma unroll
  for(int r=0;r<16;++r)rli[r]=__builtin_amdgcn_rcpf(wsf[32+crow(r,hi)]);
  bf16*Ow=O+(rowbase+q0+wid*QBLK)*OP+h*D;
  { bf16*stg=(bf16*)(shm+LDS_OST)+wid*2048;
    #pragma unroll
    for(int r=0;r<16;++r){const int orow=crow(r,hi);
      #pragma unroll
      for(int d0=0;d0<2;++d0)stg[orow*64+d0*32+r32]=__float2bfloat16(o[d0][r]*rli[r]);}
    asm volatile("s_waitcnt lgkmcnt(0)":::"memory");
    #pragma unroll
    for(int i=0;i<4;++i){const int row=i*8+(lane>>3),ch=lane&7; const u32x4 v=*(const u32x4*)(stg+row*64+ch*8); ATTN_STORE16(Ow+(long)row*OP+ch*8,v);} }
  asm volatile("s_waitcnt lgkmcnt(0)\n\ts_barrier":::"memory");
  #undef DMA_K
  #undef DMA_V
  #undef CMASK
  #undef START
  #undef RESC
  #undef ROT
}
constexpr int ATTN_LDS_BYTES=LDS_BYTES;
struct AttnTensors { const bf16* Q; const bf16* K; const bf16* V; bf16* O; };
struct AttnUnit { int bh; int qb; };
struct StaticOrder {
  int vcu,G;
  __device__ __forceinline__ explicit StaticOrder(int grid,int v):vcu(v),G(grid){}
  __device__ __forceinline__ bool next(int i,AttnUnit&u)const{ const int per=(BATCH*NHEAD*NQB)/G; if(i>=per)return false; const int x=vcu*per+i; u.bh=(x>>6)*4+((x&63)>>4); u.qb=x&15; return true; }
  __device__ __forceinline__ void a_ready(const AttnUnit&)const{}
  __device__ __forceinline__ void done(const AttnUnit&)const{}
};
template<class Sched,int THRL=8> __device__ __forceinline__ void attn_phase(char*lds,const AttnTensors&T,const Sched&S,const float*qnw,const float*knw){
  AttnUnit u;
  float mq=__builtin_fabsf(qnw[threadIdx.x&63]),mk=__builtin_fabsf(knw[threadIdx.x&63]);
  _Pragma("unroll") for(int o_=1;o_<64;o_<<=1){ mq=__builtin_fmaxf(mq,__shfl_xor(mq,o_)); mk=__builtin_fmaxf(mk,__shfl_xor(mk,o_)); }
  const float sref=C2*64.0f*1.02f*mq*mk;
  const bool fix=__builtin_amdgcn_readfirstlane((int)(sref<=40.0f && sref==sref))!=0;
  if(fix){ for(int i=0;S.next(i,u);++i){ S.a_ready(u); attn_unit<THRL,true>(u.bh/NHEAD,u.bh%NHEAD,u.qb,T.Q,T.K,T.V,T.O,lds,sref); S.done(u); } }
  else   { for(int i=0;S.next(i,u);++i){ S.a_ready(u); attn_unit<THRL,false>(u.bh/NHEAD,u.bh%NHEAD,u.qb,T.Q,T.K,T.V,T.O,lds,0.f); S.done(u); } }
}
#undef SBAR
#undef WAIT_BAR
}
#ifndef PG8_SP2
#define PG8_SP2 true
#endif
#ifndef PG8_ALIGN
#define PG8_ALIGN true
#endif
#define GAS __attribute__((address_space(1)))
#define LAS __attribute__((address_space(3)))
typedef unsigned short bf16;
typedef unsigned v4u __attribute__((ext_vector_type(4)));
typedef unsigned v2u __attribute__((ext_vector_type(2)));
typedef float f32x4 __attribute__((ext_vector_type(4)));
typedef float f32x2 __attribute__((ext_vector_type(2)));
typedef short bf16x8 __attribute__((ext_vector_type(8)));
typedef GAS unsigned gu32;
typedef GAS unsigned long long gu64;
#define RLX_AGENT __ATOMIC_RELAXED, __HIP_MEMORY_SCOPE_AGENT
#define LDS_WAIT() asm volatile("s_waitcnt lgkmcnt(0)" ::: "memory")
#define VM_WAIT() asm volatile("s_waitcnt vmcnt(0)" ::: "memory")
__device__ __forceinline__ unsigned f2bf(float f) { unsigned u = __builtin_bit_cast(unsigned, f); return (u + 0x7fffu + ((u >> 16) & 1u)) >> 16; }
__device__ __forceinline__ unsigned pk2(float lo, float hi) { unsigned r; asm("v_cvt_pk_bf16_f32 %0, %1, %2" : "=v"(r) : "v"(lo), "v"(hi)); return r; }
__device__ __forceinline__ float bf2f(unsigned h) { return __builtin_bit_cast(float, h << 16); }

#define XB_TMO      128
#define XB_XCNT(j)  (256  + 64 * (j))
#define XB_XSUB(j)  (1280 + 64 * (j))
#define XB_XGEN(j)  (2304 + 64 * (j))
#define XB_TOP      3328
#define XB_TOPGEN   3392
#define XCD_BAR_WORDS 3456
#define XB_SPIN_CAP (1u << 18)

__device__ __forceinline__ unsigned xb_ld(unsigned* p)              { return __hip_atomic_load(p, __ATOMIC_RELAXED, __HIP_MEMORY_SCOPE_AGENT); }
__device__ __forceinline__ unsigned xb_add(unsigned* p, unsigned v) { return __hip_atomic_fetch_add(p, v, __ATOMIC_RELAXED, __HIP_MEMORY_SCOPE_AGENT); }
__device__ __forceinline__ unsigned xb_xcc_id() { return (unsigned)__builtin_amdgcn_s_getreg((3 << 11) | 20) & 0xFu; }
#define XB_SPIN(cond, bar) do { unsigned _sp = 0; while (cond) { __builtin_amdgcn_s_sleep(1); \
    if ((++_sp & 255u) == 0u) { if (xb_ld(&(bar)[XB_TMO])) break; if (_sp > XB_SPIN_CAP) { atomicAdd(&(bar)[XB_TMO], 1u); break; } } } } while (0)

struct XcdBarrier {
    unsigned* bar; unsigned x;
    volatile LAS unsigned* st;
};

__device__ __forceinline__ XcdBarrier xcd_barrier_post(unsigned* bar, volatile LAS unsigned* st) {
    XcdBarrier b; b.bar = bar; b.x = xb_xcc_id(); b.st = st;
    if (threadIdx.x == 0) (void)xb_add(&bar[XB_XCNT(b.x)], 1u);
    return b;
}
__device__ __forceinline__ void xcd_barrier_complete(unsigned* bar, unsigned x, unsigned& nloc, unsigned& nx) {
    const unsigned G = gridDim.x * gridDim.y * gridDim.z;
    unsigned sum, cnt, mine, sp = 0u;
    for (;;) {
        sum = 0u; cnt = 0u; mine = 0u;
#pragma unroll
        for (unsigned j = 0; j < 16; ++j) { const unsigned c = xb_ld(&bar[XB_XCNT(j)]); sum += c; cnt += (c > 0u) ? 1u : 0u; mine = (j == x) ? c : mine; }
        if (sum == G) break;
        __builtin_amdgcn_s_sleep(1);
        if ((++sp & 255u) == 0u) { if (xb_ld(&bar[XB_TMO])) break; if (sp > XB_SPIN_CAP) { atomicAdd(&bar[XB_TMO], 1u); break; } }
    }
    nloc = mine > 0u ? mine : 1u; nx = cnt > 0u ? cnt : 1u;
}

__device__ __forceinline__ void xcd_barrier(const XcdBarrier& b) {
    asm volatile("s_waitcnt vmcnt(0)" ::: "memory");
    __syncthreads();
    if (threadIdx.x == 0) {
        unsigned* bar = b.bar;
        __builtin_amdgcn_s_waitcnt(0);
        unsigned nloc = b.st[0], nx = b.st[1];
        if (nloc == 0u) { xcd_barrier_complete(bar, b.x, nloc, nx); b.st[0] = nloc; b.st[1] = nx; }
        const unsigned old = xb_add(&bar[XB_XSUB(b.x)], 1u);
        const unsigned gen = old / nloc;
        if (old + 1u == (gen + 1u) * nloc) {
            __builtin_amdgcn_fence(__ATOMIC_RELEASE, "agent");
            asm volatile("s_waitcnt vmcnt(0)" ::: "memory");
            const unsigned og = xb_add(&bar[XB_TOP], 1u);
            const unsigned tg = og / nx;
            if (og + 1u == (tg + 1u) * nx) xb_add(&bar[XB_TOPGEN], 1u);
            else XB_SPIN(xb_ld(&bar[XB_TOPGEN]) == tg, bar);
            __builtin_amdgcn_fence(__ATOMIC_ACQUIRE, "agent");
            xb_add(&bar[XB_XGEN(b.x)], 1u);
            asm volatile("s_waitcnt vmcnt(0)" ::: "memory");
        } else {
            XB_SPIN(xb_ld(&bar[XB_XGEN(b.x)]) == gen, bar);
            __builtin_amdgcn_fence(__ATOMIC_ACQUIRE, "agent");
            asm volatile("s_waitcnt vmcnt(0)" ::: "memory");
        }
    }
    __syncthreads();
}
struct Frame {
    LAS unsigned char* lds;
    volatile LAS unsigned* MISC;
    gu32* ctl;
    int tid, lane, wave;
    int vcu, G;
};
__device__ __forceinline__ float wave_sum(float v) { return wave_sum64(v); }
__device__ __forceinline__ void p0_transpose_item(const float* W, int ldw, int k0, int n0, bf16* WT, int ldt, int dst_row0, LAS float* scr, int lane) {
#pragma unroll 8
    for (int i = 0; i < 32; ++i) { const int kk = 2 * i + (lane >> 5); scr[kk * 33 + (lane & 31)] = __builtin_nontemporal_load(W + (size_t)(k0 + kk) * ldw + n0 + (lane & 31)); }
    LDS_WAIT(); asm volatile("" ::: "memory");
    const int c = lane & 7;
#pragma unroll
    for (int j = 0; j < 4; ++j) { const int n = (lane >> 3) + 8 * j; const LAS float* s = scr + (8 * c) * 33 + n;
        v4u o; o.x = pk2(s[0 * 33], s[1 * 33]); o.y = pk2(s[2 * 33], s[3 * 33]); o.z = pk2(s[4 * 33], s[5 * 33]); o.w = pk2(s[6 * 33], s[7 * 33]);
        *(GAS v4u*)(WT + (size_t)(dst_row0 + n) * ldt + k0 + 8 * c) = o; }
    LDS_WAIT(); asm volatile("" ::: "memory");
}
constexpr int P0_I_IN = 16 * 56, P0_I_OUT = 16 * 32, P0_I_13 = 16 * 88, P0_I_2 = 44 * 32, P0_I_P = 4 * 8;
constexpr int P0_ITEMS_EARLY = P0_I_IN + P0_I_OUT + 4 * P0_I_P + 2 * P0_I_13 + P0_I_2, P0_ITEMS_ALL = P0_ITEMS_EARLY + 2 * P0_I_13 + P0_I_2;
__device__ __forceinline__ void p0_items(Frame& F, ArgsP ap, int it_lo, int it_hi, int gw, int NGW) {
    unsigned char* ws = ap->ws;
    LAS float* scr = (LAS float*)(F.lds + RING_OFF + F.wave * 16384);
    for (int it = it_lo + gw; it < it_hi; it += NGW) {
        int r = it;
        if (r < P0_I_IN) { const int kb = r / 56, nb = r % 56, f = 32 * nb, slot = f >> 6, bj = (f >> 5) & 1, pn = slot >> 2, wc = slot & 3;
            p0_transpose_item(ap->in[I_WIN], INW, 64 * kb, f, (bf16*)(ws + WS_WIN), DM, 256 * pn + 128 * bj + 32 * wc, scr, F.lane); continue; } r -= P0_I_IN;
        if (r < P0_I_OUT) { const int kb = r / 32, nb = r % 32; p0_transpose_item(ap->in[I_WOUT], DM, 64 * kb, 32 * nb, (bf16*)(ws + WS_WOUT), DM, 32 * nb, scr, F.lane); continue; } r -= P0_I_OUT;
        if (r < 4 * P0_I_P) { const int g = r / P0_I_P, rr = r % P0_I_P, kb = rr / 8, nb = rr % 8;
            p0_transpose_item(ap->in[I_WPOOL] + (size_t)g * 256 * 256, 256, 64 * kb, 32 * nb, (bf16*)(ws + WS_WPOOL), 256, g * 256 + 32 * nb, scr, F.lane); continue; } r -= 4 * P0_I_P;
        const int l = r >= 2 * P0_I_13 + P0_I_2 ? 1 : 0; r -= l * (2 * P0_I_13 + P0_I_2);
        if (r < 2 * P0_I_13) { const int which = r / P0_I_13, rr = r % P0_I_13, kb = rr / 88, nb = rr % 88, n0 = 32 * nb;
            const float* W = ap->in[which ? I_W3 : I_W1] + (size_t)l * DM * FF;
            p0_transpose_item(W, FF, 64 * kb, n0, (bf16*)(ws + WS_W13) + (size_t)l * 5632 * DM, DM, 256 * (n0 >> 7) + 128 * which + (n0 & 127), scr, F.lane); continue; } r -= 2 * P0_I_13;
        { const int kb = r / 32, nb = r % 32;
            p0_transpose_item(ap->in[I_W2] + (size_t)l * FF * DM, DM, 64 * kb, 32 * nb, (bf16*)(ws + WS_W2) + (size_t)l * DM * FF, FF, 32 * nb, scr, F.lane); }
    }
}
__device__ __forceinline__ void p0_prologue(Frame& F, ArgsP ap) {
    unsigned char* ws = ap->ws;
    if (F.vcu < 192) {
        LAS float* sc = (LAS float*)(F.lds + RING_OFF); LAS float* part = sc + 9 * 1024;
        const float* c = ap->in[I_C]; const float* cctx = ap->in[I_CCTX];
        for (int i = F.tid; i < 9 * 1024; i += NWAVES * 64) { const int bb = i >> 10, k = i & 1023; const float v = bb < 8 ? c[bb * 1024 + k] : cctx[k]; sc[i] = v / (1.0f + expf(-v)); }
        __syncthreads();
        const int l = F.vcu / 96, cb = F.vcu % 96, k0 = F.wave * 128;
        const float* w = ap->in[I_WADA] + (size_t)l * DM * MODW + (size_t)k0 * MODW + cb * 64 + F.lane;
        float acc[9];
#pragma unroll
        for (int j = 0; j < 9; ++j) acc[j] = 0.f;
        for (int k = 0; k < 128; k += 8) {
            float wv[8];
#pragma unroll
            for (int q = 0; q < 8; ++q) wv[q] = __builtin_nontemporal_load(w + (size_t)(k + q) * MODW);
#pragma unroll
            for (int j = 0; j < 9; ++j) { const f32x4 s0 = *(const LAS f32x4*)(sc + j * 1024 + k0 + k), s1 = *(const LAS f32x4*)(sc + j * 1024 + k0 + k + 4);
                acc[j] += (s0[0] * wv[0] + s0[1] * wv[1]) + (s0[2] * wv[2] + s0[3] * wv[3]) + (s1[0] * wv[4] + s1[1] * wv[5]) + (s1[2] * wv[6] + s1[3] * wv[7]); }
        }
#pragma unroll
        for (int j = 0; j < 9; ++j) part[(F.wave * 9 + j) * 64 + F.lane] = acc[j];
        __syncthreads();
        float* mods = (float*)(ws + WS_MODS);
        for (int idx = F.tid; idx < 9 * 64; idx += NWAVES * 64) { const int j = idx >> 6, col = idx & 63; float s = 0.f;
#pragma unroll
            for (int wv_ = 0; wv_ < 8; ++wv_) s += part[(wv_ * 9 + j) * 64 + col];
            mods[(size_t)(l * 9 + j) * MODW + cb * 64 + col] = s + ap->in[I_BADA][l * MODW + cb * 64 + col]; }
        __syncthreads();
    } else if (F.vcu == F.G - 1) {
        float* rc = (float*)(ws + WS_ROPE); float* rs = rc + 1024;
        for (int e = F.tid; e < 1024; e += NWAVES * 64) { const int pos = e >> 4, i = e & 15; const float fr = powf(10000.0f, -(float)(2 * i) / 32.0f); const float a = (float)pos * fr; rc[e] = cosf(a); rs[e] = sinf(a); }
    }
    p0_items(F, ap, 0, P0_ITEMS_EARLY, F.vcu * NWAVES + F.wave, F.G * NWAVES);
    { const float* wsp = ap->in[I_WSP]; bf16* dst = (bf16*)(ws + WS_WSB);
        for (int e = (F.vcu * NWAVES * 64 + F.tid) * 4; e < 8 * 128 * 128; e += F.G * NWAVES * 64 * 4) { const f32x4 v = *(const f32x4*)(wsp + e); v2u o; o.x = pk2(v[0], v[1]); o.y = pk2(v[2], v[3]); *(v2u*)(dst + e) = o; } }
}
__device__ __forceinline__ void p1_bias13(Frame& F, ArgsP ap) {
    if (F.vcu >= 176) return;
    const int l = F.vcu / 88, rem = F.vcu % 88, which = rem / 44, cb = rem % 44, k0 = F.wave * 128;
    LAS float* shs = (LAS float*)(F.lds + RING_OFF); LAS float* part = shs + 8 * 1024;
    const float* mods = (const float*)(ap->ws + WS_MODS);
    for (int i = F.tid; i < 8 * 1024; i += NWAVES * 64) { const int b = i >> 10, k = i & 1023; shs[i] = mods[(size_t)(l * 9 + b) * MODW + SH2 + k]; }
    __syncthreads();
    const float* w = ap->in[which ? I_W3 : I_W1] + (size_t)l * DM * FF + (size_t)k0 * FF + cb * 64 + F.lane;
    float acc[8];
#pragma unroll
    for (int j = 0; j < 8; ++j) acc[j] = 0.f;
    for (int k = 0; k < 128; k += 8) {
        float wv[8];
#pragma unroll
        for (int q = 0; q < 8; ++q) wv[q] = __builtin_nontemporal_load(w + (size_t)(k + q) * FF);
#pragma unroll
        for (int j = 0; j < 8; ++j) { const f32x4 s0 = *(const LAS f32x4*)(shs + j * 1024 + k0 + k), s1 = *(const LAS f32x4*)(shs + j * 1024 + k0 + k + 4);
            acc[j] += (s0[0] * wv[0] + s0[1] * wv[1]) + (s0[2] * wv[2] + s0[3] * wv[3]) + (s1[0] * wv[4] + s1[1] * wv[5]) + (s1[2] * wv[6] + s1[3] * wv[7]); }
    }
#pragma unroll
    for (int j = 0; j < 8; ++j) part[(F.wave * 8 + j) * 64 + F.lane] = acc[j];
    __syncthreads();
    float* bias = (float*)(ap->ws + WS_BIAS);
    for (int idx = F.tid; idx < 8 * 64; idx += NWAVES * 64) { const int j = idx >> 6, col = idx & 63, n = cb * 64 + col; float sum = 0.f;
#pragma unroll
        for (int wv_ = 0; wv_ < 8; ++wv_) sum += part[(wv_ * 8 + j) * 64 + col];
        bias[(size_t)(l * 8 + j) * 5632 + 256 * (n >> 7) + 128 * which + (n & 127)] = sum; }
    __syncthreads();
}
__device__ __forceinline__ void p1_poolw(Frame& F, ArgsP ap) {
    unsigned char* ws = ap->ws; const bf16* src = (const bf16*)(ws + WS_WPOOL); bf16* dst = (bf16*)(ws + WS_WPB);
    const float* gm = ap->in[I_GMIX] + DM; const float* mod1 = (const float*)(ws + WS_MODS) + (size_t)9 * MODW;
    for (int e = (F.vcu * NWAVES * 64 + F.tid) * 8; e < 8 * 1024 * 256; e += F.G * NWAVES * 64 * 8) {
        const int b = e >> 18, n = (e >> 8) & 1023, k = e & 255, gk = (n & ~255) + k;
        const v4u w = *(const v4u*)(src + (size_t)n * 256 + k); const f32x4 g0 = *(const f32x4*)(gm + gk), g1 = *(const f32x4*)(gm + gk + 4);
        const f32x4 s0 = *(const f32x4*)(mod1 + (size_t)b * MODW + SC1 + gk), s1 = *(const f32x4*)(mod1 + (size_t)b * MODW + SC1 + gk + 4);
        const f32x4 m0 = g0 * (s0 + 1.0f), m1 = g1 * (s1 + 1.0f);
        v4u o; o.x = pk2(bf2f(w.x & 0xffffu) * m0[0], bf2f(w.x >> 16) * m0[1]); o.y = pk2(bf2f(w.y & 0xffffu) * m0[2], bf2f(w.y >> 16) * m0[3]);
        o.z = pk2(bf2f(w.z & 0xffffu) * m1[0], bf2f(w.z >> 16) * m1[1]); o.w = pk2(bf2f(w.w & 0xffffu) * m1[2], bf2f(w.w >> 16) * m1[3]);
        *(v4u*)(dst + e) = o; }
}
__device__ __forceinline__ void norm_pass(Frame& F, const float* src_lat, const float* src_ctx, bf16* dst, const float* gvec, const float* modl, int sh_off, int sc_off) {
    const int total = src_ctx ? MALL : MTOK, gw = F.vcu * NWAVES + F.wave, NGW = F.G * NWAVES, rpw = (total + NGW - 1) / NGW;
    const int r0 = gw * rpw, r1 = (r0 + rpw < total) ? r0 + rpw : total;
    int cur = -1; f32x4 gm[4], sh[4];
    for (int row = r0; row < r1; ++row) {
        const int bb = row < MTOK ? (row >> 12) : 8;
        if (bb != cur) { cur = bb;
#pragma unroll
            for (int j = 0; j < 4; ++j) { const int c = 4 * F.lane + 256 * j; const f32x4 g = *(const f32x4*)(gvec + c), s = *(const f32x4*)(modl + (size_t)bb * MODW + sc_off + c);
                gm[j] = g * (s + 1.0f); sh[j] = *(const f32x4*)(modl + (size_t)bb * MODW + sh_off + c); } }
        const float* xr = row < MTOK ? src_lat + (size_t)row * DM : src_ctx + (size_t)(row - MTOK) * DM;
        f32x4 v[4]; float ss = 0.f;
#pragma unroll
        for (int j = 0; j < 4; ++j) { v[j] = __builtin_nontemporal_load((const f32x4*)(xr + 4 * F.lane + 256 * j)); ss += (v[j][0] * v[j][0] + v[j][1] * v[j][1]) + (v[j][2] * v[j][2] + v[j][3] * v[j][3]); }
        const float r = __builtin_amdgcn_rsqf(wave_sum(ss) * (1.0f / DM) + 1e-6f);
        bf16* orow = dst + (size_t)row * DM;
#pragma unroll
        for (int j = 0; j < 4; ++j) { const f32x4 o = v[j] * r * gm[j] + sh[j]; v2u w; w.x = pk2(o[0], o[1]); w.y = pk2(o[2], o[3]); *(v2u*)(orow + 4 * F.lane + 256 * j) = w; }
    }
}
__device__ __forceinline__ void final_norm(Frame& F, float* out, const float* gvec) {
    const int gw = F.vcu * NWAVES + F.wave, NGW = F.G * NWAVES, rpw = (MTOK + NGW - 1) / NGW;
    const int r0 = gw * rpw, r1 = (r0 + rpw < MTOK) ? r0 + rpw : MTOK;
    f32x4 g[4];
#pragma unroll
    for (int j = 0; j < 4; ++j) g[j] = *(const f32x4*)(gvec + 4 * F.lane + 256 * j);
    for (int row = r0; row < r1; ++row) {
        float* xr = out + (size_t)row * DM; f32x4 v[4]; float ss = 0.f;
#pragma unroll
        for (int j = 0; j < 4; ++j) { v[j] = *(const f32x4*)(xr + 4 * F.lane + 256 * j); ss += (v[j][0] * v[j][0] + v[j][1] * v[j][1]) + (v[j][2] * v[j][2] + v[j][3] * v[j][3]); }
        const float r = 1.0f / sqrtf(wave_sum(ss) * (1.0f / DM) + 1e-6f);
#pragma unroll
        for (int j = 0; j < 4; ++j) *(f32x4*)(xr + 4 * F.lane + 256 * j) = v[j] * r * g[j];
    }
}
template <int W> __device__ __forceinline__ void poolres_cols(const bf16* zb, bf16* outb, bf16* xnb, float* partb, int t0, int c, f32x4 gate, f32x4 gmn, int grp, int lane, const LAS float* rt) {
    constexpr int L = W / 2, R = W / 2 - 1, NV = W - 1 + 16;
    f32x4 v[NV];
#define BF4(u_) (f32x4){bf2f((u_).x & 0xffffu), bf2f((u_).x >> 16), bf2f((u_).y & 0xffffu), bf2f((u_).y >> 16)}
#define Z_LD(dst_, t_) do { const int tt_ = (t_); if (tt_ < 0 || tt_ >= SEQ) dst_ = (f32x4){0.f, 0.f, 0.f, 0.f}; else { const v2u u_ = __builtin_nontemporal_load((const v2u*)(zb + (size_t)tt_ * DM + c)); dst_ = BF4(u_) * rt[tt_]; } } while (0)
#pragma unroll
    for (int i = 0; i < W - 1; ++i) Z_LD(v[i], t0 - L + i);
    for (int blk = 0; blk < 4; ++blk) {
        const int tb = t0 + 16 * blk;
        v2u xr[16];
#pragma unroll
        for (int i = 0; i < 16; ++i) xr[i] = *(const v2u*)(outb + (size_t)(tb + i) * DM + c);
#pragma unroll
        for (int i = 0; i < 16; ++i) Z_LD(v[W - 1 + i], tb + R + i);
        f32x4 s = v[0];
#pragma unroll
        for (int i = 1; i < W; ++i) s += v[i];
#pragma unroll
        for (int j = 0; j < 16; ++j) { const int t = tb + j; const int lo = t - L < 0 ? 0 : t - L, hi = t + R > SEQ - 1 ? SEQ - 1 : t + R; const float icnt = __builtin_amdgcn_rcpf((float)(hi - lo + 1));
            const f32x4 o = s * icnt - v[j + L]; const f32x4 x3 = BF4(xr[j]) + gate * o;
            v2u w; w.x = pk2(x3[0], x3[1]); w.y = pk2(x3[2], x3[3]); *(v2u*)(outb + (size_t)t * DM + c) = w;
            const f32x4 y = x3 * gmn; v2u wy; wy.x = pk2(y[0], y[1]); wy.y = pk2(y[2], y[3]); *(v2u*)(xnb + (size_t)t * DM + c) = wy;
            const float ss = wave_sum((x3[0] * x3[0] + x3[1] * x3[1]) + (x3[2] * x3[2] + x3[3] * x3[3]));
            if (lane == 0) *(f32x4*)(partb + ((size_t)grp * MTOK + t) * 4) = (f32x4){ss, 0.f, 0.f, 0.f};
            if (j < 15) s += v[j + W] - v[j]; }
#pragma unroll
        for (int i = 0; i < W - 1; ++i) v[i] = v[i + 16];
    }
#undef Z_LD
#undef BF4
}
__device__ __forceinline__ void poolres_pass(Frame& F, const bf16* Z, bf16* out, bf16* xn, float* part, const float* rsum, const float* gate, const float* pscale, const float* gnext, const float* scnext) {
    LAS float* rtab = (LAS float*)(F.lds + RTAB_OFF);
    for (int strip = F.vcu; strip < MTOK / 128; strip += F.G) {
        const int b = strip >> 5, grp = F.wave >> 1, ts = (strip & 31) * 128, t0 = ts + 64 * (F.wave & 1); const size_t ro = (size_t)b * SEQ;
        __syncthreads();
        if (F.tid < 128 + 15) { const int tt = ts - 8 + F.tid; float r = 0.f;
            if (tt >= 0 && tt < SEQ) { const float* pr = rsum + (ro + tt) * 4; f32x4 p = *(const f32x4*)pr; p += *(const f32x4*)(pr + (size_t)(MTOK * 4) * 1); p += *(const f32x4*)(pr + (size_t)(MTOK * 4) * 2); p += *(const f32x4*)(pr + (size_t)(MTOK * 4) * 3);
                r = __builtin_amdgcn_rsqf(((p[0] + p[1]) + (p[2] + p[3])) * (1.0f / 1024.0f) + 1e-6f); }
            rtab[F.tid] = r; }
        __syncthreads();
        const LAS float* rt = rtab + (8 - ts);
        const int c = 256 * grp + 4 * F.lane;
        const f32x4 gt = *(const f32x4*)(gate + (size_t)b * MODW + c) * *(const f32x4*)(pscale + c);
        const f32x4 gmn = *(const f32x4*)(gnext + c) * (*(const f32x4*)(scnext + (size_t)b * MODW + c) + 1.0f);
        const bf16* zb = Z + ro * DM; bf16* outb = out + ro * DM; bf16* xnb = xn + ro * DM; float* partb = part + ro * 4;
        if (grp == 0) poolres_cols<2>(zb, outb, xnb, partb, t0, c, gt, gmn, grp, F.lane, rt); else if (grp == 1) poolres_cols<4>(zb, outb, xnb, partb, t0, c, gt, gmn, grp, F.lane, rt);
        else if (grp == 2) poolres_cols<8>(zb, outb, xnb, partb, t0, c, gt, gmn, grp, F.lane, rt); else poolres_cols<16>(zb, outb, xnb, partb, t0, c, gt, gmn, grp, F.lane, rt);
    }
}
__device__ __forceinline__ void gmlp_unit(Frame& F, int unit, const bf16* VG, const bf16* U, const bf16* WSB, const float* bs, bf16* AM) {
    using attn_body::f32x16;
    const int g = F.wave, lane = F.lane, r32 = lane & 31, hi = lane >> 5;
    const size_t R0 = (size_t)unit * 128;
    LAS unsigned char* slot = F.lds + RING_OFF + g * 16384;
    const unsigned slot_addr = (unsigned)(uintptr_t)slot;
    const int vb = (int)slot_addr + ((lane >> 4) & 1) * 32 + (lane & 3) * 8 + (4 * hi + ((lane & 15) >> 2)) * 64;
#pragma unroll
    for (int kt = 0; kt < 2; ++kt)
#pragma unroll
        for (int p = 0; p < 8; ++p)
            attn_body::glds16_nt(VG + (R0 + 64 * kt + 16 * (p & 3) + (lane >> 2)) * 512 + g * 64 + (p >> 2) * 32 + (lane & 3) * 8, (unsigned)__builtin_amdgcn_readfirstlane(slot_addr + kt * 8192 + p * 1024));
    f32x16 o[4][2];
#pragma unroll
    for (int rb = 0; rb < 4; ++rb) { o[rb][0] = f32x16{}; o[rb][1] = f32x16{}; }
#define GM_LDPA(dst, kt_, rb_) do { int z_ = 0; asm volatile("" : "+v"(z_)); const char* wp = wb + z_ + (rb_) * 8192 + (kt_) * 128;     \
            _Pragma("unroll") for (int s = 0; s < 4; ++s) { const v2u a = *(const v2u*)(wp + s * 32), b = *(const v2u*)(wp + s * 32 + 16); dst[s] = __builtin_bit_cast(bf16x8, (v4u){a.x, a.y, b.x, b.y}); } } while (0)
    const char* wb = (const char*)(WSB + ((size_t)(g * 128 + r32) * 128 + 4 * hi));
    {
        bf16x8 pA[4], pB[4];
#define GM_PV(P, kt_, rb_) attn_body::pv(o[rb_], vb + (kt_) * 8192, P[0], P[1], P[2], P[3])
        GM_LDPA(pA, 0, 0);
        VM_WAIT();
        GM_LDPA(pB, 0, 1); GM_PV(pA, 0, 0);
        GM_LDPA(pA, 0, 2); GM_PV(pB, 0, 1);
        GM_LDPA(pB, 0, 3); GM_PV(pA, 0, 2);
        GM_LDPA(pA, 1, 0); GM_PV(pB, 0, 3);
        GM_LDPA(pB, 1, 1); GM_PV(pA, 1, 0);
        GM_LDPA(pA, 1, 2); GM_PV(pB, 1, 1);
        GM_LDPA(pB, 1, 3); GM_PV(pA, 1, 2);
        GM_PV(pB, 1, 3);
#undef GM_PV
    }
#undef GM_LDPA
    LDS_WAIT();
    LAS float* stg = (LAS float*)slot;
    v4u uA[4], uB[4]; float bA[4], bB[4];
#define GM_LDU(UU, BB, rb_) do { int zz_ = 0; asm volatile("" : "+v"(zz_)); const char* ub_ = (const char*)(U + (R0 + 32 * (rb_) + (lane >> 3)) * 512 + g * 64 + (lane & 7) * 8) + zz_; \
        const float* bb_ = bs + g * 128 + 32 * (rb_) + (lane >> 3) + zz_; _Pragma("unroll") for (int i = 0; i < 4; ++i) { UU[i] = __builtin_nontemporal_load((const v4u*)(ub_ + i * 8192)); BB[i] = bb_[8 * i]; } } while (0)
#define GM_EPI(UU, BB, rb_) do { \
        _Pragma("unroll") for (int r = 0; r < 16; ++r) { const int orow = attn_body::crow(r, hi); stg[orow * 64 + r32] = o[rb_][0][r]; stg[orow * 64 + 32 + r32] = o[rb_][1][r]; } \
        LDS_WAIT(); \
        _Pragma("unroll") for (int i = 0; i < 4; ++i) { const int row = i * 8 + (lane >> 3), ch = lane & 7; \
            const f32x4 a = *(const LAS f32x4*)(stg + row * 64 + ch * 8) + BB[i], b = *(const LAS f32x4*)(stg + row * 64 + ch * 8 + 4) + BB[i]; \
            v4u w; w.x = pk2(a[0] * bf2f(UU[i].x & 0xffffu), a[1] * bf2f(UU[i].x >> 16)); w.y = pk2(a[2] * bf2f(UU[i].y & 0xffffu), a[3] * bf2f(UU[i].y >> 16)); \
            w.z = pk2(b[0] * bf2f(UU[i].z & 0xffffu), b[1] * bf2f(UU[i].z >> 16)); w.w = pk2(b[2] * bf2f(UU[i].w & 0xffffu), b[3] * bf2f(UU[i].w >> 16)); \
            *(v4u*)(AM + (R0 + 32 * (rb_) + row) * 1024 + 512 + g * 64 + ch * 8) = w; } \
        LDS_WAIT(); } while (0)
    GM_LDU(uA, bA, 0);
    GM_LDU(uB, bB, 1); GM_EPI(uA, bA, 0);
    GM_LDU(uA, bA, 2); GM_EPI(uB, bB, 1);
    GM_LDU(uB, bB, 3); GM_EPI(uA, bA, 2);
    GM_EPI(uB, bB, 3);
#undef GM_LDU
#undef GM_EPI
}

template <class Sched> __device__ __forceinline__ int build_rtab(Frame& F, const Sched& S, const float* part, LAS float* rtab) {
    pg8::Unit u; int pm0 = -1, pm1 = -1;
    for (int i = 0; S.next(i, u); ++i) { if (pm0 < 0) pm0 = u.pm; else if (u.pm != pm0) pm1 = u.pm; }
    if (pm1 < 0) pm1 = pm0;
    { const int slot = F.tid >> 8, r = F.tid & 255, row = (slot ? pm1 : pm0) * 256 + r; float tot = 0.f;
#pragma unroll
        for (int pn = 0; pn < 4; ++pn) { const f32x4 p = *(const f32x4*)(part + ((size_t)pn * MTOK + row) * 4); tot += (p[0] + p[1]) + (p[2] + p[3]); }
        rtab[F.tid] = __builtin_amdgcn_rsqf(tot * (1.0f / DM) + 1e-6f); }
    __syncthreads();
    return pm0;
}
__global__ void __launch_bounds__(NWAVES * 64, 2) mega_fwd(Args args) {
    extern __shared__ __attribute__((aligned(16))) unsigned char lds[];
    Frame F;
    F.lds = (LAS unsigned char*)lds;
    F.MISC = (volatile LAS unsigned*)(F.lds + MISC_OFF);
    F.tid = threadIdx.x; F.lane = F.tid & 63; F.wave = __builtin_amdgcn_readfirstlane(F.tid >> 6);
    F.G = gridDim.x; { const int bx = blockIdx.x; F.vcu = (F.G % 8 == 0) ? (bx % 8) * (F.G / 8) + bx / 8 : bx; }
    ArgsP akp = (ArgsP)__builtin_amdgcn_kernarg_segment_ptr();
    F.ctl = (gu32*)(akp->ws + WS_CTL);
    for (int u = F.tid; u < (LDS_BYTES - LDSCTL_OFF) / 4; u += NWAVES * 64) ((LAS unsigned*)(F.lds + LDSCTL_OFF))[u] = 0u;
    __syncthreads();
    const int lo = akp->ph_lo, hi = akp->ph_hi;
    const bool one_launch = (hi - lo) > 1;
    XcdBarrier bar; bar.bar = (unsigned*)(F.ctl + CW_BAR); bar.x = 0; bar.st = nullptr;
    if (one_launch) bar = xcd_barrier_post((unsigned*)(F.ctl + CW_BAR), F.MISC + 8);
#ifndef PHASE_MASK
#define PHASE_MASK 0x7ff
#endif
#define IN(k) (((PHASE_MASK >> (k)) & 1) && lo <= (k) && (k) < hi)
#define SEAM(k) do { if (IN(k) && IN((k) + 1)) xcd_barrier(bar); } while (0)
#ifndef REPEAT_MASK
#define REPEAT_MASK 0
#endif
#define REP(k) for (int rep_ = 0; rep_ < (((REPEAT_MASK >> (k)) & 1) ? 2 : 1); ++rep_, (((REPEAT_MASK >> (k)) & 1) && rep_ == 1 && one_launch ? (xcd_barrier(bar), 0) : 0))
#define REPRES(k, dummy) ((((REPEAT_MASK >> (k)) & 1) && rep_ == 0) ? (void*)(ws + (dummy)) : (void*)(ws + WS_RES))
#define REPOUT(k, dummy) ((((REPEAT_MASK >> (k)) & 1) && rep_ == 0) ? (float*)(ws + (dummy)) : out)
#define PHASE_VARS() ArgsP A = akp; asm volatile("" : "+s"(A)); unsigned char* ws = A->ws; float* out = A->out; float* mods = (float*)(ws + WS_MODS); const float* mod1 = mods + (size_t)9 * MODW; bf16* XN = (bf16*)(ws + WS_XN); bf16* AM = (bf16*)(ws + WS_AM); bf16* HB = (bf16*)(ws + WS_H); \
    float* rs1 = (float*)(ws + WS_PART); float* rs2 = rs1 + 16 * MTOK; float* rs3 = rs2 + 16 * MTOK; float* rs4 = rs3 + 16 * MTOK; const float* bias13 = (const float*)(ws + WS_BIAS); \
    (void)out; (void)mods; (void)mod1; (void)XN; (void)AM; (void)HB; (void)rs1; (void)rs2; (void)rs3; (void)rs4; (void)bias13
#ifndef STAGGER_US
#define STAGGER_US 0
#endif
#define STAGGER() do { const unsigned g_ = (blockIdx.x >> 3) & 3u; if (STAGGER_US > 0 && g_) { const unsigned long long t0_ = __builtin_amdgcn_s_memrealtime(); while (__builtin_amdgcn_s_memrealtime() - t0_ < (unsigned long long)(g_ * STAGGER_US * 100)) __builtin_amdgcn_s_sleep(8); } } while (0)
#define RELAUNDER() do { int t_ = threadIdx.x; asm volatile("" : "+v"(t_)); F.tid = t_; F.lane = t_ & 63; } while (0)
    if (IN(0)) REP(0) { PHASE_VARS(); RELAUNDER(); p0_prologue(F, A); } SEAM(0);
    if (IN(1)) REP(1) { PHASE_VARS(); RELAUNDER(); p1_bias13(F, A); p1_poolw(F, A); norm_pass(F, A->in[I_X], A->in[I_CTX], XN, A->in[I_GMIX], mods, SH1, SC1); } SEAM(1);
    if (IN(2)) REP(2) { PHASE_VARS();
        pg8::Gemm g{XN, (const bf16*)(ws + WS_WIN), DM, DM, 0, 0}; pg8::StaticOrder S; S.init(MTOK, INW, F.G, (int)blockIdx.x, MCTX / 256, 2);
        pg8::EpiInProj E{A};
        pg8::gemm_phase<pg8::EpiInProj, pg8::StaticOrder, PG8_ALIGN, PG8_SP2>(F.lds + RING_OFF, g, S, E);
        { const int total = (MTOK / 256) * (INW / 256) + MCTX / 256, rounds = (total + (int)F.G - 1) / (int)F.G, heavy = total - (rounds - 1) * (int)F.G, c = (int)blockIdx.x;
          RELAUNDER();
          if (heavy >= (int)F.G) p0_items(F, A, P0_ITEMS_EARLY, P0_ITEMS_ALL, c * NWAVES + F.wave, (int)F.G * NWAVES);
          else if (c >= heavy) p0_items(F, A, P0_ITEMS_EARLY, P0_ITEMS_ALL, (c - heavy) * NWAVES + F.wave, ((int)F.G - heavy) * NWAVES); }
    } SEAM(2);
    if (IN(3)) REP(3) { PHASE_VARS();
        const attn_body::AttnTensors AT{(const attn_body::bf16*)(ws + WS_Q), (const attn_body::bf16*)(ws + WS_KB), (const attn_body::bf16*)(ws + WS_VB), (attn_body::bf16*)AM};
        const attn_body::StaticOrder S((int)F.G, F.vcu);
        const bool gfirst = (F.vcu & 1) != 0;
        for (int g2_ = 0; g2_ < 2; ++g2_) {
            if ((g2_ == 0) == gfirst) {
                RELAUNDER();
                for (int rp_ = 0; rp_ < (((REPEAT_MASK >> 11) & 1) ? 2 : 1); ++rp_) {
                    for (int u = F.vcu; u < MTOK / 128; u += F.G) gmlp_unit(F, u, (const bf16*)(ws + WS_VG), (const bf16*)(ws + WS_U), (const bf16*)(ws + WS_WSB), A->in[I_BSP], AM);
                    __syncthreads(); }
            } else attn_body::attn_phase<attn_body::StaticOrder>((char*)lds + RING_OFF, AT, S, A->in[I_QN], A->in[I_KN]);
        }
    } SEAM(3);
    if (IN(4)) REP(4) { PHASE_VARS(); STAGGER();
        pg8::Gemm g{AM, (const bf16*)(ws + WS_WOUT), DM, DM, 0, 0}; pg8::StaticOrder S; S.init(MTOK, DM, F.G, (int)blockIdx.x);
        pg8::EpiResid<4> E{A, (void*)(ws + WS_RES)};
        pg8::gemm_phase<pg8::EpiResid<4>, pg8::StaticOrder, PG8_ALIGN, PG8_SP2>(F.lds + RING_OFF, g, S, E);
    } SEAM(4);
    if (IN(5)) REP(5) { PHASE_VARS();
        pg8::Gemm g{XN, (const bf16*)(ws + WS_W13), DM, DM, 0, 0}; pg8::StaticOrder S; S.init(MTOK, 2 * FF, F.G, (int)blockIdx.x);
#if defined(PROBE_NULL5)
        if (rep_ == 0) { pg8::EpiNull EN{(bf16*)(ws + WS_VG)}; pg8::StaticOrder S2; S2.init(MTOK, DM, F.G, (int)blockIdx.x);   (void)S2;
            pg8::EpiNullWide ENW{(bf16*)(ws + WS_H)}; pg8::gemm_phase<pg8::EpiNullWide, pg8::StaticOrder, PG8_ALIGN, PG8_SP2>(F.lds + RING_OFF, g, S, ENW); (void)EN; } else
#endif
        { RELAUNDER(); LAS float* rtab = (LAS float*)(F.lds + RTAB_OFF); const int pm0 = build_rtab(F, S, rs1, rtab); pg8::EpiSwiglu<0> E{A, rtab, pm0};
        pg8::gemm_phase<pg8::EpiSwiglu<0>, pg8::StaticOrder, PG8_ALIGN, PG8_SP2>(F.lds + RING_OFF, g, S, E); }
    } SEAM(5);
    if (IN(6)) REP(6) { PHASE_VARS(); STAGGER();
        pg8::Gemm g{HB, (const bf16*)(ws + WS_W2), FF, FF, 0, 0}; pg8::StaticOrder S; S.init(MTOK, DM, F.G, (int)blockIdx.x);
#if defined(PROBE_NULL6)
        if (rep_ == 0) { pg8::EpiNull EN{(bf16*)(ws + WS_VG)}; pg8::gemm_phase<pg8::EpiNull, pg8::StaticOrder, PG8_ALIGN, PG8_SP2>(F.lds + RING_OFF, g, S, EN); } else
#elif defined(PROBE_NOXN6)
        if (rep_ == 0) { pg8::EpiResid<7> E7{A, REPRES(6, WS_VG)}; pg8::gemm_phase<pg8::EpiResid<7>, pg8::StaticOrder, PG8_ALIGN, PG8_SP2>(F.lds + RING_OFF, g, S, E7); } else
#endif
        { pg8::EpiResid<6> E{A, REPRES(6, WS_VG)};
        pg8::gemm_phase<pg8::EpiResid<6>, pg8::StaticOrder, PG8_ALIGN, PG8_SP2>(F.lds + RING_OFF, g, S, E); }
        { pg8::Gemm gz{(const bf16*)(ws + WS_RES), (const bf16*)(ws + WS_WPB), 256, DM, 512, 1024 * 256 * 2}; pg8::EpiZ EZ{A};
        pg8::gemm_phase<pg8::EpiZ, pg8::StaticOrder, PG8_ALIGN, PG8_SP2>(F.lds + RING_OFF, gz, S, EZ); }
    } SEAM(7);
    if (IN(8)) { PHASE_VARS(); RELAUNDER(); poolres_pass(F, AM, (bf16*)(ws + WS_RES), XN, rs3, rs2, mod1 + GA1, A->in[I_PSC], A->in[I_GFFN] + DM, mod1 + SC2); } SEAM(8);
    if (IN(9)) REP(9) { PHASE_VARS();
        pg8::Gemm g{XN, (const bf16*)(ws + WS_W13) + (size_t)5632 * DM, DM, DM, 0, 0}; pg8::StaticOrder S; S.init(MTOK, 2 * FF, F.G, (int)blockIdx.x);
        RELAUNDER(); LAS float* rtab = (LAS float*)(F.lds + RTAB_OFF); const int pm0 = build_rtab(F, S, rs3, rtab); pg8::EpiSwiglu<1> E{A, rtab, pm0};
        pg8::gemm_phase<pg8::EpiSwiglu<1>, pg8::StaticOrder, PG8_ALIGN, PG8_SP2>(F.lds + RING_OFF, g, S, E);
    } SEAM(9);
    if (IN(10)) REP(10) { PHASE_VARS(); STAGGER();
        pg8::Gemm g{HB, (const bf16*)(ws + WS_W2) + (size_t)DM * FF, FF, FF, 0, 0}; pg8::StaticOrder S; S.init(MTOK, DM, F.G, (int)blockIdx.x);
        pg8::EpiResid<10> E{A, out};
        pg8::gemm_phase<pg8::EpiResid<10>, pg8::StaticOrder, PG8_ALIGN, PG8_SP2>(F.lds + RING_OFF, g, S, E);
    }
#undef IN
#undef SEAM
}

extern "C" void kernel_launch(void* const* d_in, const int* in_sizes, int n_in, void* d_out, int out_size, void* d_ws, size_t ws_size, hipStream_t stream) {
    static int grid = 0;
    if (grid == 0) {
        if (n_in != 21 || out_size != MTOK * DM || ws_size < WS_END) { fprintf(stderr, "kernel_launch: unexpected shapes (n_in %d, out %d, ws %zu)\n", n_in, out_size, ws_size); grid = -1; return; }
        int dev = 0, cus = 0, per_cu = 0;
        if (hipGetDevice(&dev) != hipSuccess || hipDeviceGetAttribute(&cus, hipDeviceAttributeMultiprocessorCount, dev) != hipSuccess) { grid = -1; return; }
        if (hipFuncSetAttribute((const void*)mega_fwd, hipFuncAttributeMaxDynamicSharedMemorySize, LDS_BYTES) != hipSuccess) { fprintf(stderr, "kernel_launch: hipFuncSetAttribute failed\n"); grid = -1; return; }
        if (hipOccupancyMaxActiveBlocksPerMultiprocessor(&per_cu, (const void*)mega_fwd, NWAVES * 64, LDS_BYTES) != hipSuccess || per_cu < 1) { fprintf(stderr, "kernel_launch: occupancy query says %d\n", per_cu); per_cu = 1; }
        (void)hipGetLastError();
        grid = cus;
        if (grid != 256) fprintf(stderr, "kernel_launch: %d CUs (expected 256)\n", grid);
    }
    if (grid < 0) return;
    if (hipMemsetAsync((char*)d_ws + WS_CTL, 0, CTL_ZERO_BYTES, stream) != hipSuccess) return;
    Args a{};
    for (int i = 0; i < 21; ++i) a.in[i] = (const float*)d_in[i];
    a.out = (float*)d_out; a.ws = (unsigned char*)d_ws;
#if defined(MK_PER_PHASE)
    for (int p = 0; p < N_PHASES; ++p) { a.ph_lo = p; a.ph_hi = p + 1; hipLaunchKernelGGL(mega_fwd, dim3(grid), dim3(NWAVES * 64), LDS_BYTES, stream, a); }
#else
    a.ph_lo = 0; a.ph_hi = N_PHASES;
    hipLaunchKernelGGL(mega_fwd, dim3(grid), dim3(NWAVES * 64), LDS_BYTES, stream, a);
#endif
}
```

```cpp
#include <hip/hip_runtime.h>
#include <hip/hip_bf16.h>
#include <cstdio>
#include <cstdint>
#include <cmath>
constexpr int NWAVES_ = 8;
constexpr int NWAVES = 8;
constexpr int DM = 1024, NB = 8, SEQ = 4096, MTOK = NB * SEQ, CTXL = 256, MCTX = NB * CTXL, MALL = MTOK + MCTX;
constexpr int INW = 1792, FF = 2816, SKV = SEQ + CTXL;
constexpr int N_PHASES = 11;
constexpr size_t MiB = 1u << 20;
constexpr size_t WS_CTL = 0, CTL_ZERO_BYTES = 128 * 1024;
constexpr size_t WS_MODS = 1 * MiB;
constexpr size_t WS_ROPE = WS_MODS + 512 * 1024;
constexpr size_t WS_WSB = 2 * MiB;
constexpr size_t WS_WPOOL = WS_WSB + 512 * 1024;
constexpr size_t WS_WIN = 4 * MiB;
constexpr size_t WS_WOUT = 8 * MiB;
constexpr size_t WS_W13 = 10 * MiB;
constexpr size_t WS_W2 = 32 * MiB;
constexpr size_t WS_XN = 44 * MiB;
constexpr size_t WS_Q = 112 * MiB;
constexpr size_t WS_RES = 112 * MiB;
constexpr size_t WS_KB = 144 * MiB;
constexpr size_t WS_VB = 153 * MiB;
constexpr size_t WS_U = 162 * MiB;
constexpr size_t WS_VG = 194 * MiB;
constexpr size_t WS_AM = 226 * MiB;
constexpr size_t WS_H = 290 * MiB;
constexpr size_t WS_WPB = 474 * MiB;
constexpr size_t WS_END = 478 * MiB;
constexpr int CW_BAR = 4096;
constexpr size_t CTL_CNT = 65536;
constexpr size_t WS_PART = 466 * MiB;
static_assert(CTL_CNT + 32768 <= CTL_ZERO_BYTES, "CTL map");
constexpr size_t WS_FLAG = WS_ROPE + 32768;
constexpr size_t WS_BIAS = WS_ROPE + 65536;
constexpr int RING_OFF = 0, RING_BYTES = 131072;
constexpr int LDSCTL_OFF = RING_BYTES, MISC_OFF = LDSCTL_OFF + 320;
constexpr int RTAB_OFF = LDSCTL_OFF + 1024;
constexpr int LDS_BYTES = 147456;
static_assert(MISC_OFF + 128 <= LDS_BYTES, "LDS map");

struct Args { const float* in[21]; float* out; unsigned char* ws; int ph_lo, ph_hi; };
#define KARG __attribute__((address_space(4)))
typedef const KARG Args* ArgsP;
static_assert(sizeof(Args) == 192, "Args has no padding");
enum { I_X = 0, I_C, I_CTX, I_CCTX, I_WADA, I_BADA, I_GMIX, I_GFFN, I_WIN, I_WOUT, I_QN, I_KN, I_GN, I_WSP, I_BSP, I_WPOOL, I_PSC, I_W1, I_W3, I_W2, I_GFIN };
constexpr int SH1 = 0, SC1 = DM, GA1 = 2 * DM, SH2 = 3 * DM, SC2 = 4 * DM, GA2 = 5 * DM, MODW = 6 * DM;

template <int CTRL> __device__ __forceinline__ float dpp_add(float x) { return x + __builtin_bit_cast(float, __builtin_amdgcn_update_dpp(0, __builtin_bit_cast(int, x), CTRL, 0xF, 0xF, true)); }
__device__ __forceinline__ float xor16_add(float x) { const unsigned u = __builtin_bit_cast(unsigned, x); auto r = __builtin_amdgcn_permlane16_swap(u, u, false, false); return __builtin_bit_cast(float, (unsigned)r[0]) + __builtin_bit_cast(float, (unsigned)r[1]); }
__device__ __forceinline__ float xor32_add(float x) { const unsigned u = __builtin_bit_cast(unsigned, x); auto r = __builtin_amdgcn_permlane32_swap(u, u, false, false); return __builtin_bit_cast(float, (unsigned)r[0]) + __builtin_bit_cast(float, (unsigned)r[1]); }
__device__ __forceinline__ float wave_sum64(float v) { v = dpp_add<0xB1>(v); v = dpp_add<0x4E>(v); v = dpp_add<0x124>(v); v = dpp_add<0x128>(v); v = xor16_add(v); return xor32_add(v); }
namespace pg8 {
#define PG8_LAS __attribute__((address_space(3)))
typedef unsigned short bf16_t;
typedef short bf16x8 __attribute__((ext_vector_type(8)));
typedef float f32x4 __attribute__((ext_vector_type(4)));
typedef float f32x2 __attribute__((ext_vector_type(2)));
typedef unsigned u32x4 __attribute__((ext_vector_type(4)));
constexpr int BM = 256, BK = 64, HALF = 128, HTB = HALF * BK * 2  , STAGE_BYTES = 8 * HTB, NXCD = 8, WGM = 8;

__host__ __device__ __forceinline__ int lds_byte(int r, int c) { const int st = (r >> 4) * 2 + (c >> 5), rr = r & 15, cc = c & 31, ob = rr * 64 + cc * 2; return st * 1024 + (ob ^ (((ob >> 9) & 1) << 5)); }
__host__ __device__ __forceinline__ void stage_rc(int b, int& R, int& C) { const int st = b / 1024, sb = b % 1024, swz = sb ^ (((sb >> 9) & 1) << 5); R = (st >> 1) * 16 + swz / 64; C = (st & 1) * 32 + (swz % 64) / 2; }
__host__ __device__ __forceinline__ int perm32(int rho) { const int n = rho >> 4, i = rho & 15; return 8 * (i >> 2) + 4 * n + (i & 3); }

struct Unit { int pm, pn; };
struct Gemm { const bf16_t* A; const bf16_t* Bt; int K; int lda; int a_pn_bytes; int b_batch_bytes; };

struct StaticOrder {
    int nM, nN, nwg, G, c, extra, extra_pn;
    __host__ __device__ void init(int M, int N, int G_, int c_, int extra_ = 0, int extra_pn_ = 0) { nM = M / BM; nN = N / BM; nwg = nM * nN; G = G_; c = c_; extra = extra_; extra_pn = extra_pn_; }
    __host__ __device__ bool next(int i, Unit& u) const {
        const long L = (long)i * G + c;
        if (L >= nwg) { const long e = L - nwg; if (e >= extra) return false; u.pm = nM + (int)e; u.pn = extra_pn; return true; }
        int wgid = (int)L; { const int q = nwg / NXCD, r = nwg % NXCD, xcd = wgid % NXCD, off = wgid / NXCD; wgid = (xcd < r ? xcd * (q + 1) : r * (q + 1) + (xcd - r) * q) + off; }
        const int nig = WGM * nN, gid = wgid / nig, fm = gid * WGM, gsz = (nM - fm) < WGM ? (nM - fm) : WGM;
        u.pm = fm + ((wgid % nig) % gsz); u.pn = (wgid % nig) / gsz; return true;
    }
    __device__ __forceinline__ void a_ready(const Unit&) const {}
    __device__ __forceinline__ void done(const Unit&) const {}
};

__device__ __forceinline__ unsigned cvt_pk_bf16(float lo, float hi) { unsigned r; asm volatile("v_cvt_pk_bf16_f32 %0, %1, %2" : "=v"(r) : "v"(lo), "v"(hi)); return r; }
__device__ __forceinline__ f32x2 gelu_pk(f32x2 v) {
    const f32x2 av = __builtin_elementwise_abs(v), d = av * 0.2316418882f + 1.0f;
    f32x2 t; t.x = __builtin_amdgcn_rcpf(d.x); t.y = __builtin_amdgcn_rcpf(d.y);
    f32x2 q = t * 0.5307027145f + (-0.7265760135f); q = q * t + 0.7107068705f; q = q * t + (-0.142248368f); q = q * t + 0.127414796f; q = q * t;
    const f32x2 s = (v * v) * (-0.72134752044f);
    f32x2 e; e.x = __builtin_amdgcn_exp2f(s.x); e.y = __builtin_amdgcn_exp2f(s.y);
    const f32x2 m = v * (q * e), r = v - m;
    f32x2 o; o.x = v.x < 0.f ? m.x : r.x; o.y = v.y < 0.f ? m.y : r.y; return o;
}
__device__ __forceinline__ f32x4 gelu4(f32x4 v) { const f32x2 a = gelu_pk((f32x2){v[0], v[1]}), b = gelu_pk((f32x2){v[2], v[3]}); return (f32x4){a.x, a.y, b.x, b.y}; }
__device__ __forceinline__ float silu1(float v) { return v * __builtin_amdgcn_rcpf(1.0f + __builtin_amdgcn_exp2f(v * -1.4426950408889634f)); }
__device__ __forceinline__ u32x4 pack8(f32x4 v0, f32x4 v1) { u32x4 w; w.x = cvt_pk_bf16(v0[0], v0[1]); w.y = cvt_pk_bf16(v0[2], v0[3]); w.z = cvt_pk_bf16(v1[0], v1[1]); w.w = cvt_pk_bf16(v1[2], v1[3]); return w; }

struct EpiInProj {
    static constexpr bool PERM = true, AFTER_DRAIN = false;
    ArgsP A;
    __device__ __forceinline__ void operator()(const f32x4 (&acc)[2][2][4][2], const Unit& u, int wr, int wc, int fr_, int fq_) const {
        ArgsP a_ = A; asm volatile("" : "+s"(a_)); unsigned char* ws_ = a_->ws;
        bf16_t* Q = (bf16_t*)(ws_ + WS_Q); bf16_t* KB = (bf16_t*)(ws_ + WS_KB); bf16_t* VB = (bf16_t*)(ws_ + WS_VB); bf16_t* U = (bf16_t*)(ws_ + WS_U); bf16_t* VG = (bf16_t*)(ws_ + WS_VG);
        const float* qn = a_->in[I_QN]; const float* kn = a_->in[I_KN]; const float* gv = a_->in[I_GN]; const float* ropeC = (const float*)(ws_ + WS_ROPE); const float* ropeS = ropeC + 1024;
        const float qscale = 0.125f * 1.4426950408889634f;
        int t_ = threadIdx.x; asm volatile("" : "+v"(t_)); const int fr = t_ & 15, fq = (t_ >> 4) & 3; (void)fr_; (void)fq_;
        const int slot = 4 * u.pn + wc; const bool isctx = u.pm >= 128;
        const int rowl = wr * 64 + fr;
        const int row0 = u.pm * BM + rowl;
        const int kvrow0 = (isctx ? (u.pm - 128) * 4352 + 4096 : (u.pm >> 4) * 4352 + (u.pm & 15) * 256) + rowl;
        const int dl = 8 * fq;
        if (slot < 10) {
            const float* nw = slot < 8 ? qn : kn; const float osc = slot < 8 ? qscale : 1.0f;
            f32x4 w[2][2];
#pragma unroll
            for (int bj = 0; bj < 2; ++bj)
#pragma unroll
                for (int n = 0; n < 2; ++n) w[bj][n] = *(const f32x4*)(nw + 32 * bj + dl + 4 * n);
#pragma unroll
            for (int ai = 0; ai < 2; ++ai) {
                const int posr = (4 * u.pm + 2 * ai + wr) & 63;
                const f32x4 cr = *(const f32x4*)(ropeC + posr * 16 + 4 * fq), sr = *(const f32x4*)(ropeS + posr * 16 + 4 * fq);
#pragma unroll
                for (int m = 0; m < 4; ++m) {
                    float ss = 0.f;
#pragma unroll
                    for (int bj = 0; bj < 2; ++bj)
#pragma unroll
                        for (int n = 0; n < 2; ++n) { const f32x4 x = acc[ai][bj][m][n]; ss += (x[0] * x[0] + x[1] * x[1]) + (x[2] * x[2] + x[3] * x[3]); }
                    ss = xor32_add(xor16_add(ss));
                    const float r = __builtin_amdgcn_rsqf(ss * (1.0f / 64.0f) + 1e-6f) * osc;
                    const int posc = 16 * m + fr;
                    const f32x4 cc = *(const f32x4*)(ropeC + posc * 16 + 4 * fq), sc = *(const f32x4*)(ropeS + posc * 16 + 4 * fq);
#pragma unroll
                    for (int bj = 0; bj < 2; ++bj) {
                        f32x4 v0 = acc[ai][bj][m][0] * r * w[bj][0], v1 = acc[ai][bj][m][1] * r * w[bj][1];
                        if (!isctx) { const f32x4 c = bj ? cc : cr, s = bj ? sc : sr;
                            const f32x4 o0 = (f32x4){v0[0] * c[0] - v0[1] * s[0], v0[0] * s[0] + v0[1] * c[0], v0[2] * c[1] - v0[3] * s[1], v0[2] * s[1] + v0[3] * c[1]};
                            const f32x4 o1 = (f32x4){v1[0] * c[2] - v1[1] * s[2], v1[0] * s[2] + v1[1] * c[2], v1[2] * c[3] - v1[3] * s[3], v1[2] * s[3] + v1[3] * c[3]};
                            v0 = o0; v1 = o1; }
                        bf16_t* dst = slot < 8 ? Q + (size_t)(row0 + ai * HALF + m * 16) * 512 + slot * 64 + 32 * bj + dl
                                               : KB + (size_t)(kvrow0 + ai * HALF + m * 16) * 128 + (slot - 8) * 64 + 32 * bj + dl;
                        *(u32x4*)dst = pack8(v0, v1);
                    }
                    asm volatile("" ::: "memory");
                }
            }
        } else if (slot < 12) {
#pragma unroll
            for (int ai = 0; ai < 2; ++ai)
#pragma unroll
                for (int m = 0; m < 4; ++m)
#pragma unroll
                    for (int bj = 0; bj < 2; ++bj)
                        *(u32x4*)(VB + (size_t)(kvrow0 + ai * HALF + m * 16) * 128 + (slot - 10) * 64 + 32 * bj + dl) = pack8(acc[ai][bj][m][0], acc[ai][bj][m][1]);
        } else if (slot < 20) {
#pragma unroll
            for (int ai = 0; ai < 2; ++ai)
#pragma unroll
                for (int m = 0; m < 4; ++m)
#pragma unroll
                    for (int bj = 0; bj < 2; ++bj)
                        *(u32x4*)(U + (size_t)(row0 + ai * HALF + m * 16) * 512 + (slot - 12) * 64 + 32 * bj + dl) = pack8(gelu4(acc[ai][bj][m][0]), gelu4(acc[ai][bj][m][1]));
        } else {
            f32x4 w[2][2];
#pragma unroll
            for (int bj = 0; bj < 2; ++bj)
#pragma unroll
                for (int n = 0; n < 2; ++n) w[bj][n] = *(const f32x4*)(gv + (slot - 20) * 64 + 32 * bj + dl + 4 * n);
#pragma unroll
            for (int ai = 0; ai < 2; ++ai)
#pragma unroll
                for (int m = 0; m < 4; ++m) {
                    f32x4 g[2][2]; float ss = 0.f;
#pragma unroll
                    for (int bj = 0; bj < 2; ++bj)
#pragma unroll
                        for (int n = 0; n < 2; ++n) { const f32x4 x = gelu4(acc[ai][bj][m][n]); g[bj][n] = x; ss += (x[0] * x[0] + x[1] * x[1]) + (x[2] * x[2] + x[3] * x[3]); }
                    ss = xor32_add(xor16_add(ss));
                    const float r = __builtin_amdgcn_rsqf(ss * (1.0f / 64.0f) + 1e-6f);
#pragma unroll
                    for (int bj = 0; bj < 2; ++bj)
                        *(u32x4*)(VG + (size_t)(row0 + ai * HALF + m * 16) * 512 + (slot - 20) * 64 + 32 * bj + dl) = pack8(g[bj][0] * r * w[bj][0], g[bj][1] * r * w[bj][1]);
                }
        }
    }
};
constexpr int RS_M = 32768;
__device__ __forceinline__ float row_total(const float* part, int row, int fq) {
    const f32x4 p = *(const f32x4*)(part + ((size_t)fq * RS_M + row) * 4); float t = (p[0] + p[1]) + (p[2] + p[3]); t = xor32_add(xor16_add(t)); return t;
}
template <int V> struct EpiResid {
    static constexpr bool PERM = true, AFTER_DRAIN = false, XNOUT = (V == 4 || V == 5), FINAL = (V == 10), BASE16 = !XNOUT, RESOUT = (V != 5);
    ArgsP A; void* outp;
    __device__ __forceinline__ void operator()(f32x4 (&acc)[2][2][4][2], const Unit& u, int wr, int wc, int fr_, int fq_) const {
        int t_ = threadIdx.x; asm volatile("" : "+v"(t_)); const int fr = t_ & 15, fq = (t_ >> 4) & 3; (void)fr_; (void)fq_;
        const int row0 = u.pm * BM + wr * 64 + fr, col0 = u.pn * BM + wc * 32 + 8 * fq, b = u.pm >> 4;
        ArgsP a_ = A; asm volatile("" : "+s"(a_)); unsigned char* ws_ = a_->ws; constexpr int gstride = MODW;
        const float* mods_ = (const float*)(ws_ + WS_MODS); const float* modl_ = mods_ + (V == 10 ? 9 * MODW : 0);
        const float* basef = a_->in[I_X]; const bf16_t* baseh = (const bf16_t*)(ws_ + WS_RES); const float* gate = modl_ + (XNOUT ? GA1 : GA2);
        float* part = (float*)(ws_ + WS_PART) + (size_t)(XNOUT ? 0 : V == 10 ? 3 : 1) * 16 * RS_M;
        bf16_t* xn = (bf16_t*)(ws_ + WS_XN); const float* gnext = XNOUT ? a_->in[I_GFFN] : a_->in[I_GMIX] + DM; const float* scnext = XNOUT ? mods_ + SC2 : mods_ + 9 * MODW + SC1;
        unsigned* cnt = (unsigned*)(ws_ + WS_CTL + CTL_CNT); const float* gfin = a_->in[I_GFIN];
        bf16_t* resout = (bf16_t*)outp; float* out = (float*)outp;
        const float* gp = gate + (size_t)b * gstride + col0;
        const bool xo = BASE16 ? (__builtin_amdgcn_readfirstlane(*(const int*)(ws_ + WS_FLAG)) != 0) : false;
        if (BASE16 && xo) baseh = (const bf16_t*)(ws_ + WS_XN);
        f32x4 gvv[2][2], gmn[2][2];
#pragma unroll
        for (int bj = 0; bj < 2; ++bj)
#pragma unroll
            for (int n = 0; n < 2; ++n) { gvv[bj][n] = *(const f32x4*)(gp + bj * HALF + n * 4);
                if (XNOUT) gmn[bj][n] = *(const f32x4*)(gnext + col0 + bj * HALF + n * 4) * (*(const f32x4*)(scnext + (size_t)b * gstride + col0 + bj * HALF + n * 4) + 1.0f);
                else { const float* gprev = (V == 10) ? a_->in[I_GFFN] + DM : a_->in[I_GFFN]; const float* scprev = modl_ + SC2;
                    const f32x4 m = *(const f32x4*)(gprev + col0 + bj * HALF + n * 4) * (*(const f32x4*)(scprev + (size_t)b * gstride + col0 + bj * HALF + n * 4) + 1.0f);
                    gmn[bj][n] = xo ? (f32x4){__builtin_amdgcn_rcpf(m[0]), __builtin_amdgcn_rcpf(m[1]), __builtin_amdgcn_rcpf(m[2]), __builtin_amdgcn_rcpf(m[3])} : (f32x4){1.f, 1.f, 1.f, 1.f}; } }
        float ssv[2][4];
        f32x4 bsA[2][2], bsB[2][2], bsC[2][2], bsD[2][2], bsE[2][2], bsF[2][2], bsG[2][2], bsH[2][2];
        u32x4 hsA[2], hsB[2], hsC[2], hsD[2], hsE[2], hsF[2], hsG[2], hsH[2];
#define ER_LOAD(X, p) do { const size_t off_ = (size_t)(row0 + ((p) >> 2) * HALF + ((p) & 3) * 16) * 1024 + col0; \
            _Pragma("unroll") for (int bj = 0; bj < 2; ++bj) { if (BASE16) { if (FINAL) hs##X[bj] = __builtin_nontemporal_load((const u32x4*)(baseh + off_ + bj * HALF)); else hs##X[bj] = *(const u32x4*)(baseh + off_ + bj * HALF); } \
                else { bs##X[bj][0] = __builtin_nontemporal_load((const f32x4*)(basef + off_ + bj * HALF)); bs##X[bj][1] = __builtin_nontemporal_load((const f32x4*)(basef + off_ + bj * HALF + 4)); } } } while (0)
#define ER_WORK(X, p) do { const int ai = (p) >> 2, m = (p) & 3; const size_t off_ = (size_t)(row0 + ai * HALF + m * 16) * 1024 + col0; float ss = 0.f; \
            _Pragma("unroll") for (int bj = 0; bj < 2; ++bj) { f32x4 b0, b1; \
                if (BASE16) { const u32x4 h = hs##X[bj]; b0 = (f32x4){__builtin_bit_cast(float, h.x << 16), __builtin_bit_cast(float, h.x & 0xffff0000u), __builtin_bit_cast(float, h.y << 16), __builtin_bit_cast(float, h.y & 0xffff0000u)}; \
                    b1 = (f32x4){__builtin_bit_cast(float, h.z << 16), __builtin_bit_cast(float, h.z & 0xffff0000u), __builtin_bit_cast(float, h.w << 16), __builtin_bit_cast(float, h.w & 0xffff0000u)}; b0 *= gmn[bj][0]; b1 *= gmn[bj][1]; } \
                else { b0 = bs##X[bj][0]; b1 = bs##X[bj][1]; } \
                const f32x4 x0 = b0 + gvv[bj][0] * acc[ai][bj][m][0], x1 = b1 + gvv[bj][1] * acc[ai][bj][m][1]; \
                ss += ((x0[0] * x0[0] + x0[1] * x0[1]) + (x0[2] * x0[2] + x0[3] * x0[3])) + ((x1[0] * x1[0] + x1[1] * x1[1]) + (x1[2] * x1[2] + x1[3] * x1[3])); \
                if (FINAL) { acc[ai][bj][m][0] = x0; acc[ai][bj][m][1] = x1; } else if (RESOUT) *(u32x4*)(resout + off_ + bj * HALF) = pack8(x0, x1); \
                if (XNOUT) *(u32x4*)(xn + off_ + bj * HALF) = pack8(x0 * gmn[bj][0], x1 * gmn[bj][1]); } \
            ss = xor32_add(xor16_add(ss)); ssv[ai][m] = ss; } while (0)
#define ER_FENCE asm volatile("" ::: "memory")
        if constexpr (BASE16) {
            ER_LOAD(A, 0); ER_LOAD(B, 1); ER_LOAD(C, 2); ER_LOAD(D, 3); ER_FENCE;
            ER_LOAD(E, 4); ER_FENCE; ER_WORK(A, 0); ER_FENCE;
            ER_LOAD(A, 5); ER_FENCE; ER_WORK(B, 1); ER_FENCE;
            ER_LOAD(B, 6); ER_FENCE; ER_WORK(C, 2); ER_FENCE;
            ER_LOAD(C, 7); ER_FENCE; ER_WORK(D, 3); ER_FENCE;
            ER_WORK(E, 4); ER_FENCE; ER_WORK(A, 5); ER_FENCE; ER_WORK(B, 6); ER_FENCE; ER_WORK(C, 7);
        } else {
            ER_LOAD(A, 0); ER_LOAD(B, 1); ER_FENCE;
            ER_LOAD(C, 2); ER_FENCE; ER_WORK(A, 0); ER_FENCE;
            ER_LOAD(A, 3); ER_FENCE; ER_WORK(B, 1); ER_FENCE;
            ER_LOAD(B, 4); ER_FENCE; ER_WORK(C, 2); ER_FENCE;
            ER_LOAD(C, 5); ER_FENCE; ER_WORK(A, 3); ER_FENCE;
            ER_LOAD(A, 6); ER_FENCE; ER_WORK(B, 4); ER_FENCE;
            ER_LOAD(B, 7); ER_FENCE; ER_WORK(C, 5); ER_FENCE;
            ER_WORK(A, 6); ER_FENCE;
            ER_WORK(B, 7);
        }
#undef ER_FENCE
#undef ER_LOAD
#undef ER_WORK
        if (fq == 0) {
#pragma unroll
            for (int ai = 0; ai < 2; ++ai)
#pragma unroll
                for (int m = 0; m < 4; ++m) { float* pp = part + ((size_t)u.pn * RS_M + (row0 + ai * HALF + m * 16)) * 4 + wc;
                    if (FINAL) __hip_atomic_store(pp, ssv[ai][m], __ATOMIC_RELAXED, __HIP_MEMORY_SCOPE_AGENT); else *pp = ssv[ai][m]; }
        }
        if (FINAL) {
            asm volatile("s_waitcnt vmcnt(0)" ::: "memory");
            unsigned* cw = cnt + 64 * u.pm;
            if (fr == 0 && fq == 0) __hip_atomic_fetch_add(cw, 1u, __ATOMIC_RELAXED, __HIP_MEMORY_SCOPE_AGENT);
            { unsigned sp = 0; while ((unsigned)__builtin_amdgcn_readfirstlane(__hip_atomic_load(cw, __ATOMIC_RELAXED, __HIP_MEMORY_SCOPE_AGENT)) < 32u) { __builtin_amdgcn_s_sleep(2); if (++sp > (1u << 22)) break; } }
            f32x4 gf[2][2];
#pragma unroll
            for (int bj = 0; bj < 2; ++bj)
#pragma unroll
                for (int n = 0; n < 2; ++n) gf[bj][n] = *(const f32x4*)(gfin + col0 + bj * HALF + n * 4);
            float rr[2][4];
            {
                f32x4 pq[8];
#pragma unroll
                for (int i = 0; i < 8; ++i) { const float* pp = part + ((size_t)fq * RS_M + (row0 + (i >> 2) * HALF + (i & 3) * 16)) * 4;
                    asm volatile("global_load_dwordx4 %0, %1, off sc1" : "=v"(pq[i]) : "v"(pp) : "memory"); }
                asm volatile("s_waitcnt vmcnt(0)" : "+v"(pq[0]), "+v"(pq[1]), "+v"(pq[2]), "+v"(pq[3]), "+v"(pq[4]), "+v"(pq[5]), "+v"(pq[6]), "+v"(pq[7]) :: "memory");
#pragma unroll
                for (int i = 0; i < 8; ++i) { float t = (pq[i][0] + pq[i][1]) + (pq[i][2] + pq[i][3]); t = xor32_add(xor16_add(t)); rr[i >> 2][i & 3] = __builtin_amdgcn_rsqf(t * (1.0f / 1024.0f) + 1e-6f); }
            }
#pragma unroll
            for (int ai = 0; ai < 2; ++ai)
#pragma unroll
                for (int m = 0; m < 4; ++m) { const size_t off = (size_t)(row0 + ai * HALF + m * 16) * 1024 + col0;
#pragma unroll
                    for (int bj = 0; bj < 2; ++bj)
#pragma unroll
                        for (int n = 0; n < 2; ++n) *(f32x4*)(out + off + bj * HALF + n * 4) = acc[ai][bj][m][n] * rr[ai][m] * gf[bj][n]; }
        }
    }
};
template <int L> struct EpiSwiglu {
    static constexpr bool PERM = true, AFTER_DRAIN = false;
    ArgsP A; const PG8_LAS float* rtab; int pm0;
    __device__ __forceinline__ void operator()(const f32x4 (&acc)[2][2][4][2], const Unit& u, int wr, int wc, int fr_, int fq_) const {
        int t_ = threadIdx.x; asm volatile("" : "+v"(t_)); const int fr = t_ & 15, fq = (t_ >> 4) & 3; (void)fr_; (void)fq_;
        const int row0 = u.pm * BM + wr * 64 + fr, col0 = u.pn * HALF + wc * 32 + 8 * fq;
        ArgsP a_ = A; asm volatile("" : "+s"(a_)); unsigned char* ws_ = a_->ws; constexpr int ldh = FF;
        bf16_t* H = (bf16_t*)(ws_ + WS_H); const float* rowss = (const float*)(ws_ + WS_PART) + (size_t)(L ? 2 : 0) * 16 * RS_M; const float* bias = (const float*)(ws_ + WS_BIAS) + (size_t)L * 8 * 5632;
        const float* bp = bias + (size_t)(u.pm >> 4) * 5632 + u.pn * BM + wc * 32 + 8 * fq;
        f32x4 bv[2][2];
#pragma unroll
        for (int bj = 0; bj < 2; ++bj)
#pragma unroll
            for (int n = 0; n < 2; ++n) bv[bj][n] = *(const f32x4*)(bp + bj * HALF + 4 * n);
        float rr[2][4]; { const PG8_LAS float* rt = rtab + (u.pm == pm0 ? 0 : 256) + wr * 64 + fr; (void)rowss;
#pragma unroll
            for (int ai = 0; ai < 2; ++ai)
#pragma unroll
                for (int m = 0; m < 4; ++m) rr[ai][m] = rt[ai * HALF + m * 16]; }
#pragma unroll
        for (int ai = 0; ai < 2; ++ai)
#pragma unroll
            for (int m = 0; m < 4; ++m) { const int row = row0 + ai * HALF + m * 16; const float r = rr[ai][m]; f32x4 h[2];
#pragma unroll
                for (int n = 0; n < 2; ++n) { const f32x4 a = acc[ai][0][m][n] * r + bv[0][n], b = acc[ai][1][m][n] * r + bv[1][n]; h[n] = (f32x4){silu1(a[0]) * b[0], silu1(a[1]) * b[1], silu1(a[2]) * b[2], silu1(a[3]) * b[3]}; }
                *(u32x4*)(H + (size_t)row * ldh + col0) = pack8(h[0], h[1]); }
    }
};

struct EpiNull {
    static constexpr bool PERM = true, AFTER_DRAIN = false;
    bf16_t* D;
    __device__ __forceinline__ void operator()(const f32x4 (&acc)[2][2][4][2], const Unit& u, int wr, int wc, int fr_, int fq_) const {
        int t_ = threadIdx.x; asm volatile("" : "+v"(t_)); const int fr = t_ & 15, fq = (t_ >> 4) & 3; (void)fr_; (void)fq_;
        const int row0 = u.pm * BM + wr * 64 + fr, col0 = u.pn * BM + wc * 32 + 8 * fq;
#pragma unroll
        for (int ai = 0; ai < 2; ++ai)
#pragma unroll
            for (int m = 0; m < 4; ++m)
#pragma unroll
                for (int bj = 0; bj < 2; ++bj) *(u32x4*)(D + (size_t)(row0 + ai * HALF + m * 16) * 1024 + col0 + bj * HALF) = pack8(acc[ai][bj][m][0], acc[ai][bj][m][1]);
    }
};
struct EpiNullWide {
    static constexpr bool PERM = true, AFTER_DRAIN = false;
    bf16_t* D;
    __device__ __forceinline__ void operator()(const f32x4 (&acc)[2][2][4][2], const Unit& u, int wr, int wc, int fr_, int fq_) const {
        int t_ = threadIdx.x; asm volatile("" : "+v"(t_)); const int fr = t_ & 15, fq = (t_ >> 4) & 3; (void)fr_; (void)fq_;
        const int row0 = u.pm * BM + wr * 64 + fr, col0 = u.pn * HALF + wc * 32 + 8 * fq;
#pragma unroll
        for (int ai = 0; ai < 2; ++ai)
#pragma unroll
            for (int m = 0; m < 4; ++m) *(u32x4*)(D + (size_t)(row0 + ai * HALF + m * 16) * 2816 + col0) = pack8(acc[ai][0][m][0] + acc[ai][1][m][0], acc[ai][0][m][1] + acc[ai][1][m][1]);
    }
};
struct EpiZ {
    static constexpr bool PERM = true, AFTER_DRAIN = false;
    ArgsP A;
    __device__ __forceinline__ void operator()(const f32x4 (&acc)[2][2][4][2], const Unit& u, int wr, int wc, int fr_, int fq_) const {
        int t_ = threadIdx.x; asm volatile("" : "+v"(t_)); const int fr = t_ & 15, fq = (t_ >> 4) & 3; (void)fr_; (void)fq_;
        const int row0 = u.pm * BM + wr * 64 + fr, col0 = u.pn * BM + wc * 32 + 8 * fq;
        ArgsP a_ = A; asm volatile("" : "+s"(a_)); unsigned char* ws_ = a_->ws; bf16_t* Z = (bf16_t*)(ws_ + WS_AM);
#pragma unroll
        for (int ai = 0; ai < 2; ++ai)
#pragma unroll
            for (int m = 0; m < 4; ++m)
#pragma unroll
                for (int bj = 0; bj < 2; ++bj) *(u32x4*)(Z + (size_t)(row0 + ai * HALF + m * 16) * 1024 + col0 + bj * HALF) = pack8(acc[ai][bj][m][0], acc[ai][bj][m][1]);
    }
};

template <class Epi, class Sched, bool ALIGN_EPI = false, bool SP2 = false>
__device__ __forceinline__ void gemm_phase(PG8_LAS unsigned char* lds, const Gemm g, const Sched& S, const Epi& E) {
    int tid_ = threadIdx.x; asm volatile("" : "+v"(tid_));
    const int tid = tid_, wid = __builtin_amdgcn_readfirstlane(tid >> 6), lane = tid & 63, wr = wid >> 2, wc = wid & 3, fr = lane & 15, fq = lane >> 4;
    const int K = g.K, nt = K / BK;
    unsigned voffA[2], voffB[2];
#pragma unroll
    for (int i = 0; i < 2; ++i) { int R, C; stage_rc(tid * 16 + i * 8192, R, C); const int Rb = Epi::PERM ? ((R & ~31) + perm32(R & 31)) : R;
        voffA[i] = (unsigned)(R * g.lda + C) * 2u; voffB[i] = (unsigned)(Rb * K + C) * 2u; }
    const size_t kstep = (size_t)(BK * 2);
    const size_t hsA = (size_t)HALF * g.lda * 2, hsB = (size_t)HALF * K * 2;
    const size_t tsA = 2 * hsA, tsB = 2 * hsB;
    const unsigned ldsw = (unsigned)wid * 1024u;
    const int aoff = lds_byte(wr * 64 + fr, fq * 8), boff = lds_byte(wc * 32 + fr, fq * 8);
#define PG8_SA(b, h) (((b) * 2 + (h)) * HTB)
#define PG8_SB(b, h) ((4 + (b) * 2 + (h)) * HTB)
#define PG8_STAGE(bufoff, gbase, voff) do { _Pragma("unroll") for (int _i = 0; _i < 2; ++_i) \
        __builtin_amdgcn_global_load_lds((const unsigned*)((const char*)(gbase) + (voff)[_i]), (PG8_LAS unsigned*)(lds + (bufoff) + ldsw + _i * 8192), 16, 0, 0); } while (0)
#define PG8_LDA(dst, b, h) do { _Pragma("unroll") for (int m = 0; m < 4; ++m) _Pragma("unroll") for (int k = 0; k < 2; ++k) dst[m][k] = *(const PG8_LAS bf16x8*)(lds + PG8_SA(b, h) + aoff + m * 2048 + k * 1024); } while (0)
#define PG8_LDB(dst, b, h) do { _Pragma("unroll") for (int n = 0; n < 2; ++n) _Pragma("unroll") for (int k = 0; k < 2; ++k) dst[n][k] = *(const PG8_LAS bf16x8*)(lds + PG8_SB(b, h) + boff + n * 2048 + k * 1024); } while (0)
#define PG8_MMA(ai, bj, At, Bt) do { __builtin_amdgcn_s_setprio(1); _Pragma("unroll") for (int m = 0; m < 4; ++m) _Pragma("unroll") for (int n = 0; n < 2; ++n) _Pragma("unroll") for (int k = 0; k < 2; ++k) \
        acc[ai][bj][m][n] = __builtin_amdgcn_mfma_f32_16x16x32_bf16(Bt[n][k], At[m][k], acc[ai][bj][m][n], 0, 0, 0); __builtin_amdgcn_s_setprio(0); } while (0)
#define PG8_WAIT_V(n) asm volatile("s_waitcnt vmcnt(" #n ")" ::: "memory")
#define PG8_WAIT_L(n) asm volatile("s_waitcnt lgkmcnt(" #n ")" ::: "memory")
#define PG8_BAR __builtin_amdgcn_s_barrier()
#define PG8_SCHED __builtin_amdgcn_sched_barrier(0)
    Unit cur, nxt; int ui = 0;
    if (!S.next(0, cur)) return;
    f32x4 acc[2][2][4][2];
#pragma unroll
    for (int a = 0; a < 2; ++a)
#pragma unroll
        for (int b = 0; b < 2; ++b)
#pragma unroll
            for (int m = 0; m < 4; ++m)
#pragma unroll
                for (int n = 0; n < 2; ++n) acc[a][b][m][n] = (f32x4){0.f, 0.f, 0.f, 0.f};
    bf16x8 At[4][2], B0[2][2], B1[2][2];
    const char* cA = (const char*)g.A + (size_t)cur.pm * tsA + (size_t)cur.pn * g.a_pn_bytes; const char* cB = (const char*)g.Bt + (size_t)cur.pn * tsB + (size_t)(cur.pm >> 4) * g.b_batch_bytes;
    S.a_ready(cur);
    if constexpr (SP2) {
        PG8_STAGE(PG8_SB(0, 0), cB, voffB); PG8_STAGE(PG8_SB(0, 1), cB + hsB, voffB); PG8_STAGE(PG8_SA(0, 0), cA, voffA); PG8_STAGE(PG8_SA(0, 1), cA + hsA, voffA);
        if (wr == 1) PG8_BAR;
        PG8_WAIT_V(2); PG8_BAR;
        PG8_STAGE(PG8_SB(1, 0), cB + kstep, voffB); PG8_STAGE(PG8_SA(1, 0), cA + kstep, voffA); PG8_STAGE(PG8_SB(1, 1), cB + hsB + kstep, voffB);
        PG8_WAIT_V(6); PG8_BAR;
    } else {
        PG8_STAGE(PG8_SB(0, 0), cB, voffB); PG8_STAGE(PG8_SA(0, 0), cA, voffA); PG8_STAGE(PG8_SB(0, 1), cB + hsB, voffB); PG8_STAGE(PG8_SA(0, 1), cA + hsA, voffA);
        if (wr == 1) PG8_BAR;
        PG8_WAIT_V(4); PG8_BAR;
        PG8_STAGE(PG8_SB(1, 0), cB + kstep, voffB); PG8_STAGE(PG8_SA(1, 0), cA + kstep, voffA); PG8_STAGE(PG8_SB(1, 1), cB + hsB + kstep, voffB);
        PG8_WAIT_V(6); PG8_BAR;
    }
    for (;;) {
        const bool has_next = S.next(ui + 1, nxt);
        const char* nA = has_next ? (const char*)g.A + (size_t)nxt.pm * tsA + (size_t)nxt.pn * g.a_pn_bytes : cA; const char* nB = has_next ? (const char*)g.Bt + (size_t)nxt.pn * tsB + (size_t)(nxt.pm >> 4) * g.b_batch_bytes : cB;
#pragma unroll 1
        for (int t = 0; t < nt; t += 2) {
            const bool last = (t == nt - 2);
            const char* a1 = cA + (size_t)(t + 1) * kstep;
            const char* a2 = last ? nA : cA + (size_t)(t + 2) * kstep; const char* b2 = last ? nB : cB + (size_t)(t + 2) * kstep;
            const char* a3 = a2 + kstep; const char* b3 = b2 + kstep;
            if (last && has_next) S.a_ready(nxt);
            if constexpr (SP2) {
            PG8_LDB(B0, 0, 0); PG8_LDB(B1, 0, 1); PG8_SCHED; PG8_LDA(At, 0, 0); PG8_STAGE(PG8_SA(1, 1), a1 + hsA, voffA);
            PG8_WAIT_V(8); PG8_WAIT_L(0); PG8_BAR; PG8_MMA(0, 0, At, B0); PG8_MMA(0, 1, At, B1); PG8_BAR; PG8_SCHED;
            PG8_LDA(At, 0, 1); PG8_STAGE(PG8_SB(0, 0), b2, voffB); PG8_STAGE(PG8_SB(0, 1), b2 + hsB, voffB); PG8_STAGE(PG8_SA(0, 0), a2, voffA);
            PG8_WAIT_V(8); PG8_WAIT_L(0); PG8_BAR; PG8_MMA(1, 0, At, B0); PG8_MMA(1, 1, At, B1); PG8_BAR; PG8_SCHED;
            PG8_LDB(B0, 1, 0); PG8_LDB(B1, 1, 1); PG8_SCHED; PG8_LDA(At, 1, 0); PG8_STAGE(PG8_SA(0, 1), a2 + hsA, voffA);
            PG8_WAIT_V(8); PG8_WAIT_L(0); PG8_BAR; PG8_MMA(0, 0, At, B0); PG8_MMA(0, 1, At, B1); PG8_BAR; PG8_SCHED;
            PG8_LDA(At, 1, 1); PG8_STAGE(PG8_SB(1, 0), b3, voffB); PG8_STAGE(PG8_SB(1, 1), b3 + hsB, voffB); PG8_STAGE(PG8_SA(1, 0), a3, voffA);
            PG8_WAIT_V(8); PG8_WAIT_L(0); PG8_BAR; PG8_MMA(1, 0, At, B0); PG8_MMA(1, 1, At, B1); PG8_BAR; PG8_SCHED;
            } else {
            PG8_LDB(B0, 0, 0); PG8_SCHED; PG8_LDA(At, 0, 0); PG8_STAGE(PG8_SA(1, 1), a1 + hsA, voffA);
            PG8_WAIT_L(8); PG8_BAR; PG8_WAIT_L(0); PG8_MMA(0, 0, At, B0); PG8_BAR; PG8_SCHED;
            PG8_LDB(B1, 0, 1); PG8_STAGE(PG8_SB(0, 0), b2, voffB);
            PG8_BAR; PG8_WAIT_L(0); PG8_MMA(0, 1, At, B1); PG8_BAR;
            PG8_LDA(At, 0, 1); PG8_STAGE(PG8_SA(0, 0), a2, voffA);
            PG8_BAR; PG8_WAIT_L(0); PG8_MMA(1, 0, At, B0); PG8_BAR; PG8_SCHED;
            PG8_STAGE(PG8_SB(0, 1), b2 + hsB, voffB);
            PG8_WAIT_V(6); PG8_BAR; PG8_MMA(1, 1, At, B1); PG8_BAR;
            PG8_LDB(B0, 1, 0); PG8_SCHED; PG8_LDA(At, 1, 0); PG8_STAGE(PG8_SA(0, 1), a2 + hsA, voffA);
            PG8_WAIT_L(8); PG8_BAR; PG8_WAIT_L(0); PG8_MMA(0, 0, At, B0); PG8_BAR; PG8_SCHED;
            PG8_LDB(B1, 1, 1); PG8_STAGE(PG8_SB(1, 0), b3, voffB);
            PG8_BAR; PG8_WAIT_L(0); PG8_MMA(0, 1, At, B1); PG8_BAR;
            PG8_LDA(At, 1, 1); PG8_STAGE(PG8_SA(1, 0), a3, voffA);
            PG8_BAR; PG8_WAIT_L(0); PG8_MMA(1, 0, At, B0); PG8_BAR; PG8_SCHED;
            PG8_STAGE(PG8_SB(1, 1), b3 + hsB, voffB);
            PG8_WAIT_V(6); PG8_BAR; PG8_MMA(1, 1, At, B1); PG8_BAR;
            }
        }
        if constexpr (ALIGN_EPI) { if (wr == 0) PG8_BAR; }
        if constexpr (!Epi::AFTER_DRAIN) { E(acc, cur, wr, wc, fr, fq); S.done(cur); }
        if (!has_next) break;
#pragma unroll
        for (int a = 0; a < 2; ++a)
#pragma unroll
            for (int b = 0; b < 2; ++b)
#pragma unroll
                for (int m = 0; m < 4; ++m)
#pragma unroll
                    for (int n = 0; n < 2; ++n) acc[a][b][m][n] = (f32x4){0.f, 0.f, 0.f, 0.f};
        cur = nxt; cA = nA; cB = nB; ++ui;
        if constexpr (ALIGN_EPI) { if (wr == 1) PG8_BAR; }
    }
    PG8_WAIT_V(0);
    if constexpr (!ALIGN_EPI) { if (wr == 0) PG8_BAR; }
    PG8_BAR;
    if constexpr (Epi::AFTER_DRAIN) { E.fused(acc, cur, wr, wc, fr, fq, lds, wid, lane); S.done(cur); }
#undef PG8_SA
#undef PG8_SB
#undef PG8_STAGE
#undef PG8_LDA
#undef PG8_LDB
#undef PG8_MMA
#undef PG8_WAIT_V
#undef PG8_WAIT_L
#undef PG8_BAR
#undef PG8_SCHED
}
}
namespace attn_body {
using bf16=__hip_bfloat16;
using bf16x8=__attribute__((ext_vector_type(8)))short;
using s16x4=__attribute__((ext_vector_type(4)))short;
using f32x16=__attribute__((ext_vector_type(16)))float;
using u32x4=__attribute__((ext_vector_type(4)))unsigned;
constexpr int BATCH=8,NHEAD=8,NKVH=2,SEQ=4096,SKV=4352,D=64,QP=512,KP=128,OP=1024;
constexpr int NW=8,QBLK=32,QB=QBLK*NW,KVBLK=64,NQB=SEQ/QB;
constexpr int ATTN_UNIT_ROWS=QB;
__device__ __forceinline__ int crow(int r,int hi){return (r&3)+8*(r>>2)+4*hi;}
#define SBAR() __builtin_amdgcn_sched_barrier(0)
constexpr int NSLOT=3, SLOTB=8192;
constexpr int LDS_K=0, LDS_V=NSLOT*SLOTB, LDS_WS=2*NSLOT*SLOTB, LDS_OST=LDS_WS+NW*64*4, LDS_BYTES=LDS_OST+NW*4096;
constexpr float C2=0.125f*1.4426950408889634f;
__device__ __forceinline__ void glds16(const void*gsrc,unsigned lds_dst){unsigned keep;
  asm volatile("s_mov_b32 %0, m0\n\ts_mov_b32 m0, %2\n\ts_nop 0\n\tglobal_load_lds_dwordx4 %1, off\n\ts_mov_b32 m0, %0":"=&s"(keep):"v"(gsrc),"s"(lds_dst):"memory");}
__device__ __forceinline__ void glds16_nt(const void*gsrc,unsigned lds_dst){unsigned keep;
  asm volatile("s_mov_b32 %0, m0\n\ts_mov_b32 m0, %2\n\ts_nop 0\n\tglobal_load_lds_dwordx4 %1, off nt\n\ts_mov_b32 m0, %0":"=&s"(keep):"v"(gsrc),"s"(lds_dst):"memory");}
__device__ __forceinline__ float max3f(float a,float b,float c){float r;asm("v_max3_f32 %0, %1, %2, %3":"=v"(r):"v"(a),"v"(b),"v"(c));return r;}
__device__ __forceinline__ float max2f(float a,float b){float r;asm("v_max_f32_e32 %0, %1, %2":"=v"(r):"v"(a),"v"(b));return r;}
__device__ __forceinline__ float fadd_s(float a,float b){float r;asm("v_add_f32_e32 %0, %1, %2":"=v"(r):"v"(a),"v"(b));return r;}
__device__ __forceinline__ float fsub_s(float a,float b){float r;asm("v_sub_f32_e32 %0, %1, %2":"=v"(r):"v"(a),"v"(b));return r;}
typedef float f32x2_t __attribute__((ext_vector_type(2))); typedef __bf16 bf16x2_t __attribute__((ext_vector_type(2)));
__device__ __forceinline__ unsigned cvtpk_s(float lo,float hi){f32x2_t v={lo,hi};bf16x2_t b=__builtin_convertvector(v,bf16x2_t);return __builtin_bit_cast(unsigned,b);}
#define WAIT_BAR(N) asm volatile("s_waitcnt vmcnt(" #N ") lgkmcnt(0)\n\ts_barrier":::"memory")

__device__ __forceinline__ void qkt(f32x16&p0,f32x16&p1,const char*Kslot,const bf16x8*qr,const f32x16&negm,int r32,int hi){
  const char*kb=Kslot+hi*1024+r32*16;
  #pragma unroll
  for(int d0=0;d0<4;++d0){
    const bf16x8 b0=*reinterpret_cast<const bf16x8*>(kb+d0*2048);
    const bf16x8 b1=*reinterpret_cast<const bf16x8*>(kb+d0*2048+512);
    if(d0==0){p0=__builtin_amdgcn_mfma_f32_32x32x16_bf16(b0,qr[0],negm,0,0,0);p1=__builtin_amdgcn_mfma_f32_32x32x16_bf16(b1,qr[0],negm,0,0,0);}
    else{p0=__builtin_amdgcn_mfma_f32_32x32x16_bf16(b0,qr[d0],p0,0,0,0);p1=__builtin_amdgcn_mfma_f32_32x32x16_bf16(b1,qr[d0],p1,0,0,0);}}
}
typedef __attribute__((address_space(3))) const char* lds_cptr;
typedef short v4i16_t __attribute__((ext_vector_type(4)));
__device__ __forceinline__ void kload8(bf16x8*kf,lds_cptr kp){
  kf[0]=*(const __attribute__((address_space(3))) bf16x8*)(kp);      kf[1]=*(const __attribute__((address_space(3))) bf16x8*)(kp+512);
  kf[2]=*(const __attribute__((address_space(3))) bf16x8*)(kp+2048); kf[3]=*(const __attribute__((address_space(3))) bf16x8*)(kp+2560);
  kf[4]=*(const __attribute__((address_space(3))) bf16x8*)(kp+4096); kf[5]=*(const __attribute__((address_space(3))) bf16x8*)(kp+4608);
  kf[6]=*(const __attribute__((address_space(3))) bf16x8*)(kp+6144); kf[7]=*(const __attribute__((address_space(3))) bf16x8*)(kp+6656);
}
__device__ __forceinline__ void kload2(bf16x8*kf,lds_cptr kp,int j){ kf[2*j]=*(const __attribute__((address_space(3))) bf16x8*)(kp+j*2048); kf[2*j+1]=*(const __attribute__((address_space(3))) bf16x8*)(kp+j*2048+512); }
__device__ __forceinline__ s16x4 vtr(lds_cptr p){ return __builtin_bit_cast(s16x4,__builtin_amdgcn_ds_read_tr16_b64_v4i16((__attribute__((address_space(3))) v4i16_t*)p)); }
__device__ __forceinline__ float rowmax(const f32x16&p0,const f32x16&p1){
  float a=max3f(p0[0],p0[1],p1[0]),b=max3f(p0[2],p0[3],p1[1]);a=max3f(a,p1[2],p1[3]);
  #pragma unroll
  for(int r=4;r<16;r+=4){a=max3f(a,p0[r],p0[r+1]);b=max3f(b,p0[r+2],p0[r+3]);a=max3f(a,p1[r],p1[r+1]);b=max3f(b,p1[r+2],p1[r+3]);}
  const float m=max2f(a,b);
  auto rr=__builtin_amdgcn_permlane32_swap(__float_as_uint(m),__float_as_uint(m),false,false);
  return max2f(__uint_as_float(rr[0]),__uint_as_float(rr[1]));
}
__device__ __forceinline__ void pv(f32x16*o,int vb,bf16x8 pa0,bf16x8 pa1,bf16x8 pa2,bf16x8 pa3){
  #pragma unroll
  for(int d0=0;d0<2;++d0){s16x4 lo[4],hi[4];
    #pragma unroll
    for(int ks=0;ks<4;++ks){
      asm volatile("ds_read_b64_tr_b16 %0,%1 offset:%c2":"=&v"(lo[ks]):"v"(vb),"i"(d0*4096+ks*1024):"memory");
      asm volatile("ds_read_b64_tr_b16 %0,%1 offset:%c2":"=&v"(hi[ks]):"v"(vb),"i"(d0*4096+ks*1024+512):"memory");}
    asm volatile("s_waitcnt lgkmcnt(0)":::"memory");SBAR();
    #define PK(k) (bf16x8){lo[k][0],lo[k][1],lo[k][2],lo[k][3],hi[k][0],hi[k][1],hi[k][2],hi[k][3]}
    o[d0]=__builtin_amdgcn_mfma_f32_32x32x16_bf16(pa0,PK(0),o[d0],0,0,0);
    o[d0]=__builtin_amdgcn_mfma_f32_32x32x16_bf16(pa1,PK(1),o[d0],0,0,0);
    o[d0]=__builtin_amdgcn_mfma_f32_32x32x16_bf16(pa2,PK(2),o[d0],0,0,0);
    o[d0]=__builtin_amdgcn_mfma_f32_32x32x16_bf16(pa3,PK(3),o[d0],0,0,0);
    #undef PK
  }
}

#ifndef ATTN_STORE16
#define ATTN_STORE16(p,v) (*(u32x4*)(p)=(v))
#endif
template<int THRL,bool FIX> __device__ __forceinline__ void attn_unit(int b,int h,int qb,const bf16*Q,const bf16*__restrict__ K,const bf16*__restrict__ V,bf16*O,char*shm,float sref){
  int tid_=threadIdx.x; asm volatile("":"+v"(tid_)); const int tid=tid_,lane=tid&63,r32=lane&31,hi=lane>>5; const int wid=__builtin_amdgcn_readfirstlane(tid>>6);
  const long rowbase=(long)b*SEQ, kvbase=(long)b*SKV; const int q0=qb*QB;
  const bf16*Qw=Q+(rowbase+q0+wid*QBLK)*QP+h*D;
  const bf16*Kh=K+kvbase*KP+(h/(NHEAD/NKVH))*D,*Vh=V+kvbase*KP+(h/(NHEAD/NKVH))*D;
  const unsigned lds0=(unsigned)(uintptr_t)shm;
  float*wsf=(float*)(shm+LDS_WS)+wid*64;
  const bf16*ksrc=Kh+(long)lane*KP+wid*8;
  const bf16*vsrc=Vh+(long)(16*(wid&3)+(lane>>2))*KP+(wid>>2)*32+(lane&3)*8;
  const unsigned kdst=lds0+LDS_K+wid*1024, vdst=lds0+LDS_V+wid*1024;
  #define DMA_K(t,slot) glds16(ksrc+(long)(t)*KVBLK*KP,(unsigned)__builtin_amdgcn_readfirstlane(kdst+(slot)))
  #define DMA_V(t,slot) glds16(vsrc+(long)(t)*KVBLK*KP,(unsigned)__builtin_amdgcn_readfirstlane(vdst+(slot)))
  const int vb0=(int)(lds0+LDS_V)+((lane>>4)&1)*32+(lane&3)*8+(4*hi+((lane&15)>>2))*64;
  const char*Kbase=shm+LDS_K; bf16x8 kf[8];
  const lds_cptr shm3=(lds_cptr)shm; const lds_cptr kp0=shm3+LDS_K+hi*1024+r32*16; const lds_cptr vp0=shm3+LDS_V+((lane>>4)&1)*32+(lane&3)*8+(4*hi+((lane&15)>>2))*64;
  constexpr int NT=SKV/KVBLK;
  DMA_K(0,0);DMA_V(0,0);DMA_K(1,SLOTB);
  bf16x8 qr[4];
  #pragma unroll
  for(int d0=0;d0<4;++d0)qr[d0]=__builtin_nontemporal_load(reinterpret_cast<const bf16x8*>(&Qw[(long)r32*QP+d0*16+hi*8]));
  float mhat=0.f,l_reg=0.f;f32x16 o[2];o[0]=f32x16{};o[1]=f32x16{};f32x16 negm=f32x16{};
  if constexpr(FIX){ _Pragma("unroll") for(int r=0;r<16;++r)negm[r]=-sref; }
  asm volatile("":"+v"(negm));
  #define CMASK(P0,P1,t) do{}while(0)
  bool resc=false;
  #define START(P0,P1) do{ resc=false; if constexpr(!FIX) \
    { const float rm=rowmax(P0,P1); const float dl=rm; mhat=fadd_s(mhat,dl); \
      _Pragma("unroll") for(int r=0;r<16;++r){P0[r]=fsub_s(P0[r],dl);P1[r]=fsub_s(P1[r],dl);} \
      _Pragma("unroll") for(int r=0;r<16;++r)negm[r]=-mhat; asm volatile("":"+v"(negm)); } \
    _Pragma("unroll") for(int r=0;r<16;++r)P0[r]=__builtin_amdgcn_exp2f(P0[r]); }while(0)
  #define RESC() do{ if constexpr(!FIX) if(resc){ asm volatile("s_waitcnt lgkmcnt(0)":::"memory"); \
      _Pragma("unroll") for(int d_=0;d_<2;++d_) _Pragma("unroll") for(int r=0;r<16;++r)o[d_][r]*=wsf[crow(r,hi)]; } }while(0)
  f32x16 pA0,pA1,pB0,pB1;
  int sl_prev=0,sl_cur=0,sl_next=SLOTB;
  #define ROT() do{sl_prev=sl_cur;sl_cur=sl_next;sl_next=(sl_next==(NSLOT-1)*SLOTB)?0:sl_next+SLOTB;}while(0)
  DMA_K(2,2*SLOTB);
  WAIT_BAR(3);
  qkt(pA0,pA1,Kbase,qr,negm,r32,hi);asm volatile("s_nop 15\n\ts_nop 7":"+v"(pA0),"+v"(pA1));CMASK(pA0,pA1,0);
  START(pA0,pA1);
  _Pragma("unroll") for(int r=0;r<16;++r)pA1[r]=__builtin_amdgcn_exp2f(pA1[r]);
  WAIT_BAR(0);
  DMA_K(3,0);DMA_V(1,SLOTB);
  ROT();
  kload8(kf,kp0+sl_cur);
  WAIT_BAR(2);
  s16x4 vlo[8],vhi[8]; u32x4 pw0,pw1,pw2,pw3;
  #define PKW(P,B) cvtpk_s(P[B],P[B+1])
  #define PAF(k) __builtin_bit_cast(bf16x8,pw##k)
  #define VFR(i) (bf16x8){vlo[i][0],vlo[i][1],vlo[i][2],vlo[i][3],vhi[i][0],vhi[i][1],vhi[i][2],vhi[i][3]}
  #define PIN(x) asm volatile("":"+v"(x))
  #define MX3(a,b,c) __builtin_fmaxf(__builtin_fmaxf((a),(b)),(c))
  #define GAPA(MF,A0,A1,A2,A3,W0,W1,PW) do{ MF; sacc+=A0; sacc+=A1; sacc+=A2; sacc+=A3; PIN(sacc); W0; W1; PIN(PW); SBAR(); }while(0)
  #define EX(v) __builtin_amdgcn_exp2f(v)
  #define GAPB(MF,X,B) do{ MF; X[B]=EX(X[B]); X[B+1]=EX(X[B+1]); X[B+2]=EX(X[B+2]); X[B+3]=EX(X[B+3]); PIN(X); SBAR(); }while(0)
  #define VRD(i) do{ vlo[i]=vtr(vp_+(((i)>>2)*4096+((i)&3)*1024)); vhi[i]=vtr(vp_+(((i)>>2)*4096+((i)&3)*1024+512)); }while(0)
  #define KRD(G,j) do{ if(G){ kload2(kf,kp0+sl_next,j); SBAR(); } }while(0)
  #define STEP(C0,C1,P0,P1,t,GK,GV,GL) do{ SBAR(); \
    const lds_cptr vp_=vp0+sl_prev; \
    VRD(0); SBAR(); float sacc=(P0[0]+P0[1]); \
    GAPA(C0=__builtin_amdgcn_mfma_f32_32x32x16_bf16(kf[0],qr[0],negm,0,0,0), P0[2],P0[3],P0[4],P0[5],     pw0[0]=PKW(P0,0), pw0[1]=PKW(P0,2), pw0); \
    VRD(4); SBAR(); GAPA(C1=__builtin_amdgcn_mfma_f32_32x32x16_bf16(kf[1],qr[0],negm,0,0,0), P0[6],P0[7],P0[8],P0[9],     pw0[2]=PKW(P0,4), pw0[3]=PKW(P0,6), pw0); \
    VRD(1); SBAR(); GAPA(C0=__builtin_amdgcn_mfma_f32_32x32x16_bf16(kf[2],qr[1],C0,0,0,0),   P0[10],P0[11],P0[12],P0[13], pw1[0]=PKW(P0,8), pw1[1]=PKW(P0,10), pw1); \
    VRD(5); SBAR(); GAPA(C1=__builtin_amdgcn_mfma_f32_32x32x16_bf16(kf[3],qr[1],C1,0,0,0),   P0[14],P0[15],P1[0],P1[1],   pw1[2]=PKW(P0,12),pw1[3]=PKW(P0,14), pw1); \
    VRD(2); SBAR(); GAPA(C0=__builtin_amdgcn_mfma_f32_32x32x16_bf16(kf[4],qr[2],C0,0,0,0),   P1[2],P1[3],P1[4],P1[5],     pw2[0]=PKW(P1,0), pw2[1]=PKW(P1,2), pw2); \
    VRD(6); SBAR(); GAPA(C1=__builtin_amdgcn_mfma_f32_32x32x16_bf16(kf[5],qr[2],C1,0,0,0),   P1[6],P1[7],P1[8],P1[9],     pw2[2]=PKW(P1,4), pw2[3]=PKW(P1,6), pw2); \
    VRD(3); SBAR(); GAPA(C0=__builtin_amdgcn_mfma_f32_32x32x16_bf16(kf[6],qr[3],C0,0,0,0),   P1[10],P1[11],P1[12],P1[13], pw3[0]=PKW(P1,8), pw3[1]=PKW(P1,10), pw3); \
    VRD(7); SBAR(); GAPA(C1=__builtin_amdgcn_mfma_f32_32x32x16_bf16(kf[7],qr[3],C1,0,0,0),   P1[14],P1[15],0.f,0.f,       pw3[2]=PKW(P1,12),pw3[3]=PKW(P1,14), pw3); \
    l_reg+=sacc; \
    if(GK){DMA_K((t)+3,sl_cur);} if(GV){DMA_V((t)+1,sl_next);} \
    CMASK(C0,C1,t); \
    if constexpr(!FIX) { float a=MX3(C0[0],C0[1],C1[0]),b=MX3(C0[2],C0[3],C1[1]); a=MX3(a,C1[2],C1[3]); \
      _Pragma("unroll") for(int r=4;r<16;r+=4){a=MX3(a,C0[r],C0[r+1]);b=MX3(b,C0[r+2],C0[r+3]);a=MX3(a,C1[r],C1[r+1]);b=MX3(b,C1[r+2],C1[r+3]);} \
      float rm=__builtin_fmaxf(a,b); { auto rr=__builtin_amdgcn_permlane32_swap(__float_as_uint(rm),__float_as_uint(rm),false,false); rm=__builtin_fmaxf(__uint_as_float(rr[0]),__uint_as_float(rr[1])); } \
      resc=false; \
      if(__builtin_expect(__any(rm>(float)THRL),0)){ const float dl=__builtin_fmaxf(rm,0.f); mhat+=dl; \
        _Pragma("unroll") for(int r=0;r<16;++r){C0[r]-=dl;C1[r]-=dl;} \
        _Pragma("unroll") for(int r=0;r<16;++r)negm[r]=-mhat; asm volatile("":"+v"(negm)); \
        const float f=__builtin_amdgcn_exp2f(-dl); l_reg*=f; if(hi==0)wsf[r32]=f; resc=true; } } \
    SBAR(); \
    GAPB(o[0]=__builtin_amdgcn_mfma_f32_32x32x16_bf16(PAF(0),VFR(0),o[0],0,0,0), C0,0); \
    GAPB(o[1]=__builtin_amdgcn_mfma_f32_32x32x16_bf16(PAF(0),VFR(4),o[1],0,0,0), C0,4); \
    KRD(GL,0); GAPB(o[0]=__builtin_amdgcn_mfma_f32_32x32x16_bf16(PAF(1),VFR(1),o[0],0,0,0), C0,8); \
    KRD(GL,1); GAPB(o[1]=__builtin_amdgcn_mfma_f32_32x32x16_bf16(PAF(1),VFR(5),o[1],0,0,0), C0,12); \
    KRD(GL,2); GAPB(o[0]=__builtin_amdgcn_mfma_f32_32x32x16_bf16(PAF(2),VFR(2),o[0],0,0,0), C1,0); \
    KRD(GL,3); GAPB(o[1]=__builtin_amdgcn_mfma_f32_32x32x16_bf16(PAF(2),VFR(6),o[1],0,0,0), C1,4); \
    GAPB(o[0]=__builtin_amdgcn_mfma_f32_32x32x16_bf16(PAF(3),VFR(3),o[0],0,0,0), C1,8); \
    GAPB(o[1]=__builtin_amdgcn_mfma_f32_32x32x16_bf16(PAF(3),VFR(7),o[1],0,0,0), C1,12); \
    }while(0)
  int t=1;
  #undef CMASK
  #define CMASK(P0,P1,t) do{}while(0)
  for(;t+5<NT;t+=2){
    STEP(pB0,pB1,pA0,pA1,t,true,true,true);     WAIT_BAR(2); RESC(); ROT();
    STEP(pA0,pA1,pB0,pB1,t+1,true,true,true);   WAIT_BAR(2); RESC(); ROT();
  }
  #undef CMASK
  #define CMASK(P0,P1,t) do{}while(0)
  #define ENDW(tt) do{ if((tt)+3<NT){WAIT_BAR(2);} else if((tt)+2<NT){WAIT_BAR(1);} else {WAIT_BAR(0);} }while(0)
  for(;t+1<NT;t+=2){
    STEP(pB0,pB1,pA0,pA1,t,(t+3<NT),(t+1<NT),(t+1<NT));       ENDW(t);   RESC(); ROT();
    STEP(pA0,pA1,pB0,pB1,t+1,(t+4<NT),(t+2<NT),(t+2<NT));     ENDW(t+1); RESC(); ROT();
  }
  STEP(pB0,pB1,pA0,pA1,NT-1,false,false,false); RESC();
  { float sacc=pB0[0]+pB0[1]; _Pragma("unroll") for(int r=2;r<16;++r)sacc+=pB0[r]; _Pragma("unroll") for(int r=0;r<16;++r)sacc+=pB1[r]; l_reg+=sacc;
    pw0=(u32x4){PKW(pB0,0),PKW(pB0,2),PKW(pB0,4),PKW(pB0,6)};pw1=(u32x4){PKW(pB0,8),PKW(pB0,10),PKW(pB0,12),PKW(pB0,14)};pw2=(u32x4){PKW(pB1,0),PKW(pB1,2),PKW(pB1,4),PKW(pB1,6)};pw3=(u32x4){PKW(pB1,8),PKW(pB1,10),PKW(pB1,12),PKW(pB1,14)};
    SBAR(); pv(o,vb0+sl_cur,PAF(0),PAF(1),PAF(2),PAF(3)); }
  #undef PKW
  #undef PAF
  #undef VFR
  #undef PIN
  #undef MX3
  #undef GAPA
  #undef GAPB
  #undef EX
  #undef VRD
  #undef KRD
  #undef STEP
  #undef ENDW
  {auto rr=__builtin_amdgcn_permlane32_swap(__float_as_uint(l_reg),__float_as_uint(l_reg),false,false);l_reg=__uint_as_float(rr[0])+__uint_as_float(rr[1]);}
  if(hi==0)wsf[32+r32]=l_reg;asm volatile("s_waitcnt lgkmcnt(0)":::"memory");
  float rli[16];
  #pragma unroll
  for(int r=0;r<16;++r)rli[r]=__builtin_amdgcn_rcpf(wsf[32+crow(r,hi)]);
  bf16*Ow=O+(rowbase+q0+wid*QBLK)*OP+h*D;
  { bf16*stg=(bf16*)(shm+LDS_OST)+wid*2048;
    #pragma unroll
    for(int r=0;r<16;++r){const int orow=crow(r,hi);
      #pragma unroll
      for(int d0=0;d0<2;++d0)stg[orow*64+d0*32+r32]=__float2bfloat16(o[d0][r]*rli[r]);}
    asm volatile("s_waitcnt lgkmcnt(0)":::"memory");
    #pragma unroll
    for(int i=0;i<4;++i){const int row=i*8+(lane>>3),ch=lane&7; const u32x4 v=*(const u32x4*)(stg+row*64+ch*8); ATTN_STORE16(Ow+(long)row*OP+ch*8,v);} }
  asm volatile("s_waitcnt lgkmcnt(0)\n\ts_barrier":::"memory");
  #undef DMA_K
  #undef DMA_V
  #undef CMASK
  #undef START
  #undef RESC
  #undef ROT
}
constexpr int ATTN_LDS_BYTES=LDS_BYTES;
struct AttnTensors { const bf16* Q; const bf16* K; const bf16* V; bf16* O; };
struct AttnUnit { int bh; int qb; };
struct StaticOrder {
  int vcu,G;
  __device__ __forceinline__ explicit StaticOrder(int grid,int v):vcu(v),G(grid){}
  __device__ __forceinline__ bool next(int i,AttnUnit&u)const{ const int per=(BATCH*NHEAD*NQB)/G; if(i>=per)return false; const int x=vcu*per+i; u.bh=(x>>6)*4+((x&63)>>4); u.qb=x&15; return true; }
  __device__ __forceinline__ void a_ready(const AttnUnit&)const{}
  __device__ __forceinline__ void done(const AttnUnit&)const{}
};
template<class Sched,int THRL=8> __device__ __forceinline__ void attn_phase(char*lds,const AttnTensors&T,const Sched&S,const float*qnw,const float*knw){
  AttnUnit u;
  float mq=__builtin_fabsf(qnw[threadIdx.x&63]),mk=__builtin_fabsf(knw[threadIdx.x&63]);
  _Pragma("unroll") for(int o_=1;o_<64;o_<<=1){ mq=__builtin_fmaxf(mq,__shfl_xor(mq,o_)); mk=__builtin_fmaxf(mk,__shfl_xor(mk,o_)); }
  const float sref=C2*64.0f*1.02f*mq*mk;
  const bool fix=__builtin_amdgcn_readfirstlane((int)(sref<=40.0f && sref==sref))!=0;
  if(fix){ for(int i=0;S.next(i,u);++i){ S.a_ready(u); attn_unit<THRL,true>(u.bh/NHEAD,u.bh%NHEAD,u.qb,T.Q,T.K,T.V,T.O,lds,sref); S.done(u); } }
  else   { for(int i=0;S.next(i,u);++i){ S.a_ready(u); attn_unit<THRL,false>(u.bh/NHEAD,u.bh%NHEAD,u.qb,T.Q,T.K,T.V,T.O,lds,0.f); S.done(u); } }
}
#undef SBAR
#undef WAIT_BAR
}
#ifndef PG8_SP2
#define PG8_SP2 true
#endif
#ifndef PG8_ALIGN
#define PG8_ALIGN true
#endif
#define GAS __attribute__((address_space(1)))
#define LAS __attribute__((address_space(3)))
typedef unsigned short bf16;
typedef unsigned v4u __attribute__((ext_vector_type(4)));
typedef unsigned v2u __attribute__((ext_vector_type(2)));
typedef float f32x4 __attribute__((ext_vector_type(4)));
typedef float f32x2 __attribute__((ext_vector_type(2)));
typedef short bf16x8 __attribute__((ext_vector_type(8)));
typedef GAS unsigned gu32;
typedef GAS unsigned long long gu64;
#define RLX_AGENT __ATOMIC_RELAXED, __HIP_MEMORY_SCOPE_AGENT
#define LDS_WAIT() asm volatile("s_waitcnt lgkmcnt(0)" ::: "memory")
#define VM_WAIT() asm volatile("s_waitcnt vmcnt(0)" ::: "memory")
__device__ __forceinline__ unsigned f2bf(float f) { unsigned u = __builtin_bit_cast(unsigned, f); return (u + 0x7fffu + ((u >> 16) & 1u)) >> 16; }
__device__ __forceinline__ unsigned pk2(float lo, float hi) { unsigned r; asm("v_cvt_pk_bf16_f32 %0, %1, %2" : "=v"(r) : "v"(lo), "v"(hi)); return r; }
__device__ __forceinline__ float bf2f(unsigned h) { return __builtin_bit_cast(float, h << 16); }

#define XB_TMO      128
#define XB_XCNT(j)  (256  + 64 * (j))
#define XB_XSUB(j)  (1280 + 64 * (j))
#define XB_XGEN(j)  (2304 + 64 * (j))
#define XB_TOP      3328
#define XB_TOPGEN   3392
#define XCD_BAR_WORDS 3456
#define XB_SPIN_CAP (1u << 18)

__device__ __forceinline__ unsigned xb_ld(unsigned* p)              { return __hip_atomic_load(p, __ATOMIC_RELAXED, __HIP_MEMORY_SCOPE_AGENT); }
__device__ __forceinline__ unsigned xb_add(unsigned* p, unsigned v) { return __hip_atomic_fetch_add(p, v, __ATOMIC_RELAXED, __HIP_MEMORY_SCOPE_AGENT); }
__device__ __forceinline__ unsigned xb_xcc_id() { return (unsigned)__builtin_amdgcn_s_getreg((3 << 11) | 20) & 0xFu; }
#define XB_SPIN(cond, bar) do { unsigned _sp = 0; while (cond) { __builtin_amdgcn_s_sleep(1); \
    if ((++_sp & 255u) == 0u) { if (xb_ld(&(bar)[XB_TMO])) break; if (_sp > XB_SPIN_CAP) { atomicAdd(&(bar)[XB_TMO], 1u); break; } } } } while (0)

struct XcdBarrier {
    unsigned* bar; unsigned x;
    volatile LAS unsigned* st;
};

__device__ __forceinline__ XcdBarrier xcd_barrier_post(unsigned* bar, volatile LAS unsigned* st) {
    XcdBarrier b; b.bar = bar; b.x = xb_xcc_id(); b.st = st;
    if (threadIdx.x == 0) (void)xb_add(&bar[XB_XCNT(b.x)], 1u);
    return b;
}
__device__ __forceinline__ void xcd_barrier_complete(unsigned* bar, unsigned x, unsigned& nloc, unsigned& nx) {
    const unsigned G = gridDim.x * gridDim.y * gridDim.z;
    unsigned sum, cnt, mine, sp = 0u;
    for (;;) {
        sum = 0u; cnt = 0u; mine = 0u;
#pragma unroll
        for (unsigned j = 0; j < 16; ++j) { const unsigned c = xb_ld(&bar[XB_XCNT(j)]); sum += c; cnt += (c > 0u) ? 1u : 0u; mine = (j == x) ? c : mine; }
        if (sum == G) break;
        __builtin_amdgcn_s_sleep(1);
        if ((++sp & 255u) == 0u) { if (xb_ld(&bar[XB_TMO])) break; if (sp > XB_SPIN_CAP) { atomicAdd(&bar[XB_TMO], 1u); break; } }
    }
    nloc = mine > 0u ? mine : 1u; nx = cnt > 0u ? cnt : 1u;
}

__device__ __forceinline__ void xcd_barrier(const XcdBarrier& b) {
    asm volatile("s_waitcnt vmcnt(0)" ::: "memory");
    __syncthreads();
    if (threadIdx.x == 0) {
        unsigned* bar = b.bar;
        __builtin_amdgcn_s_waitcnt(0);
        unsigned nloc = b.st[0], nx = b.st[1];
        if (nloc == 0u) { xcd_barrier_complete(bar, b.x, nloc, nx); b.st[0] = nloc; b.st[1] = nx; }
        const unsigned old = xb_add(&bar[XB_XSUB(b.x)], 1u);
        const unsigned gen = old / nloc;
        if (old + 1u == (gen + 1u) * nloc) {
            __builtin_amdgcn_fence(__ATOMIC_RELEASE, "agent");
            asm volatile("s_waitcnt vmcnt(0)" ::: "memory");
            const unsigned og = xb_add(&bar[XB_TOP], 1u);
            const unsigned tg = og / nx;
            if (og + 1u == (tg + 1u) * nx) xb_add(&bar[XB_TOPGEN], 1u);
            else XB_SPIN(xb_ld(&bar[XB_TOPGEN]) == tg, bar);
            __builtin_amdgcn_fence(__ATOMIC_ACQUIRE, "agent");
            xb_add(&bar[XB_XGEN(b.x)], 1u);
            asm volatile("s_waitcnt vmcnt(0)" ::: "memory");
        } else {
            XB_SPIN(xb_ld(&bar[XB_XGEN(b.x)]) == gen, bar);
            __builtin_amdgcn_fence(__ATOMIC_ACQUIRE, "agent");
            asm volatile("s_waitcnt vmcnt(0)" ::: "memory");
        }
    }
    __syncthreads();
}
struct Frame {
    LAS unsigned char* lds;
    volatile LAS unsigned* MISC;
    gu32* ctl;
    int tid, lane, wave;
    int vcu, G;
};
__device__ __forceinline__ float wave_sum(float v) { return wave_sum64(v); }
__device__ __forceinline__ void p0_transpose_item(const float* W, int ldw, int k0, int n0, bf16* WT, int ldt, int dst_row0, LAS float* scr, int lane) {
#pragma unroll 8
    for (int i = 0; i < 32; ++i) { const int kk = 2 * i + (lane >> 5); scr[kk * 33 + (lane & 31)] = __builtin_nontemporal_load(W + (size_t)(k0 + kk) * ldw + n0 + (lane & 31)); }
    LDS_WAIT(); asm volatile("" ::: "memory");
    const int c = lane & 7;
#pragma unroll
    for (int j = 0; j < 4; ++j) { const int n = (lane >> 3) + 8 * j; const LAS float* s = scr + (8 * c) * 33 + n;
        v4u o; o.x = pk2(s[0 * 33], s[1 * 33]); o.y = pk2(s[2 * 33], s[3 * 33]); o.z = pk2(s[4 * 33], s[5 * 33]); o.w = pk2(s[6 * 33], s[7 * 33]);
        *(GAS v4u*)(WT + (size_t)(dst_row0 + n) * ldt + k0 + 8 * c) = o; }
    LDS_WAIT(); asm volatile("" ::: "memory");
}
constexpr int P0_I_IN = 16 * 56, P0_I_OUT = 16 * 32, P0_I_13 = 16 * 88, P0_I_2 = 44 * 32, P0_I_P = 4 * 8;
constexpr int P0_ITEMS_EARLY = P0_I_IN + P0_I_OUT + 4 * P0_I_P + 2 * P0_I_13 + P0_I_2, P0_ITEMS_ALL = P0_ITEMS_EARLY + 2 * P0_I_13 + P0_I_2;
__device__ __forceinline__ void p0_items(Frame& F, ArgsP ap, int it_lo, int it_hi, int gw, int NGW) {
    unsigned char* ws = ap->ws;
    LAS float* scr = (LAS float*)(F.lds + RING_OFF + F.wave * 16384);
    for (int it = it_lo + gw; it < it_hi; it += NGW) {
        int r = it;
        if (r < P0_I_IN) { const int kb = r / 56, nb = r % 56, f = 32 * nb, slot = f >> 6, bj = (f >> 5) & 1, pn = slot >> 2, wc = slot & 3;
            p0_transpose_item(ap->in[I_WIN], INW, 64 * kb, f, (bf16*)(ws + WS_WIN), DM, 256 * pn + 128 * bj + 32 * wc, scr, F.lane); continue; } r -= P0_I_IN;
        if (r < P0_I_OUT) { const int kb = r / 32, nb = r % 32; p0_transpose_item(ap->in[I_WOUT], DM, 64 * kb, 32 * nb, (bf16*)(ws + WS_WOUT), DM, 32 * nb, scr, F.lane); continue; } r -= P0_I_OUT;
        if (r < 4 * P0_I_P) { const int g = r / P0_I_P, rr = r % P0_I_P, kb = rr / 8, nb = rr % 8;
            p0_transpose_item(ap->in[I_WPOOL] + (size_t)g * 256 * 256, 256, 64 * kb, 32 * nb, (bf16*)(ws + WS_WPOOL), 256, g * 256 + 32 * nb, scr, F.lane); continue; } r -= 4 * P0_I_P;
        const int l = r >= 2 * P0_I_13 + P0_I_2 ? 1 : 0; r -= l * (2 * P0_I_13 + P0_I_2);
        if (r < 2 * P0_I_13) { const int which = r / P0_I_13, rr = r % P0_I_13, kb = rr / 88, nb = rr % 88, n0 = 32 * nb;
            const float* W = ap->in[which ? I_W3 : I_W1] + (size_t)l * DM * FF;
            p0_transpose_item(W, FF, 64 * kb, n0, (bf16*)(ws + WS_W13) + (size_t)l * 5632 * DM, DM, 256 * (n0 >> 7) + 128 * which + (n0 & 127), scr, F.lane); continue; } r -= 2 * P0_I_13;
        { const int kb = r / 32, nb = r % 32;
            p0_transpose_item(ap->in[I_W2] + (size_t)l * FF * DM, DM, 64 * kb, 32 * nb, (bf16*)(ws + WS_W2) + (size_t)l * DM * FF, FF, 32 * nb, scr, F.lane); }
    }
}
__device__ __forceinline__ void p0_prologue(Frame& F, ArgsP ap) {
    unsigned char* ws = ap->ws;
    if (F.vcu < 192) {
        LAS float* sc = (LAS float*)(F.lds + RING_OFF); LAS float* part = sc + 9 * 1024;
        const float* c = ap->in[I_C]; const float* cctx = ap->in[I_CCTX];
        for (int i = F.tid; i < 9 * 1024; i += NWAVES * 64) { const int bb = i >> 10, k = i & 1023; const float v = bb < 8 ? c[bb * 1024 + k] : cctx[k]; sc[i] = v / (1.0f + expf(-v)); }
        __syncthreads();
        const int l = F.vcu / 96, cb = F.vcu % 96, k0 = F.wave * 128;
        const float* w = ap->in[I_WADA] + (size_t)l * DM * MODW + (size_t)k0 * MODW + cb * 64 + F.lane;
        float acc[9];
#pragma unroll
        for (int j = 0; j < 9; ++j) acc[j] = 0.f;
        for (int k = 0; k < 128; k += 8) {
            float wv[8];
#pragma unroll
            for (int q = 0; q < 8; ++q) wv[q] = __builtin_nontemporal_load(w + (size_t)(k + q) * MODW);
#pragma unroll
            for (int j = 0; j < 9; ++j) { const f32x4 s0 = *(const LAS f32x4*)(sc + j * 1024 + k0 + k), s1 = *(const LAS f32x4*)(sc + j * 1024 + k0 + k + 4);
                acc[j] += (s0[0] * wv[0] + s0[1] * wv[1]) + (s0[2] * wv[2] + s0[3] * wv[3]) + (s1[0] * wv[4] + s1[1] * wv[5]) + (s1[2] * wv[6] + s1[3] * wv[7]); }
        }
#pragma unroll
        for (int j = 0; j < 9; ++j) part[(F.wave * 9 + j) * 64 + F.lane] = acc[j];
        __syncthreads();
        float* mods = (float*)(ws + WS_MODS);
        for (int idx = F.tid; idx < 9 * 64; idx += NWAVES * 64) { const int j = idx >> 6, col = idx & 63; float s = 0.f;
#pragma unroll
            for (int wv_ = 0; wv_ < 8; ++wv_) s += part[(wv_ * 9 + j) * 64 + col];
            mods[(size_t)(l * 9 + j) * MODW + cb * 64 + col] = s + ap->in[I_BADA][l * MODW + cb * 64 + col]; }
        __syncthreads();
    } else if (F.vcu == F.G - 1) {
        float* rc = (float*)(ws + WS_ROPE); float* rs = rc + 1024;
        for (int e = F.tid; e < 1024; e += NWAVES * 64) { const int pos = e >> 4, i = e & 15; const float fr = powf(10000.0f, -(float)(2 * i) / 32.0f); const float a = (float)pos * fr; rc[e] = cosf(a); rs[e] = sinf(a); }
    }
    p0_items(F, ap, 0, P0_ITEMS_EARLY, F.vcu * NWAVES + F.wave, F.G * NWAVES);
    { const float* wsp = ap->in[I_WSP]; bf16* dst = (bf16*)(ws + WS_WSB);
        for (int e = (F.vcu * NWAVES * 64 + F.tid) * 4; e < 8 * 128 * 128; e += F.G * NWAVES * 64 * 4) { const f32x4 v = *(const f32x4*)(wsp + e); v2u o; o.x = pk2(v[0], v[1]); o.y = pk2(v[2], v[3]); *(v2u*)(dst + e) = o; } }
}
__device__ __forceinline__ void p1_bias13(Frame& F, ArgsP ap) {
    if (F.vcu >= 176) return;
    const int l = F.vcu / 88, rem = F.vcu % 88, which = rem / 44, cb = rem % 44, k0 = F.wave * 128;
    LAS float* shs = (LAS float*)(F.lds + RING_OFF); LAS float* part = shs + 8 * 1024;
    const float* mods = (const float*)(ap->ws + WS_MODS);
    for (int i = F.tid; i < 8 * 1024; i += NWAVES * 64) { const int b = i >> 10, k = i & 1023; shs[i] = mods[(size_t)(l * 9 + b) * MODW + SH2 + k]; }
    __syncthreads();
    const float* w = ap->in[which ? I_W3 : I_W1] + (size_t)l * DM * FF + (size_t)k0 * FF + cb * 64 + F.lane;
    float acc[8];
#pragma unroll
    for (int j = 0; j < 8; ++j) acc[j] = 0.f;
    for (int k = 0; k < 128; k += 8) {
        float wv[8];
#pragma unroll
        for (int q = 0; q < 8; ++q) wv[q] = __builtin_nontemporal_load(w + (size_t)(k + q) * FF);
#pragma unroll
        for (int j = 0; j < 8; ++j) { const f32x4 s0 = *(const LAS f32x4*)(shs + j * 1024 + k0 + k), s1 = *(const LAS f32x4*)(shs + j * 1024 + k0 + k + 4);
            acc[j] += (s0[0] * wv[0] + s0[1] * wv[1]) + (s0[2] * wv[2] + s0[3] * wv[3]) + (s1[0] * wv[4] + s1[1] * wv[5]) + (s1[2] * wv[6] + s1[3] * wv[7]); }
    }
#pragma unroll
    for (int j = 0; j < 8; ++j) part[(F.wave * 8 + j) * 64 + F.lane] = acc[j];
    __syncthreads();
    float* bias = (float*)(ap->ws + WS_BIAS);
    for (int idx = F.tid; idx < 8 * 64; idx += NWAVES * 64) { const int j = idx >> 6, col = idx & 63, n = cb * 64 + col; float sum = 0.f;
#pragma unroll
        for (int wv_ = 0; wv_ < 8; ++wv_) sum += part[(wv_ * 8 + j) * 64 + col];
        bias[(size_t)(l * 8 + j) * 5632 + 256 * (n >> 7) + 128 * which + (n & 127)] = sum; }
    __syncthreads();
}
__device__ __forceinline__ void p1_flag(Frame& F, ArgsP ap) {
    if (F.vcu != F.G - 1) return;
    const float* mods = (const float*)(ap->ws + WS_MODS); const float* g = ap->in[I_GFFN];
    int bad = 0;
    for (int i = F.tid; i < 2 * 8 * 1024; i += NWAVES * 64) { const int l = i >> 13, b = (i >> 10) & 7, k = i & 1023;
        const float m = fabsf(g[l * DM + k] * (mods[(size_t)(l * 9 + b) * MODW + SC2 + k] + 1.0f)); bad |= (!(m >= 1e-12f) || !(m <= 1e12f)) ? 1 : 0; }
    const int any = __syncthreads_or(bad);
    if (F.tid == 0) *(int*)(ap->ws + WS_FLAG) = any ? 0 : 1;
}
__device__ __forceinline__ void p1_poolw(Frame& F, ArgsP ap) {
    unsigned char* ws = ap->ws; const bf16* src = (const bf16*)(ws + WS_WPOOL); bf16* dst = (bf16*)(ws + WS_WPB);
    const float* gm = ap->in[I_GMIX] + DM; const float* mod1 = (const float*)(ws + WS_MODS) + (size_t)9 * MODW;
    for (int e = (F.vcu * NWAVES * 64 + F.tid) * 8; e < 8 * 1024 * 256; e += F.G * NWAVES * 64 * 8) {
        const int b = e >> 18, n = (e >> 8) & 1023, k = e & 255, gk = (n & ~255) + k;
        const v4u w = *(const v4u*)(src + (size_t)n * 256 + k); const f32x4 g0 = *(const f32x4*)(gm + gk), g1 = *(const f32x4*)(gm + gk + 4);
        const f32x4 s0 = *(const f32x4*)(mod1 + (size_t)b * MODW + SC1 + gk), s1 = *(const f32x4*)(mod1 + (size_t)b * MODW + SC1 + gk + 4);
        const f32x4 m0 = g0 * (s0 + 1.0f), m1 = g1 * (s1 + 1.0f);
        v4u o; o.x = pk2(bf2f(w.x & 0xffffu) * m0[0], bf2f(w.x >> 16) * m0[1]); o.y = pk2(bf2f(w.y & 0xffffu) * m0[2], bf2f(w.y >> 16) * m0[3]);
        o.z = pk2(bf2f(w.z & 0xffffu) * m1[0], bf2f(w.z >> 16) * m1[1]); o.w = pk2(bf2f(w.w & 0xffffu) * m1[2], bf2f(w.w >> 16) * m1[3]);
        *(v4u*)(dst + e) = o; }
}
__device__ __forceinline__ void norm_pass(Frame& F, const float* src_lat, const float* src_ctx, bf16* dst, const float* gvec, const float* modl, int sh_off, int sc_off) {
    const int total = src_ctx ? MALL : MTOK, gw = F.vcu * NWAVES + F.wave, NGW = F.G * NWAVES, rpw = (total + NGW - 1) / NGW;
    const int r0 = gw * rpw, r1 = (r0 + rpw < total) ? r0 + rpw : total;
    int cur = -1; f32x4 gm[4], sh[4];
    for (int row = r0; row < r1; ++row) {
        const int bb = row < MTOK ? (row >> 12) : 8;
        if (bb != cur) { cur = bb;
#pragma unroll
            for (int j = 0; j < 4; ++j) { const int c = 4 * F.lane + 256 * j; const f32x4 g = *(const f32x4*)(gvec + c), s = *(const f32x4*)(modl + (size_t)bb * MODW + sc_off + c);
                gm[j] = g * (s + 1.0f); sh[j] = *(const f32x4*)(modl + (size_t)bb * MODW + sh_off + c); } }
        const float* xr = row < MTOK ? src_lat + (size_t)row * DM : src_ctx + (size_t)(row - MTOK) * DM;
        f32x4 v[4]; float ss = 0.f;
#pragma unroll
        for (int j = 0; j < 4; ++j) { v[j] = __builtin_nontemporal_load((const f32x4*)(xr + 4 * F.lane + 256 * j)); ss += (v[j][0] * v[j][0] + v[j][1] * v[j][1]) + (v[j][2] * v[j][2] + v[j][3] * v[j][3]); }
        const float r = __builtin_amdgcn_rsqf(wave_sum(ss) * (1.0f / DM) + 1e-6f);
        bf16* orow = dst + (size_t)row * DM;
#pragma unroll
        for (int j = 0; j < 4; ++j) { const f32x4 o = v[j] * r * gm[j] + sh[j]; v2u w; w.x = pk2(o[0], o[1]); w.y = pk2(o[2], o[3]); *(v2u*)(orow + 4 * F.lane + 256 * j) = w; }
    }
}
__device__ __forceinline__ void final_norm(Frame& F, float* out, const float* gvec) {
    const int gw = F.vcu * NWAVES + F.wave, NGW = F.G * NWAVES, rpw = (MTOK + NGW - 1) / NGW;
    const int r0 = gw * rpw, r1 = (r0 + rpw < MTOK) ? r0 + rpw : MTOK;
    f32x4 g[4];
#pragma unroll
    for (int j = 0; j < 4; ++j) g[j] = *(const f32x4*)(gvec + 4 * F.lane + 256 * j);
    for (int row = r0; row < r1; ++row) {
        float* xr = out + (size_t)row * DM; f32x4 v[4]; float ss = 0.f;
#pragma unroll
        for (int j = 0; j < 4; ++j) { v[j] = *(const f32x4*)(xr + 4 * F.lane + 256 * j); ss += (v[j][0] * v[j][0] + v[j][1] * v[j][1]) + (v[j][2] * v[j][2] + v[j][3] * v[j][3]); }
        const float r = 1.0f / sqrtf(wave_sum(ss) * (1.0f / DM) + 1e-6f);
#pragma unroll
        for (int j = 0; j < 4; ++j) *(f32x4*)(xr + 4 * F.lane + 256 * j) = v[j] * r * g[j];
    }
}
template <int W> __device__ __forceinline__ void poolres_cols(const bf16* zb, bf16* outb, bf16* xnb, float* partb, int t0, int c, f32x4 gate, f32x4 gmn, int grp, int lane, const LAS float* rt, bool xo) {
    constexpr int L = W / 2, R = W / 2 - 1, NV = W - 1 + 16;
    f32x4 v[NV];
#define BF4(u_) (f32x4){bf2f((u_).x & 0xffffu), bf2f((u_).x >> 16), bf2f((u_).y & 0xffffu), bf2f((u_).y >> 16)}
#define Z_LD(dst_, t_) do { const int tt_ = (t_); if (tt_ < 0 || tt_ >= SEQ) dst_ = (f32x4){0.f, 0.f, 0.f, 0.f}; else { const v2u u_ = __builtin_nontemporal_load((const v2u*)(zb + (size_t)tt_ * DM + c)); dst_ = BF4(u_) * rt[tt_]; } } while (0)
#pragma unroll
    for (int i = 0; i < W - 1; ++i) Z_LD(v[i], t0 - L + i);
    for (int blk = 0; blk < 4; ++blk) {
        const int tb = t0 + 16 * blk;
        v2u xr[16];
#pragma unroll
        for (int i = 0; i < 16; ++i) xr[i] = *(const v2u*)(outb + (size_t)(tb + i) * DM + c);
#pragma unroll
        for (int i = 0; i < 16; ++i) Z_LD(v[W - 1 + i], tb + R + i);
        f32x4 s = v[0];
#pragma unroll
        for (int i = 1; i < W; ++i) s += v[i];
#pragma unroll
        for (int j = 0; j < 16; ++j) { const int t = tb + j; const int lo = t - L < 0 ? 0 : t - L, hi = t + R > SEQ - 1 ? SEQ - 1 : t + R; const float icnt = __builtin_amdgcn_rcpf((float)(hi - lo + 1));
            const f32x4 o = s * icnt - v[j + L]; const f32x4 x3 = BF4(xr[j]) + gate * o;
            if (!xo) { v2u w; w.x = pk2(x3[0], x3[1]); w.y = pk2(x3[2], x3[3]); *(v2u*)(outb + (size_t)t * DM + c) = w; }
            const f32x4 y = x3 * gmn; v2u wy; wy.x = pk2(y[0], y[1]); wy.y = pk2(y[2], y[3]); *(v2u*)(xnb + (size_t)t * DM + c) = wy;
            const float ss = wave_sum((x3[0] * x3[0] + x3[1] * x3[1]) + (x3[2] * x3[2] + x3[3] * x3[3]));
            if (lane == 0) *(f32x4*)(partb + ((size_t)grp * MTOK + t) * 4) = (f32x4){ss, 0.f, 0.f, 0.f};
            if (j < 15) s += v[j + W] - v[j]; }
#pragma unroll
        for (int i = 0; i < W - 1; ++i) v[i] = v[i + 16];
    }
#undef Z_LD
#undef BF4
}
__device__ __forceinline__ void poolres_pass(Frame& F, const bf16* Z, bf16* out, bf16* xn, float* part, const float* rsum, const int* flagp, const float* gate, const float* pscale, const float* gnext, const float* scnext) {
    LAS float* rtab = (LAS float*)(F.lds + RTAB_OFF);
    const bool xo = __builtin_amdgcn_readfirstlane(*flagp) != 0;
    for (int strip = F.vcu; strip < MTOK / 128; strip += F.G) {
        const int b = strip >> 5, grp = F.wave >> 1, ts = (strip & 31) * 128, t0 = ts + 64 * (F.wave & 1); const size_t ro = (size_t)b * SEQ;
        __syncthreads();
        if (F.tid < 128 + 15) { const int tt = ts - 8 + F.tid; float r = 0.f;
            if (tt >= 0 && tt < SEQ) { const float* pr = rsum + (ro + tt) * 4; f32x4 p = *(const f32x4*)pr; p += *(const f32x4*)(pr + (size_t)(MTOK * 4) * 1); p += *(const f32x4*)(pr + (size_t)(MTOK * 4) * 2); p += *(const f32x4*)(pr + (size_t)(MTOK * 4) * 3);
                r = __builtin_amdgcn_rsqf(((p[0] + p[1]) + (p[2] + p[3])) * (1.0f / 1024.0f) + 1e-6f); }
            rtab[F.tid] = r; }
        __syncthreads();
        const LAS float* rt = rtab + (8 - ts);
        const int c = 256 * grp + 4 * F.lane;
        const f32x4 gt = *(const f32x4*)(gate + (size_t)b * MODW + c) * *(const f32x4*)(pscale + c);
        const f32x4 gmn = *(const f32x4*)(gnext + c) * (*(const f32x4*)(scnext + (size_t)b * MODW + c) + 1.0f);
        const bf16* zb = Z + ro * DM; bf16* outb = out + ro * DM; bf16* xnb = xn + ro * DM; float* partb = part + ro * 4;
        if (grp == 0) poolres_cols<2>(zb, outb, xnb, partb, t0, c, gt, gmn, grp, F.lane, rt, xo); else if (grp == 1) poolres_cols<4>(zb, outb, xnb, partb, t0, c, gt, gmn, grp, F.lane, rt, xo);
        else if (grp == 2) poolres_cols<8>(zb, outb, xnb, partb, t0, c, gt, gmn, grp, F.lane, rt, xo); else poolres_cols<16>(zb, outb, xnb, partb, t0, c, gt, gmn, grp, F.lane, rt, xo);
    }
}
__device__ __forceinline__ void gmlp_unit(Frame& F, int unit, const bf16* VG, const bf16* U, const bf16* WSB, const float* bs, bf16* AM) {
    using attn_body::f32x16;
    const int g = F.wave, lane = F.lane, r32 = lane & 31, hi = lane >> 5;
    const size_t R0 = (size_t)unit * 128;
    LAS unsigned char* slot = F.lds + RING_OFF + g * 16384;
    const unsigned slot_addr = (unsigned)(uintptr_t)slot;
    const int vb = (int)slot_addr + ((lane >> 4) & 1) * 32 + (lane & 3) * 8 + (4 * hi + ((lane & 15) >> 2)) * 64;
#pragma unroll
    for (int kt = 0; kt < 2; ++kt)
#pragma unroll
        for (int p = 0; p < 8; ++p)
            attn_body::glds16_nt(VG + (R0 + 64 * kt + 16 * (p & 3) + (lane >> 2)) * 512 + g * 64 + (p >> 2) * 32 + (lane & 3) * 8, (unsigned)__builtin_amdgcn_readfirstlane(slot_addr + kt * 8192 + p * 1024));
    f32x16 o[4][2];
#pragma unroll
    for (int rb = 0; rb < 4; ++rb) { o[rb][0] = f32x16{}; o[rb][1] = f32x16{}; }
#define GM_LDPA(dst, kt_, rb_) do { int z_ = 0; asm volatile("" : "+v"(z_)); const char* wp = wb + z_ + (rb_) * 8192 + (kt_) * 128;     \
            _Pragma("unroll") for (int s = 0; s < 4; ++s) { const v2u a = *(const v2u*)(wp + s * 32), b = *(const v2u*)(wp + s * 32 + 16); dst[s] = __builtin_bit_cast(bf16x8, (v4u){a.x, a.y, b.x, b.y}); } } while (0)
    const char* wb = (const char*)(WSB + ((size_t)(g * 128 + r32) * 128 + 4 * hi));
    {
        bf16x8 pA[4], pB[4];
#define GM_PV(P, kt_, rb_) attn_body::pv(o[rb_], vb + (kt_) * 8192, P[0], P[1], P[2], P[3])
        GM_LDPA(pA, 0, 0);
        VM_WAIT();
        GM_LDPA(pB, 0, 1); GM_PV(pA, 0, 0);
        GM_LDPA(pA, 0, 2); GM_PV(pB, 0, 1);
        GM_LDPA(pB, 0, 3); GM_PV(pA, 0, 2);
        GM_LDPA(pA, 1, 0); GM_PV(pB, 0, 3);
        GM_LDPA(pB, 1, 1); GM_PV(pA, 1, 0);
        GM_LDPA(pA, 1, 2); GM_PV(pB, 1, 1);
        GM_LDPA(pB, 1, 3); GM_PV(pA, 1, 2);
        GM_PV(pB, 1, 3);
#undef GM_PV
    }
#undef GM_LDPA
    LDS_WAIT();
    LAS float* stg = (LAS float*)slot;
    v4u uA[4], uB[4]; float bA[4], bB[4];
#define GM_LDU(UU, BB, rb_) do { int zz_ = 0; asm volatile("" : "+v"(zz_)); const char* ub_ = (const char*)(U + (R0 + 32 * (rb_) + (lane >> 3)) * 512 + g * 64 + (lane & 7) * 8) + zz_; \
        const float* bb_ = bs + g * 128 + 32 * (rb_) + (lane >> 3) + zz_; _Pragma("unroll") for (int i = 0; i < 4; ++i) { UU[i] = __builtin_nontemporal_load((const v4u*)(ub_ + i * 8192)); BB[i] = bb_[8 * i]; } } while (0)
#define GM_EPI(UU, BB, rb_) do { \
        _Pragma("unroll") for (int r = 0; r < 16; ++r) { const int orow = attn_body::crow(r, hi); stg[orow * 64 + r32] = o[rb_][0][r]; stg[orow * 64 + 32 + r32] = o[rb_][1][r]; } \
        LDS_WAIT(); \
        _Pragma("unroll") for (int i = 0; i < 4; ++i) { const int row = i * 8 + (lane >> 3), ch = lane & 7; \
            const f32x4 a = *(const LAS f32x4*)(stg + row * 64 + ch * 8) + BB[i], b = *(const LAS f32x4*)(stg + row * 64 + ch * 8 + 4) + BB[i]; \
            v4u w; w.x = pk2(a[0] * bf2f(UU[i].x & 0xffffu), a[1] * bf2f(UU[i].x >> 16)); w.y = pk2(a[2] * bf2f(UU[i].y & 0xffffu), a[3] * bf2f(UU[i].y >> 16)); \
            w.z = pk2(b[0] * bf2f(UU[i].z & 0xffffu), b[1] * bf2f(UU[i].z >> 16)); w.w = pk2(b[2] * bf2f(UU[i].w & 0xffffu), b[3] * bf2f(UU[i].w >> 16)); \
            *(v4u*)(AM + (R0 + 32 * (rb_) + row) * 1024 + 512 + g * 64 + ch * 8) = w; } \
        LDS_WAIT(); } while (0)
    GM_LDU(uA, bA, 0);
    GM_LDU(uB, bB, 1); GM_EPI(uA, bA, 0);
    GM_LDU(uA, bA, 2); GM_EPI(uB, bB, 1);
    GM_LDU(uB, bB, 3); GM_EPI(uA, bA, 2);
    GM_EPI(uB, bB, 3);
#undef GM_LDU
#undef GM_EPI
}

template <class Sched> __device__ __forceinline__ int build_rtab(Frame& F, const Sched& S, const float* part, LAS float* rtab) {
    pg8::Unit u; int pm0 = -1, pm1 = -1;
    for (int i = 0; S.next(i, u); ++i) { if (pm0 < 0) pm0 = u.pm; else if (u.pm != pm0) pm1 = u.pm; }
    if (pm1 < 0) pm1 = pm0;
    { const int slot = F.tid >> 8, r = F.tid & 255, row = (slot ? pm1 : pm0) * 256 + r; float tot = 0.f;
#pragma unroll
        for (int pn = 0; pn < 4; ++pn) { const f32x4 p = *(const f32x4*)(part + ((size_t)pn * MTOK + row) * 4); tot += (p[0] + p[1]) + (p[2] + p[3]); }
        rtab[F.tid] = __builtin_amdgcn_rsqf(tot * (1.0f / DM) + 1e-6f); }
    __syncthreads();
    return pm0;
}
__global__ void __launch_bounds__(NWAVES * 64, 2) mega_fwd(Args args) {
    extern __shared__ __attribute__((aligned(16))) unsigned char lds[];
    Frame F;
    F.lds = (LAS unsigned char*)lds;
    F.MISC = (volatile LAS unsigned*)(F.lds + MISC_OFF);
    F.tid = threadIdx.x; F.lane = F.tid & 63; F.wave = __builtin_amdgcn_readfirstlane(F.tid >> 6);
    F.G = gridDim.x; { const int bx = blockIdx.x; F.vcu = (F.G % 8 == 0) ? (bx % 8) * (F.G / 8) + bx / 8 : bx; }
    ArgsP akp = (ArgsP)__builtin_amdgcn_kernarg_segment_ptr();
    F.ctl = (gu32*)(akp->ws + WS_CTL);
    for (int u = F.tid; u < (LDS_BYTES - LDSCTL_OFF) / 4; u += NWAVES * 64) ((LAS unsigned*)(F.lds + LDSCTL_OFF))[u] = 0u;
    __syncthreads();
    const int lo = akp->ph_lo, hi = akp->ph_hi;
    const bool one_launch = (hi - lo) > 1;
    XcdBarrier bar; bar.bar = (unsigned*)(F.ctl + CW_BAR); bar.x = 0; bar.st = nullptr;
    if (one_launch) bar = xcd_barrier_post((unsigned*)(F.ctl + CW_BAR), F.MISC + 8);
#ifndef PHASE_MASK
#define PHASE_MASK 0x7ff
#endif
#define IN(k) (((PHASE_MASK >> (k)) & 1) && lo <= (k) && (k) < hi)
#define SEAM(k) do { if (IN(k) && IN((k) + 1)) xcd_barrier(bar); } while (0)
#ifndef REPEAT_MASK
#define REPEAT_MASK 0
#endif
#define REP(k) for (int rep_ = 0; rep_ < (((REPEAT_MASK >> (k)) & 1) ? 2 : 1); ++rep_, (((REPEAT_MASK >> (k)) & 1) && rep_ == 1 && one_launch ? (xcd_barrier(bar), 0) : 0))
#define REPRES(k, dummy) ((((REPEAT_MASK >> (k)) & 1) && rep_ == 0) ? (void*)(ws + (dummy)) : (void*)(ws + WS_RES))
#define REPOUT(k, dummy) ((((REPEAT_MASK >> (k)) & 1) && rep_ == 0) ? (float*)(ws + (dummy)) : out)
#define PHASE_VARS() ArgsP A = akp; asm volatile("" : "+s"(A)); unsigned char* ws = A->ws; float* out = A->out; float* mods = (float*)(ws + WS_MODS); const float* mod1 = mods + (size_t)9 * MODW; bf16* XN = (bf16*)(ws + WS_XN); bf16* AM = (bf16*)(ws + WS_AM); bf16* HB = (bf16*)(ws + WS_H); \
    float* rs1 = (float*)(ws + WS_PART); float* rs2 = rs1 + 16 * MTOK; float* rs3 = rs2 + 16 * MTOK; float* rs4 = rs3 + 16 * MTOK; const float* bias13 = (const float*)(ws + WS_BIAS); \
    (void)out; (void)mods; (void)mod1; (void)XN; (void)AM; (void)HB; (void)rs1; (void)rs2; (void)rs3; (void)rs4; (void)bias13
#ifndef STAGGER_US
#define STAGGER_US 0
#endif
#define STAGGER() do { const unsigned g_ = (blockIdx.x >> 3) & 3u; if (STAGGER_US > 0 && g_) { const unsigned long long t0_ = __builtin_amdgcn_s_memrealtime(); while (__builtin_amdgcn_s_memrealtime() - t0_ < (unsigned long long)(g_ * STAGGER_US * 100)) __builtin_amdgcn_s_sleep(8); } } while (0)
#define RELAUNDER() do { int t_ = threadIdx.x; asm volatile("" : "+v"(t_)); F.tid = t_; F.lane = t_ & 63; } while (0)
    if (IN(0)) REP(0) { PHASE_VARS(); RELAUNDER(); p0_prologue(F, A); } SEAM(0);
    if (IN(1)) REP(1) { PHASE_VARS(); RELAUNDER(); p1_flag(F, A); p1_bias13(F, A); p1_poolw(F, A); norm_pass(F, A->in[I_X], A->in[I_CTX], XN, A->in[I_GMIX], mods, SH1, SC1); } SEAM(1);
    if (IN(2)) REP(2) { PHASE_VARS();
        pg8::Gemm g{XN, (const bf16*)(ws + WS_WIN), DM, DM, 0, 0}; pg8::StaticOrder S; S.init(MTOK, INW, F.G, (int)blockIdx.x, MCTX / 256, 2);
        pg8::EpiInProj E{A};
        pg8::gemm_phase<pg8::EpiInProj, pg8::StaticOrder, PG8_ALIGN, PG8_SP2>(F.lds + RING_OFF, g, S, E);
        { const int total = (MTOK / 256) * (INW / 256) + MCTX / 256, rounds = (total + (int)F.G - 1) / (int)F.G, heavy = total - (rounds - 1) * (int)F.G, c = (int)blockIdx.x;
          RELAUNDER();
          if (heavy >= (int)F.G) p0_items(F, A, P0_ITEMS_EARLY, P0_ITEMS_ALL, c * NWAVES + F.wave, (int)F.G * NWAVES);
          else if (c >= heavy) p0_items(F, A, P0_ITEMS_EARLY, P0_ITEMS_ALL, (c - heavy) * NWAVES + F.wave, ((int)F.G - heavy) * NWAVES); }
    } SEAM(2);
    if (IN(3)) REP(3) { PHASE_VARS();
        const attn_body::AttnTensors AT{(const attn_body::bf16*)(ws + WS_Q), (const attn_body::bf16*)(ws + WS_KB), (const attn_body::bf16*)(ws + WS_VB), (attn_body::bf16*)AM};
        const attn_body::StaticOrder S((int)F.G, F.vcu);
        const bool gfirst = (F.vcu & 1) != 0;
        for (int g2_ = 0; g2_ < 2; ++g2_) {
            if ((g2_ == 0) == gfirst) {
                RELAUNDER();
                for (int rp_ = 0; rp_ < (((REPEAT_MASK >> 11) & 1) ? 2 : 1); ++rp_) {
                    for (int u = F.vcu; u < MTOK / 128; u += F.G) gmlp_unit(F, u, (const bf16*)(ws + WS_VG), (const bf16*)(ws + WS_U), (const bf16*)(ws + WS_WSB), A->in[I_BSP], AM);
                    __syncthreads(); }
            } else attn_body::attn_phase<attn_body::StaticOrder>((char*)lds + RING_OFF, AT, S, A->in[I_QN], A->in[I_KN]);
        }
    } SEAM(3);
    if (IN(4)) REP(4) { PHASE_VARS(); STAGGER();
        pg8::Gemm g{AM, (const bf16*)(ws + WS_WOUT), DM, DM, 0, 0}; pg8::StaticOrder S; S.init(MTOK, DM, F.G, (int)blockIdx.x);
        if (__builtin_amdgcn_readfirstlane(*(const int*)(ws + WS_FLAG)) != 0) { pg8::EpiResid<5> E{A, (void*)(ws + WS_RES)};
            pg8::gemm_phase<pg8::EpiResid<5>, pg8::StaticOrder, PG8_ALIGN, PG8_SP2>(F.lds + RING_OFF, g, S, E); }
        else { pg8::EpiResid<4> E{A, (void*)(ws + WS_RES)};
            pg8::gemm_phase<pg8::EpiResid<4>, pg8::StaticOrder, PG8_ALIGN, PG8_SP2>(F.lds + RING_OFF, g, S, E); }
    } SEAM(4);
    if (IN(5)) REP(5) { PHASE_VARS();
        pg8::Gemm g{XN, (const bf16*)(ws + WS_W13), DM, DM, 0, 0}; pg8::StaticOrder S; S.init(MTOK, 2 * FF, F.G, (int)blockIdx.x);
#if defined(PROBE_NULL5)
        if (rep_ == 0) { pg8::EpiNull EN{(bf16*)(ws + WS_VG)}; pg8::StaticOrder S2; S2.init(MTOK, DM, F.G, (int)blockIdx.x);   (void)S2;
            pg8::EpiNullWide ENW{(bf16*)(ws + WS_H)}; pg8::gemm_phase<pg8::EpiNullWide, pg8::StaticOrder, PG8_ALIGN, PG8_SP2>(F.lds + RING_OFF, g, S, ENW); (void)EN; } else
#endif
        { RELAUNDER(); LAS float* rtab = (LAS float*)(F.lds + RTAB_OFF); const int pm0 = build_rtab(F, S, rs1, rtab); pg8::EpiSwiglu<0> E{A, rtab, pm0};
        pg8::gemm_phase<pg8::EpiSwiglu<0>, pg8::StaticOrder, PG8_ALIGN, PG8_SP2>(F.lds + RING_OFF, g, S, E); }
    } SEAM(5);
    if (IN(6)) REP(6) { PHASE_VARS(); STAGGER();
        pg8::Gemm g{HB, (const bf16*)(ws + WS_W2), FF, FF, 0, 0}; pg8::StaticOrder S; S.init(MTOK, DM, F.G, (int)blockIdx.x);
#if defined(PROBE_NULL6)
        if (rep_ == 0) { pg8::EpiNull EN{(bf16*)(ws + WS_VG)}; pg8::gemm_phase<pg8::EpiNull, pg8::StaticOrder, PG8_ALIGN, PG8_SP2>(F.lds + RING_OFF, g, S, EN); } else
#elif defined(PROBE_NOXN6)
        if (rep_ == 0) { pg8::EpiResid<7> E7{A, REPRES(6, WS_VG)}; pg8::gemm_phase<pg8::EpiResid<7>, pg8::StaticOrder, PG8_ALIGN, PG8_SP2>(F.lds + RING_OFF, g, S, E7); } else
#endif
        { pg8::EpiResid<6> E{A, REPRES(6, WS_VG)};
        pg8::gemm_phase<pg8::EpiResid<6>, pg8::StaticOrder, PG8_ALIGN, PG8_SP2>(F.lds + RING_OFF, g, S, E); }
        { pg8::Gemm gz{(const bf16*)(ws + WS_RES), (const bf16*)(ws + WS_WPB), 256, DM, 512, 1024 * 256 * 2}; pg8::EpiZ EZ{A};
        pg8::gemm_phase<pg8::EpiZ, pg8::StaticOrder, PG8_ALIGN, PG8_SP2>(F.lds + RING_OFF, gz, S, EZ); }
    } SEAM(7);
    if (IN(8)) { PHASE_VARS(); RELAUNDER(); poolres_pass(F, AM, (bf16*)(ws + WS_RES), XN, rs3, rs2, (const int*)(ws + WS_FLAG), mod1 + GA1, A->in[I_PSC], A->in[I_GFFN] + DM, mod1 + SC2); } SEAM(8);
    if (IN(9)) REP(9) { PHASE_VARS();
        pg8::Gemm g{XN, (const bf16*)(ws + WS_W13) + (size_t)5632 * DM, DM, DM, 0, 0}; pg8::StaticOrder S; S.init(MTOK, 2 * FF, F.G, (int)blockIdx.x);
        RELAUNDER(); LAS float* rtab = (LAS float*)(F.lds + RTAB_OFF); const int pm0 = build_rtab(F, S, rs3, rtab); pg8::EpiSwiglu<1> E{A, rtab, pm0};
        pg8::gemm_phase<pg8::EpiSwiglu<1>, pg8::StaticOrder, PG8_ALIGN, PG8_SP2>(F.lds + RING_OFF, g, S, E);
    } SEAM(9);
    if (IN(10)) REP(10) { PHASE_VARS(); STAGGER();
        pg8::Gemm g{HB, (const bf16*)(ws + WS_W2) + (size_t)DM * FF, FF, FF, 0, 0}; pg8::StaticOrder S; S.init(MTOK, DM, F.G, (int)blockIdx.x);
        pg8::EpiResid<10> E{A, out};
        pg8::gemm_phase<pg8::EpiResid<10>, pg8::StaticOrder, PG8_ALIGN, PG8_SP2>(F.lds + RING_OFF, g, S, E);
    }
#undef IN
#undef SEAM
}

extern "C" void kernel_launch(void* const* d_in, const int* in_sizes, int n_in, void* d_out, int out_size, void* d_ws, size_t ws_size, hipStream_t stream) {
    static int grid = 0;
    if (grid == 0) {
        if (n_in != 21 || out_size != MTOK * DM || ws_size < WS_END) { fprintf(stderr, "kernel_launch: unexpected shapes (n_in %d, out %d, ws %zu)\n", n_in, out_size, ws_size); grid = -1; return; }
        int dev = 0, cus = 0, per_cu = 0;
        if (hipGetDevice(&dev) != hipSuccess || hipDeviceGetAttribute(&cus, hipDeviceAttributeMultiprocessorCount, dev) != hipSuccess) { grid = -1; return; }
        if (hipFuncSetAttribute((const void*)mega_fwd, hipFuncAttributeMaxDynamicSharedMemorySize, LDS_BYTES) != hipSuccess) { fprintf(stderr, "kernel_launch: hipFuncSetAttribute failed\n"); grid = -1; return; }
        if (hipOccupancyMaxActiveBlocksPerMultiprocessor(&per_cu, (const void*)mega_fwd, NWAVES * 64, LDS_BYTES) != hipSuccess || per_cu < 1) { fprintf(stderr, "kernel_launch: occupancy query says %d\n", per_cu); per_cu = 1; }
        (void)hipGetLastError();
        grid = cus;
        if (grid != 256) fprintf(stderr, "kernel_launch: %d CUs (expected 256)\n", grid);
    }
    if (grid < 0) return;
    if (hipMemsetAsync((char*)d_ws + WS_CTL, 0, CTL_ZERO_BYTES, stream) != hipSuccess) return;
    Args a{};
    for (int i = 0; i < 21; ++i) a.in[i] = (const float*)d_in[i];
    a.out = (float*)d_out; a.ws = (unsigned char*)d_ws;
#if defined(MK_PER_PHASE)
    for (int p = 0; p < N_PHASES; ++p) { a.ph_lo = p; a.ph_hi = p + 1; hipLaunchKernelGGL(mega_fwd, dim3(grid), dim3(NWAVES * 64), LDS_BYTES, stream, a); }
#else
    a.ph_lo = 0; a.ph_hi = N_PHASES;
    hipLaunchKernelGGL(mega_fwd, dim3(grid), dim3(NWAVES * 64), LDS_BYTES, stream, a);
#endif
}
```

```cpp
#include <hip/hip_runtime.h>
#include <hip/hip_bf16.h>
#include <cstdio>
#include <cstdint>
#include <cmath>
constexpr int NWAVES_ = 8;
constexpr int NWAVES = 8;
constexpr int DM = 1024, NB = 8, SEQ = 4096, MTOK = NB * SEQ, CTXL = 256, MCTX = NB * CTXL, MALL = MTOK + MCTX;
constexpr int INW = 1792, FF = 2816, SKV = SEQ + CTXL;
constexpr int N_PHASES = 11;
constexpr size_t MiB = 1u << 20;
constexpr size_t WS_CTL = 0, CTL_ZERO_BYTES = 128 * 1024;
constexpr size_t WS_MODS = 1 * MiB;
constexpr size_t WS_ROPE = WS_MODS + 512 * 1024;
constexpr size_t WS_WSB = 2 * MiB;
constexpr size_t WS_WPOOL = WS_WSB + 512 * 1024;
constexpr size_t WS_RIN = 3 * MiB;
constexpr size_t WS_BIASIN = WS_RIN + 256 * 1024;
constexpr size_t WS_WIN = 4 * MiB;
constexpr size_t WS_WOUT = 8 * MiB;
constexpr size_t WS_W13 = 10 * MiB;
constexpr size_t WS_W2 = 32 * MiB;
constexpr size_t WS_XN = 44 * MiB;
constexpr size_t WS_Q = 112 * MiB;
constexpr size_t WS_RES = 112 * MiB;
constexpr size_t WS_KB = 144 * MiB;
constexpr size_t WS_VB = 153 * MiB;
constexpr size_t WS_U = 162 * MiB;
constexpr size_t WS_VG = 194 * MiB;
constexpr size_t WS_AM = 226 * MiB;
constexpr size_t WS_H = 290 * MiB;
constexpr size_t WS_WPB = 474 * MiB;
constexpr size_t WS_END = 478 * MiB;
constexpr int CW_BAR = 4096;
constexpr size_t CTL_CNT = 65536;
constexpr size_t WS_PART = 466 * MiB;
static_assert(CTL_CNT + 32768 <= CTL_ZERO_BYTES, "CTL map");
constexpr size_t WS_FLAG = WS_ROPE + 32768;
constexpr size_t WS_BIAS = WS_ROPE + 65536;
constexpr int RING_OFF = 0, RING_BYTES = 131072;
constexpr int LDSCTL_OFF = RING_BYTES, MISC_OFF = LDSCTL_OFF + 320;
constexpr int RTAB_OFF = LDSCTL_OFF + 1024;
constexpr int LDS_BYTES = 147456;
static_assert(MISC_OFF + 128 <= LDS_BYTES, "LDS map");

struct Args { const float* in[21]; float* out; unsigned char* ws; int ph_lo, ph_hi; };
#define KARG __attribute__((address_space(4)))
typedef const KARG Args* ArgsP;
static_assert(sizeof(Args) == 192, "Args has no padding");
enum { I_X = 0, I_C, I_CTX, I_CCTX, I_WADA, I_BADA, I_GMIX, I_GFFN, I_WIN, I_WOUT, I_QN, I_KN, I_GN, I_WSP, I_BSP, I_WPOOL, I_PSC, I_W1, I_W3, I_W2, I_GFIN };
constexpr int SH1 = 0, SC1 = DM, GA1 = 2 * DM, SH2 = 3 * DM, SC2 = 4 * DM, GA2 = 5 * DM, MODW = 6 * DM;

template <int CTRL> __device__ __forceinline__ float dpp_add(float x) { return x + __builtin_bit_cast(float, __builtin_amdgcn_update_dpp(0, __builtin_bit_cast(int, x), CTRL, 0xF, 0xF, true)); }
__device__ __forceinline__ float xor16_add(float x) { const unsigned u = __builtin_bit_cast(unsigned, x); auto r = __builtin_amdgcn_permlane16_swap(u, u, false, false); return __builtin_bit_cast(float, (unsigned)r[0]) + __builtin_bit_cast(float, (unsigned)r[1]); }
__device__ __forceinline__ float xor32_add(float x) { const unsigned u = __builtin_bit_cast(unsigned, x); auto r = __builtin_amdgcn_permlane32_swap(u, u, false, false); return __builtin_bit_cast(float, (unsigned)r[0]) + __builtin_bit_cast(float, (unsigned)r[1]); }
__device__ __forceinline__ float wave_sum64(float v) { v = dpp_add<0xB1>(v); v = dpp_add<0x4E>(v); v = dpp_add<0x124>(v); v = dpp_add<0x128>(v); v = xor16_add(v); return xor32_add(v); }
namespace pg8 {
#define PG8_LAS __attribute__((address_space(3)))
typedef unsigned short bf16_t;
typedef short bf16x8 __attribute__((ext_vector_type(8)));
typedef float f32x4 __attribute__((ext_vector_type(4)));
typedef float f32x2 __attribute__((ext_vector_type(2)));
typedef unsigned u32x4 __attribute__((ext_vector_type(4)));
constexpr int BM = 256, BK = 64, HALF = 128, HTB = HALF * BK * 2  , STAGE_BYTES = 8 * HTB, NXCD = 8, WGM = 8;

__host__ __device__ __forceinline__ int lds_byte(int r, int c) { const int st = (r >> 4) * 2 + (c >> 5), rr = r & 15, cc = c & 31, ob = rr * 64 + cc * 2; return st * 1024 + (ob ^ (((ob >> 9) & 1) << 5)); }
__host__ __device__ __forceinline__ void stage_rc(int b, int& R, int& C) { const int st = b / 1024, sb = b % 1024, swz = sb ^ (((sb >> 9) & 1) << 5); R = (st >> 1) * 16 + swz / 64; C = (st & 1) * 32 + (swz % 64) / 2; }
__host__ __device__ __forceinline__ int perm32(int rho) { const int n = rho >> 4, i = rho & 15; return 8 * (i >> 2) + 4 * n + (i & 3); }

struct Unit { int pm, pn; };
struct Gemm { const bf16_t* A; const bf16_t* Bt; int K; int lda; int a_pn_bytes; int b_batch_bytes; };

struct StaticOrder {
    int nM, nN, nwg, G, c, extra, extra_pn;
    __host__ __device__ void init(int M, int N, int G_, int c_, int extra_ = 0, int extra_pn_ = 0) { nM = M / BM; nN = N / BM; nwg = nM * nN; G = G_; c = c_; extra = extra_; extra_pn = extra_pn_; }
    __host__ __device__ bool next(int i, Unit& u) const {
        const long L = (long)i * G + c;
        if (L >= nwg) { const long e = L - nwg; if (e >= extra) return false; u.pm = nM + (int)e; u.pn = extra_pn; return true; }
        int wgid = (int)L; { const int q = nwg / NXCD, r = nwg % NXCD, xcd = wgid % NXCD, off = wgid / NXCD; wgid = (xcd < r ? xcd * (q + 1) : r * (q + 1) + (xcd - r) * q) + off; }
        const int nig = WGM * nN, gid = wgid / nig, fm = gid * WGM, gsz = (nM - fm) < WGM ? (nM - fm) : WGM;
        u.pm = fm + ((wgid % nig) % gsz); u.pn = (wgid % nig) / gsz; return true;
    }
    __device__ __forceinline__ void a_ready(const Unit&) const {}
    __device__ __forceinline__ void done(const Unit&) const {}
};

__device__ __forceinline__ unsigned cvt_pk_bf16(float lo, float hi) { unsigned r; asm volatile("v_cvt_pk_bf16_f32 %0, %1, %2" : "=v"(r) : "v"(lo), "v"(hi)); return r; }
__device__ __forceinline__ f32x2 gelu_pk(f32x2 v) {
    const f32x2 av = __builtin_elementwise_abs(v), d = av * 0.2316418882f + 1.0f;
    f32x2 t; t.x = __builtin_amdgcn_rcpf(d.x); t.y = __builtin_amdgcn_rcpf(d.y);
    f32x2 q = t * 0.5307027145f + (-0.7265760135f); q = q * t + 0.7107068705f; q = q * t + (-0.142248368f); q = q * t + 0.127414796f; q = q * t;
    const f32x2 s = (v * v) * (-0.72134752044f);
    f32x2 e; e.x = __builtin_amdgcn_exp2f(s.x); e.y = __builtin_amdgcn_exp2f(s.y);
    const f32x2 m = v * (q * e), r = v - m;
    f32x2 o; o.x = v.x < 0.f ? m.x : r.x; o.y = v.y < 0.f ? m.y : r.y; return o;
}
__device__ __forceinline__ f32x4 gelu4(f32x4 v) { const f32x2 a = gelu_pk((f32x2){v[0], v[1]}), b = gelu_pk((f32x2){v[2], v[3]}); return (f32x4){a.x, a.y, b.x, b.y}; }
__device__ __forceinline__ float silu1(float v) { return v * __builtin_amdgcn_rcpf(1.0f + __builtin_amdgcn_exp2f(v * -1.4426950408889634f)); }
__device__ __forceinline__ u32x4 pack8(f32x4 v0, f32x4 v1) { u32x4 w; w.x = cvt_pk_bf16(v0[0], v0[1]); w.y = cvt_pk_bf16(v0[2], v0[3]); w.z = cvt_pk_bf16(v1[0], v1[1]); w.w = cvt_pk_bf16(v1[2], v1[3]); return w; }

struct EpiInProj {
    static constexpr bool PERM = true, AFTER_DRAIN = false;
    ArgsP A;
    __device__ __forceinline__ void operator()(f32x4 (&acc)[2][2][4][2], const Unit& u, int wr, int wc, int fr_, int fq_) const {
        ArgsP a_ = A; asm volatile("" : "+s"(a_)); unsigned char* ws_ = a_->ws;
        bf16_t* Q = (bf16_t*)(ws_ + WS_Q); bf16_t* KB = (bf16_t*)(ws_ + WS_KB); bf16_t* VB = (bf16_t*)(ws_ + WS_VB); bf16_t* U = (bf16_t*)(ws_ + WS_U); bf16_t* VG = (bf16_t*)(ws_ + WS_VG);
        const float* qn = a_->in[I_QN]; const float* kn = a_->in[I_KN]; const float* gv = a_->in[I_GN]; const float* ropeC = (const float*)(ws_ + WS_ROPE); const float* ropeS = ropeC + 1024;
        const float qscale = 0.125f * 1.4426950408889634f;
        int t_ = threadIdx.x; asm volatile("" : "+v"(t_)); const int fr = t_ & 15, fq = (t_ >> 4) & 3; (void)fr_; (void)fq_;
        const int slot = 4 * u.pn + wc; const bool isctx = u.pm >= 128;
        const int rowl = wr * 64 + fr;
        const int row0 = u.pm * BM + rowl;
        const int kvrow0 = (isctx ? (u.pm - 128) * 4352 + 4096 : (u.pm >> 4) * 4352 + (u.pm & 15) * 256) + rowl;
        const int dl = 8 * fq;
        {
            const float* rin = (const float*)(ws_ + WS_RIN) + row0; const float* bin = (const float*)(ws_ + WS_BIASIN) + (size_t)(isctx ? 8 : (u.pm >> 4)) * INW + 64 * slot + dl;
            f32x4 bv[2][2]; float rr[2][4];
#pragma unroll
            for (int bj = 0; bj < 2; ++bj)
#pragma unroll
                for (int n = 0; n < 2; ++n) bv[bj][n] = *(const f32x4*)(bin + 32 * bj + 4 * n);
#pragma unroll
            for (int ai = 0; ai < 2; ++ai)
#pragma unroll
                for (int m = 0; m < 4; ++m) rr[ai][m] = rin[ai * HALF + m * 16];
#pragma unroll
            for (int ai = 0; ai < 2; ++ai)
#pragma unroll
                for (int bj = 0; bj < 2; ++bj)
#pragma unroll
                    for (int m = 0; m < 4; ++m)
#pragma unroll
                        for (int n = 0; n < 2; ++n) acc[ai][bj][m][n] = acc[ai][bj][m][n] * rr[ai][m] + bv[bj][n];
            asm volatile("" ::: "memory"); }
        if (slot < 10) {
            const float* nw = slot < 8 ? qn : kn; const float osc = slot < 8 ? qscale : 1.0f;
            f32x4 w[2][2];
#pragma unroll
            for (int bj = 0; bj < 2; ++bj)
#pragma unroll
                for (int n = 0; n < 2; ++n) w[bj][n] = *(const f32x4*)(nw + 32 * bj + dl + 4 * n);
#pragma unroll
            for (int ai = 0; ai < 2; ++ai) {
                const int posr = (4 * u.pm + 2 * ai + wr) & 63;
                const f32x4 cr = *(const f32x4*)(ropeC + posr * 16 + 4 * fq), sr = *(const f32x4*)(ropeS + posr * 16 + 4 * fq);
#pragma unroll
                for (int m = 0; m < 4; ++m) {
                    float ss = 0.f;
#pragma unroll
                    for (int bj = 0; bj < 2; ++bj)
#pragma unroll
                        for (int n = 0; n < 2; ++n) { const f32x4 x = acc[ai][bj][m][n]; ss += (x[0] * x[0] + x[1] * x[1]) + (x[2] * x[2] + x[3] * x[3]); }
                    ss = xor32_add(xor16_add(ss));
                    const float r = __builtin_amdgcn_rsqf(ss * (1.0f / 64.0f) + 1e-6f) * osc;
                    const int posc = 16 * m + fr;
                    const f32x4 cc = *(const f32x4*)(ropeC + posc * 16 + 4 * fq), sc = *(const f32x4*)(ropeS + posc * 16 + 4 * fq);
#pragma unroll
                    for (int bj = 0; bj < 2; ++bj) {
                        f32x4 v0 = acc[ai][bj][m][0] * r * w[bj][0], v1 = acc[ai][bj][m][1] * r * w[bj][1];
                        if (!isctx) { const f32x4 c = bj ? cc : cr, s = bj ? sc : sr;
                            const f32x4 o0 = (f32x4){v0[0] * c[0] - v0[1] * s[0], v0[0] * s[0] + v0[1] * c[0], v0[2] * c[1] - v0[3] * s[1], v0[2] * s[1] + v0[3] * c[1]};
                            const f32x4 o1 = (f32x4){v1[0] * c[2] - v1[1] * s[2], v1[0] * s[2] + v1[1] * c[2], v1[2] * c[3] - v1[3] * s[3], v1[2] * s[3] + v1[3] * c[3]};
                            v0 = o0; v1 = o1; }
                        bf16_t* dst = slot < 8 ? Q + (size_t)(row0 + ai * HALF + m * 16) * 512 + slot * 64 + 32 * bj + dl
                                               : KB + (size_t)(kvrow0 + ai * HALF + m * 16) * 128 + (slot - 8) * 64 + 32 * bj + dl;
                        *(u32x4*)dst = pack8(v0, v1);
                    }
                    asm volatile("" ::: "memory");
                }
            }
        } else if (slot < 12) {
#pragma unroll
            for (int ai = 0; ai < 2; ++ai)
#pragma unroll
                for (int m = 0; m < 4; ++m)
#pragma unroll
                    for (int bj = 0; bj < 2; ++bj)
                        *(u32x4*)(VB + (size_t)(kvrow0 + ai * HALF + m * 16) * 128 + (slot - 10) * 64 + 32 * bj + dl) = pack8(acc[ai][bj][m][0], acc[ai][bj][m][1]);
        } else if (slot < 20) {
#pragma unroll
            for (int ai = 0; ai < 2; ++ai)
#pragma unroll
                for (int m = 0; m < 4; ++m)
#pragma unroll
                    for (int bj = 0; bj < 2; ++bj)
                        *(u32x4*)(U + (size_t)(row0 + ai * HALF + m * 16) * 512 + (slot - 12) * 64 + 32 * bj + dl) = pack8(gelu4(acc[ai][bj][m][0]), gelu4(acc[ai][bj][m][1]));
        } else {
            f32x4 w[2][2];
#pragma unroll
            for (int bj = 0; bj < 2; ++bj)
#pragma unroll
                for (int n = 0; n < 2; ++n) w[bj][n] = *(const f32x4*)(gv + (slot - 20) * 64 + 32 * bj + dl + 4 * n);
#pragma unroll
            for (int ai = 0; ai < 2; ++ai)
#pragma unroll
                for (int m = 0; m < 4; ++m) {
                    f32x4 g[2][2]; float ss = 0.f;
#pragma unroll
                    for (int bj = 0; bj < 2; ++bj)
#pragma unroll
                        for (int n = 0; n < 2; ++n) { const f32x4 x = gelu4(acc[ai][bj][m][n]); g[bj][n] = x; ss += (x[0] * x[0] + x[1] * x[1]) + (x[2] * x[2] + x[3] * x[3]); }
                    ss = xor32_add(xor16_add(ss));
                    const float r = __builtin_amdgcn_rsqf(ss * (1.0f / 64.0f) + 1e-6f);
#pragma unroll
                    for (int bj = 0; bj < 2; ++bj)
                        *(u32x4*)(VG + (size_t)(row0 + ai * HALF + m * 16) * 512 + (slot - 20) * 64 + 32 * bj + dl) = pack8(g[bj][0] * r * w[bj][0], g[bj][1] * r * w[bj][1]);
                }
        }
    }
};
constexpr int RS_M = 32768;
__device__ __forceinline__ float row_total(const float* part, int row, int fq) {
    const f32x4 p = *(const f32x4*)(part + ((size_t)fq * RS_M + row) * 4); float t = (p[0] + p[1]) + (p[2] + p[3]); t = xor32_add(xor16_add(t)); return t;
}
template <int V> struct EpiResid {
    static constexpr bool PERM = true, AFTER_DRAIN = false, XNOUT = (V == 4 || V == 5), FINAL = (V == 10), BASE16 = (V != 4), RESOUT = (V != 5);
    ArgsP A; void* outp;
    __device__ __forceinline__ void operator()(f32x4 (&acc)[2][2][4][2], const Unit& u, int wr, int wc, int fr_, int fq_) const {
        int t_ = threadIdx.x; asm volatile("" : "+v"(t_)); const int fr = t_ & 15, fq = (t_ >> 4) & 3; (void)fr_; (void)fq_;
        const int row0 = u.pm * BM + wr * 64 + fr, col0 = u.pn * BM + wc * 32 + 8 * fq, b = u.pm >> 4;
        ArgsP a_ = A; asm volatile("" : "+s"(a_)); unsigned char* ws_ = a_->ws; constexpr int gstride = MODW;
        const float* mods_ = (const float*)(ws_ + WS_MODS); const float* modl_ = mods_ + (V == 10 ? 9 * MODW : 0);
        const float* basef = a_->in[I_X]; const bf16_t* baseh = (const bf16_t*)(ws_ + WS_RES); const float* gate = modl_ + (XNOUT ? GA1 : GA2);
        float* part = (float*)(ws_ + WS_PART) + (size_t)(XNOUT ? 0 : V == 10 ? 3 : 1) * 16 * RS_M;
        bf16_t* xn = (bf16_t*)(ws_ + WS_XN); const float* gnext = XNOUT ? a_->in[I_GFFN] : a_->in[I_GMIX] + DM; const float* scnext = XNOUT ? mods_ + SC2 : mods_ + 9 * MODW + SC1;
        unsigned* cnt = (unsigned*)(ws_ + WS_CTL + CTL_CNT); const float* gfin = a_->in[I_GFIN];
        bf16_t* resout = (bf16_t*)outp; float* out = (float*)outp;
        const float* gp = gate + (size_t)b * gstride + col0;
        const bool xo = (V == 5) ? true : BASE16 ? (__builtin_amdgcn_readfirstlane(*(const int*)(ws_ + WS_FLAG)) != 0) : false;
        if (BASE16 && xo) baseh = (const bf16_t*)(ws_ + WS_XN);
        f32x4 gvv[2][2], gmn[2][2], rgv[2][2];
#pragma unroll
        for (int bj = 0; bj < 2; ++bj)
#pragma unroll
            for (int n = 0; n < 2; ++n) { gvv[bj][n] = *(const f32x4*)(gp + bj * HALF + n * 4);
                if (XNOUT) gmn[bj][n] = *(const f32x4*)(gnext + col0 + bj * HALF + n * 4) * (*(const f32x4*)(scnext + (size_t)b * gstride + col0 + bj * HALF + n * 4) + 1.0f);
                if (BASE16) { const float* gprev = (V == 10) ? a_->in[I_GFFN] + DM : (V == 5) ? a_->in[I_GMIX] : a_->in[I_GFFN]; const float* scprev = modl_ + (V == 5 ? SC1 : SC2);
                    const f32x4 m = *(const f32x4*)(gprev + col0 + bj * HALF + n * 4) * (*(const f32x4*)(scprev + (size_t)b * gstride + col0 + bj * HALF + n * 4) + 1.0f);
                    rgv[bj][n] = xo ? (f32x4){__builtin_amdgcn_rcpf(m[0]), __builtin_amdgcn_rcpf(m[1]), __builtin_amdgcn_rcpf(m[2]), __builtin_amdgcn_rcpf(m[3])} : (f32x4){1.f, 1.f, 1.f, 1.f}; } }
        float ssv[2][4];
        f32x4 bsA[2][2], bsB[2][2], bsC[2][2], bsD[2][2], bsE[2][2], bsF[2][2], bsG[2][2], bsH[2][2];
        u32x4 hsA[2], hsB[2], hsC[2], hsD[2], hsE[2], hsF[2], hsG[2], hsH[2];
#define ER_LOAD(X, p) do { const size_t off_ = (size_t)(row0 + ((p) >> 2) * HALF + ((p) & 3) * 16) * 1024 + col0; \
            _Pragma("unroll") for (int bj = 0; bj < 2; ++bj) { if (BASE16) { if (FINAL) hs##X[bj] = __builtin_nontemporal_load((const u32x4*)(baseh + off_ + bj * HALF)); else hs##X[bj] = *(const u32x4*)(baseh + off_ + bj * HALF); } \
                else { bs##X[bj][0] = __builtin_nontemporal_load((const f32x4*)(basef + off_ + bj * HALF)); bs##X[bj][1] = __builtin_nontemporal_load((const f32x4*)(basef + off_ + bj * HALF + 4)); } } } while (0)
#define ER_WORK(X, p) do { const int ai = (p) >> 2, m = (p) & 3; const size_t off_ = (size_t)(row0 + ai * HALF + m * 16) * 1024 + col0; float ss = 0.f; \
            _Pragma("unroll") for (int bj = 0; bj < 2; ++bj) { f32x4 b0, b1; \
                if (BASE16) { const u32x4 h = hs##X[bj]; b0 = (f32x4){__builtin_bit_cast(float, h.x << 16), __builtin_bit_cast(float, h.x & 0xffff0000u), __builtin_bit_cast(float, h.y << 16), __builtin_bit_cast(float, h.y & 0xffff0000u)}; \
                    b1 = (f32x4){__builtin_bit_cast(float, h.z << 16), __builtin_bit_cast(float, h.z & 0xffff0000u), __builtin_bit_cast(float, h.w << 16), __builtin_bit_cast(float, h.w & 0xffff0000u)}; b0 *= rgv[bj][0]; b1 *= rgv[bj][1]; } \
                else { b0 = bs##X[bj][0]; b1 = bs##X[bj][1]; } \
                const f32x4 x0 = b0 + gvv[bj][0] * acc[ai][bj][m][0], x1 = b1 + gvv[bj][1] * acc[ai][bj][m][1]; \
                ss += ((x0[0] * x0[0] + x0[1] * x0[1]) + (x0[2] * x0[2] + x0[3] * x0[3])) + ((x1[0] * x1[0] + x1[1] * x1[1]) + (x1[2] * x1[2] + x1[3] * x1[3])); \
                if (FINAL) { acc[ai][bj][m][0] = x0; acc[ai][bj][m][1] = x1; } else if (RESOUT) *(u32x4*)(resout + off_ + bj * HALF) = pack8(x0, x1); \
                if (XNOUT) *(u32x4*)(xn + off_ + bj * HALF) = pack8(x0 * gmn[bj][0], x1 * gmn[bj][1]); } \
            ss = xor32_add(xor16_add(ss)); ssv[ai][m] = ss; } while (0)
#define ER_FENCE asm volatile("" ::: "memory")
        if constexpr (BASE16 && !XNOUT) {
            ER_LOAD(A, 0); ER_LOAD(B, 1); ER_LOAD(C, 2); ER_LOAD(D, 3); ER_FENCE;
            ER_LOAD(E, 4); ER_FENCE; ER_WORK(A, 0); ER_FENCE;
            ER_LOAD(A, 5); ER_FENCE; ER_WORK(B, 1); ER_FENCE;
            ER_LOAD(B, 6); ER_FENCE; ER_WORK(C, 2); ER_FENCE;
            ER_LOAD(C, 7); ER_FENCE; ER_WORK(D, 3); ER_FENCE;
            ER_WORK(E, 4); ER_FENCE; ER_WORK(A, 5); ER_FENCE; ER_WORK(B, 6); ER_FENCE; ER_WORK(C, 7);
        } else {
            ER_LOAD(A, 0); ER_LOAD(B, 1); ER_FENCE;
            ER_LOAD(C, 2); ER_FENCE; ER_WORK(A, 0); ER_FENCE;
            ER_LOAD(A, 3); ER_FENCE; ER_WORK(B, 1); ER_FENCE;
            ER_LOAD(B, 4); ER_FENCE; ER_WORK(C, 2); ER_FENCE;
            ER_LOAD(C, 5); ER_FENCE; ER_WORK(A, 3); ER_FENCE;
            ER_LOAD(A, 6); ER_FENCE; ER_WORK(B, 4); ER_FENCE;
            ER_LOAD(B, 7); ER_FENCE; ER_WORK(C, 5); ER_FENCE;
            ER_WORK(A, 6); ER_FENCE;
            ER_WORK(B, 7);
        }
#undef ER_FENCE
#undef ER_LOAD
#undef ER_WORK
        if (fq == 0) {
#pragma unroll
            for (int ai = 0; ai < 2; ++ai)
#pragma unroll
                for (int m = 0; m < 4; ++m) { float* pp = part + ((size_t)u.pn * RS_M + (row0 + ai * HALF + m * 16)) * 4 + wc;
                    if (FINAL) __hip_atomic_store(pp, ssv[ai][m], __ATOMIC_RELAXED, __HIP_MEMORY_SCOPE_AGENT); else *pp = ssv[ai][m]; }
        }
        if (FINAL) {
            asm volatile("s_waitcnt vmcnt(0)" ::: "memory");
            unsigned* cw = cnt + 64 * u.pm;
            if (fr == 0 && fq == 0) __hip_atomic_fetch_add(cw, 1u, __ATOMIC_RELAXED, __HIP_MEMORY_SCOPE_AGENT);
            { unsigned sp = 0; while ((unsigned)__builtin_amdgcn_readfirstlane(__hip_atomic_load(cw, __ATOMIC_RELAXED, __HIP_MEMORY_SCOPE_AGENT)) < 32u) { __builtin_amdgcn_s_sleep(2); if (++sp > (1u << 22)) break; } }
            f32x4 gf[2][2];
#pragma unroll
            for (int bj = 0; bj < 2; ++bj)
#pragma unroll
                for (int n = 0; n < 2; ++n) gf[bj][n] = *(const f32x4*)(gfin + col0 + bj * HALF + n * 4);
            float rr[2][4];
            {
                f32x4 pq[8];
#pragma unroll
                for (int i = 0; i < 8; ++i) { const float* pp = part + ((size_t)fq * RS_M + (row0 + (i >> 2) * HALF + (i & 3) * 16)) * 4;
                    asm volatile("global_load_dwordx4 %0, %1, off sc1" : "=v"(pq[i]) : "v"(pp) : "memory"); }
                asm volatile("s_waitcnt vmcnt(0)" : "+v"(pq[0]), "+v"(pq[1]), "+v"(pq[2]), "+v"(pq[3]), "+v"(pq[4]), "+v"(pq[5]), "+v"(pq[6]), "+v"(pq[7]) :: "memory");
#pragma unroll
                for (int i = 0; i < 8; ++i) { float t = (pq[i][0] + pq[i][1]) + (pq[i][2] + pq[i][3]); t = xor32_add(xor16_add(t)); rr[i >> 2][i & 3] = __builtin_amdgcn_rsqf(t * (1.0f / 1024.0f) + 1e-6f); }
            }
#pragma unroll
            for (int ai = 0; ai < 2; ++ai)
#pragma unroll
                for (int m = 0; m < 4; ++m) { const size_t off = (size_t)(row0 + ai * HALF + m * 16) * 1024 + col0;
#pragma unroll
                    for (int bj = 0; bj < 2; ++bj)
#pragma unroll
                        for (int n = 0; n < 2; ++n) *(f32x4*)(out + off + bj * HALF + n * 4) = acc[ai][bj][m][n] * rr[ai][m] * gf[bj][n]; }
        }
    }
};
template <int L> struct EpiSwiglu {
    static constexpr bool PERM = true, AFTER_DRAIN = false;
    ArgsP A; const PG8_LAS float* rtab; int pm0;
    __device__ __forceinline__ void operator()(const f32x4 (&acc)[2][2][4][2], const Unit& u, int wr, int wc, int fr_, int fq_) const {
        int t_ = threadIdx.x; asm volatile("" : "+v"(t_)); const int fr = t_ & 15, fq = (t_ >> 4) & 3; (void)fr_; (void)fq_;
        const int row0 = u.pm * BM + wr * 64 + fr, col0 = u.pn * HALF + wc * 32 + 8 * fq;
        ArgsP a_ = A; asm volatile("" : "+s"(a_)); unsigned char* ws_ = a_->ws; constexpr int ldh = FF;
        bf16_t* H = (bf16_t*)(ws_ + WS_H); const float* rowss = (const float*)(ws_ + WS_PART) + (size_t)(L ? 2 : 0) * 16 * RS_M; const float* bias = (const float*)(ws_ + WS_BIAS) + (size_t)L * 8 * 5632;
        const float* bp = bias + (size_t)(u.pm >> 4) * 5632 + u.pn * BM + wc * 32 + 8 * fq;
        f32x4 bv[2][2];
#pragma unroll
        for (int bj = 0; bj < 2; ++bj)
#pragma unroll
            for (int n = 0; n < 2; ++n) bv[bj][n] = *(const f32x4*)(bp + bj * HALF + 4 * n);
        float rr[2][4]; { const PG8_LAS float* rt = rtab + (u.pm == pm0 ? 0 : 256) + wr * 64 + fr; (void)rowss;
#pragma unroll
            for (int ai = 0; ai < 2; ++ai)
#pragma unroll
                for (int m = 0; m < 4; ++m) rr[ai][m] = rt[ai * HALF + m * 16]; }
#pragma unroll
        for (int ai = 0; ai < 2; ++ai)
#pragma unroll
            for (int m = 0; m < 4; ++m) { const int row = row0 + ai * HALF + m * 16; const float r = rr[ai][m]; f32x4 h[2];
#pragma unroll
                for (int n = 0; n < 2; ++n) { const f32x4 a = acc[ai][0][m][n] * r + bv[0][n], b = acc[ai][1][m][n] * r + bv[1][n]; h[n] = (f32x4){silu1(a[0]) * b[0], silu1(a[1]) * b[1], silu1(a[2]) * b[2], silu1(a[3]) * b[3]}; }
                *(u32x4*)(H + (size_t)row * ldh + col0) = pack8(h[0], h[1]); }
    }
};

struct EpiNull {
    static constexpr bool PERM = true, AFTER_DRAIN = false;
    bf16_t* D;
    __device__ __forceinline__ void operator()(const f32x4 (&acc)[2][2][4][2], const Unit& u, int wr, int wc, int fr_, int fq_) const {
        int t_ = threadIdx.x; asm volatile("" : "+v"(t_)); const int fr = t_ & 15, fq = (t_ >> 4) & 3; (void)fr_; (void)fq_;
        const int row0 = u.pm * BM + wr * 64 + fr, col0 = u.pn * BM + wc * 32 + 8 * fq;
#pragma unroll
        for (int ai = 0; ai < 2; ++ai)
#pragma unroll
            for (int m = 0; m < 4; ++m)
#pragma unroll
                for (int bj = 0; bj < 2; ++bj) *(u32x4*)(D + (size_t)(row0 + ai * HALF + m * 16) * 1024 + col0 + bj * HALF) = pack8(acc[ai][bj][m][0], acc[ai][bj][m][1]);
    }
};
struct EpiNullWide {
    static constexpr bool PERM = true, AFTER_DRAIN = false;
    bf16_t* D;
    __device__ __forceinline__ void operator()(const f32x4 (&acc)[2][2][4][2], const Unit& u, int wr, int wc, int fr_, int fq_) const {
        int t_ = threadIdx.x; asm volatile("" : "+v"(t_)); const int fr = t_ & 15, fq = (t_ >> 4) & 3; (void)fr_; (void)fq_;
        const int row0 = u.pm * BM + wr * 64 + fr, col0 = u.pn * HALF + wc * 32 + 8 * fq;
#pragma unroll
        for (int ai = 0; ai < 2; ++ai)
#pragma unroll
            for (int m = 0; m < 4; ++m) *(u32x4*)(D + (size_t)(row0 + ai * HALF + m * 16) * 2816 + col0) = pack8(acc[ai][0][m][0] + acc[ai][1][m][0], acc[ai][0][m][1] + acc[ai][1][m][1]);
    }
};
struct EpiZ {
    static constexpr bool PERM = true, AFTER_DRAIN = false;
    ArgsP A;
    __device__ __forceinline__ void operator()(const f32x4 (&acc)[2][2][4][2], const Unit& u, int wr, int wc, int fr_, int fq_) const {
        int t_ = threadIdx.x; asm volatile("" : "+v"(t_)); const int fr = t_ & 15, fq = (t_ >> 4) & 3; (void)fr_; (void)fq_;
        const int row0 = u.pm * BM + wr * 64 + fr, col0 = u.pn * BM + wc * 32 + 8 * fq;
        ArgsP a_ = A; asm volatile("" : "+s"(a_)); unsigned char* ws_ = a_->ws; bf16_t* Z = (bf16_t*)(ws_ + WS_AM);
#pragma unroll
        for (int ai = 0; ai < 2; ++ai)
#pragma unroll
            for (int m = 0; m < 4; ++m)
#pragma unroll
                for (int bj = 0; bj < 2; ++bj) *(u32x4*)(Z + (size_t)(row0 + ai * HALF + m * 16) * 1024 + col0 + bj * HALF) = pack8(acc[ai][bj][m][0], acc[ai][bj][m][1]);
    }
};

template <class Epi, class Sched, bool ALIGN_EPI = false, bool SP2 = false>
__device__ __forceinline__ void gemm_phase(PG8_LAS unsigned char* lds, const Gemm g, const Sched& S, const Epi& E) {
    int tid_ = threadIdx.x; asm volatile("" : "+v"(tid_));
    const int tid = tid_, wid = __builtin_amdgcn_readfirstlane(tid >> 6), lane = tid & 63, wr = wid >> 2, wc = wid & 3, fr = lane & 15, fq = lane >> 4;
    const int K = g.K, nt = K / BK;
    unsigned voffA[2], voffB[2];
#pragma unroll
    for (int i = 0; i < 2; ++i) { int R, C; stage_rc(tid * 16 + i * 8192, R, C); const int Rb = Epi::PERM ? ((R & ~31) + perm32(R & 31)) : R;
        voffA[i] = (unsigned)(R * g.lda + C) * 2u; voffB[i] = (unsigned)(Rb * K + C) * 2u; }
    const size_t kstep = (size_t)(BK * 2);
    const size_t hsA = (size_t)HALF * g.lda * 2, hsB = (size_t)HALF * K * 2;
    const size_t tsA = 2 * hsA, tsB = 2 * hsB;
    const unsigned ldsw = (unsigned)wid * 1024u;
    const int aoff = lds_byte(wr * 64 + fr, fq * 8), boff = lds_byte(wc * 32 + fr, fq * 8);
#define PG8_SA(b, h) (((b) * 2 + (h)) * HTB)
#define PG8_SB(b, h) ((4 + (b) * 2 + (h)) * HTB)
#define PG8_STAGE(bufoff, gbase, voff) do { _Pragma("unroll") for (int _i = 0; _i < 2; ++_i) \
        __builtin_amdgcn_global_load_lds((const unsigned*)((const char*)(gbase) + (voff)[_i]), (PG8_LAS unsigned*)(lds + (bufoff) + ldsw + _i * 8192), 16, 0, 0); } while (0)
#define PG8_LDA(dst, b, h) do { _Pragma("unroll") for (int m = 0; m < 4; ++m) _Pragma("unroll") for (int k = 0; k < 2; ++k) dst[m][k] = *(const PG8_LAS bf16x8*)(lds + PG8_SA(b, h) + aoff + m * 2048 + k * 1024); } while (0)
#define PG8_LDB(dst, b, h) do { _Pragma("unroll") for (int n = 0; n < 2; ++n) _Pragma("unroll") for (int k = 0; k < 2; ++k) dst[n][k] = *(const PG8_LAS bf16x8*)(lds + PG8_SB(b, h) + boff + n * 2048 + k * 1024); } while (0)
#define PG8_MMA(ai, bj, At, Bt) do { __builtin_amdgcn_s_setprio(1); _Pragma("unroll") for (int m = 0; m < 4; ++m) _Pragma("unroll") for (int n = 0; n < 2; ++n) _Pragma("unroll") for (int k = 0; k < 2; ++k) \
        acc[ai][bj][m][n] = __builtin_amdgcn_mfma_f32_16x16x32_bf16(Bt[n][k], At[m][k], acc[ai][bj][m][n], 0, 0, 0); __builtin_amdgcn_s_setprio(0); } while (0)
#define PG8_WAIT_V(n) asm volatile("s_waitcnt vmcnt(" #n ")" ::: "memory")
#define PG8_WAIT_L(n) asm volatile("s_waitcnt lgkmcnt(" #n ")" ::: "memory")
#define PG8_BAR __builtin_amdgcn_s_barrier()
#define PG8_SCHED __builtin_amdgcn_sched_barrier(0)
    Unit cur, nxt; int ui = 0;
    if (!S.next(0, cur)) return;
    f32x4 acc[2][2][4][2];
#pragma unroll
    for (int a = 0; a < 2; ++a)
#pragma unroll
        for (int b = 0; b < 2; ++b)
#pragma unroll
            for (int m = 0; m < 4; ++m)
#pragma unroll
                for (int n = 0; n < 2; ++n) acc[a][b][m][n] = (f32x4){0.f, 0.f, 0.f, 0.f};
    bf16x8 At[4][2], B0[2][2], B1[2][2];
    const char* cA = (const char*)g.A + (size_t)cur.pm * tsA + (size_t)cur.pn * g.a_pn_bytes; const char* cB = (const char*)g.Bt + (size_t)cur.pn * tsB + (size_t)(cur.pm >> 4) * g.b_batch_bytes;
    S.a_ready(cur);
    if constexpr (SP2) {
        PG8_STAGE(PG8_SB(0, 0), cB, voffB); PG8_STAGE(PG8_SB(0, 1), cB + hsB, voffB); PG8_STAGE(PG8_SA(0, 0), cA, voffA); PG8_STAGE(PG8_SA(0, 1), cA + hsA, voffA);
        if (wr == 1) PG8_BAR;
        PG8_WAIT_V(2); PG8_BAR;
        PG8_STAGE(PG8_SB(1, 0), cB + kstep, voffB); PG8_STAGE(PG8_SA(1, 0), cA + kstep, voffA); PG8_STAGE(PG8_SB(1, 1), cB + hsB + kstep, voffB);
        PG8_WAIT_V(6); PG8_BAR;
    } else {
        PG8_STAGE(PG8_SB(0, 0), cB, voffB); PG8_STAGE(PG8_SA(0, 0), cA, voffA); PG8_STAGE(PG8_SB(0, 1), cB + hsB, voffB); PG8_STAGE(PG8_SA(0, 1), cA + hsA, voffA);
        if (wr == 1) PG8_BAR;
        PG8_WAIT_V(4); PG8_BAR;
        PG8_STAGE(PG8_SB(1, 0), cB + kstep, voffB); PG8_STAGE(PG8_SA(1, 0), cA + kstep, voffA); PG8_STAGE(PG8_SB(1, 1), cB + hsB + kstep, voffB);
        PG8_WAIT_V(6); PG8_BAR;
    }
    for (;;) {
        const bool has_next = S.next(ui + 1, nxt);
        const char* nA = has_next ? (const char*)g.A + (size_t)nxt.pm * tsA + (size_t)nxt.pn * g.a_pn_bytes : cA; const char* nB = has_next ? (const char*)g.Bt + (size_t)nxt.pn * tsB + (size_t)(nxt.pm >> 4) * g.b_batch_bytes : cB;
#pragma unroll 1
        for (int t = 0; t < nt; t += 2) {
            const bool last = (t == nt - 2);
            const char* a1 = cA + (size_t)(t + 1) * kstep;
            const char* a2 = last ? nA : cA + (size_t)(t + 2) * kstep; const char* b2 = last ? nB : cB + (size_t)(t + 2) * kstep;
            const char* a3 = a2 + kstep; const char* b3 = b2 + kstep;
            if (last && has_next) S.a_ready(nxt);
            if constexpr (SP2) {
            PG8_LDB(B0, 0, 0); PG8_LDB(B1, 0, 1); PG8_SCHED; PG8_LDA(At, 0, 0); PG8_STAGE(PG8_SA(1, 1), a1 + hsA, voffA);
            PG8_WAIT_V(8); PG8_WAIT_L(0); PG8_BAR; PG8_MMA(0, 0, At, B0); PG8_MMA(0, 1, At, B1); PG8_BAR; PG8_SCHED;
            PG8_LDA(At, 0, 1); PG8_STAGE(PG8_SB(0, 0), b2, voffB); PG8_STAGE(PG8_SB(0, 1), b2 + hsB, voffB); PG8_STAGE(PG8_SA(0, 0), a2, voffA);
            PG8_WAIT_V(8); PG8_WAIT_L(0); PG8_BAR; PG8_MMA(1, 0, At, B0); PG8_MMA(1, 1, At, B1); PG8_BAR; PG8_SCHED;
            PG8_LDB(B0, 1, 0); PG8_LDB(B1, 1, 1); PG8_SCHED; PG8_LDA(At, 1, 0); PG8_STAGE(PG8_SA(0, 1), a2 + hsA, voffA);
            PG8_WAIT_V(8); PG8_WAIT_L(0); PG8_BAR; PG8_MMA(0, 0, At, B0); PG8_MMA(0, 1, At, B1); PG8_BAR; PG8_SCHED;
            PG8_LDA(At, 1, 1); PG8_STAGE(PG8_SB(1, 0), b3, voffB); PG8_STAGE(PG8_SB(1, 1), b3 + hsB, voffB); PG8_STAGE(PG8_SA(1, 0), a3, voffA);
            PG8_WAIT_V(8); PG8_WAIT_L(0); PG8_BAR; PG8_MMA(1, 0, At, B0); PG8_MMA(1, 1, At, B1); PG8_BAR; PG8_SCHED;
            } else {
            PG8_LDB(B0, 0, 0); PG8_SCHED; PG8_LDA(At, 0, 0); PG8_STAGE(PG8_SA(1, 1), a1 + hsA, voffA);
            PG8_WAIT_L(8); PG8_BAR; PG8_WAIT_L(0); PG8_MMA(0, 0, At, B0); PG8_BAR; PG8_SCHED;
            PG8_LDB(B1, 0, 1); PG8_STAGE(PG8_SB(0, 0), b2, voffB);
            PG8_BAR; PG8_WAIT_L(0); PG8_MMA(0, 1, At, B1); PG8_BAR;
            PG8_LDA(At, 0, 1); PG8_STAGE(PG8_SA(0, 0), a2, voffA);
            PG8_BAR; PG8_WAIT_L(0); PG8_MMA(1, 0, At, B0); PG8_BAR; PG8_SCHED;
            PG8_STAGE(PG8_SB(0, 1), b2 + hsB, voffB);
            PG8_WAIT_V(6); PG8_BAR; PG8_MMA(1, 1, At, B1); PG8_BAR;
            PG8_LDB(B0, 1, 0); PG8_SCHED; PG8_LDA(At, 1, 0); PG8_STAGE(PG8_SA(0, 1), a2 + hsA, voffA);
            PG8_WAIT_L(8); PG8_BAR; PG8_WAIT_L(0); PG8_MMA(0, 0, At, B0); PG8_BAR; PG8_SCHED;
            PG8_LDB(B1, 1, 1); PG8_STAGE(PG8_SB(1, 0), b3, voffB);
            PG8_BAR; PG8_WAIT_L(0); PG8_MMA(0, 1, At, B1); PG8_BAR;
            PG8_LDA(At, 1, 1); PG8_STAGE(PG8_SA(1, 0), a3, voffA);
            PG8_BAR; PG8_WAIT_L(0); PG8_MMA(1, 0, At, B0); PG8_BAR; PG8_SCHED;
            PG8_STAGE(PG8_SB(1, 1), b3 + hsB, voffB);
            PG8_WAIT_V(6); PG8_BAR; PG8_MMA(1, 1, At, B1); PG8_BAR;
            }
        }
        if constexpr (ALIGN_EPI) { if (wr == 0) PG8_BAR; }
        if constexpr (!Epi::AFTER_DRAIN) { E(acc, cur, wr, wc, fr, fq); S.done(cur); }
        if (!has_next) break;
#pragma unroll
        for (int a = 0; a < 2; ++a)
#pragma unroll
            for (int b = 0; b < 2; ++b)
#pragma unroll
                for (int m = 0; m < 4; ++m)
#pragma unroll
                    for (int n = 0; n < 2; ++n) acc[a][b][m][n] = (f32x4){0.f, 0.f, 0.f, 0.f};
        cur = nxt; cA = nA; cB = nB; ++ui;
        if constexpr (ALIGN_EPI) { if (wr == 1) PG8_BAR; }
    }
    PG8_WAIT_V(0);
    if constexpr (!ALIGN_EPI) { if (wr == 0) PG8_BAR; }
    PG8_BAR;
    if constexpr (Epi::AFTER_DRAIN) { E.fused(acc, cur, wr, wc, fr, fq, lds, wid, lane); S.done(cur); }
#undef PG8_SA
#undef PG8_SB
#undef PG8_STAGE
#undef PG8_LDA
#undef PG8_LDB
#undef PG8_MMA
#undef PG8_WAIT_V
#undef PG8_WAIT_L
#undef PG8_BAR
#undef PG8_SCHED
}
}
namespace attn_body {
using bf16=__hip_bfloat16;
using bf16x8=__attribute__((ext_vector_type(8)))short;
using s16x4=__attribute__((ext_vector_type(4)))short;
using f32x16=__attribute__((ext_vector_type(16)))float;
using u32x4=__attribute__((ext_vector_type(4)))unsigned;
constexpr int BATCH=8,NHEAD=8,NKVH=2,SEQ=4096,SKV=4352,D=64,QP=512,KP=128,OP=1024;
constexpr int NW=8,QBLK=32,QB=QBLK*NW,KVBLK=64,NQB=SEQ/QB;
constexpr int ATTN_UNIT_ROWS=QB;
__device__ __forceinline__ int crow(int r,int hi){return (r&3)+8*(r>>2)+4*hi;}
#define SBAR() __builtin_amdgcn_sched_barrier(0)
constexpr int NSLOT=3, SLOTB=8192;
constexpr int LDS_K=0, LDS_V=NSLOT*SLOTB, LDS_WS=2*NSLOT*SLOTB, LDS_OST=LDS_WS+NW*64*4, LDS_BYTES=LDS_OST+NW*4096;
constexpr float C2=0.125f*1.4426950408889634f;
__device__ __forceinline__ void glds16(const void*gsrc,unsigned lds_dst){unsigned keep;
  asm volatile("s_mov_b32 %0, m0\n\ts_mov_b32 m0, %2\n\ts_nop 0\n\tglobal_load_lds_dwordx4 %1, off\n\ts_mov_b32 m0, %0":"=&s"(keep):"v"(gsrc),"s"(lds_dst):"memory");}
__device__ __forceinline__ void glds16_nt(const void*gsrc,unsigned lds_dst){unsigned keep;
  asm volatile("s_mov_b32 %0, m0\n\ts_mov_b32 m0, %2\n\ts_nop 0\n\tglobal_load_lds_dwordx4 %1, off nt\n\ts_mov_b32 m0, %0":"=&s"(keep):"v"(gsrc),"s"(lds_dst):"memory");}
__device__ __forceinline__ float max3f(float a,float b,float c){float r;asm("v_max3_f32 %0, %1, %2, %3":"=v"(r):"v"(a),"v"(b),"v"(c));return r;}
__device__ __forceinline__ float max2f(float a,float b){float r;asm("v_max_f32_e32 %0, %1, %2":"=v"(r):"v"(a),"v"(b));return r;}
__device__ __forceinline__ float fadd_s(float a,float b){float r;asm("v_add_f32_e32 %0, %1, %2":"=v"(r):"v"(a),"v"(b));return r;}
__device__ __forceinline__ float fsub_s(float a,float b){float r;asm("v_sub_f32_e32 %0, %1, %2":"=v"(r):"v"(a),"v"(b));return r;}
typedef float f32x2_t __attribute__((ext_vector_type(2))); typedef __bf16 bf16x2_t __attribute__((ext_vector_type(2)));
__device__ __forceinline__ unsigned cvtpk_s(float lo,float hi){f32x2_t v={lo,hi};bf16x2_t b=__builtin_convertvector(v,bf16x2_t);return __builtin_bit_cast(unsigned,b);}
#define WAIT_BAR(N) asm volatile("s_waitcnt vmcnt(" #N ") lgkmcnt(0)\n\ts_barrier":::"memory")

__device__ __forceinline__ void qkt(f32x16&p0,f32x16&p1,const char*Kslot,const bf16x8*qr,const f32x16&negm,int r32,int hi){
  const char*kb=Kslot+hi*1024+r32*16;
  #pragma unroll
  for(int d0=0;d0<4;++d0){
    const bf16x8 b0=*reinterpret_cast<const bf16x8*>(kb+d0*2048);
    const bf16x8 b1=*reinterpret_cast<const bf16x8*>(kb+d0*2048+512);
    if(d0==0){p0=__builtin_amdgcn_mfma_f32_32x32x16_bf16(b0,qr[0],negm,0,0,0);p1=__builtin_amdgcn_mfma_f32_32x32x16_bf16(b1,qr[0],negm,0,0,0);}
    else{p0=__builtin_amdgcn_mfma_f32_32x32x16_bf16(b0,qr[d0],p0,0,0,0);p1=__builtin_amdgcn_mfma_f32_32x32x16_bf16(b1,qr[d0],p1,0,0,0);}}
}
typedef __attribute__((address_space(3))) const char* lds_cptr;
typedef short v4i16_t __attribute__((ext_vector_type(4)));
__device__ __forceinline__ void kload8(bf16x8*kf,lds_cptr kp){
  kf[0]=*(const __attribute__((address_space(3))) bf16x8*)(kp);      kf[1]=*(const __attribute__((address_space(3))) bf16x8*)(kp+512);
  kf[2]=*(const __attribute__((address_space(3))) bf16x8*)(kp+2048); kf[3]=*(const __attribute__((address_space(3))) bf16x8*)(kp+2560);
  kf[4]=*(const __attribute__((address_space(3))) bf16x8*)(kp+4096); kf[5]=*(const __attribute__((address_space(3))) bf16x8*)(kp+4608);
  kf[6]=*(const __attribute__((address_space(3))) bf16x8*)(kp+6144); kf[7]=*(const __attribute__((address_space(3))) bf16x8*)(kp+6656);
}
__device__ __forceinline__ void kload2(bf16x8*kf,lds_cptr kp,int j){ kf[2*j]=*(const __attribute__((address_space(3))) bf16x8*)(kp+j*2048); kf[2*j+1]=*(const __attribute__((address_space(3))) bf16x8*)(kp+j*2048+512); }
__device__ __forceinline__ s16x4 vtr(lds_cptr p){ return __builtin_bit_cast(s16x4,__builtin_amdgcn_ds_read_tr16_b64_v4i16((__attribute__((address_space(3))) v4i16_t*)p)); }
__device__ __forceinline__ float rowmax(const f32x16&p0,const f32x16&p1){
  float a=max3f(p0[0],p0[1],p1[0]),b=max3f(p0[2],p0[3],p1[1]);a=max3f(a,p1[2],p1[3]);
  #pragma unroll
  for(int r=4;r<16;r+=4){a=max3f(a,p0[r],p0[r+1]);b=max3f(b,p0[r+2],p0[r+3]);a=max3f(a,p1[r],p1[r+1]);b=max3f(b,p1[r+2],p1[r+3]);}
  const float m=max2f(a,b);
  auto rr=__builtin_amdgcn_permlane32_swap(__float_as_uint(m),__float_as_uint(m),false,false);
  return max2f(__uint_as_float(rr[0]),__uint_as_float(rr[1]));
}
__device__ __forceinline__ void pv(f32x16*o,int vb,bf16x8 pa0,bf16x8 pa1,bf16x8 pa2,bf16x8 pa3){
  #pragma unroll
  for(int d0=0;d0<2;++d0){s16x4 lo[4],hi[4];
    #pragma unroll
    for(int ks=0;ks<4;++ks){
      asm volatile("ds_read_b64_tr_b16 %0,%1 offset:%c2":"=&v"(lo[ks]):"v"(vb),"i"(d0*4096+ks*1024):"memory");
      asm volatile("ds_read_b64_tr_b16 %0,%1 offset:%c2":"=&v"(hi[ks]):"v"(vb),"i"(d0*4096+ks*1024+512):"memory");}
    asm volatile("s_waitcnt lgkmcnt(0)":::"memory");SBAR();
    #define PK(k) (bf16x8){lo[k][0],lo[k][1],lo[k][2],lo[k][3],hi[k][0],hi[k][1],hi[k][2],hi[k][3]}
    o[d0]=__builtin_amdgcn_mfma_f32_32x32x16_bf16(pa0,PK(0),o[d0],0,0,0);
    o[d0]=__builtin_amdgcn_mfma_f32_32x32x16_bf16(pa1,PK(1),o[d0],0,0,0);
    o[d0]=__builtin_amdgcn_mfma_f32_32x32x16_bf16(pa2,PK(2),o[d0],0,0,0);
    o[d0]=__builtin_amdgcn_mfma_f32_32x32x16_bf16(pa3,PK(3),o[d0],0,0,0);
    #undef PK
  }
}

#ifndef ATTN_STORE16
#define ATTN_STORE16(p,v) (*(u32x4*)(p)=(v))
#endif
template<int THRL,bool FIX> __device__ __forceinline__ void attn_unit(int b,int h,int qb,const bf16*Q,const bf16*__restrict__ K,const bf16*__restrict__ V,bf16*O,char*shm,float sref){
  int tid_=threadIdx.x; asm volatile("":"+v"(tid_)); const int tid=tid_,lane=tid&63,r32=lane&31,hi=lane>>5; const int wid=__builtin_amdgcn_readfirstlane(tid>>6);
  const long rowbase=(long)b*SEQ, kvbase=(long)b*SKV; const int q0=qb*QB;
  const bf16*Qw=Q+(rowbase+q0+wid*QBLK)*QP+h*D;
  const bf16*Kh=K+kvbase*KP+(h/(NHEAD/NKVH))*D,*Vh=V+kvbase*KP+(h/(NHEAD/NKVH))*D;
  const unsigned lds0=(unsigned)(uintptr_t)shm;
  float*wsf=(float*)(shm+LDS_WS)+wid*64;
  const bf16*ksrc=Kh+(long)lane*KP+wid*8;
  const bf16*vsrc=Vh+(long)(16*(wid&3)+(lane>>2))*KP+(wid>>2)*32+(lane&3)*8;
  const unsigned kdst=lds0+LDS_K+wid*1024, vdst=lds0+LDS_V+wid*1024;
  #define DMA_K(t,slot) glds16(ksrc+(long)(t)*KVBLK*KP,(unsigned)__builtin_amdgcn_readfirstlane(kdst+(slot)))
  #define DMA_V(t,slot) glds16(vsrc+(long)(t)*KVBLK*KP,(unsigned)__builtin_amdgcn_readfirstlane(vdst+(slot)))
  const int vb0=(int)(lds0+LDS_V)+((lane>>4)&1)*32+(lane&3)*8+(4*hi+((lane&15)>>2))*64;
  const char*Kbase=shm+LDS_K; bf16x8 kf[8];
  const lds_cptr shm3=(lds_cptr)shm; const lds_cptr kp0=shm3+LDS_K+hi*1024+r32*16; const lds_cptr vp0=shm3+LDS_V+((lane>>4)&1)*32+(lane&3)*8+(4*hi+((lane&15)>>2))*64;
  constexpr int NT=SKV/KVBLK;
  DMA_K(0,0);DMA_V(0,0);DMA_K(1,SLOTB);
  bf16x8 qr[4];
  #pragma unroll
  for(int d0=0;d0<4;++d0)qr[d0]=__builtin_nontemporal_load(reinterpret_cast<const bf16x8*>(&Qw[(long)r32*QP+d0*16+hi*8]));
  float mhat=0.f,l_reg=0.f;f32x16 o[2];o[0]=f32x16{};o[1]=f32x16{};f32x16 negm=f32x16{};
  if constexpr(FIX){ _Pragma("unroll") for(int r=0;r<16;++r)negm[r]=-sref; }
  asm volatile("":"+v"(negm));
  #define CMASK(P0,P1,t) do{}while(0)
  bool resc=false;
  #define START(P0,P1) do{ resc=false; if constexpr(!FIX) \
    { const float rm=rowmax(P0,P1); const float dl=rm; mhat=fadd_s(mhat,dl); \
      _Pragma("unroll") for(int r=0;r<16;++r){P0[r]=fsub_s(P0[r],dl);P1[r]=fsub_s(P1[r],dl);} \
      _Pragma("unroll") for(int r=0;r<16;++r)negm[r]=-mhat; asm volatile("":"+v"(negm)); } \
    _Pragma("unroll") for(int r=0;r<16;++r)P0[r]=__builtin_amdgcn_exp2f(P0[r]); }while(0)
  #define RESC() do{ if constexpr(!FIX) if(resc){ asm volatile("s_waitcnt lgkmcnt(0)":::"memory"); \
      _Pragma("unroll") for(int d_=0;d_<2;++d_) _Pragma("unroll") for(int r=0;r<16;++r)o[d_][r]*=wsf[crow(r,hi)]; } }while(0)
  f32x16 pA0,pA1,pB0,pB1;
  int sl_prev=0,sl_cur=0,sl_next=SLOTB;
  #define ROT() do{sl_prev=sl_cur;sl_cur=sl_next;sl_next=(sl_next==(NSLOT-1)*SLOTB)?0:sl_next+SLOTB;}while(0)
  DMA_K(2,2*SLOTB);
  WAIT_BAR(3);
  qkt(pA0,pA1,Kbase,qr,negm,r32,hi);asm volatile("s_nop 15\n\ts_nop 7":"+v"(pA0),"+v"(pA1));CMASK(pA0,pA1,0);
  START(pA0,pA1);
  _Pragma("unroll") for(int r=0;r<16;++r)pA1[r]=__builtin_amdgcn_exp2f(pA1[r]);
  WAIT_BAR(0);
  DMA_K(3,0);DMA_V(1,SLOTB);
  ROT();
  kload8(kf,kp0+sl_cur);
  WAIT_BAR(2);
  s16x4 vlo[8],vhi[8]; u32x4 pw0,pw1,pw2,pw3;
  #define PKW(P,B) cvtpk_s(P[B],P[B+1])
  #define PAF(k) __builtin_bit_cast(bf16x8,pw##k)
  #define VFR(i) (bf16x8){vlo[i][0],vlo[i][1],vlo[i][2],vlo[i][3],vhi[i][0],vhi[i][1],vhi[i][2],vhi[i][3]}
  #define PIN(x) asm volatile("":"+v"(x))
  #define MX3(a,b,c) __builtin_fmaxf(__builtin_fmaxf((a),(b)),(c))
  #define GAPA(MF,A0,A1,A2,A3,W0,W1,PW) do{ MF; sacc+=A0; sacc+=A1; sacc+=A2; sacc+=A3; PIN(sacc); W0; W1; PIN(PW); SBAR(); }while(0)
  #define EX(v) __builtin_amdgcn_exp2f(v)
  #define GAPB(MF,X,B) do{ MF; X[B]=EX(X[B]); X[B+1]=EX(X[B+1]); X[B+2]=EX(X[B+2]); X[B+3]=EX(X[B+3]); PIN(X); SBAR(); }while(0)
  #define VRD(i) do{ vlo[i]=vtr(vp_+(((i)>>2)*4096+((i)&3)*1024)); vhi[i]=vtr(vp_+(((i)>>2)*4096+((i)&3)*1024+512)); }while(0)
  #define KRD(G,j) do{ if(G){ kload2(kf,kp0+sl_next,j); SBAR(); } }while(0)
  #define STEP(C0,C1,P0,P1,t,GK,GV,GL) do{ SBAR(); \
    const lds_cptr vp_=vp0+sl_prev; \
    VRD(0); SBAR(); float sacc=(P0[0]+P0[1]); \
    GAPA(C0=__builtin_amdgcn_mfma_f32_32x32x16_bf16(kf[0],qr[0],negm,0,0,0), P0[2],P0[3],P0[4],P0[5],     pw0[0]=PKW(P0,0), pw0[1]=PKW(P0,2), pw0); \
    VRD(4); SBAR(); GAPA(C1=__builtin_amdgcn_mfma_f32_32x32x16_bf16(kf[1],qr[0],negm,0,0,0), P0[6],P0[7],P0[8],P0[9],     pw0[2]=PKW(P0,4), pw0[3]=PKW(P0,6), pw0); \
    VRD(1); SBAR(); GAPA(C0=__builtin_amdgcn_mfma_f32_32x32x16_bf16(kf[2],qr[1],C0,0,0,0),   P0[10],P0[11],P0[12],P0[13], pw1[0]=PKW(P0,8), pw1[1]=PKW(P0,10), pw1); \
    VRD(5); SBAR(); GAPA(C1=__builtin_amdgcn_mfma_f32_32x32x16_bf16(kf[3],qr[1],C1,0,0,0),   P0[14],P0[15],P1[0],P1[1],   pw1[2]=PKW(P0,12),pw1[3]=PKW(P0,14), pw1); \
    VRD(2); SBAR(); GAPA(C0=__builtin_amdgcn_mfma_f32_32x32x16_bf16(kf[4],qr[2],C0,0,0,0),   P1[2],P1[3],P1[4],P1[5],     pw2[0]=PKW(P1,0), pw2[1]=PKW(P1,2), pw2); \
    VRD(6); SBAR(); GAPA(C1=__builtin_amdgcn_mfma_f32_32x32x16_bf16(kf[5],qr[2],C1,0,0,0),   P1[6],P1[7],P1[8],P1[9],     pw2[2]=PKW(P1,4), pw2[3]=PKW(P1,6), pw2); \
    VRD(3); SBAR(); GAPA(C0=__builtin_amdgcn_mfma_f32_32x32x16_bf16(kf[6],qr[3],C0,0,0,0),   P1[10],P1[11],P1[12],P1[13], pw3[0]=PKW(P1,8), pw3[1]=PKW(P1,10), pw3); \
    VRD(7); SBAR(); GAPA(C1=__builtin_amdgcn_mfma_f32_32x32x16_bf16(kf[7],qr[3],C1,0,0,0),   P1[14],P1[15],0.f,0.f,       pw3[2]=PKW(P1,12),pw3[3]=PKW(P1,14), pw3); \
    l_reg+=sacc; \
    if(GK){DMA_K((t)+3,sl_cur);} if(GV){DMA_V((t)+1,sl_next);} \
    CMASK(C0,C1,t); \
    if constexpr(!FIX) { float a=MX3(C0[0],C0[1],C1[0]),b=MX3(C0[2],C0[3],C1[1]); a=MX3(a,C1[2],C1[3]); \
      _Pragma("unroll") for(int r=4;r<16;r+=4){a=MX3(a,C0[r],C0[r+1]);b=MX3(b,C0[r+2],C0[r+3]);a=MX3(a,C1[r],C1[r+1]);b=MX3(b,C1[r+2],C1[r+3]);} \
      float rm=__builtin_fmaxf(a,b); { auto rr=__builtin_amdgcn_permlane32_swap(__float_as_uint(rm),__float_as_uint(rm),false,false); rm=__builtin_fmaxf(__uint_as_float(rr[0]),__uint_as_float(rr[1])); } \
      resc=false; \
      if(__builtin_expect(__any(rm>(float)THRL),0)){ const float dl=__builtin_fmaxf(rm,0.f); mhat+=dl; \
        _Pragma("unroll") for(int r=0;r<16;++r){C0[r]-=dl;C1[r]-=dl;} \
        _Pragma("unroll") for(int r=0;r<16;++r)negm[r]=-mhat; asm volatile("":"+v"(negm)); \
        const float f=__builtin_amdgcn_exp2f(-dl); l_reg*=f; if(hi==0)wsf[r32]=f; resc=true; } } \
    SBAR(); \
    GAPB(o[0]=__builtin_amdgcn_mfma_f32_32x32x16_bf16(PAF(0),VFR(0),o[0],0,0,0), C0,0); \
    GAPB(o[1]=__builtin_amdgcn_mfma_f32_32x32x16_bf16(PAF(0),VFR(4),o[1],0,0,0), C0,4); \
    KRD(GL,0); GAPB(o[0]=__builtin_amdgcn_mfma_f32_32x32x16_bf16(PAF(1),VFR(1),o[0],0,0,0), C0,8); \
    KRD(GL,1); GAPB(o[1]=__builtin_amdgcn_mfma_f32_32x32x16_bf16(PAF(1),VFR(5),o[1],0,0,0), C0,12); \
    KRD(GL,2); GAPB(o[0]=__builtin_amdgcn_mfma_f32_32x32x16_bf16(PAF(2),VFR(2),o[0],0,0,0), C1,0); \
    KRD(GL,3); GAPB(o[1]=__builtin_amdgcn_mfma_f32_32x32x16_bf16(PAF(2),VFR(6),o[1],0,0,0), C1,4); \
    GAPB(o[0]=__builtin_amdgcn_mfma_f32_32x32x16_bf16(PAF(3),VFR(3),o[0],0,0,0), C1,8); \
    GAPB(o[1]=__builtin_amdgcn_mfma_f32_32x32x16_bf16(PAF(3),VFR(7),o[1],0,0,0), C1,12); \
    }while(0)
  int t=1;
  #undef CMASK
  #define CMASK(P0,P1,t) do{}while(0)
  for(;t+5<NT;t+=2){
    STEP(pB0,pB1,pA0,pA1,t,true,true,true);     WAIT_BAR(2); RESC(); ROT();
    STEP(pA0,pA1,pB0,pB1,t+1,true,true,true);   WAIT_BAR(2); RESC(); ROT();
  }
  #undef CMASK
  #define CMASK(P0,P1,t) do{}while(0)
  #define ENDW(tt) do{ if((tt)+3<NT){WAIT_BAR(2);} else if((tt)+2<NT){WAIT_BAR(1);} else {WAIT_BAR(0);} }while(0)
  for(;t+1<NT;t+=2){
    STEP(pB0,pB1,pA0,pA1,t,(t+3<NT),(t+1<NT),(t+1<NT));       ENDW(t);   RESC(); ROT();
    STEP(pA0,pA1,pB0,pB1,t+1,(t+4<NT),(t+2<NT),(t+2<NT));     ENDW(t+1); RESC(); ROT();
  }
  STEP(pB0,pB1,pA0,pA1,NT-1,false,false,false); RESC();
  { float sacc=pB0[0]+pB0[1]; _Pragma("unroll") for(int r=2;r<16;++r)sacc+=pB0[r]; _Pragma("unroll") for(int r=0;r<16;++r)sacc+=pB1[r]; l_reg+=sacc;
    pw0=(u32x4){PKW(pB0,0),PKW(pB0,2),PKW(pB0,4),PKW(pB0,6)};pw1=(u32x4){PKW(pB0,8),PKW(pB0,10),PKW(pB0,12),PKW(pB0,14)};pw2=(u32x4){PKW(pB1,0),PKW(pB1,2),PKW(pB1,4),PKW(pB1,6)};pw3=(u32x4){PKW(pB1,8),PKW(pB1,10),PKW(pB1,12),PKW(pB1,14)};
    SBAR(); pv(o,vb0+sl_cur,PAF(0),PAF(1),PAF(2),PAF(3)); }
  #undef PKW
  #undef PAF
  #undef VFR
  #undef PIN
  #undef MX3
  #undef GAPA
  #undef GAPB
  #undef EX
  #undef VRD
  #undef KRD
  #undef STEP
  #undef ENDW
  {auto rr=__builtin_amdgcn_permlane32_swap(__float_as_uint(l_reg),__float_as_uint(l_reg),false,false);l_reg=__uint_as_float(rr[0])+__uint_as_float(rr[1]);}
  if(hi==0)wsf[32+r32]=l_reg;asm volatile("s_waitcnt lgkmcnt(0)":::"memory");
  float rli[16];
  #pragma unroll
  for(int r=0;r<16;++r)rli[r]=__builtin_amdgcn_rcpf(wsf[32+crow(r,hi)]);
  bf16*Ow=O+(rowbase+q0+wid*QBLK)*OP+h*D;
  { bf16*stg=(bf16*)(shm+LDS_OST)+wid*2048;
    #pragma unroll
    for(int r=0;r<16;++r){const int orow=crow(r,hi);
      #pragma unroll
      for(int d0=0;d0<2;++d0)stg[orow*64+d0*32+r32]=__float2bfloat16(o[d0][r]*rli[r]);}
    asm volatile("s_waitcnt lgkmcnt(0)":::"memory");
    #pragma unroll
    for(int i=0;i<4;++i){const int row=i*8+(lane>>3),ch=lane&7; const u32x4 v=*(const u32x4*)(stg+row*64+ch*8); ATTN_STORE16(Ow+(long)row*OP+ch*8,v);} }
  asm volatile("s_waitcnt lgkmcnt(0)\n\ts_barrier":::"memory");
  #undef DMA_K
  #undef DMA_V
  #undef CMASK
  #undef START
  #undef RESC
  #undef ROT
}
constexpr int ATTN_LDS_BYTES=LDS_BYTES;
struct AttnTensors { const bf16* Q; const bf16* K; const bf16* V; bf16* O; };
struct AttnUnit { int bh; int qb; };
struct StaticOrder {
  int vcu,G;
  __device__ __forceinline__ explicit StaticOrder(int grid,int v):vcu(v),G(grid){}
  __device__ __forceinline__ bool next(int i,AttnUnit&u)const{ const int per=(BATCH*NHEAD*NQB)/G; if(i>=per)return false; const int x=vcu*per+i; u.bh=(x>>6)*4+((x&63)>>4); u.qb=x&15; return true; }
  __device__ __forceinline__ void a_ready(const AttnUnit&)const{}
  __device__ __forceinline__ void done(const AttnUnit&)const{}
};
template<class Sched,int THRL=8> __device__ __forceinline__ void attn_phase(char*lds,const AttnTensors&T,const Sched&S,const float*qnw,const float*knw){
  AttnUnit u;
  float mq=__builtin_fabsf(qnw[threadIdx.x&63]),mk=__builtin_fabsf(knw[threadIdx.x&63]);
  _Pragma("unroll") for(int o_=1;o_<64;o_<<=1){ mq=__builtin_fmaxf(mq,__shfl_xor(mq,o_)); mk=__builtin_fmaxf(mk,__shfl_xor(mk,o_)); }
  const float sref=C2*64.0f*1.02f*mq*mk;
  const bool fix=__builtin_amdgcn_readfirstlane((int)(sref<=40.0f && sref==sref))!=0;
  if(fix){ for(int i=0;S.next(i,u);++i){ S.a_ready(u); attn_unit<THRL,true>(u.bh/NHEAD,u.bh%NHEAD,u.qb,T.Q,T.K,T.V,T.O,lds,sref); S.done(u); } }
  else   { for(int i=0;S.next(i,u);++i){ S.a_ready(u); attn_unit<THRL,false>(u.bh/NHEAD,u.bh%NHEAD,u.qb,T.Q,T.K,T.V,T.O,lds,0.f); S.done(u); } }
}
#undef SBAR
#undef WAIT_BAR
}
#ifndef PG8_SP2
#define PG8_SP2 true
#endif
#ifndef PG8_ALIGN
#define PG8_ALIGN true
#endif
#define GAS __attribute__((address_space(1)))
#define LAS __attribute__((address_space(3)))
typedef unsigned short bf16;
typedef unsigned v4u __attribute__((ext_vector_type(4)));
typedef unsigned v2u __attribute__((ext_vector_type(2)));
typedef float f32x4 __attribute__((ext_vector_type(4)));
typedef float f32x2 __attribute__((ext_vector_type(2)));
typedef short bf16x8 __attribute__((ext_vector_type(8)));
typedef GAS unsigned gu32;
typedef GAS unsigned long long gu64;
#define RLX_AGENT __ATOMIC_RELAXED, __HIP_MEMORY_SCOPE_AGENT
#define LDS_WAIT() asm volatile("s_waitcnt lgkmcnt(0)" ::: "memory")
#define VM_WAIT() asm volatile("s_waitcnt vmcnt(0)" ::: "memory")
__device__ __forceinline__ unsigned f2bf(float f) { unsigned u = __builtin_bit_cast(unsigned, f); return (u + 0x7fffu + ((u >> 16) & 1u)) >> 16; }
__device__ __forceinline__ unsigned pk2(float lo, float hi) { unsigned r; asm("v_cvt_pk_bf16_f32 %0, %1, %2" : "=v"(r) : "v"(lo), "v"(hi)); return r; }
__device__ __forceinline__ float bf2f(unsigned h) { return __builtin_bit_cast(float, h << 16); }

#define XB_TMO      128
#define XB_XCNT(j)  (256  + 64 * (j))
#define XB_XSUB(j)  (1280 + 64 * (j))
#define XB_XGEN(j)  (2304 + 64 * (j))
#define XB_TOP      3328
#define XB_TOPGEN   3392
#define XCD_BAR_WORDS 3456
#define XB_SPIN_CAP (1u << 18)

__device__ __forceinline__ unsigned xb_ld(unsigned* p)              { return __hip_atomic_load(p, __ATOMIC_RELAXED, __HIP_MEMORY_SCOPE_AGENT); }
__device__ __forceinline__ unsigned xb_add(unsigned* p, unsigned v) { return __hip_atomic_fetch_add(p, v, __ATOMIC_RELAXED, __HIP_MEMORY_SCOPE_AGENT); }
__device__ __forceinline__ unsigned xb_xcc_id() { return (unsigned)__builtin_amdgcn_s_getreg((3 << 11) | 20) & 0xFu; }
#define XB_SPIN(cond, bar) do { unsigned _sp = 0; while (cond) { __builtin_amdgcn_s_sleep(1); \
    if ((++_sp & 255u) == 0u) { if (xb_ld(&(bar)[XB_TMO])) break; if (_sp > XB_SPIN_CAP) { atomicAdd(&(bar)[XB_TMO], 1u); break; } } } } while (0)

struct XcdBarrier {
    unsigned* bar; unsigned x;
    volatile LAS unsigned* st;
};

__device__ __forceinline__ XcdBarrier xcd_barrier_post(unsigned* bar, volatile LAS unsigned* st) {
    XcdBarrier b; b.bar = bar; b.x = xb_xcc_id(); b.st = st;
    if (threadIdx.x == 0) (void)xb_add(&bar[XB_XCNT(b.x)], 1u);
    return b;
}
__device__ __forceinline__ void xcd_barrier_complete(unsigned* bar, unsigned x, unsigned& nloc, unsigned& nx) {
    const unsigned G = gridDim.x * gridDim.y * gridDim.z;
    unsigned sum, cnt, mine, sp = 0u;
    for (;;) {
        sum = 0u; cnt = 0u; mine = 0u;
#pragma unroll
        for (unsigned j = 0; j < 16; ++j) { const unsigned c = xb_ld(&bar[XB_XCNT(j)]); sum += c; cnt += (c > 0u) ? 1u : 0u; mine = (j == x) ? c : mine; }
        if (sum == G) break;
        __builtin_amdgcn_s_sleep(1);
        if ((++sp & 255u) == 0u) { if (xb_ld(&bar[XB_TMO])) break; if (sp > XB_SPIN_CAP) { atomicAdd(&bar[XB_TMO], 1u); break; } }
    }
    nloc = mine > 0u ? mine : 1u; nx = cnt > 0u ? cnt : 1u;
}

__device__ __forceinline__ void xcd_barrier(const XcdBarrier& b) {
    asm volatile("s_waitcnt vmcnt(0)" ::: "memory");
    __syncthreads();
    if (threadIdx.x == 0) {
        unsigned* bar = b.bar;
        __builtin_amdgcn_s_waitcnt(0);
        unsigned nloc = b.st[0], nx = b.st[1];
        if (nloc == 0u) { xcd_barrier_complete(bar, b.x, nloc, nx); b.st[0] = nloc; b.st[1] = nx; }
        const unsigned old = xb_add(&bar[XB_XSUB(b.x)], 1u);
        const unsigned gen = old / nloc;
        if (old + 1u == (gen + 1u) * nloc) {
            __builtin_amdgcn_fence(__ATOMIC_RELEASE, "agent");
            asm volatile("s_waitcnt vmcnt(0)" ::: "memory");
            const unsigned og = xb_add(&bar[XB_TOP], 1u);
            const unsigned tg = og / nx;
            if (og + 1u == (tg + 1u) * nx) xb_add(&bar[XB_TOPGEN], 1u);
            else XB_SPIN(xb_ld(&bar[XB_TOPGEN]) == tg, bar);
            __builtin_amdgcn_fence(__ATOMIC_ACQUIRE, "agent");
            xb_add(&bar[XB_XGEN(b.x)], 1u);
            asm volatile("s_waitcnt vmcnt(0)" ::: "memory");
        } else {
            XB_SPIN(xb_ld(&bar[XB_XGEN(b.x)]) == gen, bar);
            __builtin_amdgcn_fence(__ATOMIC_ACQUIRE, "agent");
            asm volatile("s_waitcnt vmcnt(0)" ::: "memory");
        }
    }
    __syncthreads();
}
struct Frame {
    LAS unsigned char* lds;
    volatile LAS unsigned* MISC;
    gu32* ctl;
    int tid, lane, wave;
    int vcu, G;
};
__device__ __forceinline__ float wave_sum(float v) { return wave_sum64(v); }
__device__ __forceinline__ void p0_transpose_item(const float* W, int ldw, int k0, int n0, bf16* WT, int ldt, int dst_row0, LAS float* scr, int lane) {
#pragma unroll 8
    for (int i = 0; i < 32; ++i) { const int kk = 2 * i + (lane >> 5); scr[kk * 33 + (lane & 31)] = __builtin_nontemporal_load(W + (size_t)(k0 + kk) * ldw + n0 + (lane & 31)); }
    LDS_WAIT(); asm volatile("" ::: "memory");
    const int c = lane & 7;
#pragma unroll
    for (int j = 0; j < 4; ++j) { const int n = (lane >> 3) + 8 * j; const LAS float* s = scr + (8 * c) * 33 + n;
        v4u o; o.x = pk2(s[0 * 33], s[1 * 33]); o.y = pk2(s[2 * 33], s[3 * 33]); o.z = pk2(s[4 * 33], s[5 * 33]); o.w = pk2(s[6 * 33], s[7 * 33]);
        *(GAS v4u*)(WT + (size_t)(dst_row0 + n) * ldt + k0 + 8 * c) = o; }
    LDS_WAIT(); asm volatile("" ::: "memory");
}
constexpr int P0_I_IN = 16 * 56, P0_I_OUT = 16 * 32, P0_I_13 = 16 * 88, P0_I_2 = 44 * 32, P0_I_P = 4 * 8;
constexpr int P0_ITEMS_EARLY = P0_I_IN + P0_I_OUT + 4 * P0_I_P + 2 * P0_I_13 + P0_I_2, P0_ITEMS_ALL = P0_ITEMS_EARLY + 2 * P0_I_13 + P0_I_2;
__device__ __forceinline__ void p0_items(Frame& F, ArgsP ap, int it_lo, int it_hi, int gw, int NGW) {
    unsigned char* ws = ap->ws;
    LAS float* scr = (LAS float*)(F.lds + RING_OFF + F.wave * 16384);
    for (int it = it_lo + gw; it < it_hi; it += NGW) {
        int r = it;
        if (r < P0_I_IN) { const int kb = r / 56, nb = r % 56, f = 32 * nb, slot = f >> 6, bj = (f >> 5) & 1, pn = slot >> 2, wc = slot & 3;
            p0_transpose_item(ap->in[I_WIN], INW, 64 * kb, f, (bf16*)(ws + WS_WIN), DM, 256 * pn + 128 * bj + 32 * wc, scr, F.lane); continue; } r -= P0_I_IN;
        if (r < P0_I_OUT) { const int kb = r / 32, nb = r % 32; p0_transpose_item(ap->in[I_WOUT], DM, 64 * kb, 32 * nb, (bf16*)(ws + WS_WOUT), DM, 32 * nb, scr, F.lane); continue; } r -= P0_I_OUT;
        if (r < 4 * P0_I_P) { const int g = r / P0_I_P, rr = r % P0_I_P, kb = rr / 8, nb = rr % 8;
            p0_transpose_item(ap->in[I_WPOOL] + (size_t)g * 256 * 256, 256, 64 * kb, 32 * nb, (bf16*)(ws + WS_WPOOL), 256, g * 256 + 32 * nb, scr, F.lane); continue; } r -= 4 * P0_I_P;
        const int l = r >= 2 * P0_I_13 + P0_I_2 ? 1 : 0; r -= l * (2 * P0_I_13 + P0_I_2);
        if (r < 2 * P0_I_13) { const int which = r / P0_I_13, rr = r % P0_I_13, kb = rr / 88, nb = rr % 88, n0 = 32 * nb;
            const float* W = ap->in[which ? I_W3 : I_W1] + (size_t)l * DM * FF;
            p0_transpose_item(W, FF, 64 * kb, n0, (bf16*)(ws + WS_W13) + (size_t)l * 5632 * DM, DM, 256 * (n0 >> 7) + 128 * which + (n0 & 127), scr, F.lane); continue; } r -= 2 * P0_I_13;
        { const int kb = r / 32, nb = r % 32;
            p0_transpose_item(ap->in[I_W2] + (size_t)l * FF * DM, DM, 64 * kb, 32 * nb, (bf16*)(ws + WS_W2) + (size_t)l * DM * FF, FF, 32 * nb, scr, F.lane); }
    }
}
__device__ __forceinline__ void p0_prologue(Frame& F, ArgsP ap) {
    unsigned char* ws = ap->ws;
    if (F.vcu < 192) {
        LAS float* sc = (LAS float*)(F.lds + RING_OFF); LAS float* part = sc + 9 * 1024;
        const float* c = ap->in[I_C]; const float* cctx = ap->in[I_CCTX];
        for (int i = F.tid; i < 9 * 1024; i += NWAVES * 64) { const int bb = i >> 10, k = i & 1023; const float v = bb < 8 ? c[bb * 1024 + k] : cctx[k]; sc[i] = v / (1.0f + expf(-v)); }
        __syncthreads();
        const int l = F.vcu / 96, cb = F.vcu % 96, k0 = F.wave * 128;
        const float* w = ap->in[I_WADA] + (size_t)l * DM * MODW + (size_t)k0 * MODW + cb * 64 + F.lane;
        float acc[9];
#pragma unroll
        for (int j = 0; j < 9; ++j) acc[j] = 0.f;
        for (int k = 0; k < 128; k += 8) {
            float wv[8];
#pragma unroll
            for (int q = 0; q < 8; ++q) wv[q] = __builtin_nontemporal_load(w + (size_t)(k + q) * MODW);
#pragma unroll
            for (int j = 0; j < 9; ++j) { const f32x4 s0 = *(const LAS f32x4*)(sc + j * 1024 + k0 + k), s1 = *(const LAS f32x4*)(sc + j * 1024 + k0 + k + 4);
                acc[j] += (s0[0] * wv[0] + s0[1] * wv[1]) + (s0[2] * wv[2] + s0[3] * wv[3]) + (s1[0] * wv[4] + s1[1] * wv[5]) + (s1[2] * wv[6] + s1[3] * wv[7]); }
        }
#pragma unroll
        for (int j = 0; j < 9; ++j) part[(F.wave * 9 + j) * 64 + F.lane] = acc[j];
        __syncthreads();
        float* mods = (float*)(ws + WS_MODS);
        for (int idx = F.tid; idx < 9 * 64; idx += NWAVES * 64) { const int j = idx >> 6, col = idx & 63; float s = 0.f;
#pragma unroll
            for (int wv_ = 0; wv_ < 8; ++wv_) s += part[(wv_ * 9 + j) * 64 + col];
            mods[(size_t)(l * 9 + j) * MODW + cb * 64 + col] = s + ap->in[I_BADA][l * MODW + cb * 64 + col]; }
        __syncthreads();
    } else if (F.vcu == F.G - 1) {
        float* rc = (float*)(ws + WS_ROPE); float* rs = rc + 1024;
        for (int e = F.tid; e < 1024; e += NWAVES * 64) { const int pos = e >> 4, i = e & 15; const float fr = powf(10000.0f, -(float)(2 * i) / 32.0f); const float a = (float)pos * fr; rc[e] = cosf(a); rs[e] = sinf(a); }
    }
    p0_items(F, ap, 0, P0_ITEMS_EARLY, F.vcu * NWAVES + F.wave, F.G * NWAVES);
    { const float* wsp = ap->in[I_WSP]; bf16* dst = (bf16*)(ws + WS_WSB);
        for (int e = (F.vcu * NWAVES * 64 + F.tid) * 4; e < 8 * 128 * 128; e += F.G * NWAVES * 64 * 4) { const f32x4 v = *(const f32x4*)(wsp + e); v2u o; o.x = pk2(v[0], v[1]); o.y = pk2(v[2], v[3]); *(v2u*)(dst + e) = o; } }
}
__device__ __forceinline__ void p1_bias13(Frame& F, ArgsP ap) {
    if (F.vcu >= 176) return;
    const int l = F.vcu / 88, rem = F.vcu % 88, which = rem / 44, cb = rem % 44, k0 = F.wave * 128;
    LAS float* shs = (LAS float*)(F.lds + RING_OFF); LAS float* part = shs + 8 * 1024;
    const float* mods = (const float*)(ap->ws + WS_MODS);
    for (int i = F.tid; i < 8 * 1024; i += NWAVES * 64) { const int b = i >> 10, k = i & 1023; shs[i] = mods[(size_t)(l * 9 + b) * MODW + SH2 + k]; }
    __syncthreads();
    const float* w = ap->in[which ? I_W3 : I_W1] + (size_t)l * DM * FF + (size_t)k0 * FF + cb * 64 + F.lane;
    float acc[8];
#pragma unroll
    for (int j = 0; j < 8; ++j) acc[j] = 0.f;
    for (int k = 0; k < 128; k += 8) {
        float wv[8];
#pragma unroll
        for (int q = 0; q < 8; ++q) wv[q] = __builtin_nontemporal_load(w + (size_t)(k + q) * FF);
#pragma unroll
        for (int j = 0; j < 8; ++j) { const f32x4 s0 = *(const LAS f32x4*)(shs + j * 1024 + k0 + k), s1 = *(const LAS f32x4*)(shs + j * 1024 + k0 + k + 4);
            acc[j] += (s0[0] * wv[0] + s0[1] * wv[1]) + (s0[2] * wv[2] + s0[3] * wv[3]) + (s1[0] * wv[4] + s1[1] * wv[5]) + (s1[2] * wv[6] + s1[3] * wv[7]); }
    }
#pragma unroll
    for (int j = 0; j < 8; ++j) part[(F.wave * 8 + j) * 64 + F.lane] = acc[j];
    __syncthreads();
    float* bias = (float*)(ap->ws + WS_BIAS);
    for (int idx = F.tid; idx < 8 * 64; idx += NWAVES * 64) { const int j = idx >> 6, col = idx & 63, n = cb * 64 + col; float sum = 0.f;
#pragma unroll
        for (int wv_ = 0; wv_ < 8; ++wv_) sum += part[(wv_ * 8 + j) * 64 + col];
        bias[(size_t)(l * 8 + j) * 5632 + 256 * (n >> 7) + 128 * which + (n & 127)] = sum; }
    __syncthreads();
}
__device__ __forceinline__ void p1_biasin(Frame& F, ArgsP ap) {
    if (F.vcu < 176 || F.vcu >= 176 + INW / 64) return;
    const int cb = F.vcu - 176, k0 = F.wave * 128;
    LAS float* shs = (LAS float*)(F.lds + RING_OFF); LAS float* part = shs + 9 * 1024;
    const float* mods = (const float*)(ap->ws + WS_MODS);
    for (int i = F.tid; i < 9 * 1024; i += NWAVES * 64) { const int b = i >> 10, k = i & 1023; shs[i] = mods[(size_t)b * MODW + SH1 + k]; }
    __syncthreads();
    const float* w = ap->in[I_WIN] + (size_t)k0 * INW + cb * 64 + F.lane;
    float acc[9];
#pragma unroll
    for (int j = 0; j < 9; ++j) acc[j] = 0.f;
    for (int k = 0; k < 128; k += 8) {
        float wv[8];
#pragma unroll
        for (int q = 0; q < 8; ++q) wv[q] = w[(size_t)(k + q) * INW];
#pragma unroll
        for (int j = 0; j < 9; ++j) { const f32x4 s0 = *(const LAS f32x4*)(shs + j * 1024 + k0 + k), s1 = *(const LAS f32x4*)(shs + j * 1024 + k0 + k + 4);
            acc[j] += (s0[0] * wv[0] + s0[1] * wv[1]) + (s0[2] * wv[2] + s0[3] * wv[3]) + (s1[0] * wv[4] + s1[1] * wv[5]) + (s1[2] * wv[6] + s1[3] * wv[7]); }
    }
#pragma unroll
    for (int j = 0; j < 9; ++j) part[(F.wave * 9 + j) * 64 + F.lane] = acc[j];
    __syncthreads();
    float* bias = (float*)(ap->ws + WS_BIASIN);
    for (int idx = F.tid; idx < 9 * 64; idx += NWAVES * 64) { const int j = idx >> 6, col = idx & 63; float sum = 0.f;
#pragma unroll
        for (int wv_ = 0; wv_ < 8; ++wv_) sum += part[(wv_ * 9 + j) * 64 + col];
        bias[(size_t)j * INW + cb * 64 + col] = sum; }
    __syncthreads();
}
__device__ __forceinline__ void p1_flag(Frame& F, ArgsP ap) {
    if (F.vcu != F.G - 1) return;
    const float* mods = (const float*)(ap->ws + WS_MODS); const float* g = ap->in[I_GFFN];
    int bad = 0;
    for (int i = F.tid; i < 3 * 8 * 1024; i += NWAVES * 64) { const int l = i >> 13, b = (i >> 10) & 7, k = i & 1023;
        const float m = l < 2 ? fabsf(g[l * DM + k] * (mods[(size_t)(l * 9 + b) * MODW + SC2 + k] + 1.0f)) : fabsf(ap->in[I_GMIX][k] * (mods[(size_t)b * MODW + SC1 + k] + 1.0f)); bad |= (!(m >= 1e-12f) || !(m <= 1e12f)) ? 1 : 0; }
    const int any = __syncthreads_or(bad);
    if (F.tid == 0) *(int*)(ap->ws + WS_FLAG) = any ? 0 : 1;
}
__device__ __forceinline__ void p1_poolw(Frame& F, ArgsP ap) {
    unsigned char* ws = ap->ws; const bf16* src = (const bf16*)(ws + WS_WPOOL); bf16* dst = (bf16*)(ws + WS_WPB);
    const float* gm = ap->in[I_GMIX] + DM; const float* mod1 = (const float*)(ws + WS_MODS) + (size_t)9 * MODW;
    for (int e = (F.vcu * NWAVES * 64 + F.tid) * 8; e < 8 * 1024 * 256; e += F.G * NWAVES * 64 * 8) {
        const int b = e >> 18, n = (e >> 8) & 1023, k = e & 255, gk = (n & ~255) + k;
        const v4u w = *(const v4u*)(src + (size_t)n * 256 + k); const f32x4 g0 = *(const f32x4*)(gm + gk), g1 = *(const f32x4*)(gm + gk + 4);
        const f32x4 s0 = *(const f32x4*)(mod1 + (size_t)b * MODW + SC1 + gk), s1 = *(const f32x4*)(mod1 + (size_t)b * MODW + SC1 + gk + 4);
        const f32x4 m0 = g0 * (s0 + 1.0f), m1 = g1 * (s1 + 1.0f);
        v4u o; o.x = pk2(bf2f(w.x & 0xffffu) * m0[0], bf2f(w.x >> 16) * m0[1]); o.y = pk2(bf2f(w.y & 0xffffu) * m0[2], bf2f(w.y >> 16) * m0[3]);
        o.z = pk2(bf2f(w.z & 0xffffu) * m1[0], bf2f(w.z >> 16) * m1[1]); o.w = pk2(bf2f(w.w & 0xffffu) * m1[2], bf2f(w.w >> 16) * m1[3]);
        *(v4u*)(dst + e) = o; }
}
__device__ __forceinline__ void norm_pass(Frame& F, const float* src_lat, const float* src_ctx, bf16* dst, float* rin, const float* gvec, const float* modl, int sc_off) {
    const int total = src_ctx ? MALL : MTOK, gw = F.vcu * NWAVES + F.wave, NGW = F.G * NWAVES, rpw = (total + NGW - 1) / NGW;
    const int r0 = gw * rpw, r1 = (r0 + rpw < total) ? r0 + rpw : total;
    int cur = -1; f32x4 gm[4];
    for (int row = r0; row < r1; ++row) {
        const int bb = row < MTOK ? (row >> 12) : 8;
        if (bb != cur) { cur = bb;
#pragma unroll
            for (int j = 0; j < 4; ++j) { const int c = 4 * F.lane + 256 * j; const f32x4 g = *(const f32x4*)(gvec + c), s = *(const f32x4*)(modl + (size_t)bb * MODW + sc_off + c);
                gm[j] = g * (s + 1.0f); } }
        const float* xr = row < MTOK ? src_lat + (size_t)row * DM : src_ctx + (size_t)(row - MTOK) * DM;
        f32x4 v[4]; float ss = 0.f;
#pragma unroll
        for (int j = 0; j < 4; ++j) { v[j] = __builtin_nontemporal_load((const f32x4*)(xr + 4 * F.lane + 256 * j)); ss += (v[j][0] * v[j][0] + v[j][1] * v[j][1]) + (v[j][2] * v[j][2] + v[j][3] * v[j][3]); }
        const float r = __builtin_amdgcn_rsqf(wave_sum(ss) * (1.0f / DM) + 1e-6f);
        if (F.lane == 0) rin[row] = r;
        bf16* orow = dst + (size_t)row * DM;
#pragma unroll
        for (int j = 0; j < 4; ++j) { const f32x4 o = v[j] * gm[j]; v2u w; w.x = pk2(o[0], o[1]); w.y = pk2(o[2], o[3]); *(v2u*)(orow + 4 * F.lane + 256 * j) = w; }
    }
}
__device__ __forceinline__ void final_norm(Frame& F, float* out, const float* gvec) {
    const int gw = F.vcu * NWAVES + F.wave, NGW = F.G * NWAVES, rpw = (MTOK + NGW - 1) / NGW;
    const int r0 = gw * rpw, r1 = (r0 + rpw < MTOK) ? r0 + rpw : MTOK;
    f32x4 g[4];
#pragma unroll
    for (int j = 0; j < 4; ++j) g[j] = *(const f32x4*)(gvec + 4 * F.lane + 256 * j);
    for (int row = r0; row < r1; ++row) {
        float* xr = out + (size_t)row * DM; f32x4 v[4]; float ss = 0.f;
#pragma unroll
        for (int j = 0; j < 4; ++j) { v[j] = *(const f32x4*)(xr + 4 * F.lane + 256 * j); ss += (v[j][0] * v[j][0] + v[j][1] * v[j][1]) + (v[j][2] * v[j][2] + v[j][3] * v[j][3]); }
        const float r = 1.0f / sqrtf(wave_sum(ss) * (1.0f / DM) + 1e-6f);
#pragma unroll
        for (int j = 0; j < 4; ++j) *(f32x4*)(xr + 4 * F.lane + 256 * j) = v[j] * r * g[j];
    }
}
template <int W> __device__ __forceinline__ void poolres_cols(const bf16* zb, bf16* outb, bf16* xnb, float* partb, int t0, int c, f32x4 gate, f32x4 gmn, int grp, int lane, const LAS float* rt, bool xo) {
    constexpr int L = W / 2, R = W / 2 - 1, NV = W - 1 + 16;
    f32x4 v[NV];
#define BF4(u_) (f32x4){bf2f((u_).x & 0xffffu), bf2f((u_).x >> 16), bf2f((u_).y & 0xffffu), bf2f((u_).y >> 16)}
#define Z_LD(dst_, t_) do { const int tt_ = (t_); if (tt_ < 0 || tt_ >= SEQ) dst_ = (f32x4){0.f, 0.f, 0.f, 0.f}; else { const v2u u_ = __builtin_nontemporal_load((const v2u*)(zb + (size_t)tt_ * DM + c)); dst_ = BF4(u_) * rt[tt_]; } } while (0)
#pragma unroll
    for (int i = 0; i < W - 1; ++i) Z_LD(v[i], t0 - L + i);
    for (int blk = 0; blk < 4; ++blk) {
        const int tb = t0 + 16 * blk;
        v2u xr[16];
#pragma unroll
        for (int i = 0; i < 16; ++i) xr[i] = *(const v2u*)(outb + (size_t)(tb + i) * DM + c);
#pragma unroll
        for (int i = 0; i < 16; ++i) Z_LD(v[W - 1 + i], tb + R + i);
        f32x4 s = v[0];
#pragma unroll
        for (int i = 1; i < W; ++i) s += v[i];
#pragma unroll
        for (int j = 0; j < 16; ++j) { const int t = tb + j; const int lo = t - L < 0 ? 0 : t - L, hi = t + R > SEQ - 1 ? SEQ - 1 : t + R; const float icnt = __builtin_amdgcn_rcpf((float)(hi - lo + 1));
            const f32x4 o = s * icnt - v[j + L]; const f32x4 x3 = BF4(xr[j]) + gate * o;
            if (!xo) { v2u w; w.x = pk2(x3[0], x3[1]); w.y = pk2(x3[2], x3[3]); *(v2u*)(outb + (size_t)t * DM + c) = w; }
            const f32x4 y = x3 * gmn; v2u wy; wy.x = pk2(y[0], y[1]); wy.y = pk2(y[2], y[3]); *(v2u*)(xnb + (size_t)t * DM + c) = wy;
            const float ss = wave_sum((x3[0] * x3[0] + x3[1] * x3[1]) + (x3[2] * x3[2] + x3[3] * x3[3]));
            if (lane == 0) *(f32x4*)(partb + ((size_t)grp * MTOK + t) * 4) = (f32x4){ss, 0.f, 0.f, 0.f};
            if (j < 15) s += v[j + W] - v[j]; }
#pragma unroll
        for (int i = 0; i < W - 1; ++i) v[i] = v[i + 16];
    }
#undef Z_LD
#undef BF4
}
__device__ __forceinline__ void poolres_pass(Frame& F, const bf16* Z, bf16* out, bf16* xn, float* part, const float* rsum, const int* flagp, const float* gate, const float* pscale, const float* gnext, const float* scnext) {
    LAS float* rtab = (LAS float*)(F.lds + RTAB_OFF);
    const bool xo = __builtin_amdgcn_readfirstlane(*flagp) != 0;
    for (int strip = F.vcu; strip < MTOK / 128; strip += F.G) {
        const int b = strip >> 5, grp = F.wave >> 1, ts = (strip & 31) * 128, t0 = ts + 64 * (F.wave & 1); const size_t ro = (size_t)b * SEQ;
        __syncthreads();
        if (F.tid < 128 + 15) { const int tt = ts - 8 + F.tid; float r = 0.f;
            if (tt >= 0 && tt < SEQ) { const float* pr = rsum + (ro + tt) * 4; f32x4 p = *(const f32x4*)pr; p += *(const f32x4*)(pr + (size_t)(MTOK * 4) * 1); p += *(const f32x4*)(pr + (size_t)(MTOK * 4) * 2); p += *(const f32x4*)(pr + (size_t)(MTOK * 4) * 3);
                r = __builtin_amdgcn_rsqf(((p[0] + p[1]) + (p[2] + p[3])) * (1.0f / 1024.0f) + 1e-6f); }
            rtab[F.tid] = r; }
        __syncthreads();
        const LAS float* rt = rtab + (8 - ts);
        const int c = 256 * grp + 4 * F.lane;
        const f32x4 gt = *(const f32x4*)(gate + (size_t)b * MODW + c) * *(const f32x4*)(pscale + c);
        const f32x4 gmn = *(const f32x4*)(gnext + c) * (*(const f32x4*)(scnext + (size_t)b * MODW + c) + 1.0f);
        const bf16* zb = Z + ro * DM; bf16* outb = out + ro * DM; bf16* xnb = xn + ro * DM; float* partb = part + ro * 4;
        if (grp == 0) poolres_cols<2>(zb, outb, xnb, partb, t0, c, gt, gmn, grp, F.lane, rt, xo); else if (grp == 1) poolres_cols<4>(zb, outb, xnb, partb, t0, c, gt, gmn, grp, F.lane, rt, xo);
        else if (grp == 2) poolres_cols<8>(zb, outb, xnb, partb, t0, c, gt, gmn, grp, F.lane, rt, xo); else poolres_cols<16>(zb, outb, xnb, partb, t0, c, gt, gmn, grp, F.lane, rt, xo);
    }
}
__device__ __forceinline__ void gmlp_unit(Frame& F, int unit, const bf16* VG, const bf16* U, const bf16* WSB, const float* bs, bf16* AM) {
    using attn_body::f32x16;
    const int g = F.wave, lane = F.lane, r32 = lane & 31, hi = lane >> 5;
    const size_t R0 = (size_t)unit * 128;
    LAS unsigned char* slot = F.lds + RING_OFF + g * 16384;
    const unsigned slot_addr = (unsigned)(uintptr_t)slot;
    const int vb = (int)slot_addr + ((lane >> 4) & 1) * 32 + (lane & 3) * 8 + (4 * hi + ((lane & 15) >> 2)) * 64;
#pragma unroll
    for (int kt = 0; kt < 2; ++kt)
#pragma unroll
        for (int p = 0; p < 8; ++p)
            attn_body::glds16_nt(VG + (R0 + 64 * kt + 16 * (p & 3) + (lane >> 2)) * 512 + g * 64 + (p >> 2) * 32 + (lane & 3) * 8, (unsigned)__builtin_amdgcn_readfirstlane(slot_addr + kt * 8192 + p * 1024));
    f32x16 o[4][2];
#pragma unroll
    for (int rb = 0; rb < 4; ++rb) { o[rb][0] = f32x16{}; o[rb][1] = f32x16{}; }
#define GM_LDPA(dst, kt_, rb_) do { int z_ = 0; asm volatile("" : "+v"(z_)); const char* wp = wb + z_ + (rb_) * 8192 + (kt_) * 128;     \
            _Pragma("unroll") for (int s = 0; s < 4; ++s) { const v2u a = *(const v2u*)(wp + s * 32), b = *(const v2u*)(wp + s * 32 + 16); dst[s] = __builtin_bit_cast(bf16x8, (v4u){a.x, a.y, b.x, b.y}); } } while (0)
    const char* wb = (const char*)(WSB + ((size_t)(g * 128 + r32) * 128 + 4 * hi));
    {
        bf16x8 pA[4], pB[4];
#define GM_PV(P, kt_, rb_) attn_body::pv(o[rb_], vb + (kt_) * 8192, P[0], P[1], P[2], P[3])
        GM_LDPA(pA, 0, 0);
        VM_WAIT();
        GM_LDPA(pB, 0, 1); GM_PV(pA, 0, 0);
        GM_LDPA(pA, 0, 2); GM_PV(pB, 0, 1);
        GM_LDPA(pB, 0, 3); GM_PV(pA, 0, 2);
        GM_LDPA(pA, 1, 0); GM_PV(pB, 0, 3);
        GM_LDPA(pB, 1, 1); GM_PV(pA, 1, 0);
        GM_LDPA(pA, 1, 2); GM_PV(pB, 1, 1);
        GM_LDPA(pB, 1, 3); GM_PV(pA, 1, 2);
        GM_PV(pB, 1, 3);
#undef GM_PV
    }
#undef GM_LDPA
    LDS_WAIT();
    LAS float* stg = (LAS float*)slot;
    v4u uA[4], uB[4]; float bA[4], bB[4];
#define GM_LDU(UU, BB, rb_) do { int zz_ = 0; asm volatile("" : "+v"(zz_)); const char* ub_ = (const char*)(U + (R0 + 32 * (rb_) + (lane >> 3)) * 512 + g * 64 + (lane & 7) * 8) + zz_; \
        const float* bb_ = bs + g * 128 + 32 * (rb_) + (lane >> 3) + zz_; _Pragma("unroll") for (int i = 0; i < 4; ++i) { UU[i] = __builtin_nontemporal_load((const v4u*)(ub_ + i * 8192)); BB[i] = bb_[8 * i]; } } while (0)
#define GM_EPI(UU, BB, rb_) do { \
        _Pragma("unroll") for (int r = 0; r < 16; ++r) { const int orow = attn_body::crow(r, hi); stg[orow * 64 + r32] = o[rb_][0][r]; stg[orow * 64 + 32 + r32] = o[rb_][1][r]; } \
        LDS_WAIT(); \
        _Pragma("unroll") for (int i = 0; i < 4; ++i) { const int row = i * 8 + (lane >> 3), ch = lane & 7; \
            const f32x4 a = *(const LAS f32x4*)(stg + row * 64 + ch * 8) + BB[i], b = *(const LAS f32x4*)(stg + row * 64 + ch * 8 + 4) + BB[i]; \
            v4u w; w.x = pk2(a[0] * bf2f(UU[i].x & 0xffffu), a[1] * bf2f(UU[i].x >> 16)); w.y = pk2(a[2] * bf2f(UU[i].y & 0xffffu), a[3] * bf2f(UU[i].y >> 16)); \
            w.z = pk2(b[0] * bf2f(UU[i].z & 0xffffu), b[1] * bf2f(UU[i].z >> 16)); w.w = pk2(b[2] * bf2f(UU[i].w & 0xffffu), b[3] * bf2f(UU[i].w >> 16)); \
            *(v4u*)(AM + (R0 + 32 * (rb_) + row) * 1024 + 512 + g * 64 + ch * 8) = w; } \
        LDS_WAIT(); } while (0)
    GM_LDU(uA, bA, 0);
    GM_LDU(uB, bB, 1); GM_EPI(uA, bA, 0);
    GM_LDU(uA, bA, 2); GM_EPI(uB, bB, 1);
    GM_LDU(uB, bB, 3); GM_EPI(uA, bA, 2);
    GM_EPI(uB, bB, 3);
#undef GM_LDU
#undef GM_EPI
}

template <class Sched> __device__ __forceinline__ int build_rtab(Frame& F, const Sched& S, const float* part, LAS float* rtab) {
    pg8::Unit u; int pm0 = -1, pm1 = -1;
    for (int i = 0; S.next(i, u); ++i) { if (pm0 < 0) pm0 = u.pm; else if (u.pm != pm0) pm1 = u.pm; }
    if (pm1 < 0) pm1 = pm0;
    { const int slot = F.tid >> 8, r = F.tid & 255, row = (slot ? pm1 : pm0) * 256 + r; float tot = 0.f;
#pragma unroll
        for (int pn = 0; pn < 4; ++pn) { const f32x4 p = *(const f32x4*)(part + ((size_t)pn * MTOK + row) * 4); tot += (p[0] + p[1]) + (p[2] + p[3]); }
        rtab[F.tid] = __builtin_amdgcn_rsqf(tot * (1.0f / DM) + 1e-6f); }
    __syncthreads();
    return pm0;
}
__global__ void __launch_bounds__(NWAVES * 64, 2) mega_fwd(Args args) {
    extern __shared__ __attribute__((aligned(16))) unsigned char lds[];
    Frame F;
    F.lds = (LAS unsigned char*)lds;
    F.MISC = (volatile LAS unsigned*)(F.lds + MISC_OFF);
    F.tid = threadIdx.x; F.lane = F.tid & 63; F.wave = __builtin_amdgcn_readfirstlane(F.tid >> 6);
    F.G = gridDim.x; { const int bx = blockIdx.x; F.vcu = (F.G % 8 == 0) ? (bx % 8) * (F.G / 8) + bx / 8 : bx; }
    ArgsP akp = (ArgsP)__builtin_amdgcn_kernarg_segment_ptr();
    F.ctl = (gu32*)(akp->ws + WS_CTL);
    for (int u = F.tid; u < (LDS_BYTES - LDSCTL_OFF) / 4; u += NWAVES * 64) ((LAS unsigned*)(F.lds + LDSCTL_OFF))[u] = 0u;
    __syncthreads();
    const int lo = akp->ph_lo, hi = akp->ph_hi;
    const bool one_launch = (hi - lo) > 1;
    XcdBarrier bar; bar.bar = (unsigned*)(F.ctl + CW_BAR); bar.x = 0; bar.st = nullptr;
    if (one_launch) bar = xcd_barrier_post((unsigned*)(F.ctl + CW_BAR), F.MISC + 8);
#ifndef PHASE_MASK
#define PHASE_MASK 0x7ff
#endif
#define IN(k) (((PHASE_MASK >> (k)) & 1) && lo <= (k) && (k) < hi)
#define SEAM(k) do { if (IN(k) && IN((k) + 1)) xcd_barrier(bar); } while (0)
#ifndef REPEAT_MASK
#define REPEAT_MASK 0
#endif
#define REP(k) for (int rep_ = 0; rep_ < (((REPEAT_MASK >> (k)) & 1) ? 2 : 1); ++rep_, (((REPEAT_MASK >> (k)) & 1) && rep_ == 1 && one_launch ? (xcd_barrier(bar), 0) : 0))
#define REPRES(k, dummy) ((((REPEAT_MASK >> (k)) & 1) && rep_ == 0) ? (void*)(ws + (dummy)) : (void*)(ws + WS_RES))
#define REPOUT(k, dummy) ((((REPEAT_MASK >> (k)) & 1) && rep_ == 0) ? (float*)(ws + (dummy)) : out)
#define PHASE_VARS() ArgsP A = akp; asm volatile("" : "+s"(A)); unsigned char* ws = A->ws; float* out = A->out; float* mods = (float*)(ws + WS_MODS); const float* mod1 = mods + (size_t)9 * MODW; bf16* XN = (bf16*)(ws + WS_XN); bf16* AM = (bf16*)(ws + WS_AM); bf16* HB = (bf16*)(ws + WS_H); \
    float* rs1 = (float*)(ws + WS_PART); float* rs2 = rs1 + 16 * MTOK; float* rs3 = rs2 + 16 * MTOK; float* rs4 = rs3 + 16 * MTOK; const float* bias13 = (const float*)(ws + WS_BIAS); \
    (void)out; (void)mods; (void)mod1; (void)XN; (void)AM; (void)HB; (void)rs1; (void)rs2; (void)rs3; (void)rs4; (void)bias13
#ifndef STAGGER_US
#define STAGGER_US 0
#endif
#define STAGGER() do { const unsigned g_ = (blockIdx.x >> 3) & 3u; if (STAGGER_US > 0 && g_) { const unsigned long long t0_ = __builtin_amdgcn_s_memrealtime(); while (__builtin_amdgcn_s_memrealtime() - t0_ < (unsigned long long)(g_ * STAGGER_US * 100)) __builtin_amdgcn_s_sleep(8); } } while (0)
#define RELAUNDER() do { int t_ = threadIdx.x; asm volatile("" : "+v"(t_)); F.tid = t_; F.lane = t_ & 63; } while (0)
    if (IN(0)) REP(0) { PHASE_VARS(); RELAUNDER(); p0_prologue(F, A); } SEAM(0);
    if (IN(1)) REP(1) { PHASE_VARS(); RELAUNDER(); p1_flag(F, A); p1_bias13(F, A); p1_poolw(F, A); p1_biasin(F, A); norm_pass(F, A->in[I_X], A->in[I_CTX], XN, (float*)(ws + WS_RIN), A->in[I_GMIX], mods, SC1); } SEAM(1);
    if (IN(2)) REP(2) { PHASE_VARS();
        pg8::Gemm g{XN, (const bf16*)(ws + WS_WIN), DM, DM, 0, 0}; pg8::StaticOrder S; S.init(MTOK, INW, F.G, (int)blockIdx.x, MCTX / 256, 2);
        pg8::EpiInProj E{A};
        pg8::gemm_phase<pg8::EpiInProj, pg8::StaticOrder, PG8_ALIGN, PG8_SP2>(F.lds + RING_OFF, g, S, E);
        { const int total = (MTOK / 256) * (INW / 256) + MCTX / 256, rounds = (total + (int)F.G - 1) / (int)F.G, heavy = total - (rounds - 1) * (int)F.G, c = (int)blockIdx.x;
          RELAUNDER();
          if (heavy >= (int)F.G) p0_items(F, A, P0_ITEMS_EARLY, P0_ITEMS_ALL, c * NWAVES + F.wave, (int)F.G * NWAVES);
          else if (c >= heavy) p0_items(F, A, P0_ITEMS_EARLY, P0_ITEMS_ALL, (c - heavy) * NWAVES + F.wave, ((int)F.G - heavy) * NWAVES); }
    } SEAM(2);
    if (IN(3)) REP(3) { PHASE_VARS();
        const attn_body::AttnTensors AT{(const attn_body::bf16*)(ws + WS_Q), (const attn_body::bf16*)(ws + WS_KB), (const attn_body::bf16*)(ws + WS_VB), (attn_body::bf16*)AM};
        const attn_body::StaticOrder S((int)F.G, F.vcu);
        const bool gfirst = (F.vcu & 1) != 0;
        for (int g2_ = 0; g2_ < 2; ++g2_) {
            if ((g2_ == 0) == gfirst) {
                RELAUNDER();
                for (int rp_ = 0; rp_ < (((REPEAT_MASK >> 11) & 1) ? 2 : 1); ++rp_) {
                    for (int u = F.vcu; u < MTOK / 128; u += F.G) gmlp_unit(F, u, (const bf16*)(ws + WS_VG), (const bf16*)(ws + WS_U), (const bf16*)(ws + WS_WSB), A->in[I_BSP], AM);
                    __syncthreads(); }
            } else attn_body::attn_phase<attn_body::StaticOrder>((char*)lds + RING_OFF, AT, S, A->in[I_QN], A->in[I_KN]);
        }
    } SEAM(3);
    if (IN(4)) REP(4) { PHASE_VARS(); STAGGER();
        pg8::Gemm g{AM, (const bf16*)(ws + WS_WOUT), DM, DM, 0, 0}; pg8::StaticOrder S; S.init(MTOK, DM, F.G, (int)blockIdx.x);
        if (__builtin_amdgcn_readfirstlane(*(const int*)(ws + WS_FLAG)) != 0) { pg8::EpiResid<5> E{A, (void*)(ws + WS_RES)};
            pg8::gemm_phase<pg8::EpiResid<5>, pg8::StaticOrder, PG8_ALIGN, PG8_SP2>(F.lds + RING_OFF, g, S, E); }
        else { pg8::EpiResid<4> E{A, (void*)(ws + WS_RES)};
            pg8::gemm_phase<pg8::EpiResid<4>, pg8::StaticOrder, PG8_ALIGN, PG8_SP2>(F.lds + RING_OFF, g, S, E); }
    } SEAM(4);
    if (IN(5)) REP(5) { PHASE_VARS();
        pg8::Gemm g{XN, (const bf16*)(ws + WS_W13), DM, DM, 0, 0}; pg8::StaticOrder S; S.init(MTOK, 2 * FF, F.G, (int)blockIdx.x);
#if defined(PROBE_NULL5)
        if (rep_ == 0) { pg8::EpiNull EN{(bf16*)(ws + WS_VG)}; pg8::StaticOrder S2; S2.init(MTOK, DM, F.G, (int)blockIdx.x);   (void)S2;
            pg8::EpiNullWide ENW{(bf16*)(ws + WS_H)}; pg8::gemm_phase<pg8::EpiNullWide, pg8::StaticOrder, PG8_ALIGN, PG8_SP2>(F.lds + RING_OFF, g, S, ENW); (void)EN; } else
#endif
        { RELAUNDER(); LAS float* rtab = (LAS float*)(F.lds + RTAB_OFF); const int pm0 = build_rtab(F, S, rs1, rtab); pg8::EpiSwiglu<0> E{A, rtab, pm0};
        pg8::gemm_phase<pg8::EpiSwiglu<0>, pg8::StaticOrder, PG8_ALIGN, PG8_SP2>(F.lds + RING_OFF, g, S, E); }
    } SEAM(5);
    if (IN(6)) REP(6) { PHASE_VARS(); STAGGER();
        pg8::Gemm g{HB, (const bf16*)(ws + WS_W2), FF, FF, 0, 0}; pg8::StaticOrder S; S.init(MTOK, DM, F.G, (int)blockIdx.x);
#if defined(PROBE_NULL6)
        if (rep_ == 0) { pg8::EpiNull EN{(bf16*)(ws + WS_VG)}; pg8::gemm_phase<pg8::EpiNull, pg8::StaticOrder, PG8_ALIGN, PG8_SP2>(F.lds + RING_OFF, g, S, EN); } else
#elif defined(PROBE_NOXN6)
        if (rep_ == 0) { pg8::EpiResid<7> E7{A, REPRES(6, WS_VG)}; pg8::gemm_phase<pg8::EpiResid<7>, pg8::StaticOrder, PG8_ALIGN, PG8_SP2>(F.lds + RING_OFF, g, S, E7); } else
#endif
        { pg8::EpiResid<6> E{A, REPRES(6, WS_VG)};
        pg8::gemm_phase<pg8::EpiResid<6>, pg8::StaticOrder, PG8_ALIGN, PG8_SP2>(F.lds + RING_OFF, g, S, E); }
        { pg8::Gemm gz{(const bf16*)(ws + WS_RES), (const bf16*)(ws + WS_WPB), 256, DM, 512, 1024 * 256 * 2}; pg8::EpiZ EZ{A};
        pg8::gemm_phase<pg8::EpiZ, pg8::StaticOrder, PG8_ALIGN, PG8_SP2>(F.lds + RING_OFF, gz, S, EZ); }
    } SEAM(7);
    if (IN(8)) { PHASE_VARS(); RELAUNDER(); poolres_pass(F, AM, (bf16*)(ws + WS_RES), XN, rs3, rs2, (const int*)(ws + WS_FLAG), mod1 + GA1, A->in[I_PSC], A->in[I_GFFN] + DM, mod1 + SC2); } SEAM(8);
    if (IN(9)) REP(9) { PHASE_VARS();
        pg8::Gemm g{XN, (const bf16*)(ws + WS_W13) + (size_t)5632 * DM, DM, DM, 0, 0}; pg8::StaticOrder S; S.init(MTOK, 2 * FF, F.G, (int)blockIdx.x);
        RELAUNDER(); LAS float* rtab = (LAS float*)(F.lds + RTAB_OFF); const int pm0 = build_rtab(F, S, rs3, rtab); pg8::EpiSwiglu<1> E{A, rtab, pm0};
        pg8::gemm_phase<pg8::EpiSwiglu<1>, pg8::StaticOrder, PG8_ALIGN, PG8_SP2>(F.lds + RING_OFF, g, S, E);
    } SEAM(9);
    if (IN(10)) REP(10) { PHASE_VARS(); STAGGER();
        pg8::Gemm g{HB, (const bf16*)(ws + WS_W2) + (size_t)DM * FF, FF, FF, 0, 0}; pg8::StaticOrder S; S.init(MTOK, DM, F.G, (int)blockIdx.x);
        pg8::EpiResid<10> E{A, out};
        pg8::gemm_phase<pg8::EpiResid<10>, pg8::StaticOrder, PG8_ALIGN, PG8_SP2>(F.lds + RING_OFF, g, S, E);
    }
#undef IN
#undef SEAM
}

extern "C" void kernel_launch(void* const* d_in, const int* in_sizes, int n_in, void* d_out, int out_size, void* d_ws, size_t ws_size, hipStream_t stream) {
    static int grid = 0;
    if (grid == 0) {
        if (n_in != 21 || out_size != MTOK * DM || ws_size < WS_END) { fprintf(stderr, "kernel_launch: unexpected shapes (n_in %d, out %d, ws %zu)\n", n_in, out_size, ws_size); grid = -1; return; }
        int dev = 0, cus = 0, per_cu = 0;
        if (hipGetDevice(&dev) != hipSuccess || hipDeviceGetAttribute(&cus, hipDeviceAttributeMultiprocessorCount, dev) != hipSuccess) { grid = -1; return; }
        if (hipFuncSetAttribute((const void*)mega_fwd, hipFuncAttributeMaxDynamicSharedMemorySize, LDS_BYTES) != hipSuccess) { fprintf(stderr, "kernel_launch: hipFuncSetAttribute failed\n"); grid = -1; return; }
        if (hipOccupancyMaxActiveBlocksPerMultiprocessor(&per_cu, (const void*)mega_fwd, NWAVES * 64, LDS_BYTES) != hipSuccess || per_cu < 1) { fprintf(stderr, "kernel_launch: occupancy query says %d\n", per_cu); per_cu = 1; }
        (void)hipGetLastError();
        grid = cus;
        if (grid != 256) fprintf(stderr, "kernel_launch: %d CUs (expected 256)\n", grid);
    }
    if (grid < 0) return;
    if (hipMemsetAsync((char*)d_ws + WS_CTL, 0, CTL_ZERO_BYTES, stream) != hipSuccess) return;
    Args a{};
    for (int i = 0; i < 21; ++i) a.in[i] = (const float*)d_in[i];
    a.out = (float*)d_out; a.ws = (unsigned char*)d_ws;
#if defined(MK_PER_PHASE)
    for (int p = 0; p < N_PHASES; ++p) { a.ph_lo = p; a.ph_hi = p + 1; hipLaunchKernelGGL(mega_fwd, dim3(grid), dim3(NWAVES * 64), LDS_BYTES, stream, a); }
#else
    a.ph_lo = 0; a.ph_hi = N_PHASES;
    hipLaunchKernelGGL(mega_fwd, dim3(grid), dim3(NWAVES * 64), LDS_BYTES, stream, a);
#endif
}
```

```cpp
#include <hip/hip_runtime.h>
#include <hip/hip_bf16.h>
#include <cstdio>
#include <cstdint>
#include <cmath>
constexpr int NWAVES_ = 8;
constexpr int NWAVES = 8;
constexpr int DM = 1024, NB = 8, SEQ = 4096, MTOK = NB * SEQ, CTXL = 256, MCTX = NB * CTXL, MALL = MTOK + MCTX;
constexpr int INW = 1792, FF = 2816, SKV = SEQ + CTXL;
constexpr int N_PHASES = 11;
constexpr size_t MiB = 1u << 20;
constexpr size_t WS_CTL = 0, CTL_ZERO_BYTES = 128 * 1024;
constexpr size_t WS_MODS = 1 * MiB;
constexpr size_t WS_ROPE = WS_MODS + 512 * 1024;
constexpr size_t WS_WSB = 2 * MiB;
constexpr size_t WS_WPOOL = WS_WSB + 512 * 1024;
constexpr size_t WS_RIN = 3 * MiB;
constexpr size_t WS_BIASIN = WS_RIN + 256 * 1024;
constexpr size_t WS_WIN = 4 * MiB;
constexpr size_t WS_WOUT = 8 * MiB;
constexpr size_t WS_W13 = 10 * MiB;
constexpr size_t WS_W2 = 32 * MiB;
constexpr size_t WS_XN = 44 * MiB;
constexpr size_t WS_Q = 112 * MiB;
constexpr size_t WS_RES = 112 * MiB;
constexpr size_t WS_KB = 144 * MiB;
constexpr size_t WS_VB = 153 * MiB;
constexpr size_t WS_U = 162 * MiB;
constexpr size_t WS_VG = 194 * MiB;
constexpr size_t WS_AM = 226 * MiB;
constexpr size_t WS_H = 290 * MiB;
constexpr size_t WS_WPB = 474 * MiB;
constexpr size_t WS_END = 478 * MiB;
constexpr int CW_BAR = 4096;
constexpr size_t CTL_CNT = 65536;
constexpr size_t WS_PART = 466 * MiB;
constexpr size_t CTL_CNT6 = CTL_CNT + 32768;
constexpr size_t CTL_HFLAG = CTL_CNT6 + 8192;
static_assert(CTL_HFLAG + 16384 <= CTL_ZERO_BYTES, "CTL map");
constexpr size_t WS_FLAG = WS_ROPE + 32768;
constexpr size_t WS_BIAS = WS_ROPE + 65536;
constexpr int RING_OFF = 0, RING_BYTES = 131072;
constexpr int LDSCTL_OFF = RING_BYTES, MISC_OFF = LDSCTL_OFF + 320;
constexpr int RTAB_OFF = LDSCTL_OFF + 1024;
constexpr int LDS_BYTES = 147456;
static_assert(MISC_OFF + 128 <= LDS_BYTES, "LDS map");

struct Args { const float* in[21]; float* out; unsigned char* ws; int ph_lo, ph_hi; };
#define KARG __attribute__((address_space(4)))
typedef const KARG Args* ArgsP;
static_assert(sizeof(Args) == 192, "Args has no padding");
enum { I_X = 0, I_C, I_CTX, I_CCTX, I_WADA, I_BADA, I_GMIX, I_GFFN, I_WIN, I_WOUT, I_QN, I_KN, I_GN, I_WSP, I_BSP, I_WPOOL, I_PSC, I_W1, I_W3, I_W2, I_GFIN };
constexpr int SH1 = 0, SC1 = DM, GA1 = 2 * DM, SH2 = 3 * DM, SC2 = 4 * DM, GA2 = 5 * DM, MODW = 6 * DM;

template <int CTRL> __device__ __forceinline__ float dpp_add(float x) { return x + __builtin_bit_cast(float, __builtin_amdgcn_update_dpp(0, __builtin_bit_cast(int, x), CTRL, 0xF, 0xF, true)); }
__device__ __forceinline__ float xor16_add(float x) { const unsigned u = __builtin_bit_cast(unsigned, x); auto r = __builtin_amdgcn_permlane16_swap(u, u, false, false); return __builtin_bit_cast(float, (unsigned)r[0]) + __builtin_bit_cast(float, (unsigned)r[1]); }
__device__ __forceinline__ float xor32_add(float x) { const unsigned u = __builtin_bit_cast(unsigned, x); auto r = __builtin_amdgcn_permlane32_swap(u, u, false, false); return __builtin_bit_cast(float, (unsigned)r[0]) + __builtin_bit_cast(float, (unsigned)r[1]); }
__device__ __forceinline__ float wave_sum64(float v) { v = dpp_add<0xB1>(v); v = dpp_add<0x4E>(v); v = dpp_add<0x124>(v); v = dpp_add<0x128>(v); v = xor16_add(v); return xor32_add(v); }
__device__ __forceinline__ int lane_id_v() { int l; asm volatile("v_mbcnt_lo_u32_b32 %0, -1, 0\n\tv_mbcnt_hi_u32_b32 %0, -1, %0" : "=v"(l)); return l; }
namespace pg8 {
#define PG8_LAS __attribute__((address_space(3)))
typedef unsigned short bf16_t;
typedef short bf16x8 __attribute__((ext_vector_type(8)));
typedef float f32x4 __attribute__((ext_vector_type(4)));
typedef float f32x2 __attribute__((ext_vector_type(2)));
typedef unsigned u32x4 __attribute__((ext_vector_type(4)));
constexpr int BM = 256, BK = 64, HALF = 128, HTB = HALF * BK * 2  , STAGE_BYTES = 8 * HTB, NXCD = 8, WGM = 8;

__host__ __device__ __forceinline__ int lds_byte(int r, int c) { const int st = (r >> 4) * 2 + (c >> 5), rr = r & 15, cc = c & 31, ob = rr * 64 + cc * 2; return st * 1024 + (ob ^ (((ob >> 9) & 1) << 5)); }
__host__ __device__ __forceinline__ void stage_rc(int b, int& R, int& C) { const int st = b / 1024, sb = b % 1024, swz = sb ^ (((sb >> 9) & 1) << 5); R = (st >> 1) * 16 + swz / 64; C = (st & 1) * 32 + (swz % 64) / 2; }
__host__ __device__ __forceinline__ int perm32(int rho) { const int n = rho >> 4, i = rho & 15; return 8 * (i >> 2) + 4 * n + (i & 3); }

struct Unit { int pm, pn; };
struct Gemm { const bf16_t* A; const bf16_t* Bt; int K; int lda; int a_pn_bytes; int b_batch_bytes; };

struct StaticOrder {
    int nM, nN, nwg, G, c, extra, extra_pn;
    __host__ __device__ void init(int M, int N, int G_, int c_, int extra_ = 0, int extra_pn_ = 0) { nM = M / BM; nN = N / BM; nwg = nM * nN; G = G_; c = c_; extra = extra_; extra_pn = extra_pn_; }
    __host__ __device__ bool next(int i, Unit& u) const {
        const long L = (long)i * G + c;
        if (L >= nwg) { const long e = L - nwg; if (e >= extra) return false; u.pm = nM + (int)e; u.pn = extra_pn; return true; }
        int wgid = (int)L; { const int q = nwg / NXCD, r = nwg % NXCD, xcd = wgid % NXCD, off = wgid / NXCD; wgid = (xcd < r ? xcd * (q + 1) : r * (q + 1) + (xcd - r) * q) + off; }
        const int nig = WGM * nN, gid = wgid / nig, fm = gid * WGM, gsz = (nM - fm) < WGM ? (nM - fm) : WGM;
        u.pm = fm + ((wgid % nig) % gsz); u.pn = (wgid % nig) / gsz; return true;
    }
    __device__ __forceinline__ void a_ready(const Unit&) const {}
    __device__ __forceinline__ void done(const Unit&) const {}
};

__device__ __forceinline__ unsigned cvt_pk_bf16(float lo, float hi) { unsigned r; asm volatile("v_cvt_pk_bf16_f32 %0, %1, %2" : "=v"(r) : "v"(lo), "v"(hi)); return r; }
__device__ __forceinline__ f32x2 gelu_pk(f32x2 v) {
    const f32x2 av = __builtin_elementwise_abs(v), d = av * 0.2316418882f + 1.0f;
    f32x2 t; t.x = __builtin_amdgcn_rcpf(d.x); t.y = __builtin_amdgcn_rcpf(d.y);
    f32x2 q = t * 0.5307027145f + (-0.7265760135f); q = q * t + 0.7107068705f; q = q * t + (-0.142248368f); q = q * t + 0.127414796f; q = q * t;
    const f32x2 s = (v * v) * (-0.72134752044f);
    f32x2 e; e.x = __builtin_amdgcn_exp2f(s.x); e.y = __builtin_amdgcn_exp2f(s.y);
    const f32x2 m = v * (q * e), r = v - m;
    f32x2 o; o.x = v.x < 0.f ? m.x : r.x; o.y = v.y < 0.f ? m.y : r.y; return o;
}
__device__ __forceinline__ f32x4 gelu4(f32x4 v) { const f32x2 a = gelu_pk((f32x2){v[0], v[1]}), b = gelu_pk((f32x2){v[2], v[3]}); return (f32x4){a.x, a.y, b.x, b.y}; }
__device__ __forceinline__ float silu1(float v) { return v * __builtin_amdgcn_rcpf(1.0f + __builtin_amdgcn_exp2f(v * -1.4426950408889634f)); }
__device__ __forceinline__ u32x4 pack8(f32x4 v0, f32x4 v1) { u32x4 w; w.x = cvt_pk_bf16(v0[0], v0[1]); w.y = cvt_pk_bf16(v0[2], v0[3]); w.z = cvt_pk_bf16(v1[0], v1[1]); w.w = cvt_pk_bf16(v1[2], v1[3]); return w; }

struct EpiInProj {
    static constexpr bool PERM = true, AFTER_DRAIN = false;
    ArgsP A;
    __device__ __forceinline__ void operator()(f32x4 (&acc)[2][2][4][2], const Unit& u, int wr, int wc, int fr_, int fq_) const {
        ArgsP a_ = A; asm volatile("" : "+s"(a_)); unsigned char* ws_ = a_->ws;
        bf16_t* Q = (bf16_t*)(ws_ + WS_Q); bf16_t* KB = (bf16_t*)(ws_ + WS_KB); bf16_t* VB = (bf16_t*)(ws_ + WS_VB); bf16_t* U = (bf16_t*)(ws_ + WS_U); bf16_t* VG = (bf16_t*)(ws_ + WS_VG);
        const float* qn = a_->in[I_QN]; const float* kn = a_->in[I_KN]; const float* gv = a_->in[I_GN]; const float* ropeC = (const float*)(ws_ + WS_ROPE); const float* ropeS = ropeC + 1024;
        const float qscale = 0.125f * 1.4426950408889634f;
        const int t_ = lane_id_v(); const int fr = t_ & 15, fq = (t_ >> 4) & 3; (void)fr_; (void)fq_;
        const int slot = 4 * u.pn + wc; const bool isctx = u.pm >= 128;
        const int rowl = wr * 64 + fr;
        const int row0 = u.pm * BM + rowl;
        const int kvrow0 = (isctx ? (u.pm - 128) * 4352 + 4096 : (u.pm >> 4) * 4352 + (u.pm & 15) * 256) + rowl;
        const int dl = 8 * fq;
        {
            const float* rin = (const float*)(ws_ + WS_RIN) + row0; const float* bin = (const float*)(ws_ + WS_BIASIN) + (size_t)(isctx ? 8 : (u.pm >> 4)) * INW + 64 * slot + dl;
            f32x4 bv[2][2]; float rr[2][4];
#pragma unroll
            for (int bj = 0; bj < 2; ++bj)
#pragma unroll
                for (int n = 0; n < 2; ++n) bv[bj][n] = *(const f32x4*)(bin + 32 * bj + 4 * n);
#pragma unroll
            for (int ai = 0; ai < 2; ++ai)
#pragma unroll
                for (int m = 0; m < 4; ++m) rr[ai][m] = rin[ai * HALF + m * 16];
#pragma unroll
            for (int ai = 0; ai < 2; ++ai)
#pragma unroll
                for (int bj = 0; bj < 2; ++bj)
#pragma unroll
                    for (int m = 0; m < 4; ++m)
#pragma unroll
                        for (int n = 0; n < 2; ++n) acc[ai][bj][m][n] = acc[ai][bj][m][n] * rr[ai][m] + bv[bj][n];
            asm volatile("" ::: "memory"); }
        if (slot < 10) {
            const float* nw = slot < 8 ? qn : kn; const float osc = slot < 8 ? qscale : 1.0f;
            f32x4 w[2][2];
#pragma unroll
            for (int bj = 0; bj < 2; ++bj)
#pragma unroll
                for (int n = 0; n < 2; ++n) w[bj][n] = *(const f32x4*)(nw + 32 * bj + dl + 4 * n);
#pragma unroll
            for (int ai = 0; ai < 2; ++ai) {
                const int posr = (4 * u.pm + 2 * ai + wr) & 63;
                const f32x4 cr = *(const f32x4*)(ropeC + posr * 16 + 4 * fq), sr = *(const f32x4*)(ropeS + posr * 16 + 4 * fq);
#pragma unroll
                for (int m = 0; m < 4; ++m) {
                    float ss = 0.f;
#pragma unroll
                    for (int bj = 0; bj < 2; ++bj)
#pragma unroll
                        for (int n = 0; n < 2; ++n) { const f32x4 x = acc[ai][bj][m][n]; ss += (x[0] * x[0] + x[1] * x[1]) + (x[2] * x[2] + x[3] * x[3]); }
                    ss = xor32_add(xor16_add(ss));
                    const float r = __builtin_amdgcn_rsqf(ss * (1.0f / 64.0f) + 1e-6f) * osc;
                    const int posc = 16 * m + fr;
                    const f32x4 cc = *(const f32x4*)(ropeC + posc * 16 + 4 * fq), sc = *(const f32x4*)(ropeS + posc * 16 + 4 * fq);
#pragma unroll
                    for (int bj = 0; bj < 2; ++bj) {
                        f32x4 v0 = acc[ai][bj][m][0] * r * w[bj][0], v1 = acc[ai][bj][m][1] * r * w[bj][1];
                        if (!isctx) { const f32x4 c = bj ? cc : cr, s = bj ? sc : sr;
                            const f32x4 o0 = (f32x4){v0[0] * c[0] - v0[1] * s[0], v0[0] * s[0] + v0[1] * c[0], v0[2] * c[1] - v0[3] * s[1], v0[2] * s[1] + v0[3] * c[1]};
                            const f32x4 o1 = (f32x4){v1[0] * c[2] - v1[1] * s[2], v1[0] * s[2] + v1[1] * c[2], v1[2] * c[3] - v1[3] * s[3], v1[2] * s[3] + v1[3] * c[3]};
                            v0 = o0; v1 = o1; }
                        bf16_t* dst = slot < 8 ? Q + (size_t)(row0 + ai * HALF + m * 16) * 512 + slot * 64 + 32 * bj + dl
                                               : KB + (size_t)(kvrow0 + ai * HALF + m * 16) * 128 + (slot - 8) * 64 + 32 * bj + dl;
                        *(u32x4*)dst = pack8(v0, v1);
                    }
                    asm volatile("" ::: "memory");
                }
            }
        } else if (slot < 12) {
#pragma unroll
            for (int ai = 0; ai < 2; ++ai)
#pragma unroll
                for (int m = 0; m < 4; ++m)
#pragma unroll
                    for (int bj = 0; bj < 2; ++bj)
                        *(u32x4*)(VB + (size_t)(kvrow0 + ai * HALF + m * 16) * 128 + (slot - 10) * 64 + 32 * bj + dl) = pack8(acc[ai][bj][m][0], acc[ai][bj][m][1]);
        } else if (slot < 20) {
#pragma unroll
            for (int ai = 0; ai < 2; ++ai)
#pragma unroll
                for (int m = 0; m < 4; ++m)
#pragma unroll
                    for (int bj = 0; bj < 2; ++bj)
                        *(u32x4*)(U + (size_t)(row0 + ai * HALF + m * 16) * 512 + (slot - 12) * 64 + 32 * bj + dl) = pack8(gelu4(acc[ai][bj][m][0]), gelu4(acc[ai][bj][m][1]));
        } else {
            f32x4 w[2][2];
#pragma unroll
            for (int bj = 0; bj < 2; ++bj)
#pragma unroll
                for (int n = 0; n < 2; ++n) w[bj][n] = *(const f32x4*)(gv + (slot - 20) * 64 + 32 * bj + dl + 4 * n);
#pragma unroll
            for (int ai = 0; ai < 2; ++ai)
#pragma unroll
                for (int m = 0; m < 4; ++m) {
                    f32x4 g[2][2]; float ss = 0.f;
#pragma unroll
                    for (int bj = 0; bj < 2; ++bj)
#pragma unroll
                        for (int n = 0; n < 2; ++n) { const f32x4 x = gelu4(acc[ai][bj][m][n]); g[bj][n] = x; ss += (x[0] * x[0] + x[1] * x[1]) + (x[2] * x[2] + x[3] * x[3]); }
                    ss = xor32_add(xor16_add(ss));
                    const float r = __builtin_amdgcn_rsqf(ss * (1.0f / 64.0f) + 1e-6f);
#pragma unroll
                    for (int bj = 0; bj < 2; ++bj)
                        *(u32x4*)(VG + (size_t)(row0 + ai * HALF + m * 16) * 512 + (slot - 20) * 64 + 32 * bj + dl) = pack8(g[bj][0] * r * w[bj][0], g[bj][1] * r * w[bj][1]);
                }
        }
    }
};
constexpr int RS_M = 32768;
__device__ __forceinline__ float row_total(const float* part, int row, int fq) {
    const f32x4 p = *(const f32x4*)(part + ((size_t)fq * RS_M + row) * 4); float t = (p[0] + p[1]) + (p[2] + p[3]); t = xor32_add(xor16_add(t)); return t;
}
template <int V> struct EpiResid {
    static constexpr bool PERM = true, AFTER_DRAIN = false, XNOUT = (V == 4 || V == 5), FINAL = (V == 10), BASE16 = (V != 4), RESOUT = (V != 5);
    ArgsP A; void* outp;
    __device__ __forceinline__ void operator()(f32x4 (&acc)[2][2][4][2], const Unit& u, int wr, int wc, int fr_, int fq_) const {
        const int t_ = lane_id_v(); const int fr = t_ & 15, fq = (t_ >> 4) & 3; (void)fr_; (void)fq_;
        const int row0 = u.pm * BM + wr * 64 + fr, col0 = u.pn * BM + wc * 32 + 8 * fq, b = u.pm >> 4;
        ArgsP a_ = A; asm volatile("" : "+s"(a_)); unsigned char* ws_ = a_->ws; constexpr int gstride = MODW;
        const float* mods_ = (const float*)(ws_ + WS_MODS); const float* modl_ = mods_ + (V == 10 ? 9 * MODW : 0);
        const float* basef = a_->in[I_X]; const bf16_t* baseh = (const bf16_t*)(ws_ + WS_RES); const float* gate = modl_ + (XNOUT ? GA1 : GA2);
        float* part = (float*)(ws_ + WS_PART) + (size_t)(XNOUT ? 0 : V == 10 ? 3 : 1) * 16 * RS_M;
        bf16_t* xn = (bf16_t*)(ws_ + WS_XN); const float* gnext = XNOUT ? a_->in[I_GFFN] : a_->in[I_GMIX] + DM; const float* scnext = XNOUT ? mods_ + SC2 : mods_ + 9 * MODW + SC1;
        unsigned* cnt = (unsigned*)(ws_ + WS_CTL + CTL_CNT); const float* gfin = a_->in[I_GFIN];
        bf16_t* resout = (bf16_t*)outp; float* out = (float*)outp;
        const float* gp = gate + (size_t)b * gstride + col0;
        const bool xo = (V == 5) ? true : BASE16 ? (__builtin_amdgcn_readfirstlane(*(const int*)(ws_ + WS_FLAG)) != 0) : false;
        if (BASE16 && xo) baseh = (const bf16_t*)(ws_ + WS_XN);
        f32x4 gvv[2][2], gmn[2][2], rgv[2][2];
#pragma unroll
        for (int bj = 0; bj < 2; ++bj)
#pragma unroll
            for (int n = 0; n < 2; ++n) { gvv[bj][n] = *(const f32x4*)(gp + bj * HALF + n * 4);
                if (XNOUT) gmn[bj][n] = *(const f32x4*)(gnext + col0 + bj * HALF + n * 4) * (*(const f32x4*)(scnext + (size_t)b * gstride + col0 + bj * HALF + n * 4) + 1.0f);
                if (BASE16) { const float* gprev = (V == 10) ? a_->in[I_GFFN] + DM : (V == 5) ? a_->in[I_GMIX] : a_->in[I_GFFN]; const float* scprev = modl_ + (V == 5 ? SC1 : SC2);
                    const f32x4 m = *(const f32x4*)(gprev + col0 + bj * HALF + n * 4) * (*(const f32x4*)(scprev + (size_t)b * gstride + col0 + bj * HALF + n * 4) + 1.0f);
                    rgv[bj][n] = xo ? (f32x4){__builtin_amdgcn_rcpf(m[0]), __builtin_amdgcn_rcpf(m[1]), __builtin_amdgcn_rcpf(m[2]), __builtin_amdgcn_rcpf(m[3])} : (f32x4){1.f, 1.f, 1.f, 1.f}; } }
        float ssv[2][4];
        f32x4 bsA[2][2], bsB[2][2], bsC[2][2], bsD[2][2], bsE[2][2], bsF[2][2], bsG[2][2], bsH[2][2];
        u32x4 hsA[2], hsB[2], hsC[2], hsD[2], hsE[2], hsF[2], hsG[2], hsH[2];
#define ER_LOAD(X, p) do { const size_t off_ = (size_t)(row0 + ((p) >> 2) * HALF + ((p) & 3) * 16) * 1024 + col0; \
            _Pragma("unroll") for (int bj = 0; bj < 2; ++bj) { if (BASE16) { if (FINAL) hs##X[bj] = __builtin_nontemporal_load((const u32x4*)(baseh + off_ + bj * HALF)); else hs##X[bj] = *(const u32x4*)(baseh + off_ + bj * HALF); } \
                else { bs##X[bj][0] = __builtin_nontemporal_load((const f32x4*)(basef + off_ + bj * HALF)); bs##X[bj][1] = __builtin_nontemporal_load((const f32x4*)(basef + off_ + bj * HALF + 4)); } } } while (0)
#define ER_WORK(X, p) do { const int ai = (p) >> 2, m = (p) & 3; const size_t off_ = (size_t)(row0 + ai * HALF + m * 16) * 1024 + col0; float ss = 0.f; \
            _Pragma("unroll") for (int bj = 0; bj < 2; ++bj) { f32x4 b0, b1; \
                if (BASE16) { const u32x4 h = hs##X[bj]; b0 = (f32x4){__builtin_bit_cast(float, h.x << 16), __builtin_bit_cast(float, h.x & 0xffff0000u), __builtin_bit_cast(float, h.y << 16), __builtin_bit_cast(float, h.y & 0xffff0000u)}; \
                    b1 = (f32x4){__builtin_bit_cast(float, h.z << 16), __builtin_bit_cast(float, h.z & 0xffff0000u), __builtin_bit_cast(float, h.w << 16), __builtin_bit_cast(float, h.w & 0xffff0000u)}; b0 *= rgv[bj][0]; b1 *= rgv[bj][1]; } \
                else { b0 = bs##X[bj][0]; b1 = bs##X[bj][1]; } \
                const f32x4 x0 = b0 + gvv[bj][0] * acc[ai][bj][m][0], x1 = b1 + gvv[bj][1] * acc[ai][bj][m][1]; \
                ss += ((x0[0] * x0[0] + x0[1] * x0[1]) + (x0[2] * x0[2] + x0[3] * x0[3])) + ((x1[0] * x1[0] + x1[1] * x1[1]) + (x1[2] * x1[2] + x1[3] * x1[3])); \
                if (FINAL) { acc[ai][bj][m][0] = x0; acc[ai][bj][m][1] = x1; } else if (RESOUT) *(u32x4*)(resout + off_ + bj * HALF) = pack8(x0, x1); \
                if (XNOUT) *(u32x4*)(xn + off_ + bj * HALF) = pack8(x0 * gmn[bj][0], x1 * gmn[bj][1]); } \
            ss = xor32_add(xor16_add(ss)); ssv[ai][m] = ss; } while (0)
#define ER_FENCE asm volatile("" ::: "memory")
        if constexpr (BASE16 && !XNOUT) {
            ER_LOAD(A, 0); ER_LOAD(B, 1); ER_LOAD(C, 2); ER_LOAD(D, 3); ER_FENCE;
            ER_LOAD(E, 4); ER_FENCE; ER_WORK(A, 0); ER_FENCE;
            ER_LOAD(A, 5); ER_FENCE; ER_WORK(B, 1); ER_FENCE;
            ER_LOAD(B, 6); ER_FENCE; ER_WORK(C, 2); ER_FENCE;
            ER_LOAD(C, 7); ER_FENCE; ER_WORK(D, 3); ER_FENCE;
            ER_WORK(E, 4); ER_FENCE; ER_WORK(A, 5); ER_FENCE; ER_WORK(B, 6); ER_FENCE; ER_WORK(C, 7);
        } else {
            ER_LOAD(A, 0); ER_LOAD(B, 1); ER_FENCE;
            ER_LOAD(C, 2); ER_FENCE; ER_WORK(A, 0); ER_FENCE;
            ER_LOAD(A, 3); ER_FENCE; ER_WORK(B, 1); ER_FENCE;
            ER_LOAD(B, 4); ER_FENCE; ER_WORK(C, 2); ER_FENCE;
            ER_LOAD(C, 5); ER_FENCE; ER_WORK(A, 3); ER_FENCE;
            ER_LOAD(A, 6); ER_FENCE; ER_WORK(B, 4); ER_FENCE;
            ER_LOAD(B, 7); ER_FENCE; ER_WORK(C, 5); ER_FENCE;
            ER_WORK(A, 6); ER_FENCE;
            ER_WORK(B, 7);
        }
#undef ER_FENCE
#undef ER_LOAD
#undef ER_WORK
        if (fq == 0) {
#pragma unroll
            for (int ai = 0; ai < 2; ++ai)
#pragma unroll
                for (int m = 0; m < 4; ++m) { float* pp = part + ((size_t)u.pn * RS_M + (row0 + ai * HALF + m * 16)) * 4 + wc;
                    if (FINAL || V == 6) __hip_atomic_store(pp, ssv[ai][m], __ATOMIC_RELAXED, __HIP_MEMORY_SCOPE_AGENT); else *pp = ssv[ai][m]; }
        }
        if (V == 6) {
            asm volatile("s_waitcnt vmcnt(0)" ::: "memory");
            if (fr == 0 && fq == 0) __hip_atomic_fetch_add((unsigned*)(ws_ + WS_CTL + CTL_CNT6) + 16 * u.pm, 1u, __ATOMIC_RELAXED, __HIP_MEMORY_SCOPE_AGENT);
        }
        if (FINAL) {
            asm volatile("s_waitcnt vmcnt(0)" ::: "memory");
            unsigned* cw = cnt + 64 * u.pm;
            if (fr == 0 && fq == 0) __hip_atomic_fetch_add(cw, 1u, __ATOMIC_RELAXED, __HIP_MEMORY_SCOPE_AGENT);
            { unsigned sp = 0; while ((unsigned)__builtin_amdgcn_readfirstlane(__hip_atomic_load(cw, __ATOMIC_RELAXED, __HIP_MEMORY_SCOPE_AGENT)) < 32u) { __builtin_amdgcn_s_sleep(2); if (++sp > (1u << 22)) break; } }
            f32x4 gf[2][2];
#pragma unroll
            for (int bj = 0; bj < 2; ++bj)
#pragma unroll
                for (int n = 0; n < 2; ++n) gf[bj][n] = *(const f32x4*)(gfin + col0 + bj * HALF + n * 4);
            float rr[2][4];
            {
                f32x4 pq[8];
#pragma unroll
                for (int i = 0; i < 8; ++i) { const float* pp = part + ((size_t)fq * RS_M + (row0 + (i >> 2) * HALF + (i & 3) * 16)) * 4;
                    asm volatile("global_load_dwordx4 %0, %1, off sc1" : "=v"(pq[i]) : "v"(pp) : "memory"); }
                asm volatile("s_waitcnt vmcnt(0)" : "+v"(pq[0]), "+v"(pq[1]), "+v"(pq[2]), "+v"(pq[3]), "+v"(pq[4]), "+v"(pq[5]), "+v"(pq[6]), "+v"(pq[7]) :: "memory");
#pragma unroll
                for (int i = 0; i < 8; ++i) { float t = (pq[i][0] + pq[i][1]) + (pq[i][2] + pq[i][3]); t = xor32_add(xor16_add(t)); rr[i >> 2][i & 3] = __builtin_amdgcn_rsqf(t * (1.0f / 1024.0f) + 1e-6f); }
            }
#pragma unroll
            for (int ai = 0; ai < 2; ++ai)
#pragma unroll
                for (int m = 0; m < 4; ++m) { const size_t off = (size_t)(row0 + ai * HALF + m * 16) * 1024 + col0;
#pragma unroll
                    for (int bj = 0; bj < 2; ++bj)
#pragma unroll
                        for (int n = 0; n < 2; ++n) *(f32x4*)(out + off + bj * HALF + n * 4) = acc[ai][bj][m][n] * rr[ai][m] * gf[bj][n]; }
        }
    }
};
template <int L> struct EpiSwiglu {
    static constexpr bool PERM = true, AFTER_DRAIN = false;
    ArgsP A; const PG8_LAS float* rtab; int pm0;
    __device__ __forceinline__ void operator()(const f32x4 (&acc)[2][2][4][2], const Unit& u, int wr, int wc, int fr_, int fq_) const {
        const int t_ = lane_id_v(); const int fr = t_ & 15, fq = (t_ >> 4) & 3; (void)fr_; (void)fq_;
        const int row0 = u.pm * BM + wr * 64 + fr, col0 = u.pn * HALF + wc * 32 + 8 * fq;
        ArgsP a_ = A; asm volatile("" : "+s"(a_)); unsigned char* ws_ = a_->ws; constexpr int ldh = FF;
        bf16_t* H = (bf16_t*)(ws_ + WS_H); const float* rowss = (const float*)(ws_ + WS_PART) + (size_t)(L ? 2 : 0) * 16 * RS_M; const float* bias = (const float*)(ws_ + WS_BIAS) + (size_t)L * 8 * 5632;
        const float* bp = bias + (size_t)(u.pm >> 4) * 5632 + u.pn * BM + wc * 32 + 8 * fq;
        f32x4 bv[2][2];
#pragma unroll
        for (int bj = 0; bj < 2; ++bj)
#pragma unroll
            for (int n = 0; n < 2; ++n) bv[bj][n] = *(const f32x4*)(bp + bj * HALF + 4 * n);
        float rr[2][4]; { const PG8_LAS float* rt = rtab + (u.pm == pm0 ? 0 : 256) + wr * 64 + fr; (void)rowss;
#pragma unroll
            for (int ai = 0; ai < 2; ++ai)
#pragma unroll
                for (int m = 0; m < 4; ++m) rr[ai][m] = rt[ai * HALF + m * 16]; }
#pragma unroll
        for (int ai = 0; ai < 2; ++ai)
#pragma unroll
            for (int m = 0; m < 4; ++m) { const int row = row0 + ai * HALF + m * 16; const float r = rr[ai][m]; f32x4 h[2];
#pragma unroll
                for (int n = 0; n < 2; ++n) { const f32x4 a = acc[ai][0][m][n] * r + bv[0][n], b = acc[ai][1][m][n] * r + bv[1][n]; h[n] = (f32x4){silu1(a[0]) * b[0], silu1(a[1]) * b[1], silu1(a[2]) * b[2], silu1(a[3]) * b[3]}; }
                *(u32x4*)(H + (size_t)row * ldh + col0) = pack8(h[0], h[1]); }
    }
};

struct EpiNull {
    static constexpr bool PERM = true, AFTER_DRAIN = false;
    bf16_t* D;
    __device__ __forceinline__ void operator()(const f32x4 (&acc)[2][2][4][2], const Unit& u, int wr, int wc, int fr_, int fq_) const {
        const int t_ = lane_id_v(); const int fr = t_ & 15, fq = (t_ >> 4) & 3; (void)fr_; (void)fq_;
        const int row0 = u.pm * BM + wr * 64 + fr, col0 = u.pn * BM + wc * 32 + 8 * fq;
#pragma unroll
        for (int ai = 0; ai < 2; ++ai)
#pragma unroll
            for (int m = 0; m < 4; ++m)
#pragma unroll
                for (int bj = 0; bj < 2; ++bj) *(u32x4*)(D + (size_t)(row0 + ai * HALF + m * 16) * 1024 + col0 + bj * HALF) = pack8(acc[ai][bj][m][0], acc[ai][bj][m][1]);
    }
};
struct EpiNullWide {
    static constexpr bool PERM = true, AFTER_DRAIN = false;
    bf16_t* D;
    __device__ __forceinline__ void operator()(const f32x4 (&acc)[2][2][4][2], const Unit& u, int wr, int wc, int fr_, int fq_) const {
        const int t_ = lane_id_v(); const int fr = t_ & 15, fq = (t_ >> 4) & 3; (void)fr_; (void)fq_;
        const int row0 = u.pm * BM + wr * 64 + fr, col0 = u.pn * HALF + wc * 32 + 8 * fq;
#pragma unroll
        for (int ai = 0; ai < 2; ++ai)
#pragma unroll
            for (int m = 0; m < 4; ++m) *(u32x4*)(D + (size_t)(row0 + ai * HALF + m * 16) * 2816 + col0) = pack8(acc[ai][0][m][0] + acc[ai][1][m][0], acc[ai][0][m][1] + acc[ai][1][m][1]);
    }
};
struct EpiZ {
    static constexpr bool PERM = true, AFTER_DRAIN = false;
    ArgsP A;
    __device__ __forceinline__ void operator()(const f32x4 (&acc)[2][2][4][2], const Unit& u, int wr, int wc, int fr_, int fq_) const {
        const int t_ = lane_id_v(); const int fr = t_ & 15, fq = (t_ >> 4) & 3; (void)fr_; (void)fq_;
        const int row0 = u.pm * BM + wr * 64 + fr, col0 = u.pn * BM + wc * 32 + 8 * fq;
        ArgsP a_ = A; asm volatile("" : "+s"(a_)); unsigned char* ws_ = a_->ws; bf16_t* Z = (bf16_t*)(ws_ + WS_AM);
#pragma unroll
        for (int ai = 0; ai < 2; ++ai)
#pragma unroll
            for (int m = 0; m < 4; ++m)
#pragma unroll
                for (int bj = 0; bj < 2; ++bj) *(u32x4*)(Z + (size_t)(row0 + ai * HALF + m * 16) * 1024 + col0 + bj * HALF) = pack8(acc[ai][bj][m][0], acc[ai][bj][m][1]);
    }
};

template <class Epi, class Sched, bool ALIGN_EPI = false, bool SP2 = false>
__device__ __forceinline__ void gemm_phase(PG8_LAS unsigned char* lds, const Gemm g, const Sched& S, const Epi& E, const int wave_s) {
    const int tid_ = wave_s * 64 + lane_id_v();
    const int tid = tid_, wid = wave_s, lane = tid & 63, wr = wid >> 2, wc = wid & 3, fr = lane & 15, fq = lane >> 4;
    const int K = g.K, nt = K / BK;
    unsigned voffA[2], voffB[2];
#pragma unroll
    for (int i = 0; i < 2; ++i) { int R, C; stage_rc(tid * 16 + i * 8192, R, C); const int Rb = Epi::PERM ? ((R & ~31) + perm32(R & 31)) : R;
        voffA[i] = (unsigned)(R * g.lda + C) * 2u; voffB[i] = (unsigned)(Rb * K + C) * 2u; }
    const size_t kstep = (size_t)(BK * 2);
    const size_t hsA = (size_t)HALF * g.lda * 2, hsB = (size_t)HALF * K * 2;
    const size_t tsA = 2 * hsA, tsB = 2 * hsB;
    const unsigned ldsw = (unsigned)wid * 1024u;
    const int aoff = lds_byte(wr * 64 + fr, fq * 8), boff = lds_byte(wc * 32 + fr, fq * 8);
#define PG8_SA(b, h) (((b) * 2 + (h)) * HTB)
#define PG8_SB(b, h) ((4 + (b) * 2 + (h)) * HTB)
#define PG8_STAGE(bufoff, gbase, voff) do { _Pragma("unroll") for (int _i = 0; _i < 2; ++_i) \
        __builtin_amdgcn_global_load_lds((const unsigned*)((const char*)(gbase) + (voff)[_i]), (PG8_LAS unsigned*)(lds + (bufoff) + ldsw + _i * 8192), 16, 0, 0); } while (0)
#define PG8_LDA(dst, b, h) do { _Pragma("unroll") for (int m = 0; m < 4; ++m) _Pragma("unroll") for (int k = 0; k < 2; ++k) dst[m][k] = *(const PG8_LAS bf16x8*)(lds + PG8_SA(b, h) + aoff + m * 2048 + k * 1024); } while (0)
#define PG8_LDB(dst, b, h) do { _Pragma("unroll") for (int n = 0; n < 2; ++n) _Pragma("unroll") for (int k = 0; k < 2; ++k) dst[n][k] = *(const PG8_LAS bf16x8*)(lds + PG8_SB(b, h) + boff + n * 2048 + k * 1024); } while (0)
#define PG8_MMA(ai, bj, At, Bt) do { __builtin_amdgcn_s_setprio(1); _Pragma("unroll") for (int m = 0; m < 4; ++m) _Pragma("unroll") for (int n = 0; n < 2; ++n) _Pragma("unroll") for (int k = 0; k < 2; ++k) \
        acc[ai][bj][m][n] = __builtin_amdgcn_mfma_f32_16x16x32_bf16(Bt[n][k], At[m][k], acc[ai][bj][m][n], 0, 0, 0); __builtin_amdgcn_s_setprio(0); } while (0)
#define PG8_WAIT_V(n) asm volatile("s_waitcnt vmcnt(" #n ")" ::: "memory")
#define PG8_WAIT_L(n) asm volatile("s_waitcnt lgkmcnt(" #n ")" ::: "memory")
#define PG8_BAR __builtin_amdgcn_s_barrier()
#define PG8_SCHED __builtin_amdgcn_sched_barrier(0)
    Unit cur, nxt; int ui = 0;
    if (!S.next(0, cur)) return;
    f32x4 acc[2][2][4][2];
#pragma unroll
    for (int a = 0; a < 2; ++a)
#pragma unroll
        for (int b = 0; b < 2; ++b)
#pragma unroll
            for (int m = 0; m < 4; ++m)
#pragma unroll
                for (int n = 0; n < 2; ++n) acc[a][b][m][n] = (f32x4){0.f, 0.f, 0.f, 0.f};
    bf16x8 At[4][2], B0[2][2], B1[2][2];
    const char* cA = (const char*)g.A + (size_t)cur.pm * tsA + (size_t)cur.pn * g.a_pn_bytes; const char* cB = (const char*)g.Bt + (size_t)cur.pn * tsB + (size_t)(cur.pm >> 4) * g.b_batch_bytes;
    S.a_ready(cur);
    if constexpr (SP2) {
        PG8_STAGE(PG8_SB(0, 0), cB, voffB); PG8_STAGE(PG8_SB(0, 1), cB + hsB, voffB); PG8_STAGE(PG8_SA(0, 0), cA, voffA); PG8_STAGE(PG8_SA(0, 1), cA + hsA, voffA);
        if (wr == 1) PG8_BAR;
        PG8_WAIT_V(2); PG8_BAR;
        PG8_STAGE(PG8_SB(1, 0), cB + kstep, voffB); PG8_STAGE(PG8_SA(1, 0), cA + kstep, voffA); PG8_STAGE(PG8_SB(1, 1), cB + hsB + kstep, voffB);
        PG8_WAIT_V(6); PG8_BAR;
    } else {
        PG8_STAGE(PG8_SB(0, 0), cB, voffB); PG8_STAGE(PG8_SA(0, 0), cA, voffA); PG8_STAGE(PG8_SB(0, 1), cB + hsB, voffB); PG8_STAGE(PG8_SA(0, 1), cA + hsA, voffA);
        if (wr == 1) PG8_BAR;
        PG8_WAIT_V(4); PG8_BAR;
        PG8_STAGE(PG8_SB(1, 0), cB + kstep, voffB); PG8_STAGE(PG8_SA(1, 0), cA + kstep, voffA); PG8_STAGE(PG8_SB(1, 1), cB + hsB + kstep, voffB);
        PG8_WAIT_V(6); PG8_BAR;
    }
    for (;;) {
        const bool has_next = S.next(ui + 1, nxt);
        const char* nA = has_next ? (const char*)g.A + (size_t)nxt.pm * tsA + (size_t)nxt.pn * g.a_pn_bytes : cA; const char* nB = has_next ? (const char*)g.Bt + (size_t)nxt.pn * tsB + (size_t)(nxt.pm >> 4) * g.b_batch_bytes : cB;
#pragma unroll 1
        for (int t = 0; t < nt; t += 2) {
            const bool last = (t == nt - 2);
            const char* a1 = cA + (size_t)(t + 1) * kstep;
            const char* a2 = last ? nA : cA + (size_t)(t + 2) * kstep; const char* b2 = last ? nB : cB + (size_t)(t + 2) * kstep;
            const char* a3 = a2 + kstep; const char* b3 = b2 + kstep;
            if (last && has_next) S.a_ready(nxt);
            if constexpr (SP2) {
            PG8_LDB(B0, 0, 0); PG8_LDB(B1, 0, 1); PG8_SCHED; PG8_LDA(At, 0, 0); PG8_STAGE(PG8_SA(1, 1), a1 + hsA, voffA);
            PG8_WAIT_V(8); PG8_WAIT_L(0); PG8_BAR; PG8_MMA(0, 0, At, B0); PG8_MMA(0, 1, At, B1); PG8_BAR; PG8_SCHED;
            PG8_LDA(At, 0, 1); PG8_STAGE(PG8_SB(0, 0), b2, voffB); PG8_STAGE(PG8_SB(0, 1), b2 + hsB, voffB); PG8_STAGE(PG8_SA(0, 0), a2, voffA);
            PG8_WAIT_V(8); PG8_WAIT_L(0); PG8_BAR; PG8_MMA(1, 0, At, B0); PG8_MMA(1, 1, At, B1); PG8_BAR; PG8_SCHED;
            PG8_LDB(B0, 1, 0); PG8_LDB(B1, 1, 1); PG8_SCHED; PG8_LDA(At, 1, 0); PG8_STAGE(PG8_SA(0, 1), a2 + hsA, voffA);
            PG8_WAIT_V(8); PG8_WAIT_L(0); PG8_BAR; PG8_MMA(0, 0, At, B0); PG8_MMA(0, 1, At, B1); PG8_BAR; PG8_SCHED;
            PG8_LDA(At, 1, 1); PG8_STAGE(PG8_SB(1, 0), b3, voffB); PG8_STAGE(PG8_SB(1, 1), b3 + hsB, voffB); PG8_STAGE(PG8_SA(1, 0), a3, voffA);
            PG8_WAIT_V(8); PG8_WAIT_L(0); PG8_BAR; PG8_MMA(1, 0, At, B0); PG8_MMA(1, 1, At, B1); PG8_BAR; PG8_SCHED;
            } else {
            PG8_LDB(B0, 0, 0); PG8_SCHED; PG8_LDA(At, 0, 0); PG8_STAGE(PG8_SA(1, 1), a1 + hsA, voffA);
            PG8_WAIT_L(8); PG8_BAR; PG8_WAIT_L(0); PG8_MMA(0, 0, At, B0); PG8_BAR; PG8_SCHED;
            PG8_LDB(B1, 0, 1); PG8_STAGE(PG8_SB(0, 0), b2, voffB);
            PG8_BAR; PG8_WAIT_L(0); PG8_MMA(0, 1, At, B1); PG8_BAR;
            PG8_LDA(At, 0, 1); PG8_STAGE(PG8_SA(0, 0), a2, voffA);
            PG8_BAR; PG8_WAIT_L(0); PG8_MMA(1, 0, At, B0); PG8_BAR; PG8_SCHED;
            PG8_STAGE(PG8_SB(0, 1), b2 + hsB, voffB);
            PG8_WAIT_V(6); PG8_BAR; PG8_MMA(1, 1, At, B1); PG8_BAR;
            PG8_LDB(B0, 1, 0); PG8_SCHED; PG8_LDA(At, 1, 0); PG8_STAGE(PG8_SA(0, 1), a2 + hsA, voffA);
            PG8_WAIT_L(8); PG8_BAR; PG8_WAIT_L(0); PG8_MMA(0, 0, At, B0); PG8_BAR; PG8_SCHED;
            PG8_LDB(B1, 1, 1); PG8_STAGE(PG8_SB(1, 0), b3, voffB);
            PG8_BAR; PG8_WAIT_L(0); PG8_MMA(0, 1, At, B1); PG8_BAR;
            PG8_LDA(At, 1, 1); PG8_STAGE(PG8_SA(1, 0), a3, voffA);
            PG8_BAR; PG8_WAIT_L(0); PG8_MMA(1, 0, At, B0); PG8_BAR; PG8_SCHED;
            PG8_STAGE(PG8_SB(1, 1), b3 + hsB, voffB);
            PG8_WAIT_V(6); PG8_BAR; PG8_MMA(1, 1, At, B1); PG8_BAR;
            }
        }
        if constexpr (ALIGN_EPI) { if (wr == 0) PG8_BAR; }
        if constexpr (!Epi::AFTER_DRAIN) { E(acc, cur, wr, wc, fr, fq); S.done(cur); }
        if (!has_next) break;
#pragma unroll
        for (int a = 0; a < 2; ++a)
#pragma unroll
            for (int b = 0; b < 2; ++b)
#pragma unroll
                for (int m = 0; m < 4; ++m)
#pragma unroll
                    for (int n = 0; n < 2; ++n) acc[a][b][m][n] = (f32x4){0.f, 0.f, 0.f, 0.f};
        cur = nxt; cA = nA; cB = nB; ++ui;
        if constexpr (ALIGN_EPI) { if (wr == 1) PG8_BAR; }
    }
    PG8_WAIT_V(0);
    if constexpr (!ALIGN_EPI) { if (wr == 0) PG8_BAR; }
    PG8_BAR;
    if constexpr (Epi::AFTER_DRAIN) { E.fused(acc, cur, wr, wc, fr, fq, lds, wid, lane); S.done(cur); }
#undef PG8_SA
#undef PG8_SB
#undef PG8_STAGE
#undef PG8_LDA
#undef PG8_LDB
#undef PG8_MMA
#undef PG8_WAIT_V
#undef PG8_WAIT_L
#undef PG8_BAR
#undef PG8_SCHED
}
}
namespace attn_body {
using bf16=__hip_bfloat16;
using bf16x8=__attribute__((ext_vector_type(8)))short;
using s16x4=__attribute__((ext_vector_type(4)))short;
using f32x16=__attribute__((ext_vector_type(16)))float;
using u32x4=__attribute__((ext_vector_type(4)))unsigned;
constexpr int BATCH=8,NHEAD=8,NKVH=2,SEQ=4096,SKV=4352,D=64,QP=512,KP=128,OP=1024;
constexpr int NW=8,QBLK=32,QB=QBLK*NW,KVBLK=64,NQB=SEQ/QB;
constexpr int ATTN_UNIT_ROWS=QB;
__device__ __forceinline__ int crow(int r,int hi){return (r&3)+8*(r>>2)+4*hi;}
#define SBAR() __builtin_amdgcn_sched_barrier(0)
constexpr int NSLOT=3, SLOTB=8192;
constexpr int LDS_K=0, LDS_V=NSLOT*SLOTB, LDS_WS=2*NSLOT*SLOTB, LDS_OST=LDS_WS+NW*64*4, LDS_BYTES=LDS_OST+NW*4096;
constexpr float C2=0.125f*1.4426950408889634f;
__device__ __forceinline__ void glds16(const void*gsrc,unsigned lds_dst){unsigned keep;
  asm volatile("s_mov_b32 %0, m0\n\ts_mov_b32 m0, %2\n\ts_nop 0\n\tglobal_load_lds_dwordx4 %1, off\n\ts_mov_b32 m0, %0":"=&s"(keep):"v"(gsrc),"s"(lds_dst):"memory");}
__device__ __forceinline__ void glds16_nt(const void*gsrc,unsigned lds_dst){unsigned keep;
  asm volatile("s_mov_b32 %0, m0\n\ts_mov_b32 m0, %2\n\ts_nop 0\n\tglobal_load_lds_dwordx4 %1, off nt\n\ts_mov_b32 m0, %0":"=&s"(keep):"v"(gsrc),"s"(lds_dst):"memory");}
__device__ __forceinline__ float max3f(float a,float b,float c){float r;asm("v_max3_f32 %0, %1, %2, %3":"=v"(r):"v"(a),"v"(b),"v"(c));return r;}
__device__ __forceinline__ float max2f(float a,float b){float r;asm("v_max_f32_e32 %0, %1, %2":"=v"(r):"v"(a),"v"(b));return r;}
__device__ __forceinline__ float fadd_s(float a,float b){float r;asm("v_add_f32_e32 %0, %1, %2":"=v"(r):"v"(a),"v"(b));return r;}
__device__ __forceinline__ float fsub_s(float a,float b){float r;asm("v_sub_f32_e32 %0, %1, %2":"=v"(r):"v"(a),"v"(b));return r;}
typedef float f32x2_t __attribute__((ext_vector_type(2))); typedef __bf16 bf16x2_t __attribute__((ext_vector_type(2)));
__device__ __forceinline__ unsigned cvtpk_s(float lo,float hi){f32x2_t v={lo,hi};bf16x2_t b=__builtin_convertvector(v,bf16x2_t);return __builtin_bit_cast(unsigned,b);}
#define WAIT_BAR(N) asm volatile("s_waitcnt vmcnt(" #N ") lgkmcnt(0)\n\ts_barrier":::"memory")

__device__ __forceinline__ void qkt(f32x16&p0,f32x16&p1,const char*Kslot,const bf16x8*qr,const f32x16&negm,int r32,int hi){
  const char*kb=Kslot+hi*1024+r32*16;
  #pragma unroll
  for(int d0=0;d0<4;++d0){
    const bf16x8 b0=*reinterpret_cast<const bf16x8*>(kb+d0*2048);
    const bf16x8 b1=*reinterpret_cast<const bf16x8*>(kb+d0*2048+512);
    if(d0==0){p0=__builtin_amdgcn_mfma_f32_32x32x16_bf16(b0,qr[0],negm,0,0,0);p1=__builtin_amdgcn_mfma_f32_32x32x16_bf16(b1,qr[0],negm,0,0,0);}
    else{p0=__builtin_amdgcn_mfma_f32_32x32x16_bf16(b0,qr[d0],p0,0,0,0);p1=__builtin_amdgcn_mfma_f32_32x32x16_bf16(b1,qr[d0],p1,0,0,0);}}
}
typedef __attribute__((address_space(3))) const char* lds_cptr;
typedef short v4i16_t __attribute__((ext_vector_type(4)));
__device__ __forceinline__ void kload8(bf16x8*kf,lds_cptr kp){
  kf[0]=*(const __attribute__((address_space(3))) bf16x8*)(kp);      kf[1]=*(const __attribute__((address_space(3))) bf16x8*)(kp+512);
  kf[2]=*(const __attribute__((address_space(3))) bf16x8*)(kp+2048); kf[3]=*(const __attribute__((address_space(3))) bf16x8*)(kp+2560);
  kf[4]=*(const __attribute__((address_space(3))) bf16x8*)(kp+4096); kf[5]=*(const __attribute__((address_space(3))) bf16x8*)(kp+4608);
  kf[6]=*(const __attribute__((address_space(3))) bf16x8*)(kp+6144); kf[7]=*(const __attribute__((address_space(3))) bf16x8*)(kp+6656);
}
__device__ __forceinline__ void kload2(bf16x8*kf,lds_cptr kp,int j){ kf[2*j]=*(const __attribute__((address_space(3))) bf16x8*)(kp+j*2048); kf[2*j+1]=*(const __attribute__((address_space(3))) bf16x8*)(kp+j*2048+512); }
__device__ __forceinline__ s16x4 vtr(lds_cptr p){ return __builtin_bit_cast(s16x4,__builtin_amdgcn_ds_read_tr16_b64_v4i16((__attribute__((address_space(3))) v4i16_t*)p)); }
__device__ __forceinline__ float rowmax(const f32x16&p0,const f32x16&p1){
  float a=max3f(p0[0],p0[1],p1[0]),b=max3f(p0[2],p0[3],p1[1]);a=max3f(a,p1[2],p1[3]);
  #pragma unroll
  for(int r=4;r<16;r+=4){a=max3f(a,p0[r],p0[r+1]);b=max3f(b,p0[r+2],p0[r+3]);a=max3f(a,p1[r],p1[r+1]);b=max3f(b,p1[r+2],p1[r+3]);}
  const float m=max2f(a,b);
  auto rr=__builtin_amdgcn_permlane32_swap(__float_as_uint(m),__float_as_uint(m),false,false);
  return max2f(__uint_as_float(rr[0]),__uint_as_float(rr[1]));
}
__device__ __forceinline__ void pv(f32x16*o,int vb,bf16x8 pa0,bf16x8 pa1,bf16x8 pa2,bf16x8 pa3){
  #pragma unroll
  for(int d0=0;d0<2;++d0){s16x4 lo[4],hi[4];
    #pragma unroll
    for(int ks=0;ks<4;++ks){
      asm volatile("ds_read_b64_tr_b16 %0,%1 offset:%c2":"=&v"(lo[ks]):"v"(vb),"i"(d0*4096+ks*1024):"memory");
      asm volatile("ds_read_b64_tr_b16 %0,%1 offset:%c2":"=&v"(hi[ks]):"v"(vb),"i"(d0*4096+ks*1024+512):"memory");}
    asm volatile("s_waitcnt lgkmcnt(0)":::"memory");SBAR();
    #define PK(k) (bf16x8){lo[k][0],lo[k][1],lo[k][2],lo[k][3],hi[k][0],hi[k][1],hi[k][2],hi[k][3]}
    o[d0]=__builtin_amdgcn_mfma_f32_32x32x16_bf16(pa0,PK(0),o[d0],0,0,0);
    o[d0]=__builtin_amdgcn_mfma_f32_32x32x16_bf16(pa1,PK(1),o[d0],0,0,0);
    o[d0]=__builtin_amdgcn_mfma_f32_32x32x16_bf16(pa2,PK(2),o[d0],0,0,0);
    o[d0]=__builtin_amdgcn_mfma_f32_32x32x16_bf16(pa3,PK(3),o[d0],0,0,0);
    #undef PK
  }
}

#ifndef ATTN_STORE16
#define ATTN_STORE16(p,v) (*(u32x4*)(p)=(v))
#endif
template<int THRL,bool FIX> __device__ __forceinline__ void attn_unit(int b,int h,int qb,const bf16*Q,const bf16*__restrict__ K,const bf16*__restrict__ V,bf16*O,char*shm,float sref,const int wave_s){
  const int tid_=wave_s*64+lane_id_v(); const int tid=tid_,lane=tid&63,r32=lane&31,hi=lane>>5; const int wid=wave_s;
  const long rowbase=(long)b*SEQ, kvbase=(long)b*SKV; const int q0=qb*QB;
  const bf16*Qw=Q+(rowbase+q0+wid*QBLK)*QP+h*D;
  const bf16*Kh=K+kvbase*KP+(h/(NHEAD/NKVH))*D,*Vh=V+kvbase*KP+(h/(NHEAD/NKVH))*D;
  const unsigned lds0=(unsigned)(uintptr_t)shm;
  float*wsf=(float*)(shm+LDS_WS)+wid*64;
  const bf16*ksrc=Kh+(long)lane*KP+wid*8;
  const bf16*vsrc=Vh+(long)(16*(wid&3)+(lane>>2))*KP+(wid>>2)*32+(lane&3)*8;
  const unsigned kdst=lds0+LDS_K+wid*1024, vdst=lds0+LDS_V+wid*1024;
  #define DMA_K(t,slot) glds16(ksrc+(long)(t)*KVBLK*KP,(unsigned)__builtin_amdgcn_readfirstlane(kdst+(slot)))
  #define DMA_V(t,slot) glds16(vsrc+(long)(t)*KVBLK*KP,(unsigned)__builtin_amdgcn_readfirstlane(vdst+(slot)))
  const int vb0=(int)(lds0+LDS_V)+((lane>>4)&1)*32+(lane&3)*8+(4*hi+((lane&15)>>2))*64;
  const char*Kbase=shm+LDS_K; bf16x8 kf[8];
  const lds_cptr shm3=(lds_cptr)shm; const lds_cptr kp0=shm3+LDS_K+hi*1024+r32*16; const lds_cptr vp0=shm3+LDS_V+((lane>>4)&1)*32+(lane&3)*8+(4*hi+((lane&15)>>2))*64;
  constexpr int NT=SKV/KVBLK;
  DMA_K(0,0);DMA_V(0,0);DMA_K(1,SLOTB);
  bf16x8 qr[4];
  #pragma unroll
  for(int d0=0;d0<4;++d0)qr[d0]=__builtin_nontemporal_load(reinterpret_cast<const bf16x8*>(&Qw[(long)r32*QP+d0*16+hi*8]));
  float mhat=0.f,l_reg=0.f;f32x16 o[2];o[0]=f32x16{};o[1]=f32x16{};f32x16 negm=f32x16{};
  if constexpr(FIX){ _Pragma("unroll") for(int r=0;r<16;++r)negm[r]=-sref; }
  asm volatile("":"+v"(negm));
  #define CMASK(P0,P1,t) do{}while(0)
  bool resc=false;
  #define START(P0,P1) do{ resc=false; if constexpr(!FIX) \
    { const float rm=rowmax(P0,P1); const float dl=rm; mhat=fadd_s(mhat,dl); \
      _Pragma("unroll") for(int r=0;r<16;++r){P0[r]=fsub_s(P0[r],dl);P1[r]=fsub_s(P1[r],dl);} \
      _Pragma("unroll") for(int r=0;r<16;++r)negm[r]=-mhat; asm volatile("":"+v"(negm)); } \
    _Pragma("unroll") for(int r=0;r<16;++r)P0[r]=__builtin_amdgcn_exp2f(P0[r]); }while(0)
  #define RESC() do{ if constexpr(!FIX) if(resc){ asm volatile("s_waitcnt lgkmcnt(0)":::"memory"); \
      _Pragma("unroll") for(int d_=0;d_<2;++d_) _Pragma("unroll") for(int r=0;r<16;++r)o[d_][r]*=wsf[crow(r,hi)]; } }while(0)
  f32x16 pA0,pA1,pB0,pB1;
  int sl_prev=0,sl_cur=0,sl_next=SLOTB;
  #define ROT() do{sl_prev=sl_cur;sl_cur=sl_next;sl_next=(sl_next==(NSLOT-1)*SLOTB)?0:sl_next+SLOTB;}while(0)
  DMA_K(2,2*SLOTB);
  WAIT_BAR(3);
  qkt(pA0,pA1,Kbase,qr,negm,r32,hi);asm volatile("s_nop 15\n\ts_nop 7":"+v"(pA0),"+v"(pA1));CMASK(pA0,pA1,0);
  START(pA0,pA1);
  _Pragma("unroll") for(int r=0;r<16;++r)pA1[r]=__builtin_amdgcn_exp2f(pA1[r]);
  WAIT_BAR(0);
  DMA_K(3,0);DMA_V(1,SLOTB);
  ROT();
  kload8(kf,kp0+sl_cur);
  WAIT_BAR(2);
  s16x4 vlo[8],vhi[8]; u32x4 pw0,pw1,pw2,pw3;
  #define PKW(P,B) cvtpk_s(P[B],P[B+1])
  #define PAF(k) __builtin_bit_cast(bf16x8,pw##k)
  #define VFR(i) (bf16x8){vlo[i][0],vlo[i][1],vlo[i][2],vlo[i][3],vhi[i][0],vhi[i][1],vhi[i][2],vhi[i][3]}
  #define PIN(x) asm volatile("":"+v"(x))
  #define MX3(a,b,c) __builtin_fmaxf(__builtin_fmaxf((a),(b)),(c))
  #define GAPA(MF,A0,A1,A2,A3,W0,W1,PW) do{ MF; sacc+=A0; sacc+=A1; sacc+=A2; sacc+=A3; PIN(sacc); W0; W1; PIN(PW); SBAR(); }while(0)
  #define EX(v) __builtin_amdgcn_exp2f(v)
  #define GAPB(MF,X,B) do{ MF; X[B]=EX(X[B]); X[B+1]=EX(X[B+1]); X[B+2]=EX(X[B+2]); X[B+3]=EX(X[B+3]); PIN(X); SBAR(); }while(0)
  #define VRD(i) do{ vlo[i]=vtr(vp_+(((i)>>2)*4096+((i)&3)*1024)); vhi[i]=vtr(vp_+(((i)>>2)*4096+((i)&3)*1024+512)); }while(0)
  #define KRD(G,j) do{ if(G){ kload2(kf,kp0+sl_next,j); SBAR(); } }while(0)
  #define STEP(C0,C1,P0,P1,t,GK,GV,GL) do{ SBAR(); \
    const lds_cptr vp_=vp0+sl_prev; \
    VRD(0); SBAR(); float sacc=(P0[0]+P0[1]); \
    GAPA(C0=__builtin_amdgcn_mfma_f32_32x32x16_bf16(kf[0],qr[0],negm,0,0,0), P0[2],P0[3],P0[4],P0[5],     pw0[0]=PKW(P0,0), pw0[1]=PKW(P0,2), pw0); \
    VRD(4); SBAR(); GAPA(C1=__builtin_amdgcn_mfma_f32_32x32x16_bf16(kf[1],qr[0],negm,0,0,0), P0[6],P0[7],P0[8],P0[9],     pw0[2]=PKW(P0,4), pw0[3]=PKW(P0,6), pw0); \
    VRD(1); SBAR(); GAPA(C0=__builtin_amdgcn_mfma_f32_32x32x16_bf16(kf[2],qr[1],C0,0,0,0),   P0[10],P0[11],P0[12],P0[13], pw1[0]=PKW(P0,8), pw1[1]=PKW(P0,10), pw1); \
    VRD(5); SBAR(); GAPA(C1=__builtin_amdgcn_mfma_f32_32x32x16_bf16(kf[3],qr[1],C1,0,0,0),   P0[14],P0[15],P1[0],P1[1],   pw1[2]=PKW(P0,12),pw1[3]=PKW(P0,14), pw1); \
    VRD(2); SBAR(); GAPA(C0=__builtin_amdgcn_mfma_f32_32x32x16_bf16(kf[4],qr[2],C0,0,0,0),   P1[2],P1[3],P1[4],P1[5],     pw2[0]=PKW(P1,0), pw2[1]=PKW(P1,2), pw2); \
    VRD(6); SBAR(); GAPA(C1=__builtin_amdgcn_mfma_f32_32x32x16_bf16(kf[5],qr[2],C1,0,0,0),   P1[6],P1[7],P1[8],P1[9],     pw2[2]=PKW(P1,4), pw2[3]=PKW(P1,6), pw2); \
    VRD(3); SBAR(); GAPA(C0=__builtin_amdgcn_mfma_f32_32x32x16_bf16(kf[6],qr[3],C0,0,0,0),   P1[10],P1[11],P1[12],P1[13], pw3[0]=PKW(P1,8), pw3[1]=PKW(P1,10), pw3); \
    VRD(7); SBAR(); GAPA(C1=__builtin_amdgcn_mfma_f32_32x32x16_bf16(kf[7],qr[3],C1,0,0,0),   P1[14],P1[15],0.f,0.f,       pw3[2]=PKW(P1,12),pw3[3]=PKW(P1,14), pw3); \
    l_reg+=sacc; \
    if(GK){DMA_K((t)+3,sl_cur);} if(GV){DMA_V((t)+1,sl_next);} \
    CMASK(C0,C1,t); \
    if constexpr(!FIX) { float a=MX3(C0[0],C0[1],C1[0]),b=MX3(C0[2],C0[3],C1[1]); a=MX3(a,C1[2],C1[3]); \
      _Pragma("unroll") for(int r=4;r<16;r+=4){a=MX3(a,C0[r],C0[r+1]);b=MX3(b,C0[r+2],C0[r+3]);a=MX3(a,C1[r],C1[r+1]);b=MX3(b,C1[r+2],C1[r+3]);} \
      float rm=__builtin_fmaxf(a,b); { auto rr=__builtin_amdgcn_permlane32_swap(__float_as_uint(rm),__float_as_uint(rm),false,false); rm=__builtin_fmaxf(__uint_as_float(rr[0]),__uint_as_float(rr[1])); } \
      resc=false; \
      if(__builtin_expect(__any(rm>(float)THRL),0)){ const float dl=__builtin_fmaxf(rm,0.f); mhat+=dl; \
        _Pragma("unroll") for(int r=0;r<16;++r){C0[r]-=dl;C1[r]-=dl;} \
        _Pragma("unroll") for(int r=0;r<16;++r)negm[r]=-mhat; asm volatile("":"+v"(negm)); \
        const float f=__builtin_amdgcn_exp2f(-dl); l_reg*=f; if(hi==0)wsf[r32]=f; resc=true; } } \
    SBAR(); \
    GAPB(o[0]=__builtin_amdgcn_mfma_f32_32x32x16_bf16(PAF(0),VFR(0),o[0],0,0,0), C0,0); \
    GAPB(o[1]=__builtin_amdgcn_mfma_f32_32x32x16_bf16(PAF(0),VFR(4),o[1],0,0,0), C0,4); \
    KRD(GL,0); GAPB(o[0]=__builtin_amdgcn_mfma_f32_32x32x16_bf16(PAF(1),VFR(1),o[0],0,0,0), C0,8); \
    KRD(GL,1); GAPB(o[1]=__builtin_amdgcn_mfma_f32_32x32x16_bf16(PAF(1),VFR(5),o[1],0,0,0), C0,12); \
    KRD(GL,2); GAPB(o[0]=__builtin_amdgcn_mfma_f32_32x32x16_bf16(PAF(2),VFR(2),o[0],0,0,0), C1,0); \
    KRD(GL,3); GAPB(o[1]=__builtin_amdgcn_mfma_f32_32x32x16_bf16(PAF(2),VFR(6),o[1],0,0,0), C1,4); \
    GAPB(o[0]=__builtin_amdgcn_mfma_f32_32x32x16_bf16(PAF(3),VFR(3),o[0],0,0,0), C1,8); \
    GAPB(o[1]=__builtin_amdgcn_mfma_f32_32x32x16_bf16(PAF(3),VFR(7),o[1],0,0,0), C1,12); \
    }while(0)
  int t=1;
  #undef CMASK
  #define CMASK(P0,P1,t) do{}while(0)
  for(;t+5<NT;t+=2){
    STEP(pB0,pB1,pA0,pA1,t,true,true,true);     WAIT_BAR(2); RESC(); ROT();
    STEP(pA0,pA1,pB0,pB1,t+1,true,true,true);   WAIT_BAR(2); RESC(); ROT();
  }
  #undef CMASK
  #define CMASK(P0,P1,t) do{}while(0)
  #define ENDW(tt) do{ if((tt)+3<NT){WAIT_BAR(2);} else if((tt)+2<NT){WAIT_BAR(1);} else {WAIT_BAR(0);} }while(0)
  for(;t+1<NT;t+=2){
    STEP(pB0,pB1,pA0,pA1,t,(t+3<NT),(t+1<NT),(t+1<NT));       ENDW(t);   RESC(); ROT();
    STEP(pA0,pA1,pB0,pB1,t+1,(t+4<NT),(t+2<NT),(t+2<NT));     ENDW(t+1); RESC(); ROT();
  }
  STEP(pB0,pB1,pA0,pA1,NT-1,false,false,false); RESC();
  { float sacc=pB0[0]+pB0[1]; _Pragma("unroll") for(int r=2;r<16;++r)sacc+=pB0[r]; _Pragma("unroll") for(int r=0;r<16;++r)sacc+=pB1[r]; l_reg+=sacc;
    pw0=(u32x4){PKW(pB0,0),PKW(pB0,2),PKW(pB0,4),PKW(pB0,6)};pw1=(u32x4){PKW(pB0,8),PKW(pB0,10),PKW(pB0,12),PKW(pB0,14)};pw2=(u32x4){PKW(pB1,0),PKW(pB1,2),PKW(pB1,4),PKW(pB1,6)};pw3=(u32x4){PKW(pB1,8),PKW(pB1,10),PKW(pB1,12),PKW(pB1,14)};
    SBAR(); pv(o,vb0+sl_cur,PAF(0),PAF(1),PAF(2),PAF(3)); }
  #undef PKW
  #undef PAF
  #undef VFR
  #undef PIN
  #undef MX3
  #undef GAPA
  #undef GAPB
  #undef EX
  #undef VRD
  #undef KRD
  #undef STEP
  #undef ENDW
  {auto rr=__builtin_amdgcn_permlane32_swap(__float_as_uint(l_reg),__float_as_uint(l_reg),false,false);l_reg=__uint_as_float(rr[0])+__uint_as_float(rr[1]);}
  if(hi==0)wsf[32+r32]=l_reg;asm volatile("s_waitcnt lgkmcnt(0)":::"memory");
  float rli[16];
  #pragma unroll
  for(int r=0;r<16;++r)rli[r]=__builtin_amdgcn_rcpf(wsf[32+crow(r,hi)]);
  bf16*Ow=O+(rowbase+q0+wid*QBLK)*OP+h*D;
  { bf16*stg=(bf16*)(shm+LDS_OST)+wid*2048;
    #pragma unroll
    for(int r=0;r<16;++r){const int orow=crow(r,hi);
      #pragma unroll
      for(int d0=0;d0<2;++d0)stg[orow*64+d0*32+r32]=__float2bfloat16(o[d0][r]*rli[r]);}
    asm volatile("s_waitcnt lgkmcnt(0)":::"memory");
    #pragma unroll
    for(int i=0;i<4;++i){const int row=i*8+(lane>>3),ch=lane&7; const u32x4 v=*(const u32x4*)(stg+row*64+ch*8); ATTN_STORE16(Ow+(long)row*OP+ch*8,v);} }
  asm volatile("s_waitcnt lgkmcnt(0)\n\ts_barrier":::"memory");
  #undef DMA_K
  #undef DMA_V
  #undef CMASK
  #undef START
  #undef RESC
  #undef ROT
}
constexpr int ATTN_LDS_BYTES=LDS_BYTES;
struct AttnTensors { const bf16* Q; const bf16* K; const bf16* V; bf16* O; };
struct AttnUnit { int bh; int qb; };
struct StaticOrder {
  int vcu,G;
  __device__ __forceinline__ explicit StaticOrder(int grid,int v):vcu(v),G(grid){}
  __device__ __forceinline__ bool next(int i,AttnUnit&u)const{ const int per=(BATCH*NHEAD*NQB)/G; if(i>=per)return false; const int x=vcu*per+i; u.bh=(x>>6)*4+((x&63)>>4); u.qb=x&15; return true; }
  __device__ __forceinline__ void a_ready(const AttnUnit&)const{}
  __device__ __forceinline__ void done(const AttnUnit&)const{}
};
template<class Sched,int THRL=8> __device__ __forceinline__ void attn_phase(char*lds,const AttnTensors&T,const Sched&S,const float*qnw,const float*knw,const int wave_s){
  AttnUnit u;
  const int l64_=lane_id_v(); float mq=__builtin_fabsf(qnw[l64_]),mk=__builtin_fabsf(knw[l64_]);
  _Pragma("unroll") for(int o_=1;o_<64;o_<<=1){ mq=__builtin_fmaxf(mq,__shfl_xor(mq,o_)); mk=__builtin_fmaxf(mk,__shfl_xor(mk,o_)); }
  const float sref=C2*64.0f*1.02f*mq*mk;
  const bool fix=__builtin_amdgcn_readfirstlane((int)(sref<=40.0f && sref==sref))!=0;
  if(fix){ for(int i=0;S.next(i,u);++i){ S.a_ready(u); attn_unit<THRL,true>(u.bh/NHEAD,u.bh%NHEAD,u.qb,T.Q,T.K,T.V,T.O,lds,sref,wave_s); S.done(u); } }
  else   { for(int i=0;S.next(i,u);++i){ S.a_ready(u); attn_unit<THRL,false>(u.bh/NHEAD,u.bh%NHEAD,u.qb,T.Q,T.K,T.V,T.O,lds,0.f,wave_s); S.done(u); } }
}
#undef SBAR
#undef WAIT_BAR
}
#ifndef PG8_SP2
#define PG8_SP2 true
#endif
#ifndef PG8_ALIGN
#define PG8_ALIGN true
#endif
#define GAS __attribute__((address_space(1)))
#define LAS __attribute__((address_space(3)))
typedef unsigned short bf16;
typedef unsigned v4u __attribute__((ext_vector_type(4)));
typedef unsigned v2u __attribute__((ext_vector_type(2)));
typedef float f32x4 __attribute__((ext_vector_type(4)));
typedef float f32x2 __attribute__((ext_vector_type(2)));
typedef short bf16x8 __attribute__((ext_vector_type(8)));
typedef GAS unsigned gu32;
typedef GAS unsigned long long gu64;
#define RLX_AGENT __ATOMIC_RELAXED, __HIP_MEMORY_SCOPE_AGENT
#define LDS_WAIT() asm volatile("s_waitcnt lgkmcnt(0)" ::: "memory")
#define VM_WAIT() asm volatile("s_waitcnt vmcnt(0)" ::: "memory")
__device__ __forceinline__ unsigned f2bf(float f) { unsigned u = __builtin_bit_cast(unsigned, f); return (u + 0x7fffu + ((u >> 16) & 1u)) >> 16; }
__device__ __forceinline__ unsigned pk2(float lo, float hi) { unsigned r; asm("v_cvt_pk_bf16_f32 %0, %1, %2" : "=v"(r) : "v"(lo), "v"(hi)); return r; }
__device__ __forceinline__ float bf2f(unsigned h) { return __builtin_bit_cast(float, h << 16); }

#define XB_TMO      128
#define XB_XCNT(j)  (256  + 64 * (j))
#define XB_XSUB(j)  (1280 + 64 * (j))
#define XB_XGEN(j)  (2304 + 64 * (j))
#define XB_TOP      3328
#define XB_TOPGEN   3392
#define XCD_BAR_WORDS 3456
#define XB_SPIN_CAP (1u << 18)

__device__ __forceinline__ unsigned xb_ld(unsigned* p)              { return __hip_atomic_load(p, __ATOMIC_RELAXED, __HIP_MEMORY_SCOPE_AGENT); }
__device__ __forceinline__ unsigned xb_add(unsigned* p, unsigned v) { return __hip_atomic_fetch_add(p, v, __ATOMIC_RELAXED, __HIP_MEMORY_SCOPE_AGENT); }
__device__ __forceinline__ unsigned xb_xcc_id() { return (unsigned)__builtin_amdgcn_s_getreg((3 << 11) | 20) & 0xFu; }
#define XB_SPIN(cond, bar) do { unsigned _sp = 0; while (cond) { __builtin_amdgcn_s_sleep(1); \
    if ((++_sp & 255u) == 0u) { if (xb_ld(&(bar)[XB_TMO])) break; if (_sp > XB_SPIN_CAP) { atomicAdd(&(bar)[XB_TMO], 1u); break; } } } } while (0)

struct XcdBarrier {
    unsigned* bar; unsigned x;
    bool w0;
    volatile LAS unsigned* st;
};

__device__ __forceinline__ XcdBarrier xcd_barrier_post(unsigned* bar, volatile LAS unsigned* st) {
    XcdBarrier b; b.bar = bar; b.x = xb_xcc_id(); b.st = st; b.w0 = false;
    if (threadIdx.x == 0) (void)xb_add(&bar[XB_XCNT(b.x)], 1u);
    return b;
}
__device__ __forceinline__ void xcd_barrier_complete(unsigned* bar, unsigned x, unsigned& nloc, unsigned& nx) {
    const unsigned G = gridDim.x * gridDim.y * gridDim.z;
    unsigned sum, cnt, mine, sp = 0u;
    for (;;) {
        sum = 0u; cnt = 0u; mine = 0u;
#pragma unroll
        for (unsigned j = 0; j < 16; ++j) { const unsigned c = xb_ld(&bar[XB_XCNT(j)]); sum += c; cnt += (c > 0u) ? 1u : 0u; mine = (j == x) ? c : mine; }
        if (sum == G) break;
        __builtin_amdgcn_s_sleep(1);
        if ((++sp & 255u) == 0u) { if (xb_ld(&bar[XB_TMO])) break; if (sp > XB_SPIN_CAP) { atomicAdd(&bar[XB_TMO], 1u); break; } }
    }
    nloc = mine > 0u ? mine : 1u; nx = cnt > 0u ? cnt : 1u;
}

__device__ __forceinline__ void xcd_barrier(const XcdBarrier& b) {
    asm volatile("s_waitcnt vmcnt(0)" ::: "memory");
    __syncthreads();
    if (b.w0 && lane_id_v() == 0) {
        unsigned* bar = b.bar;
        __builtin_amdgcn_s_waitcnt(0);
        unsigned nloc = b.st[0], nx = b.st[1];
        if (nloc == 0u) { xcd_barrier_complete(bar, b.x, nloc, nx); b.st[0] = nloc; b.st[1] = nx; }
        const unsigned old = xb_add(&bar[XB_XSUB(b.x)], 1u);
        const unsigned gen = old / nloc;
        if (old + 1u == (gen + 1u) * nloc) {
            __builtin_amdgcn_fence(__ATOMIC_RELEASE, "agent");
            asm volatile("s_waitcnt vmcnt(0)" ::: "memory");
            const unsigned og = xb_add(&bar[XB_TOP], 1u);
            const unsigned tg = og / nx;
            if (og + 1u == (tg + 1u) * nx) xb_add(&bar[XB_TOPGEN], 1u);
            else XB_SPIN(xb_ld(&bar[XB_TOPGEN]) == tg, bar);
            __builtin_amdgcn_fence(__ATOMIC_ACQUIRE, "agent");
            xb_add(&bar[XB_XGEN(b.x)], 1u);
            asm volatile("s_waitcnt vmcnt(0)" ::: "memory");
        } else {
            XB_SPIN(xb_ld(&bar[XB_XGEN(b.x)]) == gen, bar);
            __builtin_amdgcn_fence(__ATOMIC_ACQUIRE, "agent");
            asm volatile("s_waitcnt vmcnt(0)" ::: "memory");
        }
    }
    __syncthreads();
}
struct Frame {
    LAS unsigned char* lds;
    volatile LAS unsigned* MISC;
    gu32* ctl;
    int tid, lane, wave;
    int vcu, G;
};
__device__ __forceinline__ float wave_sum(float v) { return wave_sum64(v); }
__device__ __forceinline__ void p0_transpose_item(const float* W, int ldw, int k0, int n0, bf16* WT, int ldt, int dst_row0, LAS float* scr, int lane) {
#pragma unroll 8
    for (int i = 0; i < 32; ++i) { const int kk = 2 * i + (lane >> 5); scr[kk * 33 + (lane & 31)] = __builtin_nontemporal_load(W + (size_t)(k0 + kk) * ldw + n0 + (lane & 31)); }
    LDS_WAIT(); asm volatile("" ::: "memory");
    const int c = lane & 7;
#pragma unroll
    for (int j = 0; j < 4; ++j) { const int n = (lane >> 3) + 8 * j; const LAS float* s = scr + (8 * c) * 33 + n;
        v4u o; o.x = pk2(s[0 * 33], s[1 * 33]); o.y = pk2(s[2 * 33], s[3 * 33]); o.z = pk2(s[4 * 33], s[5 * 33]); o.w = pk2(s[6 * 33], s[7 * 33]);
        *(GAS v4u*)(WT + (size_t)(dst_row0 + n) * ldt + k0 + 8 * c) = o; }
    LDS_WAIT(); asm volatile("" ::: "memory");
}
constexpr int P0_I_IN = 16 * 56, P0_I_OUT = 16 * 32, P0_I_13 = 16 * 88, P0_I_2 = 44 * 32, P0_I_P = 4 * 8;
constexpr int P0_ITEMS_EARLY = P0_I_IN + P0_I_OUT + 4 * P0_I_P + 2 * P0_I_13 + P0_I_2, P0_ITEMS_ALL = P0_ITEMS_EARLY + 2 * P0_I_13 + P0_I_2;
__device__ __forceinline__ void p0_items(Frame& F, ArgsP ap, int it_lo, int it_hi, int gw, int NGW) {
    unsigned char* ws = ap->ws;
    LAS float* scr = (LAS float*)(F.lds + RING_OFF + F.wave * 16384);
    for (int it = it_lo + gw; it < it_hi; it += NGW) {
        int r = it;
        if (r < P0_I_IN) { const int kb = r / 56, nb = r % 56, f = 32 * nb, slot = f >> 6, bj = (f >> 5) & 1, pn = slot >> 2, wc = slot & 3;
            p0_transpose_item(ap->in[I_WIN], INW, 64 * kb, f, (bf16*)(ws + WS_WIN), DM, 256 * pn + 128 * bj + 32 * wc, scr, F.lane); continue; } r -= P0_I_IN;
        if (r < P0_I_OUT) { const int kb = r / 32, nb = r % 32; p0_transpose_item(ap->in[I_WOUT], DM, 64 * kb, 32 * nb, (bf16*)(ws + WS_WOUT), DM, 32 * nb, scr, F.lane); continue; } r -= P0_I_OUT;
        if (r < 4 * P0_I_P) { const int g = r / P0_I_P, rr = r % P0_I_P, kb = rr / 8, nb = rr % 8;
            p0_transpose_item(ap->in[I_WPOOL] + (size_t)g * 256 * 256, 256, 64 * kb, 32 * nb, (bf16*)(ws + WS_WPOOL), 256, g * 256 + 32 * nb, scr, F.lane); continue; } r -= 4 * P0_I_P;
        const int l = r >= 2 * P0_I_13 + P0_I_2 ? 1 : 0; r -= l * (2 * P0_I_13 + P0_I_2);
        if (r < 2 * P0_I_13) { const int which = r / P0_I_13, rr = r % P0_I_13, kb = rr / 88, nb = rr % 88, n0 = 32 * nb;
            const float* W = ap->in[which ? I_W3 : I_W1] + (size_t)l * DM * FF;
            p0_transpose_item(W, FF, 64 * kb, n0, (bf16*)(ws + WS_W13) + (size_t)l * 5632 * DM, DM, 256 * (n0 >> 7) + 128 * which + (n0 & 127), scr, F.lane); continue; } r -= 2 * P0_I_13;
        { const int kb = r / 32, nb = r % 32;
            p0_transpose_item(ap->in[I_W2] + (size_t)l * FF * DM, DM, 64 * kb, 32 * nb, (bf16*)(ws + WS_W2) + (size_t)l * DM * FF, FF, 32 * nb, scr, F.lane); }
    }
}
__device__ __forceinline__ void p0_prologue(Frame& F, ArgsP ap) {
    unsigned char* ws = ap->ws;
    if (F.vcu < 192) {
        LAS float* sc = (LAS float*)(F.lds + RING_OFF); LAS float* part = sc + 9 * 1024;
        const float* c = ap->in[I_C]; const float* cctx = ap->in[I_CCTX];
        for (int i = F.tid; i < 9 * 1024; i += NWAVES * 64) { const int bb = i >> 10, k = i & 1023; const float v = bb < 8 ? c[bb * 1024 + k] : cctx[k]; sc[i] = v / (1.0f + expf(-v)); }
        __syncthreads();
        const int l = F.vcu / 96, cb = F.vcu % 96, k0 = F.wave * 128;
        const float* w = ap->in[I_WADA] + (size_t)l * DM * MODW + (size_t)k0 * MODW + cb * 64 + F.lane;
        float acc[9];
#pragma unroll
        for (int j = 0; j < 9; ++j) acc[j] = 0.f;
        for (int k = 0; k < 128; k += 8) {
            float wv[8];
#pragma unroll
            for (int q = 0; q < 8; ++q) wv[q] = __builtin_nontemporal_load(w + (size_t)(k + q) * MODW);
#pragma unroll
            for (int j = 0; j < 9; ++j) { const f32x4 s0 = *(const LAS f32x4*)(sc + j * 1024 + k0 + k), s1 = *(const LAS f32x4*)(sc + j * 1024 + k0 + k + 4);
                acc[j] += (s0[0] * wv[0] + s0[1] * wv[1]) + (s0[2] * wv[2] + s0[3] * wv[3]) + (s1[0] * wv[4] + s1[1] * wv[5]) + (s1[2] * wv[6] + s1[3] * wv[7]); }
        }
#pragma unroll
        for (int j = 0; j < 9; ++j) part[(F.wave * 9 + j) * 64 + F.lane] = acc[j];
        __syncthreads();
        float* mods = (float*)(ws + WS_MODS);
        for (int idx = F.tid; idx < 9 * 64; idx += NWAVES * 64) { const int j = idx >> 6, col = idx & 63; float s = 0.f;
#pragma unroll
            for (int wv_ = 0; wv_ < 8; ++wv_) s += part[(wv_ * 9 + j) * 64 + col];
            mods[(size_t)(l * 9 + j) * MODW + cb * 64 + col] = s + ap->in[I_BADA][l * MODW + cb * 64 + col]; }
        __syncthreads();
    } else if (F.vcu == F.G - 1) {
        float* rc = (float*)(ws + WS_ROPE); float* rs = rc + 1024;
        for (int e = F.tid; e < 1024; e += NWAVES * 64) { const int pos = e >> 4, i = e & 15; const float fr = powf(10000.0f, -(float)(2 * i) / 32.0f); const float a = (float)pos * fr; rc[e] = cosf(a); rs[e] = sinf(a); }
    }
    p0_items(F, ap, 0, P0_ITEMS_EARLY, F.vcu * NWAVES + F.wave, F.G * NWAVES);
    { const float* wsp = ap->in[I_WSP]; bf16* dst = (bf16*)(ws + WS_WSB);
        for (int e = (F.vcu * NWAVES * 64 + F.tid) * 4; e < 8 * 128 * 128; e += F.G * NWAVES * 64 * 4) { const f32x4 v = *(const f32x4*)(wsp + e); v2u o; o.x = pk2(v[0], v[1]); o.y = pk2(v[2], v[3]); *(v2u*)(dst + e) = o; } }
}
__device__ __forceinline__ void p1_bias13(Frame& F, ArgsP ap) {
    if (F.vcu >= 176) return;
    const int l = F.vcu / 88, rem = F.vcu % 88, which = rem / 44, cb = rem % 44, k0 = F.wave * 128;
    LAS float* shs = (LAS float*)(F.lds + RING_OFF); LAS float* part = shs + 8 * 1024;
    const float* mods = (const float*)(ap->ws + WS_MODS);
    for (int i = F.tid; i < 8 * 1024; i += NWAVES * 64) { const int b = i >> 10, k = i & 1023; shs[i] = mods[(size_t)(l * 9 + b) * MODW + SH2 + k]; }
    __syncthreads();
    const float* w = ap->in[which ? I_W3 : I_W1] + (size_t)l * DM * FF + (size_t)k0 * FF + cb * 64 + F.lane;
    float acc[8];
#pragma unroll
    for (int j = 0; j < 8; ++j) acc[j] = 0.f;
    for (int k = 0; k < 128; k += 8) {
        float wv[8];
#pragma unroll
        for (int q = 0; q < 8; ++q) wv[q] = __builtin_nontemporal_load(w + (size_t)(k + q) * FF);
#pragma unroll
        for (int j = 0; j < 8; ++j) { const f32x4 s0 = *(const LAS f32x4*)(shs + j * 1024 + k0 + k), s1 = *(const LAS f32x4*)(shs + j * 1024 + k0 + k + 4);
            acc[j] += (s0[0] * wv[0] + s0[1] * wv[1]) + (s0[2] * wv[2] + s0[3] * wv[3]) + (s1[0] * wv[4] + s1[1] * wv[5]) + (s1[2] * wv[6] + s1[3] * wv[7]); }
    }
#pragma unroll
    for (int j = 0; j < 8; ++j) part[(F.wave * 8 + j) * 64 + F.lane] = acc[j];
    __syncthreads();
    float* bias = (float*)(ap->ws + WS_BIAS);
    for (int idx = F.tid; idx < 8 * 64; idx += NWAVES * 64) { const int j = idx >> 6, col = idx & 63, n = cb * 64 + col; float sum = 0.f;
#pragma unroll
        for (int wv_ = 0; wv_ < 8; ++wv_) sum += part[(wv_ * 8 + j) * 64 + col];
        bias[(size_t)(l * 8 + j) * 5632 + 256 * (n >> 7) + 128 * which + (n & 127)] = sum; }
    __syncthreads();
}
__device__ __forceinline__ void p1_biasin(Frame& F, ArgsP ap) {
    if (F.vcu < 176 || F.vcu >= 176 + INW / 64) return;
    const int cb = F.vcu - 176, k0 = F.wave * 128;
    LAS float* shs = (LAS float*)(F.lds + RING_OFF); LAS float* part = shs + 9 * 1024;
    const float* mods = (const float*)(ap->ws + WS_MODS);
    for (int i = F.tid; i < 9 * 1024; i += NWAVES * 64) { const int b = i >> 10, k = i & 1023; shs[i] = mods[(size_t)b * MODW + SH1 + k]; }
    __syncthreads();
    const float* w = ap->in[I_WIN] + (size_t)k0 * INW + cb * 64 + F.lane;
    float acc[9];
#pragma unroll
    for (int j = 0; j < 9; ++j) acc[j] = 0.f;
    for (int k = 0; k < 128; k += 8) {
        float wv[8];
#pragma unroll
        for (int q = 0; q < 8; ++q) wv[q] = w[(size_t)(k + q) * INW];
#pragma unroll
        for (int j = 0; j < 9; ++j) { const f32x4 s0 = *(const LAS f32x4*)(shs + j * 1024 + k0 + k), s1 = *(const LAS f32x4*)(shs + j * 1024 + k0 + k + 4);
            acc[j] += (s0[0] * wv[0] + s0[1] * wv[1]) + (s0[2] * wv[2] + s0[3] * wv[3]) + (s1[0] * wv[4] + s1[1] * wv[5]) + (s1[2] * wv[6] + s1[3] * wv[7]); }
    }
#pragma unroll
    for (int j = 0; j < 9; ++j) part[(F.wave * 9 + j) * 64 + F.lane] = acc[j];
    __syncthreads();
    float* bias = (float*)(ap->ws + WS_BIASIN);
    for (int idx = F.tid; idx < 9 * 64; idx += NWAVES * 64) { const int j = idx >> 6, col = idx & 63; float sum = 0.f;
#pragma unroll
        for (int wv_ = 0; wv_ < 8; ++wv_) sum += part[(wv_ * 9 + j) * 64 + col];
        bias[(size_t)j * INW + cb * 64 + col] = sum; }
    __syncthreads();
}
__device__ __forceinline__ void p1_flag(Frame& F, ArgsP ap) {
    if (F.vcu != F.G - 1) return;
    const float* mods = (const float*)(ap->ws + WS_MODS); const float* g = ap->in[I_GFFN];
    int bad = 0;
    for (int i = F.tid; i < 3 * 8 * 1024; i += NWAVES * 64) { const int l = i >> 13, b = (i >> 10) & 7, k = i & 1023;
        const float m = l < 2 ? fabsf(g[l * DM + k] * (mods[(size_t)(l * 9 + b) * MODW + SC2 + k] + 1.0f)) : fabsf(ap->in[I_GMIX][k] * (mods[(size_t)b * MODW + SC1 + k] + 1.0f)); bad |= (!(m >= 1e-12f) || !(m <= 1e12f)) ? 1 : 0; }
    const int any = __syncthreads_or(bad);
    if (F.tid == 0) *(int*)(ap->ws + WS_FLAG) = any ? 0 : 1;
}
__device__ __forceinline__ void p1_poolw(Frame& F, ArgsP ap) {
    unsigned char* ws = ap->ws; const bf16* src = (const bf16*)(ws + WS_WPOOL); bf16* dst = (bf16*)(ws + WS_WPB);
    const float* gm = ap->in[I_GMIX] + DM; const float* mod1 = (const float*)(ws + WS_MODS) + (size_t)9 * MODW;
    for (int e = (F.vcu * NWAVES * 64 + F.tid) * 8; e < 8 * 1024 * 256; e += F.G * NWAVES * 64 * 8) {
        const int b = e >> 18, n = (e >> 8) & 1023, k = e & 255, gk = (n & ~255) + k;
        const v4u w = *(const v4u*)(src + (size_t)n * 256 + k); const f32x4 g0 = *(const f32x4*)(gm + gk), g1 = *(const f32x4*)(gm + gk + 4);
        const f32x4 s0 = *(const f32x4*)(mod1 + (size_t)b * MODW + SC1 + gk), s1 = *(const f32x4*)(mod1 + (size_t)b * MODW + SC1 + gk + 4);
        const f32x4 m0 = g0 * (s0 + 1.0f), m1 = g1 * (s1 + 1.0f);
        v4u o; o.x = pk2(bf2f(w.x & 0xffffu) * m0[0], bf2f(w.x >> 16) * m0[1]); o.y = pk2(bf2f(w.y & 0xffffu) * m0[2], bf2f(w.y >> 16) * m0[3]);
        o.z = pk2(bf2f(w.z & 0xffffu) * m1[0], bf2f(w.z >> 16) * m1[1]); o.w = pk2(bf2f(w.w & 0xffffu) * m1[2], bf2f(w.w >> 16) * m1[3]);
        *(v4u*)(dst + e) = o; }
}
__device__ __forceinline__ void norm_pass(Frame& F, const float* src_lat, const float* src_ctx, bf16* dst, float* rin, const float* gvec, const float* modl, int sc_off) {
    const int total = src_ctx ? MALL : MTOK, gw = F.vcu * NWAVES + F.wave, NGW = F.G * NWAVES, rpw = (total + NGW - 1) / NGW;
    const int r0 = gw * rpw, r1 = (r0 + rpw < total) ? r0 + rpw : total;
    int cur = -1; f32x4 gm[4];
    for (int row = r0; row < r1; ++row) {
        const int bb = row < MTOK ? (row >> 12) : 8;
        if (bb != cur) { cur = bb;
#pragma unroll
            for (int j = 0; j < 4; ++j) { const int c = 4 * F.lane + 256 * j; const f32x4 g = *(const f32x4*)(gvec + c), s = *(const f32x4*)(modl + (size_t)bb * MODW + sc_off + c);
                gm[j] = g * (s + 1.0f); } }
        const float* xr = row < MTOK ? src_lat + (size_t)row * DM : src_ctx + (size_t)(row - MTOK) * DM;
        f32x4 v[4]; float ss = 0.f;
#pragma unroll
        for (int j = 0; j < 4; ++j) { v[j] = __builtin_nontemporal_load((const f32x4*)(xr + 4 * F.lane + 256 * j)); ss += (v[j][0] * v[j][0] + v[j][1] * v[j][1]) + (v[j][2] * v[j][2] + v[j][3] * v[j][3]); }
        const float r = __builtin_amdgcn_rsqf(wave_sum(ss) * (1.0f / DM) + 1e-6f);
        if (F.lane == 0) rin[row] = r;
        bf16* orow = dst + (size_t)row * DM;
#pragma unroll
        for (int j = 0; j < 4; ++j) { const f32x4 o = v[j] * gm[j]; v2u w; w.x = pk2(o[0], o[1]); w.y = pk2(o[2], o[3]); *(v2u*)(orow + 4 * F.lane + 256 * j) = w; }
    }
}
__device__ __forceinline__ void final_norm(Frame& F, float* out, const float* gvec) {
    const int gw = F.vcu * NWAVES + F.wave, NGW = F.G * NWAVES, rpw = (MTOK + NGW - 1) / NGW;
    const int r0 = gw * rpw, r1 = (r0 + rpw < MTOK) ? r0 + rpw : MTOK;
    f32x4 g[4];
#pragma unroll
    for (int j = 0; j < 4; ++j) g[j] = *(const f32x4*)(gvec + 4 * F.lane + 256 * j);
    for (int row = r0; row < r1; ++row) {
        float* xr = out + (size_t)row * DM; f32x4 v[4]; float ss = 0.f;
#pragma unroll
        for (int j = 0; j < 4; ++j) { v[j] = *(const f32x4*)(xr + 4 * F.lane + 256 * j); ss += (v[j][0] * v[j][0] + v[j][1] * v[j][1]) + (v[j][2] * v[j][2] + v[j][3] * v[j][3]); }
        const float r = 1.0f / sqrtf(wave_sum(ss) * (1.0f / DM) + 1e-6f);
#pragma unroll
        for (int j = 0; j < 4; ++j) *(f32x4*)(xr + 4 * F.lane + 256 * j) = v[j] * r * g[j];
    }
}
template <int W> __device__ __forceinline__ void poolres_cols(const bf16* zb, bf16* outb, bf16* xnb, float* partb, int t0, int c, f32x4 gate, f32x4 gmn, int grp, int lane, const LAS float* rt, bool xo) {
    constexpr int L = W / 2, R = W / 2 - 1, NV = W - 1 + 16;
    f32x4 v[NV];
#define BF4(u_) (f32x4){bf2f((u_).x & 0xffffu), bf2f((u_).x >> 16), bf2f((u_).y & 0xffffu), bf2f((u_).y >> 16)}
#define Z_LD(dst_, t_) do { const int tt_ = (t_); if (tt_ < 0 || tt_ >= SEQ) dst_ = (f32x4){0.f, 0.f, 0.f, 0.f}; else { const v2u u_ = __builtin_nontemporal_load((const v2u*)(zb + (size_t)tt_ * DM + c)); dst_ = BF4(u_) * rt[tt_]; } } while (0)
#pragma unroll
    for (int i = 0; i < W - 1; ++i) Z_LD(v[i], t0 - L + i);
    for (int blk = 0; blk < 4; ++blk) {
        const int tb = t0 + 16 * blk;
        v2u xr[16];
#pragma unroll
        for (int i = 0; i < 16; ++i) xr[i] = *(const v2u*)(outb + (size_t)(tb + i) * DM + c);
#pragma unroll
        for (int i = 0; i < 16; ++i) Z_LD(v[W - 1 + i], tb + R + i);
        f32x4 s = v[0];
#pragma unroll
        for (int i = 1; i < W; ++i) s += v[i];
#pragma unroll
        for (int j = 0; j < 16; ++j) { const int t = tb + j; const int lo = t - L < 0 ? 0 : t - L, hi = t + R > SEQ - 1 ? SEQ - 1 : t + R; const float icnt = __builtin_amdgcn_rcpf((float)(hi - lo + 1));
            const f32x4 o = s * icnt - v[j + L]; const f32x4 x3 = BF4(xr[j]) + gate * o;
            if (!xo) { v2u w; w.x = pk2(x3[0], x3[1]); w.y = pk2(x3[2], x3[3]); *(v2u*)(outb + (size_t)t * DM + c) = w; }
            const f32x4 y = x3 * gmn; v2u wy; wy.x = pk2(y[0], y[1]); wy.y = pk2(y[2], y[3]); *(v2u*)(xnb + (size_t)t * DM + c) = wy;
            const float ss = wave_sum((x3[0] * x3[0] + x3[1] * x3[1]) + (x3[2] * x3[2] + x3[3] * x3[3]));
            if (lane == 0) *(f32x4*)(partb + ((size_t)grp * MTOK + t) * 4) = (f32x4){ss, 0.f, 0.f, 0.f};
            if (j < 15) s += v[j + W] - v[j]; }
#pragma unroll
        for (int i = 0; i < W - 1; ++i) v[i] = v[i + 16];
    }
#undef Z_LD
#undef BF4
}
__device__ __forceinline__ void poolres_pass(Frame& F, const bf16* Z, bf16* out, bf16* xn, float* part, const float* rsum, const int* flagp, const float* gate, const float* pscale, const float* gnext, const float* scnext) {
    LAS float* rtab = (LAS float*)(F.lds + RTAB_OFF);
    const bool xo = __builtin_amdgcn_readfirstlane(*flagp) != 0;
    for (int strip = F.vcu; strip < MTOK / 128; strip += F.G) {
        const int b = strip >> 5, grp = F.wave >> 1, ts = (strip & 31) * 128, t0 = ts + 64 * (F.wave & 1); const size_t ro = (size_t)b * SEQ;
        __syncthreads();
        if (F.tid < 128 + 15) { const int tt = ts - 8 + F.tid; float r = 0.f;
            if (tt >= 0 && tt < SEQ) { const float* pr = rsum + (ro + tt) * 4; f32x4 p = *(const f32x4*)pr; p += *(const f32x4*)(pr + (size_t)(MTOK * 4) * 1); p += *(const f32x4*)(pr + (size_t)(MTOK * 4) * 2); p += *(const f32x4*)(pr + (size_t)(MTOK * 4) * 3);
                r = __builtin_amdgcn_rsqf(((p[0] + p[1]) + (p[2] + p[3])) * (1.0f / 1024.0f) + 1e-6f); }
            rtab[F.tid] = r; }
        __syncthreads();
        const LAS float* rt = rtab + (8 - ts);
        const int c = 256 * grp + 4 * F.lane;
        const f32x4 gt = *(const f32x4*)(gate + (size_t)b * MODW + c) * *(const f32x4*)(pscale + c);
        const f32x4 gmn = *(const f32x4*)(gnext + c) * (*(const f32x4*)(scnext + (size_t)b * MODW + c) + 1.0f);
        const bf16* zb = Z + ro * DM; bf16* outb = out + ro * DM; bf16* xnb = xn + ro * DM; float* partb = part + ro * 4;
        if (grp == 0) poolres_cols<2>(zb, outb, xnb, partb, t0, c, gt, gmn, grp, F.lane, rt, xo); else if (grp == 1) poolres_cols<4>(zb, outb, xnb, partb, t0, c, gt, gmn, grp, F.lane, rt, xo);
        else if (grp == 2) poolres_cols<8>(zb, outb, xnb, partb, t0, c, gt, gmn, grp, F.lane, rt, xo); else poolres_cols<16>(zb, outb, xnb, partb, t0, c, gt, gmn, grp, F.lane, rt, xo);
    }
}
__device__ __forceinline__ void gmlp_unit(Frame& F, int unit, const bf16* VG, const bf16* U, const bf16* WSB, const float* bs, bf16* AM) {
    using attn_body::f32x16;
    const int g = F.wave, lane = F.lane, r32 = lane & 31, hi = lane >> 5;
    const size_t R0 = (size_t)unit * 128;
    LAS unsigned char* slot = F.lds + RING_OFF + g * 16384;
    const unsigned slot_addr = (unsigned)(uintptr_t)slot;
    const int vb = (int)slot_addr + ((lane >> 4) & 1) * 32 + (lane & 3) * 8 + (4 * hi + ((lane & 15) >> 2)) * 64;
#pragma unroll
    for (int kt = 0; kt < 2; ++kt)
#pragma unroll
        for (int p = 0; p < 8; ++p)
            attn_body::glds16_nt(VG + (R0 + 64 * kt + 16 * (p & 3) + (lane >> 2)) * 512 + g * 64 + (p >> 2) * 32 + (lane & 3) * 8, (unsigned)__builtin_amdgcn_readfirstlane(slot_addr + kt * 8192 + p * 1024));
    f32x16 o[4][2];
#pragma unroll
    for (int rb = 0; rb < 4; ++rb) { o[rb][0] = f32x16{}; o[rb][1] = f32x16{}; }
#define GM_LDPA(dst, kt_, rb_) do { int z_ = 0; asm volatile("" : "+v"(z_)); const char* wp = wb + z_ + (rb_) * 8192 + (kt_) * 128;     \
            _Pragma("unroll") for (int s = 0; s < 4; ++s) { const v2u a = *(const v2u*)(wp + s * 32), b = *(const v2u*)(wp + s * 32 + 16); dst[s] = __builtin_bit_cast(bf16x8, (v4u){a.x, a.y, b.x, b.y}); } } while (0)
    const char* wb = (const char*)(WSB + ((size_t)(g * 128 + r32) * 128 + 4 * hi));
    {
        bf16x8 pA[4], pB[4];
#define GM_PV(P, kt_, rb_) attn_body::pv(o[rb_], vb + (kt_) * 8192, P[0], P[1], P[2], P[3])
        GM_LDPA(pA, 0, 0);
        VM_WAIT();
        GM_LDPA(pB, 0, 1); GM_PV(pA, 0, 0);
        GM_LDPA(pA, 0, 2); GM_PV(pB, 0, 1);
        GM_LDPA(pB, 0, 3); GM_PV(pA, 0, 2);
        GM_LDPA(pA, 1, 0); GM_PV(pB, 0, 3);
        GM_LDPA(pB, 1, 1); GM_PV(pA, 1, 0);
        GM_LDPA(pA, 1, 2); GM_PV(pB, 1, 1);
        GM_LDPA(pB, 1, 3); GM_PV(pA, 1, 2);
        GM_PV(pB, 1, 3);
#undef GM_PV
    }
#undef GM_LDPA
    LDS_WAIT();
    LAS float* stg = (LAS float*)slot;
    v4u uA[4], uB[4]; float bA[4], bB[4];
#define GM_LDU(UU, BB, rb_) do { int zz_ = 0; asm volatile("" : "+v"(zz_)); const char* ub_ = (const char*)(U + (R0 + 32 * (rb_) + (lane >> 3)) * 512 + g * 64 + (lane & 7) * 8) + zz_; \
        const float* bb_ = bs + g * 128 + 32 * (rb_) + (lane >> 3) + zz_; _Pragma("unroll") for (int i = 0; i < 4; ++i) { UU[i] = __builtin_nontemporal_load((const v4u*)(ub_ + i * 8192)); BB[i] = bb_[8 * i]; } } while (0)
#define GM_EPI(UU, BB, rb_) do { \
        _Pragma("unroll") for (int r = 0; r < 16; ++r) { const int orow = attn_body::crow(r, hi); stg[orow * 64 + r32] = o[rb_][0][r]; stg[orow * 64 + 32 + r32] = o[rb_][1][r]; } \
        LDS_WAIT(); \
        _Pragma("unroll") for (int i = 0; i < 4; ++i) { const int row = i * 8 + (lane >> 3), ch = lane & 7; \
            const f32x4 a = *(const LAS f32x4*)(stg + row * 64 + ch * 8) + BB[i], b = *(const LAS f32x4*)(stg + row * 64 + ch * 8 + 4) + BB[i]; \
            v4u w; w.x = pk2(a[0] * bf2f(UU[i].x & 0xffffu), a[1] * bf2f(UU[i].x >> 16)); w.y = pk2(a[2] * bf2f(UU[i].y & 0xffffu), a[3] * bf2f(UU[i].y >> 16)); \
            w.z = pk2(b[0] * bf2f(UU[i].z & 0xffffu), b[1] * bf2f(UU[i].z >> 16)); w.w = pk2(b[2] * bf2f(UU[i].w & 0xffffu), b[3] * bf2f(UU[i].w >> 16)); \
            *(v4u*)(AM + (R0 + 32 * (rb_) + row) * 1024 + 512 + g * 64 + ch * 8) = w; } \
        LDS_WAIT(); } while (0)
    GM_LDU(uA, bA, 0);
    GM_LDU(uB, bB, 1); GM_EPI(uA, bA, 0);
    GM_LDU(uA, bA, 2); GM_EPI(uB, bB, 1);
    GM_LDU(uB, bB, 3); GM_EPI(uA, bA, 2);
    GM_EPI(uB, bB, 3);
#undef GM_LDU
#undef GM_EPI
}

template <class Sched> __device__ __forceinline__ int build_rtab(Frame& F, const Sched& S, const float* part, LAS float* rtab) {
    pg8::Unit u; int pm0 = -1, pm1 = -1;
    for (int i = 0; S.next(i, u); ++i) { if (pm0 < 0) pm0 = u.pm; else if (u.pm != pm0) pm1 = u.pm; }
    if (pm1 < 0) pm1 = pm0;
    { const int slot = F.tid >> 8, r = F.tid & 255, row = (slot ? pm1 : pm0) * 256 + r; float tot = 0.f;
#pragma unroll
        for (int pn = 0; pn < 4; ++pn) { const f32x4 p = *(const f32x4*)(part + ((size_t)pn * MTOK + row) * 4); tot += (p[0] + p[1]) + (p[2] + p[3]); }
        rtab[F.tid] = __builtin_amdgcn_rsqf(tot * (1.0f / DM) + 1e-6f); }
    __syncthreads();
    return pm0;
}

constexpr int POOL_HALO_OFF = RING_BYTES + 4096;
template <int W> __device__ __forceinline__ void pool_win(const LAS unsigned char* tile, const LAS unsigned char* halo, const bf16* outb, bf16* resb, bf16* xnb, float* partb, int tl0, int tg0, int c, f32x4 gate, f32x4 gmn, int grp, int lane, bool xo) {
    constexpr int L = W / 2, R = W / 2 - 1, NV = W - 1 + 16;
    f32x4 v[NV];
    const int chunk = lane >> 1, half8 = (lane & 1) * 8;
#define PW_BF4(u_) (f32x4){__builtin_bit_cast(float, (u_).x << 16), __builtin_bit_cast(float, (u_).x & 0xffff0000u), __builtin_bit_cast(float, (u_).y << 16), __builtin_bit_cast(float, (u_).y & 0xffff0000u)}
#define PW_LD(dst_, tl_) do { const int q_ = (tl_); v2u u_; \
        if (q_ < 0) u_ = *(const LAS v2u*)(halo + (q_ + 8) * 512 + lane * 8); else if (q_ >= 256) u_ = *(const LAS v2u*)(halo + (8 + q_ - 256) * 512 + lane * 8); \
        else u_ = *(const LAS v2u*)(tile + q_ * 512 + (((chunk & 16) | ((chunk ^ q_) & 15)) << 4) + half8); dst_ = PW_BF4(u_); } while (0)
#pragma unroll
    for (int i = 0; i < W - 1; ++i) PW_LD(v[i], tl0 - L + i);
    for (int blk = 0; blk < 2; ++blk) {
        const int tb = tl0 + 16 * blk, tgb = tg0 + 16 * blk;
        v2u xr[16];
#pragma unroll
        for (int i = 0; i < 16; ++i) xr[i] = *(const v2u*)(outb + (size_t)(tgb + i) * DM + c);
#pragma unroll
        for (int i = 0; i < 16; ++i) PW_LD(v[W - 1 + i], tb + R + i);
        f32x4 sum = v[0];
#pragma unroll
        for (int i = 1; i < W; ++i) sum += v[i];
#pragma unroll
        for (int j = 0; j < 16; ++j) { const int t = tgb + j; const int lo = t - L < 0 ? 0 : t - L, hi = t + R > SEQ - 1 ? SEQ - 1 : t + R; const float icnt = __builtin_amdgcn_rcpf((float)(hi - lo + 1));
            const f32x4 o = sum * icnt - v[j + L]; const f32x4 x3 = PW_BF4(xr[j]) + gate * o;
            if (!xo) { v2u w; w.x = pk2(x3[0], x3[1]); w.y = pk2(x3[2], x3[3]); *(v2u*)(resb + (size_t)t * DM + c) = w; }
            const f32x4 y = x3 * gmn; v2u wy; wy.x = pk2(y[0], y[1]); wy.y = pk2(y[2], y[3]); *(v2u*)(xnb + (size_t)t * DM + c) = wy;
            const float ss = wave_sum((x3[0] * x3[0] + x3[1] * x3[1]) + (x3[2] * x3[2] + x3[3] * x3[3]));
            if (lane == 0) *(f32x4*)(partb + ((size_t)grp * MTOK + t) * 4) = (f32x4){ss, 0.f, 0.f, 0.f};
            if (j < 15) sum += v[j + W] - v[j]; }
#pragma unroll
        for (int i = 0; i < W - 1; ++i) v[i] = v[i + 16];
    }
#undef PW_LD
#undef PW_BF4
}
struct EpiPool {
    static constexpr bool PERM = true, AFTER_DRAIN = true;
    ArgsP A;
    __device__ __forceinline__ void operator()(pg8::f32x4 (&)[2][2][4][2], const pg8::Unit&, int, int, int, int) const {}
    __device__ __forceinline__ void fused(pg8::f32x4 (&acc)[2][2][4][2], const pg8::Unit& u, int wr, int wc, int fr_, int fq_, LAS unsigned char* lds, int wid, int lane_) const {
        using pg8::RS_M; using pg8::HALF;
        const int lane = lane_id_v(); const int fr = lane & 15, fq = (lane >> 4) & 3; (void)fr_; (void)fq_; (void)lane_;
        ArgsP a_ = A; asm volatile("" : "+s"(a_)); unsigned char* ws_ = a_->ws;
        const int pm = u.pm, g = u.pn, b = pm >> 4, pl = pm & 15, rowl0 = wr * 64 + fr, row0 = pm * 256 + rowl0;
        const float* part2 = (const float*)(ws_ + WS_PART) + (size_t)16 * RS_M;
        unsigned* ctl = (unsigned*)(ws_ + WS_CTL);
        {
            unsigned* cw = ctl + CTL_CNT6 / 4 + 16 * pm; unsigned sp = 0;
            while ((unsigned)__builtin_amdgcn_readfirstlane(__hip_atomic_load(cw, __ATOMIC_RELAXED, __HIP_MEMORY_SCOPE_AGENT)) < 32u) { __builtin_amdgcn_s_sleep(2); if (++sp > (1u << 22)) break; }
        }
        float rr[2][4];
        {   pg8::f32x4 pq[8];
#pragma unroll
            for (int i = 0; i < 8; ++i) { const float* pp = part2 + ((size_t)fq * RS_M + (row0 + (i >> 2) * HALF + (i & 3) * 16)) * 4;
                asm volatile("global_load_dwordx4 %0, %1, off sc1" : "=v"(pq[i]) : "v"(pp) : "memory"); }
            asm volatile("s_waitcnt vmcnt(0)" : "+v"(pq[0]), "+v"(pq[1]), "+v"(pq[2]), "+v"(pq[3]), "+v"(pq[4]), "+v"(pq[5]), "+v"(pq[6]), "+v"(pq[7]) :: "memory");
#pragma unroll
            for (int i = 0; i < 8; ++i) { float t = (pq[i][0] + pq[i][1]) + (pq[i][2] + pq[i][3]); t = xor32_add(xor16_add(t)); rr[i >> 2][i & 3] = __builtin_amdgcn_rsqf(t * (1.0f / 1024.0f) + 1e-6f); }
        }
#pragma unroll
        for (int ai = 0; ai < 2; ++ai)
#pragma unroll
            for (int m = 0; m < 4; ++m) { const int row = rowl0 + ai * HALF + m * 16;
#pragma unroll
                for (int bj = 0; bj < 2; ++bj) { const int chunk = 16 * bj + 4 * wc + fq, cs = (chunk & 16) | ((chunk ^ row) & 15);
                    *(LAS pg8::u32x4*)(lds + row * 512 + cs * 16) = pg8::pack8(acc[ai][bj][m][0] * rr[ai][m], acc[ai][bj][m][1] * rr[ai][m]); } }
        __syncthreads();
        const int tid = wid * 64 + lane, hr = tid >> 5, ch = tid & 31;
        unsigned char* hbuf = ws_ + WS_AM;
        unsigned* hflag = ctl + CTL_HFLAG / 4;
        if (tid < 480) { const int row = hr < 7 ? hr : 241 + hr, cs = (ch & 16) | ((ch ^ row) & 15);
            const pg8::u32x4 v = *(const LAS pg8::u32x4*)(lds + row * 512 + cs * 16);
            const unsigned char* dst = hbuf + ((size_t)(pm * 4 + g) * 15 + hr) * 512 + ch * 16;
            asm volatile("global_store_dwordx4 %0, %1, off sc1" :: "v"(dst), "v"(v) : "memory"); }
        asm volatile("s_waitcnt vmcnt(0)" ::: "memory");
        if (lane == 0) __hip_atomic_fetch_add(hflag + 8 * (pm * 4 + g), 1u, __ATOMIC_RELAXED, __HIP_MEMORY_SCOPE_AGENT);
        {
            const bool above = wid < 4; const bool have = above ? (pl != 0) : (pl != 15); const int npm = above ? pm - 1 : pm + 1;
            pg8::u32x4 v = (pg8::u32x4){0u, 0u, 0u, 0u};
            if (have) { unsigned* fw = hflag + 8 * (npm * 4 + g); unsigned sp = 0;
                while ((unsigned)__builtin_amdgcn_readfirstlane(__hip_atomic_load(fw, __ATOMIC_RELAXED, __HIP_MEMORY_SCOPE_AGENT)) < 8u) { __builtin_amdgcn_s_sleep(2); if (++sp > (1u << 22)) break; }
                if (tid < 480) { const int nhr = above ? hr + 7 : hr - 8; const unsigned char* src = hbuf + ((size_t)(npm * 4 + g) * 15 + nhr) * 512 + ch * 16;
                    asm volatile("global_load_dwordx4 %0, %1, off sc1\n\ts_waitcnt vmcnt(0)" : "=v"(v) : "v"(src) : "memory"); } }
            if (tid < 480) *(LAS pg8::u32x4*)(lds + POOL_HALO_OFF + hr * 512 + ch * 16) = v;
        }
        __syncthreads();
        const bool xo = __builtin_amdgcn_readfirstlane(*(const int*)(ws_ + WS_FLAG)) != 0;
        const float* mod1 = (const float*)(ws_ + WS_MODS) + (size_t)9 * MODW;
        const int c = 256 * g + 4 * lane; const size_t ro = (size_t)b * SEQ;
        const f32x4 gt = *(const f32x4*)(mod1 + GA1 + (size_t)b * MODW + c) * *(const f32x4*)(a_->in[I_PSC] + c);
        const f32x4 gmn = *(const f32x4*)(a_->in[I_GFFN] + DM + c) * (*(const f32x4*)(mod1 + SC2 + (size_t)b * MODW + c) + 1.0f);
        const bf16* outb = (const bf16*)(ws_ + WS_RES) + ro * DM; bf16* resb = (bf16*)(ws_ + WS_RES) + ro * DM; bf16* xnb = (bf16*)(ws_ + WS_XN) + ro * DM; float* partb = (float*)(ws_ + WS_PART) + (size_t)2 * 16 * RS_M + ro * 4;
        const LAS unsigned char* tile = lds; const LAS unsigned char* halo = lds + POOL_HALO_OFF;
        const int tl0 = 32 * wid, tg0 = 256 * pl + tl0;
        if (g == 0) pool_win<2>(tile, halo, outb, resb, xnb, partb, tl0, tg0, c, gt, gmn, g, lane, xo); else if (g == 1) pool_win<4>(tile, halo, outb, resb, xnb, partb, tl0, tg0, c, gt, gmn, g, lane, xo);
        else if (g == 2) pool_win<8>(tile, halo, outb, resb, xnb, partb, tl0, tg0, c, gt, gmn, g, lane, xo); else pool_win<16>(tile, halo, outb, resb, xnb, partb, tl0, tg0, c, gt, gmn, g, lane, xo);
        __syncthreads();
    }
};
struct BatchRoundOrder { pg8::StaticOrder base; int G, c;
    __device__ void init(int M, int N, int G_, int c_) { base.init(M, N, G_, c_); G = G_; c = c_; }
    __device__ __forceinline__ bool next(int i, pg8::Unit& u) const {
        if (G != 256 || base.nwg != 512) return base.next(i, u);
        if (i >= 2) return false;
        u.pm = 8 * (8 * i + (c & 7)) + ((c >> 3) & 7); u.pn = c >> 6; return true; }
    __device__ __forceinline__ void a_ready(const pg8::Unit&) const {}
    __device__ __forceinline__ void done(const pg8::Unit&) const {} };
struct OneUnit { const BatchRoundOrder* S; int i;
    __device__ __forceinline__ bool next(int k, pg8::Unit& u) const { return k == 0 && S->next(i, u); }
    __device__ __forceinline__ void a_ready(const pg8::Unit&) const {}
    __device__ __forceinline__ void done(const pg8::Unit&) const {} };
__global__ void __launch_bounds__(NWAVES * 64, 2) mega_fwd(Args args) {
    extern __shared__ __attribute__((aligned(16))) unsigned char lds[];
    Frame F;
    F.lds = (LAS unsigned char*)lds;
    F.MISC = (volatile LAS unsigned*)(F.lds + MISC_OFF);
    F.tid = threadIdx.x; F.lane = F.tid & 63; F.wave = __builtin_amdgcn_readfirstlane(F.tid >> 6);
    F.G = gridDim.x; { const int bx = blockIdx.x; F.vcu = (F.G % 8 == 0) ? (bx % 8) * (F.G / 8) + bx / 8 : bx; }
    ArgsP akp = (ArgsP)__builtin_amdgcn_kernarg_segment_ptr();
    F.ctl = (gu32*)(akp->ws + WS_CTL);
    for (int u = F.tid; u < (LDS_BYTES - LDSCTL_OFF) / 4; u += NWAVES * 64) ((LAS unsigned*)(F.lds + LDSCTL_OFF))[u] = 0u;
    __syncthreads();
    const int lo = akp->ph_lo, hi = akp->ph_hi;
    const bool one_launch = (hi - lo) > 1;
    XcdBarrier bar; bar.bar = (unsigned*)(F.ctl + CW_BAR); bar.x = 0; bar.st = nullptr;
    if (one_launch) bar = xcd_barrier_post((unsigned*)(F.ctl + CW_BAR), F.MISC + 8);
    bar.w0 = (F.wave == 0);
#ifndef PHASE_MASK
#define PHASE_MASK 0x7ff
#endif
#define IN(k) (((PHASE_MASK >> (k)) & 1) && lo <= (k) && (k) < hi)
#define SEAM(k) do { if (IN(k) && IN((k) + 1)) xcd_barrier(bar); } while (0)
#ifndef REPEAT_MASK
#define REPEAT_MASK 0
#endif
#define REP(k) for (int rep_ = 0; rep_ < (((REPEAT_MASK >> (k)) & 1) ? 2 : 1); ++rep_, (((REPEAT_MASK >> (k)) & 1) && rep_ == 1 && one_launch ? (xcd_barrier(bar), 0) : 0))
#define REPRES(k, dummy) ((((REPEAT_MASK >> (k)) & 1) && rep_ == 0) ? (void*)(ws + (dummy)) : (void*)(ws + WS_RES))
#define REPOUT(k, dummy) ((((REPEAT_MASK >> (k)) & 1) && rep_ == 0) ? (float*)(ws + (dummy)) : out)
#define PHASE_VARS() ArgsP A = akp; asm volatile("" : "+s"(A)); unsigned char* ws = A->ws; float* out = A->out; float* mods = (float*)(ws + WS_MODS); const float* mod1 = mods + (size_t)9 * MODW; bf16* XN = (bf16*)(ws + WS_XN); bf16* AM = (bf16*)(ws + WS_AM); bf16* HB = (bf16*)(ws + WS_H); \
    float* rs1 = (float*)(ws + WS_PART); float* rs2 = rs1 + 16 * MTOK; float* rs3 = rs2 + 16 * MTOK; float* rs4 = rs3 + 16 * MTOK; const float* bias13 = (const float*)(ws + WS_BIAS); \
    (void)out; (void)mods; (void)mod1; (void)XN; (void)AM; (void)HB; (void)rs1; (void)rs2; (void)rs3; (void)rs4; (void)bias13
#ifndef STAGGER_US
#define STAGGER_US 0
#endif
#define STAGGER() do { const unsigned g_ = (blockIdx.x >> 3) & 3u; if (STAGGER_US > 0 && g_) { const unsigned long long t0_ = __builtin_amdgcn_s_memrealtime(); while (__builtin_amdgcn_s_memrealtime() - t0_ < (unsigned long long)(g_ * STAGGER_US * 100)) __builtin_amdgcn_s_sleep(8); } } while (0)
#define RELAUNDER() do { const int l_ = lane_id_v(); F.tid = F.wave * 64 + l_; F.lane = l_; } while (0)
    if (IN(0)) REP(0) { PHASE_VARS(); RELAUNDER(); p0_prologue(F, A); } SEAM(0);
    if (IN(1)) REP(1) { PHASE_VARS(); RELAUNDER(); p1_flag(F, A); p1_bias13(F, A); p1_poolw(F, A); p1_biasin(F, A); norm_pass(F, A->in[I_X], A->in[I_CTX], XN, (float*)(ws + WS_RIN), A->in[I_GMIX], mods, SC1); } SEAM(1);
    if (IN(2)) REP(2) { PHASE_VARS();
        pg8::Gemm g{XN, (const bf16*)(ws + WS_WIN), DM, DM, 0, 0}; pg8::StaticOrder S; S.init(MTOK, INW, F.G, (int)blockIdx.x, MCTX / 256, 2);
        pg8::EpiInProj E{A};
        pg8::gemm_phase<pg8::EpiInProj, pg8::StaticOrder, PG8_ALIGN, PG8_SP2>(F.lds + RING_OFF, g, S, E, F.wave);
        { const int total = (MTOK / 256) * (INW / 256) + MCTX / 256, rounds = (total + (int)F.G - 1) / (int)F.G, heavy = total - (rounds - 1) * (int)F.G, c = (int)blockIdx.x;
          RELAUNDER();
          if (heavy >= (int)F.G) p0_items(F, A, P0_ITEMS_EARLY, P0_ITEMS_ALL, c * NWAVES + F.wave, (int)F.G * NWAVES);
          else if (c >= heavy) p0_items(F, A, P0_ITEMS_EARLY, P0_ITEMS_ALL, (c - heavy) * NWAVES + F.wave, ((int)F.G - heavy) * NWAVES); }
    } SEAM(2);
    if (IN(3)) REP(3) { PHASE_VARS();
        const attn_body::AttnTensors AT{(const attn_body::bf16*)(ws + WS_Q), (const attn_body::bf16*)(ws + WS_KB), (const attn_body::bf16*)(ws + WS_VB), (attn_body::bf16*)AM};
        const attn_body::StaticOrder S((int)F.G, F.vcu);
        const bool gfirst = (F.vcu & 1) != 0;
        for (int g2_ = 0; g2_ < 2; ++g2_) {
            if ((g2_ == 0) == gfirst) {
                RELAUNDER();
                for (int rp_ = 0; rp_ < (((REPEAT_MASK >> 11) & 1) ? 2 : 1); ++rp_) {
                    for (int u = F.vcu; u < MTOK / 128; u += F.G) gmlp_unit(F, u, (const bf16*)(ws + WS_VG), (const bf16*)(ws + WS_U), (const bf16*)(ws + WS_WSB), A->in[I_BSP], AM);
                    __syncthreads(); }
            } else attn_body::attn_phase<attn_body::StaticOrder>((char*)lds + RING_OFF, AT, S, A->in[I_QN], A->in[I_KN], F.wave);
        }
    } SEAM(3);
    if (IN(4)) REP(4) { PHASE_VARS(); STAGGER();
        pg8::Gemm g{AM, (const bf16*)(ws + WS_WOUT), DM, DM, 0, 0}; pg8::StaticOrder S; S.init(MTOK, DM, F.G, (int)blockIdx.x);
        if (__builtin_amdgcn_readfirstlane(*(const int*)(ws + WS_FLAG)) != 0) { pg8::EpiResid<5> E{A, (void*)(ws + WS_RES)};
            pg8::gemm_phase<pg8::EpiResid<5>, pg8::StaticOrder, PG8_ALIGN, PG8_SP2>(F.lds + RING_OFF, g, S, E, F.wave); }
        else { pg8::EpiResid<4> E{A, (void*)(ws + WS_RES)};
            pg8::gemm_phase<pg8::EpiResid<4>, pg8::StaticOrder, PG8_ALIGN, PG8_SP2>(F.lds + RING_OFF, g, S, E, F.wave); }
    } SEAM(4);
    if (IN(5)) REP(5) { PHASE_VARS();
        pg8::Gemm g{XN, (const bf16*)(ws + WS_W13), DM, DM, 0, 0}; pg8::StaticOrder S; S.init(MTOK, 2 * FF, F.G, (int)blockIdx.x);
#if defined(PROBE_NULL5)
        if (rep_ == 0) { pg8::EpiNull EN{(bf16*)(ws + WS_VG)}; pg8::StaticOrder S2; S2.init(MTOK, DM, F.G, (int)blockIdx.x);   (void)S2;
            pg8::EpiNullWide ENW{(bf16*)(ws + WS_H)}; pg8::gemm_phase<pg8::EpiNullWide, pg8::StaticOrder, PG8_ALIGN, PG8_SP2>(F.lds + RING_OFF, g, S, ENW, F.wave); (void)EN; } else
#endif
        { RELAUNDER(); LAS float* rtab = (LAS float*)(F.lds + RTAB_OFF); const int pm0 = build_rtab(F, S, rs1, rtab); pg8::EpiSwiglu<0> E{A, rtab, pm0};
        pg8::gemm_phase<pg8::EpiSwiglu<0>, pg8::StaticOrder, PG8_ALIGN, PG8_SP2>(F.lds + RING_OFF, g, S, E, F.wave); }
    } SEAM(5);
    if (IN(6)) REP(6) { PHASE_VARS(); STAGGER();
        pg8::Gemm g{HB, (const bf16*)(ws + WS_W2), FF, FF, 0, 0}; BatchRoundOrder S; S.init(MTOK, DM, F.G, (int)blockIdx.x);
#if defined(PROBE_NULL6)
        if (rep_ == 0) { pg8::EpiNull EN{(bf16*)(ws + WS_VG)}; pg8::gemm_phase<pg8::EpiNull, BatchRoundOrder, PG8_ALIGN, PG8_SP2>(F.lds + RING_OFF, g, S, EN, F.wave); } else
#elif defined(PROBE_NOXN6)
        if (rep_ == 0) { pg8::EpiResid<7> E7{A, REPRES(6, WS_VG)}; pg8::gemm_phase<pg8::EpiResid<7>, BatchRoundOrder, PG8_ALIGN, PG8_SP2>(F.lds + RING_OFF, g, S, E7, F.wave); } else
#endif
        { pg8::EpiResid<6> E{A, REPRES(6, WS_VG)};
        pg8::gemm_phase<pg8::EpiResid<6>, BatchRoundOrder, PG8_ALIGN, PG8_SP2>(F.lds + RING_OFF, g, S, E, F.wave); }
        { pg8::Gemm gz{(const bf16*)(ws + WS_RES), (const bf16*)(ws + WS_WPB), 256, DM, 512, 1024 * 256 * 2}; EpiPool EP{A};
          for (int zi = 0; zi < 2; ++zi) { OneUnit S1{&S, zi}; pg8::gemm_phase<EpiPool, OneUnit, PG8_ALIGN, PG8_SP2>(F.lds + RING_OFF, gz, S1, EP, F.wave); } }
    } SEAM(8);

    if (IN(9)) REP(9) { PHASE_VARS();
        pg8::Gemm g{XN, (const bf16*)(ws + WS_W13) + (size_t)5632 * DM, DM, DM, 0, 0}; pg8::StaticOrder S; S.init(MTOK, 2 * FF, F.G, (int)blockIdx.x);
        RELAUNDER(); LAS float* rtab = (LAS float*)(F.lds + RTAB_OFF); const int pm0 = build_rtab(F, S, rs3, rtab); pg8::EpiSwiglu<1> E{A, rtab, pm0};
        pg8::gemm_phase<pg8::EpiSwiglu<1>, pg8::StaticOrder, PG8_ALIGN, PG8_SP2>(F.lds + RING_OFF, g, S, E, F.wave);
    } SEAM(9);
    if (IN(10)) REP(10) { PHASE_VARS(); STAGGER();
        pg8::Gemm g{HB, (const bf16*)(ws + WS_W2) + (size_t)DM * FF, FF, FF, 0, 0}; pg8::StaticOrder S; S.init(MTOK, DM, F.G, (int)blockIdx.x);
        pg8::EpiResid<10> E{A, out};
        pg8::gemm_phase<pg8::EpiResid<10>, pg8::StaticOrder, PG8_ALIGN, PG8_SP2>(F.lds + RING_OFF, g, S, E, F.wave);
    }
#undef IN
#undef SEAM
}

extern "C" void kernel_launch(void* const* d_in, const int* in_sizes, int n_in, void* d_out, int out_size, void* d_ws, size_t ws_size, hipStream_t stream) {
    static int grid = 0;
    if (grid == 0) {
        if (n_in != 21 || out_size != MTOK * DM || ws_size < WS_END) { fprintf(stderr, "kernel_launch: unexpected shapes (n_in %d, out %d, ws %zu)\n", n_in, out_size, ws_size); grid = -1; return; }
        int dev = 0, cus = 0, per_cu = 0;
        if (hipGetDevice(&dev) != hipSuccess || hipDeviceGetAttribute(&cus, hipDeviceAttributeMultiprocessorCount, dev) != hipSuccess) { grid = -1; return; }
        if (hipFuncSetAttribute((const void*)mega_fwd, hipFuncAttributeMaxDynamicSharedMemorySize, LDS_BYTES) != hipSuccess) { fprintf(stderr, "kernel_launch: hipFuncSetAttribute failed\n"); grid = -1; return; }
        if (hipOccupancyMaxActiveBlocksPerMultiprocessor(&per_cu, (const void*)mega_fwd, NWAVES * 64, LDS_BYTES) != hipSuccess || per_cu < 1) { fprintf(stderr, "kernel_launch: occupancy query says %d\n", per_cu); per_cu = 1; }
        (void)hipGetLastError();
        grid = cus;
        if (grid != 256) fprintf(stderr, "kernel_launch: %d CUs (expected 256)\n", grid);
    }
    if (grid < 0) return;
    if (hipMemsetAsync((char*)d_ws + WS_CTL, 0, CTL_ZERO_BYTES, stream) != hipSuccess) return;
    Args a{};
    for (int i = 0; i < 21; ++i) a.in[i] = (const float*)d_in[i];
    a.out = (float*)d_out; a.ws = (unsigned char*)d_ws;
#if defined(MK_PER_PHASE)
    for (int p = 0; p < N_PHASES; ++p) { a.ph_lo = p; a.ph_hi = p + 1; hipLaunchKernelGGL(mega_fwd, dim3(grid), dim3(NWAVES * 64), LDS_BYTES, stream, a); }
#else
    a.ph_lo = 0; a.ph_hi = N_PHASES;
    hipLaunchKernelGGL(mega_fwd, dim3(grid), dim3(NWAVES * 64), LDS_BYTES, stream, a);
#endif
}
```
